# Optimizing an MI355X kernel written in HIP

```python
import math
import jax
import jax.numpy as jnp
from jax import lax
import numpy as np

D_MODEL = 1024
BATCH = 4
SEQ = 4096
DEPTH = 2

H_A = 8
HD_A = 64
W_A = H_A * HD_A
MOBA_BLOCK = 256
MOBA_TOPK = 3
Q_CHUNK = 64
NUM_BUCKETS = 32
MAX_EXACT = NUM_BUCKETS // 2
MAX_DISTANCE = 128
H_B = 4
HD_B = 128
W_B = H_B * HD_B
CONV_K = 4
DN_CHUNK = 64
N_GROUPS = 4
EXPERTS_PER_GROUP = 8
TOPK_IN_GROUP = 2
D_FF_EXPERT = 256
D_IN = 3 * W_A + 4 * W_B + 2 * H_B + 2 * D_MODEL
N_MOD = 6
EPS = 1e-6
NEG = -1e30

kernel_name = "hybrid_moba_gdn_hmoe_block"


def rms_norm(x, w):
    xf = x.astype(jnp.float32)
    y = xf * lax.rsqrt(jnp.mean(xf * xf, axis=-1, keepdims=True) + EPS)
    return (y * w.astype(jnp.float32)).astype(x.dtype)


def l2_normalize(t):
    return t * lax.rsqrt(jnp.sum(t * t, axis=-1, keepdims=True) + EPS)


def t5_bucket(dist):
    n = jnp.maximum(dist, 0)
    nf = jnp.maximum(n, 1).astype(jnp.float32)
    large = MAX_EXACT + (jnp.log(nf / MAX_EXACT) / math.log(MAX_DISTANCE / MAX_EXACT)
                         * (NUM_BUCKETS - MAX_EXACT)).astype(jnp.int32)
    large = jnp.minimum(large, NUM_BUCKETS - 1)
    return jnp.where(n < MAX_EXACT, n, large)


def moba_attention(q, k, v, rel_bias):
    B, H, S, hd = q.shape
    L = MOBA_BLOCK
    Sp = -(-S // L) * L
    pad = ((0, 0), (0, 0), (0, Sp - S), (0, 0))
    q, k, v = jnp.pad(q, pad), jnp.pad(k, pad), jnp.pad(v, pad)
    NB, NQ = Sp // L, Sp // Q_CHUNK
    topk = min(MOBA_TOPK, NB)
    scale = HD_A ** -0.5
    k_blocks = k.reshape(B, H, NB, L, hd)
    v_blocks = v.reshape(B, H, NB, L, hd)
    k_mean = jnp.mean(k_blocks.astype(jnp.float32), axis=3)
    q_blk = jnp.arange(Sp) // L
    gate = jnp.einsum('bhsd,bhnd->bhsn', q.astype(jnp.float32), k_mean)
    gate = jnp.where(jnp.arange(NB)[None, :] < q_blk[:, None], gate, NEG)
    _, sel = lax.top_k(gate, topk)
    q_c = q.reshape(B, H, NQ, Q_CHUNK, hd).transpose(2, 0, 1, 3, 4)
    sel_c = sel.reshape(B, H, NQ, Q_CHUNK, topk).transpose(2, 0, 1, 3, 4)
    bi = jnp.arange(B)[:, None, None, None]
    hi = jnp.arange(H)[None, :, None, None]
    hi5 = hi[..., None]
    offs = jnp.arange(L)

    def one_chunk(args):
        q_i, sel_i, i = args
        qb = (i * Q_CHUNK) // L
        q_pos = i * Q_CHUNK + jnp.arange(Q_CHUNK)
        k_sel = k_blocks[bi, hi, sel_i]
        v_sel = v_blocks[bi, hi, sel_i]
        dist_sel = q_pos[None, None, :, None, None] - (sel_i[..., None] * L + offs)
        bias_sel = rel_bias[t5_bucket(dist_sel), hi5].astype(jnp.float32)
        s_sel = jnp.einsum('bhqd,bhqkld->bhqkl', q_i, k_sel).astype(jnp.float32) * scale + bias_sel
        s_sel = jnp.where((sel_i < qb)[..., None], s_sel, NEG)
        k_own = lax.dynamic_index_in_dim(k_blocks, qb, axis=2, keepdims=False)
        v_own = lax.dynamic_index_in_dim(v_blocks, qb, axis=2, keepdims=False)
        dist_own = q_pos[:, None] - (qb * L + offs)[None, :]
        bias_own = rel_bias[t5_bucket(dist_own)].transpose(2, 0, 1).astype(jnp.float32)
        s_own = jnp.einsum('bhqd,bhld->bhql', q_i, k_own).astype(jnp.float32) * scale + bias_own
        s_own = jnp.where(dist_own >= 0, s_own, NEG)
        p = jax.nn.softmax(jnp.concatenate(
            [s_sel.reshape(B, H, Q_CHUNK, topk * L), s_own], axis=-1), axis=-1)
        p_sel = p[..., :topk * L].reshape(B, H, Q_CHUNK, topk, L).astype(v.dtype)
        p_own = p[..., topk * L:].astype(v.dtype)
        return (jnp.einsum('bhqkl,bhqkld->bhqd', p_sel, v_sel)
                + jnp.einsum('bhql,bhld->bhqd', p_own, v_own))

    o = lax.map(one_chunk, (q_c, sel_c, jnp.arange(NQ)))
    o = o.transpose(1, 2, 0, 3, 4).reshape(B, H, Sp, hd)
    return o[:, :, :S]


def causal_depthwise_conv(x, w):
    C = x.shape[-1]
    return lax.conv_general_dilated(
        x, w[:, None, :].astype(x.dtype), window_strides=(1,), padding=[(CONV_K - 1, 0)],
        dimension_numbers=('NWC', 'WIO', 'NWC'), feature_group_count=C)


def gated_delta_rule(q, k, v, beta, g):
    out_dtype = v.dtype
    B, S, H, DK = q.shape
    DV = v.shape[-1]
    C = DN_CHUNK
    N = S // C
    f32 = jnp.float32
    q = l2_normalize(q.astype(f32)) * (DK ** -0.5)
    k = l2_normalize(k.astype(f32))
    v = v.astype(f32)

    def chunk(t):
        return t.reshape(B, N, C, H, -1).transpose(0, 3, 1, 2, 4)

    q, k, v = chunk(q), chunk(k), chunk(v)
    beta = beta.astype(f32).reshape(B, N, C, H).transpose(0, 3, 1, 2)
    G = jnp.cumsum(g.astype(f32).reshape(B, N, C, H).transpose(0, 3, 1, 2), axis=-1)
    tril = jnp.tril(jnp.ones((C, C), bool))
    strict = jnp.tril(jnp.ones((C, C), bool), -1)
    dec = jnp.exp(jnp.where(tril, G[..., :, None] - G[..., None, :], -jnp.inf))
    kb = k * beta[..., None]
    A = jnp.eye(C, dtype=f32) + jnp.where(strict, jnp.einsum('bhnid,bhnjd->bhnij', kb, k) * dec, 0.0)
    u = lax.linalg.triangular_solve(A, v * beta[..., None], left_side=True, lower=True, unit_diagonal=True)
    w = lax.linalg.triangular_solve(A, kb * jnp.exp(G)[..., None], left_side=True, lower=True, unit_diagonal=True)
    P = jnp.einsum('bhnid,bhnjd->bhnij', q, k) * dec
    qg = q * jnp.exp(G)[..., None]
    kd = k * jnp.exp(G[..., -1:] - G)[..., None]
    gl = jnp.exp(G[..., -1])
    xs = tuple(jnp.moveaxis(t, 2, 0) for t in (u, w, qg, P, kd, gl))

    def step(state, inp):
        u_n, w_n, qg_n, P_n, kd_n, gl_n = inp
        v_new = u_n - jnp.einsum('bhck,bhkv->bhcv', w_n, state)
        o_n = jnp.einsum('bhck,bhkv->bhcv', qg_n, state) + jnp.einsum('bhcj,bhjv->bhcv', P_n, v_new)
        state = state * gl_n[..., None, None] + jnp.einsum('bhck,bhcv->bhkv', kd_n, v_new)
        return state, o_n

    _, o = lax.scan(step, jnp.zeros((B, H, DK, DV), f32), xs)
    return o.transpose(1, 0, 3, 2, 4).reshape(B, S, H, DV).astype(out_dtype)


def token_mixer(h, rel_bias, w_in, conv_w, a_log, dt_bias, onorm_w, w_up_a, w_up_b, w_out):
    B, S, _ = h.shape
    proj = h @ w_in
    sizes = (W_A, W_A, W_A, 3 * W_B, W_B, H_B, H_B, D_MODEL, D_MODEL)
    offs = np.cumsum(sizes)[:-1].tolist()
    qa, ka, va, qkv_b, z_b, b_b, a_b, gate_a, gate_b = jnp.split(proj, offs, axis=-1)
    heads_a = lambda t: t.reshape(B, S, H_A, HD_A).transpose(0, 2, 1, 3)
    y_a = moba_attention(heads_a(qa), heads_a(ka), heads_a(va), rel_bias)
    y_a = y_a.transpose(0, 2, 1, 3).reshape(B, S, W_A)
    qkv_b = jax.nn.silu(causal_depthwise_conv(qkv_b, conv_w))
    q_b, k_b, v_b = (t.reshape(B, S, H_B, HD_B) for t in jnp.split(qkv_b, 3, axis=-1))
    beta = jax.nn.sigmoid(b_b)
    g = -jnp.exp(a_log) * jax.nn.softplus(a_b + dt_bias)
    o_b = gated_delta_rule(q_b, k_b, v_b, beta, g)
    o_b = rms_norm(o_b, onorm_w) * jax.nn.silu(z_b.reshape(B, S, H_B, HD_B))
    y_b = o_b.reshape(B, S, W_B)
    m = jax.nn.sigmoid(gate_a) * (y_a @ w_up_a) + jax.nn.sigmoid(gate_b) * (y_b @ w_up_b)
    return m @ w_out


def hier_moe(h, w_rg, b_rg, w_re, b_re, w_e_gate, w_e_up, w_e_down):
    B, S, D = h.shape
    t = h.reshape(-1, D)
    T = t.shape[0]
    pg = jax.nn.softmax((t @ w_rg + b_rg).astype(jnp.float32), axis=-1)
    p_top, g_top = lax.top_k(pg, 1)
    oh_g = jax.nn.one_hot(g_top[:, 0], N_GROUPS, dtype=jnp.float32)
    le = (t @ w_re + b_re).astype(jnp.float32).reshape(T, N_GROUPS, EXPERTS_PER_GROUP)
    le_g = jnp.einsum('tge,tg->te', le, oh_g)
    v2, e2 = lax.top_k(le_g, TOPK_IN_GROUP)
    w2 = jax.nn.softmax(v2, axis=-1) * p_top
    comb_e = jnp.sum(w2[..., None] * jax.nn.one_hot(e2, EXPERTS_PER_GROUP, dtype=jnp.float32), axis=1)
    comb = (oh_g[:, :, None] * comb_e[:, None, :]).astype(t.dtype)
    y = jnp.zeros_like(t)
    for gi in range(N_GROUPS):
        a = jax.nn.silu(jnp.einsum('td,edf->tef', t, w_e_gate[gi])) * jnp.einsum('td,edf->tef', t, w_e_up[gi])
        y = y + jnp.einsum('tef,te,efd->td', a, comb[:, gi], w_e_down[gi])
    return y.reshape(B, S, D)


def setup_inputs(seed: int = 0) -> dict:
    key = jax.random.key(seed)
    ks = iter(jax.random.split(key, 32))
    L, D = DEPTH, D_MODEL
    G, E, F = N_GROUPS, EXPERTS_PER_GROUP, D_FF_EXPERT

    def nrm(shape, std):
        return std * jax.random.normal(next(ks), shape, jnp.float32)

    x = nrm((BATCH, SEQ, D), 1.0)
    c = nrm((BATCH, D), 1.0)
    rel_bias = nrm((NUM_BUCKETS, H_A), 0.5)
    final_norm_w = 1.0 + nrm((D,), 0.02)
    norm1_w = 1.0 + nrm((L, D), 0.02)
    norm2_w = 1.0 + nrm((L, D), 0.02)
    w_mod = nrm((L, D, N_MOD * D), 0.5 * D ** -0.5)
    b_mod = nrm((L, N_MOD * D), 0.02)
    w_in = nrm((L, D, D_IN), D ** -0.5)
    conv_w = nrm((L, CONV_K, 3 * W_B), CONV_K ** -0.5)
    a_log = jnp.log(jax.random.uniform(next(ks), (L, H_B), jnp.float32, 1.0, 16.0))
    dt = jnp.exp(jax.random.uniform(next(ks), (L, H_B), jnp.float32, math.log(1e-3), math.log(1e-1)))
    dt_bias = dt + jnp.log(-jnp.expm1(-dt))
    onorm_w = 1.0 + nrm((L, HD_B), 0.02)
    w_up_a = nrm((L, W_A, D), W_A ** -0.5)
    w_up_b = nrm((L, W_B, D), W_B ** -0.5)
    w_out = nrm((L, D, D), D ** -0.5)
    w_rg = nrm((L, D, G), D ** -0.5)
    b_rg = nrm((L, G), 0.01)
    w_re = nrm((L, D, G * E), D ** -0.5)
    b_re = nrm((L, G * E), 0.01)
    w_e_gate = nrm((L, G, E, D, F), D ** -0.5)
    w_e_up = nrm((L, G, E, D, F), D ** -0.5)
    w_e_down = nrm((L, G, E, F, D), F ** -0.5)
    return {"x": x, "c": c, "rel_bias": rel_bias, "final_norm_w": final_norm_w,
            "norm1_w": norm1_w, "norm2_w": norm2_w, "w_mod": w_mod, "b_mod": b_mod,
            "w_in": w_in, "conv_w": conv_w, "a_log": a_log, "dt_bias": dt_bias,
            "onorm_w": onorm_w, "w_up_a": w_up_a, "w_up_b": w_up_b, "w_out": w_out,
            "w_rg": w_rg, "b_rg": b_rg, "w_re": w_re, "b_re": b_re,
            "w_e_gate": w_e_gate, "w_e_up": w_e_up, "w_e_down": w_e_down}


def reference(x, c, rel_bias, final_norm_w, norm1_w, norm2_w, w_mod, b_mod, w_in, conv_w,
              a_log, dt_bias, onorm_w, w_up_a, w_up_b, w_out, w_rg, b_rg, w_re, b_re,
              w_e_gate, w_e_up, w_e_down):
    c_act = jax.nn.silu(c)
    for l in range(DEPTH):
        mod = (c_act @ w_mod[l] + b_mod[l])[:, None, :]
        sh1, sc1, g1, sh2, sc2, g2 = jnp.split(mod, N_MOD, axis=-1)
        h = rms_norm(x, norm1_w[l]) * (1.0 + sc1) + sh1
        x = x + g1 * token_mixer(h, rel_bias, w_in[l], conv_w[l], a_log[l], dt_bias[l],
                                 onorm_w[l], w_up_a[l], w_up_b[l], w_out[l])
        h = rms_norm(x, norm2_w[l]) * (1.0 + sc2) + sh2
        x = x + g2 * hier_moe(h, w_rg[l], b_rg[l], w_re[l], b_re[l],
                              w_e_gate[l], w_e_up[l], w_e_down[l])
    return rms_norm(x, final_norm_w)
```

```cpp
#include <hip/hip_runtime.h>
#include <cstdio>
#include <cstdint>
#ifndef MK_ONE_LAUNCH
#define MK_ONE_LAUNCH 1
#endif
namespace pg8 {
#define PG8_LAS __attribute__((address_space(3)))
typedef unsigned short bf16_t;
typedef short bf16x8 __attribute__((ext_vector_type(8)));
typedef float f32x4 __attribute__((ext_vector_type(4)));
typedef unsigned u32x4 __attribute__((ext_vector_type(4)));
constexpr int BM = 256, BK = 64, HALF = 128, HTB = HALF * BK * 2  , STAGE_BYTES = 8 * HTB, NXCD = 8, WGM = 8;

__host__ __device__ __forceinline__ int lds_byte(int r, int c) { const int st = (r >> 4) * 2 + (c >> 5), rr = r & 15, cc = c & 31, ob = rr * 64 + cc * 2; return st * 1024 + (ob ^ (((ob >> 9) & 1) << 5)); }
__host__ __device__ __forceinline__ void stage_rc(int b, int& R, int& C) { const int st = b / 1024, sb = b % 1024, swz = sb ^ (((sb >> 9) & 1) << 5); R = (st >> 1) * 16 + swz / 64; C = (st & 1) * 32 + (swz % 64) / 2; }
__host__ __device__ __forceinline__ int perm32(int rho) { const int n = rho >> 4, i = rho & 15; return 8 * (i >> 2) + 4 * n + (i & 3); }

struct Unit { int pm, pn; };
struct Gemm { const bf16_t* A; const bf16_t* Bt; int M, N, K; };

struct StaticOrder {
    int nM, nN, nwg, G, c;
    __host__ __device__ void init(int M, int N, int G_, int c_) { nM = M / BM; nN = N / BM; nwg = nM * nN; G = G_; c = c_; }
    __host__ __device__ bool next(int i, Unit& u) const {
        const long L = (long)i * G + c; if (L >= nwg) return false;
        int wgid = (int)L; { const int q = nwg / NXCD, r = nwg % NXCD, xcd = wgid % NXCD, off = wgid / NXCD; wgid = (xcd < r ? xcd * (q + 1) : r * (q + 1) + (xcd - r) * q) + off; }
        const int nig = WGM * nN, gid = wgid / nig, fm = gid * WGM, gsz = (nM - fm) < WGM ? (nM - fm) : WGM;
        u.pm = fm + ((wgid % nig) % gsz); u.pn = (wgid % nig) / gsz; return true;
    }
    __device__ __forceinline__ void a_ready(const Unit&) const {}
    __device__ __forceinline__ void done(const Unit&) const {}
};

__device__ __forceinline__ unsigned cvt_pk_bf16(float lo, float hi) { unsigned r; asm volatile("v_cvt_pk_bf16_f32 %0, %1, %2" : "=v"(r) : "v"(lo), "v"(hi)); return r; }
typedef float f32x2 __attribute__((ext_vector_type(2)));
template <class Epi, class Sched, bool ALIGN_EPI = false, bool SP2 = false>
__device__ __forceinline__ void gemm_phase(PG8_LAS unsigned char* lds, const Gemm g, const Sched& S, const Epi& E, const int tid_in) {
    const int tid = tid_in, wid = __builtin_amdgcn_readfirstlane(tid >> 6), lane = tid & 63, wr = wid >> 2, wc = wid & 3, fr = lane & 15, fq = lane >> 4;
    const int K = g.K, nt = K / BK;
    unsigned voffA[2], voffB[2];
#pragma unroll
    for (int i = 0; i < 2; ++i) { int R, C; stage_rc(tid * 16 + i * 8192, R, C); const int Rb = Epi::PERM ? ((R & ~31) + perm32(R & 31)) : R;
        voffA[i] = (unsigned)(R * K + C) * 2u; voffB[i] = (unsigned)(Rb * K + C) * 2u; }
    const size_t kstep = (size_t)(BK * 2);
    const size_t hstep = (size_t)HALF * K * 2;
    const size_t tstep = 2 * hstep;
    const unsigned ldsw = (unsigned)wid * 1024u;
    const int aoff = lds_byte(wr * 64 + fr, fq * 8), boff = lds_byte(wc * 32 + fr, fq * 8);
#define PG8_SA(b, h) (((b) * 2 + (h)) * HTB)
#define PG8_SB(b, h) ((4 + (b) * 2 + (h)) * HTB)
#define PG8_STAGE(bufoff, gbase, voff) do { _Pragma("unroll") for (int _i = 0; _i < 2; ++_i) \
        __builtin_amdgcn_global_load_lds((const unsigned*)((const char*)(gbase) + (voff)[_i]), (PG8_LAS unsigned*)(lds + (bufoff) + ldsw + _i * 8192), 16, 0, 0); } while (0)
#define PG8_LDA(dst, b, h) do { _Pragma("unroll") for (int m = 0; m < 4; ++m) _Pragma("unroll") for (int k = 0; k < 2; ++k) dst[m][k] = *(const PG8_LAS bf16x8*)(lds + PG8_SA(b, h) + aoff + m * 2048 + k * 1024); } while (0)
#define PG8_LDB(dst, b, h) do { _Pragma("unroll") for (int n = 0; n < 2; ++n) _Pragma("unroll") for (int k = 0; k < 2; ++k) dst[n][k] = *(const PG8_LAS bf16x8*)(lds + PG8_SB(b, h) + boff + n * 2048 + k * 1024); } while (0)
#define PG8_MMA(ai, bj, At, Bt) do { __builtin_amdgcn_s_setprio(1); _Pragma("unroll") for (int m = 0; m < 4; ++m) _Pragma("unroll") for (int n = 0; n < 2; ++n) _Pragma("unroll") for (int k = 0; k < 2; ++k) \
        acc[ai][bj][m][n] = __builtin_amdgcn_mfma_f32_16x16x32_bf16(Bt[n][k], At[m][k], acc[ai][bj][m][n], 0, 0, 0); __builtin_amdgcn_s_setprio(0); } while (0)
#define PG8_WAIT_V(n) asm volatile("s_waitcnt vmcnt(" #n ")" ::: "memory")
#define PG8_WAIT_L(n) asm volatile("s_waitcnt lgkmcnt(" #n ")" ::: "memory")
#define PG8_BAR __builtin_amdgcn_s_barrier()
#define PG8_SCHED __builtin_amdgcn_sched_barrier(0)
    Unit cur, nxt; int ui = 0;
    if (!S.next(0, cur)) return;
    f32x4 acc[2][2][4][2];
    float zf_ = 0.f; asm volatile("" : "+v"(zf_));
#pragma unroll
    for (int a = 0; a < 2; ++a)
#pragma unroll
        for (int b = 0; b < 2; ++b)
#pragma unroll
            for (int m = 0; m < 4; ++m)
#pragma unroll
                for (int n = 0; n < 2; ++n) acc[a][b][m][n] = (f32x4){zf_, zf_, zf_, zf_};
    bf16x8 At[4][2], B0[2][2], B1[2][2];
    const char* cA = (const char*)g.A + (size_t)cur.pm * tstep; const char* cB = (const char*)g.Bt + (size_t)cur.pn * tstep;
    S.a_ready(cur);
    if constexpr (SP2) {
        PG8_STAGE(PG8_SB(0, 0), cB, voffB); PG8_STAGE(PG8_SB(0, 1), cB + hstep, voffB); PG8_STAGE(PG8_SA(0, 0), cA, voffA); PG8_STAGE(PG8_SA(0, 1), cA + hstep, voffA);
        if (wr == 1) PG8_BAR;
        PG8_WAIT_V(2); PG8_BAR;
        PG8_STAGE(PG8_SB(1, 0), cB + kstep, voffB); PG8_STAGE(PG8_SA(1, 0), cA + kstep, voffA); PG8_STAGE(PG8_SB(1, 1), cB + hstep + kstep, voffB);
        PG8_WAIT_V(6); PG8_BAR;
    } else {
        PG8_STAGE(PG8_SB(0, 0), cB, voffB); PG8_STAGE(PG8_SA(0, 0), cA, voffA); PG8_STAGE(PG8_SB(0, 1), cB + hstep, voffB); PG8_STAGE(PG8_SA(0, 1), cA + hstep, voffA);
        if (wr == 1) PG8_BAR;
        PG8_WAIT_V(4); PG8_BAR;
        PG8_STAGE(PG8_SB(1, 0), cB + kstep, voffB); PG8_STAGE(PG8_SA(1, 0), cA + kstep, voffA); PG8_STAGE(PG8_SB(1, 1), cB + hstep + kstep, voffB);
        PG8_WAIT_V(6); PG8_BAR;
    }
    for (;;) {
        const bool has_next = S.next(ui + 1, nxt);
        const char* nA = has_next ? (const char*)g.A + (size_t)nxt.pm * tstep : cA; const char* nB = has_next ? (const char*)g.Bt + (size_t)nxt.pn * tstep : cB;
        for (int t = 0; t < nt; t += 2) {
            const bool last = (t == nt - 2);
            const char* a1 = cA + (size_t)(t + 1) * kstep;
            const char* a2 = last ? nA : cA + (size_t)(t + 2) * kstep; const char* b2 = last ? nB : cB + (size_t)(t + 2) * kstep;
            const char* a3 = a2 + kstep; const char* b3 = b2 + kstep;
            if (last && has_next) S.a_ready(nxt);
            if constexpr (SP2) {
            PG8_LDB(B0, 0, 0); PG8_LDB(B1, 0, 1); PG8_SCHED; PG8_LDA(At, 0, 0); PG8_STAGE(PG8_SA(1, 1), a1 + hstep, voffA);
            PG8_WAIT_V(8); PG8_WAIT_L(0); PG8_BAR; PG8_MMA(0, 0, At, B0); PG8_MMA(0, 1, At, B1); PG8_BAR; PG8_SCHED;
            PG8_LDA(At, 0, 1); PG8_STAGE(PG8_SB(0, 0), b2, voffB); PG8_STAGE(PG8_SB(0, 1), b2 + hstep, voffB); PG8_STAGE(PG8_SA(0, 0), a2, voffA);
            PG8_WAIT_V(8); PG8_WAIT_L(0); PG8_BAR; PG8_MMA(1, 0, At, B0); PG8_MMA(1, 1, At, B1); PG8_BAR; PG8_SCHED;
            PG8_LDB(B0, 1, 0); PG8_LDB(B1, 1, 1); PG8_SCHED; PG8_LDA(At, 1, 0); PG8_STAGE(PG8_SA(0, 1), a2 + hstep, voffA);
            PG8_WAIT_V(8); PG8_WAIT_L(0); PG8_BAR; PG8_MMA(0, 0, At, B0); PG8_MMA(0, 1, At, B1); PG8_BAR; PG8_SCHED;
            PG8_LDA(At, 1, 1); PG8_STAGE(PG8_SB(1, 0), b3, voffB); PG8_STAGE(PG8_SB(1, 1), b3 + hstep, voffB); PG8_STAGE(PG8_SA(1, 0), a3, voffA);
            PG8_WAIT_V(8); PG8_WAIT_L(0); PG8_BAR; PG8_MMA(1, 0, At, B0); PG8_MMA(1, 1, At, B1); PG8_BAR; PG8_SCHED;
            } else {
            PG8_LDB(B0, 0, 0); PG8_SCHED; PG8_LDA(At, 0, 0); PG8_STAGE(PG8_SA(1, 1), a1 + hstep, voffA);
            PG8_WAIT_L(8); PG8_BAR; PG8_WAIT_L(0); PG8_MMA(0, 0, At, B0); PG8_BAR; PG8_SCHED;
            PG8_LDB(B1, 0, 1); PG8_STAGE(PG8_SB(0, 0), b2, voffB);
            PG8_BAR; PG8_WAIT_L(0); PG8_MMA(0, 1, At, B1); PG8_BAR;
            PG8_LDA(At, 0, 1); PG8_STAGE(PG8_SA(0, 0), a2, voffA);
            PG8_BAR; PG8_WAIT_L(0); PG8_MMA(1, 0, At, B0); PG8_BAR; PG8_SCHED;
            PG8_STAGE(PG8_SB(0, 1), b2 + hstep, voffB);
            PG8_WAIT_V(6); PG8_BAR; PG8_MMA(1, 1, At, B1); PG8_BAR;
            PG8_LDB(B0, 1, 0); PG8_SCHED; PG8_LDA(At, 1, 0); PG8_STAGE(PG8_SA(0, 1), a2 + hstep, voffA);
            PG8_WAIT_L(8); PG8_BAR; PG8_WAIT_L(0); PG8_MMA(0, 0, At, B0); PG8_BAR; PG8_SCHED;
            PG8_LDB(B1, 1, 1); PG8_STAGE(PG8_SB(1, 0), b3, voffB);
            PG8_BAR; PG8_WAIT_L(0); PG8_MMA(0, 1, At, B1); PG8_BAR;
            PG8_LDA(At, 1, 1); PG8_STAGE(PG8_SA(1, 0), a3, voffA);
            PG8_BAR; PG8_WAIT_L(0); PG8_MMA(1, 0, At, B0); PG8_BAR; PG8_SCHED;
            PG8_STAGE(PG8_SB(1, 1), b3 + hstep, voffB);
            PG8_WAIT_V(6); PG8_BAR; PG8_MMA(1, 1, At, B1); PG8_BAR;
            }
        }
        if constexpr (ALIGN_EPI) { if (wr == 0) PG8_BAR; }
        if constexpr (!Epi::AFTER_DRAIN) { E(acc, cur, wr, wc, fr, fq); S.done(cur); }
        if (!has_next) break;
        zf_ = 0.f; asm volatile("" : "+v"(zf_));
#pragma unroll
        for (int a = 0; a < 2; ++a)
#pragma unroll
            for (int b = 0; b < 2; ++b)
#pragma unroll
                for (int m = 0; m < 4; ++m)
#pragma unroll
                    for (int n = 0; n < 2; ++n) acc[a][b][m][n] = (f32x4){zf_, zf_, zf_, zf_};
        cur = nxt; cA = nA; cB = nB; ++ui;
        if constexpr (ALIGN_EPI) { if (wr == 1) PG8_BAR; }
    }
    PG8_WAIT_V(0);
    if constexpr (!ALIGN_EPI) { if (wr == 0) PG8_BAR; }
    PG8_BAR;
    if constexpr (Epi::AFTER_DRAIN) { E.fused(acc, cur, wr, wc, fr, fq, lds, wid, lane); S.done(cur); }
#undef PG8_SA
#undef PG8_SB
#undef PG8_STAGE
#undef PG8_LDA
#undef PG8_LDB
#undef PG8_MMA
#undef PG8_WAIT_V
#undef PG8_WAIT_L
#undef PG8_BAR
#undef PG8_SCHED
}
}
constexpr int NW = 8, NTHR = 512;
constexpr int DM = 1024, NB = 4, SEQ = 4096, NTOK = NB * SEQ, NLAYER = 2;
constexpr int HA = 8, HDA = 64, WA = 512, MBLK = 256, NBLK = SEQ / MBLK;
constexpr int HB = 4, HDB = 128, WB = 512, CONVK = 4, DNC = 64, NCH = SEQ / DNC;
constexpr int NGRP = 4, EPG = 8, NEXP = 32, DFF = 256;
constexpr int DIN = 5640, DINP = 5632, NMOD = 6;
constexpr int C_QKVA = 0, C_QKVB = 1536, C_ZB = 3072, C_BA = 3584, C_GATE = 3592;
constexpr float EPS = 1e-6f;
constexpr int MOE_MAXROWS = 2 * NTOK + NEXP * 256;
constexpr int MOE_MAXTILES = MOE_MAXROWS / 256;

constexpr size_t MiB = 1u << 20;
constexpr size_t WS_CTL = 0, CTL_ZERO_BYTES = 1 * MiB;
constexpr size_t WS_MOD = 1 * MiB;
constexpr size_t WS_WIN = 2 * MiB;
constexpr size_t WS_WUPA = 13 * MiB, WS_WUPB = 14 * MiB;
constexpr size_t WS_WOUT = 15 * MiB;
constexpr size_t WS_WEGU = 17 * MiB;
constexpr size_t WS_WED = 49 * MiB;
constexpr size_t WS_SMALL = 65 * MiB;
constexpr size_t WS_KMEAN = WS_SMALL;
constexpr size_t WS_BETA = WS_SMALL + 256 * 1024;
constexpr size_t WS_GLOG = WS_SMALL + 512 * 1024;
constexpr size_t WS_TOKINFO = WS_SMALL + 1 * MiB;
constexpr size_t WS_ROWTOK = WS_SMALL + 2 * MiB;
constexpr size_t WS_ROWW = WS_SMALL + 3 * MiB;
constexpr size_t WS_GL = WS_SMALL + 4 * MiB;
constexpr size_t WS_H = 72 * MiB;
constexpr size_t WS_QKVA = 104 * MiB;
constexpr size_t WS_QKVB = 152 * MiB;
constexpr size_t WS_ZB = 200 * MiB;
constexpr size_t WS_GATES = 216 * MiB;
constexpr size_t WS_QG = 280 * MiB, WS_KD = 296 * MiB;
constexpr size_t WS_P = 312 * MiB;
constexpr size_t WS_YA = 320 * MiB, WS_YB = 336 * MiB;
constexpr size_t WS_END = 352 * MiB;
constexpr size_t WS_M = WS_QKVB;
constexpr size_t WS_U = WS_H, WS_W = WS_H + 16 * MiB;
constexpr size_t WS_HS = WS_QKVA;
constexpr size_t WS_ACT = 184 * MiB;
constexpr size_t WS_YS = WS_GATES;
constexpr int CW_TMO = 0;
constexpr int CW_BAR = 4096;
constexpr int CW_GCNT = 8192;

constexpr int RING_BYTES = 131072;
constexpr int MISC_OFF = RING_BYTES;
constexpr int LDS_BYTES = 147456;

#define GAS __attribute__((address_space(1)))
#define LAS __attribute__((address_space(3)))
typedef unsigned short bf16;
typedef unsigned v4u __attribute__((ext_vector_type(4)));
typedef unsigned v2u __attribute__((ext_vector_type(2)));
typedef float f32x4 __attribute__((ext_vector_type(4)));
typedef float f32x16 __attribute__((ext_vector_type(16)));
typedef short bf16x8 __attribute__((ext_vector_type(8)));
typedef GAS unsigned gu32;
#define RLX_AGENT __ATOMIC_RELAXED, __HIP_MEMORY_SCOPE_AGENT
#define LDS_WAIT() asm volatile("s_waitcnt lgkmcnt(0)" ::: "memory")
#define VM_WAIT() asm volatile("s_waitcnt vmcnt(0)" ::: "memory")
__device__ __forceinline__ unsigned f2bf(float f) { unsigned u = __builtin_bit_cast(unsigned, f); return (u + 0x7fffu + ((u >> 16) & 1u)) >> 16; }
__device__ __forceinline__ unsigned pk2(float lo, float hi) { return f2bf(lo) | (f2bf(hi) << 16); }
__device__ __forceinline__ float bf2f(unsigned b) { return __builtin_bit_cast(float, b << 16); }
__device__ __forceinline__ float bflo(unsigned w) { return __builtin_bit_cast(float, w << 16); }
__device__ __forceinline__ float bfhi(unsigned w) { return __builtin_bit_cast(float, w & 0xffff0000u); }
__device__ __forceinline__ float sigmoidf_(float x) { return 1.f / (1.f + __expf(-x)); }
__device__ __forceinline__ float siluf_(float x) { return x / (1.f + __expf(-x)); }
__device__ __forceinline__ float shx(float v, int o, int lane) { return __builtin_bit_cast(float, __builtin_amdgcn_ds_bpermute((lane ^ o) << 2, __builtin_bit_cast(int, v))); }
__device__ __forceinline__ float shidx(float v, int src) { return __builtin_bit_cast(float, __builtin_amdgcn_ds_bpermute(src << 2, __builtin_bit_cast(int, v))); }
__device__ __forceinline__ int shidx_i(int v, int src) { return __builtin_amdgcn_ds_bpermute(src << 2, v); }
__device__ __forceinline__ float wave_sum(float v, int lane) {
#pragma unroll
    for (int o = 1; o < 64; o <<= 1) v += shx(v, o, lane);
    return v;
}
__device__ __forceinline__ float wave_max(float v, int lane) {
#pragma unroll
    for (int o = 1; o < 64; o <<= 1) v = fmaxf(v, shx(v, o, lane));
    return v;
}
__device__ const unsigned char T5B[128] = {0, 1, 2, 3, 4, 5, 6, 7, 8, 9, 10, 11, 12, 13, 14, 15, 16, 16, 16, 17, 17, 18, 18, 18, 19, 19, 19, 20, 20, 20, 20, 21, 21, 21, 21, 22, 22, 22, 22, 22, 23, 23, 23, 23, 23, 23, 24, 24, 24, 24, 24, 24, 25, 25, 25, 25, 25, 25, 25, 26, 26, 26, 26, 26, 26, 26, 26, 27, 27, 27, 27, 27, 27, 27, 27, 27, 27, 28, 28, 28, 28, 28, 28, 28, 28, 28, 28, 29, 29, 29, 29, 29, 29, 29, 29, 29, 29, 29, 29, 30, 30, 30, 30, 30, 30, 30, 30, 30, 30, 30, 30, 30, 30, 31, 31, 31, 31, 31, 31, 31, 31, 31, 31, 31, 31, 31, 31, 31};

#define XB_TMO      128
#define XB_XCNT(j)  (256  + 64 * (j))
#define XB_XSUB(j)  (1280 + 64 * (j))
#define XB_XGEN(j)  (2304 + 64 * (j))
#define XB_TOP      3328
#define XB_TOPGEN   3392
#define XCD_BAR_WORDS 3456
#define XB_SPIN_CAP (1u << 18)

__device__ __forceinline__ unsigned xb_ld(unsigned* p)              { return __hip_atomic_load(p, __ATOMIC_RELAXED, __HIP_MEMORY_SCOPE_AGENT); }
__device__ __forceinline__ unsigned xb_add(unsigned* p, unsigned v) { return __hip_atomic_fetch_add(p, v, __ATOMIC_RELAXED, __HIP_MEMORY_SCOPE_AGENT); }
__device__ __forceinline__ unsigned xb_xcc_id() { return (unsigned)__builtin_amdgcn_s_getreg((3 << 11) | 20) & 0xFu; }
#define XB_SPIN(cond, bar) do { unsigned _sp = 0; while (cond) { __builtin_amdgcn_s_sleep(1); \
    if ((++_sp & 255u) == 0u) { if (xb_ld(&(bar)[XB_TMO])) break; if (_sp > XB_SPIN_CAP) { atomicAdd(&(bar)[XB_TMO], 1u); break; } } } } while (0)

struct XcdBarrier {
    unsigned* bar; unsigned x;
    volatile LAS unsigned* st;
};

__device__ __forceinline__ XcdBarrier xcd_barrier_post(unsigned* bar, volatile LAS unsigned* st, const int tid_in) {
    XcdBarrier b; b.bar = bar; b.x = xb_xcc_id(); b.st = st;
    if (tid_in == 0) (void)xb_add(&bar[XB_XCNT(b.x)], 1u);
    return b;
}
__device__ __forceinline__ void xcd_barrier_complete(unsigned* bar, unsigned x, unsigned& nloc, unsigned& nx) {
    const unsigned G = gridDim.x * gridDim.y * gridDim.z;
    unsigned sum, cnt, mine, sp = 0u;
    for (;;) {
        sum = 0u; cnt = 0u; mine = 0u;
#pragma unroll
        for (unsigned j = 0; j < 16; ++j) { const unsigned c = xb_ld(&bar[XB_XCNT(j)]); sum += c; cnt += (c > 0u) ? 1u : 0u; mine = (j == x) ? c : mine; }
        if (sum == G) break;
        __builtin_amdgcn_s_sleep(1);
        if ((++sp & 255u) == 0u) { if (xb_ld(&bar[XB_TMO])) break; if (sp > XB_SPIN_CAP) { atomicAdd(&bar[XB_TMO], 1u); break; } }
    }
    nloc = mine > 0u ? mine : 1u; nx = cnt > 0u ? cnt : 1u;
}

__device__ __forceinline__ void xcd_barrier(const XcdBarrier& b, const int tid_in) {
    asm volatile("s_waitcnt vmcnt(0)" ::: "memory");
    __syncthreads();
    if (tid_in == 0) {
        unsigned* bar = b.bar;
        __builtin_amdgcn_s_waitcnt(0);
        unsigned nloc = b.st[0], nx = b.st[1];
        if (nloc == 0u) { xcd_barrier_complete(bar, b.x, nloc, nx); b.st[0] = nloc; b.st[1] = nx; }
        const unsigned old = xb_add(&bar[XB_XSUB(b.x)], 1u);
        const unsigned gen = old / nloc;
        if (old + 1u == (gen + 1u) * nloc) {
            __builtin_amdgcn_fence(__ATOMIC_RELEASE, "agent");
            asm volatile("s_waitcnt vmcnt(0)" ::: "memory");
            const unsigned og = xb_add(&bar[XB_TOP], 1u);
            const unsigned tg = og / nx;
            if (og + 1u == (tg + 1u) * nx) xb_add(&bar[XB_TOPGEN], 1u);
            else XB_SPIN(xb_ld(&bar[XB_TOPGEN]) == tg, bar);
            __builtin_amdgcn_fence(__ATOMIC_ACQUIRE, "agent");
            xb_add(&bar[XB_XGEN(b.x)], 1u);
            asm volatile("s_waitcnt vmcnt(0)" ::: "memory");
        } else {
            XB_SPIN(xb_ld(&bar[XB_XGEN(b.x)]) == gen, bar);
            __builtin_amdgcn_fence(__ATOMIC_ACQUIRE, "agent");
            asm volatile("s_waitcnt vmcnt(0)" ::: "memory");
        }
    }
    __syncthreads();
}
struct Args { const float* in[23]; float* out; unsigned char* ws; int ph_lo, ph_hi; };
enum { I_X = 0, I_C, I_RELB, I_FNW, I_N1W, I_N2W, I_WMOD, I_BMOD, I_WIN, I_CONVW, I_ALOG, I_DTB, I_ONW, I_WUPA, I_WUPB, I_WOUT, I_WRG, I_BRG, I_WRE, I_BRE, I_WEG, I_WEU, I_WED };

typedef const Args __attribute__((address_space(4)))* KArgs;
struct Ctx { LAS unsigned char* lds; int tid, lane, wave, bid, G; };
extern __shared__ __attribute__((aligned(16))) unsigned char lds_raw[];
__device__ __forceinline__ Ctx make_ctx(int& tid) { Ctx c; c.lds = (LAS unsigned char*)lds_raw; asm volatile("" : "+v"(tid)); const int t = tid; c.tid = t; c.lane = t & 63; c.wave = __builtin_amdgcn_readfirstlane(t >> 6); int bi = blockIdx.x, gd = gridDim.x; asm volatile("" : "+s"(bi), "+s"(gd)); c.bid = bi; c.G = gd; return c; }

__device__ __forceinline__ void ph_mod(KArgs a, const Ctx& c) {
    LAS float* cact = (LAS float*)c.lds;
    LAS float* red = (LAS float*)(c.lds + 16384);
    const float* cin = a->in[I_C];
    for (int i = c.tid; i < 4096; i += NTHR) cact[i] = siluf_(cin[i]);
    __syncthreads();
    float* mod = (float*)(a->ws + WS_MOD);
    for (int item = c.bid; item < 192; item += c.G) {
        const int l = item / 96, j0 = (item % 96) * 64;
        const float* W = a->in[I_WMOD] + (size_t)l * 1024 * 6144 + j0 + c.lane;
        float a0 = 0.f, a1 = 0.f, a2 = 0.f, a3 = 0.f;
        const int k0 = c.wave * 128;
#pragma unroll 8
        for (int k = k0; k < k0 + 128; ++k) { const float w = W[(size_t)k * 6144]; a0 += cact[k] * w; a1 += cact[1024 + k] * w; a2 += cact[2048 + k] * w; a3 += cact[3072 + k] * w; }
        red[(c.wave * 4 + 0) * 64 + c.lane] = a0; red[(c.wave * 4 + 1) * 64 + c.lane] = a1; red[(c.wave * 4 + 2) * 64 + c.lane] = a2; red[(c.wave * 4 + 3) * 64 + c.lane] = a3;
        __syncthreads();
        if (c.tid < 256) { const int b = c.tid >> 6, ln = c.tid & 63; float s = 0.f;
#pragma unroll
            for (int w = 0; w < 8; ++w) s += red[(w * 4 + b) * 64 + ln];
            mod[(l * 4 + b) * 6144 + j0 + ln] = s + a->in[I_BMOD][l * 6144 + j0 + ln]; }
        __syncthreads();
    }
}

__device__ __forceinline__ void tr_item(const float* src, int ld, bf16* dst, int K, int nblk, LAS float* scr, int item, int lane) {
    const int kb = item / nblk, nb = item % nblk, k0 = 64 * kb, n0 = 32 * nb;
#pragma unroll 8
    for (int i = 0; i < 32; ++i) { const int kk = 2 * i + (lane >> 5); scr[kk * 33 + (lane & 31)] = src[(size_t)(k0 + kk) * ld + n0 + (lane & 31)]; }
    LDS_WAIT(); asm volatile("" ::: "memory");
    const int cc = lane & 7;
#pragma unroll
    for (int j = 0; j < 4; ++j) { const int n = (lane >> 3) + 8 * j; const LAS float* s = scr + (8 * cc) * 33 + n;
        v4u o; o.x = pk2(s[0 * 33], s[1 * 33]); o.y = pk2(s[2 * 33], s[3 * 33]); o.z = pk2(s[4 * 33], s[5 * 33]); o.w = pk2(s[6 * 33], s[7 * 33]);
        *(v4u*)(dst + (size_t)(n0 + n) * K + k0 + 8 * cc) = o; }
    LDS_WAIT(); asm volatile("" ::: "memory");
}
__device__ __forceinline__ void ph_convert(KArgs a, const Ctx& c, int l) {
    LAS float* scr = (LAS float*)(c.lds + 32768 + c.wave * 10240);
    const int gw = c.bid * NW + c.wave, NGW = c.G * NW;
    constexpr int I0 = 1792, I1 = 1024, I2 = 256, I3 = 256, I4 = 512, I5 = 4096, I6 = 4096, I7 = 4096;
    constexpr int NIT = I0 + I1 + I2 + I3 + I4 + I5 + I6 + I7;
    bf16* WIN = (bf16*)(a->ws + WS_WIN); bf16* WEGU = (bf16*)(a->ws + WS_WEGU); bf16* WEDT = (bf16*)(a->ws + WS_WED);
    const float* win = a->in[I_WIN] + (size_t)l * 1024 * DIN;
    for (int it = gw; it < NIT; it += NGW) {
        int r = it;
        if (r < I0) { tr_item(win, DIN, WIN, 1024, 112, scr, r, c.lane); continue; } r -= I0;
        if (r < I1) { tr_item(win + C_GATE, DIN, WIN + (size_t)C_BA * 1024, 1024, 64, scr, r, c.lane); continue; } r -= I1;
        if (r < I2) { tr_item(a->in[I_WUPA] + (size_t)l * 512 * 1024, 1024, (bf16*)(a->ws + WS_WUPA), 512, 32, scr, r, c.lane); continue; } r -= I2;
        if (r < I3) { tr_item(a->in[I_WUPB] + (size_t)l * 512 * 1024, 1024, (bf16*)(a->ws + WS_WUPB), 512, 32, scr, r, c.lane); continue; } r -= I3;
        if (r < I4) { tr_item(a->in[I_WOUT] + (size_t)l * 1024 * 1024, 1024, (bf16*)(a->ws + WS_WOUT), 1024, 32, scr, r, c.lane); continue; } r -= I4;
        if (r < I5) { const int E = r >> 7, rem = r & 127, pn = rem >> 6, q = rem & 63;
            tr_item(a->in[I_WEG] + ((size_t)(l * 32 + E) * 1024 * 256) + 128 * pn, 256, WEGU + (size_t)(E * 512 + 256 * pn) * 1024, 1024, 4, scr, q, c.lane); continue; } r -= I5;
        if (r < I6) { const int E = r >> 7, rem = r & 127, pn = rem >> 6, q = rem & 63;
            tr_item(a->in[I_WEU] + ((size_t)(l * 32 + E) * 1024 * 256) + 128 * pn, 256, WEGU + (size_t)(E * 512 + 256 * pn + 128) * 1024, 1024, 4, scr, q, c.lane); continue; } r -= I6;
        { const int E = r >> 7, q = r & 127;
            tr_item(a->in[I_WED] + ((size_t)(l * 32 + E) * 256 * 1024), 1024, WEDT + (size_t)E * 1024 * 256, 256, 32, scr, q, c.lane); }
    }
}

__device__ __forceinline__ void load_row_x(KArgs a, int l, int m, int lane, f32x4 (&v)[4]) {
    const float* xr = (l == 0 ? a->in[I_X] : (const float*)a->out) + (size_t)m * DM;
#pragma unroll
    for (int j = 0; j < 4; ++j) v[j] = *(const f32x4*)(xr + 256 * j + 4 * lane);
    if (l > 0) {
        const int b = m >> 12;
        const float* g2 = (const float*)(a->ws + WS_MOD) + ((l - 1) * 4 + b) * 6144 + 5120;
        const bf16* ys = (const bf16*)(a->ws + WS_YS) + (size_t)m * 2048;
#pragma unroll
        for (int j = 0; j < 4; ++j) { const int col = 256 * j + 4 * lane; const v2u y0 = *(const v2u*)(ys + col), y1 = *(const v2u*)(ys + 1024 + col); const f32x4 g = *(const f32x4*)(g2 + col);
            v[j].x += g.x * (bflo(y0.x) + bflo(y1.x)); v[j].y += g.y * (bfhi(y0.x) + bfhi(y1.x)); v[j].z += g.z * (bflo(y0.y) + bflo(y1.y)); v[j].w += g.w * (bfhi(y0.y) + bfhi(y1.y)); }
        float* xo = a->out + (size_t)m * DM;
#pragma unroll
        for (int j = 0; j < 4; ++j) *(f32x4*)(xo + 256 * j + 4 * lane) = v[j];
    }
}
__device__ __forceinline__ float row_rstd(const f32x4 (&v)[4], int lane) {
    float s = 0.f;
#pragma unroll
    for (int j = 0; j < 4; ++j) s += (v[j].x * v[j].x + v[j].y * v[j].y) + (v[j].z * v[j].z + v[j].w * v[j].w);
    return 1.f / sqrtf(wave_sum(s, lane) * (1.f / DM) + EPS);
}
__device__ __forceinline__ void ph_norm1(KArgs a, const Ctx& c, int l) {
    LAS float* wbaT = (LAS float*)c.lds;
    const float* win = a->in[I_WIN] + (size_t)l * 1024 * DIN + C_BA;
    for (int i = c.tid; i < 8192; i += NTHR) { const int k = i >> 3, cc = i & 7; wbaT[cc * 1024 + k] = win[(size_t)k * DIN + cc]; }
    __syncthreads();
    const int gw = c.bid * NW + c.wave, NGW = c.G * NW, lane = c.lane;
    bf16* H = (bf16*)(a->ws + WS_H); float* beta = (float*)(a->ws + WS_BETA); float* glog = (float*)(a->ws + WS_GLOG);
    const float* n1w = a->in[I_N1W] + l * DM;
    for (int m = gw; m < NTOK; m += NGW) {
        f32x4 v[4]; load_row_x(a, l, m, lane, v);
        const float rstd = row_rstd(v, lane);
        const int b = m >> 12; const float* mod = (const float*)(a->ws + WS_MOD) + (l * 4 + b) * 6144;
        float acc[8];
#pragma unroll
        for (int q = 0; q < 8; ++q) acc[q] = 0.f;
#pragma unroll
        for (int j = 0; j < 4; ++j) { const int col = 256 * j + 4 * lane;
            const f32x4 nw = *(const f32x4*)(n1w + col), sh = *(const f32x4*)(mod + col), sc = *(const f32x4*)(mod + 1024 + col);
            f32x4 h = v[j] * rstd * nw * (sc + 1.0f) + sh;
            v2u o; o.x = pk2(h.x, h.y); o.y = pk2(h.z, h.w); *(v2u*)(H + (size_t)m * DM + col) = o;
#pragma unroll
            for (int q = 0; q < 8; ++q) { const f32x4 w4 = *(const LAS f32x4*)(wbaT + q * 1024 + col); acc[q] += (h.x * w4.x + h.y * w4.y) + (h.z * w4.z + h.w * w4.w); } }
#pragma unroll
        for (int q = 0; q < 8; ++q) acc[q] = wave_sum(acc[q], lane);
        if (lane < 4) {
            const float bb = lane == 0 ? acc[0] : lane == 1 ? acc[1] : lane == 2 ? acc[2] : acc[3];
            const float aa = lane == 0 ? acc[4] : lane == 1 ? acc[5] : lane == 2 ? acc[6] : acc[7];
            beta[m * 4 + lane] = sigmoidf_(bb);
            const float z = aa + a->in[I_DTB][l * 4 + lane]; const float sp = fmaxf(z, 0.f) + log1pf(__expf(-fabsf(z)));
            glog[m * 4 + lane] = -__expf(a->in[I_ALOG][l * 4 + lane]) * sp;
        }
    }
}
__device__ __forceinline__ void ph_final(KArgs a, const Ctx& c) {
    const int gw = c.bid * NW + c.wave, NGW = c.G * NW, lane = c.lane;
    const float* fw = a->in[I_FNW];
    for (int m = gw; m < NTOK; m += NGW) {
        f32x4 v[4];
        {
            const float* xr = (const float*)a->out + (size_t)m * DM; const int b = m >> 12;
            const float* g2 = (const float*)(a->ws + WS_MOD) + ((NLAYER - 1) * 4 + b) * 6144 + 5120;
            const bf16* ys = (const bf16*)(a->ws + WS_YS) + (size_t)m * 2048;
#pragma unroll
            for (int j = 0; j < 4; ++j) { const int col = 256 * j + 4 * lane; v[j] = *(const f32x4*)(xr + col);
                const v2u y0 = *(const v2u*)(ys + col), y1 = *(const v2u*)(ys + 1024 + col); const f32x4 g = *(const f32x4*)(g2 + col);
                v[j].x += g.x * (bflo(y0.x) + bflo(y1.x)); v[j].y += g.y * (bfhi(y0.x) + bfhi(y1.x)); v[j].z += g.z * (bflo(y0.y) + bflo(y1.y)); v[j].w += g.w * (bfhi(y0.y) + bfhi(y1.y)); }
        }
        const float rstd = row_rstd(v, lane);
        float* xo = a->out + (size_t)m * DM;
#pragma unroll
        for (int j = 0; j < 4; ++j) { const int col = 256 * j + 4 * lane; const f32x4 w = *(const f32x4*)(fw + col); *(f32x4*)(xo + col) = v[j] * rstd * w; }
    }
}

__device__ __forceinline__ void ph_kmean(KArgs a, const Ctx& c) {
    const int gw = c.bid * NW + c.wave, NGW = c.G * NW, lane = c.lane;
    const bf16* QKVA = (const bf16*)(a->ws + WS_QKVA); float* kmean = (float*)(a->ws + WS_KMEAN);
    for (int item = gw; item < NB * HA * NBLK; item += NGW) {
        const int nb = item & 15, h = (item >> 4) & 7, b = item >> 7;
        const int sub = lane & 7, rr = lane >> 3;
        float s[8];
#pragma unroll
        for (int q = 0; q < 8; ++q) s[q] = 0.f;
        const bf16* kp = QKVA + (size_t)(b * SEQ + nb * MBLK) * 1536 + 512 + h * 64 + sub * 8;
#pragma unroll 4
        for (int it = 0; it < 32; ++it) { const v4u w = *(const v4u*)(kp + (size_t)(it * 8 + rr) * 1536);
            s[0] += bflo(w.x); s[1] += bfhi(w.x); s[2] += bflo(w.y); s[3] += bfhi(w.y); s[4] += bflo(w.z); s[5] += bfhi(w.z); s[6] += bflo(w.w); s[7] += bfhi(w.w); }
#pragma unroll
        for (int q = 0; q < 8; ++q) { s[q] += shx(s[q], 8, lane); s[q] += shx(s[q], 16, lane); s[q] += shx(s[q], 32, lane); }
        if (lane < 8) { float* o = kmean + (size_t)item * 64 + sub * 8;
            *(f32x4*)o = (f32x4){s[0], s[1], s[2], s[3]} * (1.f / 256.f); *(f32x4*)(o + 4) = (f32x4){s[4], s[5], s[6], s[7]} * (1.f / 256.f); }
    }
}

__device__ __forceinline__ void ph_attn_simple(KArgs a, const Ctx& c) {
    const int gw = c.bid * NW + c.wave, NGW = c.G * NW, lane = c.lane;
    LAS float* btab = (LAS float*)(c.lds);
    LAS float* scw = (LAS float*)(c.lds + 8192) + c.wave * 1024;
    const float* relb = a->in[I_RELB];
    for (int i = c.tid; i < 8 * 129; i += NTHR) { const int h = i / 129, d = i % 129; btab[h * 132 + d] = relb[(d < 128 ? (int)T5B[d] : 31) * 8 + h]; }
    __syncthreads();
    const bf16* QKVA = (const bf16*)(a->ws + WS_QKVA); const float* kmean = (const float*)(a->ws + WS_KMEAN); bf16* YA = (bf16*)(a->ws + WS_YA);
    for (int r = gw; r < NB * HA * SEQ; r += NGW) {
        const int s = r & (SEQ - 1), h = (r >> 12) & 7, b = r >> 15, qb = s >> 8, tok = b * SEQ + s;
        float qv[64];
        { const bf16* qp = QKVA + (size_t)tok * 1536 + h * 64;
#pragma unroll
          for (int q = 0; q < 8; ++q) { const v4u w = *(const v4u*)(qp + q * 8); qv[q * 8 + 0] = bflo(w.x); qv[q * 8 + 1] = bfhi(w.x); qv[q * 8 + 2] = bflo(w.y); qv[q * 8 + 3] = bfhi(w.y); qv[q * 8 + 4] = bflo(w.z); qv[q * 8 + 5] = bfhi(w.z); qv[q * 8 + 6] = bflo(w.w); qv[q * 8 + 7] = bfhi(w.w); } }
        float gate = -1e30f;
        if (lane < qb) { const float* km = kmean + (size_t)(((b * 8 + h) * 16) + lane) * 64; float d = 0.f;
#pragma unroll
            for (int q = 0; q < 16; ++q) { const f32x4 k4 = *(const f32x4*)(km + q * 4); d += qv[q * 4] * k4.x + qv[q * 4 + 1] * k4.y + qv[q * 4 + 2] * k4.z + qv[q * 4 + 3] * k4.w; }
            gate = d; }
        unsigned selmask = 0u;
#pragma unroll
        for (int t = 0; t < 3; ++t) { float best = -3e38f; int bi = 0;
#pragma unroll
            for (int n = 0; n < 16; ++n) { const float gv = shidx(gate, n); if (!((selmask >> n) & 1u) && gv > best) { best = gv; bi = n; } }
            selmask |= 1u << bi; }
        selmask &= (1u << qb) - 1u;
        selmask |= 1u << qb;
        int nseg = 0; float mx = -3e38f;
        for (int blk = 0; blk <= qb; ++blk) {
            if (!((selmask >> blk) & 1u)) continue;
            for (int i = 0; i < 4; ++i) { const int key = blk * 256 + i * 64 + lane; const bf16* kp = QKVA + (size_t)(b * SEQ + key) * 1536 + 512 + h * 64; float d = 0.f;
#pragma unroll
                for (int q = 0; q < 8; ++q) { const v4u w = *(const v4u*)(kp + q * 8);
                    d += qv[q * 8] * bflo(w.x) + qv[q * 8 + 1] * bfhi(w.x) + qv[q * 8 + 2] * bflo(w.y) + qv[q * 8 + 3] * bfhi(w.y) + qv[q * 8 + 4] * bflo(w.z) + qv[q * 8 + 5] * bfhi(w.z) + qv[q * 8 + 6] * bflo(w.w) + qv[q * 8 + 7] * bfhi(w.w); }
                const int dist = s - key; float sc = d * 0.125f + btab[h * 132 + (dist < 0 ? 0 : (dist > 128 ? 128 : dist))];
                if (dist < 0) sc = -3e38f;
                scw[nseg * 256 + i * 64 + lane] = sc; mx = fmaxf(mx, sc); }
            ++nseg; }
        mx = wave_max(mx, lane);
        float sum = 0.f;
        for (int idx = lane; idx < nseg * 256; idx += 64) { const float sc = scw[idx]; const float e = sc < -1e37f ? 0.f : __expf(sc - mx); scw[idx] = e; sum += e; }
        sum = wave_sum(sum, lane);
        LDS_WAIT();
        float o = 0.f; int sg = 0;
        for (int blk = 0; blk <= qb; ++blk) {
            if (!((selmask >> blk) & 1u)) continue;
            const bf16* vp = QKVA + (size_t)(b * SEQ + blk * 256) * 1536 + 1024 + h * 64 + lane;
            const int lim = (blk == qb) ? (s & 255) + 1 : 256;
#pragma unroll 8
            for (int kk = 0; kk < lim; ++kk) o += scw[sg * 256 + kk] * bf2f(vp[(size_t)kk * 1536]);
            ++sg; }
        YA[(size_t)tok * 512 + h * 64 + lane] = (bf16)f2bf(o / sum);
    }
}

__device__ __forceinline__ void dn_load_chunk(KArgs a, const Ctx& c, int l, int b, int h, int t0, LAS float* qs, LAS float* ks, LAS float* vs) {
    const bf16* QKVB = (const bf16*)(a->ws + WS_QKVB); const float* cw = a->in[I_CONVW] + (size_t)l * 4 * 1536;
    const int cg = c.tid & 15, r0 = c.tid >> 4;
#pragma unroll
    for (int part = 0; part < 3; ++part) {
        const int colb = part * 512 + h * 128 + 8 * cg;
        float w[4][8];
#pragma unroll
        for (int i = 0; i < 4; ++i) { const f32x4 w0 = *(const f32x4*)(cw + i * 1536 + colb), w1 = *(const f32x4*)(cw + i * 1536 + colb + 4);
            w[i][0] = w0.x; w[i][1] = w0.y; w[i][2] = w0.z; w[i][3] = w0.w; w[i][4] = w1.x; w[i][5] = w1.y; w[i][6] = w1.z; w[i][7] = w1.w; }
        LAS float* dst = part == 0 ? qs : part == 1 ? ks : vs;
#pragma unroll
        for (int pass = 0; pass < 2; ++pass) {
            const int r = r0 + 32 * pass, t = t0 + r;
            float y[8];
#pragma unroll
            for (int e = 0; e < 8; ++e) y[e] = 0.f;
#pragma unroll
            for (int i = 0; i < 4; ++i) { const int tt = t - 3 + i; if (tt >= 0) { const v4u x = *(const v4u*)(QKVB + (size_t)(b * SEQ + tt) * 1536 + colb);
                y[0] += w[i][0] * bflo(x.x); y[1] += w[i][1] * bfhi(x.x); y[2] += w[i][2] * bflo(x.y); y[3] += w[i][3] * bfhi(x.y); y[4] += w[i][4] * bflo(x.z); y[5] += w[i][5] * bfhi(x.z); y[6] += w[i][6] * bflo(x.w); y[7] += w[i][7] * bfhi(x.w); } }
            float ss = 0.f;
#pragma unroll
            for (int e = 0; e < 8; ++e) { y[e] = siluf_(y[e]); ss += y[e] * y[e]; }
            if (part < 2) { ss += shx(ss, 1, c.lane); ss += shx(ss, 2, c.lane); ss += shx(ss, 4, c.lane); ss += shx(ss, 8, c.lane);
                const float rs = (1.f / sqrtf(ss + EPS)) * (part == 0 ? 0.08838834764831845f : 1.f);
#pragma unroll
                for (int e = 0; e < 8; ++e) y[e] *= rs; }
            *(LAS f32x4*)(dst + r * 128 + 8 * cg) = (f32x4){y[0], y[1], y[2], y[3]}; *(LAS f32x4*)(dst + r * 128 + 8 * cg + 4) = (f32x4){y[4], y[5], y[6], y[7]};
        }
    }
}
__device__ __forceinline__ void dn_store_chunk(KArgs a, const Ctx& c, int l, int b, int h, int t0, const LAS float* os) {
    const bf16* ZB = (const bf16*)(a->ws + WS_ZB); bf16* YB = (bf16*)(a->ws + WS_YB); const float* onw = a->in[I_ONW] + l * 128;
    const int r = c.tid >> 3, sub = c.tid & 7, tok = b * SEQ + t0 + r;
    float o[16]; float ss = 0.f;
#pragma unroll
    for (int q = 0; q < 4; ++q) { const f32x4 v = *(const LAS f32x4*)(os + r * 128 + sub * 16 + q * 4); o[q * 4] = v.x; o[q * 4 + 1] = v.y; o[q * 4 + 2] = v.z; o[q * 4 + 3] = v.w; ss += (v.x * v.x + v.y * v.y) + (v.z * v.z + v.w * v.w); }
    ss += shx(ss, 1, c.lane); ss += shx(ss, 2, c.lane); ss += shx(ss, 4, c.lane);
    const float rstd = 1.f / sqrtf(ss * (1.f / 128.f) + EPS);
    const bf16* zp = ZB + (size_t)tok * 512 + h * 128 + sub * 16; bf16* yp = YB + (size_t)tok * 512 + h * 128 + sub * 16;
#pragma unroll
    for (int q = 0; q < 2; ++q) { const v4u z = *(const v4u*)(zp + q * 8); const f32x4 w0 = *(const f32x4*)(onw + sub * 16 + q * 8), w1 = *(const f32x4*)(onw + sub * 16 + q * 8 + 4);
        v4u y; y.x = pk2(o[q * 8 + 0] * rstd * w0.x * siluf_(bflo(z.x)), o[q * 8 + 1] * rstd * w0.y * siluf_(bfhi(z.x)));
        y.y = pk2(o[q * 8 + 2] * rstd * w0.z * siluf_(bflo(z.y)), o[q * 8 + 3] * rstd * w0.w * siluf_(bfhi(z.y)));
        y.z = pk2(o[q * 8 + 4] * rstd * w1.x * siluf_(bflo(z.z)), o[q * 8 + 5] * rstd * w1.y * siluf_(bfhi(z.z)));
        y.w = pk2(o[q * 8 + 6] * rstd * w1.z * siluf_(bflo(z.w)), o[q * 8 + 7] * rstd * w1.w * siluf_(bfhi(z.w)));
        *(v4u*)(yp + q * 8) = y; }
}
__device__ __forceinline__ void ph_dn_simple(KArgs a, const Ctx& c, int l) {
    LAS float* qs = (LAS float*)c.lds; LAS float* ks = qs + 8192; LAS float* vs = ks + 8192; LAS float* os = vs + 8192;
    LAS float* bt = (LAS float*)(c.lds + MISC_OFF + 1024); LAS float* at = bt + 64;
    const float* beta = (const float*)(a->ws + WS_BETA); const float* glog = (const float*)(a->ws + WS_GLOG);
    const int v = c.tid >> 2, kq = c.tid & 3;
    for (int item = c.bid; item < NB * HB; item += c.G) {
        const int b = item >> 2, h = item & 3;
        float S[32];
#pragma unroll
        for (int q = 0; q < 32; ++q) S[q] = 0.f;
        for (int n = 0; n < NCH; ++n) {
            const int t0 = n * DNC;
            __syncthreads();
            dn_load_chunk(a, c, l, b, h, t0, qs, ks, vs);
            if (c.tid < 64) { const int tok = b * SEQ + t0 + c.tid; bt[c.tid] = beta[tok * 4 + h]; at[c.tid] = __expf(glog[tok * 4 + h]); }
            __syncthreads();
            for (int tt = 0; tt < DNC; ++tt) {
                const float a_t = at[tt], b_t = bt[tt];
                float kr[32];
#pragma unroll
                for (int q = 0; q < 8; ++q) { const f32x4 k4 = *(const LAS f32x4*)(ks + tt * 128 + kq * 32 + q * 4); kr[q * 4] = k4.x; kr[q * 4 + 1] = k4.y; kr[q * 4 + 2] = k4.z; kr[q * 4 + 3] = k4.w; }
                float kS = 0.f;
#pragma unroll
                for (int q = 0; q < 32; ++q) kS += kr[q] * S[q];
                kS += shx(kS, 1, c.lane); kS += shx(kS, 2, c.lane);
                const float vn = b_t * (vs[tt * 128 + v] - a_t * kS);
                float o = 0.f;
#pragma unroll
                for (int q = 0; q < 8; ++q) { const f32x4 q4 = *(const LAS f32x4*)(qs + tt * 128 + kq * 32 + q * 4);
                    S[q * 4] = a_t * S[q * 4] + kr[q * 4] * vn; S[q * 4 + 1] = a_t * S[q * 4 + 1] + kr[q * 4 + 1] * vn; S[q * 4 + 2] = a_t * S[q * 4 + 2] + kr[q * 4 + 2] * vn; S[q * 4 + 3] = a_t * S[q * 4 + 3] + kr[q * 4 + 3] * vn;
                    o += (q4.x * S[q * 4] + q4.y * S[q * 4 + 1]) + (q4.z * S[q * 4 + 2] + q4.w * S[q * 4 + 3]); }
                o += shx(o, 1, c.lane); o += shx(o, 2, c.lane);
                if (kq == 0) os[tt * 128 + v] = o;
            }
            __syncthreads();
            dn_store_chunk(a, c, l, b, h, t0, os);
        }
    }
}

struct EpiProj {
    static constexpr bool PERM = true, AFTER_DRAIN = false; unsigned char* ws;
    __device__ __forceinline__ void operator()(const pg8::f32x4 (&acc)[2][2][4][2], const pg8::Unit& u, int wr, int wc, int fr, int fq) const {
        const int pn = u.pn; bf16* base; int ld, ct; bool sg = false;
        if (pn < 6) { base = (bf16*)(ws + WS_QKVA); ld = 1536; ct = pn; } else if (pn < 12) { base = (bf16*)(ws + WS_QKVB); ld = 1536; ct = pn - 6; }
        else if (pn < 14) { base = (bf16*)(ws + WS_ZB); ld = 512; ct = pn - 12; } else { base = (bf16*)(ws + WS_GATES); ld = 2048; ct = pn - 14; sg = true; }
        const int row0 = u.pm * 256 + wr * 64 + fr, col0 = ct * 256 + wc * 32 + 8 * fq;
#pragma unroll
        for (int ai = 0; ai < 2; ++ai)
#pragma unroll
            for (int m = 0; m < 4; ++m) { bf16* rowp = base + (size_t)(row0 + ai * 128 + m * 16) * ld + col0;
#pragma unroll
                for (int bj = 0; bj < 2; ++bj) { f32x4 v0 = acc[ai][bj][m][0], v1 = acc[ai][bj][m][1];
                    if (sg) { v0.x = sigmoidf_(v0.x); v0.y = sigmoidf_(v0.y); v0.z = sigmoidf_(v0.z); v0.w = sigmoidf_(v0.w); v1.x = sigmoidf_(v1.x); v1.y = sigmoidf_(v1.y); v1.z = sigmoidf_(v1.z); v1.w = sigmoidf_(v1.w); }
                    v4u w; w.x = pk2(v0.x, v0.y); w.y = pk2(v0.z, v0.w); w.z = pk2(v1.x, v1.y); w.w = pk2(v1.z, v1.w);
                    *(v4u*)(rowp + bj * 128) = w; } }
    }
};
template <bool SECOND> struct EpiMerge {
    static constexpr bool PERM = true, AFTER_DRAIN = false; unsigned char* ws;
    __device__ __forceinline__ void operator()(const pg8::f32x4 (&acc)[2][2][4][2], const pg8::Unit& u, int wr, int wc, int fr, int fq) const {
        bf16* M = (bf16*)(ws + WS_M); const bf16* GT = (const bf16*)(ws + WS_GATES) + (SECOND ? 1024 : 0);
        const int row0 = u.pm * 256 + wr * 64 + fr, col0 = u.pn * 256 + wc * 32 + 8 * fq;
#pragma unroll
        for (int ai = 0; ai < 2; ++ai)
#pragma unroll
            for (int m = 0; m < 4; ++m) { const size_t row = row0 + ai * 128 + m * 16;
#pragma unroll
                for (int bj = 0; bj < 2; ++bj) { const int col = col0 + bj * 128; const f32x4 v0 = acc[ai][bj][m][0], v1 = acc[ai][bj][m][1];
                    const v4u g = *(const v4u*)(GT + row * 2048 + col);
                    float o[8] = {bflo(g.x) * v0.x, bfhi(g.x) * v0.y, bflo(g.y) * v0.z, bfhi(g.y) * v0.w, bflo(g.z) * v1.x, bfhi(g.z) * v1.y, bflo(g.w) * v1.z, bfhi(g.w) * v1.w};
                    if (SECOND) { const v4u p = *(const v4u*)(M + row * 1024 + col); o[0] += bflo(p.x); o[1] += bfhi(p.x); o[2] += bflo(p.y); o[3] += bfhi(p.y); o[4] += bflo(p.z); o[5] += bfhi(p.z); o[6] += bflo(p.w); o[7] += bfhi(p.w); }
                    v4u w; w.x = pk2(o[0], o[1]); w.y = pk2(o[2], o[3]); w.z = pk2(o[4], o[5]); w.w = pk2(o[6], o[7]);
                    *(v4u*)(M + row * 1024 + col) = w; } }
    }
};
struct EpiOut {
    static constexpr bool PERM = true, AFTER_DRAIN = false; const float* xin; float* xout; const float* g1;
    __device__ __forceinline__ void operator()(const pg8::f32x4 (&acc)[2][2][4][2], const pg8::Unit& u, int wr, int wc, int fr, int fq) const {
        const int row0 = u.pm * 256 + wr * 64 + fr, col0 = u.pn * 256 + wc * 32 + 8 * fq; const int b = (u.pm * 256) >> 12;
#pragma unroll
        for (int bj = 0; bj < 2; ++bj) { const int col = col0 + bj * 128; const f32x4 ga = *(const f32x4*)(g1 + b * 6144 + col), gb = *(const f32x4*)(g1 + b * 6144 + col + 4);
#pragma unroll
            for (int ai = 0; ai < 2; ++ai)
#pragma unroll
                for (int m = 0; m < 4; ++m) { const size_t off = (size_t)(row0 + ai * 128 + m * 16) * DM + col;
                    const f32x4 x0 = *(const f32x4*)(xin + off), x1 = *(const f32x4*)(xin + off + 4);
                    *(f32x4*)(xout + off) = x0 + ga * acc[ai][bj][m][0]; *(f32x4*)(xout + off + 4) = x1 + gb * acc[ai][bj][m][1]; } }
    }
};
struct EpiMoeGU {
    static constexpr bool PERM = true, AFTER_DRAIN = false; unsigned char* ws;
    __device__ __forceinline__ void operator()(const pg8::f32x4 (&acc)[2][2][4][2], const pg8::Unit& u, int wr, int wc, int fr, int fq) const {
        bf16* ACT = (bf16*)(ws + WS_ACT);
        const int row0 = u.pm * 256 + wr * 64 + fr, col0 = (u.pn & 1) * 128 + wc * 32 + 8 * fq;
#pragma unroll
        for (int ai = 0; ai < 2; ++ai)
#pragma unroll
            for (int m = 0; m < 4; ++m) { const f32x4 g0 = acc[ai][0][m][0], g1 = acc[ai][0][m][1], u0 = acc[ai][1][m][0], u1 = acc[ai][1][m][1];
                v4u w; w.x = pk2(siluf_(g0.x) * u0.x, siluf_(g0.y) * u0.y); w.y = pk2(siluf_(g0.z) * u0.z, siluf_(g0.w) * u0.w); w.z = pk2(siluf_(g1.x) * u1.x, siluf_(g1.y) * u1.y); w.w = pk2(siluf_(g1.z) * u1.z, siluf_(g1.w) * u1.w);
                *(v4u*)(ACT + (size_t)(row0 + ai * 128 + m * 16) * 256 + col0) = w; }
    }
};
struct EpiMoeDown {
    static constexpr bool PERM = true, AFTER_DRAIN = false; unsigned char* ws;
    __device__ __forceinline__ void operator()(const pg8::f32x4 (&acc)[2][2][4][2], const pg8::Unit& u, int wr, int wc, int fr, int fq) const {
        bf16* YS = (bf16*)(ws + WS_YS); const int* rowtok = (const int*)(ws + WS_ROWTOK); const float* roww = (const float*)(ws + WS_ROWW);
        const int row0 = u.pm * 256 + wr * 64 + fr, col0 = (u.pn & 3) * 256 + wc * 32 + 8 * fq;
#pragma unroll
        for (int ai = 0; ai < 2; ++ai)
#pragma unroll
            for (int m = 0; m < 4; ++m) { const int row = row0 + ai * 128 + m * 16; const int rt = rowtok[row]; const float wgt = roww[row];
                if (rt >= 0) {
#pragma unroll
                    for (int bj = 0; bj < 2; ++bj) { const f32x4 v0 = acc[ai][bj][m][0] * wgt, v1 = acc[ai][bj][m][1] * wgt;
                        v4u w; w.x = pk2(v0.x, v0.y); w.y = pk2(v0.z, v0.w); w.z = pk2(v1.x, v1.y); w.w = pk2(v1.z, v1.w);
                        *(v4u*)(YS + (size_t)rt * 1024 + col0 + bj * 128) = w; } } }
    }
};
struct MoeOrder {
    const LAS int* tile_exp; int nunits, G, c, sh;
    __device__ __forceinline__ bool next(int i, pg8::Unit& u) const {
        const int L = i * G + c; if (L >= nunits) return false;
        const int r = L >> sh, j = L & ((1 << sh) - 1);
        u.pm = r; u.pn = __builtin_amdgcn_readfirstlane((tile_exp[r] << sh) + j); return true;
    }
    __device__ __forceinline__ void a_ready(const pg8::Unit&) const {}
    __device__ __forceinline__ void done(const pg8::Unit&) const {}
};

__device__ __forceinline__ void ph_router(KArgs a, const Ctx& c, int l) {
    LAS int* lcnt = (LAS int*)(c.lds);
    LAS int* lbase = lcnt + 32;
    LAS int* tinf = lcnt + 64;
    const int lane = c.lane;
    bf16* H2 = (bf16*)(a->ws + WS_H); unsigned* tokinfo = (unsigned*)(a->ws + WS_TOKINFO); int* rowtok = (int*)(a->ws + WS_ROWTOK);
    unsigned* gcnt = (unsigned*)(a->ws + WS_CTL) + CW_GCNT + l * 32;
    const float* n2w = a->in[I_N2W] + l * DM; const float* wrg = a->in[I_WRG] + (size_t)l * 1024 * 4; const float* wre = a->in[I_WRE] + (size_t)l * 1024 * 32;
    for (int i = c.bid * NTHR + c.tid; i < MOE_MAXROWS; i += c.G * NTHR) rowtok[i] = -1;
    for (int tb = c.bid; tb < NTOK / 64; tb += c.G) {
        __syncthreads();
        if (c.tid < 32) lcnt[c.tid] = 0;
        __syncthreads();
        for (int i = 0; i < 8; ++i) {
            const int tl = c.wave * 8 + i, m = tb * 64 + tl, b = m >> 12;
            const float* xr = (const float*)a->out + (size_t)m * DM; const float* mod = (const float*)(a->ws + WS_MOD) + (l * 4 + b) * 6144;
            f32x4 h[4];
#pragma unroll
            for (int j = 0; j < 4; ++j) h[j] = *(const f32x4*)(xr + 256 * j + 4 * lane);
            const float rstd = row_rstd(h, lane);
            float ag[4] = {0.f, 0.f, 0.f, 0.f};
#pragma unroll
            for (int j = 0; j < 4; ++j) { const int col = 256 * j + 4 * lane;
                const f32x4 nw = *(const f32x4*)(n2w + col), sh = *(const f32x4*)(mod + 3072 + col), sc = *(const f32x4*)(mod + 4096 + col);
                h[j] = h[j] * rstd * nw * (sc + 1.0f) + sh;
                v2u o; o.x = pk2(h[j].x, h[j].y); o.y = pk2(h[j].z, h[j].w); *(v2u*)(H2 + (size_t)m * DM + col) = o;
                const f32x4 r0 = *(const f32x4*)(wrg + (size_t)(col + 0) * 4), r1 = *(const f32x4*)(wrg + (size_t)(col + 1) * 4), r2 = *(const f32x4*)(wrg + (size_t)(col + 2) * 4), r3 = *(const f32x4*)(wrg + (size_t)(col + 3) * 4);
                ag[0] += h[j].x * r0.x + h[j].y * r1.x + h[j].z * r2.x + h[j].w * r3.x; ag[1] += h[j].x * r0.y + h[j].y * r1.y + h[j].z * r2.y + h[j].w * r3.y;
                ag[2] += h[j].x * r0.z + h[j].y * r1.z + h[j].z * r2.z + h[j].w * r3.z; ag[3] += h[j].x * r0.w + h[j].y * r1.w + h[j].z * r2.w + h[j].w * r3.w; }
#pragma unroll
            for (int q = 0; q < 4; ++q) ag[q] = wave_sum(ag[q], lane) + a->in[I_BRG][l * 4 + q];
            int g = 0; float gm = ag[0];
#pragma unroll
            for (int q = 1; q < 4; ++q) if (ag[q] > gm) { gm = ag[q]; g = q; }
            float den = 0.f;
#pragma unroll
            for (int q = 0; q < 4; ++q) den += __expf(ag[q] - gm);
            const float ptop = 1.f / den;
            float ae[8] = {0.f, 0.f, 0.f, 0.f, 0.f, 0.f, 0.f, 0.f};
#pragma unroll
            for (int j = 0; j < 4; ++j) { const int col = 256 * j + 4 * lane; const float hv[4] = {h[j].x, h[j].y, h[j].z, h[j].w};
#pragma unroll
                for (int e = 0; e < 4; ++e) { const float* wr_ = wre + (size_t)(col + e) * 32 + g * 8; const f32x4 w0 = *(const f32x4*)wr_, w1 = *(const f32x4*)(wr_ + 4);
                    ae[0] += hv[e] * w0.x; ae[1] += hv[e] * w0.y; ae[2] += hv[e] * w0.z; ae[3] += hv[e] * w0.w; ae[4] += hv[e] * w1.x; ae[5] += hv[e] * w1.y; ae[6] += hv[e] * w1.z; ae[7] += hv[e] * w1.w; } }
#pragma unroll
            for (int q = 0; q < 8; ++q) ae[q] = wave_sum(ae[q], lane) + a->in[I_BRE][l * 32 + g * 8 + q];
            int e0 = 0; float v0 = ae[0];
#pragma unroll
            for (int q = 1; q < 8; ++q) if (ae[q] > v0) { v0 = ae[q]; e0 = q; }
            int e1 = -1; float v1 = -3e38f;
#pragma unroll
            for (int q = 0; q < 8; ++q) if (q != e0 && ae[q] > v1) { v1 = ae[q]; e1 = q; }
            const float ex = __expf(v1 - v0); const float w0 = ptop / (1.f + ex), w1 = ptop * ex / (1.f + ex);
            if (lane == 0) { const int E0 = g * 8 + e0, E1 = g * 8 + e1;
                const int r0 = atomicAdd((int*)(lcnt + E0), 1), r1 = atomicAdd((int*)(lcnt + E1), 1);
                tinf[tl * 6 + 0] = E0; tinf[tl * 6 + 1] = E1; tinf[tl * 6 + 2] = r0; tinf[tl * 6 + 3] = r1; tinf[tl * 6 + 4] = __float_as_int(w0); tinf[tl * 6 + 5] = __float_as_int(w1); }
        }
        __syncthreads();
        if (c.tid < 32) lbase[c.tid] = (int)__hip_atomic_fetch_add(gcnt + c.tid, (unsigned)lcnt[c.tid], RLX_AGENT);
        __syncthreads();
        if (c.tid < 64) { const int m = tb * 64 + c.tid; const int E0 = tinf[c.tid * 6], E1 = tinf[c.tid * 6 + 1];
            v4u o; o.x = (unsigned)E0; o.y = (unsigned)E1; o.z = (unsigned)(lbase[E0] + tinf[c.tid * 6 + 2]); o.w = (unsigned)(lbase[E1] + tinf[c.tid * 6 + 3]);
            *(v4u*)(tokinfo + (size_t)m * 8) = o; *(v2u*)(tokinfo + (size_t)m * 8 + 4) = (v2u){(unsigned)tinf[c.tid * 6 + 4], (unsigned)tinf[c.tid * 6 + 5]}; }
    }
}
__device__ __forceinline__ void moe_table(KArgs a, const Ctx& c, int l) {
    LAS int* tile_exp = (LAS int*)(c.lds + MISC_OFF + 2048); LAS int* offs = tile_exp + 192; LAS int* ntl = offs + 32; LAS int* pre = ntl + 4;
    const unsigned* gcnt = (const unsigned*)(a->ws + WS_CTL) + CW_GCNT + l * 32;
    __syncthreads();
    if (c.tid < 64) { const int e = c.tid & 31; const int cnt = (int)__hip_atomic_load(gcnt + e, RLX_AGENT); const int nt = (cnt + 255) >> 8; int inc = nt;
#pragma unroll
        for (int o = 1; o < 32; o <<= 1) { const int v = shidx_i(inc, (c.lane - o) & 63); if (e >= o) inc += v; }
        if (c.tid < 32) { offs[e] = (inc - nt) * 256; pre[e] = inc; if (e == 31) ntl[0] = inc; } }
    __syncthreads();
    if (c.tid < MOE_MAXTILES) { int E = 0;
#pragma unroll
        for (int e = 0; e < 32; ++e) E += (pre[e] <= c.tid) ? 1 : 0;
        tile_exp[c.tid] = E < 31 ? E : 31; }
    __syncthreads();
}
__device__ __forceinline__ void ph_gather(KArgs a, const Ctx& c, int l) {
    moe_table(a, c, l);
    const LAS int* offs = (const LAS int*)(c.lds + MISC_OFF + 2048) + 192;
    const int gw = c.bid * NW + c.wave, NGW = c.G * NW, lane = c.lane;
    const bf16* H2 = (const bf16*)(a->ws + WS_H); bf16* HS = (bf16*)(a->ws + WS_HS); const unsigned* tokinfo = (const unsigned*)(a->ws + WS_TOKINFO);
    int* rowtok = (int*)(a->ws + WS_ROWTOK); float* roww = (float*)(a->ws + WS_ROWW);
    for (int m = gw; m < NTOK; m += NGW) {
        const v4u ti = *(const v4u*)(tokinfo + (size_t)m * 8); const v2u tw = *(const v2u*)(tokinfo + (size_t)m * 8 + 4);
        const int d0 = offs[ti.x] + (int)ti.z, d1 = offs[ti.y] + (int)ti.w;
        const v4u x0 = *(const v4u*)(H2 + (size_t)m * DM + lane * 8), x1 = *(const v4u*)(H2 + (size_t)m * DM + 512 + lane * 8);
        *(v4u*)(HS + (size_t)d0 * DM + lane * 8) = x0; *(v4u*)(HS + (size_t)d0 * DM + 512 + lane * 8) = x1;
        *(v4u*)(HS + (size_t)d1 * DM + lane * 8) = x0; *(v4u*)(HS + (size_t)d1 * DM + 512 + lane * 8) = x1;
        if (lane == 0) { rowtok[d0] = m * 2; rowtok[d1] = m * 2 + 1; roww[d0] = __uint_as_float(tw.x); roww[d1] = __uint_as_float(tw.y); }
    }
}
constexpr int NPH_LAYER = 11, NPHASES = 2 + NLAYER * NPH_LAYER;
#ifndef PH_MASK
#define PH_MASK 0xFFFF
#endif
#define PH_EN(k) ((PH_MASK >> (k)) & 1)
#define GEMM_PHASE(EPI, SCHED, g, S, E) pg8::gemm_phase<EPI, SCHED, true, true>(c.lds, g, S, E, c.tid)

#define PHASE_FN static __device__ __forceinline__ void
__device__ __forceinline__ KArgs launder_k(KArgs a) { unsigned long long v = (unsigned long long)a; asm volatile("" : "+s"(v)); return (KArgs)v; }
PHASE_FN f_mod(KArgs a, int& tid) { a = launder_k(a); Ctx c = make_ctx(tid); ph_mod(a, c); }
PHASE_FN f_norm1(KArgs a, int& tid, int l) { a = launder_k(a); Ctx c = make_ctx(tid); ph_norm1(a, c, l); __syncthreads(); ph_convert(a, c, l); }
PHASE_FN f_proj(KArgs a, int& tid) { a = launder_k(a); Ctx c = make_ctx(tid);
    pg8::Gemm g{(const bf16*)(a->ws + WS_H), (const bf16*)(a->ws + WS_WIN), NTOK, DINP, DM}; pg8::StaticOrder S; S.init(NTOK, DINP, c.G, c.bid);
    EpiProj E{a->ws}; GEMM_PHASE(EpiProj, pg8::StaticOrder, g, S, E); }
PHASE_FN f_kmean(KArgs a, int& tid) { a = launder_k(a); Ctx c = make_ctx(tid); ph_kmean(a, c); }
PHASE_FN f_attn(KArgs a, int& tid) { a = launder_k(a); Ctx c = make_ctx(tid); ph_attn_simple(a, c); }
PHASE_FN f_dn(KArgs a, int& tid, int l) { a = launder_k(a); Ctx c = make_ctx(tid); ph_dn_simple(a, c, l); }
PHASE_FN f_merge1(KArgs a, int& tid) { a = launder_k(a); Ctx c = make_ctx(tid);
    pg8::Gemm g{(const bf16*)(a->ws + WS_YA), (const bf16*)(a->ws + WS_WUPA), NTOK, DM, WA}; pg8::StaticOrder S; S.init(NTOK, DM, c.G, c.bid);
    EpiMerge<false> E{a->ws}; GEMM_PHASE(EpiMerge<false>, pg8::StaticOrder, g, S, E); }
PHASE_FN f_merge2(KArgs a, int& tid) { a = launder_k(a); Ctx c = make_ctx(tid);
    pg8::Gemm g{(const bf16*)(a->ws + WS_YB), (const bf16*)(a->ws + WS_WUPB), NTOK, DM, WB}; pg8::StaticOrder S; S.init(NTOK, DM, c.G, c.bid);
    EpiMerge<true> E{a->ws}; GEMM_PHASE(EpiMerge<true>, pg8::StaticOrder, g, S, E); }
PHASE_FN f_out(KArgs a, int& tid, int l) { a = launder_k(a); Ctx c = make_ctx(tid);
    pg8::Gemm g{(const bf16*)(a->ws + WS_M), (const bf16*)(a->ws + WS_WOUT), NTOK, DM, DM}; pg8::StaticOrder S; S.init(NTOK, DM, c.G, c.bid);
    EpiOut E{l == 0 ? a->in[I_X] : (const float*)a->out, a->out, (const float*)(a->ws + WS_MOD) + l * 4 * 6144 + 2048}; GEMM_PHASE(EpiOut, pg8::StaticOrder, g, S, E); }
PHASE_FN f_router(KArgs a, int& tid, int l) { a = launder_k(a); Ctx c = make_ctx(tid); ph_router(a, c, l); }
PHASE_FN f_gather(KArgs a, int& tid, int l) { a = launder_k(a); Ctx c = make_ctx(tid); ph_gather(a, c, l); }
PHASE_FN f_moe_gu(KArgs a, int& tid, int l) { a = launder_k(a); Ctx c = make_ctx(tid);
    moe_table(a, c, l); const LAS int* te = (const LAS int*)(c.lds + MISC_OFF + 2048);
    pg8::Gemm g{(const bf16*)(a->ws + WS_HS), (const bf16*)(a->ws + WS_WEGU), MOE_MAXROWS, NEXP * 512, DM}; MoeOrder S{te, te[192 + 32] * 2, c.G, c.bid, 1};
    EpiMoeGU E{a->ws}; GEMM_PHASE(EpiMoeGU, MoeOrder, g, S, E); }
PHASE_FN f_moe_down(KArgs a, int& tid, int l) { a = launder_k(a); Ctx c = make_ctx(tid);
    moe_table(a, c, l); const LAS int* te = (const LAS int*)(c.lds + MISC_OFF + 2048);
    pg8::Gemm g{(const bf16*)(a->ws + WS_ACT), (const bf16*)(a->ws + WS_WED), MOE_MAXROWS, NEXP * 1024, DFF}; MoeOrder S{te, te[192 + 32] * 4, c.G, c.bid, 2};
    EpiMoeDown E{a->ws}; GEMM_PHASE(EpiMoeDown, MoeOrder, g, S, E); }
PHASE_FN f_final(KArgs a, int& tid) { a = launder_k(a); Ctx c = make_ctx(tid); ph_final(a, c); }

#define KA() launder_k((KArgs)__builtin_amdgcn_kernarg_segment_ptr())
__device__ __forceinline__ bool ph_in(int k) { KArgs a = KA(); return a->ph_lo <= k && k < a->ph_hi; }
__device__ __forceinline__ void grid_bar(int& tid) {
    asm volatile("" : "+v"(tid));
#if MK_ONE_LAUNCH
    KArgs a = KA(); XcdBarrier b; b.bar = (unsigned*)(a->ws + WS_CTL) + CW_BAR; b.x = xb_xcc_id(); b.st = (volatile LAS unsigned*)((LAS unsigned char*)lds_raw + MISC_OFF) + 8;
    xcd_barrier(b, tid);
#else
    __syncthreads();
#endif
}
__global__ void __launch_bounds__(NTHR, 2) mk_fwd(Args a_) {
    int tid = threadIdx.x;
    {   volatile LAS unsigned* MISC = (volatile LAS unsigned*)((LAS unsigned char*)lds_raw + MISC_OFF);
        if (tid < 64) MISC[tid] = 0u;
        __syncthreads();
#if MK_ONE_LAUNCH
        (void)xcd_barrier_post((unsigned*)(KA()->ws + WS_CTL) + CW_BAR, MISC + 8, tid);
#endif
    }
#define IN(k) ph_in(k)
#define SEAM(k) do { if (IN(k) && IN((k) + 1)) grid_bar(tid); } while (0)
    if (IN(0)) f_mod(KA(), tid); SEAM(0);
    for (int l = 0; l < NLAYER; ++l) {
        const int pb = 1 + l * NPH_LAYER;
        if (PH_EN(0) && IN(pb + 0)) f_norm1(KA(), tid, l); SEAM(pb + 0);
        if (PH_EN(1) && IN(pb + 1)) f_proj(KA(), tid); SEAM(pb + 1);
        if (PH_EN(2) && IN(pb + 2)) f_kmean(KA(), tid); SEAM(pb + 2);
        if (PH_EN(3) && IN(pb + 3)) { f_attn(KA(), tid); __syncthreads(); f_dn(KA(), tid, l); } SEAM(pb + 3);
        if (PH_EN(4) && IN(pb + 4)) f_merge1(KA(), tid); SEAM(pb + 4);
        if (PH_EN(5) && IN(pb + 5)) f_merge2(KA(), tid); SEAM(pb + 5);
        if (PH_EN(6) && IN(pb + 6)) f_out(KA(), tid, l); SEAM(pb + 6);
        if (PH_EN(7) && IN(pb + 7)) f_router(KA(), tid, l); SEAM(pb + 7);
        if (PH_EN(8) && IN(pb + 8)) f_gather(KA(), tid, l); SEAM(pb + 8);
        if (PH_EN(9) && IN(pb + 9)) f_moe_gu(KA(), tid, l); SEAM(pb + 9);
        if (PH_EN(10) && IN(pb + 10)) f_moe_down(KA(), tid, l); SEAM(pb + 10);
    }
    if (IN(NPHASES - 1)) f_final(KA(), tid);
#undef IN
#undef SEAM
}

extern "C" void kernel_launch(void* const* d_in, const int* in_sizes, int n_in, void* d_out, int out_size, void* d_ws, size_t ws_size, hipStream_t stream) {
    static int grid = 0;
    if (grid == 0) {
        if (n_in != 23 || out_size != NTOK * DM || ws_size < WS_END) { fprintf(stderr, "kernel_launch: unexpected shapes (n_in %d out %d ws %zu)\n", n_in, out_size, ws_size); grid = -1; return; }
        int dev = 0, cus = 0, per_cu = 0;
        if (hipGetDevice(&dev) != hipSuccess || hipDeviceGetAttribute(&cus, hipDeviceAttributeMultiprocessorCount, dev) != hipSuccess) { grid = -1; return; }
        if (hipFuncSetAttribute((const void*)mk_fwd, hipFuncAttributeMaxDynamicSharedMemorySize, LDS_BYTES) != hipSuccess) { fprintf(stderr, "kernel_launch: hipFuncSetAttribute failed\n"); grid = -1; return; }
        if (hipOccupancyMaxActiveBlocksPerMultiprocessor(&per_cu, (const void*)mk_fwd, NTHR, LDS_BYTES) != hipSuccess || per_cu < 1) { fprintf(stderr, "kernel_launch: occupancy query says %d\n", per_cu); (void)hipGetLastError(); grid = -1; return; }
        grid = cus;
    }
    if (grid < 0) return;
    (void)hipMemsetAsync((char*)d_ws + WS_CTL, 0, CTL_ZERO_BYTES, stream);
    Args a{};
    for (int i = 0; i < 23; ++i) a.in[i] = (const float*)d_in[i];
    a.out = (float*)d_out; a.ws = (unsigned char*)d_ws;
#if MK_ONE_LAUNCH
    a.ph_lo = 0; a.ph_hi = NPHASES;
    hipLaunchKernelGGL(mk_fwd, dim3(grid), dim3(NTHR), LDS_BYTES, stream, a);
#else
    for (int p = 0; p < NPHASES; ++p) { a.ph_lo = p; a.ph_hi = p + 1; hipLaunchKernelGGL(mk_fwd, dim3(grid), dim3(NTHR), LDS_BYTES, stream, a); }
#endif
}
```

```cpp
#include <hip/hip_runtime.h>
#include <cstdio>
#include <cstdint>
#ifndef MK_ONE_LAUNCH
#define MK_ONE_LAUNCH 1
#endif
namespace pg8 {
#define PG8_LAS __attribute__((address_space(3)))
typedef unsigned short bf16_t;
typedef short bf16x8 __attribute__((ext_vector_type(8)));
typedef float f32x4 __attribute__((ext_vector_type(4)));
typedef unsigned u32x4 __attribute__((ext_vector_type(4)));
constexpr int BM = 256, BK = 64, HALF = 128, HTB = HALF * BK * 2  , STAGE_BYTES = 8 * HTB, NXCD = 8, WGM = 8;

__host__ __device__ __forceinline__ int lds_byte(int r, int c) { const int st = (r >> 4) * 2 + (c >> 5), rr = r & 15, cc = c & 31, ob = rr * 64 + cc * 2; return st * 1024 + (ob ^ (((ob >> 9) & 1) << 5)); }
__host__ __device__ __forceinline__ void stage_rc(int b, int& R, int& C) { const int st = b / 1024, sb = b % 1024, swz = sb ^ (((sb >> 9) & 1) << 5); R = (st >> 1) * 16 + swz / 64; C = (st & 1) * 32 + (swz % 64) / 2; }
__host__ __device__ __forceinline__ int perm32(int rho) { const int n = rho >> 4, i = rho & 15; return 8 * (i >> 2) + 4 * n + (i & 3); }

struct Unit { int pm, pn; };
struct Gemm { const bf16_t* A; const bf16_t* Bt; int M, N, K; };

struct StaticOrder {
    int nM, nN, nwg, G, c;
    __host__ __device__ void init(int M, int N, int G_, int c_) { nM = M / BM; nN = N / BM; nwg = nM * nN; G = G_; c = c_; }
    __host__ __device__ bool next(int i, Unit& u) const {
        const long L = (long)i * G + c; if (L >= nwg) return false;
        int wgid = (int)L; { const int q = nwg / NXCD, r = nwg % NXCD, xcd = wgid % NXCD, off = wgid / NXCD; wgid = (xcd < r ? xcd * (q + 1) : r * (q + 1) + (xcd - r) * q) + off; }
        const int nig = WGM * nN, gid = wgid / nig, fm = gid * WGM, gsz = (nM - fm) < WGM ? (nM - fm) : WGM;
        u.pm = fm + ((wgid % nig) % gsz); u.pn = (wgid % nig) / gsz; return true;
    }
    __device__ __forceinline__ void a_ready(const Unit&) const {}
    __device__ __forceinline__ void done(const Unit&) const {}
};

__device__ __forceinline__ unsigned cvt_pk_bf16(float lo, float hi) { unsigned r; asm volatile("v_cvt_pk_bf16_f32 %0, %1, %2" : "=v"(r) : "v"(lo), "v"(hi)); return r; }
typedef float f32x2 __attribute__((ext_vector_type(2)));
template <class Epi, class Sched, bool ALIGN_EPI = false, bool SP2 = false>
__device__ __forceinline__ void gemm_phase(PG8_LAS unsigned char* lds, const Gemm g, const Sched& S, const Epi& E, const int tid_in) {
    const int tid = tid_in, wid = __builtin_amdgcn_readfirstlane(tid >> 6), lane = tid & 63, wr = wid >> 2, wc = wid & 3, fr = lane & 15, fq = lane >> 4;
    const int K = g.K, nt = K / BK;
    unsigned voffA[2], voffB[2];
#pragma unroll
    for (int i = 0; i < 2; ++i) { int R, C; stage_rc(tid * 16 + i * 8192, R, C); const int Rb = Epi::PERM ? ((R & ~31) + perm32(R & 31)) : R;
        voffA[i] = (unsigned)(R * K + C) * 2u; voffB[i] = (unsigned)(Rb * K + C) * 2u; }
    const size_t kstep = (size_t)(BK * 2);
    const size_t hstep = (size_t)HALF * K * 2;
    const size_t tstep = 2 * hstep;
    const unsigned ldsw = (unsigned)wid * 1024u;
    const int aoff = lds_byte(wr * 64 + fr, fq * 8), boff = lds_byte(wc * 32 + fr, fq * 8);
#define PG8_SA(b, h) (((b) * 2 + (h)) * HTB)
#define PG8_SB(b, h) ((4 + (b) * 2 + (h)) * HTB)
#define PG8_STAGE(bufoff, gbase, voff) do { _Pragma("unroll") for (int _i = 0; _i < 2; ++_i) \
        __builtin_amdgcn_global_load_lds((const unsigned*)((const char*)(gbase) + (voff)[_i]), (PG8_LAS unsigned*)(lds + (bufoff) + ldsw + _i * 8192), 16, 0, 0); } while (0)
#define PG8_LDA(dst, b, h) do { _Pragma("unroll") for (int m = 0; m < 4; ++m) _Pragma("unroll") for (int k = 0; k < 2; ++k) dst[m][k] = *(const PG8_LAS bf16x8*)(lds + PG8_SA(b, h) + aoff + m * 2048 + k * 1024); } while (0)
#define PG8_LDB(dst, b, h) do { _Pragma("unroll") for (int n = 0; n < 2; ++n) _Pragma("unroll") for (int k = 0; k < 2; ++k) dst[n][k] = *(const PG8_LAS bf16x8*)(lds + PG8_SB(b, h) + boff + n * 2048 + k * 1024); } while (0)
#define PG8_MMA(ai, bj, At, Bt) do { __builtin_amdgcn_s_setprio(1); _Pragma("unroll") for (int m = 0; m < 4; ++m) _Pragma("unroll") for (int n = 0; n < 2; ++n) _Pragma("unroll") for (int k = 0; k < 2; ++k) \
        acc[ai][bj][m][n] = __builtin_amdgcn_mfma_f32_16x16x32_bf16(Bt[n][k], At[m][k], acc[ai][bj][m][n], 0, 0, 0); __builtin_amdgcn_s_setprio(0); } while (0)
#define PG8_WAIT_V(n) asm volatile("s_waitcnt vmcnt(" #n ")" ::: "memory")
#define PG8_WAIT_L(n) asm volatile("s_waitcnt lgkmcnt(" #n ")" ::: "memory")
#define PG8_BAR __builtin_amdgcn_s_barrier()
#define PG8_SCHED __builtin_amdgcn_sched_barrier(0)
    Unit cur, nxt; int ui = 0;
    if (!S.next(0, cur)) return;
    f32x4 acc[2][2][4][2];
    float zf_ = 0.f; asm volatile("" : "+v"(zf_));
#pragma unroll
    for (int a = 0; a < 2; ++a)
#pragma unroll
        for (int b = 0; b < 2; ++b)
#pragma unroll
            for (int m = 0; m < 4; ++m)
#pragma unroll
                for (int n = 0; n < 2; ++n) acc[a][b][m][n] = (f32x4){zf_, zf_, zf_, zf_};
    bf16x8 At[4][2], B0[2][2], B1[2][2];
    const char* cA = (const char*)g.A + (size_t)cur.pm * tstep; const char* cB = (const char*)g.Bt + (size_t)cur.pn * tstep;
    S.a_ready(cur);
    if constexpr (SP2) {
        PG8_STAGE(PG8_SB(0, 0), cB, voffB); PG8_STAGE(PG8_SB(0, 1), cB + hstep, voffB); PG8_STAGE(PG8_SA(0, 0), cA, voffA); PG8_STAGE(PG8_SA(0, 1), cA + hstep, voffA);
        if (wr == 1) PG8_BAR;
        PG8_WAIT_V(2); PG8_BAR;
        PG8_STAGE(PG8_SB(1, 0), cB + kstep, voffB); PG8_STAGE(PG8_SA(1, 0), cA + kstep, voffA); PG8_STAGE(PG8_SB(1, 1), cB + hstep + kstep, voffB);
        PG8_WAIT_V(6); PG8_BAR;
    } else {
        PG8_STAGE(PG8_SB(0, 0), cB, voffB); PG8_STAGE(PG8_SA(0, 0), cA, voffA); PG8_STAGE(PG8_SB(0, 1), cB + hstep, voffB); PG8_STAGE(PG8_SA(0, 1), cA + hstep, voffA);
        if (wr == 1) PG8_BAR;
        PG8_WAIT_V(4); PG8_BAR;
        PG8_STAGE(PG8_SB(1, 0), cB + kstep, voffB); PG8_STAGE(PG8_SA(1, 0), cA + kstep, voffA); PG8_STAGE(PG8_SB(1, 1), cB + hstep + kstep, voffB);
        PG8_WAIT_V(6); PG8_BAR;
    }
    for (;;) {
        const bool has_next = S.next(ui + 1, nxt);
        const char* nA = has_next ? (const char*)g.A + (size_t)nxt.pm * tstep : cA; const char* nB = has_next ? (const char*)g.Bt + (size_t)nxt.pn * tstep : cB;
        for (int t = 0; t < nt; t += 2) {
            const bool last = (t == nt - 2);
            const char* a1 = cA + (size_t)(t + 1) * kstep;
            const char* a2 = last ? nA : cA + (size_t)(t + 2) * kstep; const char* b2 = last ? nB : cB + (size_t)(t + 2) * kstep;
            const char* a3 = a2 + kstep; const char* b3 = b2 + kstep;
            if (last && has_next) S.a_ready(nxt);
            if constexpr (SP2) {
            PG8_LDB(B0, 0, 0); PG8_LDB(B1, 0, 1); PG8_SCHED; PG8_LDA(At, 0, 0); PG8_STAGE(PG8_SA(1, 1), a1 + hstep, voffA);
            PG8_WAIT_V(8); PG8_WAIT_L(0); PG8_BAR; PG8_MMA(0, 0, At, B0); PG8_MMA(0, 1, At, B1); PG8_BAR; PG8_SCHED;
            PG8_LDA(At, 0, 1); PG8_STAGE(PG8_SB(0, 0), b2, voffB); PG8_STAGE(PG8_SB(0, 1), b2 + hstep, voffB); PG8_STAGE(PG8_SA(0, 0), a2, voffA);
            PG8_WAIT_V(8); PG8_WAIT_L(0); PG8_BAR; PG8_MMA(1, 0, At, B0); PG8_MMA(1, 1, At, B1); PG8_BAR; PG8_SCHED;
            PG8_LDB(B0, 1, 0); PG8_LDB(B1, 1, 1); PG8_SCHED; PG8_LDA(At, 1, 0); PG8_STAGE(PG8_SA(0, 1), a2 + hstep, voffA);
            PG8_WAIT_V(8); PG8_WAIT_L(0); PG8_BAR; PG8_MMA(0, 0, At, B0); PG8_MMA(0, 1, At, B1); PG8_BAR; PG8_SCHED;
            PG8_LDA(At, 1, 1); PG8_STAGE(PG8_SB(1, 0), b3, voffB); PG8_STAGE(PG8_SB(1, 1), b3 + hstep, voffB); PG8_STAGE(PG8_SA(1, 0), a3, voffA);
            PG8_WAIT_V(8); PG8_WAIT_L(0); PG8_BAR; PG8_MMA(1, 0, At, B0); PG8_MMA(1, 1, At, B1); PG8_BAR; PG8_SCHED;
            } else {
            PG8_LDB(B0, 0, 0); PG8_SCHED; PG8_LDA(At, 0, 0); PG8_STAGE(PG8_SA(1, 1), a1 + hstep, voffA);
            PG8_WAIT_L(8); PG8_BAR; PG8_WAIT_L(0); PG8_MMA(0, 0, At, B0); PG8_BAR; PG8_SCHED;
            PG8_LDB(B1, 0, 1); PG8_STAGE(PG8_SB(0, 0), b2, voffB);
            PG8_BAR; PG8_WAIT_L(0); PG8_MMA(0, 1, At, B1); PG8_BAR;
            PG8_LDA(At, 0, 1); PG8_STAGE(PG8_SA(0, 0), a2, voffA);
            PG8_BAR; PG8_WAIT_L(0); PG8_MMA(1, 0, At, B0); PG8_BAR; PG8_SCHED;
            PG8_STAGE(PG8_SB(0, 1), b2 + hstep, voffB);
            PG8_WAIT_V(6); PG8_BAR; PG8_MMA(1, 1, At, B1); PG8_BAR;
            PG8_LDB(B0, 1, 0); PG8_SCHED; PG8_LDA(At, 1, 0); PG8_STAGE(PG8_SA(0, 1), a2 + hstep, voffA);
            PG8_WAIT_L(8); PG8_BAR; PG8_WAIT_L(0); PG8_MMA(0, 0, At, B0); PG8_BAR; PG8_SCHED;
            PG8_LDB(B1, 1, 1); PG8_STAGE(PG8_SB(1, 0), b3, voffB);
            PG8_BAR; PG8_WAIT_L(0); PG8_MMA(0, 1, At, B1); PG8_BAR;
            PG8_LDA(At, 1, 1); PG8_STAGE(PG8_SA(1, 0), a3, voffA);
            PG8_BAR; PG8_WAIT_L(0); PG8_MMA(1, 0, At, B0); PG8_BAR; PG8_SCHED;
            PG8_STAGE(PG8_SB(1, 1), b3 + hstep, voffB);
            PG8_WAIT_V(6); PG8_BAR; PG8_MMA(1, 1, At, B1); PG8_BAR;
            }
        }
        if constexpr (ALIGN_EPI) { if (wr == 0) PG8_BAR; }
        if constexpr (!Epi::AFTER_DRAIN) { E(acc, cur, wr, wc, fr, fq); S.done(cur); }
        if (!has_next) break;
        zf_ = 0.f; asm volatile("" : "+v"(zf_));
#pragma unroll
        for (int a = 0; a < 2; ++a)
#pragma unroll
            for (int b = 0; b < 2; ++b)
#pragma unroll
                for (int m = 0; m < 4; ++m)
#pragma unroll
                    for (int n = 0; n < 2; ++n) acc[a][b][m][n] = (f32x4){zf_, zf_, zf_, zf_};
        cur = nxt; cA = nA; cB = nB; ++ui;
        if constexpr (ALIGN_EPI) { if (wr == 1) PG8_BAR; }
    }
    PG8_WAIT_V(0);
    if constexpr (!ALIGN_EPI) { if (wr == 0) PG8_BAR; }
    PG8_BAR;
    if constexpr (Epi::AFTER_DRAIN) { E.fused(acc, cur, wr, wc, fr, fq, lds, wid, lane); S.done(cur); }
#undef PG8_SA
#undef PG8_SB
#undef PG8_STAGE
#undef PG8_LDA
#undef PG8_LDB
#undef PG8_MMA
#undef PG8_WAIT_V
#undef PG8_WAIT_L
#undef PG8_BAR
#undef PG8_SCHED
}
}
constexpr int NW = 8, NTHR = 512;
constexpr int DM = 1024, NB = 4, SEQ = 4096, NTOK = NB * SEQ, NLAYER = 2;
constexpr int HA = 8, HDA = 64, WA = 512, MBLK = 256, NBLK = SEQ / MBLK;
constexpr int HB = 4, HDB = 128, WB = 512, CONVK = 4, DNC = 64, NCH = SEQ / DNC;
constexpr int NGRP = 4, EPG = 8, NEXP = 32, DFF = 256;
constexpr int DIN = 5640, DINP = 5632, NMOD = 6;
constexpr int C_QKVA = 0, C_QKVB = 1536, C_ZB = 3072, C_BA = 3584, C_GATE = 3592;
constexpr float EPS = 1e-6f;
constexpr int MOE_MAXROWS = 2 * NTOK + NEXP * 256;
constexpr int MOE_MAXTILES = MOE_MAXROWS / 256;

constexpr size_t MiB = 1u << 20;
constexpr size_t WS_CTL = 0, CTL_ZERO_BYTES = 1 * MiB;
constexpr size_t WS_MOD = 1 * MiB;
constexpr size_t WS_WIN = 2 * MiB;
constexpr size_t WS_WUPA = 13 * MiB, WS_WUPB = 14 * MiB;
constexpr size_t WS_WOUT = 15 * MiB;
constexpr size_t WS_WEGU = 17 * MiB;
constexpr size_t WS_WED = 49 * MiB;
constexpr size_t WS_SMALL = 65 * MiB;
constexpr size_t WS_KMEAN = WS_SMALL;
constexpr size_t WS_BETA = WS_SMALL + 256 * 1024;
constexpr size_t WS_GLOG = WS_SMALL + 512 * 1024;
constexpr size_t WS_TOKINFO = WS_SMALL + 1 * MiB;
constexpr size_t WS_ROWTOK = WS_SMALL + 2 * MiB;
constexpr size_t WS_ROWW = WS_SMALL + 3 * MiB;
constexpr size_t WS_GL = WS_SMALL + 4 * MiB;
constexpr size_t WS_H = 72 * MiB;
constexpr size_t WS_QKVA = 104 * MiB;
constexpr size_t WS_QKVB = 152 * MiB;
constexpr size_t WS_ZB = 200 * MiB;
constexpr size_t WS_GATES = 216 * MiB;
constexpr size_t WS_IMG = 280 * MiB;
constexpr size_t WS_YA = 72 * MiB, WS_YB = 336 * MiB;
constexpr size_t WS_END = 352 * MiB;
constexpr size_t WS_M = WS_QKVB;
constexpr size_t WS_U = 88 * MiB;
constexpr size_t WS_HS = WS_QKVA;
constexpr size_t WS_ACT = 184 * MiB;
constexpr size_t WS_YS = WS_GATES;
constexpr int CW_TMO = 0;
constexpr int CW_BAR = 4096;
constexpr int CW_GCNT = 8192;

constexpr int RING_BYTES = 131072;
constexpr int MISC_OFF = 143360;
constexpr int LDS_BYTES = 147456;

#define GAS __attribute__((address_space(1)))
#define LAS __attribute__((address_space(3)))
typedef unsigned short bf16;
typedef unsigned v4u __attribute__((ext_vector_type(4)));
typedef unsigned v2u __attribute__((ext_vector_type(2)));
typedef float f32x4 __attribute__((ext_vector_type(4)));
typedef float f32x16 __attribute__((ext_vector_type(16)));
typedef short bf16x8 __attribute__((ext_vector_type(8)));
typedef GAS unsigned gu32;
#define RLX_AGENT __ATOMIC_RELAXED, __HIP_MEMORY_SCOPE_AGENT
#define LDS_WAIT() asm volatile("s_waitcnt lgkmcnt(0)" ::: "memory")
#define VM_WAIT() asm volatile("s_waitcnt vmcnt(0)" ::: "memory")
__device__ __forceinline__ unsigned f2bf(float f) { unsigned u = __builtin_bit_cast(unsigned, f); return (u + 0x7fffu + ((u >> 16) & 1u)) >> 16; }
__device__ __forceinline__ unsigned pk2(float lo, float hi) { return f2bf(lo) | (f2bf(hi) << 16); }
__device__ __forceinline__ float bf2f(unsigned b) { return __builtin_bit_cast(float, b << 16); }
__device__ __forceinline__ float bflo(unsigned w) { return __builtin_bit_cast(float, w << 16); }
__device__ __forceinline__ float bfhi(unsigned w) { return __builtin_bit_cast(float, w & 0xffff0000u); }
__device__ __forceinline__ float sigmoidf_(float x) { return 1.f / (1.f + __expf(-x)); }
__device__ __forceinline__ float siluf_(float x) { return x / (1.f + __expf(-x)); }
__device__ __forceinline__ float shx(float v, int o, int lane) { return __builtin_bit_cast(float, __builtin_amdgcn_ds_bpermute((lane ^ o) << 2, __builtin_bit_cast(int, v))); }
__device__ __forceinline__ float shidx(float v, int src) { return __builtin_bit_cast(float, __builtin_amdgcn_ds_bpermute(src << 2, __builtin_bit_cast(int, v))); }
__device__ __forceinline__ int shidx_i(int v, int src) { return __builtin_amdgcn_ds_bpermute(src << 2, v); }
__device__ __forceinline__ float wave_sum(float v, int lane) {
#pragma unroll
    for (int o = 1; o < 64; o <<= 1) v += shx(v, o, lane);
    return v;
}
__device__ __forceinline__ float wave_max(float v, int lane) {
#pragma unroll
    for (int o = 1; o < 64; o <<= 1) v = fmaxf(v, shx(v, o, lane));
    return v;
}
__device__ const unsigned char T5B[128] = {0, 1, 2, 3, 4, 5, 6, 7, 8, 9, 10, 11, 12, 13, 14, 15, 16, 16, 16, 17, 17, 18, 18, 18, 19, 19, 19, 20, 20, 20, 20, 21, 21, 21, 21, 22, 22, 22, 22, 22, 23, 23, 23, 23, 23, 23, 24, 24, 24, 24, 24, 24, 25, 25, 25, 25, 25, 25, 25, 26, 26, 26, 26, 26, 26, 26, 26, 27, 27, 27, 27, 27, 27, 27, 27, 27, 27, 28, 28, 28, 28, 28, 28, 28, 28, 28, 28, 29, 29, 29, 29, 29, 29, 29, 29, 29, 29, 29, 29, 30, 30, 30, 30, 30, 30, 30, 30, 30, 30, 30, 30, 30, 30, 31, 31, 31, 31, 31, 31, 31, 31, 31, 31, 31, 31, 31, 31, 31};

#define XB_TMO      128
#define XB_XCNT(j)  (256  + 64 * (j))
#define XB_XSUB(j)  (1280 + 64 * (j))
#define XB_XGEN(j)  (2304 + 64 * (j))
#define XB_TOP      3328
#define XB_TOPGEN   3392
#define XCD_BAR_WORDS 3456
#define XB_SPIN_CAP (1u << 18)

__device__ __forceinline__ unsigned xb_ld(unsigned* p)              { return __hip_atomic_load(p, __ATOMIC_RELAXED, __HIP_MEMORY_SCOPE_AGENT); }
__device__ __forceinline__ unsigned xb_add(unsigned* p, unsigned v) { return __hip_atomic_fetch_add(p, v, __ATOMIC_RELAXED, __HIP_MEMORY_SCOPE_AGENT); }
__device__ __forceinline__ unsigned xb_xcc_id() { return (unsigned)__builtin_amdgcn_s_getreg((3 << 11) | 20) & 0xFu; }
#define XB_SPIN(cond, bar) do { unsigned _sp = 0; while (cond) { __builtin_amdgcn_s_sleep(1); \
    if ((++_sp & 255u) == 0u) { if (xb_ld(&(bar)[XB_TMO])) break; if (_sp > XB_SPIN_CAP) { atomicAdd(&(bar)[XB_TMO], 1u); break; } } } } while (0)

struct XcdBarrier {
    unsigned* bar; unsigned x;
    volatile LAS unsigned* st;
};

__device__ __forceinline__ XcdBarrier xcd_barrier_post(unsigned* bar, volatile LAS unsigned* st, const int tid_in) {
    XcdBarrier b; b.bar = bar; b.x = xb_xcc_id(); b.st = st;
    if (tid_in == 0) (void)xb_add(&bar[XB_XCNT(b.x)], 1u);
    return b;
}
__device__ __forceinline__ void xcd_barrier_complete(unsigned* bar, unsigned x, unsigned& nloc, unsigned& nx) {
    const unsigned G = gridDim.x * gridDim.y * gridDim.z;
    unsigned sum, cnt, mine, sp = 0u;
    for (;;) {
        sum = 0u; cnt = 0u; mine = 0u;
#pragma unroll
        for (unsigned j = 0; j < 16; ++j) { const unsigned c = xb_ld(&bar[XB_XCNT(j)]); sum += c; cnt += (c > 0u) ? 1u : 0u; mine = (j == x) ? c : mine; }
        if (sum == G) break;
        __builtin_amdgcn_s_sleep(1);
        if ((++sp & 255u) == 0u) { if (xb_ld(&bar[XB_TMO])) break; if (sp > XB_SPIN_CAP) { atomicAdd(&bar[XB_TMO], 1u); break; } }
    }
    nloc = mine > 0u ? mine : 1u; nx = cnt > 0u ? cnt : 1u;
}

__device__ __forceinline__ void xcd_barrier(const XcdBarrier& b, const int tid_in) {
    asm volatile("s_waitcnt vmcnt(0)" ::: "memory");
    __syncthreads();
    if (tid_in == 0) {
        unsigned* bar = b.bar;
        __builtin_amdgcn_s_waitcnt(0);
        unsigned nloc = b.st[0], nx = b.st[1];
        if (nloc == 0u) { xcd_barrier_complete(bar, b.x, nloc, nx); b.st[0] = nloc; b.st[1] = nx; }
        const unsigned old = xb_add(&bar[XB_XSUB(b.x)], 1u);
        const unsigned gen = old / nloc;
        if (old + 1u == (gen + 1u) * nloc) {
            __builtin_amdgcn_fence(__ATOMIC_RELEASE, "agent");
            asm volatile("s_waitcnt vmcnt(0)" ::: "memory");
            const unsigned og = xb_add(&bar[XB_TOP], 1u);
            const unsigned tg = og / nx;
            if (og + 1u == (tg + 1u) * nx) xb_add(&bar[XB_TOPGEN], 1u);
            else XB_SPIN(xb_ld(&bar[XB_TOPGEN]) == tg, bar);
            __builtin_amdgcn_fence(__ATOMIC_ACQUIRE, "agent");
            xb_add(&bar[XB_XGEN(b.x)], 1u);
            asm volatile("s_waitcnt vmcnt(0)" ::: "memory");
        } else {
            XB_SPIN(xb_ld(&bar[XB_XGEN(b.x)]) == gen, bar);
            __builtin_amdgcn_fence(__ATOMIC_ACQUIRE, "agent");
            asm volatile("s_waitcnt vmcnt(0)" ::: "memory");
        }
    }
    __syncthreads();
}
struct Args { const float* in[23]; float* out; unsigned char* ws; int ph_lo, ph_hi; };
enum { I_X = 0, I_C, I_RELB, I_FNW, I_N1W, I_N2W, I_WMOD, I_BMOD, I_WIN, I_CONVW, I_ALOG, I_DTB, I_ONW, I_WUPA, I_WUPB, I_WOUT, I_WRG, I_BRG, I_WRE, I_BRE, I_WEG, I_WEU, I_WED };

typedef const Args __attribute__((address_space(4)))* KArgs;
struct Ctx { LAS unsigned char* lds; int tid, lane, wave, bid, G; };
extern __shared__ __attribute__((aligned(16))) unsigned char lds_raw[];
__device__ __forceinline__ Ctx make_ctx(int& tid) { Ctx c; c.lds = (LAS unsigned char*)lds_raw; asm volatile("" : "+v"(tid)); const int t = tid; c.tid = t; c.lane = t & 63; c.wave = __builtin_amdgcn_readfirstlane(t >> 6); int bi = blockIdx.x, gd = gridDim.x; asm volatile("" : "+s"(bi), "+s"(gd)); c.bid = bi; c.G = gd; return c; }

__device__ __forceinline__ void ph_mod(KArgs a, const Ctx& c) {
    LAS float* cact = (LAS float*)c.lds;
    LAS float* red = (LAS float*)(c.lds + 16384);
    const float* cin = a->in[I_C];
    for (int i = c.tid; i < 4096; i += NTHR) cact[i] = siluf_(cin[i]);
    __syncthreads();
    float* mod = (float*)(a->ws + WS_MOD);
    for (int item = c.bid; item < 192; item += c.G) {
        const int l = item / 96, j0 = (item % 96) * 64;
        const float* W = a->in[I_WMOD] + (size_t)l * 1024 * 6144 + j0 + c.lane;
        float a0 = 0.f, a1 = 0.f, a2 = 0.f, a3 = 0.f;
        const int k0 = c.wave * 128;
#pragma unroll 8
        for (int k = k0; k < k0 + 128; ++k) { const float w = W[(size_t)k * 6144]; a0 += cact[k] * w; a1 += cact[1024 + k] * w; a2 += cact[2048 + k] * w; a3 += cact[3072 + k] * w; }
        red[(c.wave * 4 + 0) * 64 + c.lane] = a0; red[(c.wave * 4 + 1) * 64 + c.lane] = a1; red[(c.wave * 4 + 2) * 64 + c.lane] = a2; red[(c.wave * 4 + 3) * 64 + c.lane] = a3;
        __syncthreads();
        if (c.tid < 256) { const int b = c.tid >> 6, ln = c.tid & 63; float s = 0.f;
#pragma unroll
            for (int w = 0; w < 8; ++w) s += red[(w * 4 + b) * 64 + ln];
            mod[(l * 4 + b) * 6144 + j0 + ln] = s + a->in[I_BMOD][l * 6144 + j0 + ln]; }
        __syncthreads();
    }
}

__device__ __forceinline__ void tr_item(const float* src, int ld, bf16* dst, int K, int nblk, LAS float* scr, int item, int lane) {
    const int kb = item / nblk, nb = item % nblk, k0 = 64 * kb, n0 = 32 * nb;
#pragma unroll 8
    for (int i = 0; i < 32; ++i) { const int kk = 2 * i + (lane >> 5); scr[kk * 33 + (lane & 31)] = src[(size_t)(k0 + kk) * ld + n0 + (lane & 31)]; }
    LDS_WAIT(); asm volatile("" ::: "memory");
    const int cc = lane & 7;
#pragma unroll
    for (int j = 0; j < 4; ++j) { const int n = (lane >> 3) + 8 * j; const LAS float* s = scr + (8 * cc) * 33 + n;
        v4u o; o.x = pk2(s[0 * 33], s[1 * 33]); o.y = pk2(s[2 * 33], s[3 * 33]); o.z = pk2(s[4 * 33], s[5 * 33]); o.w = pk2(s[6 * 33], s[7 * 33]);
        *(v4u*)(dst + (size_t)(n0 + n) * K + k0 + 8 * cc) = o; }
    LDS_WAIT(); asm volatile("" ::: "memory");
}
__device__ __forceinline__ void ph_convert(KArgs a, const Ctx& c, int l) {
    LAS float* scr = (LAS float*)(c.lds + 32768 + c.wave * 10240);
    const int gw = c.bid * NW + c.wave, NGW = c.G * NW;
    constexpr int I0 = 1792, I1 = 1024, I2 = 256, I3 = 256, I4 = 512, I5 = 4096, I6 = 4096, I7 = 4096;
    constexpr int NIT = I0 + I1 + I2 + I3 + I4 + I5 + I6 + I7;
    bf16* WIN = (bf16*)(a->ws + WS_WIN); bf16* WEGU = (bf16*)(a->ws + WS_WEGU); bf16* WEDT = (bf16*)(a->ws + WS_WED);
    const float* win = a->in[I_WIN] + (size_t)l * 1024 * DIN;
    for (int it = gw; it < NIT; it += NGW) {
        int r = it;
        if (r < I0) { tr_item(win, DIN, WIN, 1024, 112, scr, r, c.lane); continue; } r -= I0;
        if (r < I1) { tr_item(win + C_GATE, DIN, WIN + (size_t)C_BA * 1024, 1024, 64, scr, r, c.lane); continue; } r -= I1;
        if (r < I2) { tr_item(a->in[I_WUPA] + (size_t)l * 512 * 1024, 1024, (bf16*)(a->ws + WS_WUPA), 512, 32, scr, r, c.lane); continue; } r -= I2;
        if (r < I3) { tr_item(a->in[I_WUPB] + (size_t)l * 512 * 1024, 1024, (bf16*)(a->ws + WS_WUPB), 512, 32, scr, r, c.lane); continue; } r -= I3;
        if (r < I4) { tr_item(a->in[I_WOUT] + (size_t)l * 1024 * 1024, 1024, (bf16*)(a->ws + WS_WOUT), 1024, 32, scr, r, c.lane); continue; } r -= I4;
        if (r < I5) { const int E = r >> 7, rem = r & 127, pn = rem >> 6, q = rem & 63;
            tr_item(a->in[I_WEG] + ((size_t)(l * 32 + E) * 1024 * 256) + 128 * pn, 256, WEGU + (size_t)(E * 512 + 256 * pn) * 1024, 1024, 4, scr, q, c.lane); continue; } r -= I5;
        if (r < I6) { const int E = r >> 7, rem = r & 127, pn = rem >> 6, q = rem & 63;
            tr_item(a->in[I_WEU] + ((size_t)(l * 32 + E) * 1024 * 256) + 128 * pn, 256, WEGU + (size_t)(E * 512 + 256 * pn + 128) * 1024, 1024, 4, scr, q, c.lane); continue; } r -= I6;
        { const int E = r >> 7, q = r & 127;
            tr_item(a->in[I_WED] + ((size_t)(l * 32 + E) * 256 * 1024), 1024, WEDT + (size_t)E * 1024 * 256, 256, 32, scr, q, c.lane); }
    }
}

__device__ __forceinline__ void load_row_x(KArgs a, int l, int m, int lane, f32x4 (&v)[4]) {
    const float* xr = (l == 0 ? a->in[I_X] : (const float*)a->out) + (size_t)m * DM;
#pragma unroll
    for (int j = 0; j < 4; ++j) v[j] = *(const f32x4*)(xr + 256 * j + 4 * lane);
    if (l > 0) {
        const int b = m >> 12;
        const float* g2 = (const float*)(a->ws + WS_MOD) + ((l - 1) * 4 + b) * 6144 + 5120;
        const bf16* ys = (const bf16*)(a->ws + WS_YS) + (size_t)m * 2048;
#pragma unroll
        for (int j = 0; j < 4; ++j) { const int col = 256 * j + 4 * lane; const v2u y0 = *(const v2u*)(ys + col), y1 = *(const v2u*)(ys + 1024 + col); const f32x4 g = *(const f32x4*)(g2 + col);
            v[j].x += g.x * (bflo(y0.x) + bflo(y1.x)); v[j].y += g.y * (bfhi(y0.x) + bfhi(y1.x)); v[j].z += g.z * (bflo(y0.y) + bflo(y1.y)); v[j].w += g.w * (bfhi(y0.y) + bfhi(y1.y)); }
        float* xo = a->out + (size_t)m * DM;
#pragma unroll
        for (int j = 0; j < 4; ++j) *(f32x4*)(xo + 256 * j + 4 * lane) = v[j];
    }
}
__device__ __forceinline__ float row_rstd(const f32x4 (&v)[4], int lane) {
    float s = 0.f;
#pragma unroll
    for (int j = 0; j < 4; ++j) s += (v[j].x * v[j].x + v[j].y * v[j].y) + (v[j].z * v[j].z + v[j].w * v[j].w);
    return 1.f / sqrtf(wave_sum(s, lane) * (1.f / DM) + EPS);
}
__device__ __forceinline__ void ph_norm1(KArgs a, const Ctx& c, int l) {
    LAS float* wbaT = (LAS float*)c.lds;
    const float* win = a->in[I_WIN] + (size_t)l * 1024 * DIN + C_BA;
    for (int i = c.tid; i < 8192; i += NTHR) { const int k = i >> 3, cc = i & 7; wbaT[cc * 1024 + k] = win[(size_t)k * DIN + cc]; }
    __syncthreads();
    const int gw = c.bid * NW + c.wave, NGW = c.G * NW, lane = c.lane;
    bf16* H = (bf16*)(a->ws + WS_H); float* beta = (float*)(a->ws + WS_BETA); float* glog = (float*)(a->ws + WS_GLOG);
    const float* n1w = a->in[I_N1W] + l * DM;
    for (int m = gw; m < NTOK; m += NGW) {
        f32x4 v[4]; load_row_x(a, l, m, lane, v);
        const float rstd = row_rstd(v, lane);
        const int b = m >> 12; const float* mod = (const float*)(a->ws + WS_MOD) + (l * 4 + b) * 6144;
        float acc[8];
#pragma unroll
        for (int q = 0; q < 8; ++q) acc[q] = 0.f;
#pragma unroll
        for (int j = 0; j < 4; ++j) { const int col = 256 * j + 4 * lane;
            const f32x4 nw = *(const f32x4*)(n1w + col), sh = *(const f32x4*)(mod + col), sc = *(const f32x4*)(mod + 1024 + col);
            f32x4 h = v[j] * rstd * nw * (sc + 1.0f) + sh;
            v2u o; o.x = pk2(h.x, h.y); o.y = pk2(h.z, h.w); *(v2u*)(H + (size_t)m * DM + col) = o;
#pragma unroll
            for (int q = 0; q < 8; ++q) { const f32x4 w4 = *(const LAS f32x4*)(wbaT + q * 1024 + col); acc[q] += (h.x * w4.x + h.y * w4.y) + (h.z * w4.z + h.w * w4.w); } }
#pragma unroll
        for (int q = 0; q < 8; ++q) acc[q] = wave_sum(acc[q], lane);
        if (lane < 4) {
            const float bb = lane == 0 ? acc[0] : lane == 1 ? acc[1] : lane == 2 ? acc[2] : acc[3];
            const float aa = lane == 0 ? acc[4] : lane == 1 ? acc[5] : lane == 2 ? acc[6] : acc[7];
            beta[m * 4 + lane] = sigmoidf_(bb);
            const float z = aa + a->in[I_DTB][l * 4 + lane]; const float sp = fmaxf(z, 0.f) + log1pf(__expf(-fabsf(z)));
            glog[m * 4 + lane] = -__expf(a->in[I_ALOG][l * 4 + lane]) * sp;
        }
    }
}
__device__ __forceinline__ void ph_final(KArgs a, const Ctx& c) {
    const int gw = c.bid * NW + c.wave, NGW = c.G * NW, lane = c.lane;
    const float* fw = a->in[I_FNW];
    for (int m = gw; m < NTOK; m += NGW) {
        f32x4 v[4];
        {
            const float* xr = (const float*)a->out + (size_t)m * DM; const int b = m >> 12;
            const float* g2 = (const float*)(a->ws + WS_MOD) + ((NLAYER - 1) * 4 + b) * 6144 + 5120;
            const bf16* ys = (const bf16*)(a->ws + WS_YS) + (size_t)m * 2048;
#pragma unroll
            for (int j = 0; j < 4; ++j) { const int col = 256 * j + 4 * lane; v[j] = *(const f32x4*)(xr + col);
                const v2u y0 = *(const v2u*)(ys + col), y1 = *(const v2u*)(ys + 1024 + col); const f32x4 g = *(const f32x4*)(g2 + col);
                v[j].x += g.x * (bflo(y0.x) + bflo(y1.x)); v[j].y += g.y * (bfhi(y0.x) + bfhi(y1.x)); v[j].z += g.z * (bflo(y0.y) + bflo(y1.y)); v[j].w += g.w * (bfhi(y0.y) + bfhi(y1.y)); }
        }
        const float rstd = row_rstd(v, lane);
        float* xo = a->out + (size_t)m * DM;
#pragma unroll
        for (int j = 0; j < 4; ++j) { const int col = 256 * j + 4 * lane; const f32x4 w = *(const f32x4*)(fw + col); *(f32x4*)(xo + col) = v[j] * rstd * w; }
    }
}

__device__ __forceinline__ void ph_kmean(KArgs a, const Ctx& c) {
    const int gw = c.bid * NW + c.wave, NGW = c.G * NW, lane = c.lane;
    const bf16* QKVA = (const bf16*)(a->ws + WS_QKVA); float* kmean = (float*)(a->ws + WS_KMEAN);
    for (int item = gw; item < NB * HA * NBLK; item += NGW) {
        const int nb = item & 15, h = (item >> 4) & 7, b = item >> 7;
        const int sub = lane & 7, rr = lane >> 3;
        float s[8];
#pragma unroll
        for (int q = 0; q < 8; ++q) s[q] = 0.f;
        const bf16* kp = QKVA + (size_t)(b * SEQ + nb * MBLK) * 1536 + 512 + h * 64 + sub * 8;
#pragma unroll 4
        for (int it = 0; it < 32; ++it) { const v4u w = *(const v4u*)(kp + (size_t)(it * 8 + rr) * 1536);
            s[0] += bflo(w.x); s[1] += bfhi(w.x); s[2] += bflo(w.y); s[3] += bfhi(w.y); s[4] += bflo(w.z); s[5] += bfhi(w.z); s[6] += bflo(w.w); s[7] += bfhi(w.w); }
#pragma unroll
        for (int q = 0; q < 8; ++q) { s[q] += shx(s[q], 8, lane); s[q] += shx(s[q], 16, lane); s[q] += shx(s[q], 32, lane); }
        if (lane < 8) { float* o = kmean + (size_t)item * 64 + sub * 8;
            *(f32x4*)o = (f32x4){s[0], s[1], s[2], s[3]} * (1.f / 256.f); *(f32x4*)(o + 4) = (f32x4){s[4], s[5], s[6], s[7]} * (1.f / 256.f); }
    }
}

__device__ __forceinline__ void ph_attn_simple(KArgs a, const Ctx& c) {
    const int gw = c.bid * NW + c.wave, NGW = c.G * NW, lane = c.lane;
    LAS float* btab = (LAS float*)(c.lds);
    LAS float* scw = (LAS float*)(c.lds + 8192) + c.wave * 1024;
    const float* relb = a->in[I_RELB];
    for (int i = c.tid; i < 8 * 129; i += NTHR) { const int h = i / 129, d = i % 129; btab[h * 132 + d] = relb[(d < 128 ? (int)T5B[d] : 31) * 8 + h]; }
    __syncthreads();
    const bf16* QKVA = (const bf16*)(a->ws + WS_QKVA); const float* kmean = (const float*)(a->ws + WS_KMEAN); bf16* YA = (bf16*)(a->ws + WS_YA);
    for (int r = gw; r < NB * HA * SEQ; r += NGW) {
        const int s = r & (SEQ - 1), h = (r >> 12) & 7, b = r >> 15, qb = s >> 8, tok = b * SEQ + s;
        float qv[64];
        { const bf16* qp = QKVA + (size_t)tok * 1536 + h * 64;
#pragma unroll
          for (int q = 0; q < 8; ++q) { const v4u w = *(const v4u*)(qp + q * 8); qv[q * 8 + 0] = bflo(w.x); qv[q * 8 + 1] = bfhi(w.x); qv[q * 8 + 2] = bflo(w.y); qv[q * 8 + 3] = bfhi(w.y); qv[q * 8 + 4] = bflo(w.z); qv[q * 8 + 5] = bfhi(w.z); qv[q * 8 + 6] = bflo(w.w); qv[q * 8 + 7] = bfhi(w.w); } }
        float gate = -1e30f;
        if (lane < qb) { const float* km = kmean + (size_t)(((b * 8 + h) * 16) + lane) * 64; float d = 0.f;
#pragma unroll
            for (int q = 0; q < 16; ++q) { const f32x4 k4 = *(const f32x4*)(km + q * 4); d += qv[q * 4] * k4.x + qv[q * 4 + 1] * k4.y + qv[q * 4 + 2] * k4.z + qv[q * 4 + 3] * k4.w; }
            gate = d; }
        unsigned selmask = 0u;
#pragma unroll
        for (int t = 0; t < 3; ++t) { float best = -3e38f; int bi = 0;
#pragma unroll
            for (int n = 0; n < 16; ++n) { const float gv = shidx(gate, n); if (!((selmask >> n) & 1u) && gv > best) { best = gv; bi = n; } }
            selmask |= 1u << bi; }
        selmask &= (1u << qb) - 1u;
        selmask |= 1u << qb;
        int nseg = 0; float mx = -3e38f;
        for (int blk = 0; blk <= qb; ++blk) {
            if (!((selmask >> blk) & 1u)) continue;
            for (int i = 0; i < 4; ++i) { const int key = blk * 256 + i * 64 + lane; const bf16* kp = QKVA + (size_t)(b * SEQ + key) * 1536 + 512 + h * 64; float d = 0.f;
#pragma unroll
                for (int q = 0; q < 8; ++q) { const v4u w = *(const v4u*)(kp + q * 8);
                    d += qv[q * 8] * bflo(w.x) + qv[q * 8 + 1] * bfhi(w.x) + qv[q * 8 + 2] * bflo(w.y) + qv[q * 8 + 3] * bfhi(w.y) + qv[q * 8 + 4] * bflo(w.z) + qv[q * 8 + 5] * bfhi(w.z) + qv[q * 8 + 6] * bflo(w.w) + qv[q * 8 + 7] * bfhi(w.w); }
                const int dist = s - key; float sc = d * 0.125f + btab[h * 132 + (dist < 0 ? 0 : (dist > 128 ? 128 : dist))];
                if (dist < 0) sc = -3e38f;
                scw[nseg * 256 + i * 64 + lane] = sc; mx = fmaxf(mx, sc); }
            ++nseg; }
        mx = wave_max(mx, lane);
        float sum = 0.f;
        for (int idx = lane; idx < nseg * 256; idx += 64) { const float sc = scw[idx]; const float e = sc < -1e37f ? 0.f : __expf(sc - mx); scw[idx] = e; sum += e; }
        sum = wave_sum(sum, lane);
        LDS_WAIT();
        float o = 0.f; int sg = 0;
        for (int blk = 0; blk <= qb; ++blk) {
            if (!((selmask >> blk) & 1u)) continue;
            const bf16* vp = QKVA + (size_t)(b * SEQ + blk * 256) * 1536 + 1024 + h * 64 + lane;
            const int lim = (blk == qb) ? (s & 255) + 1 : 256;
#pragma unroll 8
            for (int kk = 0; kk < lim; ++kk) o += scw[sg * 256 + kk] * bf2f(vp[(size_t)kk * 1536]);
            ++sg; }
        YA[(size_t)tok * 512 + h * 64 + lane] = (bf16)f2bf(o / sum);
    }
}

template <int LDW> __device__ __forceinline__ void dn_load_chunk(KArgs a, const Ctx& c, int l, int b, int h, int t0, LAS float* qs, LAS float* ks, LAS float* vs) {
    const bf16* QKVB = (const bf16*)(a->ws + WS_QKVB); const float* cw = a->in[I_CONVW] + (size_t)l * 4 * 1536;
    const int cg = c.tid & 15, r0 = c.tid >> 4;
#pragma unroll
    for (int part = 0; part < 3; ++part) {
        const int colb = part * 512 + h * 128 + 8 * cg;
        float w[4][8];
#pragma unroll
        for (int i = 0; i < 4; ++i) { const f32x4 w0 = *(const f32x4*)(cw + i * 1536 + colb), w1 = *(const f32x4*)(cw + i * 1536 + colb + 4);
            w[i][0] = w0.x; w[i][1] = w0.y; w[i][2] = w0.z; w[i][3] = w0.w; w[i][4] = w1.x; w[i][5] = w1.y; w[i][6] = w1.z; w[i][7] = w1.w; }
        LAS float* dst = part == 0 ? qs : part == 1 ? ks : vs;
#pragma unroll
        for (int pass = 0; pass < 2; ++pass) {
            const int r = r0 + 32 * pass, t = t0 + r;
            float y[8];
#pragma unroll
            for (int e = 0; e < 8; ++e) y[e] = 0.f;
#pragma unroll
            for (int i = 0; i < 4; ++i) { const int tt = t - 3 + i; if (tt >= 0) { const v4u x = *(const v4u*)(QKVB + (size_t)(b * SEQ + tt) * 1536 + colb);
                y[0] += w[i][0] * bflo(x.x); y[1] += w[i][1] * bfhi(x.x); y[2] += w[i][2] * bflo(x.y); y[3] += w[i][3] * bfhi(x.y); y[4] += w[i][4] * bflo(x.z); y[5] += w[i][5] * bfhi(x.z); y[6] += w[i][6] * bflo(x.w); y[7] += w[i][7] * bfhi(x.w); } }
            float ss = 0.f;
#pragma unroll
            for (int e = 0; e < 8; ++e) { y[e] = siluf_(y[e]); ss += y[e] * y[e]; }
            if (part < 2) { ss += shx(ss, 1, c.lane); ss += shx(ss, 2, c.lane); ss += shx(ss, 4, c.lane); ss += shx(ss, 8, c.lane);
                const float rs = (1.f / sqrtf(ss + EPS)) * (part == 0 ? 0.08838834764831845f : 1.f);
#pragma unroll
                for (int e = 0; e < 8; ++e) y[e] *= rs; }
            *(LAS f32x4*)(dst + r * LDW + 8 * cg) = (f32x4){y[0], y[1], y[2], y[3]}; *(LAS f32x4*)(dst + r * LDW + 8 * cg + 4) = (f32x4){y[4], y[5], y[6], y[7]};
        }
    }
}
__device__ __forceinline__ void dn_store_chunk(KArgs a, const Ctx& c, int l, int b, int h, int t0, const LAS float* os) {
    const bf16* ZB = (const bf16*)(a->ws + WS_ZB); bf16* YB = (bf16*)(a->ws + WS_YB); const float* onw = a->in[I_ONW] + l * 128;
    const int r = c.tid >> 3, sub = c.tid & 7, tok = b * SEQ + t0 + r;
    float o[16]; float ss = 0.f;
#pragma unroll
    for (int q = 0; q < 4; ++q) { const f32x4 v = *(const LAS f32x4*)(os + r * 128 + sub * 16 + q * 4); o[q * 4] = v.x; o[q * 4 + 1] = v.y; o[q * 4 + 2] = v.z; o[q * 4 + 3] = v.w; ss += (v.x * v.x + v.y * v.y) + (v.z * v.z + v.w * v.w); }
    ss += shx(ss, 1, c.lane); ss += shx(ss, 2, c.lane); ss += shx(ss, 4, c.lane);
    const float rstd = 1.f / sqrtf(ss * (1.f / 128.f) + EPS);
    const bf16* zp = ZB + (size_t)tok * 512 + h * 128 + sub * 16; bf16* yp = YB + (size_t)tok * 512 + h * 128 + sub * 16;
#pragma unroll
    for (int q = 0; q < 2; ++q) { const v4u z = *(const v4u*)(zp + q * 8); const f32x4 w0 = *(const f32x4*)(onw + sub * 16 + q * 8), w1 = *(const f32x4*)(onw + sub * 16 + q * 8 + 4);
        v4u y; y.x = pk2(o[q * 8 + 0] * rstd * w0.x * siluf_(bflo(z.x)), o[q * 8 + 1] * rstd * w0.y * siluf_(bfhi(z.x)));
        y.y = pk2(o[q * 8 + 2] * rstd * w0.z * siluf_(bflo(z.y)), o[q * 8 + 3] * rstd * w0.w * siluf_(bfhi(z.y)));
        y.z = pk2(o[q * 8 + 4] * rstd * w1.x * siluf_(bflo(z.z)), o[q * 8 + 5] * rstd * w1.y * siluf_(bfhi(z.z)));
        y.w = pk2(o[q * 8 + 6] * rstd * w1.z * siluf_(bflo(z.w)), o[q * 8 + 7] * rstd * w1.w * siluf_(bfhi(z.w)));
        *(v4u*)(yp + q * 8) = y; }
}
__device__ __forceinline__ void ph_dn_simple(KArgs a, const Ctx& c, int l) {
    LAS float* qs = (LAS float*)c.lds; LAS float* ks = qs + 8192; LAS float* vs = ks + 8192; LAS float* os = vs + 8192;
    LAS float* bt = (LAS float*)(c.lds + MISC_OFF + 1024); LAS float* at = bt + 64;
    const float* beta = (const float*)(a->ws + WS_BETA); const float* glog = (const float*)(a->ws + WS_GLOG);
    const int v = c.tid >> 2, kq = c.tid & 3;
    for (int item = c.bid; item < NB * HB; item += c.G) {
        const int b = item >> 2, h = item & 3;
        float S[32];
#pragma unroll
        for (int q = 0; q < 32; ++q) S[q] = 0.f;
        for (int n = 0; n < NCH; ++n) {
            const int t0 = n * DNC;
            __syncthreads();
            dn_load_chunk<128>(a, c, l, b, h, t0, qs, ks, vs);
            if (c.tid < 64) { const int tok = b * SEQ + t0 + c.tid; bt[c.tid] = beta[tok * 4 + h]; at[c.tid] = __expf(glog[tok * 4 + h]); }
            __syncthreads();
            for (int tt = 0; tt < DNC; ++tt) {
                const float a_t = at[tt], b_t = bt[tt];
                float kr[32];
#pragma unroll
                for (int q = 0; q < 8; ++q) { const f32x4 k4 = *(const LAS f32x4*)(ks + tt * 128 + kq * 32 + q * 4); kr[q * 4] = k4.x; kr[q * 4 + 1] = k4.y; kr[q * 4 + 2] = k4.z; kr[q * 4 + 3] = k4.w; }
                float kS = 0.f;
#pragma unroll
                for (int q = 0; q < 32; ++q) kS += kr[q] * S[q];
                kS += shx(kS, 1, c.lane); kS += shx(kS, 2, c.lane);
                const float vn = b_t * (vs[tt * 128 + v] - a_t * kS);
                float o = 0.f;
#pragma unroll
                for (int q = 0; q < 8; ++q) { const f32x4 q4 = *(const LAS f32x4*)(qs + tt * 128 + kq * 32 + q * 4);
                    S[q * 4] = a_t * S[q * 4] + kr[q * 4] * vn; S[q * 4 + 1] = a_t * S[q * 4 + 1] + kr[q * 4 + 1] * vn; S[q * 4 + 2] = a_t * S[q * 4 + 2] + kr[q * 4 + 2] * vn; S[q * 4 + 3] = a_t * S[q * 4 + 3] + kr[q * 4 + 3] * vn;
                    o += (q4.x * S[q * 4] + q4.y * S[q * 4 + 1]) + (q4.z * S[q * 4 + 2] + q4.w * S[q * 4 + 3]); }
                o += shx(o, 1, c.lane); o += shx(o, 2, c.lane);
                if (kq == 0) os[tt * 128 + v] = o;
            }
            __syncthreads();
            dn_store_chunk(a, c, l, b, h, t0, os);
        }
    }
}

struct EpiProj {
    static constexpr bool PERM = true, AFTER_DRAIN = false; unsigned char* ws;
    __device__ __forceinline__ void operator()(const pg8::f32x4 (&acc)[2][2][4][2], const pg8::Unit& u, int wr, int wc, int fr, int fq) const {
        const int pn = u.pn; bf16* base; int ld, ct; bool sg = false;
        if (pn < 6) { base = (bf16*)(ws + WS_QKVA); ld = 1536; ct = pn; } else if (pn < 12) { base = (bf16*)(ws + WS_QKVB); ld = 1536; ct = pn - 6; }
        else if (pn < 14) { base = (bf16*)(ws + WS_ZB); ld = 512; ct = pn - 12; } else { base = (bf16*)(ws + WS_GATES); ld = 2048; ct = pn - 14; sg = true; }
        const int row0 = u.pm * 256 + wr * 64 + fr, col0 = ct * 256 + wc * 32 + 8 * fq;
#pragma unroll
        for (int ai = 0; ai < 2; ++ai)
#pragma unroll
            for (int m = 0; m < 4; ++m) { bf16* rowp = base + (size_t)(row0 + ai * 128 + m * 16) * ld + col0;
#pragma unroll
                for (int bj = 0; bj < 2; ++bj) { f32x4 v0 = acc[ai][bj][m][0], v1 = acc[ai][bj][m][1];
                    if (sg) { v0.x = sigmoidf_(v0.x); v0.y = sigmoidf_(v0.y); v0.z = sigmoidf_(v0.z); v0.w = sigmoidf_(v0.w); v1.x = sigmoidf_(v1.x); v1.y = sigmoidf_(v1.y); v1.z = sigmoidf_(v1.z); v1.w = sigmoidf_(v1.w); }
                    v4u w; w.x = pk2(v0.x, v0.y); w.y = pk2(v0.z, v0.w); w.z = pk2(v1.x, v1.y); w.w = pk2(v1.z, v1.w);
                    *(v4u*)(rowp + bj * 128) = w; } }
    }
};
template <bool SECOND> struct EpiMerge {
    static constexpr bool PERM = true, AFTER_DRAIN = false; unsigned char* ws;
    __device__ __forceinline__ void operator()(const pg8::f32x4 (&acc)[2][2][4][2], const pg8::Unit& u, int wr, int wc, int fr, int fq) const {
        bf16* M = (bf16*)(ws + WS_M); const bf16* GT = (const bf16*)(ws + WS_GATES) + (SECOND ? 1024 : 0);
        const int row0 = u.pm * 256 + wr * 64 + fr, col0 = u.pn * 256 + wc * 32 + 8 * fq;
#pragma unroll
        for (int ai = 0; ai < 2; ++ai)
#pragma unroll
            for (int m = 0; m < 4; ++m) { const size_t row = row0 + ai * 128 + m * 16;
#pragma unroll
                for (int bj = 0; bj < 2; ++bj) { const int col = col0 + bj * 128; const f32x4 v0 = acc[ai][bj][m][0], v1 = acc[ai][bj][m][1];
                    const v4u g = *(const v4u*)(GT + row * 2048 + col);
                    float o[8] = {bflo(g.x) * v0.x, bfhi(g.x) * v0.y, bflo(g.y) * v0.z, bfhi(g.y) * v0.w, bflo(g.z) * v1.x, bfhi(g.z) * v1.y, bflo(g.w) * v1.z, bfhi(g.w) * v1.w};
                    if (SECOND) { const v4u p = *(const v4u*)(M + row * 1024 + col); o[0] += bflo(p.x); o[1] += bfhi(p.x); o[2] += bflo(p.y); o[3] += bfhi(p.y); o[4] += bflo(p.z); o[5] += bfhi(p.z); o[6] += bflo(p.w); o[7] += bfhi(p.w); }
                    v4u w; w.x = pk2(o[0], o[1]); w.y = pk2(o[2], o[3]); w.z = pk2(o[4], o[5]); w.w = pk2(o[6], o[7]);
                    *(v4u*)(M + row * 1024 + col) = w; } }
    }
};
struct EpiOut {
    static constexpr bool PERM = true, AFTER_DRAIN = false; const float* xin; float* xout; const float* g1;
    __device__ __forceinline__ void operator()(const pg8::f32x4 (&acc)[2][2][4][2], const pg8::Unit& u, int wr, int wc, int fr, int fq) const {
        const int row0 = u.pm * 256 + wr * 64 + fr, col0 = u.pn * 256 + wc * 32 + 8 * fq; const int b = (u.pm * 256) >> 12;
#pragma unroll
        for (int bj = 0; bj < 2; ++bj) { const int col = col0 + bj * 128; const f32x4 ga = *(const f32x4*)(g1 + b * 6144 + col), gb = *(const f32x4*)(g1 + b * 6144 + col + 4);
#pragma unroll
            for (int ai = 0; ai < 2; ++ai)
#pragma unroll
                for (int m = 0; m < 4; ++m) { const size_t off = (size_t)(row0 + ai * 128 + m * 16) * DM + col;
                    const f32x4 x0 = *(const f32x4*)(xin + off), x1 = *(const f32x4*)(xin + off + 4);
                    *(f32x4*)(xout + off) = x0 + ga * acc[ai][bj][m][0]; *(f32x4*)(xout + off + 4) = x1 + gb * acc[ai][bj][m][1]; } }
    }
};
struct EpiMoeGU {
    static constexpr bool PERM = true, AFTER_DRAIN = false; unsigned char* ws;
    __device__ __forceinline__ void operator()(const pg8::f32x4 (&acc)[2][2][4][2], const pg8::Unit& u, int wr, int wc, int fr, int fq) const {
        bf16* ACT = (bf16*)(ws + WS_ACT);
        const int row0 = u.pm * 256 + wr * 64 + fr, col0 = (u.pn & 1) * 128 + wc * 32 + 8 * fq;
#pragma unroll
        for (int ai = 0; ai < 2; ++ai)
#pragma unroll
            for (int m = 0; m < 4; ++m) { const f32x4 g0 = acc[ai][0][m][0], g1 = acc[ai][0][m][1], u0 = acc[ai][1][m][0], u1 = acc[ai][1][m][1];
                v4u w; w.x = pk2(siluf_(g0.x) * u0.x, siluf_(g0.y) * u0.y); w.y = pk2(siluf_(g0.z) * u0.z, siluf_(g0.w) * u0.w); w.z = pk2(siluf_(g1.x) * u1.x, siluf_(g1.y) * u1.y); w.w = pk2(siluf_(g1.z) * u1.z, siluf_(g1.w) * u1.w);
                *(v4u*)(ACT + (size_t)(row0 + ai * 128 + m * 16) * 256 + col0) = w; }
    }
};
struct EpiMoeDown {
    static constexpr bool PERM = true, AFTER_DRAIN = false; unsigned char* ws;
    __device__ __forceinline__ void operator()(const pg8::f32x4 (&acc)[2][2][4][2], const pg8::Unit& u, int wr, int wc, int fr, int fq) const {
        bf16* YS = (bf16*)(ws + WS_YS); const int* rowtok = (const int*)(ws + WS_ROWTOK); const float* roww = (const float*)(ws + WS_ROWW);
        const int row0 = u.pm * 256 + wr * 64 + fr, col0 = (u.pn & 3) * 256 + wc * 32 + 8 * fq;
#pragma unroll
        for (int ai = 0; ai < 2; ++ai)
#pragma unroll
            for (int m = 0; m < 4; ++m) { const int row = row0 + ai * 128 + m * 16; const int rt = rowtok[row]; const float wgt = roww[row];
                if (rt >= 0) {
#pragma unroll
                    for (int bj = 0; bj < 2; ++bj) { const f32x4 v0 = acc[ai][bj][m][0] * wgt, v1 = acc[ai][bj][m][1] * wgt;
                        v4u w; w.x = pk2(v0.x, v0.y); w.y = pk2(v0.z, v0.w); w.z = pk2(v1.x, v1.y); w.w = pk2(v1.z, v1.w);
                        *(v4u*)(YS + (size_t)rt * 1024 + col0 + bj * 128) = w; } } }
    }
};
struct MoeOrder {
    const LAS int* tile_exp; int nunits, G, c, sh;
    __device__ __forceinline__ bool next(int i, pg8::Unit& u) const {
        const int L = i * G + c; if (L >= nunits) return false;
        const int r = L >> sh, j = L & ((1 << sh) - 1);
        u.pm = r; u.pn = __builtin_amdgcn_readfirstlane((tile_exp[r] << sh) + j); return true;
    }
    __device__ __forceinline__ void a_ready(const pg8::Unit&) const {}
    __device__ __forceinline__ void done(const pg8::Unit&) const {}
};

__device__ __forceinline__ void ph_router(KArgs a, const Ctx& c, int l) {
    LAS int* lcnt = (LAS int*)(c.lds);
    LAS int* lbase = lcnt + 32;
    LAS int* tinf = lcnt + 64;
    const int lane = c.lane;
    bf16* H2 = (bf16*)(a->ws + WS_H); unsigned* tokinfo = (unsigned*)(a->ws + WS_TOKINFO); int* rowtok = (int*)(a->ws + WS_ROWTOK);
    unsigned* gcnt = (unsigned*)(a->ws + WS_CTL) + CW_GCNT + l * 32;
    const float* n2w = a->in[I_N2W] + l * DM; const float* wrg = a->in[I_WRG] + (size_t)l * 1024 * 4; const float* wre = a->in[I_WRE] + (size_t)l * 1024 * 32;
    for (int i = c.bid * NTHR + c.tid; i < MOE_MAXROWS; i += c.G * NTHR) rowtok[i] = -1;
    for (int tb = c.bid; tb < NTOK / 64; tb += c.G) {
        __syncthreads();
        if (c.tid < 32) lcnt[c.tid] = 0;
        __syncthreads();
        for (int i = 0; i < 8; ++i) {
            const int tl = c.wave * 8 + i, m = tb * 64 + tl, b = m >> 12;
            const float* xr = (const float*)a->out + (size_t)m * DM; const float* mod = (const float*)(a->ws + WS_MOD) + (l * 4 + b) * 6144;
            f32x4 h[4];
#pragma unroll
            for (int j = 0; j < 4; ++j) h[j] = *(const f32x4*)(xr + 256 * j + 4 * lane);
            const float rstd = row_rstd(h, lane);
            float ag[4] = {0.f, 0.f, 0.f, 0.f};
#pragma unroll
            for (int j = 0; j < 4; ++j) { const int col = 256 * j + 4 * lane;
                const f32x4 nw = *(const f32x4*)(n2w + col), sh = *(const f32x4*)(mod + 3072 + col), sc = *(const f32x4*)(mod + 4096 + col);
                h[j] = h[j] * rstd * nw * (sc + 1.0f) + sh;
                v2u o; o.x = pk2(h[j].x, h[j].y); o.y = pk2(h[j].z, h[j].w); *(v2u*)(H2 + (size_t)m * DM + col) = o;
                const f32x4 r0 = *(const f32x4*)(wrg + (size_t)(col + 0) * 4), r1 = *(const f32x4*)(wrg + (size_t)(col + 1) * 4), r2 = *(const f32x4*)(wrg + (size_t)(col + 2) * 4), r3 = *(const f32x4*)(wrg + (size_t)(col + 3) * 4);
                ag[0] += h[j].x * r0.x + h[j].y * r1.x + h[j].z * r2.x + h[j].w * r3.x; ag[1] += h[j].x * r0.y + h[j].y * r1.y + h[j].z * r2.y + h[j].w * r3.y;
                ag[2] += h[j].x * r0.z + h[j].y * r1.z + h[j].z * r2.z + h[j].w * r3.z; ag[3] += h[j].x * r0.w + h[j].y * r1.w + h[j].z * r2.w + h[j].w * r3.w; }
#pragma unroll
            for (int q = 0; q < 4; ++q) ag[q] = wave_sum(ag[q], lane) + a->in[I_BRG][l * 4 + q];
            int g = 0; float gm = ag[0];
#pragma unroll
            for (int q = 1; q < 4; ++q) if (ag[q] > gm) { gm = ag[q]; g = q; }
            float den = 0.f;
#pragma unroll
            for (int q = 0; q < 4; ++q) den += __expf(ag[q] - gm);
            const float ptop = 1.f / den;
            float ae[8] = {0.f, 0.f, 0.f, 0.f, 0.f, 0.f, 0.f, 0.f};
#pragma unroll
            for (int j = 0; j < 4; ++j) { const int col = 256 * j + 4 * lane; const float hv[4] = {h[j].x, h[j].y, h[j].z, h[j].w};
#pragma unroll
                for (int e = 0; e < 4; ++e) { const float* wr_ = wre + (size_t)(col + e) * 32 + g * 8; const f32x4 w0 = *(const f32x4*)wr_, w1 = *(const f32x4*)(wr_ + 4);
                    ae[0] += hv[e] * w0.x; ae[1] += hv[e] * w0.y; ae[2] += hv[e] * w0.z; ae[3] += hv[e] * w0.w; ae[4] += hv[e] * w1.x; ae[5] += hv[e] * w1.y; ae[6] += hv[e] * w1.z; ae[7] += hv[e] * w1.w; } }
#pragma unroll
            for (int q = 0; q < 8; ++q) ae[q] = wave_sum(ae[q], lane) + a->in[I_BRE][l * 32 + g * 8 + q];
            int e0 = 0; float v0 = ae[0];
#pragma unroll
            for (int q = 1; q < 8; ++q) if (ae[q] > v0) { v0 = ae[q]; e0 = q; }
            int e1 = -1; float v1 = -3e38f;
#pragma unroll
            for (int q = 0; q < 8; ++q) if (q != e0 && ae[q] > v1) { v1 = ae[q]; e1 = q; }
            const float ex = __expf(v1 - v0); const float w0 = ptop / (1.f + ex), w1 = ptop * ex / (1.f + ex);
            if (lane == 0) { const int E0 = g * 8 + e0, E1 = g * 8 + e1;
                const int r0 = atomicAdd((int*)(lcnt + E0), 1), r1 = atomicAdd((int*)(lcnt + E1), 1);
                tinf[tl * 6 + 0] = E0; tinf[tl * 6 + 1] = E1; tinf[tl * 6 + 2] = r0; tinf[tl * 6 + 3] = r1; tinf[tl * 6 + 4] = __float_as_int(w0); tinf[tl * 6 + 5] = __float_as_int(w1); }
        }
        __syncthreads();
        if (c.tid < 32) lbase[c.tid] = (int)__hip_atomic_fetch_add(gcnt + c.tid, (unsigned)lcnt[c.tid], RLX_AGENT);
        __syncthreads();
        if (c.tid < 64) { const int m = tb * 64 + c.tid; const int E0 = tinf[c.tid * 6], E1 = tinf[c.tid * 6 + 1];
            v4u o; o.x = (unsigned)E0; o.y = (unsigned)E1; o.z = (unsigned)(lbase[E0] + tinf[c.tid * 6 + 2]); o.w = (unsigned)(lbase[E1] + tinf[c.tid * 6 + 3]);
            *(v4u*)(tokinfo + (size_t)m * 8) = o; *(v2u*)(tokinfo + (size_t)m * 8 + 4) = (v2u){(unsigned)tinf[c.tid * 6 + 4], (unsigned)tinf[c.tid * 6 + 5]}; }
    }
}
__device__ __forceinline__ void moe_table(KArgs a, const Ctx& c, int l) {
    LAS int* tile_exp = (LAS int*)(c.lds + MISC_OFF + 2048); LAS int* offs = tile_exp + 192; LAS int* ntl = offs + 32; LAS int* pre = ntl + 4;
    const unsigned* gcnt = (const unsigned*)(a->ws + WS_CTL) + CW_GCNT + l * 32;
    __syncthreads();
    if (c.tid < 64) { const int e = c.tid & 31; const int cnt = (int)__hip_atomic_load(gcnt + e, RLX_AGENT); const int nt = (cnt + 255) >> 8; int inc = nt;
#pragma unroll
        for (int o = 1; o < 32; o <<= 1) { const int v = shidx_i(inc, (c.lane - o) & 63); if (e >= o) inc += v; }
        if (c.tid < 32) { offs[e] = (inc - nt) * 256; pre[e] = inc; if (e == 31) ntl[0] = inc; } }
    __syncthreads();
    if (c.tid < MOE_MAXTILES) { int E = 0;
#pragma unroll
        for (int e = 0; e < 32; ++e) E += (pre[e] <= c.tid) ? 1 : 0;
        tile_exp[c.tid] = E < 31 ? E : 31; }
    __syncthreads();
}
__device__ __forceinline__ void ph_gather(KArgs a, const Ctx& c, int l) {
    moe_table(a, c, l);
    const LAS int* offs = (const LAS int*)(c.lds + MISC_OFF + 2048) + 192;
    const int gw = c.bid * NW + c.wave, NGW = c.G * NW, lane = c.lane;
    const bf16* H2 = (const bf16*)(a->ws + WS_H); bf16* HS = (bf16*)(a->ws + WS_HS); const unsigned* tokinfo = (const unsigned*)(a->ws + WS_TOKINFO);
    int* rowtok = (int*)(a->ws + WS_ROWTOK); float* roww = (float*)(a->ws + WS_ROWW);
    for (int m = gw; m < NTOK; m += NGW) {
        const v4u ti = *(const v4u*)(tokinfo + (size_t)m * 8); const v2u tw = *(const v2u*)(tokinfo + (size_t)m * 8 + 4);
        const int d0 = offs[ti.x] + (int)ti.z, d1 = offs[ti.y] + (int)ti.w;
        const v4u x0 = *(const v4u*)(H2 + (size_t)m * DM + lane * 8), x1 = *(const v4u*)(H2 + (size_t)m * DM + 512 + lane * 8);
        *(v4u*)(HS + (size_t)d0 * DM + lane * 8) = x0; *(v4u*)(HS + (size_t)d0 * DM + 512 + lane * 8) = x1;
        *(v4u*)(HS + (size_t)d1 * DM + lane * 8) = x0; *(v4u*)(HS + (size_t)d1 * DM + 512 + lane * 8) = x1;
        if (lane == 0) { rowtok[d0] = m * 2; rowtok[d1] = m * 2 + 1; roww[d0] = __uint_as_float(tw.x); roww[d1] = __uint_as_float(tw.y); }
    }
}
constexpr int DN_IMG = 57344, DN_LDW = 132, DN_LDA = 68;
typedef __bf16 bf16x2_t __attribute__((ext_vector_type(2)));
typedef float f32x2_t __attribute__((ext_vector_type(2)));
__device__ __forceinline__ unsigned cvtpk(float lo, float hi) { f32x2_t v = {lo, hi}; bf16x2_t b = __builtin_convertvector(v, bf16x2_t); return __builtin_bit_cast(unsigned, b); }
__device__ __forceinline__ bf16x8 pack8(f32x4 a, f32x4 b) { v4u w; w.x = cvtpk(a.x, a.y); w.y = cvtpk(a.z, a.w); w.z = cvtpk(b.x, b.y); w.w = cvtpk(b.z, b.w); return __builtin_bit_cast(bf16x8, w); }
#define MFMA16(a, b, c) __builtin_amdgcn_mfma_f32_16x16x32_bf16((a), (b), (c), 0, 0, 0)

__device__ __forceinline__ void ph_dn_prep(KArgs a, const Ctx& c, int l) {
    LAS float* qs = (LAS float*)c.lds; LAS float* ks = qs + 64 * DN_LDW; LAS float* vs = ks + 64 * DN_LDW;
    LAS float* Am = vs + 64 * DN_LDW; LAS float* Pm = Am + 64 * DN_LDA;
    LAS float* bt = (LAS float*)(c.lds + MISC_OFF + 1024); LAS float* Gc = bt + 64;
    const float* beta = (const float*)(a->ws + WS_BETA); const float* glog = (const float*)(a->ws + WS_GLOG);
    const int lane = c.lane, row = lane & 15, quad = lane >> 4, tid = c.tid;
    for (int item = c.bid; item < NB * HB * NCH; item += c.G) {
        const int n = item & 63, h = (item >> 6) & 3, b = item >> 8, t0 = n * DNC;
        unsigned char* img = a->ws + WS_IMG + (size_t)item * DN_IMG;
        __syncthreads();
        dn_load_chunk<DN_LDW>(a, c, l, b, h, t0, qs, ks, vs);
        if (tid < 64) { const int tok = b * SEQ + t0 + tid; bt[tid] = beta[tok * 4 + h]; float g = glog[tok * 4 + h];
#pragma unroll
            for (int o = 1; o < 64; o <<= 1) { const float v = shidx(g, (lane - o) & 63); if (lane >= o) g += v; }
            Gc[tid] = g; }
        __syncthreads();
        {   const int sel = c.wave >> 2, ti = c.wave & 3; const LAS float* rs = sel == 0 ? ks : qs; LAS float* dstm = sel == 0 ? Am : Pm;
            bf16x8 af[4];
#pragma unroll
            for (int s = 0; s < 4; ++s) { const LAS float* p = rs + (ti * 16 + row) * DN_LDW + 32 * s + 8 * quad; af[s] = pack8(*(const LAS f32x4*)p, *(const LAS f32x4*)(p + 4)); }
            for (int tj = 0; tj < 4; ++tj) {
                f32x4 acc = {0.f, 0.f, 0.f, 0.f};
                if (tj <= ti) {
#pragma unroll
                    for (int s = 0; s < 4; ++s) { const LAS float* p = ks + (tj * 16 + row) * DN_LDW + 32 * s + 8 * quad; const bf16x8 bfr = pack8(*(const LAS f32x4*)p, *(const LAS f32x4*)(p + 4)); acc = MFMA16(af[s], bfr, acc); }
                }
                const int j = tj * 16 + row; const float Gj = Gc[j];
#pragma unroll
                for (int r = 0; r < 4; ++r) { const int i = ti * 16 + 4 * quad + r; const float dec = __expf(fminf(Gc[i] - Gj, 0.f));
                    float v = acc[r] * dec; if (sel == 0) v = (j < i) ? v * bt[i] : 0.f; else v = (j <= i) ? v : 0.f;
                    if (sel == 0) dstm[j * DN_LDA + i] = v; else dstm[i * DN_LDA + j] = v; }
            }
        }
        __syncthreads();
        const float Glast = Gc[63];
        {
            for (int q = 0; q < 5; ++q) { const int p = tid + 512 * q, blk = p >> 6; float v[8];
                if (blk < 16) { const int mt = blk >> 2, s = blk & 3, cr = 16 * mt + row, k0 = 32 * s + 4 * quad; const float e = __expf(Gc[cr]);
                    const f32x4 v0 = *(const LAS f32x4*)(qs + cr * DN_LDW + k0), v1 = *(const LAS f32x4*)(qs + cr * DN_LDW + k0 + 16);
                    v[0] = v0.x * e; v[1] = v0.y * e; v[2] = v0.z * e; v[3] = v0.w * e; v[4] = v1.x * e; v[5] = v1.y * e; v[6] = v1.z * e; v[7] = v1.w * e; }
                else if (blk < 32) { const int b2 = blk - 16, mt = b2 >> 1, s = b2 & 1, k = 16 * mt + row;
#pragma unroll
                    for (int j = 0; j < 8; ++j) { const int cj = 32 * s + 16 * (j >> 2) + 4 * quad + (j & 3); v[j] = ks[cj * DN_LDW + k] * __expf(Glast - Gc[cj]); } }
                else { const int b3 = blk - 32, mt = b3 >> 1, s = b3 & 1, i = 16 * mt + row, c0 = 32 * s + 4 * quad;
                    const f32x4 v0 = *(const LAS f32x4*)(Pm + i * DN_LDA + c0), v1 = *(const LAS f32x4*)(Pm + i * DN_LDA + c0 + 16);
                    v[0] = v0.x; v[1] = v0.y; v[2] = v0.z; v[3] = v0.w; v[4] = v1.x; v[5] = v1.y; v[6] = v1.z; v[7] = v1.w; }
                v4u w; w.x = cvtpk(v[0], v[1]); w.y = cvtpk(v[2], v[3]); w.z = cvtpk(v[4], v[5]); w.w = cvtpk(v[6], v[7]);
                *(v4u*)(img + 16384 + (size_t)p * 16) = w; }
            if (tid == 0) ((float*)(a->ws + WS_GL))[item] = __expf(Glast);
        }
        __syncthreads();
        if (tid < 256) {
            int vz = 0; asm volatile("" : "+v"(vz));
            const LAS float* AT = Am + vz; const LAS float* btV = bt + vz; const LAS float* GcV = Gc + vz;
            const bool isw = tid >= 128; LAS float* xc = (isw ? ks : vs) + (tid & 127);
#pragma unroll
            for (int bI = 0; bI < 4; ++bI) {
                float s[16];
#pragma unroll
                for (int r = 0; r < 16; ++r) { const int i = 16 * bI + r; float rhs = xc[i * DN_LDW] * btV[i]; if (isw) rhs *= __expf(GcV[i]); s[r] = rhs; }
                for (int j = 0; j < 16 * bI; ++j) { const float xj = xc[j * DN_LDW]; const LAS float* ap = AT + j * DN_LDA + 16 * bI;
#pragma unroll
                    for (int q = 0; q < 4; ++q) { const f32x4 a4 = *(const LAS f32x4*)(ap + 4 * q); s[4 * q] -= a4.x * xj; s[4 * q + 1] -= a4.y * xj; s[4 * q + 2] -= a4.z * xj; s[4 * q + 3] -= a4.w * xj; } }
#pragma unroll
                for (int rp = 0; rp < 15; ++rp) { const LAS float* ap = AT + (16 * bI + rp) * DN_LDA + 16 * bI;
#pragma unroll
                    for (int q = (rp + 1) / 4; q < 4; ++q) { const f32x4 a4 = *(const LAS f32x4*)(ap + 4 * q);
                        if (4 * q + 0 > rp) s[4 * q + 0] -= a4.x * s[rp]; if (4 * q + 1 > rp) s[4 * q + 1] -= a4.y * s[rp]; if (4 * q + 2 > rp) s[4 * q + 2] -= a4.z * s[rp]; if (4 * q + 3 > rp) s[4 * q + 3] -= a4.w * s[rp]; } }
#pragma unroll
                for (int r = 0; r < 16; ++r) xc[(16 * bI + r) * DN_LDW] = s[r];
            }
        }
        __syncthreads();
#pragma unroll
        for (int q = 0; q < 2; ++q) { const int p = tid + 512 * q, blk = p >> 6, mt = blk >> 2, s = blk & 3, cr = 16 * mt + row, k0 = 32 * s + 4 * quad;
            const f32x4 v0 = *(const LAS f32x4*)(ks + cr * DN_LDW + k0), v1 = *(const LAS f32x4*)(ks + cr * DN_LDW + k0 + 16);
            v4u w; w.x = cvtpk(-v0.x, -v0.y); w.y = cvtpk(-v0.z, -v0.w); w.z = cvtpk(-v1.x, -v1.y); w.w = cvtpk(-v1.z, -v1.w);
            *(v4u*)(img + (size_t)p * 16) = w; }
        {   unsigned char* ug = a->ws + WS_U + (size_t)item * 16384;
#pragma unroll
            for (int q = 0; q < 2; ++q) { const int p = tid + 512 * q, sl = p >> 7, ln = (p >> 1) & 63, hh = p & 1, v = 16 * sl + (ln & 15), qd = ln >> 4; float u8[8];
#pragma unroll
                for (int e = 0; e < 8; ++e) u8[e] = vs[(16 * (2 * hh + (e >> 2)) + 4 * qd + (e & 3)) * DN_LDW + v];
                v4u w; w.x = cvtpk(u8[0], u8[1]); w.y = cvtpk(u8[2], u8[3]); w.z = cvtpk(u8[4], u8[5]); w.w = cvtpk(u8[6], u8[7]);
                *(v4u*)(ug + (size_t)(sl * 64 + ln) * 32 + hh * 16) = w; } }
    }
}

__device__ __forceinline__ void ph_dn_scan(KArgs a, const Ctx& c, int l) {
    LAS unsigned char* lds = c.lds; LAS unsigned short* os = (LAS unsigned short*)(lds + 2 * DN_IMG);
    const int lane = c.lane, wv = c.wave, tid = c.tid;
    const bf16* ZB = (const bf16*)(a->ws + WS_ZB); bf16* YB = (bf16*)(a->ws + WS_YB); const float* onw = a->in[I_ONW] + l * 128; const float* glp = (const float*)(a->ws + WS_GL);
    for (int item = c.bid; item < NB * HB; item += c.G) {
        const int b = item >> 2, h = item & 3;
        const unsigned char* img0 = a->ws + WS_IMG + (size_t)item * 64 * DN_IMG; const unsigned char* ug0 = a->ws + WS_U + (size_t)item * 64 * 16384 + (size_t)(wv * 64 + lane) * 32;
        f32x4 S[8];
#pragma unroll
        for (int m = 0; m < 8; ++m) S[m] = (f32x4){0.f, 0.f, 0.f, 0.f};
        __syncthreads();
#define DN_DMA(n, buf) do { _Pragma("unroll") for (int q_ = 0; q_ < 7; ++q_) { const int pc_ = wv + 8 * q_; \
            __builtin_amdgcn_global_load_lds((const unsigned*)(img0 + (size_t)(n) * DN_IMG + pc_ * 1024 + lane * 16), (LAS unsigned*)(lds + (buf) * DN_IMG + pc_ * 1024), 16, 0, 0); } } while (0)
        DN_DMA(0, 0);
        v4u ucur0 = *(const v4u*)ug0, ucur1 = *(const v4u*)(ug0 + 16);
        for (int n = 0; n < NCH; ++n) {
            asm volatile("s_waitcnt vmcnt(0)" ::: "memory"); __syncthreads();
            v4u un0 = ucur0, un1 = ucur1;
            if (n + 1 < NCH) { DN_DMA(n + 1, (n + 1) & 1); un0 = *(const v4u*)(ug0 + (size_t)(n + 1) * 16384); un1 = *(const v4u*)(ug0 + (size_t)(n + 1) * 16384 + 16); }
            const LAS unsigned char* im = lds + (n & 1) * DN_IMG + lane * 16;
            const float gl = glp[item * 64 + n];
            bf16x8 Sb[4];
#pragma unroll
            for (int s = 0; s < 4; ++s) Sb[s] = pack8(S[2 * s], S[2 * s + 1]);
            f32x4 X[4], O[4];
            X[0] = (f32x4){bflo(ucur0.x), bfhi(ucur0.x), bflo(ucur0.y), bfhi(ucur0.y)}; X[1] = (f32x4){bflo(ucur0.z), bfhi(ucur0.z), bflo(ucur0.w), bfhi(ucur0.w)};
            X[2] = (f32x4){bflo(ucur1.x), bfhi(ucur1.x), bflo(ucur1.y), bfhi(ucur1.y)}; X[3] = (f32x4){bflo(ucur1.z), bfhi(ucur1.z), bflo(ucur1.w), bfhi(ucur1.w)};
#pragma unroll
            for (int mt = 0; mt < 4; ++mt) {
                O[mt] = (f32x4){0.f, 0.f, 0.f, 0.f};
#pragma unroll
                for (int s = 0; s < 4; ++s) { X[mt] = MFMA16(*(const LAS bf16x8*)(im + (mt * 4 + s) * 1024), Sb[s], X[mt]); O[mt] = MFMA16(*(const LAS bf16x8*)(im + 16384 + (mt * 4 + s) * 1024), Sb[s], O[mt]); } }
            bf16x8 Xb[2];
            Xb[0] = pack8(X[0], X[1]); Xb[1] = pack8(X[2], X[3]);
#pragma unroll
            for (int mt = 0; mt < 4; ++mt)
#pragma unroll
                for (int s = 0; s < 2; ++s) O[mt] = MFMA16(*(const LAS bf16x8*)(im + 49152 + (mt * 2 + s) * 1024), Xb[s], O[mt]);
#pragma unroll
            for (int m = 0; m < 8; ++m) { S[m] = S[m] * gl;
#pragma unroll
                for (int s = 0; s < 2; ++s) S[m] = MFMA16(*(const LAS bf16x8*)(im + 32768 + (m * 2 + s) * 1024), Xb[s], S[m]); }
#pragma unroll
            for (int mt = 0; mt < 4; ++mt)
#pragma unroll
                for (int r = 0; r < 4; ++r) os[(16 * mt + 4 * (lane >> 4) + r) * 128 + 16 * wv + (lane & 15)] = (unsigned short)(cvtpk(O[mt][r], 0.f) & 0xffffu);
            __syncthreads();
            {
                const int r = tid >> 3, sub = tid & 7, tok = b * SEQ + n * DNC + r; float o[16]; float ss = 0.f;
                const v4u o0 = *(const LAS v4u*)(os + r * 128 + sub * 16), o1 = *(const LAS v4u*)(os + r * 128 + sub * 16 + 8);
                o[0] = bflo(o0.x); o[1] = bfhi(o0.x); o[2] = bflo(o0.y); o[3] = bfhi(o0.y); o[4] = bflo(o0.z); o[5] = bfhi(o0.z); o[6] = bflo(o0.w); o[7] = bfhi(o0.w);
                o[8] = bflo(o1.x); o[9] = bfhi(o1.x); o[10] = bflo(o1.y); o[11] = bfhi(o1.y); o[12] = bflo(o1.z); o[13] = bfhi(o1.z); o[14] = bflo(o1.w); o[15] = bfhi(o1.w);
#pragma unroll
                for (int e = 0; e < 16; ++e) ss += o[e] * o[e];
                ss += shx(ss, 1, lane); ss += shx(ss, 2, lane); ss += shx(ss, 4, lane);
                const float rstd = 1.f / sqrtf(ss * (1.f / 128.f) + EPS);
                const bf16* zp = ZB + (size_t)tok * 512 + h * 128 + sub * 16; bf16* yp = YB + (size_t)tok * 512 + h * 128 + sub * 16;
#pragma unroll
                for (int q = 0; q < 2; ++q) { const v4u z = *(const v4u*)(zp + q * 8); const f32x4 w0 = *(const f32x4*)(onw + sub * 16 + q * 8), w1 = *(const f32x4*)(onw + sub * 16 + q * 8 + 4);
                    v4u y; y.x = cvtpk(o[q * 8 + 0] * rstd * w0.x * siluf_(bflo(z.x)), o[q * 8 + 1] * rstd * w0.y * siluf_(bfhi(z.x)));
                    y.y = cvtpk(o[q * 8 + 2] * rstd * w0.z * siluf_(bflo(z.y)), o[q * 8 + 3] * rstd * w0.w * siluf_(bfhi(z.y)));
                    y.z = cvtpk(o[q * 8 + 4] * rstd * w1.x * siluf_(bflo(z.z)), o[q * 8 + 5] * rstd * w1.y * siluf_(bfhi(z.z)));
                    y.w = cvtpk(o[q * 8 + 6] * rstd * w1.z * siluf_(bflo(z.w)), o[q * 8 + 7] * rstd * w1.w * siluf_(bfhi(z.w)));
                    *(v4u*)(yp + q * 8) = y; }
            }
            ucur0 = un0; ucur1 = un1;
        }
        asm volatile("s_waitcnt vmcnt(0)" ::: "memory"); __syncthreads();
#undef DN_DMA
    }
}
constexpr int NPH_LAYER = 11, NPHASES = 2 + NLAYER * NPH_LAYER;
#ifndef DN_IMPL
#define DN_IMPL 1
#endif
#ifndef PH_MASK
#define PH_MASK 0xFFFF
#endif
#define PH_EN(k) ((PH_MASK >> (k)) & 1)
#define GEMM_PHASE(EPI, SCHED, g, S, E) pg8::gemm_phase<EPI, SCHED, true, true>(c.lds, g, S, E, c.tid)

#define PHASE_FN static __device__ __forceinline__ void
__device__ __forceinline__ KArgs launder_k(KArgs a) { unsigned long long v = (unsigned long long)a; asm volatile("" : "+s"(v)); return (KArgs)v; }
PHASE_FN f_mod(KArgs a, int& tid) { a = launder_k(a); Ctx c = make_ctx(tid); ph_mod(a, c); }
PHASE_FN f_norm1(KArgs a, int& tid, int l) { a = launder_k(a); Ctx c = make_ctx(tid); ph_norm1(a, c, l); __syncthreads(); ph_convert(a, c, l); }
PHASE_FN f_proj(KArgs a, int& tid) { a = launder_k(a); Ctx c = make_ctx(tid);
    pg8::Gemm g{(const bf16*)(a->ws + WS_H), (const bf16*)(a->ws + WS_WIN), NTOK, DINP, DM}; pg8::StaticOrder S; S.init(NTOK, DINP, c.G, c.bid);
    EpiProj E{a->ws}; GEMM_PHASE(EpiProj, pg8::StaticOrder, g, S, E); }
PHASE_FN f_kmean(KArgs a, int& tid) { a = launder_k(a); Ctx c = make_ctx(tid); ph_kmean(a, c); }
PHASE_FN f_attn(KArgs a, int& tid) { a = launder_k(a); Ctx c = make_ctx(tid); ph_attn_simple(a, c); }
PHASE_FN f_dn(KArgs a, int& tid, int l) { a = launder_k(a); Ctx c = make_ctx(tid); ph_dn_simple(a, c, l); }
PHASE_FN f_dn_prep(KArgs a, int& tid, int l) { a = launder_k(a); Ctx c = make_ctx(tid); ph_dn_prep(a, c, l); }
PHASE_FN f_dn_scan(KArgs a, int& tid, int l) { a = launder_k(a); Ctx c = make_ctx(tid); ph_dn_scan(a, c, l); }
PHASE_FN f_merge1(KArgs a, int& tid) { a = launder_k(a); Ctx c = make_ctx(tid);
    pg8::Gemm g{(const bf16*)(a->ws + WS_YA), (const bf16*)(a->ws + WS_WUPA), NTOK, DM, WA}; pg8::StaticOrder S; S.init(NTOK, DM, c.G, c.bid);
    EpiMerge<false> E{a->ws}; GEMM_PHASE(EpiMerge<false>, pg8::StaticOrder, g, S, E); }
PHASE_FN f_merge2(KArgs a, int& tid) { a = launder_k(a); Ctx c = make_ctx(tid);
    pg8::Gemm g{(const bf16*)(a->ws + WS_YB), (const bf16*)(a->ws + WS_WUPB), NTOK, DM, WB}; pg8::StaticOrder S; S.init(NTOK, DM, c.G, c.bid);
    EpiMerge<true> E{a->ws}; GEMM_PHASE(EpiMerge<true>, pg8::StaticOrder, g, S, E); }
PHASE_FN f_out(KArgs a, int& tid, int l) { a = launder_k(a); Ctx c = make_ctx(tid);
    pg8::Gemm g{(const bf16*)(a->ws + WS_M), (const bf16*)(a->ws + WS_WOUT), NTOK, DM, DM}; pg8::StaticOrder S; S.init(NTOK, DM, c.G, c.bid);
    EpiOut E{l == 0 ? a->in[I_X] : (const float*)a->out, a->out, (const float*)(a->ws + WS_MOD) + l * 4 * 6144 + 2048}; GEMM_PHASE(EpiOut, pg8::StaticOrder, g, S, E); }
PHASE_FN f_router(KArgs a, int& tid, int l) { a = launder_k(a); Ctx c = make_ctx(tid); ph_router(a, c, l); }
PHASE_FN f_gather(KArgs a, int& tid, int l) { a = launder_k(a); Ctx c = make_ctx(tid); ph_gather(a, c, l); }
PHASE_FN f_moe_gu(KArgs a, int& tid, int l) { a = launder_k(a); Ctx c = make_ctx(tid);
    moe_table(a, c, l); const LAS int* te = (const LAS int*)(c.lds + MISC_OFF + 2048);
    pg8::Gemm g{(const bf16*)(a->ws + WS_HS), (const bf16*)(a->ws + WS_WEGU), MOE_MAXROWS, NEXP * 512, DM}; MoeOrder S{te, te[192 + 32] * 2, c.G, c.bid, 1};
    EpiMoeGU E{a->ws}; GEMM_PHASE(EpiMoeGU, MoeOrder, g, S, E); }
PHASE_FN f_moe_down(KArgs a, int& tid, int l) { a = launder_k(a); Ctx c = make_ctx(tid);
    moe_table(a, c, l); const LAS int* te = (const LAS int*)(c.lds + MISC_OFF + 2048);
    pg8::Gemm g{(const bf16*)(a->ws + WS_ACT), (const bf16*)(a->ws + WS_WED), MOE_MAXROWS, NEXP * 1024, DFF}; MoeOrder S{te, te[192 + 32] * 4, c.G, c.bid, 2};
    EpiMoeDown E{a->ws}; GEMM_PHASE(EpiMoeDown, MoeOrder, g, S, E); }
PHASE_FN f_final(KArgs a, int& tid) { a = launder_k(a); Ctx c = make_ctx(tid); ph_final(a, c); }

#define KA() launder_k((KArgs)__builtin_amdgcn_kernarg_segment_ptr())
__device__ __forceinline__ bool ph_in(int k) { KArgs a = KA(); return a->ph_lo <= k && k < a->ph_hi; }
__device__ __forceinline__ void grid_bar(int& tid) {
    asm volatile("" : "+v"(tid));
#if MK_ONE_LAUNCH
    KArgs a = KA(); XcdBarrier b; b.bar = (unsigned*)(a->ws + WS_CTL) + CW_BAR; b.x = xb_xcc_id(); b.st = (volatile LAS unsigned*)((LAS unsigned char*)lds_raw + MISC_OFF) + 8;
    xcd_barrier(b, tid);
#else
    __syncthreads();
#endif
}
__global__ void __launch_bounds__(NTHR, 2) mk_fwd(Args a_) {
    int tid = threadIdx.x;
    {   volatile LAS unsigned* MISC = (volatile LAS unsigned*)((LAS unsigned char*)lds_raw + MISC_OFF);
        if (tid < 64) MISC[tid] = 0u;
        __syncthreads();
#if MK_ONE_LAUNCH
        (void)xcd_barrier_post((unsigned*)(KA()->ws + WS_CTL) + CW_BAR, MISC + 8, tid);
#endif
    }
#define IN(k) ph_in(k)
#define SEAM(k) do { if (IN(k) && IN((k) + 1)) grid_bar(tid); } while (0)
    if (IN(0)) f_mod(KA(), tid); SEAM(0);
    for (int l = 0; l < NLAYER; ++l) {
        const int pb = 1 + l * NPH_LAYER;
        if (PH_EN(0) && IN(pb + 0)) f_norm1(KA(), tid, l); SEAM(pb + 0);
        if (PH_EN(1) && IN(pb + 1)) f_proj(KA(), tid); SEAM(pb + 1);
#if DN_IMPL
        if (PH_EN(2) && IN(pb + 2)) { f_kmean(KA(), tid); f_dn_prep(KA(), tid, l); } SEAM(pb + 2);
        if (PH_EN(3) && IN(pb + 3)) { f_dn_scan(KA(), tid, l); __syncthreads(); f_attn(KA(), tid); } SEAM(pb + 3);
#else
        if (PH_EN(2) && IN(pb + 2)) f_kmean(KA(), tid); SEAM(pb + 2);
        if (PH_EN(3) && IN(pb + 3)) { f_attn(KA(), tid); __syncthreads(); f_dn(KA(), tid, l); } SEAM(pb + 3);
#endif
        if (PH_EN(4) && IN(pb + 4)) f_merge1(KA(), tid); SEAM(pb + 4);
        if (PH_EN(5) && IN(pb + 5)) f_merge2(KA(), tid); SEAM(pb + 5);
        if (PH_EN(6) && IN(pb + 6)) f_out(KA(), tid, l); SEAM(pb + 6);
        if (PH_EN(7) && IN(pb + 7)) f_router(KA(), tid, l); SEAM(pb + 7);
        if (PH_EN(8) && IN(pb + 8)) f_gather(KA(), tid, l); SEAM(pb + 8);
        if (PH_EN(9) && IN(pb + 9)) f_moe_gu(KA(), tid, l); SEAM(pb + 9);
        if (PH_EN(10) && IN(pb + 10)) f_moe_down(KA(), tid, l); SEAM(pb + 10);
    }
    if (IN(NPHASES - 1)) f_final(KA(), tid);
#undef IN
#undef SEAM
}

extern "C" void kernel_launch(void* const* d_in, const int* in_sizes, int n_in, void* d_out, int out_size, void* d_ws, size_t ws_size, hipStream_t stream) {
    static int grid = 0;
    if (grid == 0) {
        if (n_in != 23 || out_size != NTOK * DM || ws_size < WS_END) { fprintf(stderr, "kernel_launch: unexpected shapes (n_in %d out %d ws %zu)\n", n_in, out_size, ws_size); grid = -1; return; }
        int dev = 0, cus = 0, per_cu = 0;
        if (hipGetDevice(&dev) != hipSuccess || hipDeviceGetAttribute(&cus, hipDeviceAttributeMultiprocessorCount, dev) != hipSuccess) { grid = -1; return; }
        if (hipFuncSetAttribute((const void*)mk_fwd, hipFuncAttributeMaxDynamicSharedMemorySize, LDS_BYTES) != hipSuccess) { fprintf(stderr, "kernel_launch: hipFuncSetAttribute failed\n"); grid = -1; return; }
        if (hipOccupancyMaxActiveBlocksPerMultiprocessor(&per_cu, (const void*)mk_fwd, NTHR, LDS_BYTES) != hipSuccess || per_cu < 1) { fprintf(stderr, "kernel_launch: occupancy query says %d\n", per_cu); (void)hipGetLastError(); grid = -1; return; }
        grid = cus;
    }
    if (grid < 0) return;
    (void)hipMemsetAsync((char*)d_ws + WS_CTL, 0, CTL_ZERO_BYTES, stream);
    Args a{};
    for (int i = 0; i < 23; ++i) a.in[i] = (const float*)d_in[i];
    a.out = (float*)d_out; a.ws = (unsigned char*)d_ws;
#if MK_ONE_LAUNCH
    a.ph_lo = 0; a.ph_hi = NPHASES;
    hipLaunchKernelGGL(mk_fwd, dim3(grid), dim3(NTHR), LDS_BYTES, stream, a);
#else
    for (int p = 0; p < NPHASES; ++p) { a.ph_lo = p; a.ph_hi = p + 1; hipLaunchKernelGGL(mk_fwd, dim3(grid), dim3(NTHR), LDS_BYTES, stream, a); }
#endif
}
```

```cpp
#include <hip/hip_runtime.h>
#include <cstdio>
#include <cstdint>
#ifndef MK_ONE_LAUNCH
#define MK_ONE_LAUNCH 1
#endif
namespace pg8 {
#define PG8_LAS __attribute__((address_space(3)))
typedef unsigned short bf16_t;
typedef short bf16x8 __attribute__((ext_vector_type(8)));
typedef float f32x4 __attribute__((ext_vector_type(4)));
typedef unsigned u32x4 __attribute__((ext_vector_type(4)));
constexpr int BM = 256, BK = 64, HALF = 128, HTB = HALF * BK * 2  , STAGE_BYTES = 8 * HTB, NXCD = 8, WGM = 8;

__host__ __device__ __forceinline__ int lds_byte(int r, int c) { const int st = (r >> 4) * 2 + (c >> 5), rr = r & 15, cc = c & 31, ob = rr * 64 + cc * 2; return st * 1024 + (ob ^ (((ob >> 9) & 1) << 5)); }
__host__ __device__ __forceinline__ void stage_rc(int b, int& R, int& C) { const int st = b / 1024, sb = b % 1024, swz = sb ^ (((sb >> 9) & 1) << 5); R = (st >> 1) * 16 + swz / 64; C = (st & 1) * 32 + (swz % 64) / 2; }
__host__ __device__ __forceinline__ int perm32(int rho) { const int n = rho >> 4, i = rho & 15; return 8 * (i >> 2) + 4 * n + (i & 3); }

struct Unit { int pm, pn; };
struct Gemm { const bf16_t* A; const bf16_t* Bt; int M, N, K; };

struct StaticOrder {
    int nM, nN, nwg, G, c;
    __host__ __device__ void init(int M, int N, int G_, int c_) { nM = M / BM; nN = N / BM; nwg = nM * nN; G = G_; c = c_; }
    __host__ __device__ bool next(int i, Unit& u) const {
        const long L = (long)i * G + c; if (L >= nwg) return false;
        int wgid = (int)L; { const int q = nwg / NXCD, r = nwg % NXCD, xcd = wgid % NXCD, off = wgid / NXCD; wgid = (xcd < r ? xcd * (q + 1) : r * (q + 1) + (xcd - r) * q) + off; }
        const int nig = WGM * nN, gid = wgid / nig, fm = gid * WGM, gsz = (nM - fm) < WGM ? (nM - fm) : WGM;
        u.pm = fm + ((wgid % nig) % gsz); u.pn = (wgid % nig) / gsz; return true;
    }
    __device__ __forceinline__ void a_ready(const Unit&) const {}
    __device__ __forceinline__ void done(const Unit&) const {}
};

__device__ __forceinline__ unsigned cvt_pk_bf16(float lo, float hi) { unsigned r; asm volatile("v_cvt_pk_bf16_f32 %0, %1, %2" : "=v"(r) : "v"(lo), "v"(hi)); return r; }
typedef float f32x2 __attribute__((ext_vector_type(2)));
template <class Epi, class Sched, bool ALIGN_EPI = false, bool SP2 = false>
__device__ __forceinline__ void gemm_phase(PG8_LAS unsigned char* lds, const Gemm g, const Sched& S, const Epi& E, const int tid_in) {
    const int tid = tid_in, wid = __builtin_amdgcn_readfirstlane(tid >> 6), lane = tid & 63, wr = wid >> 2, wc = wid & 3, fr = lane & 15, fq = lane >> 4;
    const int K = g.K, nt = K / BK;
    unsigned voffA[2], voffB[2];
#pragma unroll
    for (int i = 0; i < 2; ++i) { int R, C; stage_rc(tid * 16 + i * 8192, R, C); const int Rb = Epi::PERM ? ((R & ~31) + perm32(R & 31)) : R;
        voffA[i] = (unsigned)(R * K + C) * 2u; voffB[i] = (unsigned)(Rb * K + C) * 2u; }
    const size_t kstep = (size_t)(BK * 2);
    const size_t hstep = (size_t)HALF * K * 2;
    const size_t tstep = 2 * hstep;
    const unsigned ldsw = (unsigned)wid * 1024u;
    const int aoff = lds_byte(wr * 64 + fr, fq * 8), boff = lds_byte(wc * 32 + fr, fq * 8);
#define PG8_SA(b, h) (((b) * 2 + (h)) * HTB)
#define PG8_SB(b, h) ((4 + (b) * 2 + (h)) * HTB)
#define PG8_STAGE(bufoff, gbase, voff) do { _Pragma("unroll") for (int _i = 0; _i < 2; ++_i) \
        __builtin_amdgcn_global_load_lds((const unsigned*)((const char*)(gbase) + (voff)[_i]), (PG8_LAS unsigned*)(lds + (bufoff) + ldsw + _i * 8192), 16, 0, 0); } while (0)
#define PG8_LDA(dst, b, h) do { _Pragma("unroll") for (int m = 0; m < 4; ++m) _Pragma("unroll") for (int k = 0; k < 2; ++k) dst[m][k] = *(const PG8_LAS bf16x8*)(lds + PG8_SA(b, h) + aoff + m * 2048 + k * 1024); } while (0)
#define PG8_LDB(dst, b, h) do { _Pragma("unroll") for (int n = 0; n < 2; ++n) _Pragma("unroll") for (int k = 0; k < 2; ++k) dst[n][k] = *(const PG8_LAS bf16x8*)(lds + PG8_SB(b, h) + boff + n * 2048 + k * 1024); } while (0)
#define PG8_MMA(ai, bj, At, Bt) do { __builtin_amdgcn_s_setprio(1); _Pragma("unroll") for (int m = 0; m < 4; ++m) _Pragma("unroll") for (int n = 0; n < 2; ++n) _Pragma("unroll") for (int k = 0; k < 2; ++k) \
        acc[ai][bj][m][n] = __builtin_amdgcn_mfma_f32_16x16x32_bf16(Bt[n][k], At[m][k], acc[ai][bj][m][n], 0, 0, 0); __builtin_amdgcn_s_setprio(0); } while (0)
#define PG8_WAIT_V(n) asm volatile("s_waitcnt vmcnt(" #n ")" ::: "memory")
#define PG8_WAIT_L(n) asm volatile("s_waitcnt lgkmcnt(" #n ")" ::: "memory")
#define PG8_BAR __builtin_amdgcn_s_barrier()
#define PG8_SCHED __builtin_amdgcn_sched_barrier(0)
    Unit cur, nxt; int ui = 0;
    if (!S.next(0, cur)) return;
    f32x4 acc[2][2][4][2];
    float zf_ = 0.f; asm volatile("" : "+v"(zf_));
#pragma unroll
    for (int a = 0; a < 2; ++a)
#pragma unroll
        for (int b = 0; b < 2; ++b)
#pragma unroll
            for (int m = 0; m < 4; ++m)
#pragma unroll
                for (int n = 0; n < 2; ++n) acc[a][b][m][n] = (f32x4){zf_, zf_, zf_, zf_};
    bf16x8 At[4][2], B0[2][2], B1[2][2];
    const char* cA = (const char*)g.A + (size_t)cur.pm * tstep; const char* cB = (const char*)g.Bt + (size_t)cur.pn * tstep;
    S.a_ready(cur);
    if constexpr (SP2) {
        PG8_STAGE(PG8_SB(0, 0), cB, voffB); PG8_STAGE(PG8_SB(0, 1), cB + hstep, voffB); PG8_STAGE(PG8_SA(0, 0), cA, voffA); PG8_STAGE(PG8_SA(0, 1), cA + hstep, voffA);
        if (wr == 1) PG8_BAR;
        PG8_WAIT_V(2); PG8_BAR;
        PG8_STAGE(PG8_SB(1, 0), cB + kstep, voffB); PG8_STAGE(PG8_SA(1, 0), cA + kstep, voffA); PG8_STAGE(PG8_SB(1, 1), cB + hstep + kstep, voffB);
        PG8_WAIT_V(6); PG8_BAR;
    } else {
        PG8_STAGE(PG8_SB(0, 0), cB, voffB); PG8_STAGE(PG8_SA(0, 0), cA, voffA); PG8_STAGE(PG8_SB(0, 1), cB + hstep, voffB); PG8_STAGE(PG8_SA(0, 1), cA + hstep, voffA);
        if (wr == 1) PG8_BAR;
        PG8_WAIT_V(4); PG8_BAR;
        PG8_STAGE(PG8_SB(1, 0), cB + kstep, voffB); PG8_STAGE(PG8_SA(1, 0), cA + kstep, voffA); PG8_STAGE(PG8_SB(1, 1), cB + hstep + kstep, voffB);
        PG8_WAIT_V(6); PG8_BAR;
    }
    for (;;) {
        const bool has_next = S.next(ui + 1, nxt);
        const char* nA = has_next ? (const char*)g.A + (size_t)nxt.pm * tstep : cA; const char* nB = has_next ? (const char*)g.Bt + (size_t)nxt.pn * tstep : cB;
        for (int t = 0; t < nt; t += 2) {
            const bool last = (t == nt - 2);
            const char* a1 = cA + (size_t)(t + 1) * kstep;
            const char* a2 = last ? nA : cA + (size_t)(t + 2) * kstep; const char* b2 = last ? nB : cB + (size_t)(t + 2) * kstep;
            const char* a3 = a2 + kstep; const char* b3 = b2 + kstep;
            if (last && has_next) S.a_ready(nxt);
            if constexpr (SP2) {
            PG8_LDB(B0, 0, 0); PG8_LDB(B1, 0, 1); PG8_SCHED; PG8_LDA(At, 0, 0); PG8_STAGE(PG8_SA(1, 1), a1 + hstep, voffA);
            PG8_WAIT_V(8); PG8_WAIT_L(0); PG8_BAR; PG8_MMA(0, 0, At, B0); PG8_MMA(0, 1, At, B1); PG8_BAR; PG8_SCHED;
            PG8_LDA(At, 0, 1); PG8_STAGE(PG8_SB(0, 0), b2, voffB); PG8_STAGE(PG8_SB(0, 1), b2 + hstep, voffB); PG8_STAGE(PG8_SA(0, 0), a2, voffA);
            PG8_WAIT_V(8); PG8_WAIT_L(0); PG8_BAR; PG8_MMA(1, 0, At, B0); PG8_MMA(1, 1, At, B1); PG8_BAR; PG8_SCHED;
            PG8_LDB(B0, 1, 0); PG8_LDB(B1, 1, 1); PG8_SCHED; PG8_LDA(At, 1, 0); PG8_STAGE(PG8_SA(0, 1), a2 + hstep, voffA);
            PG8_WAIT_V(8); PG8_WAIT_L(0); PG8_BAR; PG8_MMA(0, 0, At, B0); PG8_MMA(0, 1, At, B1); PG8_BAR; PG8_SCHED;
            PG8_LDA(At, 1, 1); PG8_STAGE(PG8_SB(1, 0), b3, voffB); PG8_STAGE(PG8_SB(1, 1), b3 + hstep, voffB); PG8_STAGE(PG8_SA(1, 0), a3, voffA);
            PG8_WAIT_V(8); PG8_WAIT_L(0); PG8_BAR; PG8_MMA(1, 0, At, B0); PG8_MMA(1, 1, At, B1); PG8_BAR; PG8_SCHED;
            } else {
            PG8_LDB(B0, 0, 0); PG8_SCHED; PG8_LDA(At, 0, 0); PG8_STAGE(PG8_SA(1, 1), a1 + hstep, voffA);
            PG8_WAIT_L(8); PG8_BAR; PG8_WAIT_L(0); PG8_MMA(0, 0, At, B0); PG8_BAR; PG8_SCHED;
            PG8_LDB(B1, 0, 1); PG8_STAGE(PG8_SB(0, 0), b2, voffB);
            PG8_BAR; PG8_WAIT_L(0); PG8_MMA(0, 1, At, B1); PG8_BAR;
            PG8_LDA(At, 0, 1); PG8_STAGE(PG8_SA(0, 0), a2, voffA);
            PG8_BAR; PG8_WAIT_L(0); PG8_MMA(1, 0, At, B0); PG8_BAR; PG8_SCHED;
            PG8_STAGE(PG8_SB(0, 1), b2 + hstep, voffB);
            PG8_WAIT_V(6); PG8_BAR; PG8_MMA(1, 1, At, B1); PG8_BAR;
            PG8_LDB(B0, 1, 0); PG8_SCHED; PG8_LDA(At, 1, 0); PG8_STAGE(PG8_SA(0, 1), a2 + hstep, voffA);
            PG8_WAIT_L(8); PG8_BAR; PG8_WAIT_L(0); PG8_MMA(0, 0, At, B0); PG8_BAR; PG8_SCHED;
            PG8_LDB(B1, 1, 1); PG8_STAGE(PG8_SB(1, 0), b3, voffB);
            PG8_BAR; PG8_WAIT_L(0); PG8_MMA(0, 1, At, B1); PG8_BAR;
            PG8_LDA(At, 1, 1); PG8_STAGE(PG8_SA(1, 0), a3, voffA);
            PG8_BAR; PG8_WAIT_L(0); PG8_MMA(1, 0, At, B0); PG8_BAR; PG8_SCHED;
            PG8_STAGE(PG8_SB(1, 1), b3 + hstep, voffB);
            PG8_WAIT_V(6); PG8_BAR; PG8_MMA(1, 1, At, B1); PG8_BAR;
            }
        }
        if constexpr (ALIGN_EPI) { if (wr == 0) PG8_BAR; }
        if constexpr (!Epi::AFTER_DRAIN) { E(acc, cur, wr, wc, fr, fq); S.done(cur); }
        if (!has_next) break;
        zf_ = 0.f; asm volatile("" : "+v"(zf_));
#pragma unroll
        for (int a = 0; a < 2; ++a)
#pragma unroll
            for (int b = 0; b < 2; ++b)
#pragma unroll
                for (int m = 0; m < 4; ++m)
#pragma unroll
                    for (int n = 0; n < 2; ++n) acc[a][b][m][n] = (f32x4){zf_, zf_, zf_, zf_};
        cur = nxt; cA = nA; cB = nB; ++ui;
        if constexpr (ALIGN_EPI) { if (wr == 1) PG8_BAR; }
    }
    PG8_WAIT_V(0);
    if constexpr (!ALIGN_EPI) { if (wr == 0) PG8_BAR; }
    PG8_BAR;
    if constexpr (Epi::AFTER_DRAIN) { E.fused(acc, cur, wr, wc, fr, fq, lds, wid, lane); S.done(cur); }
#undef PG8_SA
#undef PG8_SB
#undef PG8_STAGE
#undef PG8_LDA
#undef PG8_LDB
#undef PG8_MMA
#undef PG8_WAIT_V
#undef PG8_WAIT_L
#undef PG8_BAR
#undef PG8_SCHED
}
}
constexpr int NW = 8, NTHR = 512;
constexpr int DM = 1024, NB = 4, SEQ = 4096, NTOK = NB * SEQ, NLAYER = 2;
constexpr int HA = 8, HDA = 64, WA = 512, MBLK = 256, NBLK = SEQ / MBLK;
constexpr int HB = 4, HDB = 128, WB = 512, CONVK = 4, DNC = 64, NCH = SEQ / DNC;
constexpr int NGRP = 4, EPG = 8, NEXP = 32, DFF = 256;
constexpr int DIN = 5640, DINP = 5632, NMOD = 6;
constexpr int C_QKVA = 0, C_QKVB = 1536, C_ZB = 3072, C_BA = 3584, C_GATE = 3592;
constexpr float EPS = 1e-6f;
constexpr int MOE_MAXROWS = 2 * NTOK + NEXP * 256;
constexpr int MOE_MAXTILES = MOE_MAXROWS / 256;

constexpr size_t MiB = 1u << 20;
constexpr size_t WS_CTL = 0, CTL_ZERO_BYTES = 1 * MiB;
constexpr size_t WS_MOD = 1 * MiB;
constexpr size_t WS_WIN = 2 * MiB;
constexpr size_t WS_WUPA = 13 * MiB, WS_WUPB = 14 * MiB;
constexpr size_t WS_WOUT = 15 * MiB;
constexpr size_t WS_WEGU = 17 * MiB;
constexpr size_t WS_WED = 49 * MiB;
constexpr size_t WS_SMALL = 65 * MiB;
constexpr size_t WS_KMEAN = WS_SMALL;
constexpr size_t WS_BETA = WS_SMALL + 256 * 1024;
constexpr size_t WS_GLOG = WS_SMALL + 512 * 1024;
constexpr size_t WS_TOKINFO = WS_SMALL + 1 * MiB;
constexpr size_t WS_ROWTOK = WS_SMALL + 2 * MiB;
constexpr size_t WS_ROWW = WS_SMALL + 3 * MiB;
constexpr size_t WS_GL = WS_SMALL + 4 * MiB;
constexpr size_t WS_H = 72 * MiB;
constexpr size_t WS_QKVA = 104 * MiB;
constexpr size_t WS_QKVB = 152 * MiB;
constexpr size_t WS_ZB = 200 * MiB;
constexpr size_t WS_GATES = 216 * MiB;
constexpr size_t WS_IMG = 280 * MiB;
constexpr size_t WS_YA = 72 * MiB, WS_YB = 336 * MiB;
constexpr size_t WS_END = 352 * MiB;
constexpr size_t WS_M = WS_QKVB;
constexpr size_t WS_U = 88 * MiB;
constexpr size_t WS_HS = WS_QKVA;
constexpr size_t WS_ACT = 184 * MiB;
constexpr size_t WS_YS = WS_GATES;
constexpr int CW_TMO = 0;
constexpr int CW_BAR = 4096;
constexpr int CW_GCNT = 8192;
constexpr int CW_ACTR = 8320;

constexpr int RING_BYTES = 131072;
constexpr int MISC_OFF = 143360;
constexpr int LDS_BYTES = 147456;

#define GAS __attribute__((address_space(1)))
#define LAS __attribute__((address_space(3)))
typedef unsigned short bf16;
typedef unsigned v4u __attribute__((ext_vector_type(4)));
typedef unsigned v2u __attribute__((ext_vector_type(2)));
typedef float f32x4 __attribute__((ext_vector_type(4)));
typedef float f32x16 __attribute__((ext_vector_type(16)));
typedef short bf16x8 __attribute__((ext_vector_type(8)));
typedef GAS unsigned gu32;
#define RLX_AGENT __ATOMIC_RELAXED, __HIP_MEMORY_SCOPE_AGENT
#define LDS_WAIT() asm volatile("s_waitcnt lgkmcnt(0)" ::: "memory")
#define VM_WAIT() asm volatile("s_waitcnt vmcnt(0)" ::: "memory")
__device__ __forceinline__ unsigned f2bf(float f) { unsigned u = __builtin_bit_cast(unsigned, f); return (u + 0x7fffu + ((u >> 16) & 1u)) >> 16; }
__device__ __forceinline__ unsigned pk2(float lo, float hi) { return f2bf(lo) | (f2bf(hi) << 16); }
__device__ __forceinline__ float bf2f(unsigned b) { return __builtin_bit_cast(float, b << 16); }
__device__ __forceinline__ float bflo(unsigned w) { return __builtin_bit_cast(float, w << 16); }
__device__ __forceinline__ float bfhi(unsigned w) { return __builtin_bit_cast(float, w & 0xffff0000u); }
__device__ __forceinline__ float sigmoidf_(float x) { return 1.f / (1.f + __expf(-x)); }
__device__ __forceinline__ float siluf_(float x) { return x / (1.f + __expf(-x)); }
__device__ __forceinline__ float shx(float v, int o, int lane) { return __builtin_bit_cast(float, __builtin_amdgcn_ds_bpermute((lane ^ o) << 2, __builtin_bit_cast(int, v))); }
__device__ __forceinline__ float shidx(float v, int src) { return __builtin_bit_cast(float, __builtin_amdgcn_ds_bpermute(src << 2, __builtin_bit_cast(int, v))); }
__device__ __forceinline__ int shidx_i(int v, int src) { return __builtin_amdgcn_ds_bpermute(src << 2, v); }
__device__ __forceinline__ float wave_sum(float v, int lane) {
#pragma unroll
    for (int o = 1; o < 64; o <<= 1) v += shx(v, o, lane);
    return v;
}
__device__ __forceinline__ float wave_max(float v, int lane) {
#pragma unroll
    for (int o = 1; o < 64; o <<= 1) v = fmaxf(v, shx(v, o, lane));
    return v;
}
__device__ const unsigned char T5B[128] = {0, 1, 2, 3, 4, 5, 6, 7, 8, 9, 10, 11, 12, 13, 14, 15, 16, 16, 16, 17, 17, 18, 18, 18, 19, 19, 19, 20, 20, 20, 20, 21, 21, 21, 21, 22, 22, 22, 22, 22, 23, 23, 23, 23, 23, 23, 24, 24, 24, 24, 24, 24, 25, 25, 25, 25, 25, 25, 25, 26, 26, 26, 26, 26, 26, 26, 26, 27, 27, 27, 27, 27, 27, 27, 27, 27, 27, 28, 28, 28, 28, 28, 28, 28, 28, 28, 28, 29, 29, 29, 29, 29, 29, 29, 29, 29, 29, 29, 29, 30, 30, 30, 30, 30, 30, 30, 30, 30, 30, 30, 30, 30, 30, 31, 31, 31, 31, 31, 31, 31, 31, 31, 31, 31, 31, 31, 31, 31};

#define XB_TMO      128
#define XB_XCNT(j)  (256  + 64 * (j))
#define XB_XSUB(j)  (1280 + 64 * (j))
#define XB_XGEN(j)  (2304 + 64 * (j))
#define XB_TOP      3328
#define XB_TOPGEN   3392
#define XCD_BAR_WORDS 3456
#define XB_SPIN_CAP (1u << 18)

__device__ __forceinline__ unsigned xb_ld(unsigned* p)              { return __hip_atomic_load(p, __ATOMIC_RELAXED, __HIP_MEMORY_SCOPE_AGENT); }
__device__ __forceinline__ unsigned xb_add(unsigned* p, unsigned v) { return __hip_atomic_fetch_add(p, v, __ATOMIC_RELAXED, __HIP_MEMORY_SCOPE_AGENT); }
__device__ __forceinline__ unsigned xb_xcc_id() { return (unsigned)__builtin_amdgcn_s_getreg((3 << 11) | 20) & 0xFu; }
#define XB_SPIN(cond, bar) do { unsigned _sp = 0; while (cond) { __builtin_amdgcn_s_sleep(1); \
    if ((++_sp & 255u) == 0u) { if (xb_ld(&(bar)[XB_TMO])) break; if (_sp > XB_SPIN_CAP) { atomicAdd(&(bar)[XB_TMO], 1u); break; } } } } while (0)

struct XcdBarrier {
    unsigned* bar; unsigned x;
    volatile LAS unsigned* st;
};

__device__ __forceinline__ XcdBarrier xcd_barrier_post(unsigned* bar, volatile LAS unsigned* st, const int tid_in) {
    XcdBarrier b; b.bar = bar; b.x = xb_xcc_id(); b.st = st;
    if (tid_in == 0) (void)xb_add(&bar[XB_XCNT(b.x)], 1u);
    return b;
}
__device__ __forceinline__ void xcd_barrier_complete(unsigned* bar, unsigned x, unsigned& nloc, unsigned& nx) {
    const unsigned G = gridDim.x * gridDim.y * gridDim.z;
    unsigned sum, cnt, mine, sp = 0u;
    for (;;) {
        sum = 0u; cnt = 0u; mine = 0u;
#pragma unroll
        for (unsigned j = 0; j < 16; ++j) { const unsigned c = xb_ld(&bar[XB_XCNT(j)]); sum += c; cnt += (c > 0u) ? 1u : 0u; mine = (j == x) ? c : mine; }
        if (sum == G) break;
        __builtin_amdgcn_s_sleep(1);
        if ((++sp & 255u) == 0u) { if (xb_ld(&bar[XB_TMO])) break; if (sp > XB_SPIN_CAP) { atomicAdd(&bar[XB_TMO], 1u); break; } }
    }
    nloc = mine > 0u ? mine : 1u; nx = cnt > 0u ? cnt : 1u;
}

__device__ __forceinline__ void xcd_barrier(const XcdBarrier& b, const int tid_in) {
    asm volatile("s_waitcnt vmcnt(0)" ::: "memory");
    __syncthreads();
    if (tid_in == 0) {
        unsigned* bar = b.bar;
        __builtin_amdgcn_s_waitcnt(0);
        unsigned nloc = b.st[0], nx = b.st[1];
        if (nloc == 0u) { xcd_barrier_complete(bar, b.x, nloc, nx); b.st[0] = nloc; b.st[1] = nx; }
        const unsigned old = xb_add(&bar[XB_XSUB(b.x)], 1u);
        const unsigned gen = old / nloc;
        if (old + 1u == (gen + 1u) * nloc) {
            __builtin_amdgcn_fence(__ATOMIC_RELEASE, "agent");
            asm volatile("s_waitcnt vmcnt(0)" ::: "memory");
            const unsigned og = xb_add(&bar[XB_TOP], 1u);
            const unsigned tg = og / nx;
            if (og + 1u == (tg + 1u) * nx) xb_add(&bar[XB_TOPGEN], 1u);
            else XB_SPIN(xb_ld(&bar[XB_TOPGEN]) == tg, bar);
            __builtin_amdgcn_fence(__ATOMIC_ACQUIRE, "agent");
            xb_add(&bar[XB_XGEN(b.x)], 1u);
            asm volatile("s_waitcnt vmcnt(0)" ::: "memory");
        } else {
            XB_SPIN(xb_ld(&bar[XB_XGEN(b.x)]) == gen, bar);
            __builtin_amdgcn_fence(__ATOMIC_ACQUIRE, "agent");
            asm volatile("s_waitcnt vmcnt(0)" ::: "memory");
        }
    }
    __syncthreads();
}
struct Args { const float* in[23]; float* out; unsigned char* ws; int ph_lo, ph_hi; };
enum { I_X = 0, I_C, I_RELB, I_FNW, I_N1W, I_N2W, I_WMOD, I_BMOD, I_WIN, I_CONVW, I_ALOG, I_DTB, I_ONW, I_WUPA, I_WUPB, I_WOUT, I_WRG, I_BRG, I_WRE, I_BRE, I_WEG, I_WEU, I_WED };

typedef const Args __attribute__((address_space(4)))* KArgs;
struct Ctx { LAS unsigned char* lds; int tid, lane, wave, bid, G; };
extern __shared__ __attribute__((aligned(16))) unsigned char lds_raw[];
__device__ __forceinline__ Ctx make_ctx(int& tid) { Ctx c; c.lds = (LAS unsigned char*)lds_raw; asm volatile("" : "+v"(tid)); const int t = tid; c.tid = t; c.lane = t & 63; c.wave = __builtin_amdgcn_readfirstlane(t >> 6); int bi = blockIdx.x, gd = gridDim.x; asm volatile("" : "+s"(bi), "+s"(gd)); c.bid = bi; c.G = gd; return c; }

__device__ __forceinline__ void ph_mod(KArgs a, const Ctx& c) {
    LAS float* cact = (LAS float*)c.lds;
    LAS float* red = (LAS float*)(c.lds + 16384);
    const float* cin = a->in[I_C];
    for (int i = c.tid; i < 4096; i += NTHR) cact[i] = siluf_(cin[i]);
    __syncthreads();
    float* mod = (float*)(a->ws + WS_MOD);
    for (int item = c.bid; item < 192; item += c.G) {
        const int l = item / 96, j0 = (item % 96) * 64;
        const float* W = a->in[I_WMOD] + (size_t)l * 1024 * 6144 + j0 + c.lane;
        float a0 = 0.f, a1 = 0.f, a2 = 0.f, a3 = 0.f;
        const int k0 = c.wave * 128;
#pragma unroll 8
        for (int k = k0; k < k0 + 128; ++k) { const float w = W[(size_t)k * 6144]; a0 += cact[k] * w; a1 += cact[1024 + k] * w; a2 += cact[2048 + k] * w; a3 += cact[3072 + k] * w; }
        red[(c.wave * 4 + 0) * 64 + c.lane] = a0; red[(c.wave * 4 + 1) * 64 + c.lane] = a1; red[(c.wave * 4 + 2) * 64 + c.lane] = a2; red[(c.wave * 4 + 3) * 64 + c.lane] = a3;
        __syncthreads();
        if (c.tid < 256) { const int b = c.tid >> 6, ln = c.tid & 63; float s = 0.f;
#pragma unroll
            for (int w = 0; w < 8; ++w) s += red[(w * 4 + b) * 64 + ln];
            mod[(l * 4 + b) * 6144 + j0 + ln] = s + a->in[I_BMOD][l * 6144 + j0 + ln]; }
        __syncthreads();
    }
}

__device__ __forceinline__ void tr_item(const float* src, int ld, bf16* dst, int K, int nblk, LAS float* scr, int item, int lane) {
    const int kb = item / nblk, nb = item % nblk, k0 = 64 * kb, n0 = 32 * nb;
#pragma unroll 8
    for (int i = 0; i < 32; ++i) { const int kk = 2 * i + (lane >> 5); scr[kk * 33 + (lane & 31)] = src[(size_t)(k0 + kk) * ld + n0 + (lane & 31)]; }
    LDS_WAIT(); asm volatile("" ::: "memory");
    const int cc = lane & 7;
#pragma unroll
    for (int j = 0; j < 4; ++j) { const int n = (lane >> 3) + 8 * j; const LAS float* s = scr + (8 * cc) * 33 + n;
        v4u o; o.x = pk2(s[0 * 33], s[1 * 33]); o.y = pk2(s[2 * 33], s[3 * 33]); o.z = pk2(s[4 * 33], s[5 * 33]); o.w = pk2(s[6 * 33], s[7 * 33]);
        *(v4u*)(dst + (size_t)(n0 + n) * K + k0 + 8 * cc) = o; }
    LDS_WAIT(); asm volatile("" ::: "memory");
}
__device__ __forceinline__ void ph_convert(KArgs a, const Ctx& c, int l) {
    LAS float* scr = (LAS float*)(c.lds + 32768 + c.wave * 10240);
    const int gw = c.bid * NW + c.wave, NGW = c.G * NW;
    constexpr int I0 = 1792, I1 = 1024, I2 = 256, I3 = 256, I4 = 512, I5 = 4096, I6 = 4096, I7 = 4096;
    constexpr int NIT = I0 + I1 + I2 + I3 + I4 + I5 + I6 + I7;
    bf16* WIN = (bf16*)(a->ws + WS_WIN); bf16* WEGU = (bf16*)(a->ws + WS_WEGU); bf16* WEDT = (bf16*)(a->ws + WS_WED);
    const float* win = a->in[I_WIN] + (size_t)l * 1024 * DIN;
    for (int it = gw; it < NIT; it += NGW) {
        int r = it;
        if (r < I0) { tr_item(win, DIN, WIN, 1024, 112, scr, r, c.lane); continue; } r -= I0;
        if (r < I1) { tr_item(win + C_GATE, DIN, WIN + (size_t)C_BA * 1024, 1024, 64, scr, r, c.lane); continue; } r -= I1;
        if (r < I2) { tr_item(a->in[I_WUPA] + (size_t)l * 512 * 1024, 1024, (bf16*)(a->ws + WS_WUPA), 512, 32, scr, r, c.lane); continue; } r -= I2;
        if (r < I3) { tr_item(a->in[I_WUPB] + (size_t)l * 512 * 1024, 1024, (bf16*)(a->ws + WS_WUPB), 512, 32, scr, r, c.lane); continue; } r -= I3;
        if (r < I4) { tr_item(a->in[I_WOUT] + (size_t)l * 1024 * 1024, 1024, (bf16*)(a->ws + WS_WOUT), 1024, 32, scr, r, c.lane); continue; } r -= I4;
        if (r < I5) { const int E = r >> 7, rem = r & 127, pn = rem >> 6, q = rem & 63;
            tr_item(a->in[I_WEG] + ((size_t)(l * 32 + E) * 1024 * 256) + 128 * pn, 256, WEGU + (size_t)(E * 512 + 256 * pn) * 1024, 1024, 4, scr, q, c.lane); continue; } r -= I5;
        if (r < I6) { const int E = r >> 7, rem = r & 127, pn = rem >> 6, q = rem & 63;
            tr_item(a->in[I_WEU] + ((size_t)(l * 32 + E) * 1024 * 256) + 128 * pn, 256, WEGU + (size_t)(E * 512 + 256 * pn + 128) * 1024, 1024, 4, scr, q, c.lane); continue; } r -= I6;
        { const int E = r >> 7, q = r & 127;
            tr_item(a->in[I_WED] + ((size_t)(l * 32 + E) * 256 * 1024), 1024, WEDT + (size_t)E * 1024 * 256, 256, 32, scr, q, c.lane); }
    }
}

__device__ __forceinline__ void load_row_x(KArgs a, int l, int m, int lane, f32x4 (&v)[4]) {
    const float* xr = (l == 0 ? a->in[I_X] : (const float*)a->out) + (size_t)m * DM;
#pragma unroll
    for (int j = 0; j < 4; ++j) v[j] = *(const f32x4*)(xr + 256 * j + 4 * lane);
    if (l > 0) {
        const int b = m >> 12;
        const float* g2 = (const float*)(a->ws + WS_MOD) + ((l - 1) * 4 + b) * 6144 + 5120;
        const bf16* ys = (const bf16*)(a->ws + WS_YS) + (size_t)m * 2048;
#pragma unroll
        for (int j = 0; j < 4; ++j) { const int col = 256 * j + 4 * lane; const v2u y0 = *(const v2u*)(ys + col), y1 = *(const v2u*)(ys + 1024 + col); const f32x4 g = *(const f32x4*)(g2 + col);
            v[j].x += g.x * (bflo(y0.x) + bflo(y1.x)); v[j].y += g.y * (bfhi(y0.x) + bfhi(y1.x)); v[j].z += g.z * (bflo(y0.y) + bflo(y1.y)); v[j].w += g.w * (bfhi(y0.y) + bfhi(y1.y)); }
        float* xo = a->out + (size_t)m * DM;
#pragma unroll
        for (int j = 0; j < 4; ++j) *(f32x4*)(xo + 256 * j + 4 * lane) = v[j];
    }
}
__device__ __forceinline__ float row_rstd(const f32x4 (&v)[4], int lane) {
    float s = 0.f;
#pragma unroll
    for (int j = 0; j < 4; ++j) s += (v[j].x * v[j].x + v[j].y * v[j].y) + (v[j].z * v[j].z + v[j].w * v[j].w);
    return 1.f / sqrtf(wave_sum(s, lane) * (1.f / DM) + EPS);
}
__device__ __forceinline__ void ph_norm1(KArgs a, const Ctx& c, int l) {
    LAS float* wbaT = (LAS float*)c.lds;
    const float* win = a->in[I_WIN] + (size_t)l * 1024 * DIN + C_BA;
    for (int i = c.tid; i < 8192; i += NTHR) { const int k = i >> 3, cc = i & 7; wbaT[cc * 1024 + k] = win[(size_t)k * DIN + cc]; }
    __syncthreads();
    const int gw = c.bid * NW + c.wave, NGW = c.G * NW, lane = c.lane;
    bf16* H = (bf16*)(a->ws + WS_H); float* beta = (float*)(a->ws + WS_BETA); float* glog = (float*)(a->ws + WS_GLOG);
    const float* n1w = a->in[I_N1W] + l * DM;
    for (int m = gw; m < NTOK; m += NGW) {
        f32x4 v[4]; load_row_x(a, l, m, lane, v);
        const float rstd = row_rstd(v, lane);
        const int b = m >> 12; const float* mod = (const float*)(a->ws + WS_MOD) + (l * 4 + b) * 6144;
        float acc[8];
#pragma unroll
        for (int q = 0; q < 8; ++q) acc[q] = 0.f;
#pragma unroll
        for (int j = 0; j < 4; ++j) { const int col = 256 * j + 4 * lane;
            const f32x4 nw = *(const f32x4*)(n1w + col), sh = *(const f32x4*)(mod + col), sc = *(const f32x4*)(mod + 1024 + col);
            f32x4 h = v[j] * rstd * nw * (sc + 1.0f) + sh;
            v2u o; o.x = pk2(h.x, h.y); o.y = pk2(h.z, h.w); *(v2u*)(H + (size_t)m * DM + col) = o;
#pragma unroll
            for (int q = 0; q < 8; ++q) { const f32x4 w4 = *(const LAS f32x4*)(wbaT + q * 1024 + col); acc[q] += (h.x * w4.x + h.y * w4.y) + (h.z * w4.z + h.w * w4.w); } }
#pragma unroll
        for (int q = 0; q < 8; ++q) acc[q] = wave_sum(acc[q], lane);
        if (lane < 4) {
            const float bb = lane == 0 ? acc[0] : lane == 1 ? acc[1] : lane == 2 ? acc[2] : acc[3];
            const float aa = lane == 0 ? acc[4] : lane == 1 ? acc[5] : lane == 2 ? acc[6] : acc[7];
            beta[m * 4 + lane] = sigmoidf_(bb);
            const float z = aa + a->in[I_DTB][l * 4 + lane]; const float sp = fmaxf(z, 0.f) + log1pf(__expf(-fabsf(z)));
            glog[m * 4 + lane] = -__expf(a->in[I_ALOG][l * 4 + lane]) * sp;
        }
    }
}
__device__ __forceinline__ void ph_final(KArgs a, const Ctx& c) {
    const int gw = c.bid * NW + c.wave, NGW = c.G * NW, lane = c.lane;
    const float* fw = a->in[I_FNW];
    for (int m = gw; m < NTOK; m += NGW) {
        f32x4 v[4];
        {
            const float* xr = (const float*)a->out + (size_t)m * DM; const int b = m >> 12;
            const float* g2 = (const float*)(a->ws + WS_MOD) + ((NLAYER - 1) * 4 + b) * 6144 + 5120;
            const bf16* ys = (const bf16*)(a->ws + WS_YS) + (size_t)m * 2048;
#pragma unroll
            for (int j = 0; j < 4; ++j) { const int col = 256 * j + 4 * lane; v[j] = *(const f32x4*)(xr + col);
                const v2u y0 = *(const v2u*)(ys + col), y1 = *(const v2u*)(ys + 1024 + col); const f32x4 g = *(const f32x4*)(g2 + col);
                v[j].x += g.x * (bflo(y0.x) + bflo(y1.x)); v[j].y += g.y * (bfhi(y0.x) + bfhi(y1.x)); v[j].z += g.z * (bflo(y0.y) + bflo(y1.y)); v[j].w += g.w * (bfhi(y0.y) + bfhi(y1.y)); }
        }
        const float rstd = row_rstd(v, lane);
        float* xo = a->out + (size_t)m * DM;
#pragma unroll
        for (int j = 0; j < 4; ++j) { const int col = 256 * j + 4 * lane; const f32x4 w = *(const f32x4*)(fw + col); *(f32x4*)(xo + col) = v[j] * rstd * w; }
    }
}

__device__ __forceinline__ void ph_kmean(KArgs a, const Ctx& c) {
    const int gw = c.bid * NW + c.wave, NGW = c.G * NW, lane = c.lane;
    const bf16* QKVA = (const bf16*)(a->ws + WS_QKVA); float* kmean = (float*)(a->ws + WS_KMEAN);
    for (int item = gw; item < NB * HA * NBLK; item += NGW) {
        const int nb = item & 15, h = (item >> 4) & 7, b = item >> 7;
        const int sub = lane & 7, rr = lane >> 3;
        float s[8];
#pragma unroll
        for (int q = 0; q < 8; ++q) s[q] = 0.f;
        const bf16* kp = QKVA + (size_t)(b * SEQ + nb * MBLK) * 1536 + 512 + h * 64 + sub * 8;
#pragma unroll 4
        for (int it = 0; it < 32; ++it) { const v4u w = *(const v4u*)(kp + (size_t)(it * 8 + rr) * 1536);
            s[0] += bflo(w.x); s[1] += bfhi(w.x); s[2] += bflo(w.y); s[3] += bfhi(w.y); s[4] += bflo(w.z); s[5] += bfhi(w.z); s[6] += bflo(w.w); s[7] += bfhi(w.w); }
#pragma unroll
        for (int q = 0; q < 8; ++q) { s[q] += shx(s[q], 8, lane); s[q] += shx(s[q], 16, lane); s[q] += shx(s[q], 32, lane); }
        if (lane < 8) { float* o = kmean + (size_t)item * 64 + sub * 8;
            *(f32x4*)o = (f32x4){s[0], s[1], s[2], s[3]} * (1.f / 256.f); *(f32x4*)(o + 4) = (f32x4){s[4], s[5], s[6], s[7]} * (1.f / 256.f); }
    }
}

__device__ __forceinline__ void ph_attn_simple(KArgs a, const Ctx& c) {
    const int gw = c.bid * NW + c.wave, NGW = c.G * NW, lane = c.lane;
    LAS float* btab = (LAS float*)(c.lds);
    LAS float* scw = (LAS float*)(c.lds + 8192) + c.wave * 1024;
    const float* relb = a->in[I_RELB];
    for (int i = c.tid; i < 8 * 129; i += NTHR) { const int h = i / 129, d = i % 129; btab[h * 132 + d] = relb[(d < 128 ? (int)T5B[d] : 31) * 8 + h]; }
    __syncthreads();
    const bf16* QKVA = (const bf16*)(a->ws + WS_QKVA); const float* kmean = (const float*)(a->ws + WS_KMEAN); bf16* YA = (bf16*)(a->ws + WS_YA);
    for (int r = gw; r < NB * HA * SEQ; r += NGW) {
        const int s = r & (SEQ - 1), h = (r >> 12) & 7, b = r >> 15, qb = s >> 8, tok = b * SEQ + s;
        float qv[64];
        { const bf16* qp = QKVA + (size_t)tok * 1536 + h * 64;
#pragma unroll
          for (int q = 0; q < 8; ++q) { const v4u w = *(const v4u*)(qp + q * 8); qv[q * 8 + 0] = bflo(w.x); qv[q * 8 + 1] = bfhi(w.x); qv[q * 8 + 2] = bflo(w.y); qv[q * 8 + 3] = bfhi(w.y); qv[q * 8 + 4] = bflo(w.z); qv[q * 8 + 5] = bfhi(w.z); qv[q * 8 + 6] = bflo(w.w); qv[q * 8 + 7] = bfhi(w.w); } }
        float gate = -1e30f;
        if (lane < qb) { const float* km = kmean + (size_t)(((b * 8 + h) * 16) + lane) * 64; float d = 0.f;
#pragma unroll
            for (int q = 0; q < 16; ++q) { const f32x4 k4 = *(const f32x4*)(km + q * 4); d += qv[q * 4] * k4.x + qv[q * 4 + 1] * k4.y + qv[q * 4 + 2] * k4.z + qv[q * 4 + 3] * k4.w; }
            gate = d; }
        unsigned selmask = 0u;
#pragma unroll
        for (int t = 0; t < 3; ++t) { float best = -3e38f; int bi = 0;
#pragma unroll
            for (int n = 0; n < 16; ++n) { const float gv = shidx(gate, n); if (!((selmask >> n) & 1u) && gv > best) { best = gv; bi = n; } }
            selmask |= 1u << bi; }
        selmask &= (1u << qb) - 1u;
        selmask |= 1u << qb;
        int nseg = 0; float mx = -3e38f;
        for (int blk = 0; blk <= qb; ++blk) {
            if (!((selmask >> blk) & 1u)) continue;
            for (int i = 0; i < 4; ++i) { const int key = blk * 256 + i * 64 + lane; const bf16* kp = QKVA + (size_t)(b * SEQ + key) * 1536 + 512 + h * 64; float d = 0.f;
#pragma unroll
                for (int q = 0; q < 8; ++q) { const v4u w = *(const v4u*)(kp + q * 8);
                    d += qv[q * 8] * bflo(w.x) + qv[q * 8 + 1] * bfhi(w.x) + qv[q * 8 + 2] * bflo(w.y) + qv[q * 8 + 3] * bfhi(w.y) + qv[q * 8 + 4] * bflo(w.z) + qv[q * 8 + 5] * bfhi(w.z) + qv[q * 8 + 6] * bflo(w.w) + qv[q * 8 + 7] * bfhi(w.w); }
                const int dist = s - key; float sc = d * 0.125f + btab[h * 132 + (dist < 0 ? 0 : (dist > 128 ? 128 : dist))];
                if (dist < 0) sc = -3e38f;
                scw[nseg * 256 + i * 64 + lane] = sc; mx = fmaxf(mx, sc); }
            ++nseg; }
        mx = wave_max(mx, lane);
        float sum = 0.f;
        for (int idx = lane; idx < nseg * 256; idx += 64) { const float sc = scw[idx]; const float e = sc < -1e37f ? 0.f : __expf(sc - mx); scw[idx] = e; sum += e; }
        sum = wave_sum(sum, lane);
        LDS_WAIT();
        float o = 0.f; int sg = 0;
        for (int blk = 0; blk <= qb; ++blk) {
            if (!((selmask >> blk) & 1u)) continue;
            const bf16* vp = QKVA + (size_t)(b * SEQ + blk * 256) * 1536 + 1024 + h * 64 + lane;
            const int lim = (blk == qb) ? (s & 255) + 1 : 256;
#pragma unroll 8
            for (int kk = 0; kk < lim; ++kk) o += scw[sg * 256 + kk] * bf2f(vp[(size_t)kk * 1536]);
            ++sg; }
        YA[(size_t)tok * 512 + h * 64 + lane] = (bf16)f2bf(o / sum);
    }
}

template <int LDW> __device__ __forceinline__ void dn_load_chunk(KArgs a, const Ctx& c, int l, int b, int h, int t0, LAS float* qs, LAS float* ks, LAS float* vs) {
    const bf16* QKVB = (const bf16*)(a->ws + WS_QKVB); const float* cw = a->in[I_CONVW] + (size_t)l * 4 * 1536;
    const int cg = c.tid & 15, r0 = c.tid >> 4;
#pragma unroll
    for (int part = 0; part < 3; ++part) {
        const int colb = part * 512 + h * 128 + 8 * cg;
        float w[4][8];
#pragma unroll
        for (int i = 0; i < 4; ++i) { const f32x4 w0 = *(const f32x4*)(cw + i * 1536 + colb), w1 = *(const f32x4*)(cw + i * 1536 + colb + 4);
            w[i][0] = w0.x; w[i][1] = w0.y; w[i][2] = w0.z; w[i][3] = w0.w; w[i][4] = w1.x; w[i][5] = w1.y; w[i][6] = w1.z; w[i][7] = w1.w; }
        LAS float* dst = part == 0 ? qs : part == 1 ? ks : vs;
#pragma unroll
        for (int pass = 0; pass < 2; ++pass) {
            const int r = r0 + 32 * pass, t = t0 + r;
            float y[8];
#pragma unroll
            for (int e = 0; e < 8; ++e) y[e] = 0.f;
#pragma unroll
            for (int i = 0; i < 4; ++i) { const int tt = t - 3 + i; if (tt >= 0) { const v4u x = *(const v4u*)(QKVB + (size_t)(b * SEQ + tt) * 1536 + colb);
                y[0] += w[i][0] * bflo(x.x); y[1] += w[i][1] * bfhi(x.x); y[2] += w[i][2] * bflo(x.y); y[3] += w[i][3] * bfhi(x.y); y[4] += w[i][4] * bflo(x.z); y[5] += w[i][5] * bfhi(x.z); y[6] += w[i][6] * bflo(x.w); y[7] += w[i][7] * bfhi(x.w); } }
            float ss = 0.f;
#pragma unroll
            for (int e = 0; e < 8; ++e) { y[e] = siluf_(y[e]); ss += y[e] * y[e]; }
            if (part < 2) { ss += shx(ss, 1, c.lane); ss += shx(ss, 2, c.lane); ss += shx(ss, 4, c.lane); ss += shx(ss, 8, c.lane);
                const float rs = (1.f / sqrtf(ss + EPS)) * (part == 0 ? 0.08838834764831845f : 1.f);
#pragma unroll
                for (int e = 0; e < 8; ++e) y[e] *= rs; }
            *(LAS f32x4*)(dst + r * LDW + 8 * cg) = (f32x4){y[0], y[1], y[2], y[3]}; *(LAS f32x4*)(dst + r * LDW + 8 * cg + 4) = (f32x4){y[4], y[5], y[6], y[7]};
        }
    }
}
__device__ __forceinline__ void dn_store_chunk(KArgs a, const Ctx& c, int l, int b, int h, int t0, const LAS float* os) {
    const bf16* ZB = (const bf16*)(a->ws + WS_ZB); bf16* YB = (bf16*)(a->ws + WS_YB); const float* onw = a->in[I_ONW] + l * 128;
    const int r = c.tid >> 3, sub = c.tid & 7, tok = b * SEQ + t0 + r;
    float o[16]; float ss = 0.f;
#pragma unroll
    for (int q = 0; q < 4; ++q) { const f32x4 v = *(const LAS f32x4*)(os + r * 128 + sub * 16 + q * 4); o[q * 4] = v.x; o[q * 4 + 1] = v.y; o[q * 4 + 2] = v.z; o[q * 4 + 3] = v.w; ss += (v.x * v.x + v.y * v.y) + (v.z * v.z + v.w * v.w); }
    ss += shx(ss, 1, c.lane); ss += shx(ss, 2, c.lane); ss += shx(ss, 4, c.lane);
    const float rstd = 1.f / sqrtf(ss * (1.f / 128.f) + EPS);
    const bf16* zp = ZB + (size_t)tok * 512 + h * 128 + sub * 16; bf16* yp = YB + (size_t)tok * 512 + h * 128 + sub * 16;
#pragma unroll
    for (int q = 0; q < 2; ++q) { const v4u z = *(const v4u*)(zp + q * 8); const f32x4 w0 = *(const f32x4*)(onw + sub * 16 + q * 8), w1 = *(const f32x4*)(onw + sub * 16 + q * 8 + 4);
        v4u y; y.x = pk2(o[q * 8 + 0] * rstd * w0.x * siluf_(bflo(z.x)), o[q * 8 + 1] * rstd * w0.y * siluf_(bfhi(z.x)));
        y.y = pk2(o[q * 8 + 2] * rstd * w0.z * siluf_(bflo(z.y)), o[q * 8 + 3] * rstd * w0.w * siluf_(bfhi(z.y)));
        y.z = pk2(o[q * 8 + 4] * rstd * w1.x * siluf_(bflo(z.z)), o[q * 8 + 5] * rstd * w1.y * siluf_(bfhi(z.z)));
        y.w = pk2(o[q * 8 + 6] * rstd * w1.z * siluf_(bflo(z.w)), o[q * 8 + 7] * rstd * w1.w * siluf_(bfhi(z.w)));
        *(v4u*)(yp + q * 8) = y; }
}
__device__ __forceinline__ void ph_dn_simple(KArgs a, const Ctx& c, int l) {
    LAS float* qs = (LAS float*)c.lds; LAS float* ks = qs + 8192; LAS float* vs = ks + 8192; LAS float* os = vs + 8192;
    LAS float* bt = (LAS float*)(c.lds + MISC_OFF + 1024); LAS float* at = bt + 64;
    const float* beta = (const float*)(a->ws + WS_BETA); const float* glog = (const float*)(a->ws + WS_GLOG);
    const int v = c.tid >> 2, kq = c.tid & 3;
    for (int item = c.bid; item < NB * HB; item += c.G) {
        const int b = item >> 2, h = item & 3;
        float S[32];
#pragma unroll
        for (int q = 0; q < 32; ++q) S[q] = 0.f;
        for (int n = 0; n < NCH; ++n) {
            const int t0 = n * DNC;
            __syncthreads();
            dn_load_chunk<128>(a, c, l, b, h, t0, qs, ks, vs);
            if (c.tid < 64) { const int tok = b * SEQ + t0 + c.tid; bt[c.tid] = beta[tok * 4 + h]; at[c.tid] = __expf(glog[tok * 4 + h]); }
            __syncthreads();
            for (int tt = 0; tt < DNC; ++tt) {
                const float a_t = at[tt], b_t = bt[tt];
                float kr[32];
#pragma unroll
                for (int q = 0; q < 8; ++q) { const f32x4 k4 = *(const LAS f32x4*)(ks + tt * 128 + kq * 32 + q * 4); kr[q * 4] = k4.x; kr[q * 4 + 1] = k4.y; kr[q * 4 + 2] = k4.z; kr[q * 4 + 3] = k4.w; }
                float kS = 0.f;
#pragma unroll
                for (int q = 0; q < 32; ++q) kS += kr[q] * S[q];
                kS += shx(kS, 1, c.lane); kS += shx(kS, 2, c.lane);
                const float vn = b_t * (vs[tt * 128 + v] - a_t * kS);
                float o = 0.f;
#pragma unroll
                for (int q = 0; q < 8; ++q) { const f32x4 q4 = *(const LAS f32x4*)(qs + tt * 128 + kq * 32 + q * 4);
                    S[q * 4] = a_t * S[q * 4] + kr[q * 4] * vn; S[q * 4 + 1] = a_t * S[q * 4 + 1] + kr[q * 4 + 1] * vn; S[q * 4 + 2] = a_t * S[q * 4 + 2] + kr[q * 4 + 2] * vn; S[q * 4 + 3] = a_t * S[q * 4 + 3] + kr[q * 4 + 3] * vn;
                    o += (q4.x * S[q * 4] + q4.y * S[q * 4 + 1]) + (q4.z * S[q * 4 + 2] + q4.w * S[q * 4 + 3]); }
                o += shx(o, 1, c.lane); o += shx(o, 2, c.lane);
                if (kq == 0) os[tt * 128 + v] = o;
            }
            __syncthreads();
            dn_store_chunk(a, c, l, b, h, t0, os);
        }
    }
}

struct EpiProj {
    static constexpr bool PERM = true, AFTER_DRAIN = false; unsigned char* ws;
    __device__ __forceinline__ void operator()(const pg8::f32x4 (&acc)[2][2][4][2], const pg8::Unit& u, int wr, int wc, int fr, int fq) const {
        const int pn = u.pn; bf16* base; int ld, ct; bool sg = false;
        if (pn < 6) { base = (bf16*)(ws + WS_QKVA); ld = 1536; ct = pn; } else if (pn < 12) { base = (bf16*)(ws + WS_QKVB); ld = 1536; ct = pn - 6; }
        else if (pn < 14) { base = (bf16*)(ws + WS_ZB); ld = 512; ct = pn - 12; } else { base = (bf16*)(ws + WS_GATES); ld = 2048; ct = pn - 14; sg = true; }
        const int row0 = u.pm * 256 + wr * 64 + fr, col0 = ct * 256 + wc * 32 + 8 * fq;
#pragma unroll
        for (int ai = 0; ai < 2; ++ai)
#pragma unroll
            for (int m = 0; m < 4; ++m) { bf16* rowp = base + (size_t)(row0 + ai * 128 + m * 16) * ld + col0;
#pragma unroll
                for (int bj = 0; bj < 2; ++bj) { f32x4 v0 = acc[ai][bj][m][0], v1 = acc[ai][bj][m][1];
                    if (sg) { v0.x = sigmoidf_(v0.x); v0.y = sigmoidf_(v0.y); v0.z = sigmoidf_(v0.z); v0.w = sigmoidf_(v0.w); v1.x = sigmoidf_(v1.x); v1.y = sigmoidf_(v1.y); v1.z = sigmoidf_(v1.z); v1.w = sigmoidf_(v1.w); }
                    v4u w; w.x = pk2(v0.x, v0.y); w.y = pk2(v0.z, v0.w); w.z = pk2(v1.x, v1.y); w.w = pk2(v1.z, v1.w);
                    *(v4u*)(rowp + bj * 128) = w; } }
    }
};
template <bool SECOND> struct EpiMerge {
    static constexpr bool PERM = true, AFTER_DRAIN = false; unsigned char* ws;
    __device__ __forceinline__ void operator()(const pg8::f32x4 (&acc)[2][2][4][2], const pg8::Unit& u, int wr, int wc, int fr, int fq) const {
        bf16* M = (bf16*)(ws + WS_M); const bf16* GT = (const bf16*)(ws + WS_GATES) + (SECOND ? 1024 : 0);
        const int row0 = u.pm * 256 + wr * 64 + fr, col0 = u.pn * 256 + wc * 32 + 8 * fq;
#pragma unroll
        for (int ai = 0; ai < 2; ++ai)
#pragma unroll
            for (int m = 0; m < 4; ++m) { const size_t row = row0 + ai * 128 + m * 16;
#pragma unroll
                for (int bj = 0; bj < 2; ++bj) { const int col = col0 + bj * 128; const f32x4 v0 = acc[ai][bj][m][0], v1 = acc[ai][bj][m][1];
                    const v4u g = *(const v4u*)(GT + row * 2048 + col);
                    float o[8] = {bflo(g.x) * v0.x, bfhi(g.x) * v0.y, bflo(g.y) * v0.z, bfhi(g.y) * v0.w, bflo(g.z) * v1.x, bfhi(g.z) * v1.y, bflo(g.w) * v1.z, bfhi(g.w) * v1.w};
                    if (SECOND) { const v4u p = *(const v4u*)(M + row * 1024 + col); o[0] += bflo(p.x); o[1] += bfhi(p.x); o[2] += bflo(p.y); o[3] += bfhi(p.y); o[4] += bflo(p.z); o[5] += bfhi(p.z); o[6] += bflo(p.w); o[7] += bfhi(p.w); }
                    v4u w; w.x = pk2(o[0], o[1]); w.y = pk2(o[2], o[3]); w.z = pk2(o[4], o[5]); w.w = pk2(o[6], o[7]);
                    *(v4u*)(M + row * 1024 + col) = w; } }
    }
};
struct EpiOut {
    static constexpr bool PERM = true, AFTER_DRAIN = false; const float* xin; float* xout; const float* g1;
    __device__ __forceinline__ void operator()(const pg8::f32x4 (&acc)[2][2][4][2], const pg8::Unit& u, int wr, int wc, int fr, int fq) const {
        const int row0 = u.pm * 256 + wr * 64 + fr, col0 = u.pn * 256 + wc * 32 + 8 * fq; const int b = (u.pm * 256) >> 12;
#pragma unroll
        for (int bj = 0; bj < 2; ++bj) { const int col = col0 + bj * 128; const f32x4 ga = *(const f32x4*)(g1 + b * 6144 + col), gb = *(const f32x4*)(g1 + b * 6144 + col + 4);
#pragma unroll
            for (int ai = 0; ai < 2; ++ai)
#pragma unroll
                for (int m = 0; m < 4; ++m) { const size_t off = (size_t)(row0 + ai * 128 + m * 16) * DM + col;
                    const f32x4 x0 = *(const f32x4*)(xin + off), x1 = *(const f32x4*)(xin + off + 4);
                    *(f32x4*)(xout + off) = x0 + ga * acc[ai][bj][m][0]; *(f32x4*)(xout + off + 4) = x1 + gb * acc[ai][bj][m][1]; } }
    }
};
struct EpiMoeGU {
    static constexpr bool PERM = true, AFTER_DRAIN = false; unsigned char* ws;
    __device__ __forceinline__ void operator()(const pg8::f32x4 (&acc)[2][2][4][2], const pg8::Unit& u, int wr, int wc, int fr, int fq) const {
        bf16* ACT = (bf16*)(ws + WS_ACT);
        const int row0 = u.pm * 256 + wr * 64 + fr, col0 = (u.pn & 1) * 128 + wc * 32 + 8 * fq;
#pragma unroll
        for (int ai = 0; ai < 2; ++ai)
#pragma unroll
            for (int m = 0; m < 4; ++m) { const f32x4 g0 = acc[ai][0][m][0], g1 = acc[ai][0][m][1], u0 = acc[ai][1][m][0], u1 = acc[ai][1][m][1];
                v4u w; w.x = pk2(siluf_(g0.x) * u0.x, siluf_(g0.y) * u0.y); w.y = pk2(siluf_(g0.z) * u0.z, siluf_(g0.w) * u0.w); w.z = pk2(siluf_(g1.x) * u1.x, siluf_(g1.y) * u1.y); w.w = pk2(siluf_(g1.z) * u1.z, siluf_(g1.w) * u1.w);
                *(v4u*)(ACT + (size_t)(row0 + ai * 128 + m * 16) * 256 + col0) = w; }
    }
};
struct EpiMoeDown {
    static constexpr bool PERM = true, AFTER_DRAIN = false; unsigned char* ws;
    __device__ __forceinline__ void operator()(const pg8::f32x4 (&acc)[2][2][4][2], const pg8::Unit& u, int wr, int wc, int fr, int fq) const {
        bf16* YS = (bf16*)(ws + WS_YS); const int* rowtok = (const int*)(ws + WS_ROWTOK); const float* roww = (const float*)(ws + WS_ROWW);
        const int row0 = u.pm * 256 + wr * 64 + fr, col0 = (u.pn & 3) * 256 + wc * 32 + 8 * fq;
#pragma unroll
        for (int ai = 0; ai < 2; ++ai)
#pragma unroll
            for (int m = 0; m < 4; ++m) { const int row = row0 + ai * 128 + m * 16; const int rt = rowtok[row]; const float wgt = roww[row];
                if (rt >= 0) {
#pragma unroll
                    for (int bj = 0; bj < 2; ++bj) { const f32x4 v0 = acc[ai][bj][m][0] * wgt, v1 = acc[ai][bj][m][1] * wgt;
                        v4u w; w.x = pk2(v0.x, v0.y); w.y = pk2(v0.z, v0.w); w.z = pk2(v1.x, v1.y); w.w = pk2(v1.z, v1.w);
                        *(v4u*)(YS + (size_t)rt * 1024 + col0 + bj * 128) = w; } } }
    }
};
struct MoeOrder {
    const LAS int* tile_exp; int nunits, G, c, sh;
    __device__ __forceinline__ bool next(int i, pg8::Unit& u) const {
        const int L = i * G + c; if (L >= nunits) return false;
        const int r = L >> sh, j = L & ((1 << sh) - 1);
        u.pm = r; u.pn = __builtin_amdgcn_readfirstlane((tile_exp[r] << sh) + j); return true;
    }
    __device__ __forceinline__ void a_ready(const pg8::Unit&) const {}
    __device__ __forceinline__ void done(const pg8::Unit&) const {}
};

__device__ __forceinline__ void ph_router(KArgs a, const Ctx& c, int l) {
    LAS int* lcnt = (LAS int*)(c.lds);
    LAS int* lbase = lcnt + 32;
    LAS int* tinf = lcnt + 64;
    const int lane = c.lane;
    bf16* H2 = (bf16*)(a->ws + WS_H); unsigned* tokinfo = (unsigned*)(a->ws + WS_TOKINFO); int* rowtok = (int*)(a->ws + WS_ROWTOK);
    unsigned* gcnt = (unsigned*)(a->ws + WS_CTL) + CW_GCNT + l * 32;
    const float* n2w = a->in[I_N2W] + l * DM; const float* wrg = a->in[I_WRG] + (size_t)l * 1024 * 4; const float* wre = a->in[I_WRE] + (size_t)l * 1024 * 32;
    for (int i = c.bid * NTHR + c.tid; i < MOE_MAXROWS; i += c.G * NTHR) rowtok[i] = -1;
    for (int tb = c.bid; tb < NTOK / 64; tb += c.G) {
        __syncthreads();
        if (c.tid < 32) lcnt[c.tid] = 0;
        __syncthreads();
        for (int i = 0; i < 8; ++i) {
            const int tl = c.wave * 8 + i, m = tb * 64 + tl, b = m >> 12;
            const float* xr = (const float*)a->out + (size_t)m * DM; const float* mod = (const float*)(a->ws + WS_MOD) + (l * 4 + b) * 6144;
            f32x4 h[4];
#pragma unroll
            for (int j = 0; j < 4; ++j) h[j] = *(const f32x4*)(xr + 256 * j + 4 * lane);
            const float rstd = row_rstd(h, lane);
            float ag[4] = {0.f, 0.f, 0.f, 0.f};
#pragma unroll
            for (int j = 0; j < 4; ++j) { const int col = 256 * j + 4 * lane;
                const f32x4 nw = *(const f32x4*)(n2w + col), sh = *(const f32x4*)(mod + 3072 + col), sc = *(const f32x4*)(mod + 4096 + col);
                h[j] = h[j] * rstd * nw * (sc + 1.0f) + sh;
                v2u o; o.x = pk2(h[j].x, h[j].y); o.y = pk2(h[j].z, h[j].w); *(v2u*)(H2 + (size_t)m * DM + col) = o;
                const f32x4 r0 = *(const f32x4*)(wrg + (size_t)(col + 0) * 4), r1 = *(const f32x4*)(wrg + (size_t)(col + 1) * 4), r2 = *(const f32x4*)(wrg + (size_t)(col + 2) * 4), r3 = *(const f32x4*)(wrg + (size_t)(col + 3) * 4);
                ag[0] += h[j].x * r0.x + h[j].y * r1.x + h[j].z * r2.x + h[j].w * r3.x; ag[1] += h[j].x * r0.y + h[j].y * r1.y + h[j].z * r2.y + h[j].w * r3.y;
                ag[2] += h[j].x * r0.z + h[j].y * r1.z + h[j].z * r2.z + h[j].w * r3.z; ag[3] += h[j].x * r0.w + h[j].y * r1.w + h[j].z * r2.w + h[j].w * r3.w; }
#pragma unroll
            for (int q = 0; q < 4; ++q) ag[q] = wave_sum(ag[q], lane) + a->in[I_BRG][l * 4 + q];
            int g = 0; float gm = ag[0];
#pragma unroll
            for (int q = 1; q < 4; ++q) if (ag[q] > gm) { gm = ag[q]; g = q; }
            float den = 0.f;
#pragma unroll
            for (int q = 0; q < 4; ++q) den += __expf(ag[q] - gm);
            const float ptop = 1.f / den;
            float ae[8] = {0.f, 0.f, 0.f, 0.f, 0.f, 0.f, 0.f, 0.f};
#pragma unroll
            for (int j = 0; j < 4; ++j) { const int col = 256 * j + 4 * lane; const float hv[4] = {h[j].x, h[j].y, h[j].z, h[j].w};
#pragma unroll
                for (int e = 0; e < 4; ++e) { const float* wr_ = wre + (size_t)(col + e) * 32 + g * 8; const f32x4 w0 = *(const f32x4*)wr_, w1 = *(const f32x4*)(wr_ + 4);
                    ae[0] += hv[e] * w0.x; ae[1] += hv[e] * w0.y; ae[2] += hv[e] * w0.z; ae[3] += hv[e] * w0.w; ae[4] += hv[e] * w1.x; ae[5] += hv[e] * w1.y; ae[6] += hv[e] * w1.z; ae[7] += hv[e] * w1.w; } }
#pragma unroll
            for (int q = 0; q < 8; ++q) ae[q] = wave_sum(ae[q], lane) + a->in[I_BRE][l * 32 + g * 8 + q];
            int e0 = 0; float v0 = ae[0];
#pragma unroll
            for (int q = 1; q < 8; ++q) if (ae[q] > v0) { v0 = ae[q]; e0 = q; }
            int e1 = -1; float v1 = -3e38f;
#pragma unroll
            for (int q = 0; q < 8; ++q) if (q != e0 && ae[q] > v1) { v1 = ae[q]; e1 = q; }
            const float ex = __expf(v1 - v0); const float w0 = ptop / (1.f + ex), w1 = ptop * ex / (1.f + ex);
            if (lane == 0) { const int E0 = g * 8 + e0, E1 = g * 8 + e1;
                const int r0 = atomicAdd((int*)(lcnt + E0), 1), r1 = atomicAdd((int*)(lcnt + E1), 1);
                tinf[tl * 6 + 0] = E0; tinf[tl * 6 + 1] = E1; tinf[tl * 6 + 2] = r0; tinf[tl * 6 + 3] = r1; tinf[tl * 6 + 4] = __float_as_int(w0); tinf[tl * 6 + 5] = __float_as_int(w1); }
        }
        __syncthreads();
        if (c.tid < 32) lbase[c.tid] = (int)__hip_atomic_fetch_add(gcnt + c.tid, (unsigned)lcnt[c.tid], RLX_AGENT);
        __syncthreads();
        if (c.tid < 64) { const int m = tb * 64 + c.tid; const int E0 = tinf[c.tid * 6], E1 = tinf[c.tid * 6 + 1];
            v4u o; o.x = (unsigned)E0; o.y = (unsigned)E1; o.z = (unsigned)(lbase[E0] + tinf[c.tid * 6 + 2]); o.w = (unsigned)(lbase[E1] + tinf[c.tid * 6 + 3]);
            *(v4u*)(tokinfo + (size_t)m * 8) = o; *(v2u*)(tokinfo + (size_t)m * 8 + 4) = (v2u){(unsigned)tinf[c.tid * 6 + 4], (unsigned)tinf[c.tid * 6 + 5]}; }
    }
}
__device__ __forceinline__ void moe_table(KArgs a, const Ctx& c, int l) {
    LAS int* tile_exp = (LAS int*)(c.lds + MISC_OFF + 2048); LAS int* offs = tile_exp + 192; LAS int* ntl = offs + 32; LAS int* pre = ntl + 4;
    const unsigned* gcnt = (const unsigned*)(a->ws + WS_CTL) + CW_GCNT + l * 32;
    __syncthreads();
    if (c.tid < 64) { const int e = c.tid & 31; const int cnt = (int)__hip_atomic_load(gcnt + e, RLX_AGENT); const int nt = (cnt + 255) >> 8; int inc = nt;
#pragma unroll
        for (int o = 1; o < 32; o <<= 1) { const int v = shidx_i(inc, (c.lane - o) & 63); if (e >= o) inc += v; }
        if (c.tid < 32) { offs[e] = (inc - nt) * 256; pre[e] = inc; if (e == 31) ntl[0] = inc; } }
    __syncthreads();
    if (c.tid < MOE_MAXTILES) { int E = 0;
#pragma unroll
        for (int e = 0; e < 32; ++e) E += (pre[e] <= c.tid) ? 1 : 0;
        tile_exp[c.tid] = E < 31 ? E : 31; }
    __syncthreads();
}
__device__ __forceinline__ void ph_gather(KArgs a, const Ctx& c, int l) {
    moe_table(a, c, l);
    const LAS int* offs = (const LAS int*)(c.lds + MISC_OFF + 2048) + 192;
    const int gw = c.bid * NW + c.wave, NGW = c.G * NW, lane = c.lane;
    const bf16* H2 = (const bf16*)(a->ws + WS_H); bf16* HS = (bf16*)(a->ws + WS_HS); const unsigned* tokinfo = (const unsigned*)(a->ws + WS_TOKINFO);
    int* rowtok = (int*)(a->ws + WS_ROWTOK); float* roww = (float*)(a->ws + WS_ROWW);
    for (int m = gw; m < NTOK; m += NGW) {
        const v4u ti = *(const v4u*)(tokinfo + (size_t)m * 8); const v2u tw = *(const v2u*)(tokinfo + (size_t)m * 8 + 4);
        const int d0 = offs[ti.x] + (int)ti.z, d1 = offs[ti.y] + (int)ti.w;
        const v4u x0 = *(const v4u*)(H2 + (size_t)m * DM + lane * 8), x1 = *(const v4u*)(H2 + (size_t)m * DM + 512 + lane * 8);
        *(v4u*)(HS + (size_t)d0 * DM + lane * 8) = x0; *(v4u*)(HS + (size_t)d0 * DM + 512 + lane * 8) = x1;
        *(v4u*)(HS + (size_t)d1 * DM + lane * 8) = x0; *(v4u*)(HS + (size_t)d1 * DM + 512 + lane * 8) = x1;
        if (lane == 0) { rowtok[d0] = m * 2; rowtok[d1] = m * 2 + 1; roww[d0] = __uint_as_float(tw.x); roww[d1] = __uint_as_float(tw.y); }
    }
}
constexpr int DN_IMG = 57344, DN_LDW = 132, DN_LDA = 68;
typedef __bf16 bf16x2_t __attribute__((ext_vector_type(2)));
typedef float f32x2_t __attribute__((ext_vector_type(2)));
__device__ __forceinline__ unsigned cvtpk(float lo, float hi) { f32x2_t v = {lo, hi}; bf16x2_t b = __builtin_convertvector(v, bf16x2_t); return __builtin_bit_cast(unsigned, b); }
__device__ __forceinline__ bf16x8 pack8(f32x4 a, f32x4 b) { v4u w; w.x = cvtpk(a.x, a.y); w.y = cvtpk(a.z, a.w); w.z = cvtpk(b.x, b.y); w.w = cvtpk(b.z, b.w); return __builtin_bit_cast(bf16x8, w); }
#define MFMA16(a, b, c) __builtin_amdgcn_mfma_f32_16x16x32_bf16((a), (b), (c), 0, 0, 0)

__device__ __forceinline__ void ph_dn_prep(KArgs a, const Ctx& c, int l) {
    LAS float* qs = (LAS float*)c.lds; LAS float* ks = qs + 64 * DN_LDW; LAS float* vs = ks + 64 * DN_LDW;
    LAS float* Am = vs + 64 * DN_LDW; LAS float* Pm = Am + 64 * DN_LDA;
    LAS float* bt = (LAS float*)(c.lds + MISC_OFF + 1024); LAS float* Gc = bt + 64;
    const float* beta = (const float*)(a->ws + WS_BETA); const float* glog = (const float*)(a->ws + WS_GLOG);
    const int lane = c.lane, row = lane & 15, quad = lane >> 4, tid = c.tid;
    for (int item = c.bid; item < NB * HB * NCH; item += c.G) {
        const int n = item & 63, h = (item >> 6) & 3, b = item >> 8, t0 = n * DNC;
        unsigned char* img = a->ws + WS_IMG + (size_t)item * DN_IMG;
        __syncthreads();
        dn_load_chunk<DN_LDW>(a, c, l, b, h, t0, qs, ks, vs);
        if (tid < 64) { const int tok = b * SEQ + t0 + tid; bt[tid] = beta[tok * 4 + h]; float g = glog[tok * 4 + h];
#pragma unroll
            for (int o = 1; o < 64; o <<= 1) { const float v = shidx(g, (lane - o) & 63); if (lane >= o) g += v; }
            Gc[tid] = g; }
        __syncthreads();
        {   const int sel = c.wave >> 2, ti = c.wave & 3; const LAS float* rs = sel == 0 ? ks : qs; LAS float* dstm = sel == 0 ? Am : Pm;
            bf16x8 af[4];
#pragma unroll
            for (int s = 0; s < 4; ++s) { const LAS float* p = rs + (ti * 16 + row) * DN_LDW + 32 * s + 8 * quad; af[s] = pack8(*(const LAS f32x4*)p, *(const LAS f32x4*)(p + 4)); }
            for (int tj = 0; tj < 4; ++tj) {
                f32x4 acc = {0.f, 0.f, 0.f, 0.f};
                if (tj <= ti) {
#pragma unroll
                    for (int s = 0; s < 4; ++s) { const LAS float* p = ks + (tj * 16 + row) * DN_LDW + 32 * s + 8 * quad; const bf16x8 bfr = pack8(*(const LAS f32x4*)p, *(const LAS f32x4*)(p + 4)); acc = MFMA16(af[s], bfr, acc); }
                }
                const int j = tj * 16 + row; const float Gj = Gc[j];
#pragma unroll
                for (int r = 0; r < 4; ++r) { const int i = ti * 16 + 4 * quad + r; const float dec = __expf(fminf(Gc[i] - Gj, 0.f));
                    float v = acc[r] * dec; if (sel == 0) v = (j < i) ? v * bt[i] : 0.f; else v = (j <= i) ? v : 0.f;
                    if (sel == 0) dstm[j * DN_LDA + i] = v; else dstm[i * DN_LDA + j] = v; }
            }
        }
        __syncthreads();
        const float Glast = Gc[63];
        {
            for (int q = 0; q < 5; ++q) { const int p = tid + 512 * q, blk = p >> 6; float v[8];
                if (blk < 16) { const int mt = blk >> 2, s = blk & 3, cr = 16 * mt + row, k0 = 32 * s + 4 * quad; const float e = __expf(Gc[cr]);
                    const f32x4 v0 = *(const LAS f32x4*)(qs + cr * DN_LDW + k0), v1 = *(const LAS f32x4*)(qs + cr * DN_LDW + k0 + 16);
                    v[0] = v0.x * e; v[1] = v0.y * e; v[2] = v0.z * e; v[3] = v0.w * e; v[4] = v1.x * e; v[5] = v1.y * e; v[6] = v1.z * e; v[7] = v1.w * e; }
                else if (blk < 32) { const int b2 = blk - 16, mt = b2 >> 1, s = b2 & 1, k = 16 * mt + row;
#pragma unroll
                    for (int j = 0; j < 8; ++j) { const int cj = 32 * s + 16 * (j >> 2) + 4 * quad + (j & 3); v[j] = ks[cj * DN_LDW + k] * __expf(Glast - Gc[cj]); } }
                else { const int b3 = blk - 32, mt = b3 >> 1, s = b3 & 1, i = 16 * mt + row, c0 = 32 * s + 4 * quad;
                    const f32x4 v0 = *(const LAS f32x4*)(Pm + i * DN_LDA + c0), v1 = *(const LAS f32x4*)(Pm + i * DN_LDA + c0 + 16);
                    v[0] = v0.x; v[1] = v0.y; v[2] = v0.z; v[3] = v0.w; v[4] = v1.x; v[5] = v1.y; v[6] = v1.z; v[7] = v1.w; }
                v4u w; w.x = cvtpk(v[0], v[1]); w.y = cvtpk(v[2], v[3]); w.z = cvtpk(v[4], v[5]); w.w = cvtpk(v[6], v[7]);
                *(v4u*)(img + 16384 + (size_t)p * 16) = w; }
            if (tid == 0) ((float*)(a->ws + WS_GL))[item] = __expf(Glast);
        }
        __syncthreads();
        if (tid < 256) {
            int vz = 0; asm volatile("" : "+v"(vz));
            const LAS float* AT = Am + vz; const LAS float* btV = bt + vz; const LAS float* GcV = Gc + vz;
            const bool isw = tid >= 128; LAS float* xc = (isw ? ks : vs) + (tid & 127);
#pragma unroll
            for (int bI = 0; bI < 4; ++bI) {
                float s[16];
#pragma unroll
                for (int r = 0; r < 16; ++r) { const int i = 16 * bI + r; float rhs = xc[i * DN_LDW] * btV[i]; if (isw) rhs *= __expf(GcV[i]); s[r] = rhs; }
                for (int j = 0; j < 16 * bI; ++j) { const float xj = xc[j * DN_LDW]; const LAS float* ap = AT + j * DN_LDA + 16 * bI;
#pragma unroll
                    for (int q = 0; q < 4; ++q) { const f32x4 a4 = *(const LAS f32x4*)(ap + 4 * q); s[4 * q] -= a4.x * xj; s[4 * q + 1] -= a4.y * xj; s[4 * q + 2] -= a4.z * xj; s[4 * q + 3] -= a4.w * xj; } }
#pragma unroll
                for (int rp = 0; rp < 15; ++rp) { const LAS float* ap = AT + (16 * bI + rp) * DN_LDA + 16 * bI;
#pragma unroll
                    for (int q = (rp + 1) / 4; q < 4; ++q) { const f32x4 a4 = *(const LAS f32x4*)(ap + 4 * q);
                        if (4 * q + 0 > rp) s[4 * q + 0] -= a4.x * s[rp]; if (4 * q + 1 > rp) s[4 * q + 1] -= a4.y * s[rp]; if (4 * q + 2 > rp) s[4 * q + 2] -= a4.z * s[rp]; if (4 * q + 3 > rp) s[4 * q + 3] -= a4.w * s[rp]; } }
#pragma unroll
                for (int r = 0; r < 16; ++r) xc[(16 * bI + r) * DN_LDW] = s[r];
            }
        }
        __syncthreads();
#pragma unroll
        for (int q = 0; q < 2; ++q) { const int p = tid + 512 * q, blk = p >> 6, mt = blk >> 2, s = blk & 3, cr = 16 * mt + row, k0 = 32 * s + 4 * quad;
            const f32x4 v0 = *(const LAS f32x4*)(ks + cr * DN_LDW + k0), v1 = *(const LAS f32x4*)(ks + cr * DN_LDW + k0 + 16);
            v4u w; w.x = cvtpk(-v0.x, -v0.y); w.y = cvtpk(-v0.z, -v0.w); w.z = cvtpk(-v1.x, -v1.y); w.w = cvtpk(-v1.z, -v1.w);
            *(v4u*)(img + (size_t)p * 16) = w; }
        {   unsigned char* ug = a->ws + WS_U + (size_t)item * 16384;
#pragma unroll
            for (int q = 0; q < 2; ++q) { const int p = tid + 512 * q, sl = p >> 7, ln = (p >> 1) & 63, hh = p & 1, v = 16 * sl + (ln & 15), qd = ln >> 4; float u8[8];
#pragma unroll
                for (int e = 0; e < 8; ++e) u8[e] = vs[(16 * (2 * hh + (e >> 2)) + 4 * qd + (e & 3)) * DN_LDW + v];
                v4u w; w.x = cvtpk(u8[0], u8[1]); w.y = cvtpk(u8[2], u8[3]); w.z = cvtpk(u8[4], u8[5]); w.w = cvtpk(u8[6], u8[7]);
                *(v4u*)(ug + (size_t)(sl * 64 + ln) * 32 + hh * 16) = w; } }
    }
}

__device__ __forceinline__ void ph_dn_scan(KArgs a, const Ctx& c, int l) {
    LAS unsigned char* lds = c.lds; LAS unsigned short* os = (LAS unsigned short*)(lds + 2 * DN_IMG);
    const int lane = c.lane, wv = c.wave, tid = c.tid;
    const bf16* ZB = (const bf16*)(a->ws + WS_ZB); bf16* YB = (bf16*)(a->ws + WS_YB); const float* onw = a->in[I_ONW] + l * 128; const float* glp = (const float*)(a->ws + WS_GL);
    for (int item = c.bid; item < NB * HB; item += c.G) {
        const int b = item >> 2, h = item & 3;
        const unsigned char* img0 = a->ws + WS_IMG + (size_t)item * 64 * DN_IMG; const unsigned char* ug0 = a->ws + WS_U + (size_t)item * 64 * 16384 + (size_t)(wv * 64 + lane) * 32;
        f32x4 S[8];
#pragma unroll
        for (int m = 0; m < 8; ++m) S[m] = (f32x4){0.f, 0.f, 0.f, 0.f};
        __syncthreads();
#define DN_DMA(n, buf) do { _Pragma("unroll") for (int q_ = 0; q_ < 7; ++q_) { const int pc_ = wv + 8 * q_; \
            __builtin_amdgcn_global_load_lds((const unsigned*)(img0 + (size_t)(n) * DN_IMG + pc_ * 1024 + lane * 16), (LAS unsigned*)(lds + (buf) * DN_IMG + pc_ * 1024), 16, 0, 0); } } while (0)
        DN_DMA(0, 0);
        v4u ucur0 = *(const v4u*)ug0, ucur1 = *(const v4u*)(ug0 + 16);
        for (int n = 0; n < NCH; ++n) {
            asm volatile("s_waitcnt vmcnt(0)" ::: "memory"); __syncthreads();
            v4u un0 = ucur0, un1 = ucur1;
            if (n + 1 < NCH) { DN_DMA(n + 1, (n + 1) & 1); un0 = *(const v4u*)(ug0 + (size_t)(n + 1) * 16384); un1 = *(const v4u*)(ug0 + (size_t)(n + 1) * 16384 + 16); }
            const LAS unsigned char* im = lds + (n & 1) * DN_IMG + lane * 16;
            const float gl = glp[item * 64 + n];
            bf16x8 Sb[4];
#pragma unroll
            for (int s = 0; s < 4; ++s) Sb[s] = pack8(S[2 * s], S[2 * s + 1]);
            f32x4 X[4], O[4];
            X[0] = (f32x4){bflo(ucur0.x), bfhi(ucur0.x), bflo(ucur0.y), bfhi(ucur0.y)}; X[1] = (f32x4){bflo(ucur0.z), bfhi(ucur0.z), bflo(ucur0.w), bfhi(ucur0.w)};
            X[2] = (f32x4){bflo(ucur1.x), bfhi(ucur1.x), bflo(ucur1.y), bfhi(ucur1.y)}; X[3] = (f32x4){bflo(ucur1.z), bfhi(ucur1.z), bflo(ucur1.w), bfhi(ucur1.w)};
#pragma unroll
            for (int mt = 0; mt < 4; ++mt) {
                O[mt] = (f32x4){0.f, 0.f, 0.f, 0.f};
#pragma unroll
                for (int s = 0; s < 4; ++s) { X[mt] = MFMA16(*(const LAS bf16x8*)(im + (mt * 4 + s) * 1024), Sb[s], X[mt]); O[mt] = MFMA16(*(const LAS bf16x8*)(im + 16384 + (mt * 4 + s) * 1024), Sb[s], O[mt]); } }
            bf16x8 Xb[2];
            Xb[0] = pack8(X[0], X[1]); Xb[1] = pack8(X[2], X[3]);
#pragma unroll
            for (int mt = 0; mt < 4; ++mt)
#pragma unroll
                for (int s = 0; s < 2; ++s) O[mt] = MFMA16(*(const LAS bf16x8*)(im + 49152 + (mt * 2 + s) * 1024), Xb[s], O[mt]);
#pragma unroll
            for (int m = 0; m < 8; ++m) { S[m] = S[m] * gl;
#pragma unroll
                for (int s = 0; s < 2; ++s) S[m] = MFMA16(*(const LAS bf16x8*)(im + 32768 + (m * 2 + s) * 1024), Xb[s], S[m]); }
#pragma unroll
            for (int mt = 0; mt < 4; ++mt)
#pragma unroll
                for (int r = 0; r < 4; ++r) os[(16 * mt + 4 * (lane >> 4) + r) * 128 + 16 * wv + (lane & 15)] = (unsigned short)(cvtpk(O[mt][r], 0.f) & 0xffffu);
            __syncthreads();
            {
                const int r = tid >> 3, sub = tid & 7, tok = b * SEQ + n * DNC + r; float o[16]; float ss = 0.f;
                const v4u o0 = *(const LAS v4u*)(os + r * 128 + sub * 16), o1 = *(const LAS v4u*)(os + r * 128 + sub * 16 + 8);
                o[0] = bflo(o0.x); o[1] = bfhi(o0.x); o[2] = bflo(o0.y); o[3] = bfhi(o0.y); o[4] = bflo(o0.z); o[5] = bfhi(o0.z); o[6] = bflo(o0.w); o[7] = bfhi(o0.w);
                o[8] = bflo(o1.x); o[9] = bfhi(o1.x); o[10] = bflo(o1.y); o[11] = bfhi(o1.y); o[12] = bflo(o1.z); o[13] = bfhi(o1.z); o[14] = bflo(o1.w); o[15] = bfhi(o1.w);
#pragma unroll
                for (int e = 0; e < 16; ++e) ss += o[e] * o[e];
                ss += shx(ss, 1, lane); ss += shx(ss, 2, lane); ss += shx(ss, 4, lane);
                const float rstd = 1.f / sqrtf(ss * (1.f / 128.f) + EPS);
                const bf16* zp = ZB + (size_t)tok * 512 + h * 128 + sub * 16; bf16* yp = YB + (size_t)tok * 512 + h * 128 + sub * 16;
#pragma unroll
                for (int q = 0; q < 2; ++q) { const v4u z = *(const v4u*)(zp + q * 8); const f32x4 w0 = *(const f32x4*)(onw + sub * 16 + q * 8), w1 = *(const f32x4*)(onw + sub * 16 + q * 8 + 4);
                    v4u y; y.x = cvtpk(o[q * 8 + 0] * rstd * w0.x * siluf_(bflo(z.x)), o[q * 8 + 1] * rstd * w0.y * siluf_(bfhi(z.x)));
                    y.y = cvtpk(o[q * 8 + 2] * rstd * w0.z * siluf_(bflo(z.y)), o[q * 8 + 3] * rstd * w0.w * siluf_(bfhi(z.y)));
                    y.z = cvtpk(o[q * 8 + 4] * rstd * w1.x * siluf_(bflo(z.z)), o[q * 8 + 5] * rstd * w1.y * siluf_(bfhi(z.z)));
                    y.w = cvtpk(o[q * 8 + 6] * rstd * w1.z * siluf_(bflo(z.w)), o[q * 8 + 7] * rstd * w1.w * siluf_(bfhi(z.w)));
                    *(v4u*)(yp + q * 8) = y; }
            }
            ucur0 = un0; ucur1 = un1;
        }
        asm volatile("s_waitcnt vmcnt(0)" ::: "memory"); __syncthreads();
#undef DN_DMA
    }
}
typedef short v4i16_t __attribute__((ext_vector_type(4)));
#define MFMA32(a, b, c) __builtin_amdgcn_mfma_f32_32x32x16_bf16((a), (b), (c), 0, 0, 0)
constexpr int AT_ROWB = 144;
constexpr int AT_K = 0, AT_V = 2 * 64 * AT_ROWB, AT_OST = 4 * 64 * AT_ROWB, AT_BT = AT_OST + 8 * 32 * AT_ROWB, AT_KM = AT_BT + 1024, AT_UW = AT_KM + 4096;
__device__ __forceinline__ int crow(int r, int hi) { return (r & 3) + 8 * (r >> 2) + 4 * hi; }
__device__ __forceinline__ bf16x8 vtr2(const LAS unsigned char* p) {
    const v4i16_t lo = __builtin_amdgcn_ds_read_tr16_b64_v4i16((LAS v4i16_t*)p), hi = __builtin_amdgcn_ds_read_tr16_b64_v4i16((LAS v4i16_t*)(p + 8 * AT_ROWB));
    return (bf16x8){lo[0], lo[1], lo[2], lo[3], hi[0], hi[1], hi[2], hi[3]};
}
__device__ __forceinline__ void ph_attn(KArgs a, const Ctx& c, int l) {
    LAS unsigned char* lds = c.lds; const int lane = c.lane, wv = c.wave, tid = c.tid, r32 = lane & 31, hi = lane >> 5;
    LAS float* btab = (LAS float*)(lds + AT_BT); LAS float* kms = (LAS float*)(lds + AT_KM); volatile LAS int* uw = (volatile LAS int*)(lds + AT_UW);
    const bf16* QKVA = (const bf16*)(a->ws + WS_QKVA); const float* kmean = (const float*)(a->ws + WS_KMEAN); bf16* YA = (bf16*)(a->ws + WS_YA); const float* relb = a->in[I_RELB];
    unsigned* ctr = (unsigned*)(a->ws + WS_CTL) + CW_ACTR + l * 64;
    const float LOG2E = 1.4426950408889634f, C2 = 0.125f * LOG2E, NINF = -__builtin_inff();
    const int srow = tid >> 3, sch = tid & 7; const unsigned sdst = srow * AT_ROWB + sch * 16;
    for (;;) {
        __syncthreads();
        if (tid == 0) uw[0] = (int)__hip_atomic_fetch_add(ctr, 1u, RLX_AGENT);
        __syncthreads();
        const int u = uw[0]; if (u >= NB * HA * NBLK) break;
        const int qb = 15 - (u >> 5), bh = u & 31, b = bh >> 3, h = bh & 7;
        const float c31 = relb[31 * 8 + h];
        for (int i = tid; i < 129; i += NTHR) btab[i] = (i < 128 ? (relb[(int)T5B[i] * 8 + h] - c31) : 0.f) * LOG2E;
        for (int i = tid; i < 1024; i += NTHR) kms[i] = kmean[(size_t)bh * 1024 + i];
        const int qrel = wv * 32 + r32, tokq = b * SEQ + qb * 256 + qrel;
        const bf16* kbase = QKVA + (size_t)(b * SEQ) * 1536 + 512 + h * 64 + sch * 8;
        {   const int key0 = qb * 256; const v4u kr = *(const v4u*)(kbase + (size_t)(key0 + srow) * 1536), vr = *(const v4u*)(kbase + (size_t)(key0 + srow) * 1536 + 512);
            *(LAS v4u*)(lds + AT_K + sdst) = kr; *(LAS v4u*)(lds + AT_V + sdst) = vr; }
        float qf[32];
        {   const bf16* qp = QKVA + (size_t)tokq * 1536 + h * 64 + 8 * hi;
#pragma unroll
            for (int s = 0; s < 4; ++s) { const v4u w = *(const v4u*)(qp + 16 * s); qf[s * 8 + 0] = bflo(w.x); qf[s * 8 + 1] = bfhi(w.x); qf[s * 8 + 2] = bflo(w.y); qf[s * 8 + 3] = bfhi(w.y); qf[s * 8 + 4] = bflo(w.z); qf[s * 8 + 5] = bfhi(w.z); qf[s * 8 + 6] = bflo(w.w); qf[s * 8 + 7] = bfhi(w.w); } }
        __syncthreads();
        unsigned selmask = 0u;
        {   float g[16];
#pragma unroll
            for (int n = 0; n < 16; ++n) { g[n] = -3e38f;
                if (n < qb) { float d = 0.f;
#pragma unroll
                    for (int s = 0; s < 4; ++s) { const f32x4 k0 = *(const LAS f32x4*)(kms + n * 64 + 16 * s + 8 * hi), k1 = *(const LAS f32x4*)(kms + n * 64 + 16 * s + 8 * hi + 4);
                        d += qf[s * 8] * k0.x + qf[s * 8 + 1] * k0.y + qf[s * 8 + 2] * k0.z + qf[s * 8 + 3] * k0.w + qf[s * 8 + 4] * k1.x + qf[s * 8 + 5] * k1.y + qf[s * 8 + 6] * k1.z + qf[s * 8 + 7] * k1.w; }
                    g[n] = d + shx(d, 32, lane); } }
#pragma unroll
            for (int t = 0; t < 3; ++t) { float best = -3.4e38f; int bi = 0;
#pragma unroll
                for (int n = 0; n < 16; ++n) { const bool ok = !((selmask >> n) & 1u) && g[n] > best; best = ok ? g[n] : best; bi = ok ? n : bi; }
                selmask |= 1u << bi; }
            selmask &= (1u << qb) - 1u; }
        bf16x8 qs[4];
#pragma unroll
        for (int s = 0; s < 4; ++s) { v4u w; w.x = cvtpk(qf[s * 8] * C2, qf[s * 8 + 1] * C2); w.y = cvtpk(qf[s * 8 + 2] * C2, qf[s * 8 + 3] * C2); w.z = cvtpk(qf[s * 8 + 4] * C2, qf[s * 8 + 5] * C2); w.w = cvtpk(qf[s * 8 + 6] * C2, qf[s * 8 + 7] * C2); qs[s] = __builtin_bit_cast(bf16x8, w); }
        float m = NINF, lsum = 0.f; f32x16 o0, o1;
#pragma unroll
        for (int r = 0; r < 16; ++r) { o0[r] = 0.f; o1[r] = 0.f; }
        const int NT = 4 * (qb + 1);
        for (int t = 0; t < NT; ++t) {
            const int blk = t < 4 ? qb : ((t - 4) >> 2), kt = t < 4 ? t : ((t - 4) & 3);
            v4u kr = {0u, 0u, 0u, 0u}, vr = {0u, 0u, 0u, 0u};
            if (t + 1 < NT) { const int t1 = t + 1, blk1 = t1 < 4 ? qb : ((t1 - 4) >> 2), kt1 = t1 < 4 ? t1 : ((t1 - 4) & 3); const size_t ro = (size_t)(blk1 * 256 + kt1 * 64 + srow) * 1536;
                kr = *(const v4u*)(kbase + ro); vr = *(const v4u*)(kbase + ro + 512); }
            const bool own = t < 4;
            const bool lane_act = own || ((selmask >> blk) & 1u);
            const bool wave_act = own ? (kt * 64 <= wv * 32 + 31) : (__builtin_amdgcn_ballot_w64(lane_act) != 0ull);
            if (wave_act) {
                const LAS unsigned char* Kb = lds + AT_K + (t & 1) * 64 * AT_ROWB; const LAS unsigned char* Vb = lds + AT_V + (t & 1) * 64 * AT_ROWB;
                f32x16 p0, p1;
#pragma unroll
                for (int r = 0; r < 16; ++r) { p0[r] = 0.f; p1[r] = 0.f; }
#pragma unroll
                for (int s = 0; s < 4; ++s) { const bf16x8 a0 = *(const LAS bf16x8*)(Kb + r32 * AT_ROWB + 32 * s + 16 * hi), a1 = *(const LAS bf16x8*)(Kb + (32 + r32) * AT_ROWB + 32 * s + 16 * hi);
                    p0 = MFMA32(a0, qs[s], p0); p1 = MFMA32(a1, qs[s], p1); }
                if (own) {
#pragma unroll
                    for (int r = 0; r < 16; ++r) { const int d0 = qrel - (kt * 64 + crow(r, hi)), d1 = d0 - 32;
                        p0[r] = d0 >= 0 ? p0[r] + btab[d0 > 128 ? 128 : d0] : NINF; p1[r] = d1 >= 0 ? p1[r] + btab[d1 > 128 ? 128 : d1] : NINF; }
                } else if (blk == qb - 1 && kt >= 1) {
#pragma unroll
                    for (int r = 0; r < 16; ++r) { const int d0 = qrel + 256 - (kt * 64 + crow(r, hi)), d1 = d0 - 32;
                        p0[r] += btab[d0 > 128 ? 128 : d0]; p1[r] += btab[d1 > 128 ? 128 : d1]; }
                }
                float mx = fmaxf(p0[0], p1[0]);
#pragma unroll
                for (int r = 1; r < 16; ++r) mx = fmaxf(mx, fmaxf(p0[r], p1[r]));
                mx = fmaxf(mx, shx(mx, 32, lane));
                const float tmax = lane_act ? mx : NINF, mnew = fmaxf(m, tmax), alpha = __builtin_amdgcn_exp2f(m - mnew), muse = lane_act ? mnew : __builtin_inff();
                float rs = 0.f;
#pragma unroll
                for (int r = 0; r < 16; ++r) { p0[r] = __builtin_amdgcn_exp2f(p0[r] - muse); p1[r] = __builtin_amdgcn_exp2f(p1[r] - muse); rs += p0[r] + p1[r]; }
                lsum = lsum * alpha + rs; m = mnew;
                if (__builtin_amdgcn_ballot_w64(alpha != 1.f) != 0ull) {
#pragma unroll
                    for (int r = 0; r < 16; ++r) { o0[r] *= alpha; o1[r] *= alpha; } }
                bf16x8 pa[4];
                { v4u w; w.x = cvtpk(p0[0], p0[1]); w.y = cvtpk(p0[2], p0[3]); w.z = cvtpk(p0[4], p0[5]); w.w = cvtpk(p0[6], p0[7]); pa[0] = __builtin_bit_cast(bf16x8, w);
                  w.x = cvtpk(p0[8], p0[9]); w.y = cvtpk(p0[10], p0[11]); w.z = cvtpk(p0[12], p0[13]); w.w = cvtpk(p0[14], p0[15]); pa[1] = __builtin_bit_cast(bf16x8, w);
                  w.x = cvtpk(p1[0], p1[1]); w.y = cvtpk(p1[2], p1[3]); w.z = cvtpk(p1[4], p1[5]); w.w = cvtpk(p1[6], p1[7]); pa[2] = __builtin_bit_cast(bf16x8, w);
                  w.x = cvtpk(p1[8], p1[9]); w.y = cvtpk(p1[10], p1[11]); w.z = cvtpk(p1[12], p1[13]); w.w = cvtpk(p1[14], p1[15]); pa[3] = __builtin_bit_cast(bf16x8, w); }
                const LAS unsigned char* vp = Vb + (4 * hi + ((lane & 15) >> 2)) * AT_ROWB + 2 * (16 * ((lane >> 4) & 1) + 4 * (lane & 3));
#pragma unroll
                for (int ks = 0; ks < 4; ++ks) { const bf16x8 v0 = vtr2(vp + 16 * ks * AT_ROWB), v1 = vtr2(vp + 16 * ks * AT_ROWB + 64);
                    o0 = MFMA32(v0, pa[ks], o0); o1 = MFMA32(v1, pa[ks], o1); }
            }
            if (t + 1 < NT) { *(LAS v4u*)(lds + AT_K + ((t + 1) & 1) * 64 * AT_ROWB + sdst) = kr; *(LAS v4u*)(lds + AT_V + ((t + 1) & 1) * 64 * AT_ROWB + sdst) = vr; }
            __syncthreads();
        }
        lsum += shx(lsum, 32, lane);
        const float inv = 1.f / lsum;
        LAS unsigned short* stg = (LAS unsigned short*)(lds + AT_OST + wv * 32 * AT_ROWB);
#pragma unroll
        for (int r = 0; r < 16; ++r) { stg[r32 * (AT_ROWB / 2) + crow(r, hi)] = (unsigned short)(cvtpk(o0[r] * inv, 0.f) & 0xffffu); stg[r32 * (AT_ROWB / 2) + 32 + crow(r, hi)] = (unsigned short)(cvtpk(o1[r] * inv, 0.f) & 0xffffu); }
        LDS_WAIT();
#pragma unroll
        for (int i = 0; i < 4; ++i) { const int row = i * 8 + (lane >> 3), ch = lane & 7; const v4u v = *(const LAS v4u*)((const LAS unsigned char*)stg + row * AT_ROWB + ch * 16);
            *(v4u*)(YA + (size_t)(b * SEQ + qb * 256 + wv * 32 + row) * 512 + h * 64 + ch * 8) = v; }
    }
}
constexpr int NPH_LAYER = 11, NPHASES = 2 + NLAYER * NPH_LAYER;
#ifndef DN_IMPL
#define DN_IMPL 1
#endif
#ifndef PH_MASK
#define PH_MASK 0xFFFF
#endif
#define PH_EN(k) ((PH_MASK >> (k)) & 1)
#define GEMM_PHASE(EPI, SCHED, g, S, E) pg8::gemm_phase<EPI, SCHED, true, true>(c.lds, g, S, E, c.tid)

#define PHASE_FN static __device__ __forceinline__ void
__device__ __forceinline__ KArgs launder_k(KArgs a) { unsigned long long v = (unsigned long long)a; asm volatile("" : "+s"(v)); return (KArgs)v; }
PHASE_FN f_mod(KArgs a, int& tid) { a = launder_k(a); Ctx c = make_ctx(tid); ph_mod(a, c); }
PHASE_FN f_norm1(KArgs a, int& tid, int l) { a = launder_k(a); Ctx c = make_ctx(tid); ph_norm1(a, c, l); __syncthreads(); ph_convert(a, c, l); }
PHASE_FN f_proj(KArgs a, int& tid) { a = launder_k(a); Ctx c = make_ctx(tid);
    pg8::Gemm g{(const bf16*)(a->ws + WS_H), (const bf16*)(a->ws + WS_WIN), NTOK, DINP, DM}; pg8::StaticOrder S; S.init(NTOK, DINP, c.G, c.bid);
    EpiProj E{a->ws}; GEMM_PHASE(EpiProj, pg8::StaticOrder, g, S, E); }
PHASE_FN f_kmean(KArgs a, int& tid) { a = launder_k(a); Ctx c = make_ctx(tid); ph_kmean(a, c); }
#ifndef ATTN_IMPL
#define ATTN_IMPL 1
#endif
#if ATTN_IMPL
PHASE_FN f_attn(KArgs a, int& tid, int l) { a = launder_k(a); Ctx c = make_ctx(tid); ph_attn(a, c, l); }
#else
PHASE_FN f_attn(KArgs a, int& tid, int l) { a = launder_k(a); Ctx c = make_ctx(tid); ph_attn_simple(a, c); }
#endif
PHASE_FN f_dn(KArgs a, int& tid, int l) { a = launder_k(a); Ctx c = make_ctx(tid); ph_dn_simple(a, c, l); }
PHASE_FN f_dn_prep(KArgs a, int& tid, int l) { a = launder_k(a); Ctx c = make_ctx(tid); ph_dn_prep(a, c, l); }
PHASE_FN f_dn_scan(KArgs a, int& tid, int l) { a = launder_k(a); Ctx c = make_ctx(tid); ph_dn_scan(a, c, l); }
PHASE_FN f_merge1(KArgs a, int& tid) { a = launder_k(a); Ctx c = make_ctx(tid);
    pg8::Gemm g{(const bf16*)(a->ws + WS_YA), (const bf16*)(a->ws + WS_WUPA), NTOK, DM, WA}; pg8::StaticOrder S; S.init(NTOK, DM, c.G, c.bid);
    EpiMerge<false> E{a->ws}; GEMM_PHASE(EpiMerge<false>, pg8::StaticOrder, g, S, E); }
PHASE_FN f_merge2(KArgs a, int& tid) { a = launder_k(a); Ctx c = make_ctx(tid);
    pg8::Gemm g{(const bf16*)(a->ws + WS_YB), (const bf16*)(a->ws + WS_WUPB), NTOK, DM, WB}; pg8::StaticOrder S; S.init(NTOK, DM, c.G, c.bid);
    EpiMerge<true> E{a->ws}; GEMM_PHASE(EpiMerge<true>, pg8::StaticOrder, g, S, E); }
PHASE_FN f_out(KArgs a, int& tid, int l) { a = launder_k(a); Ctx c = make_ctx(tid);
    pg8::Gemm g{(const bf16*)(a->ws + WS_M), (const bf16*)(a->ws + WS_WOUT), NTOK, DM, DM}; pg8::StaticOrder S; S.init(NTOK, DM, c.G, c.bid);
    EpiOut E{l == 0 ? a->in[I_X] : (const float*)a->out, a->out, (const float*)(a->ws + WS_MOD) + l * 4 * 6144 + 2048}; GEMM_PHASE(EpiOut, pg8::StaticOrder, g, S, E); }
PHASE_FN f_router(KArgs a, int& tid, int l) { a = launder_k(a); Ctx c = make_ctx(tid); ph_router(a, c, l); }
PHASE_FN f_gather(KArgs a, int& tid, int l) { a = launder_k(a); Ctx c = make_ctx(tid); ph_gather(a, c, l); }
PHASE_FN f_moe_gu(KArgs a, int& tid, int l) { a = launder_k(a); Ctx c = make_ctx(tid);
    moe_table(a, c, l); const LAS int* te = (const LAS int*)(c.lds + MISC_OFF + 2048);
    pg8::Gemm g{(const bf16*)(a->ws + WS_HS), (const bf16*)(a->ws + WS_WEGU), MOE_MAXROWS, NEXP * 512, DM}; MoeOrder S{te, te[192 + 32] * 2, c.G, c.bid, 1};
    EpiMoeGU E{a->ws}; GEMM_PHASE(EpiMoeGU, MoeOrder, g, S, E); }
PHASE_FN f_moe_down(KArgs a, int& tid, int l) { a = launder_k(a); Ctx c = make_ctx(tid);
    moe_table(a, c, l); const LAS int* te = (const LAS int*)(c.lds + MISC_OFF + 2048);
    pg8::Gemm g{(const bf16*)(a->ws + WS_ACT), (const bf16*)(a->ws + WS_WED), MOE_MAXROWS, NEXP * 1024, DFF}; MoeOrder S{te, te[192 + 32] * 4, c.G, c.bid, 2};
    EpiMoeDown E{a->ws}; GEMM_PHASE(EpiMoeDown, MoeOrder, g, S, E); }
PHASE_FN f_final(KArgs a, int& tid) { a = launder_k(a); Ctx c = make_ctx(tid); ph_final(a, c); }

#define KA() launder_k((KArgs)__builtin_amdgcn_kernarg_segment_ptr())
__device__ __forceinline__ bool ph_in(int k) { KArgs a = KA(); return a->ph_lo <= k && k < a->ph_hi; }
__device__ __forceinline__ void grid_bar(int& tid) {
    asm volatile("" : "+v"(tid));
#if MK_ONE_LAUNCH
    KArgs a = KA(); XcdBarrier b; b.bar = (unsigned*)(a->ws + WS_CTL) + CW_BAR; b.x = xb_xcc_id(); b.st = (volatile LAS unsigned*)((LAS unsigned char*)lds_raw + MISC_OFF) + 8;
    xcd_barrier(b, tid);
#else
    __syncthreads();
#endif
}
__global__ void __launch_bounds__(NTHR, 2) mk_fwd(Args a_) {
    int tid = threadIdx.x;
    {   volatile LAS unsigned* MISC = (volatile LAS unsigned*)((LAS unsigned char*)lds_raw + MISC_OFF);
        if (tid < 64) MISC[tid] = 0u;
        __syncthreads();
#if MK_ONE_LAUNCH
        (void)xcd_barrier_post((unsigned*)(KA()->ws + WS_CTL) + CW_BAR, MISC + 8, tid);
#endif
    }
#define IN(k) ph_in(k)
#define SEAM(k) do { if (IN(k) && IN((k) + 1)) grid_bar(tid); } while (0)
    if (IN(0)) f_mod(KA(), tid); SEAM(0);
    for (int l = 0; l < NLAYER; ++l) {
        const int pb = 1 + l * NPH_LAYER;
        if (PH_EN(0) && IN(pb + 0)) f_norm1(KA(), tid, l); SEAM(pb + 0);
        if (PH_EN(1) && IN(pb + 1)) f_proj(KA(), tid); SEAM(pb + 1);
#if DN_IMPL
        if (PH_EN(2) && IN(pb + 2)) { f_kmean(KA(), tid); f_dn_prep(KA(), tid, l); } SEAM(pb + 2);
        if (PH_EN(3) && IN(pb + 3)) { f_dn_scan(KA(), tid, l); __syncthreads(); f_attn(KA(), tid, l); } SEAM(pb + 3);
#else
        if (PH_EN(2) && IN(pb + 2)) f_kmean(KA(), tid); SEAM(pb + 2);
        if (PH_EN(3) && IN(pb + 3)) { f_attn(KA(), tid, l); __syncthreads(); f_dn(KA(), tid, l); } SEAM(pb + 3);
#endif
        if (PH_EN(4) && IN(pb + 4)) f_merge1(KA(), tid); SEAM(pb + 4);
        if (PH_EN(5) && IN(pb + 5)) f_merge2(KA(), tid); SEAM(pb + 5);
        if (PH_EN(6) && IN(pb + 6)) f_out(KA(), tid, l); SEAM(pb + 6);
        if (PH_EN(7) && IN(pb + 7)) f_router(KA(), tid, l); SEAM(pb + 7);
        if (PH_EN(8) && IN(pb + 8)) f_gather(KA(), tid, l); SEAM(pb + 8);
        if (PH_EN(9) && IN(pb + 9)) f_moe_gu(KA(), tid, l); SEAM(pb + 9);
        if (PH_EN(10) && IN(pb + 10)) f_moe_down(KA(), tid, l); SEAM(pb + 10);
    }
    if (IN(NPHASES - 1)) f_final(KA(), tid);
#undef IN
#undef SEAM
}

extern "C" void kernel_launch(void* const* d_in, const int* in_sizes, int n_in, void* d_out, int out_size, void* d_ws, size_t ws_size, hipStream_t stream) {
    static int grid = 0;
    if (grid == 0) {
        if (n_in != 23 || out_size != NTOK * DM || ws_size < WS_END) { fprintf(stderr, "kernel_launch: unexpected shapes (n_in %d out %d ws %zu)\n", n_in, out_size, ws_size); grid = -1; return; }
        int dev = 0, cus = 0, per_cu = 0;
        if (hipGetDevice(&dev) != hipSuccess || hipDeviceGetAttribute(&cus, hipDeviceAttributeMultiprocessorCount, dev) != hipSuccess) { grid = -1; return; }
        if (hipFuncSetAttribute((const void*)mk_fwd, hipFuncAttributeMaxDynamicSharedMemorySize, LDS_BYTES) != hipSuccess) { fprintf(stderr, "kernel_launch: hipFuncSetAttribute failed\n"); grid = -1; return; }
        if (hipOccupancyMaxActiveBlocksPerMultiprocessor(&per_cu, (const void*)mk_fwd, NTHR, LDS_BYTES) != hipSuccess || per_cu < 1) { fprintf(stderr, "kernel_launch: occupancy query says %d\n", per_cu); (void)hipGetLastError(); grid = -1; return; }
        grid = cus;
    }
    if (grid < 0) return;
    (void)hipMemsetAsync((char*)d_ws + WS_CTL, 0, CTL_ZERO_BYTES, stream);
    Args a{};
    for (int i = 0; i < 23; ++i) a.in[i] = (const float*)d_in[i];
    a.out = (float*)d_out; a.ws = (unsigned char*)d_ws;
#if MK_ONE_LAUNCH
    a.ph_lo = 0; a.ph_hi = NPHASES;
    hipLaunchKernelGGL(mk_fwd, dim3(grid), dim3(NTHR), LDS_BYTES, stream, a);
#else
    for (int p = 0; p < NPHASES; ++p) { a.ph_lo = p; a.ph_hi = p + 1; hipLaunchKernelGGL(mk_fwd, dim3(grid), dim3(NTHR), LDS_BYTES, stream, a); }
#endif
}
```

```cpp
#include <hip/hip_runtime.h>
#include <cstdio>
#include <cstdint>
#ifndef MK_ONE_LAUNCH
#define MK_ONE_LAUNCH 1
#endif
#ifndef MK_PROBE_A
#define MK_PROBE_A -1
#endif
#ifndef MK_PROBE_B
#define MK_PROBE_B -1
#endif
namespace pg8 {
#define PG8_LAS __attribute__((address_space(3)))
typedef unsigned short bf16_t;
typedef short bf16x8 __attribute__((ext_vector_type(8)));
typedef float f32x4 __attribute__((ext_vector_type(4)));
typedef unsigned u32x4 __attribute__((ext_vector_type(4)));
constexpr int BM = 256, BK = 64, HALF = 128, HTB = HALF * BK * 2  , STAGE_BYTES = 8 * HTB, NXCD = 8, WGM = 8;

__host__ __device__ __forceinline__ int lds_byte(int r, int c) { const int st = (r >> 4) * 2 + (c >> 5), rr = r & 15, cc = c & 31, ob = rr * 64 + cc * 2; return st * 1024 + (ob ^ (((ob >> 9) & 1) << 5)); }
__host__ __device__ __forceinline__ void stage_rc(int b, int& R, int& C) { const int st = b / 1024, sb = b % 1024, swz = sb ^ (((sb >> 9) & 1) << 5); R = (st >> 1) * 16 + swz / 64; C = (st & 1) * 32 + (swz % 64) / 2; }
__host__ __device__ __forceinline__ int perm32(int rho) { const int n = rho >> 4, i = rho & 15; return 8 * (i >> 2) + 4 * n + (i & 3); }

struct Unit { int pm, pn; };
struct Gemm { const bf16_t* A; const bf16_t* Bt; int M, N, K; };

struct StaticOrder {
    int nM, nN, nwg, G, c;
    __host__ __device__ void init(int M, int N, int G_, int c_) { nM = M / BM; nN = N / BM; nwg = nM * nN; G = G_; c = c_; }
    __host__ __device__ bool next(int i, Unit& u) const {
        const long L = (long)i * G + c; if (L >= nwg) return false;
        int wgid = (int)L; { const int q = nwg / NXCD, r = nwg % NXCD, xcd = wgid % NXCD, off = wgid / NXCD; wgid = (xcd < r ? xcd * (q + 1) : r * (q + 1) + (xcd - r) * q) + off; }
        const int nig = WGM * nN, gid = wgid / nig, fm = gid * WGM, gsz = (nM - fm) < WGM ? (nM - fm) : WGM;
        u.pm = fm + ((wgid % nig) % gsz); u.pn = (wgid % nig) / gsz; return true;
    }
    __device__ __forceinline__ void a_ready(const Unit&) const {}
    __device__ __forceinline__ void done(const Unit&) const {}
};

__device__ __forceinline__ unsigned cvt_pk_bf16(float lo, float hi) { unsigned r; asm volatile("v_cvt_pk_bf16_f32 %0, %1, %2" : "=v"(r) : "v"(lo), "v"(hi)); return r; }
typedef float f32x2 __attribute__((ext_vector_type(2)));
template <class Epi, class Sched, bool ALIGN_EPI = false, bool SP2 = false>
__device__ __forceinline__ void gemm_phase(PG8_LAS unsigned char* lds, const Gemm g, const Sched& S, const Epi& E, const int tid_in) {
    const int tid = tid_in, wid = __builtin_amdgcn_readfirstlane(tid >> 6), lane = tid & 63, wr = wid >> 2, wc = wid & 3, fr = lane & 15, fq = lane >> 4;
    const int K = g.K, nt = K / BK;
    unsigned voffA[2], voffB[2];
#pragma unroll
    for (int i = 0; i < 2; ++i) { int R, C; stage_rc(tid * 16 + i * 8192, R, C); const int Rb = Epi::PERM ? ((R & ~31) + perm32(R & 31)) : R;
        voffA[i] = (unsigned)(R * K + C) * 2u; voffB[i] = (unsigned)(Rb * K + C) * 2u; }
    const size_t kstep = (size_t)(BK * 2);
    const size_t hstep = (size_t)HALF * K * 2;
    const size_t tstep = 2 * hstep;
    const unsigned ldsw = (unsigned)wid * 1024u;
    const int aoff = lds_byte(wr * 64 + fr, fq * 8), boff = lds_byte(wc * 32 + fr, fq * 8);
#define PG8_SA(b, h) (((b) * 2 + (h)) * HTB)
#define PG8_SB(b, h) ((4 + (b) * 2 + (h)) * HTB)
#define PG8_STAGE(bufoff, gbase, voff) do { _Pragma("unroll") for (int _i = 0; _i < 2; ++_i) \
        __builtin_amdgcn_global_load_lds((const unsigned*)((const char*)(gbase) + (voff)[_i]), (PG8_LAS unsigned*)(lds + (bufoff) + ldsw + _i * 8192), 16, 0, 0); } while (0)
#define PG8_LDA(dst, b, h) do { _Pragma("unroll") for (int m = 0; m < 4; ++m) _Pragma("unroll") for (int k = 0; k < 2; ++k) dst[m][k] = *(const PG8_LAS bf16x8*)(lds + PG8_SA(b, h) + aoff + m * 2048 + k * 1024); } while (0)
#define PG8_LDB(dst, b, h) do { _Pragma("unroll") for (int n = 0; n < 2; ++n) _Pragma("unroll") for (int k = 0; k < 2; ++k) dst[n][k] = *(const PG8_LAS bf16x8*)(lds + PG8_SB(b, h) + boff + n * 2048 + k * 1024); } while (0)
#define PG8_MMA(ai, bj, At, Bt) do { __builtin_amdgcn_s_setprio(1); _Pragma("unroll") for (int m = 0; m < 4; ++m) _Pragma("unroll") for (int n = 0; n < 2; ++n) _Pragma("unroll") for (int k = 0; k < 2; ++k) \
        acc[ai][bj][m][n] = __builtin_amdgcn_mfma_f32_16x16x32_bf16(Bt[n][k], At[m][k], acc[ai][bj][m][n], 0, 0, 0); __builtin_amdgcn_s_setprio(0); } while (0)
#define PG8_WAIT_V(n) asm volatile("s_waitcnt vmcnt(" #n ")" ::: "memory")
#define PG8_WAIT_L(n) asm volatile("s_waitcnt lgkmcnt(" #n ")" ::: "memory")
#define PG8_BAR __builtin_amdgcn_s_barrier()
#define PG8_SCHED __builtin_amdgcn_sched_barrier(0)
    Unit cur, nxt; int ui = 0;
    if (!S.next(0, cur)) return;
    f32x4 acc[2][2][4][2];
    float zf_ = 0.f; asm volatile("" : "+v"(zf_));
#pragma unroll
    for (int a = 0; a < 2; ++a)
#pragma unroll
        for (int b = 0; b < 2; ++b)
#pragma unroll
            for (int m = 0; m < 4; ++m)
#pragma unroll
                for (int n = 0; n < 2; ++n) acc[a][b][m][n] = (f32x4){zf_, zf_, zf_, zf_};
    bf16x8 At[4][2], B0[2][2], B1[2][2];
    const char* cA = (const char*)g.A + (size_t)cur.pm * tstep; const char* cB = (const char*)g.Bt + (size_t)cur.pn * tstep;
    S.a_ready(cur);
    if constexpr (SP2) {
        PG8_STAGE(PG8_SB(0, 0), cB, voffB); PG8_STAGE(PG8_SB(0, 1), cB + hstep, voffB); PG8_STAGE(PG8_SA(0, 0), cA, voffA); PG8_STAGE(PG8_SA(0, 1), cA + hstep, voffA);
        if (wr == 1) PG8_BAR;
        PG8_WAIT_V(2); PG8_BAR;
        PG8_STAGE(PG8_SB(1, 0), cB + kstep, voffB); PG8_STAGE(PG8_SA(1, 0), cA + kstep, voffA); PG8_STAGE(PG8_SB(1, 1), cB + hstep + kstep, voffB);
        PG8_WAIT_V(6); PG8_BAR;
    } else {
        PG8_STAGE(PG8_SB(0, 0), cB, voffB); PG8_STAGE(PG8_SA(0, 0), cA, voffA); PG8_STAGE(PG8_SB(0, 1), cB + hstep, voffB); PG8_STAGE(PG8_SA(0, 1), cA + hstep, voffA);
        if (wr == 1) PG8_BAR;
        PG8_WAIT_V(4); PG8_BAR;
        PG8_STAGE(PG8_SB(1, 0), cB + kstep, voffB); PG8_STAGE(PG8_SA(1, 0), cA + kstep, voffA); PG8_STAGE(PG8_SB(1, 1), cB + hstep + kstep, voffB);
        PG8_WAIT_V(6); PG8_BAR;
    }
    for (;;) {
        const bool has_next = S.next(ui + 1, nxt);
        const char* nA = has_next ? (const char*)g.A + (size_t)nxt.pm * tstep : cA; const char* nB = has_next ? (const char*)g.Bt + (size_t)nxt.pn * tstep : cB;
        for (int t = 0; t < nt; t += 2) {
            const bool last = (t == nt - 2);
            const char* a1 = cA + (size_t)(t + 1) * kstep;
            const char* a2 = last ? nA : cA + (size_t)(t + 2) * kstep; const char* b2 = last ? nB : cB + (size_t)(t + 2) * kstep;
            const char* a3 = a2 + kstep; const char* b3 = b2 + kstep;
            if (last && has_next) S.a_ready(nxt);
            if constexpr (SP2) {
            PG8_LDB(B0, 0, 0); PG8_LDB(B1, 0, 1); PG8_SCHED; PG8_LDA(At, 0, 0); PG8_STAGE(PG8_SA(1, 1), a1 + hstep, voffA);
            PG8_WAIT_V(8); PG8_WAIT_L(0); PG8_BAR; PG8_MMA(0, 0, At, B0); PG8_MMA(0, 1, At, B1); PG8_BAR; PG8_SCHED;
            PG8_LDA(At, 0, 1); PG8_STAGE(PG8_SB(0, 0), b2, voffB); PG8_STAGE(PG8_SB(0, 1), b2 + hstep, voffB); PG8_STAGE(PG8_SA(0, 0), a2, voffA);
            PG8_WAIT_V(8); PG8_WAIT_L(0); PG8_BAR; PG8_MMA(1, 0, At, B0); PG8_MMA(1, 1, At, B1); PG8_BAR; PG8_SCHED;
            PG8_LDB(B0, 1, 0); PG8_LDB(B1, 1, 1); PG8_SCHED; PG8_LDA(At, 1, 0); PG8_STAGE(PG8_SA(0, 1), a2 + hstep, voffA);
            PG8_WAIT_V(8); PG8_WAIT_L(0); PG8_BAR; PG8_MMA(0, 0, At, B0); PG8_MMA(0, 1, At, B1); PG8_BAR; PG8_SCHED;
            PG8_LDA(At, 1, 1); PG8_STAGE(PG8_SB(1, 0), b3, voffB); PG8_STAGE(PG8_SB(1, 1), b3 + hstep, voffB); PG8_STAGE(PG8_SA(1, 0), a3, voffA);
            PG8_WAIT_V(8); PG8_WAIT_L(0); PG8_BAR; PG8_MMA(1, 0, At, B0); PG8_MMA(1, 1, At, B1); PG8_BAR; PG8_SCHED;
            } else {
            PG8_LDB(B0, 0, 0); PG8_SCHED; PG8_LDA(At, 0, 0); PG8_STAGE(PG8_SA(1, 1), a1 + hstep, voffA);
            PG8_WAIT_L(8); PG8_BAR; PG8_WAIT_L(0); PG8_MMA(0, 0, At, B0); PG8_BAR; PG8_SCHED;
            PG8_LDB(B1, 0, 1); PG8_STAGE(PG8_SB(0, 0), b2, voffB);
            PG8_BAR; PG8_WAIT_L(0); PG8_MMA(0, 1, At, B1); PG8_BAR;
            PG8_LDA(At, 0, 1); PG8_STAGE(PG8_SA(0, 0), a2, voffA);
            PG8_BAR; PG8_WAIT_L(0); PG8_MMA(1, 0, At, B0); PG8_BAR; PG8_SCHED;
            PG8_STAGE(PG8_SB(0, 1), b2 + hstep, voffB);
            PG8_WAIT_V(6); PG8_BAR; PG8_MMA(1, 1, At, B1); PG8_BAR;
            PG8_LDB(B0, 1, 0); PG8_SCHED; PG8_LDA(At, 1, 0); PG8_STAGE(PG8_SA(0, 1), a2 + hstep, voffA);
            PG8_WAIT_L(8); PG8_BAR; PG8_WAIT_L(0); PG8_MMA(0, 0, At, B0); PG8_BAR; PG8_SCHED;
            PG8_LDB(B1, 1, 1); PG8_STAGE(PG8_SB(1, 0), b3, voffB);
            PG8_BAR; PG8_WAIT_L(0); PG8_MMA(0, 1, At, B1); PG8_BAR;
            PG8_LDA(At, 1, 1); PG8_STAGE(PG8_SA(1, 0), a3, voffA);
            PG8_BAR; PG8_WAIT_L(0); PG8_MMA(1, 0, At, B0); PG8_BAR; PG8_SCHED;
            PG8_STAGE(PG8_SB(1, 1), b3 + hstep, voffB);
            PG8_WAIT_V(6); PG8_BAR; PG8_MMA(1, 1, At, B1); PG8_BAR;
            }
        }
        if constexpr (ALIGN_EPI) { if (wr == 0) PG8_BAR; }
        if constexpr (!Epi::AFTER_DRAIN) { int te_ = tid_in; asm volatile("" : "+v"(te_)); E(acc, cur, wr, wc, te_ & 15, (te_ & 63) >> 4); S.done(cur); }
        if (!has_next) break;
        zf_ = 0.f; asm volatile("" : "+v"(zf_));
#pragma unroll
        for (int a = 0; a < 2; ++a)
#pragma unroll
            for (int b = 0; b < 2; ++b)
#pragma unroll
                for (int m = 0; m < 4; ++m)
#pragma unroll
                    for (int n = 0; n < 2; ++n) acc[a][b][m][n] = (f32x4){zf_, zf_, zf_, zf_};
        cur = nxt; cA = nA; cB = nB; ++ui;
        if constexpr (ALIGN_EPI) { if (wr == 1) PG8_BAR; }
    }
    PG8_WAIT_V(0);
    if constexpr (!ALIGN_EPI) { if (wr == 0) PG8_BAR; }
    PG8_BAR;
    if constexpr (Epi::AFTER_DRAIN) { E.fused(acc, cur, wr, wc, fr, fq, lds, wid, lane); S.done(cur); }
#undef PG8_SA
#undef PG8_SB
#undef PG8_STAGE
#undef PG8_LDA
#undef PG8_LDB
#undef PG8_MMA
#undef PG8_WAIT_V
#undef PG8_WAIT_L
#undef PG8_BAR
#undef PG8_SCHED
}
}
constexpr int NW = 8, NTHR = 512;
constexpr int DM = 1024, NB = 4, SEQ = 4096, NTOK = NB * SEQ, NLAYER = 2;
constexpr int HA = 8, HDA = 64, WA = 512, MBLK = 256, NBLK = SEQ / MBLK;
constexpr int HB = 4, HDB = 128, WB = 512, CONVK = 4, DNC = 64, NCH = SEQ / DNC;
constexpr int NGRP = 4, EPG = 8, NEXP = 32, DFF = 256;
constexpr int DIN = 5640, DINP = 5632, NMOD = 6;
constexpr int C_QKVA = 0, C_QKVB = 1536, C_ZB = 3072, C_BA = 3584, C_GATE = 3592;
constexpr float EPS = 1e-6f;
constexpr int MOE_MAXROWS = 2 * NTOK + NEXP * 256;
constexpr int MOE_MAXTILES = MOE_MAXROWS / 256;

constexpr size_t MiB = 1u << 20;
constexpr size_t WS_CTL = 0, CTL_ZERO_BYTES = 1 * MiB;
constexpr size_t WS_MOD = 1 * MiB;
constexpr size_t WS_WIN = 2 * MiB;
constexpr size_t WS_WUPA = 13 * MiB, WS_WUPB = 14 * MiB;
constexpr size_t WS_WOUT = 15 * MiB;
constexpr size_t WS_WEGU = 17 * MiB;
constexpr size_t WS_WED = 49 * MiB;
constexpr size_t WS_SMALL = 65 * MiB;
constexpr size_t WS_KMEAN = WS_SMALL;
constexpr size_t WS_BETA = WS_SMALL + 256 * 1024;
constexpr size_t WS_GLOG = WS_SMALL + 512 * 1024;
constexpr size_t WS_TOKINFO = WS_SMALL + 1 * MiB;
constexpr size_t WS_ROWTOK = WS_SMALL + 2 * MiB;
constexpr size_t WS_ROWW = WS_SMALL + 3 * MiB;
constexpr size_t WS_GL = WS_SMALL + 4 * MiB;
constexpr size_t WS_H = 72 * MiB;
constexpr size_t WS_QKVA = 104 * MiB;
constexpr size_t WS_QKVB = 152 * MiB;
constexpr size_t WS_ZB = 200 * MiB;
constexpr size_t WS_GATES = 216 * MiB;
constexpr size_t WS_IMG = 280 * MiB;
constexpr size_t WS_YA = 72 * MiB, WS_YB = 336 * MiB;
constexpr size_t WS_END = 352 * MiB;
constexpr size_t WS_M = WS_QKVB;
constexpr size_t WS_U = 88 * MiB;
constexpr size_t WS_HS = WS_QKVA;
constexpr size_t WS_ACT = 184 * MiB;
constexpr size_t WS_YS = WS_GATES;
constexpr int CW_TMO = 0;
constexpr int CW_BAR = 4096;
constexpr int CW_GCNT = 8192;
constexpr int CW_ACTR = 8320;

constexpr int RING_BYTES = 131072;
constexpr int MISC_OFF = 143360;
constexpr int LDS_BYTES = 147456;

#define GAS __attribute__((address_space(1)))
#define LAS __attribute__((address_space(3)))
typedef unsigned short bf16;
typedef unsigned v4u __attribute__((ext_vector_type(4)));
typedef unsigned v2u __attribute__((ext_vector_type(2)));
typedef float f32x4 __attribute__((ext_vector_type(4)));
typedef float f32x16 __attribute__((ext_vector_type(16)));
typedef short bf16x8 __attribute__((ext_vector_type(8)));
typedef GAS unsigned gu32;
#define RLX_AGENT __ATOMIC_RELAXED, __HIP_MEMORY_SCOPE_AGENT
#define LDS_WAIT() asm volatile("s_waitcnt lgkmcnt(0)" ::: "memory")
#define VM_WAIT() asm volatile("s_waitcnt vmcnt(0)" ::: "memory")
__device__ __forceinline__ unsigned f2bf(float f) { unsigned u = __builtin_bit_cast(unsigned, f); return (u + 0x7fffu + ((u >> 16) & 1u)) >> 16; }
__device__ __forceinline__ unsigned pk2(float lo, float hi) { return f2bf(lo) | (f2bf(hi) << 16); }
__device__ __forceinline__ float bf2f(unsigned b) { return __builtin_bit_cast(float, b << 16); }
__device__ __forceinline__ float bflo(unsigned w) { return __builtin_bit_cast(float, w << 16); }
__device__ __forceinline__ float bfhi(unsigned w) { return __builtin_bit_cast(float, w & 0xffff0000u); }
__device__ __forceinline__ float sigmoidf_(float x) { return 1.f / (1.f + __expf(-x)); }
__device__ __forceinline__ float siluf_(float x) { return x / (1.f + __expf(-x)); }
__device__ __forceinline__ float shx(float v, int o, int lane) { return __builtin_bit_cast(float, __builtin_amdgcn_ds_bpermute((lane ^ o) << 2, __builtin_bit_cast(int, v))); }
__device__ __forceinline__ float shidx(float v, int src) { return __builtin_bit_cast(float, __builtin_amdgcn_ds_bpermute(src << 2, __builtin_bit_cast(int, v))); }
__device__ __forceinline__ int shidx_i(int v, int src) { return __builtin_amdgcn_ds_bpermute(src << 2, v); }
__device__ __forceinline__ float wave_sum(float v, int lane) {
#pragma unroll
    for (int o = 1; o < 64; o <<= 1) v += shx(v, o, lane);
    return v;
}
__device__ __forceinline__ float wave_max(float v, int lane) {
#pragma unroll
    for (int o = 1; o < 64; o <<= 1) v = fmaxf(v, shx(v, o, lane));
    return v;
}
__device__ const unsigned char T5B[128] = {0, 1, 2, 3, 4, 5, 6, 7, 8, 9, 10, 11, 12, 13, 14, 15, 16, 16, 16, 17, 17, 18, 18, 18, 19, 19, 19, 20, 20, 20, 20, 21, 21, 21, 21, 22, 22, 22, 22, 22, 23, 23, 23, 23, 23, 23, 24, 24, 24, 24, 24, 24, 25, 25, 25, 25, 25, 25, 25, 26, 26, 26, 26, 26, 26, 26, 26, 27, 27, 27, 27, 27, 27, 27, 27, 27, 27, 28, 28, 28, 28, 28, 28, 28, 28, 28, 28, 29, 29, 29, 29, 29, 29, 29, 29, 29, 29, 29, 29, 30, 30, 30, 30, 30, 30, 30, 30, 30, 30, 30, 30, 30, 30, 31, 31, 31, 31, 31, 31, 31, 31, 31, 31, 31, 31, 31, 31, 31};

#define XB_TMO      128
#define XB_XCNT(j)  (256  + 64 * (j))
#define XB_XSUB(j)  (1280 + 64 * (j))
#define XB_XGEN(j)  (2304 + 64 * (j))
#define XB_TOP      3328
#define XB_TOPGEN   3392
#define XCD_BAR_WORDS 3456
#define XB_SPIN_CAP (1u << 18)

__device__ __forceinline__ unsigned xb_ld(unsigned* p)              { return __hip_atomic_load(p, __ATOMIC_RELAXED, __HIP_MEMORY_SCOPE_AGENT); }
__device__ __forceinline__ unsigned xb_add(unsigned* p, unsigned v) { return __hip_atomic_fetch_add(p, v, __ATOMIC_RELAXED, __HIP_MEMORY_SCOPE_AGENT); }
__device__ __forceinline__ unsigned xb_xcc_id() { return (unsigned)__builtin_amdgcn_s_getreg((3 << 11) | 20) & 0xFu; }
#define XB_SPIN(cond, bar) do { unsigned _sp = 0; while (cond) { __builtin_amdgcn_s_sleep(1); \
    if ((++_sp & 255u) == 0u) { if (xb_ld(&(bar)[XB_TMO])) break; if (_sp > XB_SPIN_CAP) { atomicAdd(&(bar)[XB_TMO], 1u); break; } } } } while (0)

struct XcdBarrier {
    unsigned* bar; unsigned x;
    volatile LAS unsigned* st;
};

__device__ __forceinline__ XcdBarrier xcd_barrier_post(unsigned* bar, volatile LAS unsigned* st, const int tid_in) {
    XcdBarrier b; b.bar = bar; b.x = xb_xcc_id(); b.st = st;
    if (tid_in == 0) (void)xb_add(&bar[XB_XCNT(b.x)], 1u);
    return b;
}
__device__ __forceinline__ void xcd_barrier_complete(unsigned* bar, unsigned x, unsigned& nloc, unsigned& nx) {
    const unsigned G = gridDim.x * gridDim.y * gridDim.z;
    unsigned sum, cnt, mine, sp = 0u;
    for (;;) {
        sum = 0u; cnt = 0u; mine = 0u;
#pragma unroll
        for (unsigned j = 0; j < 16; ++j) { const unsigned c = xb_ld(&bar[XB_XCNT(j)]); sum += c; cnt += (c > 0u) ? 1u : 0u; mine = (j == x) ? c : mine; }
        if (sum == G) break;
        __builtin_amdgcn_s_sleep(1);
        if ((++sp & 255u) == 0u) { if (xb_ld(&bar[XB_TMO])) break; if (sp > XB_SPIN_CAP) { atomicAdd(&bar[XB_TMO], 1u); break; } }
    }
    nloc = mine > 0u ? mine : 1u; nx = cnt > 0u ? cnt : 1u;
}

__device__ __forceinline__ void xcd_barrier(const XcdBarrier& b, const int tid_in) {
    asm volatile("s_waitcnt vmcnt(0)" ::: "memory");
    __syncthreads();
    if (tid_in == 0) {
        unsigned* bar = b.bar;
        __builtin_amdgcn_s_waitcnt(0);
        unsigned nloc = b.st[0], nx = b.st[1];
        if (nloc == 0u) { xcd_barrier_complete(bar, b.x, nloc, nx); b.st[0] = nloc; b.st[1] = nx; }
        const unsigned old = xb_add(&bar[XB_XSUB(b.x)], 1u);
        const unsigned gen = old / nloc;
        if (old + 1u == (gen + 1u) * nloc) {
            __builtin_amdgcn_fence(__ATOMIC_RELEASE, "agent");
            asm volatile("s_waitcnt vmcnt(0)" ::: "memory");
            const unsigned og = xb_add(&bar[XB_TOP], 1u);
            const unsigned tg = og / nx;
            if (og + 1u == (tg + 1u) * nx) xb_add(&bar[XB_TOPGEN], 1u);
            else XB_SPIN(xb_ld(&bar[XB_TOPGEN]) == tg, bar);
            __builtin_amdgcn_fence(__ATOMIC_ACQUIRE, "agent");
            xb_add(&bar[XB_XGEN(b.x)], 1u);
            asm volatile("s_waitcnt vmcnt(0)" ::: "memory");
        } else {
            XB_SPIN(xb_ld(&bar[XB_XGEN(b.x)]) == gen, bar);
            __builtin_amdgcn_fence(__ATOMIC_ACQUIRE, "agent");
            asm volatile("s_waitcnt vmcnt(0)" ::: "memory");
        }
    }
    __syncthreads();
}
struct Args { const float* in[23]; float* out; unsigned char* ws; int ph_lo, ph_hi; };
enum { I_X = 0, I_C, I_RELB, I_FNW, I_N1W, I_N2W, I_WMOD, I_BMOD, I_WIN, I_CONVW, I_ALOG, I_DTB, I_ONW, I_WUPA, I_WUPB, I_WOUT, I_WRG, I_BRG, I_WRE, I_BRE, I_WEG, I_WEU, I_WED };

typedef const Args __attribute__((address_space(4)))* KArgs;
struct Ctx { LAS unsigned char* lds; int tid, lane, wave, bid, G; };
extern __shared__ __attribute__((aligned(16))) unsigned char lds_raw[];
__device__ __forceinline__ Ctx make_ctx(int& tid) { Ctx c; c.lds = (LAS unsigned char*)lds_raw; asm volatile("" : "+v"(tid)); const int t = tid; c.tid = t; c.lane = t & 63; c.wave = __builtin_amdgcn_readfirstlane(t >> 6); int bi = blockIdx.x, gd = gridDim.x; asm volatile("" : "+s"(bi), "+s"(gd)); c.bid = bi; c.G = gd; return c; }

__device__ __forceinline__ void ph_mod(KArgs a, const Ctx& c) {
    LAS float* cact = (LAS float*)c.lds;
    LAS float* red = (LAS float*)(c.lds + 16384);
    const float* cin = a->in[I_C];
    for (int i = c.tid; i < 4096; i += NTHR) cact[i] = siluf_(cin[i]);
    __syncthreads();
    float* mod = (float*)(a->ws + WS_MOD);
    for (int item = c.bid; item < 192; item += c.G) {
        const int l = item / 96, j0 = (item % 96) * 64;
        const float* W = a->in[I_WMOD] + (size_t)l * 1024 * 6144 + j0 + c.lane;
        float a0 = 0.f, a1 = 0.f, a2 = 0.f, a3 = 0.f;
        const int k0 = c.wave * 128;
#pragma unroll 8
        for (int k = k0; k < k0 + 128; ++k) { const float w = W[(size_t)k * 6144]; a0 += cact[k] * w; a1 += cact[1024 + k] * w; a2 += cact[2048 + k] * w; a3 += cact[3072 + k] * w; }
        red[(c.wave * 4 + 0) * 64 + c.lane] = a0; red[(c.wave * 4 + 1) * 64 + c.lane] = a1; red[(c.wave * 4 + 2) * 64 + c.lane] = a2; red[(c.wave * 4 + 3) * 64 + c.lane] = a3;
        __syncthreads();
        if (c.tid < 256) { const int b = c.tid >> 6, ln = c.tid & 63; float s = 0.f;
#pragma unroll
            for (int w = 0; w < 8; ++w) s += red[(w * 4 + b) * 64 + ln];
            mod[(l * 4 + b) * 6144 + j0 + ln] = s + a->in[I_BMOD][l * 6144 + j0 + ln]; }
        __syncthreads();
    }
}

__device__ __forceinline__ void tr_item(const float* src, int ld, bf16* dst, int K, int nblk, LAS float* scr, int item, int lane) {
    const int kb = item / nblk, nb = item % nblk, k0 = 64 * kb, n0 = 32 * nb;
#pragma unroll 8
    for (int i = 0; i < 32; ++i) { const int kk = 2 * i + (lane >> 5); scr[kk * 33 + (lane & 31)] = src[(size_t)(k0 + kk) * ld + n0 + (lane & 31)]; }
    LDS_WAIT(); asm volatile("" ::: "memory");
    const int cc = lane & 7;
#pragma unroll
    for (int j = 0; j < 4; ++j) { const int n = (lane >> 3) + 8 * j; const LAS float* s = scr + (8 * cc) * 33 + n;
        v4u o; o.x = pk2(s[0 * 33], s[1 * 33]); o.y = pk2(s[2 * 33], s[3 * 33]); o.z = pk2(s[4 * 33], s[5 * 33]); o.w = pk2(s[6 * 33], s[7 * 33]);
        *(v4u*)(dst + (size_t)(n0 + n) * K + k0 + 8 * cc) = o; }
    LDS_WAIT(); asm volatile("" ::: "memory");
}
constexpr int CV_I0 = 1792, CV_I1 = 1024, CV_I2 = 256, CV_I3 = 256, CV_I4 = 512, CV_I5 = 4096, CV_I6 = 4096, CV_I7 = 4096;
constexpr int CV_NIT = CV_I0 + CV_I1 + CV_I2 + CV_I3 + CV_I4 + CV_I5 + CV_I6 + CV_I7, CV_EARLY = CV_I0 + CV_I1;
__device__ __forceinline__ void convert_item(KArgs a, int l, int it, LAS float* scr, int lane) {
    bf16* WIN = (bf16*)(a->ws + WS_WIN); bf16* WEGU = (bf16*)(a->ws + WS_WEGU); bf16* WEDT = (bf16*)(a->ws + WS_WED);
    const float* win = a->in[I_WIN] + (size_t)l * 1024 * DIN;
    int r = it;
    if (r < CV_I0) { tr_item(win, DIN, WIN, 1024, 112, scr, r, lane); return; } r -= CV_I0;
    if (r < CV_I1) { tr_item(win + C_GATE, DIN, WIN + (size_t)C_BA * 1024, 1024, 64, scr, r, lane); return; } r -= CV_I1;
    if (r < CV_I2) { tr_item(a->in[I_WUPA] + (size_t)l * 512 * 1024, 1024, (bf16*)(a->ws + WS_WUPA), 512, 32, scr, r, lane); return; } r -= CV_I2;
    if (r < CV_I3) { tr_item(a->in[I_WUPB] + (size_t)l * 512 * 1024, 1024, (bf16*)(a->ws + WS_WUPB), 512, 32, scr, r, lane); return; } r -= CV_I3;
    if (r < CV_I4) { tr_item(a->in[I_WOUT] + (size_t)l * 1024 * 1024, 1024, (bf16*)(a->ws + WS_WOUT), 1024, 32, scr, r, lane); return; } r -= CV_I4;
    if (r < CV_I5) { const int E = r >> 7, rem = r & 127, pn = rem >> 6, q = rem & 63;
        tr_item(a->in[I_WEG] + ((size_t)(l * 32 + E) * 1024 * 256) + 128 * pn, 256, WEGU + (size_t)(E * 512 + 256 * pn) * 1024, 1024, 4, scr, q, lane); return; } r -= CV_I5;
    if (r < CV_I6) { const int E = r >> 7, rem = r & 127, pn = rem >> 6, q = rem & 63;
        tr_item(a->in[I_WEU] + ((size_t)(l * 32 + E) * 1024 * 256) + 128 * pn, 256, WEGU + (size_t)(E * 512 + 256 * pn + 128) * 1024, 1024, 4, scr, q, lane); return; } r -= CV_I6;
    { const int E = r >> 7, q = r & 127;
        tr_item(a->in[I_WED] + ((size_t)(l * 32 + E) * 256 * 1024), 1024, WEDT + (size_t)E * 1024 * 256, 256, 32, scr, q, lane); }
}
__device__ __forceinline__ void ph_convert(KArgs a, const Ctx& c, int l) {
    LAS float* scr = (LAS float*)(c.lds + 32768 + c.wave * 10240);
    const int gw = c.bid * NW + c.wave, NGW = c.G * NW;
    for (int it = gw; it < CV_EARLY; it += NGW) convert_item(a, l, it, scr, c.lane);
}
constexpr int CV_UNIT = 64, CV_NUNITS = (CV_NIT - CV_EARLY) / CV_UNIT;
static_assert((CV_NIT - CV_EARLY) % CV_UNIT == 0, "convert units");
__device__ __forceinline__ void convert_unit(KArgs a, const Ctx& c, int l, int cu) {
    LAS float* scr = (LAS float*)(c.lds + 32768 + c.wave * 10240);
#pragma unroll 1
    for (int i = 0; i < 8; ++i) convert_item(a, l, CV_EARLY + cu * CV_UNIT + c.wave * 8 + i, scr, c.lane);
}

__device__ __forceinline__ void load_row_x(KArgs a, int l, int m, int lane, f32x4 (&v)[4]) {
    const float* xr = (l == 0 ? a->in[I_X] : (const float*)a->out) + (size_t)m * DM;
#pragma unroll
    for (int j = 0; j < 4; ++j) v[j] = *(const f32x4*)(xr + 256 * j + 4 * lane);
    if (l > 0) {
        const int b = m >> 12;
        const float* g2 = (const float*)(a->ws + WS_MOD) + ((l - 1) * 4 + b) * 6144 + 5120;
        const bf16* ys = (const bf16*)(a->ws + WS_YS) + (size_t)m * 2048;
#pragma unroll
        for (int j = 0; j < 4; ++j) { const int col = 256 * j + 4 * lane; const v2u y0 = *(const v2u*)(ys + col), y1 = *(const v2u*)(ys + 1024 + col); const f32x4 g = *(const f32x4*)(g2 + col);
            v[j].x += g.x * (bflo(y0.x) + bflo(y1.x)); v[j].y += g.y * (bfhi(y0.x) + bfhi(y1.x)); v[j].z += g.z * (bflo(y0.y) + bflo(y1.y)); v[j].w += g.w * (bfhi(y0.y) + bfhi(y1.y)); }
        float* xo = a->out + (size_t)m * DM;
#pragma unroll
        for (int j = 0; j < 4; ++j) *(f32x4*)(xo + 256 * j + 4 * lane) = v[j];
    }
}
__device__ __forceinline__ float row_rstd(const f32x4 (&v)[4], int lane) {
    float s = 0.f;
#pragma unroll
    for (int j = 0; j < 4; ++j) s += (v[j].x * v[j].x + v[j].y * v[j].y) + (v[j].z * v[j].z + v[j].w * v[j].w);
    return 1.f / sqrtf(wave_sum(s, lane) * (1.f / DM) + EPS);
}
__device__ __forceinline__ void ph_norm1(KArgs a, const Ctx& c, int l) {
    LAS float* wbaT = (LAS float*)c.lds;
    const float* win = a->in[I_WIN] + (size_t)l * 1024 * DIN + C_BA;
    for (int i = c.tid; i < 8192; i += NTHR) { const int k = i >> 3, cc = i & 7; wbaT[cc * 1024 + k] = win[(size_t)k * DIN + cc]; }
    __syncthreads();
    const int gw = c.bid * NW + c.wave, NGW = c.G * NW, lane = c.lane;
    bf16* H = (bf16*)(a->ws + WS_H); float* beta = (float*)(a->ws + WS_BETA); float* glog = (float*)(a->ws + WS_GLOG);
    const float* n1w = a->in[I_N1W] + l * DM;
    for (int m = gw; m < NTOK; m += NGW) {
        f32x4 v[4]; load_row_x(a, l, m, lane, v);
        const float rstd = row_rstd(v, lane);
        const int b = m >> 12; const float* mod = (const float*)(a->ws + WS_MOD) + (l * 4 + b) * 6144;
        float acc[8];
#pragma unroll
        for (int q = 0; q < 8; ++q) acc[q] = 0.f;
#pragma unroll
        for (int j = 0; j < 4; ++j) { const int col = 256 * j + 4 * lane;
            const f32x4 nw = *(const f32x4*)(n1w + col), sh = *(const f32x4*)(mod + col), sc = *(const f32x4*)(mod + 1024 + col);
            f32x4 h = v[j] * rstd * nw * (sc + 1.0f) + sh;
            v2u o; o.x = pk2(h.x, h.y); o.y = pk2(h.z, h.w); *(v2u*)(H + (size_t)m * DM + col) = o;
#pragma unroll
            for (int q = 0; q < 8; ++q) { const f32x4 w4 = *(const LAS f32x4*)(wbaT + q * 1024 + col); acc[q] += (h.x * w4.x + h.y * w4.y) + (h.z * w4.z + h.w * w4.w); } }
#pragma unroll
        for (int q = 0; q < 8; ++q) acc[q] = wave_sum(acc[q], lane);
        if (lane < 4) {
            const float bb = lane == 0 ? acc[0] : lane == 1 ? acc[1] : lane == 2 ? acc[2] : acc[3];
            const float aa = lane == 0 ? acc[4] : lane == 1 ? acc[5] : lane == 2 ? acc[6] : acc[7];
            beta[m * 4 + lane] = sigmoidf_(bb);
            const float z = aa + a->in[I_DTB][l * 4 + lane]; const float sp = fmaxf(z, 0.f) + log1pf(__expf(-fabsf(z)));
            glog[m * 4 + lane] = -__expf(a->in[I_ALOG][l * 4 + lane]) * sp;
        }
    }
}
__device__ __forceinline__ void ph_final(KArgs a, const Ctx& c) {
    const int gw = c.bid * NW + c.wave, NGW = c.G * NW, lane = c.lane;
    const float* fw = a->in[I_FNW];
    for (int m = gw; m < NTOK; m += NGW) {
        f32x4 v[4];
        {
            const float* xr = (const float*)a->out + (size_t)m * DM; const int b = m >> 12;
            const float* g2 = (const float*)(a->ws + WS_MOD) + ((NLAYER - 1) * 4 + b) * 6144 + 5120;
            const bf16* ys = (const bf16*)(a->ws + WS_YS) + (size_t)m * 2048;
#pragma unroll
            for (int j = 0; j < 4; ++j) { const int col = 256 * j + 4 * lane; v[j] = *(const f32x4*)(xr + col);
                const v2u y0 = *(const v2u*)(ys + col), y1 = *(const v2u*)(ys + 1024 + col); const f32x4 g = *(const f32x4*)(g2 + col);
                v[j].x += g.x * (bflo(y0.x) + bflo(y1.x)); v[j].y += g.y * (bfhi(y0.x) + bfhi(y1.x)); v[j].z += g.z * (bflo(y0.y) + bflo(y1.y)); v[j].w += g.w * (bfhi(y0.y) + bfhi(y1.y)); }
        }
        float rstd = row_rstd(v, lane);
#if defined(MK_PROBE_A) && MK_PROBE_A >= 0
        {   const unsigned long long* ts = (const unsigned long long*)((const unsigned*)(a->ws + WS_CTL) + 12288);
            float tA = 0.f, tB = 0.f;
            for (int ly = 0; ly < NLAYER; ++ly) { const int ka = 1 + ly * 11 + MK_PROBE_A, kb = 1 + ly * 11 + MK_PROBE_B;
                if (MK_PROBE_A < 11) tA += (float)(ts[ka + 1] - ts[ka]) * 0.01f; if (MK_PROBE_B < 11) tB += (float)(ts[kb + 1] - ts[kb]) * 0.01f; }
            if (MK_PROBE_A == 20) { tA = 0.f; for (int ly = 0; ly < NLAYER; ++ly) tA += (float)(ts[40 + ly] - ts[1 + ly * 11 + 3]) * 0.01f; }
            if (MK_PROBE_B == 21) { tB = 0.f; for (int ly = 0; ly < NLAYER; ++ly) tB += (float)(ts[44 + ly] - ts[1 + ly * 11 + 3]) * 0.01f; }
            if (MK_PROBE_A == 11) tA = (float)(ts[1] - ts[0]) * 0.01f; if (MK_PROBE_A == 12) tA = (float)(ts[23] - ts[0]) * 0.01f;
            if (MK_PROBE_B == 11) tB = (float)(ts[1] - ts[0]) * 0.01f; if (MK_PROBE_B == 12) tB = (float)(ts[23] - ts[0]) * 0.01f;
            rstd *= 1.f + sqrtf(tB * 1e-6f);
            if (m == 0 && lane == 0) v[0].x += tA * 0.05f / rstd / fw[0]; }
#endif
        float* xo = a->out + (size_t)m * DM;
#pragma unroll
        for (int j = 0; j < 4; ++j) { const int col = 256 * j + 4 * lane; const f32x4 w = *(const f32x4*)(fw + col); *(f32x4*)(xo + col) = v[j] * rstd * w; }
    }
}

__device__ __forceinline__ void ph_kmean(KArgs a, const Ctx& c) {
    const int gw = c.bid * NW + c.wave, NGW = c.G * NW, lane = c.lane;
    const bf16* QKVA = (const bf16*)(a->ws + WS_QKVA); float* kmean = (float*)(a->ws + WS_KMEAN);
    for (int item = gw; item < NB * HA * NBLK; item += NGW) {
        const int nb = item & 15, h = (item >> 4) & 7, b = item >> 7;
        const int sub = lane & 7, rr = lane >> 3;
        float s[8];
#pragma unroll
        for (int q = 0; q < 8; ++q) s[q] = 0.f;
        const bf16* kp = QKVA + (size_t)(b * SEQ + nb * MBLK) * 1536 + 512 + h * 64 + sub * 8;
#pragma unroll 4
        for (int it = 0; it < 32; ++it) { const v4u w = *(const v4u*)(kp + (size_t)(it * 8 + rr) * 1536);
            s[0] += bflo(w.x); s[1] += bfhi(w.x); s[2] += bflo(w.y); s[3] += bfhi(w.y); s[4] += bflo(w.z); s[5] += bfhi(w.z); s[6] += bflo(w.w); s[7] += bfhi(w.w); }
#pragma unroll
        for (int q = 0; q < 8; ++q) { s[q] += shx(s[q], 8, lane); s[q] += shx(s[q], 16, lane); s[q] += shx(s[q], 32, lane); }
        if (lane < 8) { float* o = kmean + (size_t)item * 64 + sub * 8;
            *(f32x4*)o = (f32x4){s[0], s[1], s[2], s[3]} * (1.f / 256.f); *(f32x4*)(o + 4) = (f32x4){s[4], s[5], s[6], s[7]} * (1.f / 256.f); }
    }
}

__device__ __forceinline__ void ph_attn_simple(KArgs a, const Ctx& c) {
    const int gw = c.bid * NW + c.wave, NGW = c.G * NW, lane = c.lane;
    LAS float* btab = (LAS float*)(c.lds);
    LAS float* scw = (LAS float*)(c.lds + 8192) + c.wave * 1024;
    const float* relb = a->in[I_RELB];
    for (int i = c.tid; i < 8 * 129; i += NTHR) { const int h = i / 129, d = i % 129; btab[h * 132 + d] = relb[(d < 128 ? (int)T5B[d] : 31) * 8 + h]; }
    __syncthreads();
    const bf16* QKVA = (const bf16*)(a->ws + WS_QKVA); const float* kmean = (const float*)(a->ws + WS_KMEAN); bf16* YA = (bf16*)(a->ws + WS_YA);
    for (int r = gw; r < NB * HA * SEQ; r += NGW) {
        const int s = r & (SEQ - 1), h = (r >> 12) & 7, b = r >> 15, qb = s >> 8, tok = b * SEQ + s;
        float qv[64];
        { const bf16* qp = QKVA + (size_t)tok * 1536 + h * 64;
#pragma unroll
          for (int q = 0; q < 8; ++q) { const v4u w = *(const v4u*)(qp + q * 8); qv[q * 8 + 0] = bflo(w.x); qv[q * 8 + 1] = bfhi(w.x); qv[q * 8 + 2] = bflo(w.y); qv[q * 8 + 3] = bfhi(w.y); qv[q * 8 + 4] = bflo(w.z); qv[q * 8 + 5] = bfhi(w.z); qv[q * 8 + 6] = bflo(w.w); qv[q * 8 + 7] = bfhi(w.w); } }
        float gate = -1e30f;
        if (lane < qb) { const float* km = kmean + (size_t)(((b * 8 + h) * 16) + lane) * 64; float d = 0.f;
#pragma unroll
            for (int q = 0; q < 16; ++q) { const f32x4 k4 = *(const f32x4*)(km + q * 4); d += qv[q * 4] * k4.x + qv[q * 4 + 1] * k4.y + qv[q * 4 + 2] * k4.z + qv[q * 4 + 3] * k4.w; }
            gate = d; }
        unsigned selmask = 0u;
#pragma unroll
        for (int t = 0; t < 3; ++t) { float best = -3e38f; int bi = 0;
#pragma unroll
            for (int n = 0; n < 16; ++n) { const float gv = shidx(gate, n); if (!((selmask >> n) & 1u) && gv > best) { best = gv; bi = n; } }
            selmask |= 1u << bi; }
        selmask &= (1u << qb) - 1u;
        selmask |= 1u << qb;
        int nseg = 0; float mx = -3e38f;
        for (int blk = 0; blk <= qb; ++blk) {
            if (!((selmask >> blk) & 1u)) continue;
            for (int i = 0; i < 4; ++i) { const int key = blk * 256 + i * 64 + lane; const bf16* kp = QKVA + (size_t)(b * SEQ + key) * 1536 + 512 + h * 64; float d = 0.f;
#pragma unroll
                for (int q = 0; q < 8; ++q) { const v4u w = *(const v4u*)(kp + q * 8);
                    d += qv[q * 8] * bflo(w.x) + qv[q * 8 + 1] * bfhi(w.x) + qv[q * 8 + 2] * bflo(w.y) + qv[q * 8 + 3] * bfhi(w.y) + qv[q * 8 + 4] * bflo(w.z) + qv[q * 8 + 5] * bfhi(w.z) + qv[q * 8 + 6] * bflo(w.w) + qv[q * 8 + 7] * bfhi(w.w); }
                const int dist = s - key; float sc = d * 0.125f + btab[h * 132 + (dist < 0 ? 0 : (dist > 128 ? 128 : dist))];
                if (dist < 0) sc = -3e38f;
                scw[nseg * 256 + i * 64 + lane] = sc; mx = fmaxf(mx, sc); }
            ++nseg; }
        mx = wave_max(mx, lane);
        float sum = 0.f;
        for (int idx = lane; idx < nseg * 256; idx += 64) { const float sc = scw[idx]; const float e = sc < -1e37f ? 0.f : __expf(sc - mx); scw[idx] = e; sum += e; }
        sum = wave_sum(sum, lane);
        LDS_WAIT();
        float o = 0.f; int sg = 0;
        for (int blk = 0; blk <= qb; ++blk) {
            if (!((selmask >> blk) & 1u)) continue;
            const bf16* vp = QKVA + (size_t)(b * SEQ + blk * 256) * 1536 + 1024 + h * 64 + lane;
            const int lim = (blk == qb) ? (s & 255) + 1 : 256;
#pragma unroll 8
            for (int kk = 0; kk < lim; ++kk) o += scw[sg * 256 + kk] * bf2f(vp[(size_t)kk * 1536]);
            ++sg; }
        YA[(size_t)tok * 512 + h * 64 + lane] = (bf16)f2bf(o / sum);
    }
}

template <int LDW> __device__ __forceinline__ void dn_load_chunk(KArgs a, const Ctx& c, int l, int b, int h, int t0, LAS float* qs, LAS float* ks, LAS float* vs) {
    const bf16* QKVB = (const bf16*)(a->ws + WS_QKVB); const float* cw = a->in[I_CONVW] + (size_t)l * 4 * 1536;
    const int cg = c.tid & 15, r0 = c.tid >> 4;
#pragma unroll
    for (int part = 0; part < 3; ++part) {
        const int colb = part * 512 + h * 128 + 8 * cg;
        float w[4][8];
#pragma unroll
        for (int i = 0; i < 4; ++i) { const f32x4 w0 = *(const f32x4*)(cw + i * 1536 + colb), w1 = *(const f32x4*)(cw + i * 1536 + colb + 4);
            w[i][0] = w0.x; w[i][1] = w0.y; w[i][2] = w0.z; w[i][3] = w0.w; w[i][4] = w1.x; w[i][5] = w1.y; w[i][6] = w1.z; w[i][7] = w1.w; }
        LAS float* dst = part == 0 ? qs : part == 1 ? ks : vs;
#pragma unroll
        for (int pass = 0; pass < 2; ++pass) {
            const int r = r0 + 32 * pass, t = t0 + r;
            float y[8];
#pragma unroll
            for (int e = 0; e < 8; ++e) y[e] = 0.f;
#pragma unroll
            for (int i = 0; i < 4; ++i) { const int tt = t - 3 + i; if (tt >= 0) { const v4u x = *(const v4u*)(QKVB + (size_t)(b * SEQ + tt) * 1536 + colb);
                y[0] += w[i][0] * bflo(x.x); y[1] += w[i][1] * bfhi(x.x); y[2] += w[i][2] * bflo(x.y); y[3] += w[i][3] * bfhi(x.y); y[4] += w[i][4] * bflo(x.z); y[5] += w[i][5] * bfhi(x.z); y[6] += w[i][6] * bflo(x.w); y[7] += w[i][7] * bfhi(x.w); } }
            float ss = 0.f;
#pragma unroll
            for (int e = 0; e < 8; ++e) { y[e] = siluf_(y[e]); ss += y[e] * y[e]; }
            if (part < 2) { ss += shx(ss, 1, c.lane); ss += shx(ss, 2, c.lane); ss += shx(ss, 4, c.lane); ss += shx(ss, 8, c.lane);
                const float rs = (1.f / sqrtf(ss + EPS)) * (part == 0 ? 0.08838834764831845f : 1.f);
#pragma unroll
                for (int e = 0; e < 8; ++e) y[e] *= rs; }
            *(LAS f32x4*)(dst + r * LDW + 8 * cg) = (f32x4){y[0], y[1], y[2], y[3]}; *(LAS f32x4*)(dst + r * LDW + 8 * cg + 4) = (f32x4){y[4], y[5], y[6], y[7]};
        }
    }
}
__device__ __forceinline__ void dn_store_chunk(KArgs a, const Ctx& c, int l, int b, int h, int t0, const LAS float* os) {
    const bf16* ZB = (const bf16*)(a->ws + WS_ZB); bf16* YB = (bf16*)(a->ws + WS_YB); const float* onw = a->in[I_ONW] + l * 128;
    const int r = c.tid >> 3, sub = c.tid & 7, tok = b * SEQ + t0 + r;
    float o[16]; float ss = 0.f;
#pragma unroll
    for (int q = 0; q < 4; ++q) { const f32x4 v = *(const LAS f32x4*)(os + r * 128 + sub * 16 + q * 4); o[q * 4] = v.x; o[q * 4 + 1] = v.y; o[q * 4 + 2] = v.z; o[q * 4 + 3] = v.w; ss += (v.x * v.x + v.y * v.y) + (v.z * v.z + v.w * v.w); }
    ss += shx(ss, 1, c.lane); ss += shx(ss, 2, c.lane); ss += shx(ss, 4, c.lane);
    const float rstd = 1.f / sqrtf(ss * (1.f / 128.f) + EPS);
    const bf16* zp = ZB + (size_t)tok * 512 + h * 128 + sub * 16; bf16* yp = YB + (size_t)tok * 512 + h * 128 + sub * 16;
#pragma unroll
    for (int q = 0; q < 2; ++q) { const v4u z = *(const v4u*)(zp + q * 8); const f32x4 w0 = *(const f32x4*)(onw + sub * 16 + q * 8), w1 = *(const f32x4*)(onw + sub * 16 + q * 8 + 4);
        v4u y; y.x = pk2(o[q * 8 + 0] * rstd * w0.x * siluf_(bflo(z.x)), o[q * 8 + 1] * rstd * w0.y * siluf_(bfhi(z.x)));
        y.y = pk2(o[q * 8 + 2] * rstd * w0.z * siluf_(bflo(z.y)), o[q * 8 + 3] * rstd * w0.w * siluf_(bfhi(z.y)));
        y.z = pk2(o[q * 8 + 4] * rstd * w1.x * siluf_(bflo(z.z)), o[q * 8 + 5] * rstd * w1.y * siluf_(bfhi(z.z)));
        y.w = pk2(o[q * 8 + 6] * rstd * w1.z * siluf_(bflo(z.w)), o[q * 8 + 7] * rstd * w1.w * siluf_(bfhi(z.w)));
        *(v4u*)(yp + q * 8) = y; }
}
__device__ __forceinline__ void ph_dn_simple(KArgs a, const Ctx& c, int l) {
    LAS float* qs = (LAS float*)c.lds; LAS float* ks = qs + 8192; LAS float* vs = ks + 8192; LAS float* os = vs + 8192;
    LAS float* bt = (LAS float*)(c.lds + MISC_OFF + 1024); LAS float* at = bt + 64;
    const float* beta = (const float*)(a->ws + WS_BETA); const float* glog = (const float*)(a->ws + WS_GLOG);
    const int v = c.tid >> 2, kq = c.tid & 3;
    for (int item = c.bid; item < NB * HB; item += c.G) {
        const int b = item >> 2, h = item & 3;
        float S[32];
#pragma unroll
        for (int q = 0; q < 32; ++q) S[q] = 0.f;
        for (int n = 0; n < NCH; ++n) {
            const int t0 = n * DNC;
            __syncthreads();
            dn_load_chunk<128>(a, c, l, b, h, t0, qs, ks, vs);
            if (c.tid < 64) { const int tok = b * SEQ + t0 + c.tid; bt[c.tid] = beta[tok * 4 + h]; at[c.tid] = __expf(glog[tok * 4 + h]); }
            __syncthreads();
            for (int tt = 0; tt < DNC; ++tt) {
                const float a_t = at[tt], b_t = bt[tt];
                float kr[32];
#pragma unroll
                for (int q = 0; q < 8; ++q) { const f32x4 k4 = *(const LAS f32x4*)(ks + tt * 128 + kq * 32 + q * 4); kr[q * 4] = k4.x; kr[q * 4 + 1] = k4.y; kr[q * 4 + 2] = k4.z; kr[q * 4 + 3] = k4.w; }
                float kS = 0.f;
#pragma unroll
                for (int q = 0; q < 32; ++q) kS += kr[q] * S[q];
                kS += shx(kS, 1, c.lane); kS += shx(kS, 2, c.lane);
                const float vn = b_t * (vs[tt * 128 + v] - a_t * kS);
                float o = 0.f;
#pragma unroll
                for (int q = 0; q < 8; ++q) { const f32x4 q4 = *(const LAS f32x4*)(qs + tt * 128 + kq * 32 + q * 4);
                    S[q * 4] = a_t * S[q * 4] + kr[q * 4] * vn; S[q * 4 + 1] = a_t * S[q * 4 + 1] + kr[q * 4 + 1] * vn; S[q * 4 + 2] = a_t * S[q * 4 + 2] + kr[q * 4 + 2] * vn; S[q * 4 + 3] = a_t * S[q * 4 + 3] + kr[q * 4 + 3] * vn;
                    o += (q4.x * S[q * 4] + q4.y * S[q * 4 + 1]) + (q4.z * S[q * 4 + 2] + q4.w * S[q * 4 + 3]); }
                o += shx(o, 1, c.lane); o += shx(o, 2, c.lane);
                if (kq == 0) os[tt * 128 + v] = o;
            }
            __syncthreads();
            dn_store_chunk(a, c, l, b, h, t0, os);
        }
    }
}

struct EpiProj {
    static constexpr bool PERM = true, AFTER_DRAIN = false; unsigned char* ws;
    __device__ __forceinline__ void operator()(const pg8::f32x4 (&acc)[2][2][4][2], const pg8::Unit& u, int wr, int wc, int fr, int fq) const {
        const int pn = u.pn; bf16* base; int ld, ct; bool sg = false;
        if (pn < 6) { base = (bf16*)(ws + WS_QKVA); ld = 1536; ct = pn; } else if (pn < 12) { base = (bf16*)(ws + WS_QKVB); ld = 1536; ct = pn - 6; }
        else if (pn < 14) { base = (bf16*)(ws + WS_ZB); ld = 512; ct = pn - 12; } else { base = (bf16*)(ws + WS_GATES); ld = 2048; ct = pn - 14; sg = true; }
        const int row0 = u.pm * 256 + wr * 64 + fr, col0 = ct * 256 + wc * 32 + 8 * fq;
#pragma unroll
        for (int ai = 0; ai < 2; ++ai)
#pragma unroll
            for (int m = 0; m < 4; ++m) { bf16* rowp = base + (size_t)(row0 + ai * 128 + m * 16) * ld + col0;
#pragma unroll
                for (int bj = 0; bj < 2; ++bj) { f32x4 v0 = acc[ai][bj][m][0], v1 = acc[ai][bj][m][1];
                    if (sg) { v0.x = sigmoidf_(v0.x); v0.y = sigmoidf_(v0.y); v0.z = sigmoidf_(v0.z); v0.w = sigmoidf_(v0.w); v1.x = sigmoidf_(v1.x); v1.y = sigmoidf_(v1.y); v1.z = sigmoidf_(v1.z); v1.w = sigmoidf_(v1.w); }
                    v4u w; w.x = pk2(v0.x, v0.y); w.y = pk2(v0.z, v0.w); w.z = pk2(v1.x, v1.y); w.w = pk2(v1.z, v1.w);
                    *(v4u*)(rowp + bj * 128) = w; } }
    }
};
template <bool SECOND> struct EpiMerge {
    static constexpr bool PERM = true, AFTER_DRAIN = false; unsigned char* ws;
    __device__ __forceinline__ void operator()(const pg8::f32x4 (&acc)[2][2][4][2], const pg8::Unit& u, int wr, int wc, int fr, int fq) const {
        bf16* M = (bf16*)(ws + WS_M); const bf16* GT = (const bf16*)(ws + WS_GATES) + (SECOND ? 1024 : 0);
        const int row0 = u.pm * 256 + wr * 64 + fr, col0 = u.pn * 256 + wc * 32 + 8 * fq;
#pragma unroll
        for (int ai = 0; ai < 2; ++ai)
#pragma unroll
            for (int m = 0; m < 4; ++m) { const size_t row = row0 + ai * 128 + m * 16;
#pragma unroll
                for (int bj = 0; bj < 2; ++bj) { const int col = col0 + bj * 128; const f32x4 v0 = acc[ai][bj][m][0], v1 = acc[ai][bj][m][1];
                    const v4u g = *(const v4u*)(GT + row * 2048 + col);
                    float o[8] = {bflo(g.x) * v0.x, bfhi(g.x) * v0.y, bflo(g.y) * v0.z, bfhi(g.y) * v0.w, bflo(g.z) * v1.x, bfhi(g.z) * v1.y, bflo(g.w) * v1.z, bfhi(g.w) * v1.w};
                    if (SECOND) { const v4u p = *(const v4u*)(M + row * 1024 + col); o[0] += bflo(p.x); o[1] += bfhi(p.x); o[2] += bflo(p.y); o[3] += bfhi(p.y); o[4] += bflo(p.z); o[5] += bfhi(p.z); o[6] += bflo(p.w); o[7] += bfhi(p.w); }
                    v4u w; w.x = pk2(o[0], o[1]); w.y = pk2(o[2], o[3]); w.z = pk2(o[4], o[5]); w.w = pk2(o[6], o[7]);
                    *(v4u*)(M + row * 1024 + col) = w; } }
    }
};
struct EpiOut {
    static constexpr bool PERM = true, AFTER_DRAIN = false; const float* xin; float* xout; const float* g1;
    __device__ __forceinline__ void operator()(const pg8::f32x4 (&acc)[2][2][4][2], const pg8::Unit& u, int wr, int wc, int fr, int fq) const {
        const int row0 = u.pm * 256 + wr * 64 + fr, col0 = u.pn * 256 + wc * 32 + 8 * fq; const int b = (u.pm * 256) >> 12;
#pragma unroll
        for (int bj = 0; bj < 2; ++bj) { const int col = col0 + bj * 128; const f32x4 ga = *(const f32x4*)(g1 + b * 6144 + col), gb = *(const f32x4*)(g1 + b * 6144 + col + 4);
#pragma unroll
            for (int ai = 0; ai < 2; ++ai)
#pragma unroll
                for (int m = 0; m < 4; ++m) { const size_t off = (size_t)(row0 + ai * 128 + m * 16) * DM + col;
                    const f32x4 x0 = *(const f32x4*)(xin + off), x1 = *(const f32x4*)(xin + off + 4);
                    *(f32x4*)(xout + off) = x0 + ga * acc[ai][bj][m][0]; *(f32x4*)(xout + off + 4) = x1 + gb * acc[ai][bj][m][1]; } }
    }
};
struct EpiMoeGU {
    static constexpr bool PERM = true, AFTER_DRAIN = false; unsigned char* ws;
    __device__ __forceinline__ void operator()(const pg8::f32x4 (&acc)[2][2][4][2], const pg8::Unit& u, int wr, int wc, int fr, int fq) const {
        bf16* ACT = (bf16*)(ws + WS_ACT);
        const int row0 = u.pm * 256 + wr * 64 + fr, col0 = (u.pn & 1) * 128 + wc * 32 + 8 * fq;
#pragma unroll
        for (int ai = 0; ai < 2; ++ai)
#pragma unroll
            for (int m = 0; m < 4; ++m) { const f32x4 g0 = acc[ai][0][m][0], g1 = acc[ai][0][m][1], u0 = acc[ai][1][m][0], u1 = acc[ai][1][m][1];
                v4u w; w.x = pk2(siluf_(g0.x) * u0.x, siluf_(g0.y) * u0.y); w.y = pk2(siluf_(g0.z) * u0.z, siluf_(g0.w) * u0.w); w.z = pk2(siluf_(g1.x) * u1.x, siluf_(g1.y) * u1.y); w.w = pk2(siluf_(g1.z) * u1.z, siluf_(g1.w) * u1.w);
                *(v4u*)(ACT + (size_t)(row0 + ai * 128 + m * 16) * 256 + col0) = w; }
    }
};
struct EpiMoeDown {
    static constexpr bool PERM = true, AFTER_DRAIN = false; unsigned char* ws;
    __device__ __forceinline__ void operator()(const pg8::f32x4 (&acc)[2][2][4][2], const pg8::Unit& u, int wr, int wc, int fr, int fq) const {
        bf16* YS = (bf16*)(ws + WS_YS); const int* rowtok = (const int*)(ws + WS_ROWTOK); const float* roww = (const float*)(ws + WS_ROWW);
        const int row0 = u.pm * 256 + wr * 64 + fr, col0 = (u.pn & 3) * 256 + wc * 32 + 8 * fq;
#pragma unroll
        for (int ai = 0; ai < 2; ++ai)
#pragma unroll
            for (int m = 0; m < 4; ++m) { const int row = row0 + ai * 128 + m * 16; const int rt = rowtok[row]; const float wgt = roww[row];
                if (rt >= 0) {
#pragma unroll
                    for (int bj = 0; bj < 2; ++bj) { const f32x4 v0 = acc[ai][bj][m][0] * wgt, v1 = acc[ai][bj][m][1] * wgt;
                        v4u w; w.x = pk2(v0.x, v0.y); w.y = pk2(v0.z, v0.w); w.z = pk2(v1.x, v1.y); w.w = pk2(v1.z, v1.w);
                        *(v4u*)(YS + (size_t)rt * 1024 + col0 + bj * 128) = w; } } }
    }
};
struct MoeOrder {
    const LAS int* tile_exp; int nunits, G, c, sh;
    __device__ __forceinline__ bool next(int i, pg8::Unit& u) const {
        const int L = i * G + c; if (L >= nunits) return false;
        const int r = L >> sh, j = L & ((1 << sh) - 1);
        u.pm = r; u.pn = __builtin_amdgcn_readfirstlane((tile_exp[r] << sh) + j); return true;
    }
    __device__ __forceinline__ void a_ready(const pg8::Unit&) const {}
    __device__ __forceinline__ void done(const pg8::Unit&) const {}
};

__device__ __forceinline__ void ph_router(KArgs a, const Ctx& c, int l) {
    LAS int* lcnt = (LAS int*)(c.lds);
    LAS int* lbase = lcnt + 32;
    LAS int* tinf = lcnt + 64;
    const int lane = c.lane;
    bf16* H2 = (bf16*)(a->ws + WS_H); unsigned* tokinfo = (unsigned*)(a->ws + WS_TOKINFO); int* rowtok = (int*)(a->ws + WS_ROWTOK);
    unsigned* gcnt = (unsigned*)(a->ws + WS_CTL) + CW_GCNT + l * 32;
    const float* n2w = a->in[I_N2W] + l * DM; const float* wrg = a->in[I_WRG] + (size_t)l * 1024 * 4; const float* wre = a->in[I_WRE] + (size_t)l * 1024 * 32;
    for (int i = c.bid * NTHR + c.tid; i < MOE_MAXROWS; i += c.G * NTHR) rowtok[i] = -1;
    for (int tb = c.bid; tb < NTOK / 64; tb += c.G) {
        __syncthreads();
        if (c.tid < 32) lcnt[c.tid] = 0;
        __syncthreads();
        for (int i = 0; i < 8; ++i) {
            const int tl = c.wave * 8 + i, m = tb * 64 + tl, b = m >> 12;
            const float* xr = (const float*)a->out + (size_t)m * DM; const float* mod = (const float*)(a->ws + WS_MOD) + (l * 4 + b) * 6144;
            f32x4 h[4];
#pragma unroll
            for (int j = 0; j < 4; ++j) h[j] = *(const f32x4*)(xr + 256 * j + 4 * lane);
            const float rstd = row_rstd(h, lane);
            float ag[4] = {0.f, 0.f, 0.f, 0.f};
#pragma unroll
            for (int j = 0; j < 4; ++j) { const int col = 256 * j + 4 * lane;
                const f32x4 nw = *(const f32x4*)(n2w + col), sh = *(const f32x4*)(mod + 3072 + col), sc = *(const f32x4*)(mod + 4096 + col);
                h[j] = h[j] * rstd * nw * (sc + 1.0f) + sh;
                v2u o; o.x = pk2(h[j].x, h[j].y); o.y = pk2(h[j].z, h[j].w); *(v2u*)(H2 + (size_t)m * DM + col) = o;
                const f32x4 r0 = *(const f32x4*)(wrg + (size_t)(col + 0) * 4), r1 = *(const f32x4*)(wrg + (size_t)(col + 1) * 4), r2 = *(const f32x4*)(wrg + (size_t)(col + 2) * 4), r3 = *(const f32x4*)(wrg + (size_t)(col + 3) * 4);
                ag[0] += h[j].x * r0.x + h[j].y * r1.x + h[j].z * r2.x + h[j].w * r3.x; ag[1] += h[j].x * r0.y + h[j].y * r1.y + h[j].z * r2.y + h[j].w * r3.y;
                ag[2] += h[j].x * r0.z + h[j].y * r1.z + h[j].z * r2.z + h[j].w * r3.z; ag[3] += h[j].x * r0.w + h[j].y * r1.w + h[j].z * r2.w + h[j].w * r3.w; }
#pragma unroll
            for (int q = 0; q < 4; ++q) ag[q] = wave_sum(ag[q], lane) + a->in[I_BRG][l * 4 + q];
            int g = 0; float gm = ag[0];
#pragma unroll
            for (int q = 1; q < 4; ++q) if (ag[q] > gm) { gm = ag[q]; g = q; }
            float den = 0.f;
#pragma unroll
            for (int q = 0; q < 4; ++q) den += __expf(ag[q] - gm);
            const float ptop = 1.f / den;
            float ae[8] = {0.f, 0.f, 0.f, 0.f, 0.f, 0.f, 0.f, 0.f};
#pragma unroll
            for (int j = 0; j < 4; ++j) { const int col = 256 * j + 4 * lane; const float hv[4] = {h[j].x, h[j].y, h[j].z, h[j].w};
#pragma unroll
                for (int e = 0; e < 4; ++e) { const float* wr_ = wre + (size_t)(col + e) * 32 + g * 8; const f32x4 w0 = *(const f32x4*)wr_, w1 = *(const f32x4*)(wr_ + 4);
                    ae[0] += hv[e] * w0.x; ae[1] += hv[e] * w0.y; ae[2] += hv[e] * w0.z; ae[3] += hv[e] * w0.w; ae[4] += hv[e] * w1.x; ae[5] += hv[e] * w1.y; ae[6] += hv[e] * w1.z; ae[7] += hv[e] * w1.w; } }
#pragma unroll
            for (int q = 0; q < 8; ++q) ae[q] = wave_sum(ae[q], lane) + a->in[I_BRE][l * 32 + g * 8 + q];
            int e0 = 0; float v0 = ae[0];
#pragma unroll
            for (int q = 1; q < 8; ++q) if (ae[q] > v0) { v0 = ae[q]; e0 = q; }
            int e1 = -1; float v1 = -3e38f;
#pragma unroll
            for (int q = 0; q < 8; ++q) if (q != e0 && ae[q] > v1) { v1 = ae[q]; e1 = q; }
            const float ex = __expf(v1 - v0); const float w0 = ptop / (1.f + ex), w1 = ptop * ex / (1.f + ex);
            if (lane == 0) { const int E0 = g * 8 + e0, E1 = g * 8 + e1;
                const int r0 = atomicAdd((int*)(lcnt + E0), 1), r1 = atomicAdd((int*)(lcnt + E1), 1);
                tinf[tl * 6 + 0] = E0; tinf[tl * 6 + 1] = E1; tinf[tl * 6 + 2] = r0; tinf[tl * 6 + 3] = r1; tinf[tl * 6 + 4] = __float_as_int(w0); tinf[tl * 6 + 5] = __float_as_int(w1); }
        }
        __syncthreads();
        if (c.tid < 32) lbase[c.tid] = (int)__hip_atomic_fetch_add(gcnt + c.tid, (unsigned)lcnt[c.tid], RLX_AGENT);
        __syncthreads();
        if (c.tid < 64) { const int m = tb * 64 + c.tid; const int E0 = tinf[c.tid * 6], E1 = tinf[c.tid * 6 + 1];
            v4u o; o.x = (unsigned)E0; o.y = (unsigned)E1; o.z = (unsigned)(lbase[E0] + tinf[c.tid * 6 + 2]); o.w = (unsigned)(lbase[E1] + tinf[c.tid * 6 + 3]);
            *(v4u*)(tokinfo + (size_t)m * 8) = o; *(v2u*)(tokinfo + (size_t)m * 8 + 4) = (v2u){(unsigned)tinf[c.tid * 6 + 4], (unsigned)tinf[c.tid * 6 + 5]}; }
    }
}
__device__ __forceinline__ void moe_table(KArgs a, const Ctx& c, int l) {
    LAS int* tile_exp = (LAS int*)(c.lds + MISC_OFF + 2048); LAS int* offs = tile_exp + 192; LAS int* ntl = offs + 32; LAS int* pre = ntl + 4;
    const unsigned* gcnt = (const unsigned*)(a->ws + WS_CTL) + CW_GCNT + l * 32;
    __syncthreads();
    if (c.tid < 64) { const int e = c.tid & 31; const int cnt = (int)__hip_atomic_load(gcnt + e, RLX_AGENT); const int nt = (cnt + 255) >> 8; int inc = nt;
#pragma unroll
        for (int o = 1; o < 32; o <<= 1) { const int v = shidx_i(inc, (c.lane - o) & 63); if (e >= o) inc += v; }
        if (c.tid < 32) { offs[e] = (inc - nt) * 256; pre[e] = inc; if (e == 31) ntl[0] = inc; } }
    __syncthreads();
    if (c.tid < MOE_MAXTILES) { int E = 0;
#pragma unroll
        for (int e = 0; e < 32; ++e) E += (pre[e] <= c.tid) ? 1 : 0;
        tile_exp[c.tid] = E < 31 ? E : 31; }
    __syncthreads();
}
__device__ __forceinline__ void ph_gather(KArgs a, const Ctx& c, int l) {
    moe_table(a, c, l);
    const LAS int* offs = (const LAS int*)(c.lds + MISC_OFF + 2048) + 192;
    const int gw = c.bid * NW + c.wave, NGW = c.G * NW, lane = c.lane;
    const bf16* H2 = (const bf16*)(a->ws + WS_H); bf16* HS = (bf16*)(a->ws + WS_HS); const unsigned* tokinfo = (const unsigned*)(a->ws + WS_TOKINFO);
    int* rowtok = (int*)(a->ws + WS_ROWTOK); float* roww = (float*)(a->ws + WS_ROWW);
    for (int m = gw; m < NTOK; m += NGW) {
        const v4u ti = *(const v4u*)(tokinfo + (size_t)m * 8); const v2u tw = *(const v2u*)(tokinfo + (size_t)m * 8 + 4);
        const int d0 = offs[ti.x] + (int)ti.z, d1 = offs[ti.y] + (int)ti.w;
        const v4u x0 = *(const v4u*)(H2 + (size_t)m * DM + lane * 8), x1 = *(const v4u*)(H2 + (size_t)m * DM + 512 + lane * 8);
        *(v4u*)(HS + (size_t)d0 * DM + lane * 8) = x0; *(v4u*)(HS + (size_t)d0 * DM + 512 + lane * 8) = x1;
        *(v4u*)(HS + (size_t)d1 * DM + lane * 8) = x0; *(v4u*)(HS + (size_t)d1 * DM + 512 + lane * 8) = x1;
        if (lane == 0) { rowtok[d0] = m * 2; rowtok[d1] = m * 2 + 1; roww[d0] = __uint_as_float(tw.x); roww[d1] = __uint_as_float(tw.y); }
    }
}
constexpr int DN_IMG = 57344, DN_LDW = 132, DN_LDA = 68;
typedef __bf16 bf16x2_t __attribute__((ext_vector_type(2)));
typedef float f32x2_t __attribute__((ext_vector_type(2)));
__device__ __forceinline__ unsigned cvtpk(float lo, float hi) { f32x2_t v = {lo, hi}; bf16x2_t b = __builtin_convertvector(v, bf16x2_t); return __builtin_bit_cast(unsigned, b); }
__device__ __forceinline__ bf16x8 pack8(f32x4 a, f32x4 b) { v4u w; w.x = cvtpk(a.x, a.y); w.y = cvtpk(a.z, a.w); w.z = cvtpk(b.x, b.y); w.w = cvtpk(b.z, b.w); return __builtin_bit_cast(bf16x8, w); }
#define MFMA16(a, b, c) __builtin_amdgcn_mfma_f32_16x16x32_bf16((a), (b), (c), 0, 0, 0)

__device__ __forceinline__ void ph_dn_prep(KArgs a, const Ctx& c, int l) {
    LAS float* qs = (LAS float*)c.lds; LAS float* ks = qs + 64 * DN_LDW; LAS float* vs = ks + 64 * DN_LDW;
    LAS float* Am = vs + 64 * DN_LDW; LAS float* Pm = Am + 64 * DN_LDA;
    LAS float* bt = (LAS float*)(c.lds + MISC_OFF + 1024); LAS float* Gc = bt + 64;
    const float* beta = (const float*)(a->ws + WS_BETA); const float* glog = (const float*)(a->ws + WS_GLOG);
    const int lane = c.lane, row = lane & 15, quad = lane >> 4, tid = c.tid;
    for (int item = c.bid; item < NB * HB * NCH; item += c.G) {
        const int n = item & 63, h = (item >> 6) & 3, b = item >> 8, t0 = n * DNC;
        unsigned char* img = a->ws + WS_IMG + (size_t)item * DN_IMG;
        __syncthreads();
        dn_load_chunk<DN_LDW>(a, c, l, b, h, t0, qs, ks, vs);
        if (tid < 64) { const int tok = b * SEQ + t0 + tid; bt[tid] = beta[tok * 4 + h]; float g = glog[tok * 4 + h];
#pragma unroll
            for (int o = 1; o < 64; o <<= 1) { const float v = shidx(g, (lane - o) & 63); if (lane >= o) g += v; }
            Gc[tid] = g; }
        __syncthreads();
        {   const int sel = c.wave >> 2, ti = c.wave & 3; const LAS float* rs = sel == 0 ? ks : qs; LAS float* dstm = sel == 0 ? Am : Pm;
            bf16x8 af[4];
#pragma unroll
            for (int s = 0; s < 4; ++s) { const LAS float* p = rs + (ti * 16 + row) * DN_LDW + 32 * s + 8 * quad; af[s] = pack8(*(const LAS f32x4*)p, *(const LAS f32x4*)(p + 4)); }
            for (int tj = 0; tj < 4; ++tj) {
                f32x4 acc = {0.f, 0.f, 0.f, 0.f};
                if (tj <= ti) {
#pragma unroll
                    for (int s = 0; s < 4; ++s) { const LAS float* p = ks + (tj * 16 + row) * DN_LDW + 32 * s + 8 * quad; const bf16x8 bfr = pack8(*(const LAS f32x4*)p, *(const LAS f32x4*)(p + 4)); acc = MFMA16(af[s], bfr, acc); }
                }
                const int j = tj * 16 + row; const float Gj = Gc[j];
#pragma unroll
                for (int r = 0; r < 4; ++r) { const int i = ti * 16 + 4 * quad + r; const float dec = __expf(fminf(Gc[i] - Gj, 0.f));
                    float v = acc[r] * dec; if (sel == 0) v = (j < i) ? v * bt[i] : 0.f; else v = (j <= i) ? v : 0.f;
                    if (sel == 0) dstm[j * DN_LDA + i] = v; else dstm[i * DN_LDA + j] = v; }
            }
        }
        __syncthreads();
        const float Glast = Gc[63];
        {
            for (int q = 0; q < 5; ++q) { const int p = tid + 512 * q, blk = p >> 6; float v[8];
                if (blk < 16) { const int mt = blk >> 2, s = blk & 3, cr = 16 * mt + row, k0 = 32 * s + 4 * quad; const float e = __expf(Gc[cr]);
                    const f32x4 v0 = *(const LAS f32x4*)(qs + cr * DN_LDW + k0), v1 = *(const LAS f32x4*)(qs + cr * DN_LDW + k0 + 16);
                    v[0] = v0.x * e; v[1] = v0.y * e; v[2] = v0.z * e; v[3] = v0.w * e; v[4] = v1.x * e; v[5] = v1.y * e; v[6] = v1.z * e; v[7] = v1.w * e; }
                else if (blk < 32) { const int b2 = blk - 16, mt = b2 >> 1, s = b2 & 1, k = 16 * mt + row;
#pragma unroll
                    for (int j = 0; j < 8; ++j) { const int cj = 32 * s + 16 * (j >> 2) + 4 * quad + (j & 3); v[j] = ks[cj * DN_LDW + k] * __expf(Glast - Gc[cj]); } }
                else { const int b3 = blk - 32, mt = b3 >> 1, s = b3 & 1, i = 16 * mt + row, c0 = 32 * s + 4 * quad;
                    const f32x4 v0 = *(const LAS f32x4*)(Pm + i * DN_LDA + c0), v1 = *(const LAS f32x4*)(Pm + i * DN_LDA + c0 + 16);
                    v[0] = v0.x; v[1] = v0.y; v[2] = v0.z; v[3] = v0.w; v[4] = v1.x; v[5] = v1.y; v[6] = v1.z; v[7] = v1.w; }
                v4u w; w.x = cvtpk(v[0], v[1]); w.y = cvtpk(v[2], v[3]); w.z = cvtpk(v[4], v[5]); w.w = cvtpk(v[6], v[7]);
                *(v4u*)(img + 16384 + (size_t)p * 16) = w; }
            if (tid == 0) ((float*)(a->ws + WS_GL))[item] = __expf(Glast);
        }
        __syncthreads();
        if (tid < 256) {
            int vz = 0; asm volatile("" : "+v"(vz));
            const LAS float* AT = Am + vz; const LAS float* btV = bt + vz; const LAS float* GcV = Gc + vz;
            const bool isw = tid >= 128; LAS float* xc = (isw ? ks : vs) + (tid & 127);
#pragma unroll
            for (int bI = 0; bI < 4; ++bI) {
                float s[16];
#pragma unroll
                for (int r = 0; r < 16; ++r) { const int i = 16 * bI + r; float rhs = xc[i * DN_LDW] * btV[i]; if (isw) rhs *= __expf(GcV[i]); s[r] = rhs; }
                for (int j = 0; j < 16 * bI; ++j) { const float xj = xc[j * DN_LDW]; const LAS float* ap = AT + j * DN_LDA + 16 * bI;
#pragma unroll
                    for (int q = 0; q < 4; ++q) { const f32x4 a4 = *(const LAS f32x4*)(ap + 4 * q); s[4 * q] -= a4.x * xj; s[4 * q + 1] -= a4.y * xj; s[4 * q + 2] -= a4.z * xj; s[4 * q + 3] -= a4.w * xj; } }
#pragma unroll
                for (int rp = 0; rp < 15; ++rp) { const LAS float* ap = AT + (16 * bI + rp) * DN_LDA + 16 * bI;
#pragma unroll
                    for (int q = (rp + 1) / 4; q < 4; ++q) { const f32x4 a4 = *(const LAS f32x4*)(ap + 4 * q);
                        if (4 * q + 0 > rp) s[4 * q + 0] -= a4.x * s[rp]; if (4 * q + 1 > rp) s[4 * q + 1] -= a4.y * s[rp]; if (4 * q + 2 > rp) s[4 * q + 2] -= a4.z * s[rp]; if (4 * q + 3 > rp) s[4 * q + 3] -= a4.w * s[rp]; } }
#pragma unroll
                for (int r = 0; r < 16; ++r) xc[(16 * bI + r) * DN_LDW] = s[r];
            }
        }
        __syncthreads();
#pragma unroll
        for (int q = 0; q < 2; ++q) { const int p = tid + 512 * q, blk = p >> 6, mt = blk >> 2, s = blk & 3, cr = 16 * mt + row, k0 = 32 * s + 4 * quad;
            const f32x4 v0 = *(const LAS f32x4*)(ks + cr * DN_LDW + k0), v1 = *(const LAS f32x4*)(ks + cr * DN_LDW + k0 + 16);
            v4u w; w.x = cvtpk(-v0.x, -v0.y); w.y = cvtpk(-v0.z, -v0.w); w.z = cvtpk(-v1.x, -v1.y); w.w = cvtpk(-v1.z, -v1.w);
            *(v4u*)(img + (size_t)p * 16) = w; }
        {   unsigned char* ug = a->ws + WS_U + (size_t)item * 16384;
#pragma unroll
            for (int q = 0; q < 2; ++q) { const int p = tid + 512 * q, sl = p >> 7, ln = (p >> 1) & 63, hh = p & 1, v = 16 * sl + (ln & 15), qd = ln >> 4; float u8[8];
#pragma unroll
                for (int e = 0; e < 8; ++e) u8[e] = vs[(16 * (2 * hh + (e >> 2)) + 4 * qd + (e & 3)) * DN_LDW + v];
                v4u w; w.x = cvtpk(u8[0], u8[1]); w.y = cvtpk(u8[2], u8[3]); w.z = cvtpk(u8[4], u8[5]); w.w = cvtpk(u8[6], u8[7]);
                *(v4u*)(ug + (size_t)(sl * 64 + ln) * 32 + hh * 16) = w; } }
    }
}

__device__ __forceinline__ void ph_dn_scan(KArgs a, const Ctx& c, int l) {
    LAS unsigned char* lds = c.lds; LAS unsigned short* os = (LAS unsigned short*)(lds + 2 * DN_IMG);
    const int lane = c.lane, wv = c.wave, tid = c.tid;
    const bf16* ZB = (const bf16*)(a->ws + WS_ZB); bf16* YB = (bf16*)(a->ws + WS_YB); const float* onw = a->in[I_ONW] + l * 128; const float* glp = (const float*)(a->ws + WS_GL);
    for (int item = c.bid; item < NB * HB; item += c.G) {
        const int b = item >> 2, h = item & 3;
        const unsigned char* img0 = a->ws + WS_IMG + (size_t)item * 64 * DN_IMG; const unsigned char* ugb = a->ws + WS_U + (size_t)item * 64 * 16384; const unsigned uoff = (unsigned)(wv * 64 + lane) * 32u;
        const int nr = tid >> 3, nsub = tid & 7;
        const unsigned zoff = (unsigned)(nr * 512 + nsub * 16);
        const bf16* zpb = ZB + (size_t)(b * SEQ) * 512 + h * 128; bf16* ypb = YB + (size_t)(b * SEQ) * 512 + h * 128;
#define ug0 (ugb + uoff)
#define zp0 (zpb + zoff)
#define yp0 (ypb + zoff)
        f32x4 S[8];
#pragma unroll
        for (int m = 0; m < 8; ++m) S[m] = (f32x4){0.f, 0.f, 0.f, 0.f};
        __syncthreads();
#define DN_DMA(n, buf) do { _Pragma("unroll") for (int q_ = 0; q_ < 7; ++q_) { const int pc_ = wv + 8 * q_; \
            __builtin_amdgcn_global_load_lds((const unsigned*)(img0 + (size_t)(n) * DN_IMG + pc_ * 1024 + lane * 16), (LAS unsigned*)(lds + (buf) * DN_IMG + pc_ * 1024), 16, 0, 0); } } while (0)
        DN_DMA(0, 0);
        v4u ucur0 = *(const v4u*)ug0, ucur1 = *(const v4u*)(ug0 + 16);
        v4u zc0 = *(const v4u*)zp0, zc1 = *(const v4u*)(zp0 + 8);
        float glc = glp[item * 64];
        for (int n = 0; n < NCH; ++n) {
            asm volatile("s_waitcnt vmcnt(0)" ::: "memory"); __syncthreads();
            v4u un0 = ucur0, un1 = ucur1, zn0 = zc0, zn1 = zc1; float gln = glc;
            if (n + 1 < NCH) { DN_DMA(n + 1, (n + 1) & 1); un0 = *(const v4u*)(ug0 + (size_t)(n + 1) * 16384); un1 = *(const v4u*)(ug0 + (size_t)(n + 1) * 16384 + 16);
                zn0 = *(const v4u*)(zp0 + (size_t)(n + 1) * DNC * 512); zn1 = *(const v4u*)(zp0 + (size_t)(n + 1) * DNC * 512 + 8); gln = glp[item * 64 + n + 1]; }
            asm volatile("" ::: "memory");
            const LAS unsigned char* im = lds + (n & 1) * DN_IMG + lane * 16;
            bf16x8 Sb[4];
#pragma unroll
            for (int s = 0; s < 4; ++s) Sb[s] = pack8(S[2 * s], S[2 * s + 1]);
            f32x4 X[4], O[4];
            X[0] = (f32x4){bflo(ucur0.x), bfhi(ucur0.x), bflo(ucur0.y), bfhi(ucur0.y)}; X[1] = (f32x4){bflo(ucur0.z), bfhi(ucur0.z), bflo(ucur0.w), bfhi(ucur0.w)};
            X[2] = (f32x4){bflo(ucur1.x), bfhi(ucur1.x), bflo(ucur1.y), bfhi(ucur1.y)}; X[3] = (f32x4){bflo(ucur1.z), bfhi(ucur1.z), bflo(ucur1.w), bfhi(ucur1.w)};
            bf16x8 fa[8], fb[8];
#define DN_LDF(arr, off) do { _Pragma("unroll") for (int q_ = 0; q_ < 8; ++q_) arr[q_] = *(const LAS bf16x8*)(im + (off) + q_ * 1024); } while (0)
            DN_LDF(fa, 0); DN_LDF(fb, 8192);
#pragma unroll
            for (int mt = 0; mt < 2; ++mt)
#pragma unroll
                for (int s = 0; s < 4; ++s) X[mt] = MFMA16(fa[mt * 4 + s], Sb[s], X[mt]);
            DN_LDF(fa, 16384);
#pragma unroll
            for (int mt = 0; mt < 2; ++mt)
#pragma unroll
                for (int s = 0; s < 4; ++s) X[2 + mt] = MFMA16(fb[mt * 4 + s], Sb[s], X[2 + mt]);
            DN_LDF(fb, 16384 + 8192);
#pragma unroll
            for (int mt = 0; mt < 2; ++mt) { O[mt] = (f32x4){0.f, 0.f, 0.f, 0.f};
#pragma unroll
                for (int s = 0; s < 4; ++s) O[mt] = MFMA16(fa[mt * 4 + s], Sb[s], O[mt]); }
            DN_LDF(fa, 32768);
#pragma unroll
            for (int mt = 0; mt < 2; ++mt) { O[2 + mt] = (f32x4){0.f, 0.f, 0.f, 0.f};
#pragma unroll
                for (int s = 0; s < 4; ++s) O[2 + mt] = MFMA16(fb[mt * 4 + s], Sb[s], O[2 + mt]); }
            DN_LDF(fb, 32768 + 8192);
            bf16x8 Xb[2];
            Xb[0] = pack8(X[0], X[1]); Xb[1] = pack8(X[2], X[3]);
#pragma unroll
            for (int m = 0; m < 4; ++m) { S[m] = S[m] * glc;
#pragma unroll
                for (int s = 0; s < 2; ++s) S[m] = MFMA16(fa[m * 2 + s], Xb[s], S[m]); }
            DN_LDF(fa, 49152);
#pragma unroll
            for (int m = 0; m < 4; ++m) { S[4 + m] = S[4 + m] * glc;
#pragma unroll
                for (int s = 0; s < 2; ++s) S[4 + m] = MFMA16(fb[m * 2 + s], Xb[s], S[4 + m]); }
#pragma unroll
            for (int mt = 0; mt < 4; ++mt)
#pragma unroll
                for (int s = 0; s < 2; ++s) O[mt] = MFMA16(fa[mt * 2 + s], Xb[s], O[mt]);
#undef DN_LDF
#pragma unroll
            for (int mt = 0; mt < 4; ++mt)
#pragma unroll
                for (int r = 0; r < 4; ++r) os[(16 * mt + 4 * (lane >> 4) + r) * 128 + 16 * wv + (lane & 15)] = (unsigned short)(cvtpk(O[mt][r], 0.f) & 0xffffu);
            asm volatile("s_waitcnt lgkmcnt(0)\n\ts_barrier" ::: "memory");
            {
                float o[16]; float ss = 0.f; f32x4 ow[4];
#pragma unroll
                for (int q = 0; q < 4; ++q) ow[q] = *(const f32x4*)(onw + nsub * 16 + q * 4);
                const v4u o0 = *(const LAS v4u*)(os + nr * 128 + nsub * 16), o1 = *(const LAS v4u*)(os + nr * 128 + nsub * 16 + 8);
                o[0] = bflo(o0.x); o[1] = bfhi(o0.x); o[2] = bflo(o0.y); o[3] = bfhi(o0.y); o[4] = bflo(o0.z); o[5] = bfhi(o0.z); o[6] = bflo(o0.w); o[7] = bfhi(o0.w);
                o[8] = bflo(o1.x); o[9] = bfhi(o1.x); o[10] = bflo(o1.y); o[11] = bfhi(o1.y); o[12] = bflo(o1.z); o[13] = bfhi(o1.z); o[14] = bflo(o1.w); o[15] = bfhi(o1.w);
#pragma unroll
                for (int e = 0; e < 16; ++e) ss += o[e] * o[e];
                ss += shx(ss, 1, lane); ss += shx(ss, 2, lane); ss += shx(ss, 4, lane);
                const float rstd = 1.f / sqrtf(ss * (1.f / 128.f) + EPS);
                bf16* yp = yp0 + (size_t)n * DNC * 512;
                v4u y; y.x = cvtpk(o[0] * rstd * ow[0].x * siluf_(bflo(zc0.x)), o[1] * rstd * ow[0].y * siluf_(bfhi(zc0.x))); y.y = cvtpk(o[2] * rstd * ow[0].z * siluf_(bflo(zc0.y)), o[3] * rstd * ow[0].w * siluf_(bfhi(zc0.y)));
                y.z = cvtpk(o[4] * rstd * ow[1].x * siluf_(bflo(zc0.z)), o[5] * rstd * ow[1].y * siluf_(bfhi(zc0.z))); y.w = cvtpk(o[6] * rstd * ow[1].z * siluf_(bflo(zc0.w)), o[7] * rstd * ow[1].w * siluf_(bfhi(zc0.w)));
                *(v4u*)yp = y;
                y.x = cvtpk(o[8] * rstd * ow[2].x * siluf_(bflo(zc1.x)), o[9] * rstd * ow[2].y * siluf_(bfhi(zc1.x))); y.y = cvtpk(o[10] * rstd * ow[2].z * siluf_(bflo(zc1.y)), o[11] * rstd * ow[2].w * siluf_(bfhi(zc1.y)));
                y.z = cvtpk(o[12] * rstd * ow[3].x * siluf_(bflo(zc1.z)), o[13] * rstd * ow[3].y * siluf_(bfhi(zc1.z))); y.w = cvtpk(o[14] * rstd * ow[3].z * siluf_(bflo(zc1.w)), o[15] * rstd * ow[3].w * siluf_(bfhi(zc1.w)));
                *(v4u*)(yp + 8) = y;
            }
            ucur0 = un0; ucur1 = un1; zc0 = zn0; zc1 = zn1; glc = gln;
        }
        asm volatile("s_waitcnt vmcnt(0)" ::: "memory"); __syncthreads();
#undef DN_DMA
#undef ug0
#undef zp0
#undef yp0
    }
}
typedef short v4i16_t __attribute__((ext_vector_type(4)));
#define MFMA32(a, b, c) __builtin_amdgcn_mfma_f32_32x32x16_bf16((a), (b), (c), 0, 0, 0)
constexpr int AT_ROWB = 144;
constexpr int AT_K = 0, AT_V = 2 * 64 * AT_ROWB, AT_OST = 4 * 64 * AT_ROWB, AT_BT = AT_OST + 8 * 32 * AT_ROWB, AT_KM = AT_BT + 1024, AT_UW = AT_KM + 4096;
__device__ __forceinline__ int crow(int r, int hi) { return (r & 3) + 8 * (r >> 2) + 4 * hi; }
__device__ __forceinline__ bf16x8 vtr2(const LAS unsigned char* p) {
    const v4i16_t lo = __builtin_amdgcn_ds_read_tr16_b64_v4i16((LAS v4i16_t*)p), hi = __builtin_amdgcn_ds_read_tr16_b64_v4i16((LAS v4i16_t*)(p + 8 * AT_ROWB));
    return (bf16x8){lo[0], lo[1], lo[2], lo[3], hi[0], hi[1], hi[2], hi[3]};
}
__device__ __forceinline__ void ph_attn(KArgs a, const Ctx& c, int l) {
    LAS unsigned char* lds = c.lds; const int lane = c.lane, wv = c.wave, tid = c.tid, r32 = lane & 31, hi = lane >> 5;
    LAS float* btab = (LAS float*)(lds + AT_BT); LAS float* kms = (LAS float*)(lds + AT_KM); volatile LAS int* uw = (volatile LAS int*)(lds + AT_UW);
    const bf16* QKVA = (const bf16*)(a->ws + WS_QKVA); const float* kmean = (const float*)(a->ws + WS_KMEAN); bf16* YA = (bf16*)(a->ws + WS_YA); const float* relb = a->in[I_RELB];
    unsigned* ctr = (unsigned*)(a->ws + WS_CTL) + CW_ACTR + l * 64;
    const float LOG2E = 1.4426950408889634f, C2 = 0.125f * LOG2E, NINF = -__builtin_inff();
    const int srow = tid >> 3, sch = tid & 7; const unsigned sdst = srow * AT_ROWB + sch * 16;
    for (;;) {
        __syncthreads();
        if (tid == 0) uw[0] = (int)__hip_atomic_fetch_add(ctr, 1u, RLX_AGENT);
        __syncthreads();
        const int u = uw[0];
        if (u >= NB * HA * NBLK) { if (u >= NB * HA * NBLK + CV_NUNITS) break; convert_unit(a, c, l, u - NB * HA * NBLK); continue; }
        const int qb = 15 - (u >> 5), bh = u & 31, b = bh >> 3, h = bh & 7;
        const float c31 = relb[31 * 8 + h];
        for (int i = tid; i < 129; i += NTHR) btab[i] = (i < 128 ? (relb[(int)T5B[i] * 8 + h] - c31) : 0.f) * LOG2E;
        for (int i = tid; i < 1024; i += NTHR) kms[i] = kmean[(size_t)bh * 1024 + i];
        const int qrel = wv * 32 + r32, tokq = b * SEQ + qb * 256 + qrel;
        const bf16* kbase = QKVA + (size_t)(b * SEQ) * 1536 + 512 + h * 64 + sch * 8;
        {   const int key0 = qb * 256; const v4u kr = *(const v4u*)(kbase + (size_t)(key0 + srow) * 1536), vr = *(const v4u*)(kbase + (size_t)(key0 + srow) * 1536 + 512);
            *(LAS v4u*)(lds + AT_K + sdst) = kr; *(LAS v4u*)(lds + AT_V + sdst) = vr; }
        float qf[32];
        {   const bf16* qp = QKVA + (size_t)tokq * 1536 + h * 64 + 8 * hi;
#pragma unroll
            for (int s = 0; s < 4; ++s) { const v4u w = *(const v4u*)(qp + 16 * s); qf[s * 8 + 0] = bflo(w.x); qf[s * 8 + 1] = bfhi(w.x); qf[s * 8 + 2] = bflo(w.y); qf[s * 8 + 3] = bfhi(w.y); qf[s * 8 + 4] = bflo(w.z); qf[s * 8 + 5] = bfhi(w.z); qf[s * 8 + 6] = bflo(w.w); qf[s * 8 + 7] = bfhi(w.w); } }
        __syncthreads();
        unsigned selmask = 0u;
        {   float g[16];
#pragma unroll
            for (int n = 0; n < 16; ++n) { g[n] = -3e38f;
                if (n < qb) { float d = 0.f;
#pragma unroll
                    for (int s = 0; s < 4; ++s) { const f32x4 k0 = *(const LAS f32x4*)(kms + n * 64 + 16 * s + 8 * hi), k1 = *(const LAS f32x4*)(kms + n * 64 + 16 * s + 8 * hi + 4);
                        d += qf[s * 8] * k0.x + qf[s * 8 + 1] * k0.y + qf[s * 8 + 2] * k0.z + qf[s * 8 + 3] * k0.w + qf[s * 8 + 4] * k1.x + qf[s * 8 + 5] * k1.y + qf[s * 8 + 6] * k1.z + qf[s * 8 + 7] * k1.w; }
                    g[n] = d + shx(d, 32, lane); } }
#pragma unroll
            for (int t = 0; t < 3; ++t) { float best = -3.4e38f; int bi = 0;
#pragma unroll
                for (int n = 0; n < 16; ++n) { const bool ok = !((selmask >> n) & 1u) && g[n] > best; best = ok ? g[n] : best; bi = ok ? n : bi; }
                selmask |= 1u << bi; }
            selmask &= (1u << qb) - 1u; }
        bf16x8 qs[4];
#pragma unroll
        for (int s = 0; s < 4; ++s) { v4u w; w.x = cvtpk(qf[s * 8] * C2, qf[s * 8 + 1] * C2); w.y = cvtpk(qf[s * 8 + 2] * C2, qf[s * 8 + 3] * C2); w.z = cvtpk(qf[s * 8 + 4] * C2, qf[s * 8 + 5] * C2); w.w = cvtpk(qf[s * 8 + 6] * C2, qf[s * 8 + 7] * C2); qs[s] = __builtin_bit_cast(bf16x8, w); }
        float m = NINF, lsum = 0.f; f32x16 o0, o1;
#pragma unroll
        for (int r = 0; r < 16; ++r) { o0[r] = 0.f; o1[r] = 0.f; }
        const int NT = 4 * (qb + 1);
        for (int t = 0; t < NT; ++t) {
            const int blk = t < 4 ? qb : ((t - 4) >> 2), kt = t < 4 ? t : ((t - 4) & 3);
            v4u kr = {0u, 0u, 0u, 0u}, vr = {0u, 0u, 0u, 0u};
            if (t + 1 < NT) { const int t1 = t + 1, blk1 = t1 < 4 ? qb : ((t1 - 4) >> 2), kt1 = t1 < 4 ? t1 : ((t1 - 4) & 3); const size_t ro = (size_t)(blk1 * 256 + kt1 * 64 + srow) * 1536;
                kr = *(const v4u*)(kbase + ro); vr = *(const v4u*)(kbase + ro + 512); }
            const bool own = t < 4;
            const bool lane_act = own || ((selmask >> blk) & 1u);
            const bool wave_act = own ? (kt * 64 <= wv * 32 + 31) : (__builtin_amdgcn_ballot_w64(lane_act) != 0ull);
            if (wave_act) {
                const LAS unsigned char* Kb = lds + AT_K + (t & 1) * 64 * AT_ROWB; const LAS unsigned char* Vb = lds + AT_V + (t & 1) * 64 * AT_ROWB;
                f32x16 p0, p1;
#pragma unroll
                for (int r = 0; r < 16; ++r) { p0[r] = 0.f; p1[r] = 0.f; }
#pragma unroll
                for (int s = 0; s < 4; ++s) { const bf16x8 a0 = *(const LAS bf16x8*)(Kb + r32 * AT_ROWB + 32 * s + 16 * hi), a1 = *(const LAS bf16x8*)(Kb + (32 + r32) * AT_ROWB + 32 * s + 16 * hi);
                    p0 = MFMA32(a0, qs[s], p0); p1 = MFMA32(a1, qs[s], p1); }
                if (own) {
#pragma unroll
                    for (int r = 0; r < 16; ++r) { const int d0 = qrel - (kt * 64 + crow(r, hi)), d1 = d0 - 32;
                        p0[r] = d0 >= 0 ? p0[r] + btab[d0 > 128 ? 128 : d0] : NINF; p1[r] = d1 >= 0 ? p1[r] + btab[d1 > 128 ? 128 : d1] : NINF; }
                } else if (blk == qb - 1 && kt >= 1) {
#pragma unroll
                    for (int r = 0; r < 16; ++r) { const int d0 = qrel + 256 - (kt * 64 + crow(r, hi)), d1 = d0 - 32;
                        p0[r] += btab[d0 > 128 ? 128 : d0]; p1[r] += btab[d1 > 128 ? 128 : d1]; }
                }
                float mx = fmaxf(p0[0], p1[0]);
#pragma unroll
                for (int r = 1; r < 16; ++r) mx = fmaxf(mx, fmaxf(p0[r], p1[r]));
                mx = fmaxf(mx, shx(mx, 32, lane));
                const float tmax = lane_act ? mx : NINF, mnew = fmaxf(m, tmax), alpha = __builtin_amdgcn_exp2f(m - mnew), muse = lane_act ? mnew : __builtin_inff();
                float rs = 0.f;
#pragma unroll
                for (int r = 0; r < 16; ++r) { p0[r] = __builtin_amdgcn_exp2f(p0[r] - muse); p1[r] = __builtin_amdgcn_exp2f(p1[r] - muse); rs += p0[r] + p1[r]; }
                lsum = lsum * alpha + rs; m = mnew;
                if (__builtin_amdgcn_ballot_w64(alpha != 1.f) != 0ull) {
#pragma unroll
                    for (int r = 0; r < 16; ++r) { o0[r] *= alpha; o1[r] *= alpha; } }
                bf16x8 pa[4];
                { v4u w; w.x = cvtpk(p0[0], p0[1]); w.y = cvtpk(p0[2], p0[3]); w.z = cvtpk(p0[4], p0[5]); w.w = cvtpk(p0[6], p0[7]); pa[0] = __builtin_bit_cast(bf16x8, w);
                  w.x = cvtpk(p0[8], p0[9]); w.y = cvtpk(p0[10], p0[11]); w.z = cvtpk(p0[12], p0[13]); w.w = cvtpk(p0[14], p0[15]); pa[1] = __builtin_bit_cast(bf16x8, w);
                  w.x = cvtpk(p1[0], p1[1]); w.y = cvtpk(p1[2], p1[3]); w.z = cvtpk(p1[4], p1[5]); w.w = cvtpk(p1[6], p1[7]); pa[2] = __builtin_bit_cast(bf16x8, w);
                  w.x = cvtpk(p1[8], p1[9]); w.y = cvtpk(p1[10], p1[11]); w.z = cvtpk(p1[12], p1[13]); w.w = cvtpk(p1[14], p1[15]); pa[3] = __builtin_bit_cast(bf16x8, w); }
                const LAS unsigned char* vp = Vb + (4 * hi + ((lane & 15) >> 2)) * AT_ROWB + 2 * (16 * ((lane >> 4) & 1) + 4 * (lane & 3));
#pragma unroll
                for (int ks = 0; ks < 4; ++ks) { const bf16x8 v0 = vtr2(vp + 16 * ks * AT_ROWB), v1 = vtr2(vp + 16 * ks * AT_ROWB + 64);
                    o0 = MFMA32(v0, pa[ks], o0); o1 = MFMA32(v1, pa[ks], o1); }
            }
            if (t + 1 < NT) { *(LAS v4u*)(lds + AT_K + ((t + 1) & 1) * 64 * AT_ROWB + sdst) = kr; *(LAS v4u*)(lds + AT_V + ((t + 1) & 1) * 64 * AT_ROWB + sdst) = vr; }
            __syncthreads();
        }
        lsum += shx(lsum, 32, lane);
        const float inv = 1.f / lsum;
        LAS unsigned short* stg = (LAS unsigned short*)(lds + AT_OST + wv * 32 * AT_ROWB);
#pragma unroll
        for (int r = 0; r < 16; ++r) { stg[r32 * (AT_ROWB / 2) + crow(r, hi)] = (unsigned short)(cvtpk(o0[r] * inv, 0.f) & 0xffffu); stg[r32 * (AT_ROWB / 2) + 32 + crow(r, hi)] = (unsigned short)(cvtpk(o1[r] * inv, 0.f) & 0xffffu); }
        LDS_WAIT();
#pragma unroll
        for (int i = 0; i < 4; ++i) { const int row = i * 8 + (lane >> 3), ch = lane & 7; const v4u v = *(const LAS v4u*)((const LAS unsigned char*)stg + row * AT_ROWB + ch * 16);
            *(v4u*)(YA + (size_t)(b * SEQ + qb * 256 + wv * 32 + row) * 512 + h * 64 + ch * 8) = v; }
    }
}
constexpr int NPH_LAYER = 11, NPHASES = 2 + NLAYER * NPH_LAYER;
#ifndef DN_IMPL
#define DN_IMPL 1
#endif
#ifndef PH_MASK
#define PH_MASK 0xFFFF
#endif
#define PH_EN(k) ((PH_MASK >> (k)) & 1)
#define GEMM_PHASE(EPI, SCHED, g, S, E) pg8::gemm_phase<EPI, SCHED, true, true>(c.lds, g, S, E, c.tid)

#define PHASE_FN static __device__ __forceinline__ void
__device__ __forceinline__ KArgs launder_k(KArgs a) { unsigned long long v = (unsigned long long)a; asm volatile("" : "+s"(v)); return (KArgs)v; }
PHASE_FN f_mod(KArgs a, int& tid) { a = launder_k(a); Ctx c = make_ctx(tid); ph_mod(a, c); }
PHASE_FN f_norm1(KArgs a, int& tid, int l) { a = launder_k(a); Ctx c = make_ctx(tid); ph_norm1(a, c, l); __syncthreads(); ph_convert(a, c, l); }
PHASE_FN f_proj(KArgs a, int& tid) { a = launder_k(a); Ctx c = make_ctx(tid);
    pg8::Gemm g{(const bf16*)(a->ws + WS_H), (const bf16*)(a->ws + WS_WIN), NTOK, DINP, DM}; pg8::StaticOrder S; S.init(NTOK, DINP, c.G, c.bid);
    EpiProj E{a->ws}; GEMM_PHASE(EpiProj, pg8::StaticOrder, g, S, E); }
PHASE_FN f_kmean(KArgs a, int& tid) { a = launder_k(a); Ctx c = make_ctx(tid); ph_kmean(a, c); }
#ifndef ATTN_IMPL
#define ATTN_IMPL 1
#endif
#if ATTN_IMPL
PHASE_FN f_attn(KArgs a, int& tid, int l) { a = launder_k(a); Ctx c = make_ctx(tid); ph_attn(a, c, l); }
#else
PHASE_FN f_attn(KArgs a, int& tid, int l) { a = launder_k(a); Ctx c = make_ctx(tid); ph_attn_simple(a, c); }
#endif
PHASE_FN f_dn(KArgs a, int& tid, int l) { a = launder_k(a); Ctx c = make_ctx(tid); ph_dn_simple(a, c, l); }
PHASE_FN f_dn_prep(KArgs a, int& tid, int l) { a = launder_k(a); Ctx c = make_ctx(tid); ph_dn_prep(a, c, l); }
PHASE_FN f_dn_scan(KArgs a, int& tid, int l) { a = launder_k(a); Ctx c = make_ctx(tid); ph_dn_scan(a, c, l); }
PHASE_FN f_merge1(KArgs a, int& tid) { a = launder_k(a); Ctx c = make_ctx(tid);
    pg8::Gemm g{(const bf16*)(a->ws + WS_YA), (const bf16*)(a->ws + WS_WUPA), NTOK, DM, WA}; pg8::StaticOrder S; S.init(NTOK, DM, c.G, c.bid);
    EpiMerge<false> E{a->ws}; GEMM_PHASE(EpiMerge<false>, pg8::StaticOrder, g, S, E); }
PHASE_FN f_merge2(KArgs a, int& tid) { a = launder_k(a); Ctx c = make_ctx(tid);
    pg8::Gemm g{(const bf16*)(a->ws + WS_YB), (const bf16*)(a->ws + WS_WUPB), NTOK, DM, WB}; pg8::StaticOrder S; S.init(NTOK, DM, c.G, c.bid);
    EpiMerge<true> E{a->ws}; GEMM_PHASE(EpiMerge<true>, pg8::StaticOrder, g, S, E); }
PHASE_FN f_out(KArgs a, int& tid, int l) { a = launder_k(a); Ctx c = make_ctx(tid);
    pg8::Gemm g{(const bf16*)(a->ws + WS_M), (const bf16*)(a->ws + WS_WOUT), NTOK, DM, DM}; pg8::StaticOrder S; S.init(NTOK, DM, c.G, c.bid);
    EpiOut E{l == 0 ? a->in[I_X] : (const float*)a->out, a->out, (const float*)(a->ws + WS_MOD) + l * 4 * 6144 + 2048}; GEMM_PHASE(EpiOut, pg8::StaticOrder, g, S, E); }
PHASE_FN f_router(KArgs a, int& tid, int l) { a = launder_k(a); Ctx c = make_ctx(tid); ph_router(a, c, l); }
PHASE_FN f_gather(KArgs a, int& tid, int l) { a = launder_k(a); Ctx c = make_ctx(tid); ph_gather(a, c, l); }
PHASE_FN f_moe_gu(KArgs a, int& tid, int l) { a = launder_k(a); Ctx c = make_ctx(tid);
    moe_table(a, c, l); const LAS int* te = (const LAS int*)(c.lds + MISC_OFF + 2048);
    pg8::Gemm g{(const bf16*)(a->ws + WS_HS), (const bf16*)(a->ws + WS_WEGU), MOE_MAXROWS, NEXP * 512, DM}; MoeOrder S{te, te[192 + 32] * 2, c.G, c.bid, 1};
    EpiMoeGU E{a->ws}; GEMM_PHASE(EpiMoeGU, MoeOrder, g, S, E); }
PHASE_FN f_moe_down(KArgs a, int& tid, int l) { a = launder_k(a); Ctx c = make_ctx(tid);
    moe_table(a, c, l); const LAS int* te = (const LAS int*)(c.lds + MISC_OFF + 2048);
    pg8::Gemm g{(const bf16*)(a->ws + WS_ACT), (const bf16*)(a->ws + WS_WED), MOE_MAXROWS, NEXP * 1024, DFF}; MoeOrder S{te, te[192 + 32] * 4, c.G, c.bid, 2};
    EpiMoeDown E{a->ws}; GEMM_PHASE(EpiMoeDown, MoeOrder, g, S, E); }
PHASE_FN f_final(KArgs a, int& tid) { a = launder_k(a); Ctx c = make_ctx(tid); ph_final(a, c); }

#define KA() launder_k((KArgs)__builtin_amdgcn_kernarg_segment_ptr())
__device__ __forceinline__ bool ph_in(int k) { KArgs a = KA(); return a->ph_lo <= k && k < a->ph_hi; }
#ifndef MK_PROBE_A
#define MK_PROBE_A -1
#endif
#ifndef MK_PROBE_B
#define MK_PROBE_B -1
#endif
constexpr int CW_TS = 12288;
__device__ __forceinline__ void grid_bar(int& tid, int k) {
    asm volatile("" : "+v"(tid));
#if MK_ONE_LAUNCH
    KArgs a = KA(); XcdBarrier b; b.bar = (unsigned*)(a->ws + WS_CTL) + CW_BAR; b.x = xb_xcc_id(); b.st = (volatile LAS unsigned*)((LAS unsigned char*)lds_raw + MISC_OFF) + 8;
    xcd_barrier(b, tid);
    if (MK_PROBE_A >= 0 && blockIdx.x == 0 && tid == 0) ((unsigned long long*)((unsigned*)(a->ws + WS_CTL) + CW_TS))[k + 1] = __builtin_amdgcn_s_memrealtime();
#else
    __syncthreads();
#endif
}
__global__ void __launch_bounds__(NTHR, 2) mk_fwd(Args a_) {
    int tid = threadIdx.x;
    {   volatile LAS unsigned* MISC = (volatile LAS unsigned*)((LAS unsigned char*)lds_raw + MISC_OFF);
        if (tid < 64) MISC[tid] = 0u;
        __syncthreads();
#if MK_ONE_LAUNCH
        (void)xcd_barrier_post((unsigned*)(KA()->ws + WS_CTL) + CW_BAR, MISC + 8, tid);
#endif
        if (MK_PROBE_A >= 0 && blockIdx.x == 0 && tid == 0) ((unsigned long long*)((unsigned*)(KA()->ws + WS_CTL) + CW_TS))[0] = __builtin_amdgcn_s_memrealtime();
    }
#define IN(k) ph_in(k)
#define SEAM(k) do { if (IN(k) && IN((k) + 1)) grid_bar(tid, (k)); } while (0)
    if (IN(0)) f_mod(KA(), tid); SEAM(0);
    for (int l = 0; l < NLAYER; ++l) {
        const int pb = 1 + l * NPH_LAYER;
        if (PH_EN(0) && IN(pb + 0)) f_norm1(KA(), tid, l); SEAM(pb + 0);
        if (PH_EN(1) && IN(pb + 1)) f_proj(KA(), tid); SEAM(pb + 1);
#if DN_IMPL
        if (PH_EN(2) && IN(pb + 2)) { f_kmean(KA(), tid); f_dn_prep(KA(), tid, l); } SEAM(pb + 2);
        if (PH_EN(3) && IN(pb + 3)) { f_dn_scan(KA(), tid, l);
            if (MK_PROBE_A >= 0 && blockIdx.x == 0 && tid == 0) ((unsigned long long*)((unsigned*)(KA()->ws + WS_CTL) + CW_TS))[40 + l] = __builtin_amdgcn_s_memrealtime();
            __syncthreads(); f_attn(KA(), tid, l);
            if (MK_PROBE_A >= 0 && blockIdx.x == 255 && tid == 0) ((unsigned long long*)((unsigned*)(KA()->ws + WS_CTL) + CW_TS))[44 + l] = __builtin_amdgcn_s_memrealtime(); } SEAM(pb + 3);
#else
        if (PH_EN(2) && IN(pb + 2)) f_kmean(KA(), tid); SEAM(pb + 2);
        if (PH_EN(3) && IN(pb + 3)) { f_attn(KA(), tid, l); __syncthreads(); f_dn(KA(), tid, l); } SEAM(pb + 3);
#endif
        if (PH_EN(4) && IN(pb + 4)) f_merge1(KA(), tid); SEAM(pb + 4);
        if (PH_EN(5) && IN(pb + 5)) f_merge2(KA(), tid); SEAM(pb + 5);
        if (PH_EN(6) && IN(pb + 6)) f_out(KA(), tid, l); SEAM(pb + 6);
        if (PH_EN(7) && IN(pb + 7)) f_router(KA(), tid, l); SEAM(pb + 7);
        if (PH_EN(8) && IN(pb + 8)) f_gather(KA(), tid, l); SEAM(pb + 8);
        if (PH_EN(9) && IN(pb + 9)) f_moe_gu(KA(), tid, l); SEAM(pb + 9);
        if (PH_EN(10) && IN(pb + 10)) f_moe_down(KA(), tid, l); SEAM(pb + 10);
    }
    if (IN(NPHASES - 1)) f_final(KA(), tid);
#undef IN
#undef SEAM
}

extern "C" void kernel_launch(void* const* d_in, const int* in_sizes, int n_in, void* d_out, int out_size, void* d_ws, size_t ws_size, hipStream_t stream) {
    static int grid = 0;
    if (grid == 0) {
        if (n_in != 23 || out_size != NTOK * DM || ws_size < WS_END) { fprintf(stderr, "kernel_launch: unexpected shapes (n_in %d out %d ws %zu)\n", n_in, out_size, ws_size); grid = -1; return; }
        int dev = 0, cus = 0, per_cu = 0;
        if (hipGetDevice(&dev) != hipSuccess || hipDeviceGetAttribute(&cus, hipDeviceAttributeMultiprocessorCount, dev) != hipSuccess) { grid = -1; return; }
        if (hipFuncSetAttribute((const void*)mk_fwd, hipFuncAttributeMaxDynamicSharedMemorySize, LDS_BYTES) != hipSuccess) { fprintf(stderr, "kernel_launch: hipFuncSetAttribute failed\n"); grid = -1; return; }
        if (hipOccupancyMaxActiveBlocksPerMultiprocessor(&per_cu, (const void*)mk_fwd, NTHR, LDS_BYTES) != hipSuccess || per_cu < 1) { fprintf(stderr, "kernel_launch: occupancy query says %d\n", per_cu); (void)hipGetLastError(); grid = -1; return; }
        grid = cus;
    }
    if (grid < 0) return;
    (void)hipMemsetAsync((char*)d_ws + WS_CTL, 0, CTL_ZERO_BYTES, stream);
    Args a{};
    for (int i = 0; i < 23; ++i) a.in[i] = (const float*)d_in[i];
    a.out = (float*)d_out; a.ws = (unsigned char*)d_ws;
#if MK_ONE_LAUNCH
    a.ph_lo = 0; a.ph_hi = NPHASES;
    hipLaunchKernelGGL(mk_fwd, dim3(grid), dim3(NTHR), LDS_BYTES, stream, a);
#else
    for (int p = 0; p < NPHASES; ++p) { a.ph_lo = p; a.ph_hi = p + 1; hipLaunchKernelGGL(mk_fwd, dim3(grid), dim3(NTHR), LDS_BYTES, stream, a); }
#endif
}
```

```cpp
#include <hip/hip_runtime.h>
#include <cstdio>
#include <cstdint>
#ifndef MK_ONE_LAUNCH
#define MK_ONE_LAUNCH 1
#endif
#ifndef MK_PROBE_A
#define MK_PROBE_A -1
#endif
#ifndef MK_PROBE_B
#define MK_PROBE_B -1
#endif
namespace pg8 {
#define PG8_LAS __attribute__((address_space(3)))
typedef unsigned short bf16_t;
typedef short bf16x8 __attribute__((ext_vector_type(8)));
typedef float f32x4 __attribute__((ext_vector_type(4)));
typedef unsigned u32x4 __attribute__((ext_vector_type(4)));
constexpr int BM = 256, BK = 64, HALF = 128, HTB = HALF * BK * 2  , STAGE_BYTES = 8 * HTB, NXCD = 8, WGM = 8;

__host__ __device__ __forceinline__ int lds_byte(int r, int c) { const int st = (r >> 4) * 2 + (c >> 5), rr = r & 15, cc = c & 31, ob = rr * 64 + cc * 2; return st * 1024 + (ob ^ (((ob >> 9) & 1) << 5)); }
__host__ __device__ __forceinline__ void stage_rc(int b, int& R, int& C) { const int st = b / 1024, sb = b % 1024, swz = sb ^ (((sb >> 9) & 1) << 5); R = (st >> 1) * 16 + swz / 64; C = (st & 1) * 32 + (swz % 64) / 2; }
__host__ __device__ __forceinline__ int perm32(int rho) { const int n = rho >> 4, i = rho & 15; return 8 * (i >> 2) + 4 * n + (i & 3); }

struct Unit { int pm, pn; };
struct Gemm { const bf16_t* A; const bf16_t* Bt; int M, N, K; };

struct StaticOrder {
    int nM, nN, nwg, G, c;
    __host__ __device__ void init(int M, int N, int G_, int c_) { nM = M / BM; nN = N / BM; nwg = nM * nN; G = G_; c = c_; }
    __host__ __device__ bool next(int i, Unit& u) const {
        const long L = (long)i * G + c; if (L >= nwg) return false;
        int wgid = (int)L; { const int q = nwg / NXCD, r = nwg % NXCD, xcd = wgid % NXCD, off = wgid / NXCD; wgid = (xcd < r ? xcd * (q + 1) : r * (q + 1) + (xcd - r) * q) + off; }
        const int nig = WGM * nN, gid = wgid / nig, fm = gid * WGM, gsz = (nM - fm) < WGM ? (nM - fm) : WGM;
        u.pm = fm + ((wgid % nig) % gsz); u.pn = (wgid % nig) / gsz; return true;
    }
    __device__ __forceinline__ void a_ready(const Unit&) const {}
    __device__ __forceinline__ void done(const Unit&) const {}
};

__device__ __forceinline__ unsigned cvt_pk_bf16(float lo, float hi) { unsigned r; asm volatile("v_cvt_pk_bf16_f32 %0, %1, %2" : "=v"(r) : "v"(lo), "v"(hi)); return r; }
typedef float f32x2 __attribute__((ext_vector_type(2)));
template <class Epi, class Sched, bool ALIGN_EPI = false, bool SP2 = false>
__device__ __forceinline__ void gemm_phase(PG8_LAS unsigned char* lds, const Gemm g, const Sched& S, const Epi& E, const int tid_in) {
    const int tid = tid_in, wid = __builtin_amdgcn_readfirstlane(tid >> 6), lane = tid & 63, wr = wid >> 2, wc = wid & 3, fr = lane & 15, fq = lane >> 4;
    const int K = g.K, nt = K / BK;
    unsigned voffA[2], voffB[2];
#pragma unroll
    for (int i = 0; i < 2; ++i) { int R, C; stage_rc(tid * 16 + i * 8192, R, C); const int Rb = Epi::PERM ? ((R & ~31) + perm32(R & 31)) : R;
        voffA[i] = (unsigned)(R * K + C) * 2u; voffB[i] = (unsigned)(Rb * K + C) * 2u; }
    const size_t kstep = (size_t)(BK * 2);
    const size_t hstep = (size_t)HALF * K * 2;
    const size_t tstep = 2 * hstep;
    const unsigned ldsw = (unsigned)wid * 1024u;
    const int aoff = lds_byte(wr * 64 + fr, fq * 8), boff = lds_byte(wc * 32 + fr, fq * 8);
#define PG8_SA(b, h) (((b) * 2 + (h)) * HTB)
#define PG8_SB(b, h) ((4 + (b) * 2 + (h)) * HTB)
#define PG8_STAGE(bufoff, gbase, voff) do { _Pragma("unroll") for (int _i = 0; _i < 2; ++_i) \
        __builtin_amdgcn_global_load_lds((const unsigned*)((const char*)(gbase) + (voff)[_i]), (PG8_LAS unsigned*)(lds + (bufoff) + ldsw + _i * 8192), 16, 0, 0); } while (0)
#define PG8_LDA(dst, b, h) do { _Pragma("unroll") for (int m = 0; m < 4; ++m) _Pragma("unroll") for (int k = 0; k < 2; ++k) dst[m][k] = *(const PG8_LAS bf16x8*)(lds + PG8_SA(b, h) + aoff + m * 2048 + k * 1024); } while (0)
#define PG8_LDB(dst, b, h) do { _Pragma("unroll") for (int n = 0; n < 2; ++n) _Pragma("unroll") for (int k = 0; k < 2; ++k) dst[n][k] = *(const PG8_LAS bf16x8*)(lds + PG8_SB(b, h) + boff + n * 2048 + k * 1024); } while (0)
#define PG8_MMA(ai, bj, At, Bt) do { __builtin_amdgcn_s_setprio(1); _Pragma("unroll") for (int m = 0; m < 4; ++m) _Pragma("unroll") for (int n = 0; n < 2; ++n) _Pragma("unroll") for (int k = 0; k < 2; ++k) \
        acc[ai][bj][m][n] = __builtin_amdgcn_mfma_f32_16x16x32_bf16(Bt[n][k], At[m][k], acc[ai][bj][m][n], 0, 0, 0); __builtin_amdgcn_s_setprio(0); } while (0)
#define PG8_WAIT_V(n) asm volatile("s_waitcnt vmcnt(" #n ")" ::: "memory")
#define PG8_WAIT_L(n) asm volatile("s_waitcnt lgkmcnt(" #n ")" ::: "memory")
#define PG8_BAR __builtin_amdgcn_s_barrier()
#define PG8_SCHED __builtin_amdgcn_sched_barrier(0)
    Unit cur, nxt; int ui = 0;
    if (!S.next(0, cur)) return;
    f32x4 acc[2][2][4][2];
    float zf_ = 0.f; asm volatile("" : "+v"(zf_));
#pragma unroll
    for (int a = 0; a < 2; ++a)
#pragma unroll
        for (int b = 0; b < 2; ++b)
#pragma unroll
            for (int m = 0; m < 4; ++m)
#pragma unroll
                for (int n = 0; n < 2; ++n) acc[a][b][m][n] = (f32x4){zf_, zf_, zf_, zf_};
    bf16x8 At[4][2], B0[2][2], B1[2][2];
    const char* cA = (const char*)g.A + (size_t)cur.pm * tstep; const char* cB = (const char*)g.Bt + (size_t)cur.pn * tstep;
    S.a_ready(cur);
    if constexpr (SP2) {
        PG8_STAGE(PG8_SB(0, 0), cB, voffB); PG8_STAGE(PG8_SB(0, 1), cB + hstep, voffB); PG8_STAGE(PG8_SA(0, 0), cA, voffA); PG8_STAGE(PG8_SA(0, 1), cA + hstep, voffA);
        if (wr == 1) PG8_BAR;
        PG8_WAIT_V(2); PG8_BAR;
        PG8_STAGE(PG8_SB(1, 0), cB + kstep, voffB); PG8_STAGE(PG8_SA(1, 0), cA + kstep, voffA); PG8_STAGE(PG8_SB(1, 1), cB + hstep + kstep, voffB);
        PG8_WAIT_V(6); PG8_BAR;
    } else {
        PG8_STAGE(PG8_SB(0, 0), cB, voffB); PG8_STAGE(PG8_SA(0, 0), cA, voffA); PG8_STAGE(PG8_SB(0, 1), cB + hstep, voffB); PG8_STAGE(PG8_SA(0, 1), cA + hstep, voffA);
        if (wr == 1) PG8_BAR;
        PG8_WAIT_V(4); PG8_BAR;
        PG8_STAGE(PG8_SB(1, 0), cB + kstep, voffB); PG8_STAGE(PG8_SA(1, 0), cA + kstep, voffA); PG8_STAGE(PG8_SB(1, 1), cB + hstep + kstep, voffB);
        PG8_WAIT_V(6); PG8_BAR;
    }
    for (;;) {
        const bool has_next = S.next(ui + 1, nxt);
        const char* nA = has_next ? (const char*)g.A + (size_t)nxt.pm * tstep : cA; const char* nB = has_next ? (const char*)g.Bt + (size_t)nxt.pn * tstep : cB;
        for (int t = 0; t < nt; t += 2) {
            const bool last = (t == nt - 2);
            const char* a1 = cA + (size_t)(t + 1) * kstep;
            const char* a2 = last ? nA : cA + (size_t)(t + 2) * kstep; const char* b2 = last ? nB : cB + (size_t)(t + 2) * kstep;
            const char* a3 = a2 + kstep; const char* b3 = b2 + kstep;
            if (last && has_next) S.a_ready(nxt);
            if constexpr (SP2) {
            PG8_LDB(B0, 0, 0); PG8_LDB(B1, 0, 1); PG8_SCHED; PG8_LDA(At, 0, 0); PG8_STAGE(PG8_SA(1, 1), a1 + hstep, voffA);
            PG8_WAIT_V(8); PG8_WAIT_L(0); PG8_BAR; PG8_MMA(0, 0, At, B0); PG8_MMA(0, 1, At, B1); PG8_BAR; PG8_SCHED;
            PG8_LDA(At, 0, 1); PG8_STAGE(PG8_SB(0, 0), b2, voffB); PG8_STAGE(PG8_SB(0, 1), b2 + hstep, voffB); PG8_STAGE(PG8_SA(0, 0), a2, voffA);
            PG8_WAIT_V(8); PG8_WAIT_L(0); PG8_BAR; PG8_MMA(1, 0, At, B0); PG8_MMA(1, 1, At, B1); PG8_BAR; PG8_SCHED;
            PG8_LDB(B0, 1, 0); PG8_LDB(B1, 1, 1); PG8_SCHED; PG8_LDA(At, 1, 0); PG8_STAGE(PG8_SA(0, 1), a2 + hstep, voffA);
            PG8_WAIT_V(8); PG8_WAIT_L(0); PG8_BAR; PG8_MMA(0, 0, At, B0); PG8_MMA(0, 1, At, B1); PG8_BAR; PG8_SCHED;
            PG8_LDA(At, 1, 1); PG8_STAGE(PG8_SB(1, 0), b3, voffB); PG8_STAGE(PG8_SB(1, 1), b3 + hstep, voffB); PG8_STAGE(PG8_SA(1, 0), a3, voffA);
            PG8_WAIT_V(8); PG8_WAIT_L(0); PG8_BAR; PG8_MMA(1, 0, At, B0); PG8_MMA(1, 1, At, B1); PG8_BAR; PG8_SCHED;
            } else {
            PG8_LDB(B0, 0, 0); PG8_SCHED; PG8_LDA(At, 0, 0); PG8_STAGE(PG8_SA(1, 1), a1 + hstep, voffA);
            PG8_WAIT_L(8); PG8_BAR; PG8_WAIT_L(0); PG8_MMA(0, 0, At, B0); PG8_BAR; PG8_SCHED;
            PG8_LDB(B1, 0, 1); PG8_STAGE(PG8_SB(0, 0), b2, voffB);
            PG8_BAR; PG8_WAIT_L(0); PG8_MMA(0, 1, At, B1); PG8_BAR;
            PG8_LDA(At, 0, 1); PG8_STAGE(PG8_SA(0, 0), a2, voffA);
            PG8_BAR; PG8_WAIT_L(0); PG8_MMA(1, 0, At, B0); PG8_BAR; PG8_SCHED;
            PG8_STAGE(PG8_SB(0, 1), b2 + hstep, voffB);
            PG8_WAIT_V(6); PG8_BAR; PG8_MMA(1, 1, At, B1); PG8_BAR;
            PG8_LDB(B0, 1, 0); PG8_SCHED; PG8_LDA(At, 1, 0); PG8_STAGE(PG8_SA(0, 1), a2 + hstep, voffA);
            PG8_WAIT_L(8); PG8_BAR; PG8_WAIT_L(0); PG8_MMA(0, 0, At, B0); PG8_BAR; PG8_SCHED;
            PG8_LDB(B1, 1, 1); PG8_STAGE(PG8_SB(1, 0), b3, voffB);
            PG8_BAR; PG8_WAIT_L(0); PG8_MMA(0, 1, At, B1); PG8_BAR;
            PG8_LDA(At, 1, 1); PG8_STAGE(PG8_SA(1, 0), a3, voffA);
            PG8_BAR; PG8_WAIT_L(0); PG8_MMA(1, 0, At, B0); PG8_BAR; PG8_SCHED;
            PG8_STAGE(PG8_SB(1, 1), b3 + hstep, voffB);
            PG8_WAIT_V(6); PG8_BAR; PG8_MMA(1, 1, At, B1); PG8_BAR;
            }
        }
        if constexpr (ALIGN_EPI) { if (wr == 0) PG8_BAR; }
        if constexpr (!Epi::AFTER_DRAIN) { int te_ = tid_in; asm volatile("" : "+v"(te_)); E(acc, cur, wr, wc, te_ & 15, (te_ & 63) >> 4); S.done(cur); }
        if (!has_next) break;
        zf_ = 0.f; asm volatile("" : "+v"(zf_));
#pragma unroll
        for (int a = 0; a < 2; ++a)
#pragma unroll
            for (int b = 0; b < 2; ++b)
#pragma unroll
                for (int m = 0; m < 4; ++m)
#pragma unroll
                    for (int n = 0; n < 2; ++n) acc[a][b][m][n] = (f32x4){zf_, zf_, zf_, zf_};
        cur = nxt; cA = nA; cB = nB; ++ui;
        if constexpr (ALIGN_EPI) { if (wr == 1) PG8_BAR; }
    }
    PG8_WAIT_V(0);
    if constexpr (!ALIGN_EPI) { if (wr == 0) PG8_BAR; }
    PG8_BAR;
    if constexpr (Epi::AFTER_DRAIN) { E.fused(acc, cur, wr, wc, fr, fq, lds, wid, lane); S.done(cur); }
#undef PG8_SA
#undef PG8_SB
#undef PG8_STAGE
#undef PG8_LDA
#undef PG8_LDB
#undef PG8_MMA
#undef PG8_WAIT_V
#undef PG8_WAIT_L
#undef PG8_BAR
#undef PG8_SCHED
}
}
constexpr int NW = 8, NTHR = 512;
constexpr int DM = 1024, NB = 4, SEQ = 4096, NTOK = NB * SEQ, NLAYER = 2;
constexpr int HA = 8, HDA = 64, WA = 512, MBLK = 256, NBLK = SEQ / MBLK;
constexpr int HB = 4, HDB = 128, WB = 512, CONVK = 4, DNC = 64, NCH = SEQ / DNC;
constexpr int NGRP = 4, EPG = 8, NEXP = 32, DFF = 256;
constexpr int DIN = 5640, DINP = 5632, NMOD = 6;
constexpr int C_QKVA = 0, C_QKVB = 1536, C_ZB = 3072, C_BA = 3584, C_GATE = 3592;
constexpr float EPS = 1e-6f;
constexpr int MOE_MAXROWS = 2 * NTOK + NEXP * 256;
constexpr int MOE_MAXTILES = MOE_MAXROWS / 256;

constexpr size_t MiB = 1u << 20;
constexpr size_t WS_CTL = 0, CTL_ZERO_BYTES = 1 * MiB;
constexpr size_t WS_MOD = 1 * MiB;
constexpr size_t WS_WIN = 2 * MiB;
constexpr size_t WS_WUPA = 13 * MiB, WS_WUPB = 14 * MiB;
constexpr size_t WS_WOUT = 15 * MiB;
constexpr size_t WS_WEGU = 17 * MiB;
constexpr size_t WS_WED = 49 * MiB;
constexpr size_t WS_SMALL = 65 * MiB;
constexpr size_t WS_KMEAN = WS_SMALL;
constexpr size_t WS_BETA = WS_SMALL + 256 * 1024;
constexpr size_t WS_GLOG = WS_SMALL + 512 * 1024;
constexpr size_t WS_TOKINFO = WS_SMALL + 1 * MiB;
constexpr size_t WS_ROWTOK = WS_SMALL + 2 * MiB;
constexpr size_t WS_ROWW = WS_SMALL + 3 * MiB;
constexpr size_t WS_GL = WS_SMALL + 4 * MiB;
constexpr size_t WS_H = 72 * MiB;
constexpr size_t WS_QKVA = 104 * MiB;
constexpr size_t WS_QKVB = 152 * MiB;
constexpr size_t WS_ZB = 200 * MiB;
constexpr size_t WS_GATES = 216 * MiB;
constexpr size_t WS_IMG = 280 * MiB;
constexpr size_t WS_YA = 72 * MiB, WS_YB = 336 * MiB;
constexpr size_t WS_END = 352 * MiB;
constexpr size_t WS_M = WS_QKVB;
constexpr size_t WS_U = 88 * MiB;
constexpr size_t WS_HS = WS_QKVA;
constexpr size_t WS_ACT = 184 * MiB;
constexpr size_t WS_YS = WS_GATES;
constexpr int CW_TMO = 0;
constexpr int CW_BAR = 4096;
constexpr int CW_GCNT = 8192;
constexpr int CW_ACTR = 8320;

constexpr int RING_BYTES = 131072;
constexpr int MISC_OFF = 143360;
constexpr int LDS_BYTES = 147456;

#define GAS __attribute__((address_space(1)))
#define LAS __attribute__((address_space(3)))
typedef unsigned short bf16;
typedef unsigned v4u __attribute__((ext_vector_type(4)));
typedef unsigned v2u __attribute__((ext_vector_type(2)));
typedef float f32x4 __attribute__((ext_vector_type(4)));
typedef float f32x16 __attribute__((ext_vector_type(16)));
typedef short bf16x8 __attribute__((ext_vector_type(8)));
typedef GAS unsigned gu32;
#define RLX_AGENT __ATOMIC_RELAXED, __HIP_MEMORY_SCOPE_AGENT
#define LDS_WAIT() asm volatile("s_waitcnt lgkmcnt(0)" ::: "memory")
#define VM_WAIT() asm volatile("s_waitcnt vmcnt(0)" ::: "memory")
__device__ __forceinline__ unsigned f2bf(float f) { unsigned u = __builtin_bit_cast(unsigned, f); return (u + 0x7fffu + ((u >> 16) & 1u)) >> 16; }
__device__ __forceinline__ unsigned pk2(float lo, float hi) { return f2bf(lo) | (f2bf(hi) << 16); }
__device__ __forceinline__ float bf2f(unsigned b) { return __builtin_bit_cast(float, b << 16); }
__device__ __forceinline__ float bflo(unsigned w) { return __builtin_bit_cast(float, w << 16); }
__device__ __forceinline__ float bfhi(unsigned w) { return __builtin_bit_cast(float, w & 0xffff0000u); }
__device__ __forceinline__ float rcpf_(float x) { return __builtin_amdgcn_rcpf(x); }
__device__ __forceinline__ float sigmoidf_(float x) { return rcpf_(1.f + __builtin_amdgcn_exp2f(-1.4426950408889634f * x)); }
__device__ __forceinline__ float siluf_(float x) { return x * rcpf_(1.f + __builtin_amdgcn_exp2f(-1.4426950408889634f * x)); }
__device__ __forceinline__ float shx(float v, int o, int lane) { return __builtin_bit_cast(float, __builtin_amdgcn_ds_bpermute((lane ^ o) << 2, __builtin_bit_cast(int, v))); }
__device__ __forceinline__ float shidx(float v, int src) { return __builtin_bit_cast(float, __builtin_amdgcn_ds_bpermute(src << 2, __builtin_bit_cast(int, v))); }
__device__ __forceinline__ int shidx_i(int v, int src) { return __builtin_amdgcn_ds_bpermute(src << 2, v); }
template <int CTRL> __device__ __forceinline__ float dpp_f(float v) { return __builtin_bit_cast(float, __builtin_amdgcn_update_dpp(0, __builtin_bit_cast(int, v), CTRL, 0xf, 0xf, true)); }
__device__ __forceinline__ float rdlane_f(float v, int l) { return __builtin_bit_cast(float, __builtin_amdgcn_readlane(__builtin_bit_cast(int, v), l)); }
__device__ __forceinline__ float wave_sum(float v, int) {
    v += dpp_f<0xB1>(v); v += dpp_f<0x4E>(v); v += dpp_f<0x141>(v); v += dpp_f<0x140>(v);
    return (rdlane_f(v, 0) + rdlane_f(v, 16)) + (rdlane_f(v, 32) + rdlane_f(v, 48));
}
__device__ __forceinline__ float wave_max(float v, int) {
    v = fmaxf(v, dpp_f<0xB1>(v)); v = fmaxf(v, dpp_f<0x4E>(v)); v = fmaxf(v, dpp_f<0x141>(v)); v = fmaxf(v, dpp_f<0x140>(v));
    return fmaxf(fmaxf(rdlane_f(v, 0), rdlane_f(v, 16)), fmaxf(rdlane_f(v, 32), rdlane_f(v, 48)));
}
__device__ const unsigned char T5B[128] = {0, 1, 2, 3, 4, 5, 6, 7, 8, 9, 10, 11, 12, 13, 14, 15, 16, 16, 16, 17, 17, 18, 18, 18, 19, 19, 19, 20, 20, 20, 20, 21, 21, 21, 21, 22, 22, 22, 22, 22, 23, 23, 23, 23, 23, 23, 24, 24, 24, 24, 24, 24, 25, 25, 25, 25, 25, 25, 25, 26, 26, 26, 26, 26, 26, 26, 26, 27, 27, 27, 27, 27, 27, 27, 27, 27, 27, 28, 28, 28, 28, 28, 28, 28, 28, 28, 28, 29, 29, 29, 29, 29, 29, 29, 29, 29, 29, 29, 29, 30, 30, 30, 30, 30, 30, 30, 30, 30, 30, 30, 30, 30, 30, 31, 31, 31, 31, 31, 31, 31, 31, 31, 31, 31, 31, 31, 31, 31};

#define XB_TMO      128
#define XB_XCNT(j)  (256  + 64 * (j))
#define XB_XSUB(j)  (1280 + 64 * (j))
#define XB_XGEN(j)  (2304 + 64 * (j))
#define XB_TOP      3328
#define XB_TOPGEN   3392
#define XCD_BAR_WORDS 3456
#define XB_SPIN_CAP (1u << 18)

__device__ __forceinline__ unsigned xb_ld(unsigned* p)              { return __hip_atomic_load(p, __ATOMIC_RELAXED, __HIP_MEMORY_SCOPE_AGENT); }
__device__ __forceinline__ unsigned xb_add(unsigned* p, unsigned v) { return __hip_atomic_fetch_add(p, v, __ATOMIC_RELAXED, __HIP_MEMORY_SCOPE_AGENT); }
__device__ __forceinline__ unsigned xb_xcc_id() { return (unsigned)__builtin_amdgcn_s_getreg((3 << 11) | 20) & 0xFu; }
#define XB_SPIN(cond, bar) do { unsigned _sp = 0; while (cond) { __builtin_amdgcn_s_sleep(1); \
    if ((++_sp & 255u) == 0u) { if (xb_ld(&(bar)[XB_TMO])) break; if (_sp > XB_SPIN_CAP) { atomicAdd(&(bar)[XB_TMO], 1u); break; } } } } while (0)

struct XcdBarrier {
    unsigned* bar; unsigned x;
    volatile LAS unsigned* st;
};

__device__ __forceinline__ XcdBarrier xcd_barrier_post(unsigned* bar, volatile LAS unsigned* st, const int tid_in) {
    XcdBarrier b; b.bar = bar; b.x = xb_xcc_id(); b.st = st;
    if (tid_in == 0) (void)xb_add(&bar[XB_XCNT(b.x)], 1u);
    return b;
}
__device__ __forceinline__ void xcd_barrier_complete(unsigned* bar, unsigned x, unsigned& nloc, unsigned& nx) {
    const unsigned G = gridDim.x * gridDim.y * gridDim.z;
    unsigned sum, cnt, mine, sp = 0u;
    for (;;) {
        sum = 0u; cnt = 0u; mine = 0u;
#pragma unroll
        for (unsigned j = 0; j < 16; ++j) { const unsigned c = xb_ld(&bar[XB_XCNT(j)]); sum += c; cnt += (c > 0u) ? 1u : 0u; mine = (j == x) ? c : mine; }
        if (sum == G) break;
        __builtin_amdgcn_s_sleep(1);
        if ((++sp & 255u) == 0u) { if (xb_ld(&bar[XB_TMO])) break; if (sp > XB_SPIN_CAP) { atomicAdd(&bar[XB_TMO], 1u); break; } }
    }
    nloc = mine > 0u ? mine : 1u; nx = cnt > 0u ? cnt : 1u;
}

__device__ __forceinline__ void xcd_barrier(const XcdBarrier& b, const int tid_in) {
    asm volatile("s_waitcnt vmcnt(0)" ::: "memory");
    __syncthreads();
    if (tid_in == 0) {
        unsigned* bar = b.bar;
        __builtin_amdgcn_s_waitcnt(0);
        unsigned nloc = b.st[0], nx = b.st[1];
        if (nloc == 0u) { xcd_barrier_complete(bar, b.x, nloc, nx); b.st[0] = nloc; b.st[1] = nx; }
        const unsigned old = xb_add(&bar[XB_XSUB(b.x)], 1u);
        const unsigned gen = old / nloc;
        if (old + 1u == (gen + 1u) * nloc) {
            __builtin_amdgcn_fence(__ATOMIC_RELEASE, "agent");
            asm volatile("s_waitcnt vmcnt(0)" ::: "memory");
            const unsigned og = xb_add(&bar[XB_TOP], 1u);
            const unsigned tg = og / nx;
            if (og + 1u == (tg + 1u) * nx) xb_add(&bar[XB_TOPGEN], 1u);
            else XB_SPIN(xb_ld(&bar[XB_TOPGEN]) == tg, bar);
            __builtin_amdgcn_fence(__ATOMIC_ACQUIRE, "agent");
            xb_add(&bar[XB_XGEN(b.x)], 1u);
            asm volatile("s_waitcnt vmcnt(0)" ::: "memory");
        } else {
            XB_SPIN(xb_ld(&bar[XB_XGEN(b.x)]) == gen, bar);
            __builtin_amdgcn_fence(__ATOMIC_ACQUIRE, "agent");
            asm volatile("s_waitcnt vmcnt(0)" ::: "memory");
        }
    }
    __syncthreads();
}
struct Args { const float* in[23]; float* out; unsigned char* ws; int ph_lo, ph_hi; };
enum { I_X = 0, I_C, I_RELB, I_FNW, I_N1W, I_N2W, I_WMOD, I_BMOD, I_WIN, I_CONVW, I_ALOG, I_DTB, I_ONW, I_WUPA, I_WUPB, I_WOUT, I_WRG, I_BRG, I_WRE, I_BRE, I_WEG, I_WEU, I_WED };

typedef const Args __attribute__((address_space(4)))* KArgs;
struct Ctx { LAS unsigned char* lds; int tid, lane, wave, bid, G; };
extern __shared__ __attribute__((aligned(16))) unsigned char lds_raw[];
__device__ __forceinline__ Ctx make_ctx(int& tid) { Ctx c; c.lds = (LAS unsigned char*)lds_raw; asm volatile("" : "+v"(tid)); const int t = tid; c.tid = t; c.lane = t & 63; c.wave = __builtin_amdgcn_readfirstlane(t >> 6); int bi = blockIdx.x, gd = gridDim.x; asm volatile("" : "+s"(bi), "+s"(gd)); c.bid = bi; c.G = gd; return c; }

__device__ __forceinline__ void ph_mod(KArgs a, const Ctx& c) {
    LAS float* cact = (LAS float*)c.lds;
    LAS float* red = (LAS float*)(c.lds + 16384);
    const float* cin = a->in[I_C];
    for (int i = c.tid; i < 4096; i += NTHR) cact[i] = siluf_(cin[i]);
    __syncthreads();
    float* mod = (float*)(a->ws + WS_MOD);
    for (int item = c.bid; item < 192; item += c.G) {
        const int l = item / 96, j0 = (item % 96) * 64;
        const float* W = a->in[I_WMOD] + (size_t)l * 1024 * 6144 + j0 + c.lane;
        float a0 = 0.f, a1 = 0.f, a2 = 0.f, a3 = 0.f;
        const int k0 = c.wave * 128;
#pragma unroll 8
        for (int k = k0; k < k0 + 128; ++k) { const float w = W[(size_t)k * 6144]; a0 += cact[k] * w; a1 += cact[1024 + k] * w; a2 += cact[2048 + k] * w; a3 += cact[3072 + k] * w; }
        red[(c.wave * 4 + 0) * 64 + c.lane] = a0; red[(c.wave * 4 + 1) * 64 + c.lane] = a1; red[(c.wave * 4 + 2) * 64 + c.lane] = a2; red[(c.wave * 4 + 3) * 64 + c.lane] = a3;
        __syncthreads();
        if (c.tid < 256) { const int b = c.tid >> 6, ln = c.tid & 63; float s = 0.f;
#pragma unroll
            for (int w = 0; w < 8; ++w) s += red[(w * 4 + b) * 64 + ln];
            mod[(l * 4 + b) * 6144 + j0 + ln] = s + a->in[I_BMOD][l * 6144 + j0 + ln]; }
        __syncthreads();
    }
}

__device__ __forceinline__ void tr_item(const float* src, int ld, bf16* dst, int K, int nblk, LAS float* scr, int item, int lane) {
    const int kb = item / nblk, nb = item % nblk, k0 = 64 * kb, n0 = 32 * nb;
#pragma unroll 8
    for (int i = 0; i < 32; ++i) { const int kk = 2 * i + (lane >> 5); scr[kk * 33 + (lane & 31)] = src[(size_t)(k0 + kk) * ld + n0 + (lane & 31)]; }
    LDS_WAIT(); asm volatile("" ::: "memory");
    const int cc = lane & 7;
#pragma unroll
    for (int j = 0; j < 4; ++j) { const int n = (lane >> 3) + 8 * j; const LAS float* s = scr + (8 * cc) * 33 + n;
        v4u o; o.x = pk2(s[0 * 33], s[1 * 33]); o.y = pk2(s[2 * 33], s[3 * 33]); o.z = pk2(s[4 * 33], s[5 * 33]); o.w = pk2(s[6 * 33], s[7 * 33]);
        *(v4u*)(dst + (size_t)(n0 + n) * K + k0 + 8 * cc) = o; }
    LDS_WAIT(); asm volatile("" ::: "memory");
}
constexpr int CV_I0 = 1792, CV_I1 = 1024, CV_I2 = 256, CV_I3 = 256, CV_I4 = 512, CV_I5 = 4096, CV_I6 = 4096, CV_I7 = 4096;
constexpr int CV_NIT = CV_I0 + CV_I1 + CV_I2 + CV_I3 + CV_I4 + CV_I5 + CV_I6 + CV_I7, CV_EARLY = CV_I0 + CV_I1;
__device__ __forceinline__ void convert_item(KArgs a, int l, int it, LAS float* scr, int lane) {
    bf16* WIN = (bf16*)(a->ws + WS_WIN); bf16* WEGU = (bf16*)(a->ws + WS_WEGU); bf16* WEDT = (bf16*)(a->ws + WS_WED);
    const float* win = a->in[I_WIN] + (size_t)l * 1024 * DIN;
    int r = it;
    if (r < CV_I0) { tr_item(win, DIN, WIN, 1024, 112, scr, r, lane); return; } r -= CV_I0;
    if (r < CV_I1) { tr_item(win + C_GATE, DIN, WIN + (size_t)C_BA * 1024, 1024, 64, scr, r, lane); return; } r -= CV_I1;
    if (r < CV_I2) { tr_item(a->in[I_WUPA] + (size_t)l * 512 * 1024, 1024, (bf16*)(a->ws + WS_WUPA), 512, 32, scr, r, lane); return; } r -= CV_I2;
    if (r < CV_I3) { tr_item(a->in[I_WUPB] + (size_t)l * 512 * 1024, 1024, (bf16*)(a->ws + WS_WUPB), 512, 32, scr, r, lane); return; } r -= CV_I3;
    if (r < CV_I4) { tr_item(a->in[I_WOUT] + (size_t)l * 1024 * 1024, 1024, (bf16*)(a->ws + WS_WOUT), 1024, 32, scr, r, lane); return; } r -= CV_I4;
    if (r < CV_I5) { const int E = r >> 7, rem = r & 127, pn = rem >> 6, q = rem & 63;
        tr_item(a->in[I_WEG] + ((size_t)(l * 32 + E) * 1024 * 256) + 128 * pn, 256, WEGU + (size_t)(E * 512 + 256 * pn) * 1024, 1024, 4, scr, q, lane); return; } r -= CV_I5;
    if (r < CV_I6) { const int E = r >> 7, rem = r & 127, pn = rem >> 6, q = rem & 63;
        tr_item(a->in[I_WEU] + ((size_t)(l * 32 + E) * 1024 * 256) + 128 * pn, 256, WEGU + (size_t)(E * 512 + 256 * pn + 128) * 1024, 1024, 4, scr, q, lane); return; } r -= CV_I6;
    { const int E = r >> 7, q = r & 127;
        tr_item(a->in[I_WED] + ((size_t)(l * 32 + E) * 256 * 1024), 1024, WEDT + (size_t)E * 1024 * 256, 256, 32, scr, q, lane); }
}
__device__ __forceinline__ void ph_convert(KArgs a, const Ctx& c, int l) {
    LAS float* scr = (LAS float*)(c.lds + 32768 + c.wave * 10240);
    const int gw = c.bid * NW + c.wave, NGW = c.G * NW;
    for (int it = gw; it < CV_EARLY; it += NGW) convert_item(a, l, it, scr, c.lane);
}
constexpr int CV_UNIT = 64, CV_NUNITS = (CV_NIT - CV_EARLY) / CV_UNIT;
static_assert((CV_NIT - CV_EARLY) % CV_UNIT == 0, "convert units");
__device__ __forceinline__ void convert_unit(KArgs a, const Ctx& c, int l, int cu) {
    LAS float* scr = (LAS float*)(c.lds + 32768 + c.wave * 10240);
#pragma unroll 1
    for (int i = 0; i < 8; ++i) convert_item(a, l, CV_EARLY + cu * CV_UNIT + c.wave * 8 + i, scr, c.lane);
}

__device__ __forceinline__ void load_row_x(KArgs a, int l, int m, int lane, f32x4 (&v)[4]) {
    const float* xr = (l == 0 ? a->in[I_X] : (const float*)a->out) + (size_t)m * DM;
#pragma unroll
    for (int j = 0; j < 4; ++j) v[j] = *(const f32x4*)(xr + 256 * j + 4 * lane);
    if (l > 0) {
        const int b = m >> 12;
        const float* g2 = (const float*)(a->ws + WS_MOD) + ((l - 1) * 4 + b) * 6144 + 5120;
        const bf16* ys = (const bf16*)(a->ws + WS_YS) + (size_t)m * 2048;
#pragma unroll
        for (int j = 0; j < 4; ++j) { const int col = 256 * j + 4 * lane; const v2u y0 = *(const v2u*)(ys + col), y1 = *(const v2u*)(ys + 1024 + col); const f32x4 g = *(const f32x4*)(g2 + col);
            v[j].x += g.x * (bflo(y0.x) + bflo(y1.x)); v[j].y += g.y * (bfhi(y0.x) + bfhi(y1.x)); v[j].z += g.z * (bflo(y0.y) + bflo(y1.y)); v[j].w += g.w * (bfhi(y0.y) + bfhi(y1.y)); }
        float* xo = a->out + (size_t)m * DM;
#pragma unroll
        for (int j = 0; j < 4; ++j) *(f32x4*)(xo + 256 * j + 4 * lane) = v[j];
    }
}
__device__ __forceinline__ float row_rstd(const f32x4 (&v)[4], int lane) {
    float s = 0.f;
#pragma unroll
    for (int j = 0; j < 4; ++j) s += (v[j].x * v[j].x + v[j].y * v[j].y) + (v[j].z * v[j].z + v[j].w * v[j].w);
    return __builtin_amdgcn_rsqf(wave_sum(s, lane) * (1.f / DM) + EPS);
}
__device__ __forceinline__ void ph_norm1(KArgs a, const Ctx& c, int l) {
    LAS float* wbaT = (LAS float*)c.lds;
    const float* win = a->in[I_WIN] + (size_t)l * 1024 * DIN + C_BA;
    for (int i = c.tid; i < 8192; i += NTHR) { const int k = i >> 3, cc = i & 7; wbaT[cc * 1024 + k] = win[(size_t)k * DIN + cc]; }
    __syncthreads();
    const int gw = c.bid * NW + c.wave, NGW = c.G * NW, lane = c.lane;
    bf16* H = (bf16*)(a->ws + WS_H); float* beta = (float*)(a->ws + WS_BETA); float* glog = (float*)(a->ws + WS_GLOG);
    const float* n1w = a->in[I_N1W] + l * DM;
    for (int m = gw; m < NTOK; m += NGW) {
        f32x4 v[4]; load_row_x(a, l, m, lane, v);
        const float rstd = row_rstd(v, lane);
        const int b = m >> 12; const float* mod = (const float*)(a->ws + WS_MOD) + (l * 4 + b) * 6144;
        float acc[8];
#pragma unroll
        for (int q = 0; q < 8; ++q) acc[q] = 0.f;
#pragma unroll
        for (int j = 0; j < 4; ++j) { const int col = 256 * j + 4 * lane;
            const f32x4 nw = *(const f32x4*)(n1w + col), sh = *(const f32x4*)(mod + col), sc = *(const f32x4*)(mod + 1024 + col);
            f32x4 h = v[j] * rstd * nw * (sc + 1.0f) + sh;
            v2u o; o.x = pk2(h.x, h.y); o.y = pk2(h.z, h.w); *(v2u*)(H + (size_t)m * DM + col) = o;
#pragma unroll
            for (int q = 0; q < 8; ++q) { const f32x4 w4 = *(const LAS f32x4*)(wbaT + q * 1024 + col); acc[q] += (h.x * w4.x + h.y * w4.y) + (h.z * w4.z + h.w * w4.w); } }
#pragma unroll
        for (int q = 0; q < 8; ++q) acc[q] = wave_sum(acc[q], lane);
        if (lane < 4) {
            const float bb = lane == 0 ? acc[0] : lane == 1 ? acc[1] : lane == 2 ? acc[2] : acc[3];
            const float aa = lane == 0 ? acc[4] : lane == 1 ? acc[5] : lane == 2 ? acc[6] : acc[7];
            beta[m * 4 + lane] = sigmoidf_(bb);
            const float z = aa + a->in[I_DTB][l * 4 + lane]; const float sp = fmaxf(z, 0.f) + log1pf(__expf(-fabsf(z)));
            glog[m * 4 + lane] = -__expf(a->in[I_ALOG][l * 4 + lane]) * sp;
        }
    }
}
__device__ __forceinline__ void ph_final(KArgs a, const Ctx& c) {
    const int gw = c.bid * NW + c.wave, NGW = c.G * NW, lane = c.lane;
    const float* fw = a->in[I_FNW];
    for (int m = gw; m < NTOK; m += NGW) {
        f32x4 v[4];
        {
            const float* xr = (const float*)a->out + (size_t)m * DM; const int b = m >> 12;
            const float* g2 = (const float*)(a->ws + WS_MOD) + ((NLAYER - 1) * 4 + b) * 6144 + 5120;
            const bf16* ys = (const bf16*)(a->ws + WS_YS) + (size_t)m * 2048;
#pragma unroll
            for (int j = 0; j < 4; ++j) { const int col = 256 * j + 4 * lane; v[j] = *(const f32x4*)(xr + col);
                const v2u y0 = *(const v2u*)(ys + col), y1 = *(const v2u*)(ys + 1024 + col); const f32x4 g = *(const f32x4*)(g2 + col);
                v[j].x += g.x * (bflo(y0.x) + bflo(y1.x)); v[j].y += g.y * (bfhi(y0.x) + bfhi(y1.x)); v[j].z += g.z * (bflo(y0.y) + bflo(y1.y)); v[j].w += g.w * (bfhi(y0.y) + bfhi(y1.y)); }
        }
        float rstd = row_rstd(v, lane);
#if defined(MK_PROBE_A) && MK_PROBE_A >= 0
        {   const unsigned long long* ts = (const unsigned long long*)((const unsigned*)(a->ws + WS_CTL) + 12288);
            float tA = 0.f, tB = 0.f;
            for (int ly = 0; ly < NLAYER; ++ly) { const int ka = 1 + ly * 11 + MK_PROBE_A, kb = 1 + ly * 11 + MK_PROBE_B;
                if (MK_PROBE_A < 11) tA += (float)(ts[ka + 1] - ts[ka]) * 0.01f; if (MK_PROBE_B < 11) tB += (float)(ts[kb + 1] - ts[kb]) * 0.01f; }
            if (MK_PROBE_A == 20) { tA = 0.f; for (int ly = 0; ly < NLAYER; ++ly) tA += (float)(ts[40 + ly] - ts[1 + ly * 11 + 3]) * 0.01f; }
            if (MK_PROBE_B == 21) { tB = 0.f; for (int ly = 0; ly < NLAYER; ++ly) tB += (float)(ts[44 + ly] - ts[1 + ly * 11 + 3]) * 0.01f; }
            if (MK_PROBE_A >= 22 && MK_PROBE_A <= 24) { tA = 0.f; for (int ly = 0; ly < NLAYER; ++ly) tA += (float)ts[48 + ly * 4 + MK_PROBE_A - 22] * 0.01f; }
            if (MK_PROBE_B >= 22 && MK_PROBE_B <= 24) { tB = 0.f; for (int ly = 0; ly < NLAYER; ++ly) tB += (float)ts[48 + ly * 4 + MK_PROBE_B - 22] * 0.01f; }
            if (MK_PROBE_A == 11) tA = (float)(ts[1] - ts[0]) * 0.01f; if (MK_PROBE_A == 12) tA = (float)(ts[23] - ts[0]) * 0.01f;
            if (MK_PROBE_B == 11) tB = (float)(ts[1] - ts[0]) * 0.01f; if (MK_PROBE_B == 12) tB = (float)(ts[23] - ts[0]) * 0.01f;
            rstd *= 1.f + sqrtf(tB * 1e-6f);
            if (m == 0 && lane == 0) v[0].x += tA * 0.05f / rstd / fw[0]; }
#endif
        float* xo = a->out + (size_t)m * DM;
#pragma unroll
        for (int j = 0; j < 4; ++j) { const int col = 256 * j + 4 * lane; const f32x4 w = *(const f32x4*)(fw + col); *(f32x4*)(xo + col) = v[j] * rstd * w; }
    }
}

__device__ __forceinline__ void ph_kmean(KArgs a, const Ctx& c) {
    const int gw = c.bid * NW + c.wave, NGW = c.G * NW, lane = c.lane;
    const bf16* QKVA = (const bf16*)(a->ws + WS_QKVA); float* kmean = (float*)(a->ws + WS_KMEAN);
    for (int item = gw; item < NB * HA * NBLK; item += NGW) {
        const int nb = item & 15, h = (item >> 4) & 7, b = item >> 7;
        const int sub = lane & 7, rr = lane >> 3;
        float s[8];
#pragma unroll
        for (int q = 0; q < 8; ++q) s[q] = 0.f;
        const bf16* kp = QKVA + (size_t)(b * SEQ + nb * MBLK) * 1536 + 512 + h * 64 + sub * 8;
#pragma unroll 4
        for (int it = 0; it < 32; ++it) { const v4u w = *(const v4u*)(kp + (size_t)(it * 8 + rr) * 1536);
            s[0] += bflo(w.x); s[1] += bfhi(w.x); s[2] += bflo(w.y); s[3] += bfhi(w.y); s[4] += bflo(w.z); s[5] += bfhi(w.z); s[6] += bflo(w.w); s[7] += bfhi(w.w); }
#pragma unroll
        for (int q = 0; q < 8; ++q) { s[q] += shx(s[q], 8, lane); s[q] += shx(s[q], 16, lane); s[q] += shx(s[q], 32, lane); }
        if (lane < 8) { float* o = kmean + (size_t)item * 64 + sub * 8;
            *(f32x4*)o = (f32x4){s[0], s[1], s[2], s[3]} * (1.f / 256.f); *(f32x4*)(o + 4) = (f32x4){s[4], s[5], s[6], s[7]} * (1.f / 256.f); }
    }
}

__device__ __forceinline__ void ph_attn_simple(KArgs a, const Ctx& c) {
    const int gw = c.bid * NW + c.wave, NGW = c.G * NW, lane = c.lane;
    LAS float* btab = (LAS float*)(c.lds);
    LAS float* scw = (LAS float*)(c.lds + 8192) + c.wave * 1024;
    const float* relb = a->in[I_RELB];
    for (int i = c.tid; i < 8 * 129; i += NTHR) { const int h = i / 129, d = i % 129; btab[h * 132 + d] = relb[(d < 128 ? (int)T5B[d] : 31) * 8 + h]; }
    __syncthreads();
    const bf16* QKVA = (const bf16*)(a->ws + WS_QKVA); const float* kmean = (const float*)(a->ws + WS_KMEAN); bf16* YA = (bf16*)(a->ws + WS_YA);
    for (int r = gw; r < NB * HA * SEQ; r += NGW) {
        const int s = r & (SEQ - 1), h = (r >> 12) & 7, b = r >> 15, qb = s >> 8, tok = b * SEQ + s;
        float qv[64];
        { const bf16* qp = QKVA + (size_t)tok * 1536 + h * 64;
#pragma unroll
          for (int q = 0; q < 8; ++q) { const v4u w = *(const v4u*)(qp + q * 8); qv[q * 8 + 0] = bflo(w.x); qv[q * 8 + 1] = bfhi(w.x); qv[q * 8 + 2] = bflo(w.y); qv[q * 8 + 3] = bfhi(w.y); qv[q * 8 + 4] = bflo(w.z); qv[q * 8 + 5] = bfhi(w.z); qv[q * 8 + 6] = bflo(w.w); qv[q * 8 + 7] = bfhi(w.w); } }
        float gate = -1e30f;
        if (lane < qb) { const float* km = kmean + (size_t)(((b * 8 + h) * 16) + lane) * 64; float d = 0.f;
#pragma unroll
            for (int q = 0; q < 16; ++q) { const f32x4 k4 = *(const f32x4*)(km + q * 4); d += qv[q * 4] * k4.x + qv[q * 4 + 1] * k4.y + qv[q * 4 + 2] * k4.z + qv[q * 4 + 3] * k4.w; }
            gate = d; }
        unsigned selmask = 0u;
#pragma unroll
        for (int t = 0; t < 3; ++t) { float best = -3e38f; int bi = 0;
#pragma unroll
            for (int n = 0; n < 16; ++n) { const float gv = shidx(gate, n); if (!((selmask >> n) & 1u) && gv > best) { best = gv; bi = n; } }
            selmask |= 1u << bi; }
        selmask &= (1u << qb) - 1u;
        selmask |= 1u << qb;
        int nseg = 0; float mx = -3e38f;
        for (int blk = 0; blk <= qb; ++blk) {
            if (!((selmask >> blk) & 1u)) continue;
            for (int i = 0; i < 4; ++i) { const int key = blk * 256 + i * 64 + lane; const bf16* kp = QKVA + (size_t)(b * SEQ + key) * 1536 + 512 + h * 64; float d = 0.f;
#pragma unroll
                for (int q = 0; q < 8; ++q) { const v4u w = *(const v4u*)(kp + q * 8);
                    d += qv[q * 8] * bflo(w.x) + qv[q * 8 + 1] * bfhi(w.x) + qv[q * 8 + 2] * bflo(w.y) + qv[q * 8 + 3] * bfhi(w.y) + qv[q * 8 + 4] * bflo(w.z) + qv[q * 8 + 5] * bfhi(w.z) + qv[q * 8 + 6] * bflo(w.w) + qv[q * 8 + 7] * bfhi(w.w); }
                const int dist = s - key; float sc = d * 0.125f + btab[h * 132 + (dist < 0 ? 0 : (dist > 128 ? 128 : dist))];
                if (dist < 0) sc = -3e38f;
                scw[nseg * 256 + i * 64 + lane] = sc; mx = fmaxf(mx, sc); }
            ++nseg; }
        mx = wave_max(mx, lane);
        float sum = 0.f;
        for (int idx = lane; idx < nseg * 256; idx += 64) { const float sc = scw[idx]; const float e = sc < -1e37f ? 0.f : __expf(sc - mx); scw[idx] = e; sum += e; }
        sum = wave_sum(sum, lane);
        LDS_WAIT();
        float o = 0.f; int sg = 0;
        for (int blk = 0; blk <= qb; ++blk) {
            if (!((selmask >> blk) & 1u)) continue;
            const bf16* vp = QKVA + (size_t)(b * SEQ + blk * 256) * 1536 + 1024 + h * 64 + lane;
            const int lim = (blk == qb) ? (s & 255) + 1 : 256;
#pragma unroll 8
            for (int kk = 0; kk < lim; ++kk) o += scw[sg * 256 + kk] * bf2f(vp[(size_t)kk * 1536]);
            ++sg; }
        YA[(size_t)tok * 512 + h * 64 + lane] = (bf16)f2bf(o / sum);
    }
}

template <int LDW> __device__ __forceinline__ void dn_load_chunk(KArgs a, const Ctx& c, int l, int b, int h, int t0, LAS float* qs, LAS float* ks, LAS float* vs) {
    const bf16* QKVB = (const bf16*)(a->ws + WS_QKVB); const float* cw = a->in[I_CONVW] + (size_t)l * 4 * 1536;
    const int cg = c.tid & 15, r0 = c.tid >> 4;
#pragma unroll
    for (int part = 0; part < 3; ++part) {
        const int colb = part * 512 + h * 128 + 8 * cg;
        float w[4][8];
#pragma unroll
        for (int i = 0; i < 4; ++i) { const f32x4 w0 = *(const f32x4*)(cw + i * 1536 + colb), w1 = *(const f32x4*)(cw + i * 1536 + colb + 4);
            w[i][0] = w0.x; w[i][1] = w0.y; w[i][2] = w0.z; w[i][3] = w0.w; w[i][4] = w1.x; w[i][5] = w1.y; w[i][6] = w1.z; w[i][7] = w1.w; }
        LAS float* dst = part == 0 ? qs : part == 1 ? ks : vs;
#pragma unroll
        for (int pass = 0; pass < 2; ++pass) {
            const int r = r0 + 32 * pass, t = t0 + r;
            float y[8];
#pragma unroll
            for (int e = 0; e < 8; ++e) y[e] = 0.f;
#pragma unroll
            for (int i = 0; i < 4; ++i) { const int tt = t - 3 + i; if (tt >= 0) { const v4u x = *(const v4u*)(QKVB + (size_t)(b * SEQ + tt) * 1536 + colb);
                y[0] += w[i][0] * bflo(x.x); y[1] += w[i][1] * bfhi(x.x); y[2] += w[i][2] * bflo(x.y); y[3] += w[i][3] * bfhi(x.y); y[4] += w[i][4] * bflo(x.z); y[5] += w[i][5] * bfhi(x.z); y[6] += w[i][6] * bflo(x.w); y[7] += w[i][7] * bfhi(x.w); } }
            float ss = 0.f;
#pragma unroll
            for (int e = 0; e < 8; ++e) { y[e] = siluf_(y[e]); ss += y[e] * y[e]; }
            if (part < 2) { ss += shx(ss, 1, c.lane); ss += shx(ss, 2, c.lane); ss += shx(ss, 4, c.lane); ss += shx(ss, 8, c.lane);
                const float rs = __builtin_amdgcn_rsqf(ss + EPS) * (part == 0 ? 0.08838834764831845f : 1.f);
#pragma unroll
                for (int e = 0; e < 8; ++e) y[e] *= rs; }
            *(LAS f32x4*)(dst + r * LDW + 8 * cg) = (f32x4){y[0], y[1], y[2], y[3]}; *(LAS f32x4*)(dst + r * LDW + 8 * cg + 4) = (f32x4){y[4], y[5], y[6], y[7]};
        }
    }
}
__device__ __forceinline__ void dn_store_chunk(KArgs a, const Ctx& c, int l, int b, int h, int t0, const LAS float* os) {
    const bf16* ZB = (const bf16*)(a->ws + WS_ZB); bf16* YB = (bf16*)(a->ws + WS_YB); const float* onw = a->in[I_ONW] + l * 128;
    const int r = c.tid >> 3, sub = c.tid & 7, tok = b * SEQ + t0 + r;
    float o[16]; float ss = 0.f;
#pragma unroll
    for (int q = 0; q < 4; ++q) { const f32x4 v = *(const LAS f32x4*)(os + r * 128 + sub * 16 + q * 4); o[q * 4] = v.x; o[q * 4 + 1] = v.y; o[q * 4 + 2] = v.z; o[q * 4 + 3] = v.w; ss += (v.x * v.x + v.y * v.y) + (v.z * v.z + v.w * v.w); }
    ss += shx(ss, 1, c.lane); ss += shx(ss, 2, c.lane); ss += shx(ss, 4, c.lane);
    const float rstd = __builtin_amdgcn_rsqf(ss * (1.f / 128.f) + EPS);
    const bf16* zp = ZB + (size_t)tok * 512 + h * 128 + sub * 16; bf16* yp = YB + (size_t)tok * 512 + h * 128 + sub * 16;
#pragma unroll
    for (int q = 0; q < 2; ++q) { const v4u z = *(const v4u*)(zp + q * 8); const f32x4 w0 = *(const f32x4*)(onw + sub * 16 + q * 8), w1 = *(const f32x4*)(onw + sub * 16 + q * 8 + 4);
        v4u y; y.x = pk2(o[q * 8 + 0] * rstd * w0.x * siluf_(bflo(z.x)), o[q * 8 + 1] * rstd * w0.y * siluf_(bfhi(z.x)));
        y.y = pk2(o[q * 8 + 2] * rstd * w0.z * siluf_(bflo(z.y)), o[q * 8 + 3] * rstd * w0.w * siluf_(bfhi(z.y)));
        y.z = pk2(o[q * 8 + 4] * rstd * w1.x * siluf_(bflo(z.z)), o[q * 8 + 5] * rstd * w1.y * siluf_(bfhi(z.z)));
        y.w = pk2(o[q * 8 + 6] * rstd * w1.z * siluf_(bflo(z.w)), o[q * 8 + 7] * rstd * w1.w * siluf_(bfhi(z.w)));
        *(v4u*)(yp + q * 8) = y; }
}
__device__ __forceinline__ void ph_dn_simple(KArgs a, const Ctx& c, int l) {
    LAS float* qs = (LAS float*)c.lds; LAS float* ks = qs + 8192; LAS float* vs = ks + 8192; LAS float* os = vs + 8192;
    LAS float* bt = (LAS float*)(c.lds + MISC_OFF + 1024); LAS float* at = bt + 64;
    const float* beta = (const float*)(a->ws + WS_BETA); const float* glog = (const float*)(a->ws + WS_GLOG);
    const int v = c.tid >> 2, kq = c.tid & 3;
    for (int item = c.bid; item < NB * HB; item += c.G) {
        const int b = item >> 2, h = item & 3;
        float S[32];
#pragma unroll
        for (int q = 0; q < 32; ++q) S[q] = 0.f;
        for (int n = 0; n < NCH; ++n) {
            const int t0 = n * DNC;
            __syncthreads();
            dn_load_chunk<128>(a, c, l, b, h, t0, qs, ks, vs);
            if (c.tid < 64) { const int tok = b * SEQ + t0 + c.tid; bt[c.tid] = beta[tok * 4 + h]; at[c.tid] = __expf(glog[tok * 4 + h]); }
            __syncthreads();
            for (int tt = 0; tt < DNC; ++tt) {
                const float a_t = at[tt], b_t = bt[tt];
                float kr[32];
#pragma unroll
                for (int q = 0; q < 8; ++q) { const f32x4 k4 = *(const LAS f32x4*)(ks + tt * 128 + kq * 32 + q * 4); kr[q * 4] = k4.x; kr[q * 4 + 1] = k4.y; kr[q * 4 + 2] = k4.z; kr[q * 4 + 3] = k4.w; }
                float kS = 0.f;
#pragma unroll
                for (int q = 0; q < 32; ++q) kS += kr[q] * S[q];
                kS += shx(kS, 1, c.lane); kS += shx(kS, 2, c.lane);
                const float vn = b_t * (vs[tt * 128 + v] - a_t * kS);
                float o = 0.f;
#pragma unroll
                for (int q = 0; q < 8; ++q) { const f32x4 q4 = *(const LAS f32x4*)(qs + tt * 128 + kq * 32 + q * 4);
                    S[q * 4] = a_t * S[q * 4] + kr[q * 4] * vn; S[q * 4 + 1] = a_t * S[q * 4 + 1] + kr[q * 4 + 1] * vn; S[q * 4 + 2] = a_t * S[q * 4 + 2] + kr[q * 4 + 2] * vn; S[q * 4 + 3] = a_t * S[q * 4 + 3] + kr[q * 4 + 3] * vn;
                    o += (q4.x * S[q * 4] + q4.y * S[q * 4 + 1]) + (q4.z * S[q * 4 + 2] + q4.w * S[q * 4 + 3]); }
                o += shx(o, 1, c.lane); o += shx(o, 2, c.lane);
                if (kq == 0) os[tt * 128 + v] = o;
            }
            __syncthreads();
            dn_store_chunk(a, c, l, b, h, t0, os);
        }
    }
}

struct EpiProj {
    static constexpr bool PERM = true, AFTER_DRAIN = false; unsigned char* ws;
    __device__ __forceinline__ void operator()(const pg8::f32x4 (&acc)[2][2][4][2], const pg8::Unit& u, int wr, int wc, int fr, int fq) const {
        const int pn = u.pn; bf16* base; int ld, ct; bool sg = false;
        if (pn < 6) { base = (bf16*)(ws + WS_QKVA); ld = 1536; ct = pn; } else if (pn < 12) { base = (bf16*)(ws + WS_QKVB); ld = 1536; ct = pn - 6; }
        else if (pn < 14) { base = (bf16*)(ws + WS_ZB); ld = 512; ct = pn - 12; } else { base = (bf16*)(ws + WS_GATES); ld = 2048; ct = pn - 14; sg = true; }
        const int row0 = u.pm * 256 + wr * 64 + fr, col0 = ct * 256 + wc * 32 + 8 * fq;
#pragma unroll
        for (int ai = 0; ai < 2; ++ai)
#pragma unroll
            for (int m = 0; m < 4; ++m) { bf16* rowp = base + (size_t)(row0 + ai * 128 + m * 16) * ld + col0;
#pragma unroll
                for (int bj = 0; bj < 2; ++bj) { f32x4 v0 = acc[ai][bj][m][0], v1 = acc[ai][bj][m][1];
                    if (sg) { v0.x = sigmoidf_(v0.x); v0.y = sigmoidf_(v0.y); v0.z = sigmoidf_(v0.z); v0.w = sigmoidf_(v0.w); v1.x = sigmoidf_(v1.x); v1.y = sigmoidf_(v1.y); v1.z = sigmoidf_(v1.z); v1.w = sigmoidf_(v1.w); }
                    v4u w; w.x = pk2(v0.x, v0.y); w.y = pk2(v0.z, v0.w); w.z = pk2(v1.x, v1.y); w.w = pk2(v1.z, v1.w);
                    *(v4u*)(rowp + bj * 128) = w; } }
    }
};
template <bool SECOND> struct EpiMerge {
    static constexpr bool PERM = true, AFTER_DRAIN = false; unsigned char* ws;
    __device__ __forceinline__ void operator()(const pg8::f32x4 (&acc)[2][2][4][2], const pg8::Unit& u, int wr, int wc, int fr, int fq) const {
        bf16* M = (bf16*)(ws + WS_M); const bf16* GT = (const bf16*)(ws + WS_GATES) + (SECOND ? 1024 : 0);
        const int row0 = u.pm * 256 + wr * 64 + fr, col0 = u.pn * 256 + wc * 32 + 8 * fq;
#pragma unroll
        for (int ai = 0; ai < 2; ++ai)
#pragma unroll
            for (int m = 0; m < 4; ++m) { const size_t row = row0 + ai * 128 + m * 16;
#pragma unroll
                for (int bj = 0; bj < 2; ++bj) { const int col = col0 + bj * 128; const f32x4 v0 = acc[ai][bj][m][0], v1 = acc[ai][bj][m][1];
                    const v4u g = *(const v4u*)(GT + row * 2048 + col);
                    float o[8] = {bflo(g.x) * v0.x, bfhi(g.x) * v0.y, bflo(g.y) * v0.z, bfhi(g.y) * v0.w, bflo(g.z) * v1.x, bfhi(g.z) * v1.y, bflo(g.w) * v1.z, bfhi(g.w) * v1.w};
                    if (SECOND) { const v4u p = *(const v4u*)(M + row * 1024 + col); o[0] += bflo(p.x); o[1] += bfhi(p.x); o[2] += bflo(p.y); o[3] += bfhi(p.y); o[4] += bflo(p.z); o[5] += bfhi(p.z); o[6] += bflo(p.w); o[7] += bfhi(p.w); }
                    v4u w; w.x = pk2(o[0], o[1]); w.y = pk2(o[2], o[3]); w.z = pk2(o[4], o[5]); w.w = pk2(o[6], o[7]);
                    *(v4u*)(M + row * 1024 + col) = w; } }
    }
};
struct EpiOut {
    static constexpr bool PERM = true, AFTER_DRAIN = false; const float* xin; float* xout; const float* g1;
    __device__ __forceinline__ void operator()(const pg8::f32x4 (&acc)[2][2][4][2], const pg8::Unit& u, int wr, int wc, int fr, int fq) const {
        const int row0 = u.pm * 256 + wr * 64 + fr, col0 = u.pn * 256 + wc * 32 + 8 * fq; const int b = (u.pm * 256) >> 12;
#pragma unroll
        for (int bj = 0; bj < 2; ++bj) { const int col = col0 + bj * 128; const f32x4 ga = *(const f32x4*)(g1 + b * 6144 + col), gb = *(const f32x4*)(g1 + b * 6144 + col + 4);
#pragma unroll
            for (int ai = 0; ai < 2; ++ai)
#pragma unroll
                for (int m = 0; m < 4; ++m) { const size_t off = (size_t)(row0 + ai * 128 + m * 16) * DM + col;
                    const f32x4 x0 = *(const f32x4*)(xin + off), x1 = *(const f32x4*)(xin + off + 4);
                    *(f32x4*)(xout + off) = x0 + ga * acc[ai][bj][m][0]; *(f32x4*)(xout + off + 4) = x1 + gb * acc[ai][bj][m][1]; } }
    }
};
struct EpiMoeGU {
    static constexpr bool PERM = true, AFTER_DRAIN = false; unsigned char* ws;
    __device__ __forceinline__ void operator()(const pg8::f32x4 (&acc)[2][2][4][2], const pg8::Unit& u, int wr, int wc, int fr, int fq) const {
        bf16* ACT = (bf16*)(ws + WS_ACT);
        const int row0 = u.pm * 256 + wr * 64 + fr, col0 = (u.pn & 1) * 128 + wc * 32 + 8 * fq;
#pragma unroll
        for (int ai = 0; ai < 2; ++ai)
#pragma unroll
            for (int m = 0; m < 4; ++m) { const f32x4 g0 = acc[ai][0][m][0], g1 = acc[ai][0][m][1], u0 = acc[ai][1][m][0], u1 = acc[ai][1][m][1];
                v4u w; w.x = pk2(siluf_(g0.x) * u0.x, siluf_(g0.y) * u0.y); w.y = pk2(siluf_(g0.z) * u0.z, siluf_(g0.w) * u0.w); w.z = pk2(siluf_(g1.x) * u1.x, siluf_(g1.y) * u1.y); w.w = pk2(siluf_(g1.z) * u1.z, siluf_(g1.w) * u1.w);
                *(v4u*)(ACT + (size_t)(row0 + ai * 128 + m * 16) * 256 + col0) = w; }
    }
};
struct EpiMoeDown {
    static constexpr bool PERM = true, AFTER_DRAIN = false; unsigned char* ws;
    __device__ __forceinline__ void operator()(const pg8::f32x4 (&acc)[2][2][4][2], const pg8::Unit& u, int wr, int wc, int fr, int fq) const {
        bf16* YS = (bf16*)(ws + WS_YS); const int* rowtok = (const int*)(ws + WS_ROWTOK); const float* roww = (const float*)(ws + WS_ROWW);
        const int row0 = u.pm * 256 + wr * 64 + fr, col0 = (u.pn & 3) * 256 + wc * 32 + 8 * fq;
#pragma unroll
        for (int ai = 0; ai < 2; ++ai)
#pragma unroll
            for (int m = 0; m < 4; ++m) { const int row = row0 + ai * 128 + m * 16; const int rt = rowtok[row]; const float wgt = roww[row];
                if (rt >= 0) {
#pragma unroll
                    for (int bj = 0; bj < 2; ++bj) { const f32x4 v0 = acc[ai][bj][m][0] * wgt, v1 = acc[ai][bj][m][1] * wgt;
                        v4u w; w.x = pk2(v0.x, v0.y); w.y = pk2(v0.z, v0.w); w.z = pk2(v1.x, v1.y); w.w = pk2(v1.z, v1.w);
                        *(v4u*)(YS + (size_t)rt * 1024 + col0 + bj * 128) = w; } } }
    }
};
struct MoeOrder {
    const LAS int* tile_exp; int nunits, G, c, sh;
    __device__ __forceinline__ bool next(int i, pg8::Unit& u) const {
        const int L = i * G + c; if (L >= nunits) return false;
        const int r = L >> sh, j = L & ((1 << sh) - 1);
        u.pm = r; u.pn = __builtin_amdgcn_readfirstlane((tile_exp[r] << sh) + j); return true;
    }
    __device__ __forceinline__ void a_ready(const pg8::Unit&) const {}
    __device__ __forceinline__ void done(const pg8::Unit&) const {}
};

__device__ __forceinline__ void ph_router(KArgs a, const Ctx& c, int l) {
    LAS int* lcnt = (LAS int*)(c.lds + MISC_OFF + 1024);
    LAS int* lbase = lcnt + 32;
    LAS int* tinf = lcnt + 64;
    LAS float* wreT = (LAS float*)c.lds;
    const int lane = c.lane;
    bf16* H2 = (bf16*)(a->ws + WS_H); unsigned* tokinfo = (unsigned*)(a->ws + WS_TOKINFO); int* rowtok = (int*)(a->ws + WS_ROWTOK);
    unsigned* gcnt = (unsigned*)(a->ws + WS_CTL) + CW_GCNT + l * 32;
    const float* n2w = a->in[I_N2W] + l * DM; const float* wrg = a->in[I_WRG] + (size_t)l * 1024 * 4; const float* wre = a->in[I_WRE] + (size_t)l * 1024 * 32;
    for (int i = c.bid * NTHR + c.tid; i < MOE_MAXROWS; i += c.G * NTHR) rowtok[i] = -1;
    for (int i = c.tid; i < 8192; i += NTHR) { const int k = i >> 3, n4 = (i & 7) * 4; const f32x4 w = *(const f32x4*)(wre + (size_t)k * 32 + n4);
        wreT[(n4 + 0) * 1024 + k] = w.x; wreT[(n4 + 1) * 1024 + k] = w.y; wreT[(n4 + 2) * 1024 + k] = w.z; wreT[(n4 + 3) * 1024 + k] = w.w; }
    for (int tb = c.bid; tb < NTOK / 64; tb += c.G) {
        __syncthreads();
        if (c.tid < 32) lcnt[c.tid] = 0;
        __syncthreads();
        for (int i = 0; i < 8; ++i) {
            const int tl = c.wave * 8 + i, m = tb * 64 + tl, b = m >> 12;
            const float* xr = (const float*)a->out + (size_t)m * DM; const float* mod = (const float*)(a->ws + WS_MOD) + (l * 4 + b) * 6144;
            f32x4 h[4];
#pragma unroll
            for (int j = 0; j < 4; ++j) h[j] = *(const f32x4*)(xr + 256 * j + 4 * lane);
            const float rstd = row_rstd(h, lane);
            float ag[4] = {0.f, 0.f, 0.f, 0.f};
#pragma unroll
            for (int j = 0; j < 4; ++j) { const int col = 256 * j + 4 * lane;
                const f32x4 nw = *(const f32x4*)(n2w + col), sh = *(const f32x4*)(mod + 3072 + col), sc = *(const f32x4*)(mod + 4096 + col);
                h[j] = h[j] * rstd * nw * (sc + 1.0f) + sh;
                v2u o; o.x = pk2(h[j].x, h[j].y); o.y = pk2(h[j].z, h[j].w); *(v2u*)(H2 + (size_t)m * DM + col) = o;
                const f32x4 r0 = *(const f32x4*)(wrg + (size_t)(col + 0) * 4), r1 = *(const f32x4*)(wrg + (size_t)(col + 1) * 4), r2 = *(const f32x4*)(wrg + (size_t)(col + 2) * 4), r3 = *(const f32x4*)(wrg + (size_t)(col + 3) * 4);
                ag[0] += h[j].x * r0.x + h[j].y * r1.x + h[j].z * r2.x + h[j].w * r3.x; ag[1] += h[j].x * r0.y + h[j].y * r1.y + h[j].z * r2.y + h[j].w * r3.y;
                ag[2] += h[j].x * r0.z + h[j].y * r1.z + h[j].z * r2.z + h[j].w * r3.z; ag[3] += h[j].x * r0.w + h[j].y * r1.w + h[j].z * r2.w + h[j].w * r3.w; }
#pragma unroll
            for (int q = 0; q < 4; ++q) ag[q] = wave_sum(ag[q], lane) + a->in[I_BRG][l * 4 + q];
            int g = 0; float gm = ag[0];
#pragma unroll
            for (int q = 1; q < 4; ++q) if (ag[q] > gm) { gm = ag[q]; g = q; }
            float den = 0.f;
#pragma unroll
            for (int q = 0; q < 4; ++q) den += __expf(ag[q] - gm);
            const float ptop = 1.f / den;
            float ae[8] = {0.f, 0.f, 0.f, 0.f, 0.f, 0.f, 0.f, 0.f};
#pragma unroll
            for (int j = 0; j < 4; ++j) { const int col = 256 * j + 4 * lane;
#pragma unroll
                for (int e = 0; e < 8; ++e) { const f32x4 w = *(const LAS f32x4*)(wreT + (g * 8 + e) * 1024 + col); ae[e] += (h[j].x * w.x + h[j].y * w.y) + (h[j].z * w.z + h[j].w * w.w); } }
#pragma unroll
            for (int q = 0; q < 8; ++q) ae[q] = wave_sum(ae[q], lane) + a->in[I_BRE][l * 32 + g * 8 + q];
            int e0 = 0; float v0 = ae[0];
#pragma unroll
            for (int q = 1; q < 8; ++q) if (ae[q] > v0) { v0 = ae[q]; e0 = q; }
            int e1 = -1; float v1 = -3e38f;
#pragma unroll
            for (int q = 0; q < 8; ++q) if (q != e0 && ae[q] > v1) { v1 = ae[q]; e1 = q; }
            const float ex = __expf(v1 - v0); const float w0 = ptop / (1.f + ex), w1 = ptop * ex / (1.f + ex);
            if (lane == 0) { const int E0 = g * 8 + e0, E1 = g * 8 + e1;
                const int r0 = atomicAdd((int*)(lcnt + E0), 1), r1 = atomicAdd((int*)(lcnt + E1), 1);
                tinf[tl * 6 + 0] = E0; tinf[tl * 6 + 1] = E1; tinf[tl * 6 + 2] = r0; tinf[tl * 6 + 3] = r1; tinf[tl * 6 + 4] = __float_as_int(w0); tinf[tl * 6 + 5] = __float_as_int(w1); }
        }
        __syncthreads();
        if (c.tid < 32) lbase[c.tid] = (int)__hip_atomic_fetch_add(gcnt + c.tid, (unsigned)lcnt[c.tid], RLX_AGENT);
        __syncthreads();
        if (c.tid < 64) { const int m = tb * 64 + c.tid; const int E0 = tinf[c.tid * 6], E1 = tinf[c.tid * 6 + 1];
            v4u o; o.x = (unsigned)E0; o.y = (unsigned)E1; o.z = (unsigned)(lbase[E0] + tinf[c.tid * 6 + 2]); o.w = (unsigned)(lbase[E1] + tinf[c.tid * 6 + 3]);
            *(v4u*)(tokinfo + (size_t)m * 8) = o; *(v2u*)(tokinfo + (size_t)m * 8 + 4) = (v2u){(unsigned)tinf[c.tid * 6 + 4], (unsigned)tinf[c.tid * 6 + 5]}; }
    }
}
__device__ __forceinline__ void moe_table(KArgs a, const Ctx& c, int l) {
    LAS int* tile_exp = (LAS int*)(c.lds + MISC_OFF + 2048); LAS int* offs = tile_exp + 192; LAS int* ntl = offs + 32; LAS int* pre = ntl + 4;
    const unsigned* gcnt = (const unsigned*)(a->ws + WS_CTL) + CW_GCNT + l * 32;
    __syncthreads();
    if (c.tid < 64) { const int e = c.tid & 31; const int cnt = (int)__hip_atomic_load(gcnt + e, RLX_AGENT); const int nt = (cnt + 255) >> 8; int inc = nt;
#pragma unroll
        for (int o = 1; o < 32; o <<= 1) { const int v = shidx_i(inc, (c.lane - o) & 63); if (e >= o) inc += v; }
        if (c.tid < 32) { offs[e] = (inc - nt) * 256; pre[e] = inc; if (e == 31) ntl[0] = inc; } }
    __syncthreads();
    if (c.tid < MOE_MAXTILES) { int E = 0;
#pragma unroll
        for (int e = 0; e < 32; ++e) E += (pre[e] <= c.tid) ? 1 : 0;
        tile_exp[c.tid] = E < 31 ? E : 31; }
    __syncthreads();
}
__device__ __forceinline__ void ph_gather(KArgs a, const Ctx& c, int l) {
    moe_table(a, c, l);
    const LAS int* offs = (const LAS int*)(c.lds + MISC_OFF + 2048) + 192;
    const int gw = c.bid * NW + c.wave, NGW = c.G * NW, lane = c.lane;
    const bf16* H2 = (const bf16*)(a->ws + WS_H); bf16* HS = (bf16*)(a->ws + WS_HS); const unsigned* tokinfo = (const unsigned*)(a->ws + WS_TOKINFO);
    int* rowtok = (int*)(a->ws + WS_ROWTOK); float* roww = (float*)(a->ws + WS_ROWW);
    for (int m = gw; m < NTOK; m += NGW) {
        const v4u ti = *(const v4u*)(tokinfo + (size_t)m * 8); const v2u tw = *(const v2u*)(tokinfo + (size_t)m * 8 + 4);
        const int d0 = offs[ti.x] + (int)ti.z, d1 = offs[ti.y] + (int)ti.w;
        const v4u x0 = *(const v4u*)(H2 + (size_t)m * DM + lane * 8), x1 = *(const v4u*)(H2 + (size_t)m * DM + 512 + lane * 8);
        *(v4u*)(HS + (size_t)d0 * DM + lane * 8) = x0; *(v4u*)(HS + (size_t)d0 * DM + 512 + lane * 8) = x1;
        *(v4u*)(HS + (size_t)d1 * DM + lane * 8) = x0; *(v4u*)(HS + (size_t)d1 * DM + 512 + lane * 8) = x1;
        if (lane == 0) { rowtok[d0] = m * 2; rowtok[d1] = m * 2 + 1; roww[d0] = __uint_as_float(tw.x); roww[d1] = __uint_as_float(tw.y); }
    }
}
constexpr int DN_IMG = 57344, DN_LDW = 132, DN_LDA = 68;
typedef __bf16 bf16x2_t __attribute__((ext_vector_type(2)));
typedef float f32x2_t __attribute__((ext_vector_type(2)));
__device__ __forceinline__ unsigned cvtpk(float lo, float hi) { f32x2_t v = {lo, hi}; bf16x2_t b = __builtin_convertvector(v, bf16x2_t); return __builtin_bit_cast(unsigned, b); }
__device__ __forceinline__ bf16x8 pack8(f32x4 a, f32x4 b) { v4u w; w.x = cvtpk(a.x, a.y); w.y = cvtpk(a.z, a.w); w.z = cvtpk(b.x, b.y); w.w = cvtpk(b.z, b.w); return __builtin_bit_cast(bf16x8, w); }
#define MFMA16(a, b, c) __builtin_amdgcn_mfma_f32_16x16x32_bf16((a), (b), (c), 0, 0, 0)

__device__ __forceinline__ void ph_dn_prep(KArgs a, const Ctx& c, int l) {
    LAS float* qs = (LAS float*)c.lds; LAS float* ks = qs + 64 * DN_LDW; LAS float* vs = ks + 64 * DN_LDW;
    LAS float* Am = vs + 64 * DN_LDW; LAS float* Pm = Am + 64 * DN_LDA;
    LAS float* bt = (LAS float*)(c.lds + MISC_OFF + 1024); LAS float* Gc = bt + 64;
    const float* beta = (const float*)(a->ws + WS_BETA); const float* glog = (const float*)(a->ws + WS_GLOG);
    const int lane = c.lane, row = lane & 15, quad = lane >> 4, tid = c.tid;
    for (int item = c.bid; item < NB * HB * NCH; item += c.G) {
        const int n = item & 63, h = (item >> 6) & 3, b = item >> 8, t0 = n * DNC;
        unsigned char* img = a->ws + WS_IMG + (size_t)item * DN_IMG;
        __syncthreads();
        dn_load_chunk<DN_LDW>(a, c, l, b, h, t0, qs, ks, vs);
        if (tid < 64) { const int tok = b * SEQ + t0 + tid; bt[tid] = beta[tok * 4 + h]; float g = glog[tok * 4 + h];
#pragma unroll
            for (int o = 1; o < 64; o <<= 1) { const float v = shidx(g, (lane - o) & 63); if (lane >= o) g += v; }
            Gc[tid] = g; }
        __syncthreads();
        {   const int sel = c.wave >> 2, ti = c.wave & 3; const LAS float* rs = sel == 0 ? ks : qs; LAS float* dstm = sel == 0 ? Am : Pm;
            bf16x8 af[4];
#pragma unroll
            for (int s = 0; s < 4; ++s) { const LAS float* p = rs + (ti * 16 + row) * DN_LDW + 32 * s + 8 * quad; af[s] = pack8(*(const LAS f32x4*)p, *(const LAS f32x4*)(p + 4)); }
            for (int tj = 0; tj < 4; ++tj) {
                f32x4 acc = {0.f, 0.f, 0.f, 0.f};
                if (tj <= ti) {
#pragma unroll
                    for (int s = 0; s < 4; ++s) { const LAS float* p = ks + (tj * 16 + row) * DN_LDW + 32 * s + 8 * quad; const bf16x8 bfr = pack8(*(const LAS f32x4*)p, *(const LAS f32x4*)(p + 4)); acc = MFMA16(af[s], bfr, acc); }
                }
                const int j = tj * 16 + row; const float Gj = Gc[j];
#pragma unroll
                for (int r = 0; r < 4; ++r) { const int i = ti * 16 + 4 * quad + r; const float dec = __expf(fminf(Gc[i] - Gj, 0.f));
                    float v = acc[r] * dec; if (sel == 0) v = (j < i) ? v * bt[i] : 0.f; else v = (j <= i) ? v : 0.f;
                    if (sel == 0) dstm[j * DN_LDA + i] = v; else dstm[i * DN_LDA + j] = v; }
            }
        }
        __syncthreads();
        const float Glast = Gc[63];
        {
            for (int q = 0; q < 5; ++q) { const int p = tid + 512 * q, blk = p >> 6; float v[8];
                if (blk < 16) { const int mt = blk >> 2, s = blk & 3, cr = 16 * mt + row, k0 = 32 * s + 4 * quad; const float e = __expf(Gc[cr]);
                    const f32x4 v0 = *(const LAS f32x4*)(qs + cr * DN_LDW + k0), v1 = *(const LAS f32x4*)(qs + cr * DN_LDW + k0 + 16);
                    v[0] = v0.x * e; v[1] = v0.y * e; v[2] = v0.z * e; v[3] = v0.w * e; v[4] = v1.x * e; v[5] = v1.y * e; v[6] = v1.z * e; v[7] = v1.w * e; }
                else if (blk < 32) { const int b2 = blk - 16, mt = b2 >> 1, s = b2 & 1, k = 16 * mt + row;
#pragma unroll
                    for (int j = 0; j < 8; ++j) { const int cj = 32 * s + 16 * (j >> 2) + 4 * quad + (j & 3); v[j] = ks[cj * DN_LDW + k] * __expf(Glast - Gc[cj]); } }
                else { const int b3 = blk - 32, mt = b3 >> 1, s = b3 & 1, i = 16 * mt + row, c0 = 32 * s + 4 * quad;
                    const f32x4 v0 = *(const LAS f32x4*)(Pm + i * DN_LDA + c0), v1 = *(const LAS f32x4*)(Pm + i * DN_LDA + c0 + 16);
                    v[0] = v0.x; v[1] = v0.y; v[2] = v0.z; v[3] = v0.w; v[4] = v1.x; v[5] = v1.y; v[6] = v1.z; v[7] = v1.w; }
                v4u w; w.x = cvtpk(v[0], v[1]); w.y = cvtpk(v[2], v[3]); w.z = cvtpk(v[4], v[5]); w.w = cvtpk(v[6], v[7]);
                *(v4u*)(img + 16384 + (size_t)p * 16) = w; }
            if (tid == 0) ((float*)(a->ws + WS_GL))[item] = __expf(Glast);
        }
        __syncthreads();
        if (tid < 256) {
            int vz = 0; asm volatile("" : "+v"(vz));
            const LAS float* AT = Am + vz; const LAS float* btV = bt + vz; const LAS float* GcV = Gc + vz;
            const bool isw = tid >= 128; LAS float* xc = (isw ? ks : vs) + (tid & 127);
#pragma unroll
            for (int bI = 0; bI < 4; ++bI) {
                float s[16];
#pragma unroll
                for (int r = 0; r < 16; ++r) { const int i = 16 * bI + r; float rhs = xc[i * DN_LDW] * btV[i]; if (isw) rhs *= __expf(GcV[i]); s[r] = rhs; }
                for (int j = 0; j < 16 * bI; ++j) { const float xj = xc[j * DN_LDW]; const LAS float* ap = AT + j * DN_LDA + 16 * bI;
#pragma unroll
                    for (int q = 0; q < 4; ++q) { const f32x4 a4 = *(const LAS f32x4*)(ap + 4 * q); s[4 * q] -= a4.x * xj; s[4 * q + 1] -= a4.y * xj; s[4 * q + 2] -= a4.z * xj; s[4 * q + 3] -= a4.w * xj; } }
#pragma unroll
                for (int rp = 0; rp < 15; ++rp) { const LAS float* ap = AT + (16 * bI + rp) * DN_LDA + 16 * bI;
#pragma unroll
                    for (int q = (rp + 1) / 4; q < 4; ++q) { const f32x4 a4 = *(const LAS f32x4*)(ap + 4 * q);
                        if (4 * q + 0 > rp) s[4 * q + 0] -= a4.x * s[rp]; if (4 * q + 1 > rp) s[4 * q + 1] -= a4.y * s[rp]; if (4 * q + 2 > rp) s[4 * q + 2] -= a4.z * s[rp]; if (4 * q + 3 > rp) s[4 * q + 3] -= a4.w * s[rp]; } }
#pragma unroll
                for (int r = 0; r < 16; ++r) xc[(16 * bI + r) * DN_LDW] = s[r];
            }
        }
        __syncthreads();
#pragma unroll
        for (int q = 0; q < 2; ++q) { const int p = tid + 512 * q, blk = p >> 6, mt = blk >> 2, s = blk & 3, cr = 16 * mt + row, k0 = 32 * s + 4 * quad;
            const f32x4 v0 = *(const LAS f32x4*)(ks + cr * DN_LDW + k0), v1 = *(const LAS f32x4*)(ks + cr * DN_LDW + k0 + 16);
            v4u w; w.x = cvtpk(-v0.x, -v0.y); w.y = cvtpk(-v0.z, -v0.w); w.z = cvtpk(-v1.x, -v1.y); w.w = cvtpk(-v1.z, -v1.w);
            *(v4u*)(img + (size_t)p * 16) = w; }
        {   unsigned char* ug = a->ws + WS_U + (size_t)item * 16384;
#pragma unroll
            for (int q = 0; q < 2; ++q) { const int p = tid + 512 * q, sl = p >> 7, ln = (p >> 1) & 63, hh = p & 1, v = 16 * sl + (ln & 15), qd = ln >> 4; float u8[8];
#pragma unroll
                for (int e = 0; e < 8; ++e) u8[e] = vs[(16 * (2 * hh + (e >> 2)) + 4 * qd + (e & 3)) * DN_LDW + v];
                v4u w; w.x = cvtpk(u8[0], u8[1]); w.y = cvtpk(u8[2], u8[3]); w.z = cvtpk(u8[4], u8[5]); w.w = cvtpk(u8[6], u8[7]);
                *(v4u*)(ug + (size_t)(sl * 64 + ln) * 32 + hh * 16) = w; } }
    }
}

__device__ __forceinline__ void ph_dn_scan(KArgs a, const Ctx& c, int l) {
    LAS unsigned char* lds = c.lds; LAS unsigned short* os = (LAS unsigned short*)(lds + 2 * DN_IMG);
    const int lane = c.lane, wv = c.wave, tid = c.tid;
    const bf16* ZB = (const bf16*)(a->ws + WS_ZB); bf16* YB = (bf16*)(a->ws + WS_YB); const float* onw = a->in[I_ONW] + l * 128; const float* glp = (const float*)(a->ws + WS_GL);
    for (int item = c.bid; item < NB * HB; item += c.G) {
        const int b = item >> 2, h = item & 3;
        const unsigned char* img0 = a->ws + WS_IMG + (size_t)item * 64 * DN_IMG; const unsigned char* ugb = a->ws + WS_U + (size_t)item * 64 * 16384; const unsigned uoff = (unsigned)(wv * 64 + lane) * 32u;
        const int nr = tid >> 3, nsub = tid & 7;
        const unsigned zoff = (unsigned)(nr * 512 + nsub * 16);
        const bf16* zpb = ZB + (size_t)(b * SEQ) * 512 + h * 128; bf16* ypb = YB + (size_t)(b * SEQ) * 512 + h * 128;
#define ug0 (ugb + uoff)
#define zp0 (zpb + zoff)
#define yp0 (ypb + zoff)
        f32x4 S[8];
#pragma unroll
        for (int m = 0; m < 8; ++m) S[m] = (f32x4){0.f, 0.f, 0.f, 0.f};
        __syncthreads();
#define DN_DMA(n, buf) do { _Pragma("unroll") for (int q_ = 0; q_ < 7; ++q_) { const int pc_ = wv + 8 * q_; \
            __builtin_amdgcn_global_load_lds((const unsigned*)(img0 + (size_t)(n) * DN_IMG + pc_ * 1024 + lane * 16), (LAS unsigned*)(lds + (buf) * DN_IMG + pc_ * 1024), 16, 0, 0); } } while (0)
        DN_DMA(0, 0);
        v4u ucur0 = *(const v4u*)ug0, ucur1 = *(const v4u*)(ug0 + 16);
        v4u zc0 = *(const v4u*)zp0, zc1 = *(const v4u*)(zp0 + 8);
        float glc = glp[item * 64];
#if MK_PROBE_A >= 0
        unsigned long long tp0 = 0, tp1 = 0, tp2 = 0, tq = __builtin_amdgcn_s_memrealtime();
#define DN_TICK(acc) do { const unsigned long long t_ = __builtin_amdgcn_s_memrealtime(); acc += t_ - tq; tq = t_; } while (0)
#else
#define DN_TICK(acc) do {} while (0)
#endif
        for (int n = 0; n < NCH; ++n) {
            asm volatile("s_waitcnt vmcnt(0)" ::: "memory"); __syncthreads();
            DN_TICK(tp0);
            v4u un0 = ucur0, un1 = ucur1, zn0 = zc0, zn1 = zc1; float gln = glc;
            if (n + 1 < NCH) { DN_DMA(n + 1, (n + 1) & 1); un0 = *(const v4u*)(ug0 + (size_t)(n + 1) * 16384); un1 = *(const v4u*)(ug0 + (size_t)(n + 1) * 16384 + 16);
                zn0 = *(const v4u*)(zp0 + (size_t)(n + 1) * DNC * 512); zn1 = *(const v4u*)(zp0 + (size_t)(n + 1) * DNC * 512 + 8); gln = glp[item * 64 + n + 1]; }
            asm volatile("" ::: "memory");
            const LAS unsigned char* im = lds + (n & 1) * DN_IMG + lane * 16;
            bf16x8 Sb[4];
#pragma unroll
            for (int s = 0; s < 4; ++s) Sb[s] = pack8(S[2 * s], S[2 * s + 1]);
            f32x4 X[4], O[4];
            X[0] = (f32x4){bflo(ucur0.x), bfhi(ucur0.x), bflo(ucur0.y), bfhi(ucur0.y)}; X[1] = (f32x4){bflo(ucur0.z), bfhi(ucur0.z), bflo(ucur0.w), bfhi(ucur0.w)};
            X[2] = (f32x4){bflo(ucur1.x), bfhi(ucur1.x), bflo(ucur1.y), bfhi(ucur1.y)}; X[3] = (f32x4){bflo(ucur1.z), bfhi(ucur1.z), bflo(ucur1.w), bfhi(ucur1.w)};
            bf16x8 fa[8], fb[8];
#define DN_LDF(arr, off) do { _Pragma("unroll") for (int q_ = 0; q_ < 8; ++q_) arr[q_] = *(const LAS bf16x8*)(im + (off) + q_ * 1024); } while (0)
            DN_LDF(fa, 0); DN_LDF(fb, 8192);
#pragma unroll
            for (int mt = 0; mt < 2; ++mt)
#pragma unroll
                for (int s = 0; s < 4; ++s) X[mt] = MFMA16(fa[mt * 4 + s], Sb[s], X[mt]);
            DN_LDF(fa, 16384);
#pragma unroll
            for (int mt = 0; mt < 2; ++mt)
#pragma unroll
                for (int s = 0; s < 4; ++s) X[2 + mt] = MFMA16(fb[mt * 4 + s], Sb[s], X[2 + mt]);
            DN_LDF(fb, 16384 + 8192);
#pragma unroll
            for (int mt = 0; mt < 2; ++mt) { O[mt] = (f32x4){0.f, 0.f, 0.f, 0.f};
#pragma unroll
                for (int s = 0; s < 4; ++s) O[mt] = MFMA16(fa[mt * 4 + s], Sb[s], O[mt]); }
            DN_LDF(fa, 32768);
#pragma unroll
            for (int mt = 0; mt < 2; ++mt) { O[2 + mt] = (f32x4){0.f, 0.f, 0.f, 0.f};
#pragma unroll
                for (int s = 0; s < 4; ++s) O[2 + mt] = MFMA16(fb[mt * 4 + s], Sb[s], O[2 + mt]); }
            DN_LDF(fb, 32768 + 8192);
            bf16x8 Xb[2];
            Xb[0] = pack8(X[0], X[1]); Xb[1] = pack8(X[2], X[3]);
#pragma unroll
            for (int m = 0; m < 4; ++m) { S[m] = S[m] * glc;
#pragma unroll
                for (int s = 0; s < 2; ++s) S[m] = MFMA16(fa[m * 2 + s], Xb[s], S[m]); }
            DN_LDF(fa, 49152);
#pragma unroll
            for (int m = 0; m < 4; ++m) { S[4 + m] = S[4 + m] * glc;
#pragma unroll
                for (int s = 0; s < 2; ++s) S[4 + m] = MFMA16(fb[m * 2 + s], Xb[s], S[4 + m]); }
#pragma unroll
            for (int mt = 0; mt < 4; ++mt)
#pragma unroll
                for (int s = 0; s < 2; ++s) O[mt] = MFMA16(fa[mt * 2 + s], Xb[s], O[mt]);
#undef DN_LDF
#pragma unroll
            for (int mt = 0; mt < 4; ++mt)
#pragma unroll
                for (int r = 0; r < 4; ++r) os[(16 * mt + 4 * (lane >> 4) + r) * 128 + 16 * wv + (lane & 15)] = (unsigned short)(cvtpk(O[mt][r], 0.f) & 0xffffu);
            DN_TICK(tp1);
            asm volatile("s_waitcnt lgkmcnt(0)\n\ts_barrier" ::: "memory");
            {
                float o[16]; float ss = 0.f; f32x4 ow[4];
#pragma unroll
                for (int q = 0; q < 4; ++q) ow[q] = *(const f32x4*)(onw + nsub * 16 + q * 4);
                const v4u o0 = *(const LAS v4u*)(os + nr * 128 + nsub * 16), o1 = *(const LAS v4u*)(os + nr * 128 + nsub * 16 + 8);
                o[0] = bflo(o0.x); o[1] = bfhi(o0.x); o[2] = bflo(o0.y); o[3] = bfhi(o0.y); o[4] = bflo(o0.z); o[5] = bfhi(o0.z); o[6] = bflo(o0.w); o[7] = bfhi(o0.w);
                o[8] = bflo(o1.x); o[9] = bfhi(o1.x); o[10] = bflo(o1.y); o[11] = bfhi(o1.y); o[12] = bflo(o1.z); o[13] = bfhi(o1.z); o[14] = bflo(o1.w); o[15] = bfhi(o1.w);
#pragma unroll
                for (int e = 0; e < 16; ++e) ss += o[e] * o[e];
                ss += shx(ss, 1, lane); ss += shx(ss, 2, lane); ss += shx(ss, 4, lane);
                const float rstd = __builtin_amdgcn_rsqf(ss * (1.f / 128.f) + EPS);
                bf16* yp = yp0 + (size_t)n * DNC * 512;
                v4u y; y.x = cvtpk(o[0] * rstd * ow[0].x * siluf_(bflo(zc0.x)), o[1] * rstd * ow[0].y * siluf_(bfhi(zc0.x))); y.y = cvtpk(o[2] * rstd * ow[0].z * siluf_(bflo(zc0.y)), o[3] * rstd * ow[0].w * siluf_(bfhi(zc0.y)));
                y.z = cvtpk(o[4] * rstd * ow[1].x * siluf_(bflo(zc0.z)), o[5] * rstd * ow[1].y * siluf_(bfhi(zc0.z))); y.w = cvtpk(o[6] * rstd * ow[1].z * siluf_(bflo(zc0.w)), o[7] * rstd * ow[1].w * siluf_(bfhi(zc0.w)));
                *(v4u*)yp = y;
                y.x = cvtpk(o[8] * rstd * ow[2].x * siluf_(bflo(zc1.x)), o[9] * rstd * ow[2].y * siluf_(bfhi(zc1.x))); y.y = cvtpk(o[10] * rstd * ow[2].z * siluf_(bflo(zc1.y)), o[11] * rstd * ow[2].w * siluf_(bfhi(zc1.y)));
                y.z = cvtpk(o[12] * rstd * ow[3].x * siluf_(bflo(zc1.z)), o[13] * rstd * ow[3].y * siluf_(bfhi(zc1.z))); y.w = cvtpk(o[14] * rstd * ow[3].z * siluf_(bflo(zc1.w)), o[15] * rstd * ow[3].w * siluf_(bfhi(zc1.w)));
                *(v4u*)(yp + 8) = y;
            }
            ucur0 = un0; ucur1 = un1; zc0 = zn0; zc1 = zn1; glc = gln;
            DN_TICK(tp2);
        }
#if MK_PROBE_A >= 0
        if (blockIdx.x == 0 && tid == 0) { unsigned long long* tsx = (unsigned long long*)((unsigned*)(a->ws + WS_CTL) + 12288) + 48 + l * 4; tsx[0] = tp0; tsx[1] = tp1; tsx[2] = tp2; }
#endif
        asm volatile("s_waitcnt vmcnt(0)" ::: "memory"); __syncthreads();
#undef DN_DMA
#undef ug0
#undef zp0
#undef yp0
    }
}
typedef short v4i16_t __attribute__((ext_vector_type(4)));
#define MFMA32(a, b, c) __builtin_amdgcn_mfma_f32_32x32x16_bf16((a), (b), (c), 0, 0, 0)
constexpr int AT_ROWB = 144;
constexpr int AT_K = 0, AT_V = 2 * 64 * AT_ROWB, AT_OST = 4 * 64 * AT_ROWB, AT_BT = AT_OST + 8 * 32 * AT_ROWB, AT_KM = AT_BT + 1024, AT_UW = AT_KM + 4096;
__device__ __forceinline__ int crow(int r, int hi) { return (r & 3) + 8 * (r >> 2) + 4 * hi; }
__device__ __forceinline__ bf16x8 vtr2(const LAS unsigned char* p) {
    const v4i16_t lo = __builtin_amdgcn_ds_read_tr16_b64_v4i16((LAS v4i16_t*)p), hi = __builtin_amdgcn_ds_read_tr16_b64_v4i16((LAS v4i16_t*)(p + 8 * AT_ROWB));
    return (bf16x8){lo[0], lo[1], lo[2], lo[3], hi[0], hi[1], hi[2], hi[3]};
}
__device__ __forceinline__ void ph_attn(KArgs a, const Ctx& c, int l) {
    LAS unsigned char* lds = c.lds; const int lane = c.lane, wv = c.wave, tid = c.tid, r32 = lane & 31, hi = lane >> 5;
    LAS float* btab = (LAS float*)(lds + AT_BT); LAS float* kms = (LAS float*)(lds + AT_KM); volatile LAS int* uw = (volatile LAS int*)(lds + AT_UW);
    const bf16* QKVA = (const bf16*)(a->ws + WS_QKVA); const float* kmean = (const float*)(a->ws + WS_KMEAN); bf16* YA = (bf16*)(a->ws + WS_YA); const float* relb = a->in[I_RELB];
    unsigned* ctr = (unsigned*)(a->ws + WS_CTL) + CW_ACTR + l * 64;
    const float LOG2E = 1.4426950408889634f, C2 = 0.125f * LOG2E, NINF = -__builtin_inff();
    const int srow = tid >> 3, sch = tid & 7; const unsigned sdst = srow * AT_ROWB + sch * 16;
    for (;;) {
        __syncthreads();
        if (tid == 0) uw[0] = (int)__hip_atomic_fetch_add(ctr, 1u, RLX_AGENT);
        __syncthreads();
        const int u = uw[0];
        if (u >= NB * HA * NBLK) { if (u >= NB * HA * NBLK + CV_NUNITS) break; convert_unit(a, c, l, u - NB * HA * NBLK); continue; }
        const int qb = 15 - (u >> 5), bh = u & 31, b = bh >> 3, h = bh & 7;
        const float c31 = relb[31 * 8 + h];
        for (int i = tid; i < 129; i += NTHR) btab[i] = (i < 128 ? (relb[(int)T5B[i] * 8 + h] - c31) : 0.f) * LOG2E;
        for (int i = tid; i < 1024; i += NTHR) kms[i] = kmean[(size_t)bh * 1024 + i];
        const int qrel = wv * 32 + r32, tokq = b * SEQ + qb * 256 + qrel;
        const bf16* kbase = QKVA + (size_t)(b * SEQ) * 1536 + 512 + h * 64 + sch * 8;
        {   const int key0 = qb * 256; const v4u kr = *(const v4u*)(kbase + (size_t)(key0 + srow) * 1536), vr = *(const v4u*)(kbase + (size_t)(key0 + srow) * 1536 + 512);
            *(LAS v4u*)(lds + AT_K + sdst) = kr; *(LAS v4u*)(lds + AT_V + sdst) = vr; }
        float qf[32];
        {   const bf16* qp = QKVA + (size_t)tokq * 1536 + h * 64 + 8 * hi;
#pragma unroll
            for (int s = 0; s < 4; ++s) { const v4u w = *(const v4u*)(qp + 16 * s); qf[s * 8 + 0] = bflo(w.x); qf[s * 8 + 1] = bfhi(w.x); qf[s * 8 + 2] = bflo(w.y); qf[s * 8 + 3] = bfhi(w.y); qf[s * 8 + 4] = bflo(w.z); qf[s * 8 + 5] = bfhi(w.z); qf[s * 8 + 6] = bflo(w.w); qf[s * 8 + 7] = bfhi(w.w); } }
        __syncthreads();
        unsigned selmask = 0u;
        {   float g[16];
#pragma unroll
            for (int n = 0; n < 16; ++n) { g[n] = -3e38f;
                if (n < qb) { float d = 0.f;
#pragma unroll
                    for (int s = 0; s < 4; ++s) { const f32x4 k0 = *(const LAS f32x4*)(kms + n * 64 + 16 * s + 8 * hi), k1 = *(const LAS f32x4*)(kms + n * 64 + 16 * s + 8 * hi + 4);
                        d += qf[s * 8] * k0.x + qf[s * 8 + 1] * k0.y + qf[s * 8 + 2] * k0.z + qf[s * 8 + 3] * k0.w + qf[s * 8 + 4] * k1.x + qf[s * 8 + 5] * k1.y + qf[s * 8 + 6] * k1.z + qf[s * 8 + 7] * k1.w; }
                    g[n] = d + shx(d, 32, lane); } }
#pragma unroll
            for (int t = 0; t < 3; ++t) { float best = -3.4e38f; int bi = 0;
#pragma unroll
                for (int n = 0; n < 16; ++n) { const bool ok = !((selmask >> n) & 1u) && g[n] > best; best = ok ? g[n] : best; bi = ok ? n : bi; }
                selmask |= 1u << bi; }
            selmask &= (1u << qb) - 1u; }
        bf16x8 qs[4];
#pragma unroll
        for (int s = 0; s < 4; ++s) { v4u w; w.x = cvtpk(qf[s * 8] * C2, qf[s * 8 + 1] * C2); w.y = cvtpk(qf[s * 8 + 2] * C2, qf[s * 8 + 3] * C2); w.z = cvtpk(qf[s * 8 + 4] * C2, qf[s * 8 + 5] * C2); w.w = cvtpk(qf[s * 8 + 6] * C2, qf[s * 8 + 7] * C2); qs[s] = __builtin_bit_cast(bf16x8, w); }
        float m = NINF, lsum = 0.f; f32x16 o0, o1;
#pragma unroll
        for (int r = 0; r < 16; ++r) { o0[r] = 0.f; o1[r] = 0.f; }
        const int NT = 4 * (qb + 1);
        for (int t = 0; t < NT; ++t) {
            const int blk = t < 4 ? qb : ((t - 4) >> 2), kt = t < 4 ? t : ((t - 4) & 3);
            v4u kr = {0u, 0u, 0u, 0u}, vr = {0u, 0u, 0u, 0u};
            if (t + 1 < NT) { const int t1 = t + 1, blk1 = t1 < 4 ? qb : ((t1 - 4) >> 2), kt1 = t1 < 4 ? t1 : ((t1 - 4) & 3); const size_t ro = (size_t)(blk1 * 256 + kt1 * 64 + srow) * 1536;
                kr = *(const v4u*)(kbase + ro); vr = *(const v4u*)(kbase + ro + 512); }
            const bool own = t < 4;
            const bool lane_act = own || ((selmask >> blk) & 1u);
            const bool wave_act = own ? (kt * 64 <= wv * 32 + 31) : (__builtin_amdgcn_ballot_w64(lane_act) != 0ull);
            if (wave_act) {
                const LAS unsigned char* Kb = lds + AT_K + (t & 1) * 64 * AT_ROWB; const LAS unsigned char* Vb = lds + AT_V + (t & 1) * 64 * AT_ROWB;
                f32x16 p0, p1;
#pragma unroll
                for (int r = 0; r < 16; ++r) { p0[r] = 0.f; p1[r] = 0.f; }
#pragma unroll
                for (int s = 0; s < 4; ++s) { const bf16x8 a0 = *(const LAS bf16x8*)(Kb + r32 * AT_ROWB + 32 * s + 16 * hi), a1 = *(const LAS bf16x8*)(Kb + (32 + r32) * AT_ROWB + 32 * s + 16 * hi);
                    p0 = MFMA32(a0, qs[s], p0); p1 = MFMA32(a1, qs[s], p1); }
                if (own) {
#pragma unroll
                    for (int r = 0; r < 16; ++r) { const int d0 = qrel - (kt * 64 + crow(r, hi)), d1 = d0 - 32;
                        p0[r] = d0 >= 0 ? p0[r] + btab[d0 > 128 ? 128 : d0] : NINF; p1[r] = d1 >= 0 ? p1[r] + btab[d1 > 128 ? 128 : d1] : NINF; }
                } else if (blk == qb - 1 && kt >= 1) {
#pragma unroll
                    for (int r = 0; r < 16; ++r) { const int d0 = qrel + 256 - (kt * 64 + crow(r, hi)), d1 = d0 - 32;
                        p0[r] += btab[d0 > 128 ? 128 : d0]; p1[r] += btab[d1 > 128 ? 128 : d1]; }
                }
                float mx = fmaxf(p0[0], p1[0]);
#pragma unroll
                for (int r = 1; r < 16; ++r) mx = fmaxf(mx, fmaxf(p0[r], p1[r]));
                mx = fmaxf(mx, shx(mx, 32, lane));
                const float tmax = lane_act ? mx : NINF, mnew = fmaxf(m, tmax), alpha = __builtin_amdgcn_exp2f(m - mnew), muse = lane_act ? mnew : __builtin_inff();
                float rs = 0.f;
#pragma unroll
                for (int r = 0; r < 16; ++r) { p0[r] = __builtin_amdgcn_exp2f(p0[r] - muse); p1[r] = __builtin_amdgcn_exp2f(p1[r] - muse); rs += p0[r] + p1[r]; }
                lsum = lsum * alpha + rs; m = mnew;
                if (__builtin_amdgcn_ballot_w64(alpha != 1.f) != 0ull) {
#pragma unroll
                    for (int r = 0; r < 16; ++r) { o0[r] *= alpha; o1[r] *= alpha; } }
                bf16x8 pa[4];
                { v4u w; w.x = cvtpk(p0[0], p0[1]); w.y = cvtpk(p0[2], p0[3]); w.z = cvtpk(p0[4], p0[5]); w.w = cvtpk(p0[6], p0[7]); pa[0] = __builtin_bit_cast(bf16x8, w);
                  w.x = cvtpk(p0[8], p0[9]); w.y = cvtpk(p0[10], p0[11]); w.z = cvtpk(p0[12], p0[13]); w.w = cvtpk(p0[14], p0[15]); pa[1] = __builtin_bit_cast(bf16x8, w);
                  w.x = cvtpk(p1[0], p1[1]); w.y = cvtpk(p1[2], p1[3]); w.z = cvtpk(p1[4], p1[5]); w.w = cvtpk(p1[6], p1[7]); pa[2] = __builtin_bit_cast(bf16x8, w);
                  w.x = cvtpk(p1[8], p1[9]); w.y = cvtpk(p1[10], p1[11]); w.z = cvtpk(p1[12], p1[13]); w.w = cvtpk(p1[14], p1[15]); pa[3] = __builtin_bit_cast(bf16x8, w); }
                const LAS unsigned char* vp = Vb + (4 * hi + ((lane & 15) >> 2)) * AT_ROWB + 2 * (16 * ((lane >> 4) & 1) + 4 * (lane & 3));
#pragma unroll
                for (int ks = 0; ks < 4; ++ks) { const bf16x8 v0 = vtr2(vp + 16 * ks * AT_ROWB), v1 = vtr2(vp + 16 * ks * AT_ROWB + 64);
                    o0 = MFMA32(v0, pa[ks], o0); o1 = MFMA32(v1, pa[ks], o1); }
            }
            if (t + 1 < NT) { *(LAS v4u*)(lds + AT_K + ((t + 1) & 1) * 64 * AT_ROWB + sdst) = kr; *(LAS v4u*)(lds + AT_V + ((t + 1) & 1) * 64 * AT_ROWB + sdst) = vr; }
            __syncthreads();
        }
        lsum += shx(lsum, 32, lane);
        const float inv = 1.f / lsum;
        LAS unsigned short* stg = (LAS unsigned short*)(lds + AT_OST + wv * 32 * AT_ROWB);
#pragma unroll
        for (int r = 0; r < 16; ++r) { stg[r32 * (AT_ROWB / 2) + crow(r, hi)] = (unsigned short)(cvtpk(o0[r] * inv, 0.f) & 0xffffu); stg[r32 * (AT_ROWB / 2) + 32 + crow(r, hi)] = (unsigned short)(cvtpk(o1[r] * inv, 0.f) & 0xffffu); }
        LDS_WAIT();
#pragma unroll
        for (int i = 0; i < 4; ++i) { const int row = i * 8 + (lane >> 3), ch = lane & 7; const v4u v = *(const LAS v4u*)((const LAS unsigned char*)stg + row * AT_ROWB + ch * 16);
            *(v4u*)(YA + (size_t)(b * SEQ + qb * 256 + wv * 32 + row) * 512 + h * 64 + ch * 8) = v; }
    }
}
constexpr int NPH_LAYER = 11, NPHASES = 2 + NLAYER * NPH_LAYER;
#ifndef DN_IMPL
#define DN_IMPL 1
#endif
#ifndef PH_MASK
#define PH_MASK 0xFFFF
#endif
#define PH_EN(k) ((PH_MASK >> (k)) & 1)
#define GEMM_PHASE(EPI, SCHED, g, S, E) pg8::gemm_phase<EPI, SCHED, true, true>(c.lds, g, S, E, c.tid)

#define PHASE_FN static __device__ __forceinline__ void
__device__ __forceinline__ KArgs launder_k(KArgs a) { unsigned long long v = (unsigned long long)a; asm volatile("" : "+s"(v)); return (KArgs)v; }
PHASE_FN f_mod(KArgs a, int& tid) { a = launder_k(a); Ctx c = make_ctx(tid); ph_mod(a, c); }
PHASE_FN f_norm1(KArgs a, int& tid, int l) { a = launder_k(a); Ctx c = make_ctx(tid); ph_norm1(a, c, l); __syncthreads(); ph_convert(a, c, l); }
PHASE_FN f_proj(KArgs a, int& tid) { a = launder_k(a); Ctx c = make_ctx(tid);
    pg8::Gemm g{(const bf16*)(a->ws + WS_H), (const bf16*)(a->ws + WS_WIN), NTOK, DINP, DM}; pg8::StaticOrder S; S.init(NTOK, DINP, c.G, c.bid);
    EpiProj E{a->ws}; GEMM_PHASE(EpiProj, pg8::StaticOrder, g, S, E); }
PHASE_FN f_kmean(KArgs a, int& tid) { a = launder_k(a); Ctx c = make_ctx(tid); ph_kmean(a, c); }
#ifndef ATTN_IMPL
#define ATTN_IMPL 1
#endif
#if ATTN_IMPL
PHASE_FN f_attn(KArgs a, int& tid, int l) { a = launder_k(a); Ctx c = make_ctx(tid); ph_attn(a, c, l); }
#else
PHASE_FN f_attn(KArgs a, int& tid, int l) { a = launder_k(a); Ctx c = make_ctx(tid); ph_attn_simple(a, c); }
#endif
PHASE_FN f_dn(KArgs a, int& tid, int l) { a = launder_k(a); Ctx c = make_ctx(tid); ph_dn_simple(a, c, l); }
PHASE_FN f_dn_prep(KArgs a, int& tid, int l) { a = launder_k(a); Ctx c = make_ctx(tid); ph_dn_prep(a, c, l); }
PHASE_FN f_dn_scan(KArgs a, int& tid, int l) { a = launder_k(a); Ctx c = make_ctx(tid); ph_dn_scan(a, c, l); }
PHASE_FN f_merge1(KArgs a, int& tid) { a = launder_k(a); Ctx c = make_ctx(tid);
    pg8::Gemm g{(const bf16*)(a->ws + WS_YA), (const bf16*)(a->ws + WS_WUPA), NTOK, DM, WA}; pg8::StaticOrder S; S.init(NTOK, DM, c.G, c.bid);
    EpiMerge<false> E{a->ws}; GEMM_PHASE(EpiMerge<false>, pg8::StaticOrder, g, S, E); }
PHASE_FN f_merge2(KArgs a, int& tid) { a = launder_k(a); Ctx c = make_ctx(tid);
    pg8::Gemm g{(const bf16*)(a->ws + WS_YB), (const bf16*)(a->ws + WS_WUPB), NTOK, DM, WB}; pg8::StaticOrder S; S.init(NTOK, DM, c.G, c.bid);
    EpiMerge<true> E{a->ws}; GEMM_PHASE(EpiMerge<true>, pg8::StaticOrder, g, S, E); }
PHASE_FN f_out(KArgs a, int& tid, int l) { a = launder_k(a); Ctx c = make_ctx(tid);
    pg8::Gemm g{(const bf16*)(a->ws + WS_M), (const bf16*)(a->ws + WS_WOUT), NTOK, DM, DM}; pg8::StaticOrder S; S.init(NTOK, DM, c.G, c.bid);
    EpiOut E{l == 0 ? a->in[I_X] : (const float*)a->out, a->out, (const float*)(a->ws + WS_MOD) + l * 4 * 6144 + 2048}; GEMM_PHASE(EpiOut, pg8::StaticOrder, g, S, E); }
PHASE_FN f_router(KArgs a, int& tid, int l) { a = launder_k(a); Ctx c = make_ctx(tid); ph_router(a, c, l); }
PHASE_FN f_gather(KArgs a, int& tid, int l) { a = launder_k(a); Ctx c = make_ctx(tid); ph_gather(a, c, l); }
PHASE_FN f_moe_gu(KArgs a, int& tid, int l) { a = launder_k(a); Ctx c = make_ctx(tid);
    moe_table(a, c, l); const LAS int* te = (const LAS int*)(c.lds + MISC_OFF + 2048);
    pg8::Gemm g{(const bf16*)(a->ws + WS_HS), (const bf16*)(a->ws + WS_WEGU), MOE_MAXROWS, NEXP * 512, DM}; MoeOrder S{te, te[192 + 32] * 2, c.G, c.bid, 1};
    EpiMoeGU E{a->ws}; GEMM_PHASE(EpiMoeGU, MoeOrder, g, S, E); }
PHASE_FN f_moe_down(KArgs a, int& tid, int l) { a = launder_k(a); Ctx c = make_ctx(tid);
    moe_table(a, c, l); const LAS int* te = (const LAS int*)(c.lds + MISC_OFF + 2048);
    pg8::Gemm g{(const bf16*)(a->ws + WS_ACT), (const bf16*)(a->ws + WS_WED), MOE_MAXROWS, NEXP * 1024, DFF}; MoeOrder S{te, te[192 + 32] * 4, c.G, c.bid, 2};
    EpiMoeDown E{a->ws}; GEMM_PHASE(EpiMoeDown, MoeOrder, g, S, E); }
PHASE_FN f_final(KArgs a, int& tid) { a = launder_k(a); Ctx c = make_ctx(tid); ph_final(a, c); }

#define KA() launder_k((KArgs)__builtin_amdgcn_kernarg_segment_ptr())
__device__ __forceinline__ bool ph_in(int k) { KArgs a = KA(); return a->ph_lo <= k && k < a->ph_hi; }
#ifndef MK_PROBE_A
#define MK_PROBE_A -1
#endif
#ifndef MK_PROBE_B
#define MK_PROBE_B -1
#endif
constexpr int CW_TS = 12288;
__device__ __forceinline__ void grid_bar(int& tid, int k) {
    asm volatile("" : "+v"(tid));
#if MK_ONE_LAUNCH
    KArgs a = KA(); XcdBarrier b; b.bar = (unsigned*)(a->ws + WS_CTL) + CW_BAR; b.x = xb_xcc_id(); b.st = (volatile LAS unsigned*)((LAS unsigned char*)lds_raw + MISC_OFF) + 8;
    xcd_barrier(b, tid);
    if (MK_PROBE_A >= 0 && blockIdx.x == 0 && tid == 0) ((unsigned long long*)((unsigned*)(a->ws + WS_CTL) + CW_TS))[k + 1] = __builtin_amdgcn_s_memrealtime();
#else
    __syncthreads();
#endif
}
__global__ void __launch_bounds__(NTHR, 2) mk_fwd(Args a_) {
    int tid = threadIdx.x;
    {   volatile LAS unsigned* MISC = (volatile LAS unsigned*)((LAS unsigned char*)lds_raw + MISC_OFF);
        if (tid < 64) MISC[tid] = 0u;
        __syncthreads();
#if MK_ONE_LAUNCH
        (void)xcd_barrier_post((unsigned*)(KA()->ws + WS_CTL) + CW_BAR, MISC + 8, tid);
#endif
        if (MK_PROBE_A >= 0 && blockIdx.x == 0 && tid == 0) ((unsigned long long*)((unsigned*)(KA()->ws + WS_CTL) + CW_TS))[0] = __builtin_amdgcn_s_memrealtime();
    }
#define IN(k) ph_in(k)
#define SEAM(k) do { if (IN(k) && IN((k) + 1)) grid_bar(tid, (k)); } while (0)
    if (IN(0)) f_mod(KA(), tid); SEAM(0);
    for (int l = 0; l < NLAYER; ++l) {
        const int pb = 1 + l * NPH_LAYER;
        if (PH_EN(0) && IN(pb + 0)) f_norm1(KA(), tid, l); SEAM(pb + 0);
        if (PH_EN(1) && IN(pb + 1)) f_proj(KA(), tid); SEAM(pb + 1);
#if DN_IMPL
        if (PH_EN(2) && IN(pb + 2)) { f_kmean(KA(), tid); f_dn_prep(KA(), tid, l); } SEAM(pb + 2);
        if (PH_EN(3) && IN(pb + 3)) { f_dn_scan(KA(), tid, l);
            if (MK_PROBE_A >= 0 && blockIdx.x == 0 && tid == 0) ((unsigned long long*)((unsigned*)(KA()->ws + WS_CTL) + CW_TS))[40 + l] = __builtin_amdgcn_s_memrealtime();
            __syncthreads(); f_attn(KA(), tid, l);
            if (MK_PROBE_A >= 0 && blockIdx.x == 255 && tid == 0) ((unsigned long long*)((unsigned*)(KA()->ws + WS_CTL) + CW_TS))[44 + l] = __builtin_amdgcn_s_memrealtime(); } SEAM(pb + 3);
#else
        if (PH_EN(2) && IN(pb + 2)) f_kmean(KA(), tid); SEAM(pb + 2);
        if (PH_EN(3) && IN(pb + 3)) { f_attn(KA(), tid, l); __syncthreads(); f_dn(KA(), tid, l); } SEAM(pb + 3);
#endif
        if (PH_EN(4) && IN(pb + 4)) f_merge1(KA(), tid); SEAM(pb + 4);
        if (PH_EN(5) && IN(pb + 5)) f_merge2(KA(), tid); SEAM(pb + 5);
        if (PH_EN(6) && IN(pb + 6)) f_out(KA(), tid, l); SEAM(pb + 6);
        if (PH_EN(7) && IN(pb + 7)) f_router(KA(), tid, l); SEAM(pb + 7);
        if (PH_EN(8) && IN(pb + 8)) f_gather(KA(), tid, l); SEAM(pb + 8);
        if (PH_EN(9) && IN(pb + 9)) f_moe_gu(KA(), tid, l); SEAM(pb + 9);
        if (PH_EN(10) && IN(pb + 10)) f_moe_down(KA(), tid, l); SEAM(pb + 10);
    }
    if (IN(NPHASES - 1)) f_final(KA(), tid);
#undef IN
#undef SEAM
}

extern "C" void kernel_launch(void* const* d_in, const int* in_sizes, int n_in, void* d_out, int out_size, void* d_ws, size_t ws_size, hipStream_t stream) {
    static int grid = 0;
    if (grid == 0) {
        if (n_in != 23 || out_size != NTOK * DM || ws_size < WS_END) { fprintf(stderr, "kernel_launch: unexpected shapes (n_in %d out %d ws %zu)\n", n_in, out_size, ws_size); grid = -1; return; }
        int dev = 0, cus = 0, per_cu = 0;
        if (hipGetDevice(&dev) != hipSuccess || hipDeviceGetAttribute(&cus, hipDeviceAttributeMultiprocessorCount, dev) != hipSuccess) { grid = -1; return; }
        if (hipFuncSetAttribute((const void*)mk_fwd, hipFuncAttributeMaxDynamicSharedMemorySize, LDS_BYTES) != hipSuccess) { fprintf(stderr, "kernel_launch: hipFuncSetAttribute failed\n"); grid = -1; return; }
        if (hipOccupancyMaxActiveBlocksPerMultiprocessor(&per_cu, (const void*)mk_fwd, NTHR, LDS_BYTES) != hipSuccess || per_cu < 1) { fprintf(stderr, "kernel_launch: occupancy query says %d\n", per_cu); (void)hipGetLastError(); grid = -1; return; }
        grid = cus;
    }
    if (grid < 0) return;
    (void)hipMemsetAsync((char*)d_ws + WS_CTL, 0, CTL_ZERO_BYTES, stream);
    Args a{};
    for (int i = 0; i < 23; ++i) a.in[i] = (const float*)d_in[i];
    a.out = (float*)d_out; a.ws = (unsigned char*)d_ws;
#if MK_ONE_LAUNCH
    a.ph_lo = 0; a.ph_hi = NPHASES;
    hipLaunchKernelGGL(mk_fwd, dim3(grid), dim3(NTHR), LDS_BYTES, stream, a);
#else
    for (int p = 0; p < NPHASES; ++p) { a.ph_lo = p; a.ph_hi = p + 1; hipLaunchKernelGGL(mk_fwd, dim3(grid), dim3(NTHR), LDS_BYTES, stream, a); }
#endif
}
```

```cpp
#include <hip/hip_runtime.h>
#include <cstdio>
#include <cstdint>
#ifndef MK_ONE_LAUNCH
#define MK_ONE_LAUNCH 1
#endif
#ifndef MK_PROBE_A
#define MK_PROBE_A -1
#endif
#ifndef MK_PROBE_B
#define MK_PROBE_B -1
#endif
namespace pg8 {
#define PG8_LAS __attribute__((address_space(3)))
typedef unsigned short bf16_t;
typedef short bf16x8 __attribute__((ext_vector_type(8)));
typedef float f32x4 __attribute__((ext_vector_type(4)));
typedef unsigned u32x4 __attribute__((ext_vector_type(4)));
constexpr int BM = 256, BK = 64, HALF = 128, HTB = HALF * BK * 2  , STAGE_BYTES = 8 * HTB, NXCD = 8, WGM = 8;

__host__ __device__ __forceinline__ int lds_byte(int r, int c) { const int st = (r >> 4) * 2 + (c >> 5), rr = r & 15, cc = c & 31, ob = rr * 64 + cc * 2; return st * 1024 + (ob ^ (((ob >> 9) & 1) << 5)); }
__host__ __device__ __forceinline__ void stage_rc(int b, int& R, int& C) { const int st = b / 1024, sb = b % 1024, swz = sb ^ (((sb >> 9) & 1) << 5); R = (st >> 1) * 16 + swz / 64; C = (st & 1) * 32 + (swz % 64) / 2; }
__host__ __device__ __forceinline__ int perm32(int rho) { const int n = rho >> 4, i = rho & 15; return 8 * (i >> 2) + 4 * n + (i & 3); }

struct Unit { int pm, pn; };
struct Gemm { const bf16_t* A; const bf16_t* Bt; int M, N, K; };

struct StaticOrder {
    int nM, nN, nwg, G, c;
    __host__ __device__ void init(int M, int N, int G_, int c_) { nM = M / BM; nN = N / BM; nwg = nM * nN; G = G_; c = c_; }
    __host__ __device__ bool next(int i, Unit& u) const {
        const long L = (long)i * G + c; if (L >= nwg) return false;
        int wgid = (int)L; { const int q = nwg / NXCD, r = nwg % NXCD, xcd = wgid % NXCD, off = wgid / NXCD; wgid = (xcd < r ? xcd * (q + 1) : r * (q + 1) + (xcd - r) * q) + off; }
        const int nig = WGM * nN, gid = wgid / nig, fm = gid * WGM, gsz = (nM - fm) < WGM ? (nM - fm) : WGM;
        u.pm = fm + ((wgid % nig) % gsz); u.pn = (wgid % nig) / gsz; return true;
    }
    __device__ __forceinline__ void a_ready(const Unit&) const {}
    __device__ __forceinline__ void done(const Unit&) const {}
};

__device__ __forceinline__ unsigned cvt_pk_bf16(float lo, float hi) { unsigned r; asm volatile("v_cvt_pk_bf16_f32 %0, %1, %2" : "=v"(r) : "v"(lo), "v"(hi)); return r; }
typedef float f32x2 __attribute__((ext_vector_type(2)));
template <class Epi, class Sched, bool ALIGN_EPI = false, bool SP2 = false>
__device__ __forceinline__ void gemm_phase(PG8_LAS unsigned char* lds, const Gemm g, const Sched& S, const Epi& E, const int tid_in) {
    const int tid = tid_in, wid = __builtin_amdgcn_readfirstlane(tid >> 6), lane = tid & 63, wr = wid >> 2, wc = wid & 3, fr = lane & 15, fq = lane >> 4;
    const int K = g.K, nt = K / BK;
    unsigned voffA[2], voffB[2];
#pragma unroll
    for (int i = 0; i < 2; ++i) { int R, C; stage_rc(tid * 16 + i * 8192, R, C); const int Rb = Epi::PERM ? ((R & ~31) + perm32(R & 31)) : R;
        voffA[i] = (unsigned)(R * K + C) * 2u; voffB[i] = (unsigned)(Rb * K + C) * 2u; }
    const size_t kstep = (size_t)(BK * 2);
    const size_t hstep = (size_t)HALF * K * 2;
    const size_t tstep = 2 * hstep;
    const unsigned ldsw = (unsigned)wid * 1024u;
    const int aoff = lds_byte(wr * 64 + fr, fq * 8), boff = lds_byte(wc * 32 + fr, fq * 8);
#define PG8_SA(b, h) (((b) * 2 + (h)) * HTB)
#define PG8_SB(b, h) ((4 + (b) * 2 + (h)) * HTB)
#define PG8_STAGE(bufoff, gbase, voff) do { _Pragma("unroll") for (int _i = 0; _i < 2; ++_i) \
        __builtin_amdgcn_global_load_lds((const unsigned*)((const char*)(gbase) + (voff)[_i]), (PG8_LAS unsigned*)(lds + (bufoff) + ldsw + _i * 8192), 16, 0, 0); } while (0)
#define PG8_LDA(dst, b, h) do { _Pragma("unroll") for (int m = 0; m < 4; ++m) _Pragma("unroll") for (int k = 0; k < 2; ++k) dst[m][k] = *(const PG8_LAS bf16x8*)(lds + PG8_SA(b, h) + aoff + m * 2048 + k * 1024); } while (0)
#define PG8_LDB(dst, b, h) do { _Pragma("unroll") for (int n = 0; n < 2; ++n) _Pragma("unroll") for (int k = 0; k < 2; ++k) dst[n][k] = *(const PG8_LAS bf16x8*)(lds + PG8_SB(b, h) + boff + n * 2048 + k * 1024); } while (0)
#define PG8_MMA(ai, bj, At, Bt) do { __builtin_amdgcn_s_setprio(1); _Pragma("unroll") for (int m = 0; m < 4; ++m) _Pragma("unroll") for (int n = 0; n < 2; ++n) _Pragma("unroll") for (int k = 0; k < 2; ++k) \
        acc[ai][bj][m][n] = __builtin_amdgcn_mfma_f32_16x16x32_bf16(Bt[n][k], At[m][k], acc[ai][bj][m][n], 0, 0, 0); __builtin_amdgcn_s_setprio(0); } while (0)
#define PG8_WAIT_V(n) asm volatile("s_waitcnt vmcnt(" #n ")" ::: "memory")
#define PG8_WAIT_L(n) asm volatile("s_waitcnt lgkmcnt(" #n ")" ::: "memory")
#define PG8_BAR __builtin_amdgcn_s_barrier()
#define PG8_SCHED __builtin_amdgcn_sched_barrier(0)
    Unit cur, nxt; int ui = 0;
    if (!S.next(0, cur)) return;
    f32x4 acc[2][2][4][2];
    float zf_ = 0.f; asm volatile("" : "+v"(zf_));
#pragma unroll
    for (int a = 0; a < 2; ++a)
#pragma unroll
        for (int b = 0; b < 2; ++b)
#pragma unroll
            for (int m = 0; m < 4; ++m)
#pragma unroll
                for (int n = 0; n < 2; ++n) acc[a][b][m][n] = (f32x4){zf_, zf_, zf_, zf_};
    bf16x8 At[4][2], B0[2][2], B1[2][2];
    const char* cA = (const char*)g.A + (size_t)cur.pm * tstep; const char* cB = (const char*)g.Bt + (size_t)cur.pn * tstep;
    S.a_ready(cur);
    if constexpr (SP2) {
        PG8_STAGE(PG8_SB(0, 0), cB, voffB); PG8_STAGE(PG8_SB(0, 1), cB + hstep, voffB); PG8_STAGE(PG8_SA(0, 0), cA, voffA); PG8_STAGE(PG8_SA(0, 1), cA + hstep, voffA);
        if (wr == 1) PG8_BAR;
        PG8_WAIT_V(2); PG8_BAR;
        PG8_STAGE(PG8_SB(1, 0), cB + kstep, voffB); PG8_STAGE(PG8_SA(1, 0), cA + kstep, voffA); PG8_STAGE(PG8_SB(1, 1), cB + hstep + kstep, voffB);
        PG8_WAIT_V(6); PG8_BAR;
    } else {
        PG8_STAGE(PG8_SB(0, 0), cB, voffB); PG8_STAGE(PG8_SA(0, 0), cA, voffA); PG8_STAGE(PG8_SB(0, 1), cB + hstep, voffB); PG8_STAGE(PG8_SA(0, 1), cA + hstep, voffA);
        if (wr == 1) PG8_BAR;
        PG8_WAIT_V(4); PG8_BAR;
        PG8_STAGE(PG8_SB(1, 0), cB + kstep, voffB); PG8_STAGE(PG8_SA(1, 0), cA + kstep, voffA); PG8_STAGE(PG8_SB(1, 1), cB + hstep + kstep, voffB);
        PG8_WAIT_V(6); PG8_BAR;
    }
    for (;;) {
        const bool has_next = S.next(ui + 1, nxt);
        const char* nA = has_next ? (const char*)g.A + (size_t)nxt.pm * tstep : cA; const char* nB = has_next ? (const char*)g.Bt + (size_t)nxt.pn * tstep : cB;
        for (int t = 0; t < nt; t += 2) {
            const bool last = (t == nt - 2);
            const char* a1 = cA + (size_t)(t + 1) * kstep;
            const char* a2 = last ? nA : cA + (size_t)(t + 2) * kstep; const char* b2 = last ? nB : cB + (size_t)(t + 2) * kstep;
            const char* a3 = a2 + kstep; const char* b3 = b2 + kstep;
            if (last && has_next) S.a_ready(nxt);
            if constexpr (SP2) {
            PG8_LDB(B0, 0, 0); PG8_LDB(B1, 0, 1); PG8_SCHED; PG8_LDA(At, 0, 0); PG8_STAGE(PG8_SA(1, 1), a1 + hstep, voffA);
            PG8_WAIT_V(8); PG8_WAIT_L(0); PG8_BAR; PG8_MMA(0, 0, At, B0); PG8_MMA(0, 1, At, B1); PG8_BAR; PG8_SCHED;
            PG8_LDA(At, 0, 1); PG8_STAGE(PG8_SB(0, 0), b2, voffB); PG8_STAGE(PG8_SB(0, 1), b2 + hstep, voffB); PG8_STAGE(PG8_SA(0, 0), a2, voffA);
            PG8_WAIT_V(8); PG8_WAIT_L(0); PG8_BAR; PG8_MMA(1, 0, At, B0); PG8_MMA(1, 1, At, B1); PG8_BAR; PG8_SCHED;
            PG8_LDB(B0, 1, 0); PG8_LDB(B1, 1, 1); PG8_SCHED; PG8_LDA(At, 1, 0); PG8_STAGE(PG8_SA(0, 1), a2 + hstep, voffA);
            PG8_WAIT_V(8); PG8_WAIT_L(0); PG8_BAR; PG8_MMA(0, 0, At, B0); PG8_MMA(0, 1, At, B1); PG8_BAR; PG8_SCHED;
            PG8_LDA(At, 1, 1); PG8_STAGE(PG8_SB(1, 0), b3, voffB); PG8_STAGE(PG8_SB(1, 1), b3 + hstep, voffB); PG8_STAGE(PG8_SA(1, 0), a3, voffA);
            PG8_WAIT_V(8); PG8_WAIT_L(0); PG8_BAR; PG8_MMA(1, 0, At, B0); PG8_MMA(1, 1, At, B1); PG8_BAR; PG8_SCHED;
            } else {
            PG8_LDB(B0, 0, 0); PG8_SCHED; PG8_LDA(At, 0, 0); PG8_STAGE(PG8_SA(1, 1), a1 + hstep, voffA);
            PG8_WAIT_L(8); PG8_BAR; PG8_WAIT_L(0); PG8_MMA(0, 0, At, B0); PG8_BAR; PG8_SCHED;
            PG8_LDB(B1, 0, 1); PG8_STAGE(PG8_SB(0, 0), b2, voffB);
            PG8_BAR; PG8_WAIT_L(0); PG8_MMA(0, 1, At, B1); PG8_BAR;
            PG8_LDA(At, 0, 1); PG8_STAGE(PG8_SA(0, 0), a2, voffA);
            PG8_BAR; PG8_WAIT_L(0); PG8_MMA(1, 0, At, B0); PG8_BAR; PG8_SCHED;
            PG8_STAGE(PG8_SB(0, 1), b2 + hstep, voffB);
            PG8_WAIT_V(6); PG8_BAR; PG8_MMA(1, 1, At, B1); PG8_BAR;
            PG8_LDB(B0, 1, 0); PG8_SCHED; PG8_LDA(At, 1, 0); PG8_STAGE(PG8_SA(0, 1), a2 + hstep, voffA);
            PG8_WAIT_L(8); PG8_BAR; PG8_WAIT_L(0); PG8_MMA(0, 0, At, B0); PG8_BAR; PG8_SCHED;
            PG8_LDB(B1, 1, 1); PG8_STAGE(PG8_SB(1, 0), b3, voffB);
            PG8_BAR; PG8_WAIT_L(0); PG8_MMA(0, 1, At, B1); PG8_BAR;
            PG8_LDA(At, 1, 1); PG8_STAGE(PG8_SA(1, 0), a3, voffA);
            PG8_BAR; PG8_WAIT_L(0); PG8_MMA(1, 0, At, B0); PG8_BAR; PG8_SCHED;
            PG8_STAGE(PG8_SB(1, 1), b3 + hstep, voffB);
            PG8_WAIT_V(6); PG8_BAR; PG8_MMA(1, 1, At, B1); PG8_BAR;
            }
        }
        if constexpr (ALIGN_EPI) { if (wr == 0) PG8_BAR; }
        if constexpr (!Epi::AFTER_DRAIN) { int te_ = tid_in; asm volatile("" : "+v"(te_)); E(acc, cur, wr, wc, te_ & 15, (te_ & 63) >> 4); S.done(cur); }
        if (!has_next) break;
        zf_ = 0.f; asm volatile("" : "+v"(zf_));
#pragma unroll
        for (int a = 0; a < 2; ++a)
#pragma unroll
            for (int b = 0; b < 2; ++b)
#pragma unroll
                for (int m = 0; m < 4; ++m)
#pragma unroll
                    for (int n = 0; n < 2; ++n) acc[a][b][m][n] = (f32x4){zf_, zf_, zf_, zf_};
        cur = nxt; cA = nA; cB = nB; ++ui;
        if constexpr (ALIGN_EPI) { if (wr == 1) PG8_BAR; }
    }
    PG8_WAIT_V(0);
    if constexpr (!ALIGN_EPI) { if (wr == 0) PG8_BAR; }
    PG8_BAR;
    if constexpr (Epi::AFTER_DRAIN) { E.fused(acc, cur, wr, wc, fr, fq, lds, wid, lane); S.done(cur); }
#undef PG8_SA
#undef PG8_SB
#undef PG8_STAGE
#undef PG8_LDA
#undef PG8_LDB
#undef PG8_MMA
#undef PG8_WAIT_V
#undef PG8_WAIT_L
#undef PG8_BAR
#undef PG8_SCHED
}
}
constexpr int NW = 8, NTHR = 512;
constexpr int DM = 1024, NB = 4, SEQ = 4096, NTOK = NB * SEQ, NLAYER = 2;
constexpr int HA = 8, HDA = 64, WA = 512, MBLK = 256, NBLK = SEQ / MBLK;
constexpr int HB = 4, HDB = 128, WB = 512, CONVK = 4, DNC = 64, NCH = SEQ / DNC;
constexpr int NGRP = 4, EPG = 8, NEXP = 32, DFF = 256;
constexpr int DIN = 5640, DINP = 5632, NMOD = 6;
constexpr int C_QKVA = 0, C_QKVB = 1536, C_ZB = 3072, C_BA = 3584, C_GATE = 3592;
constexpr float EPS = 1e-6f;
constexpr int MOE_MAXROWS = 2 * NTOK + NEXP * 256;
constexpr int MOE_MAXTILES = MOE_MAXROWS / 256;

constexpr size_t MiB = 1u << 20;
constexpr size_t WS_CTL = 0, CTL_ZERO_BYTES = 1 * MiB;
constexpr size_t WS_MOD = 1 * MiB;
constexpr size_t WS_WIN = 2 * MiB;
constexpr size_t WS_WUPA = 13 * MiB, WS_WUPB = 14 * MiB;
constexpr size_t WS_WOUT = 15 * MiB;
constexpr size_t WS_WEGU = 17 * MiB;
constexpr size_t WS_WED = 49 * MiB;
constexpr size_t WS_SMALL = 65 * MiB;
constexpr size_t WS_KMEAN = WS_SMALL;
constexpr size_t WS_BETA = WS_SMALL + 256 * 1024;
constexpr size_t WS_GLOG = WS_SMALL + 512 * 1024;
constexpr size_t WS_TOKINFO = WS_SMALL + 1 * MiB;
constexpr size_t WS_ROWTOK = WS_SMALL + 2 * MiB;
constexpr size_t WS_ROWW = WS_SMALL + 3 * MiB;
constexpr size_t WS_GL = WS_SMALL + 4 * MiB;
constexpr size_t WS_H = 72 * MiB;
constexpr size_t WS_QKVA = 104 * MiB;
constexpr size_t WS_QKVB = 152 * MiB;
constexpr size_t WS_ZB = 200 * MiB;
constexpr size_t WS_GATES = 216 * MiB;
constexpr size_t WS_IMG = 280 * MiB;
constexpr size_t WS_YA = 72 * MiB, WS_YB = 336 * MiB;
constexpr size_t WS_END = 352 * MiB;
constexpr size_t WS_M = WS_QKVB;
constexpr size_t WS_U = 88 * MiB;
constexpr size_t WS_HS = WS_QKVA;
constexpr size_t WS_ACT = 184 * MiB;
constexpr size_t WS_YS = WS_GATES;
constexpr int CW_TMO = 0;
constexpr int CW_BAR = 4096;
constexpr int CW_GCNT = 8192;
constexpr int CW_ACTR = 8320;

constexpr int RING_BYTES = 131072;
constexpr int MISC_OFF = 147456;
constexpr int LDS_BYTES = 151552;

#define GAS __attribute__((address_space(1)))
#define LAS __attribute__((address_space(3)))
typedef unsigned short bf16;
typedef unsigned v4u __attribute__((ext_vector_type(4)));
typedef unsigned v2u __attribute__((ext_vector_type(2)));
typedef float f32x4 __attribute__((ext_vector_type(4)));
typedef float f32x16 __attribute__((ext_vector_type(16)));
typedef short bf16x8 __attribute__((ext_vector_type(8)));
typedef GAS unsigned gu32;
#define RLX_AGENT __ATOMIC_RELAXED, __HIP_MEMORY_SCOPE_AGENT
#define LDS_WAIT() asm volatile("s_waitcnt lgkmcnt(0)" ::: "memory")
#define VM_WAIT() asm volatile("s_waitcnt vmcnt(0)" ::: "memory")
__device__ __forceinline__ unsigned f2bf(float f) { unsigned u = __builtin_bit_cast(unsigned, f); return (u + 0x7fffu + ((u >> 16) & 1u)) >> 16; }
__device__ __forceinline__ unsigned pk2(float lo, float hi) { return f2bf(lo) | (f2bf(hi) << 16); }
__device__ __forceinline__ float bf2f(unsigned b) { return __builtin_bit_cast(float, b << 16); }
__device__ __forceinline__ float bflo(unsigned w) { return __builtin_bit_cast(float, w << 16); }
__device__ __forceinline__ float bfhi(unsigned w) { return __builtin_bit_cast(float, w & 0xffff0000u); }
__device__ __forceinline__ float rcpf_(float x) { return __builtin_amdgcn_rcpf(x); }
__device__ __forceinline__ float sigmoidf_(float x) { return rcpf_(1.f + __builtin_amdgcn_exp2f(-1.4426950408889634f * x)); }
__device__ __forceinline__ float siluf_(float x) { return x * rcpf_(1.f + __builtin_amdgcn_exp2f(-1.4426950408889634f * x)); }
__device__ __forceinline__ float shx(float v, int o, int lane) { return __builtin_bit_cast(float, __builtin_amdgcn_ds_bpermute((lane ^ o) << 2, __builtin_bit_cast(int, v))); }
__device__ __forceinline__ float shidx(float v, int src) { return __builtin_bit_cast(float, __builtin_amdgcn_ds_bpermute(src << 2, __builtin_bit_cast(int, v))); }
__device__ __forceinline__ int shidx_i(int v, int src) { return __builtin_amdgcn_ds_bpermute(src << 2, v); }
template <int CTRL> __device__ __forceinline__ float dpp_f(float v) { return __builtin_bit_cast(float, __builtin_amdgcn_update_dpp(0, __builtin_bit_cast(int, v), CTRL, 0xf, 0xf, true)); }
__device__ __forceinline__ float rdlane_f(float v, int l) { return __builtin_bit_cast(float, __builtin_amdgcn_readlane(__builtin_bit_cast(int, v), l)); }
__device__ __forceinline__ float wave_sum(float v, int) {
    v += dpp_f<0xB1>(v); v += dpp_f<0x4E>(v); v += dpp_f<0x141>(v); v += dpp_f<0x140>(v);
    return (rdlane_f(v, 0) + rdlane_f(v, 16)) + (rdlane_f(v, 32) + rdlane_f(v, 48));
}
__device__ __forceinline__ float wave_max(float v, int) {
    v = fmaxf(v, dpp_f<0xB1>(v)); v = fmaxf(v, dpp_f<0x4E>(v)); v = fmaxf(v, dpp_f<0x141>(v)); v = fmaxf(v, dpp_f<0x140>(v));
    return fmaxf(fmaxf(rdlane_f(v, 0), rdlane_f(v, 16)), fmaxf(rdlane_f(v, 32), rdlane_f(v, 48)));
}
__device__ const unsigned char T5B[128] = {0, 1, 2, 3, 4, 5, 6, 7, 8, 9, 10, 11, 12, 13, 14, 15, 16, 16, 16, 17, 17, 18, 18, 18, 19, 19, 19, 20, 20, 20, 20, 21, 21, 21, 21, 22, 22, 22, 22, 22, 23, 23, 23, 23, 23, 23, 24, 24, 24, 24, 24, 24, 25, 25, 25, 25, 25, 25, 25, 26, 26, 26, 26, 26, 26, 26, 26, 27, 27, 27, 27, 27, 27, 27, 27, 27, 27, 28, 28, 28, 28, 28, 28, 28, 28, 28, 28, 29, 29, 29, 29, 29, 29, 29, 29, 29, 29, 29, 29, 30, 30, 30, 30, 30, 30, 30, 30, 30, 30, 30, 30, 30, 30, 31, 31, 31, 31, 31, 31, 31, 31, 31, 31, 31, 31, 31, 31, 31};

#define XB_TMO      128
#define XB_XCNT(j)  (256  + 64 * (j))
#define XB_XSUB(j)  (1280 + 64 * (j))
#define XB_XGEN(j)  (2304 + 64 * (j))
#define XB_TOP      3328
#define XB_TOPGEN   3392
#define XCD_BAR_WORDS 3456
#define XB_SPIN_CAP (1u << 18)

__device__ __forceinline__ unsigned xb_ld(unsigned* p)              { return __hip_atomic_load(p, __ATOMIC_RELAXED, __HIP_MEMORY_SCOPE_AGENT); }
__device__ __forceinline__ unsigned xb_add(unsigned* p, unsigned v) { return __hip_atomic_fetch_add(p, v, __ATOMIC_RELAXED, __HIP_MEMORY_SCOPE_AGENT); }
__device__ __forceinline__ unsigned xb_xcc_id() { return (unsigned)__builtin_amdgcn_s_getreg((3 << 11) | 20) & 0xFu; }
#define XB_SPIN(cond, bar) do { unsigned _sp = 0; while (cond) { __builtin_amdgcn_s_sleep(1); \
    if ((++_sp & 255u) == 0u) { if (xb_ld(&(bar)[XB_TMO])) break; if (_sp > XB_SPIN_CAP) { atomicAdd(&(bar)[XB_TMO], 1u); break; } } } } while (0)

struct XcdBarrier {
    unsigned* bar; unsigned x;
    volatile LAS unsigned* st;
};

__device__ __forceinline__ XcdBarrier xcd_barrier_post(unsigned* bar, volatile LAS unsigned* st, const int tid_in) {
    XcdBarrier b; b.bar = bar; b.x = xb_xcc_id(); b.st = st;
    if (tid_in == 0) (void)xb_add(&bar[XB_XCNT(b.x)], 1u);
    return b;
}
__device__ __forceinline__ void xcd_barrier_complete(unsigned* bar, unsigned x, unsigned& nloc, unsigned& nx) {
    const unsigned G = gridDim.x * gridDim.y * gridDim.z;
    unsigned sum, cnt, mine, sp = 0u;
    for (;;) {
        sum = 0u; cnt = 0u; mine = 0u;
#pragma unroll
        for (unsigned j = 0; j < 16; ++j) { const unsigned c = xb_ld(&bar[XB_XCNT(j)]); sum += c; cnt += (c > 0u) ? 1u : 0u; mine = (j == x) ? c : mine; }
        if (sum == G) break;
        __builtin_amdgcn_s_sleep(1);
        if ((++sp & 255u) == 0u) { if (xb_ld(&bar[XB_TMO])) break; if (sp > XB_SPIN_CAP) { atomicAdd(&bar[XB_TMO], 1u); break; } }
    }
    nloc = mine > 0u ? mine : 1u; nx = cnt > 0u ? cnt : 1u;
}

__device__ __forceinline__ void xcd_barrier(const XcdBarrier& b, const int tid_in) {
    asm volatile("s_waitcnt vmcnt(0)" ::: "memory");
    __syncthreads();
    if (tid_in == 0) {
        unsigned* bar = b.bar;
        __builtin_amdgcn_s_waitcnt(0);
        unsigned nloc = b.st[0], nx = b.st[1];
        if (nloc == 0u) { xcd_barrier_complete(bar, b.x, nloc, nx); b.st[0] = nloc; b.st[1] = nx; }
        const unsigned old = xb_add(&bar[XB_XSUB(b.x)], 1u);
        const unsigned gen = old / nloc;
        if (old + 1u == (gen + 1u) * nloc) {
            __builtin_amdgcn_fence(__ATOMIC_RELEASE, "agent");
            asm volatile("s_waitcnt vmcnt(0)" ::: "memory");
            const unsigned og = xb_add(&bar[XB_TOP], 1u);
            const unsigned tg = og / nx;
            if (og + 1u == (tg + 1u) * nx) xb_add(&bar[XB_TOPGEN], 1u);
            else XB_SPIN(xb_ld(&bar[XB_TOPGEN]) == tg, bar);
            __builtin_amdgcn_fence(__ATOMIC_ACQUIRE, "agent");
            xb_add(&bar[XB_XGEN(b.x)], 1u);
            asm volatile("s_waitcnt vmcnt(0)" ::: "memory");
        } else {
            XB_SPIN(xb_ld(&bar[XB_XGEN(b.x)]) == gen, bar);
            __builtin_amdgcn_fence(__ATOMIC_ACQUIRE, "agent");
            asm volatile("s_waitcnt vmcnt(0)" ::: "memory");
        }
    }
    __syncthreads();
}
struct Args { const float* in[23]; float* out; unsigned char* ws; int ph_lo, ph_hi; };
enum { I_X = 0, I_C, I_RELB, I_FNW, I_N1W, I_N2W, I_WMOD, I_BMOD, I_WIN, I_CONVW, I_ALOG, I_DTB, I_ONW, I_WUPA, I_WUPB, I_WOUT, I_WRG, I_BRG, I_WRE, I_BRE, I_WEG, I_WEU, I_WED };

typedef const Args __attribute__((address_space(4)))* KArgs;
struct Ctx { LAS unsigned char* lds; int tid, lane, wave, bid, G; };
extern __shared__ __attribute__((aligned(16))) unsigned char lds_raw[];
__device__ __forceinline__ Ctx make_ctx(int& tid) { Ctx c; c.lds = (LAS unsigned char*)lds_raw; asm volatile("" : "+v"(tid)); const int t = tid; c.tid = t; c.lane = t & 63; c.wave = __builtin_amdgcn_readfirstlane(t >> 6); int bi = blockIdx.x, gd = gridDim.x; asm volatile("" : "+s"(bi), "+s"(gd)); c.bid = bi; c.G = gd; return c; }

__device__ __forceinline__ void ph_mod(KArgs a, const Ctx& c) {
    LAS float* cact = (LAS float*)c.lds;
    LAS float* red = (LAS float*)(c.lds + 16384);
    const float* cin = a->in[I_C];
    for (int i = c.tid; i < 4096; i += NTHR) cact[i] = siluf_(cin[i]);
    __syncthreads();
    float* mod = (float*)(a->ws + WS_MOD);
    for (int item = c.bid; item < 192; item += c.G) {
        const int l = item / 96, j0 = (item % 96) * 64;
        const float* W = a->in[I_WMOD] + (size_t)l * 1024 * 6144 + j0 + c.lane;
        float a0 = 0.f, a1 = 0.f, a2 = 0.f, a3 = 0.f;
        const int k0 = c.wave * 128;
#pragma unroll 8
        for (int k = k0; k < k0 + 128; ++k) { const float w = W[(size_t)k * 6144]; a0 += cact[k] * w; a1 += cact[1024 + k] * w; a2 += cact[2048 + k] * w; a3 += cact[3072 + k] * w; }
        red[(c.wave * 4 + 0) * 64 + c.lane] = a0; red[(c.wave * 4 + 1) * 64 + c.lane] = a1; red[(c.wave * 4 + 2) * 64 + c.lane] = a2; red[(c.wave * 4 + 3) * 64 + c.lane] = a3;
        __syncthreads();
        if (c.tid < 256) { const int b = c.tid >> 6, ln = c.tid & 63; float s = 0.f;
#pragma unroll
            for (int w = 0; w < 8; ++w) s += red[(w * 4 + b) * 64 + ln];
            mod[(l * 4 + b) * 6144 + j0 + ln] = s + a->in[I_BMOD][l * 6144 + j0 + ln]; }
        __syncthreads();
    }
}

__device__ __forceinline__ void tr_item(const float* src, int ld, bf16* dst, int K, int nblk, LAS float* scr, int item, int lane) {
    const int kb = item / nblk, nb = item % nblk, k0 = 64 * kb, n0 = 32 * nb;
#pragma unroll 8
    for (int i = 0; i < 32; ++i) { const int kk = 2 * i + (lane >> 5); scr[kk * 33 + (lane & 31)] = src[(size_t)(k0 + kk) * ld + n0 + (lane & 31)]; }
    LDS_WAIT(); asm volatile("" ::: "memory");
    const int cc = lane & 7;
#pragma unroll
    for (int j = 0; j < 4; ++j) { const int n = (lane >> 3) + 8 * j; const LAS float* s = scr + (8 * cc) * 33 + n;
        v4u o; o.x = pk2(s[0 * 33], s[1 * 33]); o.y = pk2(s[2 * 33], s[3 * 33]); o.z = pk2(s[4 * 33], s[5 * 33]); o.w = pk2(s[6 * 33], s[7 * 33]);
        *(v4u*)(dst + (size_t)(n0 + n) * K + k0 + 8 * cc) = o; }
    LDS_WAIT(); asm volatile("" ::: "memory");
}
constexpr int CV_I0 = 1792, CV_I1 = 1024, CV_I2 = 256, CV_I3 = 256, CV_I4 = 512, CV_I5 = 4096, CV_I6 = 4096, CV_I7 = 4096;
constexpr int CV_NIT = CV_I0 + CV_I1 + CV_I2 + CV_I3 + CV_I4 + CV_I5 + CV_I6 + CV_I7, CV_EARLY = CV_I0 + CV_I1;
__device__ __forceinline__ void convert_item(KArgs a, int l, int it, LAS float* scr, int lane) {
    bf16* WIN = (bf16*)(a->ws + WS_WIN); bf16* WEGU = (bf16*)(a->ws + WS_WEGU); bf16* WEDT = (bf16*)(a->ws + WS_WED);
    const float* win = a->in[I_WIN] + (size_t)l * 1024 * DIN;
    int r = it;
    if (r < CV_I0) { tr_item(win, DIN, WIN, 1024, 112, scr, r, lane); return; } r -= CV_I0;
    if (r < CV_I1) { tr_item(win + C_GATE, DIN, WIN + (size_t)C_BA * 1024, 1024, 64, scr, r, lane); return; } r -= CV_I1;
    if (r < CV_I2) { tr_item(a->in[I_WUPA] + (size_t)l * 512 * 1024, 1024, (bf16*)(a->ws + WS_WUPA), 512, 32, scr, r, lane); return; } r -= CV_I2;
    if (r < CV_I3) { tr_item(a->in[I_WUPB] + (size_t)l * 512 * 1024, 1024, (bf16*)(a->ws + WS_WUPB), 512, 32, scr, r, lane); return; } r -= CV_I3;
    if (r < CV_I4) { tr_item(a->in[I_WOUT] + (size_t)l * 1024 * 1024, 1024, (bf16*)(a->ws + WS_WOUT), 1024, 32, scr, r, lane); return; } r -= CV_I4;
    if (r < CV_I5) { const int E = r >> 7, rem = r & 127, pn = rem >> 6, q = rem & 63;
        tr_item(a->in[I_WEG] + ((size_t)(l * 32 + E) * 1024 * 256) + 128 * pn, 256, WEGU + (size_t)(E * 512 + 256 * pn) * 1024, 1024, 4, scr, q, lane); return; } r -= CV_I5;
    if (r < CV_I6) { const int E = r >> 7, rem = r & 127, pn = rem >> 6, q = rem & 63;
        tr_item(a->in[I_WEU] + ((size_t)(l * 32 + E) * 1024 * 256) + 128 * pn, 256, WEGU + (size_t)(E * 512 + 256 * pn + 128) * 1024, 1024, 4, scr, q, lane); return; } r -= CV_I6;
    { const int E = r >> 7, q = r & 127;
        tr_item(a->in[I_WED] + ((size_t)(l * 32 + E) * 256 * 1024), 1024, WEDT + (size_t)E * 1024 * 256, 256, 32, scr, q, lane); }
}
__device__ __forceinline__ void ph_convert(KArgs a, const Ctx& c, int l) {
    LAS float* scr = (LAS float*)(c.lds + 32768 + c.wave * 10240);
    const int gw = c.bid * NW + c.wave, NGW = c.G * NW;
    for (int it = gw; it < CV_EARLY; it += NGW) convert_item(a, l, it, scr, c.lane);
}
constexpr int CV_UNIT = 64, CV_NUNITS = (CV_NIT - CV_EARLY) / CV_UNIT;
static_assert((CV_NIT - CV_EARLY) % CV_UNIT == 0, "convert units");
__device__ __forceinline__ void convert_unit(KArgs a, const Ctx& c, int l, int cu) {
    LAS float* scr = (LAS float*)(c.lds + 32768 + c.wave * 10240);
#pragma unroll 1
    for (int i = 0; i < 8; ++i) convert_item(a, l, CV_EARLY + cu * CV_UNIT + c.wave * 8 + i, scr, c.lane);
}

__device__ __forceinline__ void load_row_x(KArgs a, int l, int m, int lane, f32x4 (&v)[4]) {
    const float* xr = (l == 0 ? a->in[I_X] : (const float*)a->out) + (size_t)m * DM;
#pragma unroll
    for (int j = 0; j < 4; ++j) v[j] = *(const f32x4*)(xr + 256 * j + 4 * lane);
    if (l > 0) {
        const int b = m >> 12;
        const float* g2 = (const float*)(a->ws + WS_MOD) + ((l - 1) * 4 + b) * 6144 + 5120;
        const bf16* ys = (const bf16*)(a->ws + WS_YS) + (size_t)m * 2048;
#pragma unroll
        for (int j = 0; j < 4; ++j) { const int col = 256 * j + 4 * lane; const v2u y0 = *(const v2u*)(ys + col), y1 = *(const v2u*)(ys + 1024 + col); const f32x4 g = *(const f32x4*)(g2 + col);
            v[j].x += g.x * (bflo(y0.x) + bflo(y1.x)); v[j].y += g.y * (bfhi(y0.x) + bfhi(y1.x)); v[j].z += g.z * (bflo(y0.y) + bflo(y1.y)); v[j].w += g.w * (bfhi(y0.y) + bfhi(y1.y)); }
        float* xo = a->out + (size_t)m * DM;
#pragma unroll
        for (int j = 0; j < 4; ++j) *(f32x4*)(xo + 256 * j + 4 * lane) = v[j];
    }
}
__device__ __forceinline__ float row_rstd(const f32x4 (&v)[4], int lane) {
    float s = 0.f;
#pragma unroll
    for (int j = 0; j < 4; ++j) s += (v[j].x * v[j].x + v[j].y * v[j].y) + (v[j].z * v[j].z + v[j].w * v[j].w);
    return __builtin_amdgcn_rsqf(wave_sum(s, lane) * (1.f / DM) + EPS);
}
__device__ __forceinline__ void ph_norm1(KArgs a, const Ctx& c, int l) {
    LAS float* wbaT = (LAS float*)c.lds;
    const float* win = a->in[I_WIN] + (size_t)l * 1024 * DIN + C_BA;
    for (int i = c.tid; i < 8192; i += NTHR) { const int k = i >> 3, cc = i & 7; wbaT[cc * 1024 + k] = win[(size_t)k * DIN + cc]; }
    __syncthreads();
    const int gw = c.bid * NW + c.wave, NGW = c.G * NW, lane = c.lane;
    bf16* H = (bf16*)(a->ws + WS_H); float* beta = (float*)(a->ws + WS_BETA); float* glog = (float*)(a->ws + WS_GLOG);
    const float* n1w = a->in[I_N1W] + l * DM;
    for (int m = gw; m < NTOK; m += NGW) {
        f32x4 v[4]; load_row_x(a, l, m, lane, v);
        const float rstd = row_rstd(v, lane);
        const int b = m >> 12; const float* mod = (const float*)(a->ws + WS_MOD) + (l * 4 + b) * 6144;
        float acc[8];
#pragma unroll
        for (int q = 0; q < 8; ++q) acc[q] = 0.f;
#pragma unroll
        for (int j = 0; j < 4; ++j) { const int col = 256 * j + 4 * lane;
            const f32x4 nw = *(const f32x4*)(n1w + col), sh = *(const f32x4*)(mod + col), sc = *(const f32x4*)(mod + 1024 + col);
            f32x4 h = v[j] * rstd * nw * (sc + 1.0f) + sh;
            v2u o; o.x = pk2(h.x, h.y); o.y = pk2(h.z, h.w); *(v2u*)(H + (size_t)m * DM + col) = o;
#pragma unroll
            for (int q = 0; q < 8; ++q) { const f32x4 w4 = *(const LAS f32x4*)(wbaT + q * 1024 + col); acc[q] += (h.x * w4.x + h.y * w4.y) + (h.z * w4.z + h.w * w4.w); } }
#pragma unroll
        for (int q = 0; q < 8; ++q) acc[q] = wave_sum(acc[q], lane);
        if (lane < 4) {
            const float bb = lane == 0 ? acc[0] : lane == 1 ? acc[1] : lane == 2 ? acc[2] : acc[3];
            const float aa = lane == 0 ? acc[4] : lane == 1 ? acc[5] : lane == 2 ? acc[6] : acc[7];
            beta[m * 4 + lane] = sigmoidf_(bb);
            const float z = aa + a->in[I_DTB][l * 4 + lane]; const float sp = fmaxf(z, 0.f) + log1pf(__expf(-fabsf(z)));
            glog[m * 4 + lane] = -__expf(a->in[I_ALOG][l * 4 + lane]) * sp;
        }
    }
}
__device__ __forceinline__ void ph_final(KArgs a, const Ctx& c) {
    const int gw = c.bid * NW + c.wave, NGW = c.G * NW, lane = c.lane;
    const float* fw = a->in[I_FNW];
    for (int m = gw; m < NTOK; m += NGW) {
        f32x4 v[4];
        {
            const float* xr = (const float*)a->out + (size_t)m * DM; const int b = m >> 12;
            const float* g2 = (const float*)(a->ws + WS_MOD) + ((NLAYER - 1) * 4 + b) * 6144 + 5120;
            const bf16* ys = (const bf16*)(a->ws + WS_YS) + (size_t)m * 2048;
#pragma unroll
            for (int j = 0; j < 4; ++j) { const int col = 256 * j + 4 * lane; v[j] = *(const f32x4*)(xr + col);
                const v2u y0 = *(const v2u*)(ys + col), y1 = *(const v2u*)(ys + 1024 + col); const f32x4 g = *(const f32x4*)(g2 + col);
                v[j].x += g.x * (bflo(y0.x) + bflo(y1.x)); v[j].y += g.y * (bfhi(y0.x) + bfhi(y1.x)); v[j].z += g.z * (bflo(y0.y) + bflo(y1.y)); v[j].w += g.w * (bfhi(y0.y) + bfhi(y1.y)); }
        }
        float rstd = row_rstd(v, lane);
#if defined(MK_PROBE_A) && MK_PROBE_A >= 0
        {   const unsigned long long* ts = (const unsigned long long*)((const unsigned*)(a->ws + WS_CTL) + 12288);
            float tA = 0.f, tB = 0.f;
            for (int ly = 0; ly < NLAYER; ++ly) { const int ka = 1 + ly * 11 + MK_PROBE_A, kb = 1 + ly * 11 + MK_PROBE_B;
                if (MK_PROBE_A < 11) tA += (float)(ts[ka + 1] - ts[ka]) * 0.01f; if (MK_PROBE_B < 11) tB += (float)(ts[kb + 1] - ts[kb]) * 0.01f; }
            if (MK_PROBE_A == 20) { tA = 0.f; for (int ly = 0; ly < NLAYER; ++ly) tA += (float)(ts[40 + ly] - ts[1 + ly * 11 + 3]) * 0.01f; }
            if (MK_PROBE_B == 21) { tB = 0.f; for (int ly = 0; ly < NLAYER; ++ly) tB += (float)(ts[44 + ly] - ts[1 + ly * 11 + 3]) * 0.01f; }
            if (MK_PROBE_A >= 22 && MK_PROBE_A <= 24) { tA = 0.f; for (int ly = 0; ly < NLAYER; ++ly) tA += (float)ts[48 + ly * 4 + MK_PROBE_A - 22] * 0.01f; }
            if (MK_PROBE_B >= 22 && MK_PROBE_B <= 24) { tB = 0.f; for (int ly = 0; ly < NLAYER; ++ly) tB += (float)ts[48 + ly * 4 + MK_PROBE_B - 22] * 0.01f; }
            if (MK_PROBE_A == 11) tA = (float)(ts[1] - ts[0]) * 0.01f; if (MK_PROBE_A == 12) tA = (float)(ts[23] - ts[0]) * 0.01f;
            if (MK_PROBE_B == 11) tB = (float)(ts[1] - ts[0]) * 0.01f; if (MK_PROBE_B == 12) tB = (float)(ts[23] - ts[0]) * 0.01f;
            (void)tB;
            if (m == 0 && lane == 0) v[0].x += tA * 0.05f / rstd / fw[0]; }
#endif
        float* xo = a->out + (size_t)m * DM;
#pragma unroll
        for (int j = 0; j < 4; ++j) { const int col = 256 * j + 4 * lane; const f32x4 w = *(const f32x4*)(fw + col); *(f32x4*)(xo + col) = v[j] * rstd * w; }
    }
}

__device__ __forceinline__ void ph_kmean(KArgs a, const Ctx& c) {
    const int gw = c.bid * NW + c.wave, NGW = c.G * NW, lane = c.lane;
    const bf16* QKVA = (const bf16*)(a->ws + WS_QKVA); float* kmean = (float*)(a->ws + WS_KMEAN);
    for (int item = gw; item < NB * HA * NBLK; item += NGW) {
        const int nb = item & 15, h = (item >> 4) & 7, b = item >> 7;
        const int sub = lane & 7, rr = lane >> 3;
        float s[8];
#pragma unroll
        for (int q = 0; q < 8; ++q) s[q] = 0.f;
        const bf16* kp = QKVA + (size_t)(b * SEQ + nb * MBLK) * 1536 + 512 + h * 64 + sub * 8;
#pragma unroll 4
        for (int it = 0; it < 32; ++it) { const v4u w = *(const v4u*)(kp + (size_t)(it * 8 + rr) * 1536);
            s[0] += bflo(w.x); s[1] += bfhi(w.x); s[2] += bflo(w.y); s[3] += bfhi(w.y); s[4] += bflo(w.z); s[5] += bfhi(w.z); s[6] += bflo(w.w); s[7] += bfhi(w.w); }
#pragma unroll
        for (int q = 0; q < 8; ++q) { s[q] += shx(s[q], 8, lane); s[q] += shx(s[q], 16, lane); s[q] += shx(s[q], 32, lane); }
        if (lane < 8) { float* o = kmean + (size_t)item * 64 + sub * 8;
            *(f32x4*)o = (f32x4){s[0], s[1], s[2], s[3]} * (1.f / 256.f); *(f32x4*)(o + 4) = (f32x4){s[4], s[5], s[6], s[7]} * (1.f / 256.f); }
    }
}

__device__ __forceinline__ void ph_attn_simple(KArgs a, const Ctx& c) {
    const int gw = c.bid * NW + c.wave, NGW = c.G * NW, lane = c.lane;
    LAS float* btab = (LAS float*)(c.lds);
    LAS float* scw = (LAS float*)(c.lds + 8192) + c.wave * 1024;
    const float* relb = a->in[I_RELB];
    for (int i = c.tid; i < 8 * 129; i += NTHR) { const int h = i / 129, d = i % 129; btab[h * 132 + d] = relb[(d < 128 ? (int)T5B[d] : 31) * 8 + h]; }
    __syncthreads();
    const bf16* QKVA = (const bf16*)(a->ws + WS_QKVA); const float* kmean = (const float*)(a->ws + WS_KMEAN); bf16* YA = (bf16*)(a->ws + WS_YA);
    for (int r = gw; r < NB * HA * SEQ; r += NGW) {
        const int s = r & (SEQ - 1), h = (r >> 12) & 7, b = r >> 15, qb = s >> 8, tok = b * SEQ + s;
        float qv[64];
        { const bf16* qp = QKVA + (size_t)tok * 1536 + h * 64;
#pragma unroll
          for (int q = 0; q < 8; ++q) { const v4u w = *(const v4u*)(qp + q * 8); qv[q * 8 + 0] = bflo(w.x); qv[q * 8 + 1] = bfhi(w.x); qv[q * 8 + 2] = bflo(w.y); qv[q * 8 + 3] = bfhi(w.y); qv[q * 8 + 4] = bflo(w.z); qv[q * 8 + 5] = bfhi(w.z); qv[q * 8 + 6] = bflo(w.w); qv[q * 8 + 7] = bfhi(w.w); } }
        float gate = -1e30f;
        if (lane < qb) { const float* km = kmean + (size_t)(((b * 8 + h) * 16) + lane) * 64; float d = 0.f;
#pragma unroll
            for (int q = 0; q < 16; ++q) { const f32x4 k4 = *(const f32x4*)(km + q * 4); d += qv[q * 4] * k4.x + qv[q * 4 + 1] * k4.y + qv[q * 4 + 2] * k4.z + qv[q * 4 + 3] * k4.w; }
            gate = d; }
        unsigned selmask = 0u;
#pragma unroll
        for (int t = 0; t < 3; ++t) { float best = -3e38f; int bi = 0;
#pragma unroll
            for (int n = 0; n < 16; ++n) { const float gv = shidx(gate, n); if (!((selmask >> n) & 1u) && gv > best) { best = gv; bi = n; } }
            selmask |= 1u << bi; }
        selmask &= (1u << qb) - 1u;
        selmask |= 1u << qb;
        int nseg = 0; float mx = -3e38f;
        for (int blk = 0; blk <= qb; ++blk) {
            if (!((selmask >> blk) & 1u)) continue;
            for (int i = 0; i < 4; ++i) { const int key = blk * 256 + i * 64 + lane; const bf16* kp = QKVA + (size_t)(b * SEQ + key) * 1536 + 512 + h * 64; float d = 0.f;
#pragma unroll
                for (int q = 0; q < 8; ++q) { const v4u w = *(const v4u*)(kp + q * 8);
                    d += qv[q * 8] * bflo(w.x) + qv[q * 8 + 1] * bfhi(w.x) + qv[q * 8 + 2] * bflo(w.y) + qv[q * 8 + 3] * bfhi(w.y) + qv[q * 8 + 4] * bflo(w.z) + qv[q * 8 + 5] * bfhi(w.z) + qv[q * 8 + 6] * bflo(w.w) + qv[q * 8 + 7] * bfhi(w.w); }
                const int dist = s - key; float sc = d * 0.125f + btab[h * 132 + (dist < 0 ? 0 : (dist > 128 ? 128 : dist))];
                if (dist < 0) sc = -3e38f;
                scw[nseg * 256 + i * 64 + lane] = sc; mx = fmaxf(mx, sc); }
            ++nseg; }
        mx = wave_max(mx, lane);
        float sum = 0.f;
        for (int idx = lane; idx < nseg * 256; idx += 64) { const float sc = scw[idx]; const float e = sc < -1e37f ? 0.f : __expf(sc - mx); scw[idx] = e; sum += e; }
        sum = wave_sum(sum, lane);
        LDS_WAIT();
        float o = 0.f; int sg = 0;
        for (int blk = 0; blk <= qb; ++blk) {
            if (!((selmask >> blk) & 1u)) continue;
            const bf16* vp = QKVA + (size_t)(b * SEQ + blk * 256) * 1536 + 1024 + h * 64 + lane;
            const int lim = (blk == qb) ? (s & 255) + 1 : 256;
#pragma unroll 8
            for (int kk = 0; kk < lim; ++kk) o += scw[sg * 256 + kk] * bf2f(vp[(size_t)kk * 1536]);
            ++sg; }
        YA[(size_t)tok * 512 + h * 64 + lane] = (bf16)f2bf(o / sum);
    }
}

template <int LDW> __device__ __forceinline__ void dn_load_chunk(KArgs a, const Ctx& c, int l, int b, int h, int t0, LAS float* qs, LAS float* ks, LAS float* vs) {
    const bf16* QKVB = (const bf16*)(a->ws + WS_QKVB); const float* cw = a->in[I_CONVW] + (size_t)l * 4 * 1536;
    const int cg = c.tid & 15, r0 = c.tid >> 4;
#pragma unroll
    for (int part = 0; part < 3; ++part) {
        const int colb = part * 512 + h * 128 + 8 * cg;
        float w[4][8];
#pragma unroll
        for (int i = 0; i < 4; ++i) { const f32x4 w0 = *(const f32x4*)(cw + i * 1536 + colb), w1 = *(const f32x4*)(cw + i * 1536 + colb + 4);
            w[i][0] = w0.x; w[i][1] = w0.y; w[i][2] = w0.z; w[i][3] = w0.w; w[i][4] = w1.x; w[i][5] = w1.y; w[i][6] = w1.z; w[i][7] = w1.w; }
        LAS float* dst = part == 0 ? qs : part == 1 ? ks : vs;
#pragma unroll
        for (int pass = 0; pass < 2; ++pass) {
            const int r = r0 + 32 * pass, t = t0 + r;
            float y[8];
#pragma unroll
            for (int e = 0; e < 8; ++e) y[e] = 0.f;
#pragma unroll
            for (int i = 0; i < 4; ++i) { const int tt = t - 3 + i; if (tt >= 0) { const v4u x = *(const v4u*)(QKVB + (size_t)(b * SEQ + tt) * 1536 + colb);
                y[0] += w[i][0] * bflo(x.x); y[1] += w[i][1] * bfhi(x.x); y[2] += w[i][2] * bflo(x.y); y[3] += w[i][3] * bfhi(x.y); y[4] += w[i][4] * bflo(x.z); y[5] += w[i][5] * bfhi(x.z); y[6] += w[i][6] * bflo(x.w); y[7] += w[i][7] * bfhi(x.w); } }
            float ss = 0.f;
#pragma unroll
            for (int e = 0; e < 8; ++e) { y[e] = siluf_(y[e]); ss += y[e] * y[e]; }
            if (part < 2) { ss += shx(ss, 1, c.lane); ss += shx(ss, 2, c.lane); ss += shx(ss, 4, c.lane); ss += shx(ss, 8, c.lane);
                const float rs = __builtin_amdgcn_rsqf(ss + EPS) * (part == 0 ? 0.08838834764831845f : 1.f);
#pragma unroll
                for (int e = 0; e < 8; ++e) y[e] *= rs; }
            *(LAS f32x4*)(dst + r * LDW + 8 * cg) = (f32x4){y[0], y[1], y[2], y[3]}; *(LAS f32x4*)(dst + r * LDW + 8 * cg + 4) = (f32x4){y[4], y[5], y[6], y[7]};
        }
    }
}
__device__ __forceinline__ void dn_store_chunk(KArgs a, const Ctx& c, int l, int b, int h, int t0, const LAS float* os) {
    const bf16* ZB = (const bf16*)(a->ws + WS_ZB); bf16* YB = (bf16*)(a->ws + WS_YB); const float* onw = a->in[I_ONW] + l * 128;
    const int r = c.tid >> 3, sub = c.tid & 7, tok = b * SEQ + t0 + r;
    float o[16]; float ss = 0.f;
#pragma unroll
    for (int q = 0; q < 4; ++q) { const f32x4 v = *(const LAS f32x4*)(os + r * 128 + sub * 16 + q * 4); o[q * 4] = v.x; o[q * 4 + 1] = v.y; o[q * 4 + 2] = v.z; o[q * 4 + 3] = v.w; ss += (v.x * v.x + v.y * v.y) + (v.z * v.z + v.w * v.w); }
    ss += shx(ss, 1, c.lane); ss += shx(ss, 2, c.lane); ss += shx(ss, 4, c.lane);
    const float rstd = __builtin_amdgcn_rsqf(ss * (1.f / 128.f) + EPS);
    const bf16* zp = ZB + (size_t)tok * 512 + h * 128 + sub * 16; bf16* yp = YB + (size_t)tok * 512 + h * 128 + sub * 16;
#pragma unroll
    for (int q = 0; q < 2; ++q) { const v4u z = *(const v4u*)(zp + q * 8); const f32x4 w0 = *(const f32x4*)(onw + sub * 16 + q * 8), w1 = *(const f32x4*)(onw + sub * 16 + q * 8 + 4);
        v4u y; y.x = pk2(o[q * 8 + 0] * rstd * w0.x * siluf_(bflo(z.x)), o[q * 8 + 1] * rstd * w0.y * siluf_(bfhi(z.x)));
        y.y = pk2(o[q * 8 + 2] * rstd * w0.z * siluf_(bflo(z.y)), o[q * 8 + 3] * rstd * w0.w * siluf_(bfhi(z.y)));
        y.z = pk2(o[q * 8 + 4] * rstd * w1.x * siluf_(bflo(z.z)), o[q * 8 + 5] * rstd * w1.y * siluf_(bfhi(z.z)));
        y.w = pk2(o[q * 8 + 6] * rstd * w1.z * siluf_(bflo(z.w)), o[q * 8 + 7] * rstd * w1.w * siluf_(bfhi(z.w)));
        *(v4u*)(yp + q * 8) = y; }
}
__device__ __forceinline__ void ph_dn_simple(KArgs a, const Ctx& c, int l) {
    LAS float* qs = (LAS float*)c.lds; LAS float* ks = qs + 8192; LAS float* vs = ks + 8192; LAS float* os = vs + 8192;
    LAS float* bt = (LAS float*)(c.lds + MISC_OFF + 1024); LAS float* at = bt + 64;
    const float* beta = (const float*)(a->ws + WS_BETA); const float* glog = (const float*)(a->ws + WS_GLOG);
    const int v = c.tid >> 2, kq = c.tid & 3;
    for (int item = c.bid; item < NB * HB; item += c.G) {
        const int b = item >> 2, h = item & 3;
        float S[32];
#pragma unroll
        for (int q = 0; q < 32; ++q) S[q] = 0.f;
        for (int n = 0; n < NCH; ++n) {
            const int t0 = n * DNC;
            __syncthreads();
            dn_load_chunk<128>(a, c, l, b, h, t0, qs, ks, vs);
            if (c.tid < 64) { const int tok = b * SEQ + t0 + c.tid; bt[c.tid] = beta[tok * 4 + h]; at[c.tid] = __expf(glog[tok * 4 + h]); }
            __syncthreads();
            for (int tt = 0; tt < DNC; ++tt) {
                const float a_t = at[tt], b_t = bt[tt];
                float kr[32];
#pragma unroll
                for (int q = 0; q < 8; ++q) { const f32x4 k4 = *(const LAS f32x4*)(ks + tt * 128 + kq * 32 + q * 4); kr[q * 4] = k4.x; kr[q * 4 + 1] = k4.y; kr[q * 4 + 2] = k4.z; kr[q * 4 + 3] = k4.w; }
                float kS = 0.f;
#pragma unroll
                for (int q = 0; q < 32; ++q) kS += kr[q] * S[q];
                kS += shx(kS, 1, c.lane); kS += shx(kS, 2, c.lane);
                const float vn = b_t * (vs[tt * 128 + v] - a_t * kS);
                float o = 0.f;
#pragma unroll
                for (int q = 0; q < 8; ++q) { const f32x4 q4 = *(const LAS f32x4*)(qs + tt * 128 + kq * 32 + q * 4);
                    S[q * 4] = a_t * S[q * 4] + kr[q * 4] * vn; S[q * 4 + 1] = a_t * S[q * 4 + 1] + kr[q * 4 + 1] * vn; S[q * 4 + 2] = a_t * S[q * 4 + 2] + kr[q * 4 + 2] * vn; S[q * 4 + 3] = a_t * S[q * 4 + 3] + kr[q * 4 + 3] * vn;
                    o += (q4.x * S[q * 4] + q4.y * S[q * 4 + 1]) + (q4.z * S[q * 4 + 2] + q4.w * S[q * 4 + 3]); }
                o += shx(o, 1, c.lane); o += shx(o, 2, c.lane);
                if (kq == 0) os[tt * 128 + v] = o;
            }
            __syncthreads();
            dn_store_chunk(a, c, l, b, h, t0, os);
        }
    }
}

struct EpiProj {
    static constexpr bool PERM = true, AFTER_DRAIN = false; unsigned char* ws;
    __device__ __forceinline__ void operator()(const pg8::f32x4 (&acc)[2][2][4][2], const pg8::Unit& u, int wr, int wc, int fr, int fq) const {
        const int pn = u.pn; bf16* base; int ld, ct; bool sg = false;
        if (pn < 6) { base = (bf16*)(ws + WS_QKVA); ld = 1536; ct = pn; } else if (pn < 12) { base = (bf16*)(ws + WS_QKVB); ld = 1536; ct = pn - 6; }
        else if (pn < 14) { base = (bf16*)(ws + WS_ZB); ld = 512; ct = pn - 12; } else { base = (bf16*)(ws + WS_GATES); ld = 2048; ct = pn - 14; sg = true; }
        const int row0 = u.pm * 256 + wr * 64 + fr, col0 = ct * 256 + wc * 32 + 8 * fq;
#pragma unroll
        for (int ai = 0; ai < 2; ++ai)
#pragma unroll
            for (int m = 0; m < 4; ++m) { bf16* rowp = base + (size_t)(row0 + ai * 128 + m * 16) * ld + col0;
#pragma unroll
                for (int bj = 0; bj < 2; ++bj) { f32x4 v0 = acc[ai][bj][m][0], v1 = acc[ai][bj][m][1];
                    if (sg) { v0.x = sigmoidf_(v0.x); v0.y = sigmoidf_(v0.y); v0.z = sigmoidf_(v0.z); v0.w = sigmoidf_(v0.w); v1.x = sigmoidf_(v1.x); v1.y = sigmoidf_(v1.y); v1.z = sigmoidf_(v1.z); v1.w = sigmoidf_(v1.w); }
                    v4u w; w.x = pk2(v0.x, v0.y); w.y = pk2(v0.z, v0.w); w.z = pk2(v1.x, v1.y); w.w = pk2(v1.z, v1.w);
                    *(v4u*)(rowp + bj * 128) = w; } }
    }
};
template <bool SECOND> struct EpiMerge {
    static constexpr bool PERM = true, AFTER_DRAIN = false; unsigned char* ws;
    __device__ __forceinline__ void operator()(const pg8::f32x4 (&acc)[2][2][4][2], const pg8::Unit& u, int wr, int wc, int fr, int fq) const {
        bf16* M = (bf16*)(ws + WS_M); const bf16* GT = (const bf16*)(ws + WS_GATES) + (SECOND ? 1024 : 0);
        const int row0 = u.pm * 256 + wr * 64 + fr, col0 = u.pn * 256 + wc * 32 + 8 * fq;
#pragma unroll
        for (int ai = 0; ai < 2; ++ai)
#pragma unroll
            for (int m = 0; m < 4; ++m) { const size_t row = row0 + ai * 128 + m * 16;
#pragma unroll
                for (int bj = 0; bj < 2; ++bj) { const int col = col0 + bj * 128; const f32x4 v0 = acc[ai][bj][m][0], v1 = acc[ai][bj][m][1];
                    const v4u g = *(const v4u*)(GT + row * 2048 + col);
                    float o[8] = {bflo(g.x) * v0.x, bfhi(g.x) * v0.y, bflo(g.y) * v0.z, bfhi(g.y) * v0.w, bflo(g.z) * v1.x, bfhi(g.z) * v1.y, bflo(g.w) * v1.z, bfhi(g.w) * v1.w};
                    if (SECOND) { const v4u p = *(const v4u*)(M + row * 1024 + col); o[0] += bflo(p.x); o[1] += bfhi(p.x); o[2] += bflo(p.y); o[3] += bfhi(p.y); o[4] += bflo(p.z); o[5] += bfhi(p.z); o[6] += bflo(p.w); o[7] += bfhi(p.w); }
                    v4u w; w.x = pk2(o[0], o[1]); w.y = pk2(o[2], o[3]); w.z = pk2(o[4], o[5]); w.w = pk2(o[6], o[7]);
                    *(v4u*)(M + row * 1024 + col) = w; } }
    }
};
struct EpiOut {
    static constexpr bool PERM = true, AFTER_DRAIN = false; const float* xin; float* xout; const float* g1;
    __device__ __forceinline__ void operator()(const pg8::f32x4 (&acc)[2][2][4][2], const pg8::Unit& u, int wr, int wc, int fr, int fq) const {
        const int row0 = u.pm * 256 + wr * 64 + fr, col0 = u.pn * 256 + wc * 32 + 8 * fq; const int b = (u.pm * 256) >> 12;
#pragma unroll
        for (int bj = 0; bj < 2; ++bj) { const int col = col0 + bj * 128; const f32x4 ga = *(const f32x4*)(g1 + b * 6144 + col), gb = *(const f32x4*)(g1 + b * 6144 + col + 4);
#pragma unroll
            for (int ai = 0; ai < 2; ++ai)
#pragma unroll
                for (int m = 0; m < 4; ++m) { const size_t off = (size_t)(row0 + ai * 128 + m * 16) * DM + col;
                    const f32x4 x0 = *(const f32x4*)(xin + off), x1 = *(const f32x4*)(xin + off + 4);
                    *(f32x4*)(xout + off) = x0 + ga * acc[ai][bj][m][0]; *(f32x4*)(xout + off + 4) = x1 + gb * acc[ai][bj][m][1]; } }
    }
};
struct EpiMoeGU {
    static constexpr bool PERM = true, AFTER_DRAIN = false; unsigned char* ws;
    __device__ __forceinline__ void operator()(const pg8::f32x4 (&acc)[2][2][4][2], const pg8::Unit& u, int wr, int wc, int fr, int fq) const {
        bf16* ACT = (bf16*)(ws + WS_ACT);
        const int row0 = u.pm * 256 + wr * 64 + fr, col0 = (u.pn & 1) * 128 + wc * 32 + 8 * fq;
#pragma unroll
        for (int ai = 0; ai < 2; ++ai)
#pragma unroll
            for (int m = 0; m < 4; ++m) { const f32x4 g0 = acc[ai][0][m][0], g1 = acc[ai][0][m][1], u0 = acc[ai][1][m][0], u1 = acc[ai][1][m][1];
                v4u w; w.x = pk2(siluf_(g0.x) * u0.x, siluf_(g0.y) * u0.y); w.y = pk2(siluf_(g0.z) * u0.z, siluf_(g0.w) * u0.w); w.z = pk2(siluf_(g1.x) * u1.x, siluf_(g1.y) * u1.y); w.w = pk2(siluf_(g1.z) * u1.z, siluf_(g1.w) * u1.w);
                *(v4u*)(ACT + (size_t)(row0 + ai * 128 + m * 16) * 256 + col0) = w; }
    }
};
struct EpiMoeDown {
    static constexpr bool PERM = true, AFTER_DRAIN = false; unsigned char* ws;
    __device__ __forceinline__ void operator()(const pg8::f32x4 (&acc)[2][2][4][2], const pg8::Unit& u, int wr, int wc, int fr, int fq) const {
        bf16* YS = (bf16*)(ws + WS_YS); const int* rowtok = (const int*)(ws + WS_ROWTOK); const float* roww = (const float*)(ws + WS_ROWW);
        const int row0 = u.pm * 256 + wr * 64 + fr, col0 = (u.pn & 3) * 256 + wc * 32 + 8 * fq;
#pragma unroll
        for (int ai = 0; ai < 2; ++ai)
#pragma unroll
            for (int m = 0; m < 4; ++m) { const int row = row0 + ai * 128 + m * 16; const int rt = rowtok[row]; const float wgt = roww[row];
                if (rt >= 0) {
#pragma unroll
                    for (int bj = 0; bj < 2; ++bj) { const f32x4 v0 = acc[ai][bj][m][0] * wgt, v1 = acc[ai][bj][m][1] * wgt;
                        v4u w; w.x = pk2(v0.x, v0.y); w.y = pk2(v0.z, v0.w); w.z = pk2(v1.x, v1.y); w.w = pk2(v1.z, v1.w);
                        *(v4u*)(YS + (size_t)rt * 1024 + col0 + bj * 128) = w; } } }
    }
};
struct MoeOrder {
    const LAS int* tile_exp; int nunits, G, c, sh;
    __device__ __forceinline__ bool next(int i, pg8::Unit& u) const {
        const int L = i * G + c; if (L >= nunits) return false;
        const int r = L >> sh, j = L & ((1 << sh) - 1);
        u.pm = r; u.pn = __builtin_amdgcn_readfirstlane((tile_exp[r] << sh) + j); return true;
    }
    __device__ __forceinline__ void a_ready(const pg8::Unit&) const {}
    __device__ __forceinline__ void done(const pg8::Unit&) const {}
};

__device__ __forceinline__ void ph_router(KArgs a, const Ctx& c, int l) {
    LAS int* lcnt = (LAS int*)(c.lds + MISC_OFF + 1024);
    LAS int* lbase = lcnt + 32;
    LAS int* tinf = lcnt + 64;
    LAS float* wreT = (LAS float*)c.lds;
    const int lane = c.lane;
    bf16* H2 = (bf16*)(a->ws + WS_H); unsigned* tokinfo = (unsigned*)(a->ws + WS_TOKINFO); int* rowtok = (int*)(a->ws + WS_ROWTOK);
    unsigned* gcnt = (unsigned*)(a->ws + WS_CTL) + CW_GCNT + l * 32;
    const float* n2w = a->in[I_N2W] + l * DM; const float* wrg = a->in[I_WRG] + (size_t)l * 1024 * 4; const float* wre = a->in[I_WRE] + (size_t)l * 1024 * 32;
    for (int i = c.bid * NTHR + c.tid; i < MOE_MAXROWS; i += c.G * NTHR) rowtok[i] = -1;
    for (int i = c.tid; i < 8192; i += NTHR) { const int k = i >> 3, n4 = (i & 7) * 4; const f32x4 w = *(const f32x4*)(wre + (size_t)k * 32 + n4);
        wreT[(n4 + 0) * 1024 + k] = w.x; wreT[(n4 + 1) * 1024 + k] = w.y; wreT[(n4 + 2) * 1024 + k] = w.z; wreT[(n4 + 3) * 1024 + k] = w.w; }
    for (int tb = c.bid; tb < NTOK / 64; tb += c.G) {
        __syncthreads();
        if (c.tid < 32) lcnt[c.tid] = 0;
        __syncthreads();
        for (int i = 0; i < 8; ++i) {
            const int tl = c.wave * 8 + i, m = tb * 64 + tl, b = m >> 12;
            const float* xr = (const float*)a->out + (size_t)m * DM; const float* mod = (const float*)(a->ws + WS_MOD) + (l * 4 + b) * 6144;
            f32x4 h[4];
#pragma unroll
            for (int j = 0; j < 4; ++j) h[j] = *(const f32x4*)(xr + 256 * j + 4 * lane);
            const float rstd = row_rstd(h, lane);
            float ag[4] = {0.f, 0.f, 0.f, 0.f};
#pragma unroll
            for (int j = 0; j < 4; ++j) { const int col = 256 * j + 4 * lane;
                const f32x4 nw = *(const f32x4*)(n2w + col), sh = *(const f32x4*)(mod + 3072 + col), sc = *(const f32x4*)(mod + 4096 + col);
                h[j] = h[j] * rstd * nw * (sc + 1.0f) + sh;
                v2u o; o.x = pk2(h[j].x, h[j].y); o.y = pk2(h[j].z, h[j].w); *(v2u*)(H2 + (size_t)m * DM + col) = o;
                const f32x4 r0 = *(const f32x4*)(wrg + (size_t)(col + 0) * 4), r1 = *(const f32x4*)(wrg + (size_t)(col + 1) * 4), r2 = *(const f32x4*)(wrg + (size_t)(col + 2) * 4), r3 = *(const f32x4*)(wrg + (size_t)(col + 3) * 4);
                ag[0] += h[j].x * r0.x + h[j].y * r1.x + h[j].z * r2.x + h[j].w * r3.x; ag[1] += h[j].x * r0.y + h[j].y * r1.y + h[j].z * r2.y + h[j].w * r3.y;
                ag[2] += h[j].x * r0.z + h[j].y * r1.z + h[j].z * r2.z + h[j].w * r3.z; ag[3] += h[j].x * r0.w + h[j].y * r1.w + h[j].z * r2.w + h[j].w * r3.w; }
#pragma unroll
            for (int q = 0; q < 4; ++q) ag[q] = wave_sum(ag[q], lane) + a->in[I_BRG][l * 4 + q];
            int g = 0; float gm = ag[0];
#pragma unroll
            for (int q = 1; q < 4; ++q) if (ag[q] > gm) { gm = ag[q]; g = q; }
            float den = 0.f;
#pragma unroll
            for (int q = 0; q < 4; ++q) den += __expf(ag[q] - gm);
            const float ptop = 1.f / den;
            float ae[8] = {0.f, 0.f, 0.f, 0.f, 0.f, 0.f, 0.f, 0.f};
#pragma unroll
            for (int j = 0; j < 4; ++j) { const int col = 256 * j + 4 * lane;
#pragma unroll
                for (int e = 0; e < 8; ++e) { const f32x4 w = *(const LAS f32x4*)(wreT + (g * 8 + e) * 1024 + col); ae[e] += (h[j].x * w.x + h[j].y * w.y) + (h[j].z * w.z + h[j].w * w.w); } }
#pragma unroll
            for (int q = 0; q < 8; ++q) ae[q] = wave_sum(ae[q], lane) + a->in[I_BRE][l * 32 + g * 8 + q];
            int e0 = 0; float v0 = ae[0];
#pragma unroll
            for (int q = 1; q < 8; ++q) if (ae[q] > v0) { v0 = ae[q]; e0 = q; }
            int e1 = -1; float v1 = -3e38f;
#pragma unroll
            for (int q = 0; q < 8; ++q) if (q != e0 && ae[q] > v1) { v1 = ae[q]; e1 = q; }
            const float ex = __expf(v1 - v0); const float w0 = ptop / (1.f + ex), w1 = ptop * ex / (1.f + ex);
            if (lane == 0) { const int E0 = g * 8 + e0, E1 = g * 8 + e1;
                const int r0 = atomicAdd((int*)(lcnt + E0), 1), r1 = atomicAdd((int*)(lcnt + E1), 1);
                tinf[tl * 6 + 0] = E0; tinf[tl * 6 + 1] = E1; tinf[tl * 6 + 2] = r0; tinf[tl * 6 + 3] = r1; tinf[tl * 6 + 4] = __float_as_int(w0); tinf[tl * 6 + 5] = __float_as_int(w1); }
        }
        __syncthreads();
        if (c.tid < 32) lbase[c.tid] = (int)__hip_atomic_fetch_add(gcnt + c.tid, (unsigned)lcnt[c.tid], RLX_AGENT);
        __syncthreads();
        if (c.tid < 64) { const int m = tb * 64 + c.tid; const int E0 = tinf[c.tid * 6], E1 = tinf[c.tid * 6 + 1];
            v4u o; o.x = (unsigned)E0; o.y = (unsigned)E1; o.z = (unsigned)(lbase[E0] + tinf[c.tid * 6 + 2]); o.w = (unsigned)(lbase[E1] + tinf[c.tid * 6 + 3]);
            *(v4u*)(tokinfo + (size_t)m * 8) = o; *(v2u*)(tokinfo + (size_t)m * 8 + 4) = (v2u){(unsigned)tinf[c.tid * 6 + 4], (unsigned)tinf[c.tid * 6 + 5]}; }
    }
}
__device__ __forceinline__ void moe_table(KArgs a, const Ctx& c, int l) {
    LAS int* tile_exp = (LAS int*)(c.lds + MISC_OFF + 2048); LAS int* offs = tile_exp + 192; LAS int* ntl = offs + 32; LAS int* pre = ntl + 4;
    const unsigned* gcnt = (const unsigned*)(a->ws + WS_CTL) + CW_GCNT + l * 32;
    __syncthreads();
    if (c.tid < 64) { const int e = c.tid & 31; const int cnt = (int)__hip_atomic_load(gcnt + e, RLX_AGENT); const int nt = (cnt + 255) >> 8; int inc = nt;
#pragma unroll
        for (int o = 1; o < 32; o <<= 1) { const int v = shidx_i(inc, (c.lane - o) & 63); if (e >= o) inc += v; }
        if (c.tid < 32) { offs[e] = (inc - nt) * 256; pre[e] = inc; if (e == 31) ntl[0] = inc; } }
    __syncthreads();
    if (c.tid < MOE_MAXTILES) { int E = 0;
#pragma unroll
        for (int e = 0; e < 32; ++e) E += (pre[e] <= c.tid) ? 1 : 0;
        tile_exp[c.tid] = E < 31 ? E : 31; }
    __syncthreads();
}
__device__ __forceinline__ void ph_gather(KArgs a, const Ctx& c, int l) {
    moe_table(a, c, l);
    const LAS int* offs = (const LAS int*)(c.lds + MISC_OFF + 2048) + 192;
    const int gw = c.bid * NW + c.wave, NGW = c.G * NW, lane = c.lane;
    const bf16* H2 = (const bf16*)(a->ws + WS_H); bf16* HS = (bf16*)(a->ws + WS_HS); const unsigned* tokinfo = (const unsigned*)(a->ws + WS_TOKINFO);
    int* rowtok = (int*)(a->ws + WS_ROWTOK); float* roww = (float*)(a->ws + WS_ROWW);
    for (int m = gw; m < NTOK; m += NGW) {
        const v4u ti = *(const v4u*)(tokinfo + (size_t)m * 8); const v2u tw = *(const v2u*)(tokinfo + (size_t)m * 8 + 4);
        const int d0 = offs[ti.x] + (int)ti.z, d1 = offs[ti.y] + (int)ti.w;
        const v4u x0 = *(const v4u*)(H2 + (size_t)m * DM + lane * 8), x1 = *(const v4u*)(H2 + (size_t)m * DM + 512 + lane * 8);
        *(v4u*)(HS + (size_t)d0 * DM + lane * 8) = x0; *(v4u*)(HS + (size_t)d0 * DM + 512 + lane * 8) = x1;
        *(v4u*)(HS + (size_t)d1 * DM + lane * 8) = x0; *(v4u*)(HS + (size_t)d1 * DM + 512 + lane * 8) = x1;
        if (lane == 0) { rowtok[d0] = m * 2; rowtok[d1] = m * 2 + 1; roww[d0] = __uint_as_float(tw.x); roww[d1] = __uint_as_float(tw.y); }
    }
}
constexpr int DN_IMG = 57344, DN_LDW = 132, DN_LDA = 68;
typedef __bf16 bf16x2_t __attribute__((ext_vector_type(2)));
typedef float f32x2_t __attribute__((ext_vector_type(2)));
__device__ __forceinline__ unsigned cvtpk(float lo, float hi) { f32x2_t v = {lo, hi}; bf16x2_t b = __builtin_convertvector(v, bf16x2_t); return __builtin_bit_cast(unsigned, b); }
__device__ __forceinline__ bf16x8 pack8(f32x4 a, f32x4 b) { v4u w; w.x = cvtpk(a.x, a.y); w.y = cvtpk(a.z, a.w); w.z = cvtpk(b.x, b.y); w.w = cvtpk(b.z, b.w); return __builtin_bit_cast(bf16x8, w); }
#define MFMA16(a, b, c) __builtin_amdgcn_mfma_f32_16x16x32_bf16((a), (b), (c), 0, 0, 0)

__device__ __forceinline__ void ph_dn_prep(KArgs a, const Ctx& c, int l) {
    LAS float* qs = (LAS float*)c.lds; LAS float* ks = qs + 64 * DN_LDW; LAS float* vs = ks + 64 * DN_LDW;
    LAS float* Am = vs + 64 * DN_LDW; LAS float* Pm = Am + 64 * DN_LDA;
    LAS float* bt = (LAS float*)(c.lds + MISC_OFF + 1024); LAS float* Gc = bt + 64;
    const float* beta = (const float*)(a->ws + WS_BETA); const float* glog = (const float*)(a->ws + WS_GLOG);
    const int lane = c.lane, row = lane & 15, quad = lane >> 4, tid = c.tid;
    for (int item = c.bid; item < NB * HB * NCH; item += c.G) {
        const int n = item & 63, h = (item >> 6) & 3, b = item >> 8, t0 = n * DNC;
        unsigned char* img = a->ws + WS_IMG + (size_t)item * DN_IMG;
        __syncthreads();
        dn_load_chunk<DN_LDW>(a, c, l, b, h, t0, qs, ks, vs);
        if (tid < 64) { const int tok = b * SEQ + t0 + tid; bt[tid] = beta[tok * 4 + h]; float g = glog[tok * 4 + h];
#pragma unroll
            for (int o = 1; o < 64; o <<= 1) { const float v = shidx(g, (lane - o) & 63); if (lane >= o) g += v; }
            Gc[tid] = g; }
        __syncthreads();
        {   const int sel = c.wave >> 2, ti = c.wave & 3; const LAS float* rs = sel == 0 ? ks : qs; LAS float* dstm = sel == 0 ? Am : Pm;
            bf16x8 af[4];
#pragma unroll
            for (int s = 0; s < 4; ++s) { const LAS float* p = rs + (ti * 16 + row) * DN_LDW + 32 * s + 8 * quad; af[s] = pack8(*(const LAS f32x4*)p, *(const LAS f32x4*)(p + 4)); }
            for (int tj = 0; tj < 4; ++tj) {
                f32x4 acc = {0.f, 0.f, 0.f, 0.f};
                if (tj <= ti) {
#pragma unroll
                    for (int s = 0; s < 4; ++s) { const LAS float* p = ks + (tj * 16 + row) * DN_LDW + 32 * s + 8 * quad; const bf16x8 bfr = pack8(*(const LAS f32x4*)p, *(const LAS f32x4*)(p + 4)); acc = MFMA16(af[s], bfr, acc); }
                }
                const int j = tj * 16 + row; const float Gj = Gc[j];
#pragma unroll
                for (int r = 0; r < 4; ++r) { const int i = ti * 16 + 4 * quad + r; const float dec = __expf(fminf(Gc[i] - Gj, 0.f));
                    float v = acc[r] * dec; if (sel == 0) v = (j < i) ? v * bt[i] : 0.f; else v = (j <= i) ? v : 0.f;
                    if (sel == 0) dstm[j * DN_LDA + i] = v; else dstm[i * DN_LDA + j] = v; }
            }
        }
        __syncthreads();
        const float Glast = Gc[63];
        {
            for (int q = 0; q < 5; ++q) { const int p = tid + 512 * q, blk = p >> 6; float v[8];
                if (blk < 16) { const int mt = blk >> 2, s = blk & 3, cr = 16 * mt + row, k0 = 32 * s + 4 * quad; const float e = __expf(Gc[cr]);
                    const f32x4 v0 = *(const LAS f32x4*)(qs + cr * DN_LDW + k0), v1 = *(const LAS f32x4*)(qs + cr * DN_LDW + k0 + 16);
                    v[0] = v0.x * e; v[1] = v0.y * e; v[2] = v0.z * e; v[3] = v0.w * e; v[4] = v1.x * e; v[5] = v1.y * e; v[6] = v1.z * e; v[7] = v1.w * e; }
                else if (blk < 32) { const int b2 = blk - 16, mt = b2 >> 1, s = b2 & 1, k = 16 * mt + row;
#pragma unroll
                    for (int j = 0; j < 8; ++j) { const int cj = 32 * s + 16 * (j >> 2) + 4 * quad + (j & 3); v[j] = ks[cj * DN_LDW + k] * __expf(Glast - Gc[cj]); } }
                else { const int b3 = blk - 32, mt = b3 >> 1, s = b3 & 1, i = 16 * mt + row, c0 = 32 * s + 4 * quad;
                    const f32x4 v0 = *(const LAS f32x4*)(Pm + i * DN_LDA + c0), v1 = *(const LAS f32x4*)(Pm + i * DN_LDA + c0 + 16);
                    v[0] = v0.x; v[1] = v0.y; v[2] = v0.z; v[3] = v0.w; v[4] = v1.x; v[5] = v1.y; v[6] = v1.z; v[7] = v1.w; }
                v4u w; w.x = cvtpk(v[0], v[1]); w.y = cvtpk(v[2], v[3]); w.z = cvtpk(v[4], v[5]); w.w = cvtpk(v[6], v[7]);
                *(v4u*)(img + 16384 + (size_t)p * 16) = w; }
            if (tid == 0) ((float*)(a->ws + WS_GL))[item] = __expf(Glast);
        }
        __syncthreads();
        if (tid < 256) {
            int vz = 0; asm volatile("" : "+v"(vz));
            const LAS float* AT = Am + vz; const LAS float* btV = bt + vz; const LAS float* GcV = Gc + vz;
            const bool isw = tid >= 128; LAS float* xc = (isw ? ks : vs) + (tid & 127);
#pragma unroll
            for (int bI = 0; bI < 4; ++bI) {
                float s[16];
#pragma unroll
                for (int r = 0; r < 16; ++r) { const int i = 16 * bI + r; float rhs = xc[i * DN_LDW] * btV[i]; if (isw) rhs *= __expf(GcV[i]); s[r] = rhs; }
                for (int j = 0; j < 16 * bI; ++j) { const float xj = xc[j * DN_LDW]; const LAS float* ap = AT + j * DN_LDA + 16 * bI;
#pragma unroll
                    for (int q = 0; q < 4; ++q) { const f32x4 a4 = *(const LAS f32x4*)(ap + 4 * q); s[4 * q] -= a4.x * xj; s[4 * q + 1] -= a4.y * xj; s[4 * q + 2] -= a4.z * xj; s[4 * q + 3] -= a4.w * xj; } }
#pragma unroll
                for (int rp = 0; rp < 15; ++rp) { const LAS float* ap = AT + (16 * bI + rp) * DN_LDA + 16 * bI;
#pragma unroll
                    for (int q = (rp + 1) / 4; q < 4; ++q) { const f32x4 a4 = *(const LAS f32x4*)(ap + 4 * q);
                        if (4 * q + 0 > rp) s[4 * q + 0] -= a4.x * s[rp]; if (4 * q + 1 > rp) s[4 * q + 1] -= a4.y * s[rp]; if (4 * q + 2 > rp) s[4 * q + 2] -= a4.z * s[rp]; if (4 * q + 3 > rp) s[4 * q + 3] -= a4.w * s[rp]; } }
#pragma unroll
                for (int r = 0; r < 16; ++r) xc[(16 * bI + r) * DN_LDW] = s[r];
            }
        }
        __syncthreads();
#pragma unroll
        for (int q = 0; q < 2; ++q) { const int p = tid + 512 * q, blk = p >> 6, mt = blk >> 2, s = blk & 3, cr = 16 * mt + row, k0 = 32 * s + 4 * quad;
            const f32x4 v0 = *(const LAS f32x4*)(ks + cr * DN_LDW + k0), v1 = *(const LAS f32x4*)(ks + cr * DN_LDW + k0 + 16);
            v4u w; w.x = cvtpk(-v0.x, -v0.y); w.y = cvtpk(-v0.z, -v0.w); w.z = cvtpk(-v1.x, -v1.y); w.w = cvtpk(-v1.z, -v1.w);
            *(v4u*)(img + (size_t)p * 16) = w; }
        {   unsigned char* ug = a->ws + WS_U + (size_t)item * 16384;
#pragma unroll
            for (int q = 0; q < 2; ++q) { const int p = tid + 512 * q, sl = p >> 7, ln = (p >> 1) & 63, hh = p & 1, v = 16 * sl + (ln & 15), qd = ln >> 4; float u8[8];
#pragma unroll
                for (int e = 0; e < 8; ++e) u8[e] = vs[(16 * (2 * hh + (e >> 2)) + 4 * qd + (e & 3)) * DN_LDW + v];
                v4u w; w.x = cvtpk(u8[0], u8[1]); w.y = cvtpk(u8[2], u8[3]); w.z = cvtpk(u8[4], u8[5]); w.w = cvtpk(u8[6], u8[7]);
                *(v4u*)(ug + (size_t)(sl * 64 + ln) * 32 + hh * 16) = w; } }
    }
}

constexpr int DN_OS = 2 * DN_IMG;
__device__ __forceinline__ void ph_dn_scan(KArgs a, const Ctx& c, int l) {
    LAS unsigned char* lds = c.lds;
    const int lane = c.lane, wv = c.wave, tid = c.tid; const bool cw = wv < 4;
    const bf16* ZB = (const bf16*)(a->ws + WS_ZB); bf16* YB = (bf16*)(a->ws + WS_YB); const float* onw = a->in[I_ONW] + l * 128; const float* glp = (const float*)(a->ws + WS_GL);
    for (int item = c.bid; item < NB * HB; item += c.G) {
        const int b = item >> 2, h = item & 3;
        const unsigned char* img0 = a->ws + WS_IMG + (size_t)item * 64 * DN_IMG;
        __syncthreads();
        if (cw) {
            const unsigned char* ugb = a->ws + WS_U + (size_t)item * 64 * 16384; const unsigned uoff = (unsigned)(2 * wv * 64 + lane) * 32u;
            f32x4 S[8][2];
#pragma unroll
            for (int m = 0; m < 8; ++m) { S[m][0] = (f32x4){0.f, 0.f, 0.f, 0.f}; S[m][1] = (f32x4){0.f, 0.f, 0.f, 0.f}; }
            v4u uc[4];
#pragma unroll
            for (int q = 0; q < 4; ++q) uc[q] = *(const v4u*)(ugb + uoff + (q >> 1) * 2048 + (q & 1) * 16);
#if MK_PROBE_A == 22 || MK_PROBE_A == 23
            unsigned tpa = 0, tq = (unsigned)__builtin_amdgcn_s_memrealtime();
#define DN_TICK(w) do { const unsigned t_ = (unsigned)__builtin_amdgcn_s_memrealtime(); if ((w) == MK_PROBE_A - 22) tpa += t_ - tq; tq = t_; } while (0)
#else
#define DN_TICK(w) do {} while (0)
#endif
            for (int n = 0; n <= NCH; ++n) {
                asm volatile("s_waitcnt lgkmcnt(0)\n\ts_barrier" ::: "memory");
                DN_TICK(0);
                if (n == NCH) break;
                v4u un[4];
#pragma unroll
                for (int q = 0; q < 4; ++q) un[q] = uc[q];
                if (n + 1 < NCH) {
#pragma unroll
                    for (int q = 0; q < 4; ++q) un[q] = *(const v4u*)(ugb + (size_t)(n + 1) * 16384 + uoff + (q >> 1) * 2048 + (q & 1) * 16); }
                const float gl = glp[item * 64 + n];
                const LAS unsigned char* im = lds + (n & 1) * DN_IMG + lane * 16;
                bf16x8 Sb[4][2];
#pragma unroll
                for (int s = 0; s < 4; ++s) { Sb[s][0] = pack8(S[2 * s][0], S[2 * s + 1][0]); Sb[s][1] = pack8(S[2 * s][1], S[2 * s + 1][1]); }
                f32x4 X[4][2];
#pragma unroll
                for (int nt = 0; nt < 2; ++nt) { const v4u u0 = uc[2 * nt], u1 = uc[2 * nt + 1];
                    X[0][nt] = (f32x4){bflo(u0.x), bfhi(u0.x), bflo(u0.y), bfhi(u0.y)}; X[1][nt] = (f32x4){bflo(u0.z), bfhi(u0.z), bflo(u0.w), bfhi(u0.w)};
                    X[2][nt] = (f32x4){bflo(u1.x), bfhi(u1.x), bflo(u1.y), bfhi(u1.y)}; X[3][nt] = (f32x4){bflo(u1.z), bfhi(u1.z), bflo(u1.w), bfhi(u1.w)}; }
                bf16x8 fa[8], fb[8];
#define DN_LDF(arr, off) do { _Pragma("unroll") for (int q_ = 0; q_ < 8; ++q_) arr[q_] = *(const LAS bf16x8*)(im + (off) + q_ * 1024); } while (0)
                DN_LDF(fa, 0); DN_LDF(fb, 8192);
#pragma unroll
                for (int mt = 0; mt < 2; ++mt)
#pragma unroll
                    for (int s = 0; s < 4; ++s) { X[mt][0] = MFMA16(fa[mt * 4 + s], Sb[s][0], X[mt][0]); X[mt][1] = MFMA16(fa[mt * 4 + s], Sb[s][1], X[mt][1]); }
                DN_LDF(fa, 16384);
#pragma unroll
                for (int mt = 0; mt < 2; ++mt)
#pragma unroll
                    for (int s = 0; s < 4; ++s) { X[2 + mt][0] = MFMA16(fb[mt * 4 + s], Sb[s][0], X[2 + mt][0]); X[2 + mt][1] = MFMA16(fb[mt * 4 + s], Sb[s][1], X[2 + mt][1]); }
                DN_LDF(fb, 16384 + 8192);
                f32x4 O[4][2];
#pragma unroll
                for (int mt = 0; mt < 2; ++mt) { O[mt][0] = (f32x4){0.f, 0.f, 0.f, 0.f}; O[mt][1] = (f32x4){0.f, 0.f, 0.f, 0.f};
#pragma unroll
                    for (int s = 0; s < 4; ++s) { O[mt][0] = MFMA16(fa[mt * 4 + s], Sb[s][0], O[mt][0]); O[mt][1] = MFMA16(fa[mt * 4 + s], Sb[s][1], O[mt][1]); } }
                DN_LDF(fa, 32768);
#pragma unroll
                for (int mt = 0; mt < 2; ++mt) { O[2 + mt][0] = (f32x4){0.f, 0.f, 0.f, 0.f}; O[2 + mt][1] = (f32x4){0.f, 0.f, 0.f, 0.f};
#pragma unroll
                    for (int s = 0; s < 4; ++s) { O[2 + mt][0] = MFMA16(fb[mt * 4 + s], Sb[s][0], O[2 + mt][0]); O[2 + mt][1] = MFMA16(fb[mt * 4 + s], Sb[s][1], O[2 + mt][1]); } }
                DN_LDF(fb, 32768 + 8192);
                bf16x8 Xb[2][2];
#pragma unroll
                for (int nt = 0; nt < 2; ++nt) { Xb[0][nt] = pack8(X[0][nt], X[1][nt]); Xb[1][nt] = pack8(X[2][nt], X[3][nt]); }
#pragma unroll
                for (int m = 0; m < 4; ++m) { S[m][0] = S[m][0] * gl; S[m][1] = S[m][1] * gl;
#pragma unroll
                    for (int s = 0; s < 2; ++s) { S[m][0] = MFMA16(fa[m * 2 + s], Xb[s][0], S[m][0]); S[m][1] = MFMA16(fa[m * 2 + s], Xb[s][1], S[m][1]); } }
                DN_LDF(fa, 49152);
#pragma unroll
                for (int m = 0; m < 4; ++m) { S[4 + m][0] = S[4 + m][0] * gl; S[4 + m][1] = S[4 + m][1] * gl;
#pragma unroll
                    for (int s = 0; s < 2; ++s) { S[4 + m][0] = MFMA16(fb[m * 2 + s], Xb[s][0], S[4 + m][0]); S[4 + m][1] = MFMA16(fb[m * 2 + s], Xb[s][1], S[4 + m][1]); } }
#pragma unroll
                for (int mt = 0; mt < 4; ++mt)
#pragma unroll
                    for (int s = 0; s < 2; ++s) { O[mt][0] = MFMA16(fa[mt * 2 + s], Xb[s][0], O[mt][0]); O[mt][1] = MFMA16(fa[mt * 2 + s], Xb[s][1], O[mt][1]); }
#undef DN_LDF
                LAS unsigned short* os = (LAS unsigned short*)(lds + DN_OS + (n & 1) * 16384);
#pragma unroll
                for (int mt = 0; mt < 4; ++mt)
#pragma unroll
                    for (int nt = 0; nt < 2; ++nt)
#pragma unroll
                        for (int r = 0; r < 4; ++r) os[(16 * mt + 4 * (lane >> 4) + r) * 128 + 32 * wv + 16 * nt + (lane & 15)] = (unsigned short)(cvtpk(O[mt][nt][r], 0.f) & 0xffffu);
#pragma unroll
                for (int q = 0; q < 4; ++q) uc[q] = un[q];
                asm volatile("s_waitcnt lgkmcnt(0)" ::: "memory"); DN_TICK(1);
            }
#if MK_PROBE_A == 22 || MK_PROBE_A == 23
            if (blockIdx.x == 0 && tid == 0) { unsigned long long* tsx = (unsigned long long*)((unsigned*)(a->ws + WS_CTL) + 12288) + 48 + l * 4; tsx[MK_PROBE_A - 22] = tpa; }
#endif
        } else {
            const int ht = tid - 256, hw = wv - 4, nr = ht >> 2, nq = ht & 3;
            const bf16* zpb = ZB + (size_t)(b * SEQ) * 512 + h * 128; bf16* ypb = YB + (size_t)(b * SEQ) * 512 + h * 128; const unsigned zoff = (unsigned)(nr * 512 + nq * 32);
#define DN_DMA(n, buf) do { _Pragma("unroll") for (int q_ = 0; q_ < 14; ++q_) { const int pc_ = hw + 4 * q_; \
                __builtin_amdgcn_global_load_lds((const unsigned*)(img0 + (size_t)(n) * DN_IMG + pc_ * 1024 + lane * 16), (LAS unsigned*)(lds + (buf) * DN_IMG + pc_ * 1024), 16, 0, 0); } } while (0)
            DN_DMA(0, 0);
            v4u zc[4];
#pragma unroll
            for (int q = 0; q < 4; ++q) zc[q] = *(const v4u*)(zpb + zoff + q * 8);
            asm volatile("s_waitcnt vmcnt(0) lgkmcnt(0)\n\ts_barrier" ::: "memory");
            DN_DMA(1, 1);
            for (int n = 1; n <= NCH; ++n) {
                if (n == 1) asm volatile("s_waitcnt vmcnt(0) lgkmcnt(0)\n\ts_barrier" ::: "memory"); else asm volatile("s_waitcnt vmcnt(4) lgkmcnt(0)\n\ts_barrier" ::: "memory");
                v4u zn[4];
#pragma unroll
                for (int q = 0; q < 4; ++q) zn[q] = zc[q];
                if (n < NCH) {
#pragma unroll
                    for (int q = 0; q < 4; ++q) zn[q] = *(const v4u*)(zpb + (size_t)n * DNC * 512 + zoff + q * 8); }
                asm volatile("" ::: "memory");
                if (n + 1 < NCH) DN_DMA(n + 1, (n + 1) & 1);
                asm volatile("" ::: "memory");
                {
                    const LAS unsigned short* os = (const LAS unsigned short*)(lds + DN_OS + ((n - 1) & 1) * 16384) + nr * 128 + nq * 32;
                    float o[32]; float ss = 0.f;
#pragma unroll
                    for (int q = 0; q < 4; ++q) { const v4u w = *(const LAS v4u*)(os + q * 8);
                        o[q * 8 + 0] = bflo(w.x); o[q * 8 + 1] = bfhi(w.x); o[q * 8 + 2] = bflo(w.y); o[q * 8 + 3] = bfhi(w.y); o[q * 8 + 4] = bflo(w.z); o[q * 8 + 5] = bfhi(w.z); o[q * 8 + 6] = bflo(w.w); o[q * 8 + 7] = bfhi(w.w); }
#pragma unroll
                    for (int e = 0; e < 32; ++e) ss += o[e] * o[e];
                    ss += dpp_f<0xB1>(ss); ss += dpp_f<0x4E>(ss);
                    const float rstd = __builtin_amdgcn_rsqf(ss * (1.f / 128.f) + EPS);
                    bf16* yp = ypb + (size_t)(n - 1) * DNC * 512 + zoff;
#pragma unroll
                    for (int q = 0; q < 4; ++q) { const f32x4 w0 = *(const f32x4*)(onw + nq * 32 + q * 8), w1 = *(const f32x4*)(onw + nq * 32 + q * 8 + 4); const v4u z = zc[q];
                        v4u y; y.x = cvtpk(o[q * 8 + 0] * rstd * w0.x * siluf_(bflo(z.x)), o[q * 8 + 1] * rstd * w0.y * siluf_(bfhi(z.x))); y.y = cvtpk(o[q * 8 + 2] * rstd * w0.z * siluf_(bflo(z.y)), o[q * 8 + 3] * rstd * w0.w * siluf_(bfhi(z.y)));
                        y.z = cvtpk(o[q * 8 + 4] * rstd * w1.x * siluf_(bflo(z.z)), o[q * 8 + 5] * rstd * w1.y * siluf_(bfhi(z.z))); y.w = cvtpk(o[q * 8 + 6] * rstd * w1.z * siluf_(bflo(z.w)), o[q * 8 + 7] * rstd * w1.w * siluf_(bfhi(z.w)));
                        *(v4u*)(yp + q * 8) = y; }
                }
#pragma unroll
                for (int q = 0; q < 4; ++q) zc[q] = zn[q];
            }
#undef DN_DMA
        }
        asm volatile("s_waitcnt vmcnt(0)" ::: "memory"); __syncthreads();
    }
}
typedef short v4i16_t __attribute__((ext_vector_type(4)));
#define MFMA32(a, b, c) __builtin_amdgcn_mfma_f32_32x32x16_bf16((a), (b), (c), 0, 0, 0)
constexpr int AT_ROWB = 144;
constexpr int AT_K = 0, AT_V = 2 * 64 * AT_ROWB, AT_OST = 4 * 64 * AT_ROWB, AT_BT = AT_OST + 8 * 32 * AT_ROWB, AT_KM = AT_BT + 1024, AT_UW = AT_KM + 4096;
__device__ __forceinline__ int crow(int r, int hi) { return (r & 3) + 8 * (r >> 2) + 4 * hi; }
__device__ __forceinline__ bf16x8 vtr2(const LAS unsigned char* p) {
    const v4i16_t lo = __builtin_amdgcn_ds_read_tr16_b64_v4i16((LAS v4i16_t*)p), hi = __builtin_amdgcn_ds_read_tr16_b64_v4i16((LAS v4i16_t*)(p + 8 * AT_ROWB));
    return (bf16x8){lo[0], lo[1], lo[2], lo[3], hi[0], hi[1], hi[2], hi[3]};
}
__device__ __forceinline__ void ph_attn(KArgs a, const Ctx& c, int l) {
    LAS unsigned char* lds = c.lds; const int lane = c.lane, wv = c.wave, tid = c.tid, r32 = lane & 31, hi = lane >> 5;
    LAS float* btab = (LAS float*)(lds + AT_BT); LAS float* kms = (LAS float*)(lds + AT_KM); volatile LAS int* uw = (volatile LAS int*)(lds + AT_UW);
    const bf16* QKVA = (const bf16*)(a->ws + WS_QKVA); const float* kmean = (const float*)(a->ws + WS_KMEAN); bf16* YA = (bf16*)(a->ws + WS_YA); const float* relb = a->in[I_RELB];
    unsigned* ctr = (unsigned*)(a->ws + WS_CTL) + CW_ACTR + l * 64;
    const float LOG2E = 1.4426950408889634f, C2 = 0.125f * LOG2E, NINF = -__builtin_inff();
    const int srow = tid >> 3, sch = tid & 7; const unsigned sdst = srow * AT_ROWB + sch * 16;
    for (;;) {
        __syncthreads();
        if (tid == 0) uw[0] = (int)__hip_atomic_fetch_add(ctr, 1u, RLX_AGENT);
        __syncthreads();
        const int u = uw[0];
        if (u >= NB * HA * NBLK) { if (u >= NB * HA * NBLK + CV_NUNITS) break; convert_unit(a, c, l, u - NB * HA * NBLK); continue; }
        const int qb = 15 - (u >> 5), bh = u & 31, b = bh >> 3, h = bh & 7;
        const float c31 = relb[31 * 8 + h];
        for (int i = tid; i < 129; i += NTHR) btab[i] = (i < 128 ? (relb[(int)T5B[i] * 8 + h] - c31) : 0.f) * LOG2E;
        for (int i = tid; i < 1024; i += NTHR) kms[i] = kmean[(size_t)bh * 1024 + i];
        const int qrel = wv * 32 + r32, tokq = b * SEQ + qb * 256 + qrel;
        const bf16* kbase = QKVA + (size_t)(b * SEQ) * 1536 + 512 + h * 64 + sch * 8;
        {   const int key0 = qb * 256; const v4u kr = *(const v4u*)(kbase + (size_t)(key0 + srow) * 1536), vr = *(const v4u*)(kbase + (size_t)(key0 + srow) * 1536 + 512);
            *(LAS v4u*)(lds + AT_K + sdst) = kr; *(LAS v4u*)(lds + AT_V + sdst) = vr; }
        float qf[32];
        {   const bf16* qp = QKVA + (size_t)tokq * 1536 + h * 64 + 8 * hi;
#pragma unroll
            for (int s = 0; s < 4; ++s) { const v4u w = *(const v4u*)(qp + 16 * s); qf[s * 8 + 0] = bflo(w.x); qf[s * 8 + 1] = bfhi(w.x); qf[s * 8 + 2] = bflo(w.y); qf[s * 8 + 3] = bfhi(w.y); qf[s * 8 + 4] = bflo(w.z); qf[s * 8 + 5] = bfhi(w.z); qf[s * 8 + 6] = bflo(w.w); qf[s * 8 + 7] = bfhi(w.w); } }
        __syncthreads();
        unsigned selmask = 0u;
        {   float g[16];
#pragma unroll
            for (int n = 0; n < 16; ++n) { g[n] = -3e38f;
                if (n < qb) { float d = 0.f;
#pragma unroll
                    for (int s = 0; s < 4; ++s) { const f32x4 k0 = *(const LAS f32x4*)(kms + n * 64 + 16 * s + 8 * hi), k1 = *(const LAS f32x4*)(kms + n * 64 + 16 * s + 8 * hi + 4);
                        d += qf[s * 8] * k0.x + qf[s * 8 + 1] * k0.y + qf[s * 8 + 2] * k0.z + qf[s * 8 + 3] * k0.w + qf[s * 8 + 4] * k1.x + qf[s * 8 + 5] * k1.y + qf[s * 8 + 6] * k1.z + qf[s * 8 + 7] * k1.w; }
                    g[n] = d + shx(d, 32, lane); } }
#pragma unroll
            for (int t = 0; t < 3; ++t) { float best = -3.4e38f; int bi = 0;
#pragma unroll
                for (int n = 0; n < 16; ++n) { const bool ok = !((selmask >> n) & 1u) && g[n] > best; best = ok ? g[n] : best; bi = ok ? n : bi; }
                selmask |= 1u << bi; }
            selmask &= (1u << qb) - 1u; }
        bf16x8 qs[4];
#pragma unroll
        for (int s = 0; s < 4; ++s) { v4u w; w.x = cvtpk(qf[s * 8] * C2, qf[s * 8 + 1] * C2); w.y = cvtpk(qf[s * 8 + 2] * C2, qf[s * 8 + 3] * C2); w.z = cvtpk(qf[s * 8 + 4] * C2, qf[s * 8 + 5] * C2); w.w = cvtpk(qf[s * 8 + 6] * C2, qf[s * 8 + 7] * C2); qs[s] = __builtin_bit_cast(bf16x8, w); }
        float m = NINF, lsum = 0.f; f32x16 o0, o1;
#pragma unroll
        for (int r = 0; r < 16; ++r) { o0[r] = 0.f; o1[r] = 0.f; }
        const int NT = 4 * (qb + 1);
        for (int t = 0; t < NT; ++t) {
            const int blk = t < 4 ? qb : ((t - 4) >> 2), kt = t < 4 ? t : ((t - 4) & 3);
            v4u kr = {0u, 0u, 0u, 0u}, vr = {0u, 0u, 0u, 0u};
            if (t + 1 < NT) { const int t1 = t + 1, blk1 = t1 < 4 ? qb : ((t1 - 4) >> 2), kt1 = t1 < 4 ? t1 : ((t1 - 4) & 3); const size_t ro = (size_t)(blk1 * 256 + kt1 * 64 + srow) * 1536;
                kr = *(const v4u*)(kbase + ro); vr = *(const v4u*)(kbase + ro + 512); }
            const bool own = t < 4;
            const bool lane_act = own || ((selmask >> blk) & 1u);
            const bool wave_act = own ? (kt * 64 <= wv * 32 + 31) : (__builtin_amdgcn_ballot_w64(lane_act) != 0ull);
            if (wave_act) {
                const LAS unsigned char* Kb = lds + AT_K + (t & 1) * 64 * AT_ROWB; const LAS unsigned char* Vb = lds + AT_V + (t & 1) * 64 * AT_ROWB;
                f32x16 p0, p1;
#pragma unroll
                for (int r = 0; r < 16; ++r) { p0[r] = 0.f; p1[r] = 0.f; }
#pragma unroll
                for (int s = 0; s < 4; ++s) { const bf16x8 a0 = *(const LAS bf16x8*)(Kb + r32 * AT_ROWB + 32 * s + 16 * hi), a1 = *(const LAS bf16x8*)(Kb + (32 + r32) * AT_ROWB + 32 * s + 16 * hi);
                    p0 = MFMA32(a0, qs[s], p0); p1 = MFMA32(a1, qs[s], p1); }
                if (own) {
#pragma unroll
                    for (int r = 0; r < 16; ++r) { const int d0 = qrel - (kt * 64 + crow(r, hi)), d1 = d0 - 32;
                        p0[r] = d0 >= 0 ? p0[r] + btab[d0 > 128 ? 128 : d0] : NINF; p1[r] = d1 >= 0 ? p1[r] + btab[d1 > 128 ? 128 : d1] : NINF; }
                } else if (blk == qb - 1 && kt >= 1) {
#pragma unroll
                    for (int r = 0; r < 16; ++r) { const int d0 = qrel + 256 - (kt * 64 + crow(r, hi)), d1 = d0 - 32;
                        p0[r] += btab[d0 > 128 ? 128 : d0]; p1[r] += btab[d1 > 128 ? 128 : d1]; }
                }
                float mx = fmaxf(p0[0], p1[0]);
#pragma unroll
                for (int r = 1; r < 16; ++r) mx = fmaxf(mx, fmaxf(p0[r], p1[r]));
                mx = fmaxf(mx, shx(mx, 32, lane));
                const float tmax = lane_act ? mx : NINF, mnew = fmaxf(m, tmax), alpha = __builtin_amdgcn_exp2f(m - mnew), muse = lane_act ? mnew : __builtin_inff();
                float rs = 0.f;
#pragma unroll
                for (int r = 0; r < 16; ++r) { p0[r] = __builtin_amdgcn_exp2f(p0[r] - muse); p1[r] = __builtin_amdgcn_exp2f(p1[r] - muse); rs += p0[r] + p1[r]; }
                lsum = lsum * alpha + rs; m = mnew;
                if (__builtin_amdgcn_ballot_w64(alpha != 1.f) != 0ull) {
#pragma unroll
                    for (int r = 0; r < 16; ++r) { o0[r] *= alpha; o1[r] *= alpha; } }
                bf16x8 pa[4];
                { v4u w; w.x = cvtpk(p0[0], p0[1]); w.y = cvtpk(p0[2], p0[3]); w.z = cvtpk(p0[4], p0[5]); w.w = cvtpk(p0[6], p0[7]); pa[0] = __builtin_bit_cast(bf16x8, w);
                  w.x = cvtpk(p0[8], p0[9]); w.y = cvtpk(p0[10], p0[11]); w.z = cvtpk(p0[12], p0[13]); w.w = cvtpk(p0[14], p0[15]); pa[1] = __builtin_bit_cast(bf16x8, w);
                  w.x = cvtpk(p1[0], p1[1]); w.y = cvtpk(p1[2], p1[3]); w.z = cvtpk(p1[4], p1[5]); w.w = cvtpk(p1[6], p1[7]); pa[2] = __builtin_bit_cast(bf16x8, w);
                  w.x = cvtpk(p1[8], p1[9]); w.y = cvtpk(p1[10], p1[11]); w.z = cvtpk(p1[12], p1[13]); w.w = cvtpk(p1[14], p1[15]); pa[3] = __builtin_bit_cast(bf16x8, w); }
                const LAS unsigned char* vp = Vb + (4 * hi + ((lane & 15) >> 2)) * AT_ROWB + 2 * (16 * ((lane >> 4) & 1) + 4 * (lane & 3));
#pragma unroll
                for (int ks = 0; ks < 4; ++ks) { const bf16x8 v0 = vtr2(vp + 16 * ks * AT_ROWB), v1 = vtr2(vp + 16 * ks * AT_ROWB + 64);
                    o0 = MFMA32(v0, pa[ks], o0); o1 = MFMA32(v1, pa[ks], o1); }
            }
            if (t + 1 < NT) { *(LAS v4u*)(lds + AT_K + ((t + 1) & 1) * 64 * AT_ROWB + sdst) = kr; *(LAS v4u*)(lds + AT_V + ((t + 1) & 1) * 64 * AT_ROWB + sdst) = vr; }
            __syncthreads();
        }
        lsum += shx(lsum, 32, lane);
        const float inv = 1.f / lsum;
        LAS unsigned short* stg = (LAS unsigned short*)(lds + AT_OST + wv * 32 * AT_ROWB);
#pragma unroll
        for (int r = 0; r < 16; ++r) { stg[r32 * (AT_ROWB / 2) + crow(r, hi)] = (unsigned short)(cvtpk(o0[r] * inv, 0.f) & 0xffffu); stg[r32 * (AT_ROWB / 2) + 32 + crow(r, hi)] = (unsigned short)(cvtpk(o1[r] * inv, 0.f) & 0xffffu); }
        LDS_WAIT();
#pragma unroll
        for (int i = 0; i < 4; ++i) { const int row = i * 8 + (lane >> 3), ch = lane & 7; const v4u v = *(const LAS v4u*)((const LAS unsigned char*)stg + row * AT_ROWB + ch * 16);
            *(v4u*)(YA + (size_t)(b * SEQ + qb * 256 + wv * 32 + row) * 512 + h * 64 + ch * 8) = v; }
    }
}
constexpr int NPH_LAYER = 11, NPHASES = 2 + NLAYER * NPH_LAYER;
#ifndef DN_IMPL
#define DN_IMPL 1
#endif
#ifndef PH_MASK
#define PH_MASK 0xFFFF
#endif
#define PH_EN(k) ((PH_MASK >> (k)) & 1)
#define GEMM_PHASE(EPI, SCHED, g, S, E) pg8::gemm_phase<EPI, SCHED, true, true>(c.lds, g, S, E, c.tid)

#define PHASE_FN static __device__ __forceinline__ void
__device__ __forceinline__ KArgs launder_k(KArgs a) { unsigned long long v = (unsigned long long)a; asm volatile("" : "+s"(v)); return (KArgs)v; }
PHASE_FN f_mod(KArgs a, int& tid) { a = launder_k(a); Ctx c = make_ctx(tid); ph_mod(a, c); }
PHASE_FN f_norm1(KArgs a, int& tid, int l) { a = launder_k(a); Ctx c = make_ctx(tid); ph_norm1(a, c, l); __syncthreads(); ph_convert(a, c, l); }
PHASE_FN f_proj(KArgs a, int& tid) { a = launder_k(a); Ctx c = make_ctx(tid);
    pg8::Gemm g{(const bf16*)(a->ws + WS_H), (const bf16*)(a->ws + WS_WIN), NTOK, DINP, DM}; pg8::StaticOrder S; S.init(NTOK, DINP, c.G, c.bid);
    EpiProj E{a->ws}; GEMM_PHASE(EpiProj, pg8::StaticOrder, g, S, E); }
PHASE_FN f_kmean(KArgs a, int& tid) { a = launder_k(a); Ctx c = make_ctx(tid); ph_kmean(a, c); }
#ifndef ATTN_IMPL
#define ATTN_IMPL 1
#endif
#if ATTN_IMPL
PHASE_FN f_attn(KArgs a, int& tid, int l) { a = launder_k(a); Ctx c = make_ctx(tid); ph_attn(a, c, l); }
#else
PHASE_FN f_attn(KArgs a, int& tid, int l) { a = launder_k(a); Ctx c = make_ctx(tid); ph_attn_simple(a, c); }
#endif
PHASE_FN f_dn(KArgs a, int& tid, int l) { a = launder_k(a); Ctx c = make_ctx(tid); ph_dn_simple(a, c, l); }
PHASE_FN f_dn_prep(KArgs a, int& tid, int l) { a = launder_k(a); Ctx c = make_ctx(tid); ph_dn_prep(a, c, l); }
PHASE_FN f_dn_scan(KArgs a, int& tid, int l) { a = launder_k(a); Ctx c = make_ctx(tid); ph_dn_scan(a, c, l); }
PHASE_FN f_merge1(KArgs a, int& tid) { a = launder_k(a); Ctx c = make_ctx(tid);
    pg8::Gemm g{(const bf16*)(a->ws + WS_YA), (const bf16*)(a->ws + WS_WUPA), NTOK, DM, WA}; pg8::StaticOrder S; S.init(NTOK, DM, c.G, c.bid);
    EpiMerge<false> E{a->ws}; GEMM_PHASE(EpiMerge<false>, pg8::StaticOrder, g, S, E); }
PHASE_FN f_merge2(KArgs a, int& tid) { a = launder_k(a); Ctx c = make_ctx(tid);
    pg8::Gemm g{(const bf16*)(a->ws + WS_YB), (const bf16*)(a->ws + WS_WUPB), NTOK, DM, WB}; pg8::StaticOrder S; S.init(NTOK, DM, c.G, c.bid);
    EpiMerge<true> E{a->ws}; GEMM_PHASE(EpiMerge<true>, pg8::StaticOrder, g, S, E); }
PHASE_FN f_out(KArgs a, int& tid, int l) { a = launder_k(a); Ctx c = make_ctx(tid);
    pg8::Gemm g{(const bf16*)(a->ws + WS_M), (const bf16*)(a->ws + WS_WOUT), NTOK, DM, DM}; pg8::StaticOrder S; S.init(NTOK, DM, c.G, c.bid);
    EpiOut E{l == 0 ? a->in[I_X] : (const float*)a->out, a->out, (const float*)(a->ws + WS_MOD) + l * 4 * 6144 + 2048}; GEMM_PHASE(EpiOut, pg8::StaticOrder, g, S, E); }
PHASE_FN f_router(KArgs a, int& tid, int l) { a = launder_k(a); Ctx c = make_ctx(tid); ph_router(a, c, l); }
PHASE_FN f_gather(KArgs a, int& tid, int l) { a = launder_k(a); Ctx c = make_ctx(tid); ph_gather(a, c, l); }
PHASE_FN f_moe_gu(KArgs a, int& tid, int l) { a = launder_k(a); Ctx c = make_ctx(tid);
    moe_table(a, c, l); const LAS int* te = (const LAS int*)(c.lds + MISC_OFF + 2048);
    pg8::Gemm g{(const bf16*)(a->ws + WS_HS), (const bf16*)(a->ws + WS_WEGU), MOE_MAXROWS, NEXP * 512, DM}; MoeOrder S{te, te[192 + 32] * 2, c.G, c.bid, 1};
    EpiMoeGU E{a->ws}; GEMM_PHASE(EpiMoeGU, MoeOrder, g, S, E); }
PHASE_FN f_moe_down(KArgs a, int& tid, int l) { a = launder_k(a); Ctx c = make_ctx(tid);
    moe_table(a, c, l); const LAS int* te = (const LAS int*)(c.lds + MISC_OFF + 2048);
    pg8::Gemm g{(const bf16*)(a->ws + WS_ACT), (const bf16*)(a->ws + WS_WED), MOE_MAXROWS, NEXP * 1024, DFF}; MoeOrder S{te, te[192 + 32] * 4, c.G, c.bid, 2};
    EpiMoeDown E{a->ws}; GEMM_PHASE(EpiMoeDown, MoeOrder, g, S, E); }
PHASE_FN f_final(KArgs a, int& tid) { a = launder_k(a); Ctx c = make_ctx(tid); ph_final(a, c); }

#define KA() launder_k((KArgs)__builtin_amdgcn_kernarg_segment_ptr())
__device__ __forceinline__ bool ph_in(int k) { KArgs a = KA(); return a->ph_lo <= k && k < a->ph_hi; }
#ifndef MK_PROBE_A
#define MK_PROBE_A -1
#endif
#ifndef MK_PROBE_B
#define MK_PROBE_B -1
#endif
constexpr int CW_TS = 12288;
__device__ __forceinline__ void grid_bar(int& tid, int k) {
    asm volatile("" : "+v"(tid));
#if MK_ONE_LAUNCH
    KArgs a = KA(); XcdBarrier b; b.bar = (unsigned*)(a->ws + WS_CTL) + CW_BAR; b.x = xb_xcc_id(); b.st = (volatile LAS unsigned*)((LAS unsigned char*)lds_raw + MISC_OFF) + 8;
    xcd_barrier(b, tid);
    if (MK_PROBE_A >= 0 && blockIdx.x == 0 && tid == 0) ((unsigned long long*)((unsigned*)(a->ws + WS_CTL) + CW_TS))[k + 1] = __builtin_amdgcn_s_memrealtime();
#else
    __syncthreads();
#endif
}
__global__ void __launch_bounds__(NTHR, 2) mk_fwd(Args a_) {
    int tid = threadIdx.x;
    {   volatile LAS unsigned* MISC = (volatile LAS unsigned*)((LAS unsigned char*)lds_raw + MISC_OFF);
        if (tid < 64) MISC[tid] = 0u;
        __syncthreads();
#if MK_ONE_LAUNCH
        (void)xcd_barrier_post((unsigned*)(KA()->ws + WS_CTL) + CW_BAR, MISC + 8, tid);
#endif
        if (MK_PROBE_A >= 0 && blockIdx.x == 0 && tid == 0) ((unsigned long long*)((unsigned*)(KA()->ws + WS_CTL) + CW_TS))[0] = __builtin_amdgcn_s_memrealtime();
    }
#define IN(k) ph_in(k)
#define SEAM(k) do { if (IN(k) && IN((k) + 1)) grid_bar(tid, (k)); } while (0)
    if (IN(0)) f_mod(KA(), tid); SEAM(0);
    for (int l = 0; l < NLAYER; ++l) {
        const int pb = 1 + l * NPH_LAYER;
        if (PH_EN(0) && IN(pb + 0)) f_norm1(KA(), tid, l); SEAM(pb + 0);
        if (PH_EN(1) && IN(pb + 1)) f_proj(KA(), tid); SEAM(pb + 1);
#if DN_IMPL
        if (PH_EN(2) && IN(pb + 2)) { f_kmean(KA(), tid); f_dn_prep(KA(), tid, l); } SEAM(pb + 2);
        if (PH_EN(3) && IN(pb + 3)) { f_dn_scan(KA(), tid, l);
            if (MK_PROBE_A >= 0 && blockIdx.x == 0 && tid == 0) ((unsigned long long*)((unsigned*)(KA()->ws + WS_CTL) + CW_TS))[40 + l] = __builtin_amdgcn_s_memrealtime();
            __syncthreads(); f_attn(KA(), tid, l);
            if (MK_PROBE_A >= 0 && blockIdx.x == 255 && tid == 0) ((unsigned long long*)((unsigned*)(KA()->ws + WS_CTL) + CW_TS))[44 + l] = __builtin_amdgcn_s_memrealtime(); } SEAM(pb + 3);
#else
        if (PH_EN(2) && IN(pb + 2)) f_kmean(KA(), tid); SEAM(pb + 2);
        if (PH_EN(3) && IN(pb + 3)) { f_attn(KA(), tid, l); __syncthreads(); f_dn(KA(), tid, l); } SEAM(pb + 3);
#endif
        if (PH_EN(4) && IN(pb + 4)) f_merge1(KA(), tid); SEAM(pb + 4);
        if (PH_EN(5) && IN(pb + 5)) f_merge2(KA(), tid); SEAM(pb + 5);
        if (PH_EN(6) && IN(pb + 6)) f_out(KA(), tid, l); SEAM(pb + 6);
        if (PH_EN(7) && IN(pb + 7)) f_router(KA(), tid, l); SEAM(pb + 7);
        if (PH_EN(8) && IN(pb + 8)) f_gather(KA(), tid, l); SEAM(pb + 8);
        if (PH_EN(9) && IN(pb + 9)) f_moe_gu(KA(), tid, l); SEAM(pb + 9);
        if (PH_EN(10) && IN(pb + 10)) f_moe_down(KA(), tid, l); SEAM(pb + 10);
    }
    if (IN(NPHASES - 1)) f_final(KA(), tid);
#undef IN
#undef SEAM
}

extern "C" void kernel_launch(void* const* d_in, const int* in_sizes, int n_in, void* d_out, int out_size, void* d_ws, size_t ws_size, hipStream_t stream) {
    static int grid = 0;
    if (grid == 0) {
        if (n_in != 23 || out_size != NTOK * DM || ws_size < WS_END) { fprintf(stderr, "kernel_launch: unexpected shapes (n_in %d out %d ws %zu)\n", n_in, out_size, ws_size); grid = -1; return; }
        int dev = 0, cus = 0, per_cu = 0;
        if (hipGetDevice(&dev) != hipSuccess || hipDeviceGetAttribute(&cus, hipDeviceAttributeMultiprocessorCount, dev) != hipSuccess) { grid = -1; return; }
        if (hipFuncSetAttribute((const void*)mk_fwd, hipFuncAttributeMaxDynamicSharedMemorySize, LDS_BYTES) != hipSuccess) { fprintf(stderr, "kernel_launch: hipFuncSetAttribute failed\n"); grid = -1; return; }
        if (hipOccupancyMaxActiveBlocksPerMultiprocessor(&per_cu, (const void*)mk_fwd, NTHR, LDS_BYTES) != hipSuccess || per_cu < 1) { fprintf(stderr, "kernel_launch: occupancy query says %d\n", per_cu); (void)hipGetLastError(); grid = -1; return; }
        grid = cus;
    }
    if (grid < 0) return;
    (void)hipMemsetAsync((char*)d_ws + WS_CTL, 0, CTL_ZERO_BYTES, stream);
    Args a{};
    for (int i = 0; i < 23; ++i) a.in[i] = (const float*)d_in[i];
    a.out = (float*)d_out; a.ws = (unsigned char*)d_ws;
#if MK_ONE_LAUNCH
    a.ph_lo = 0; a.ph_hi = NPHASES;
    hipLaunchKernelGGL(mk_fwd, dim3(grid), dim3(NTHR), LDS_BYTES, stream, a);
#else
    for (int p = 0; p < NPHASES; ++p) { a.ph_lo = p; a.ph_hi = p + 1; hipLaunchKernelGGL(mk_fwd, dim3(grid), dim3(NTHR), LDS_BYTES, stream, a); }
#endif
}
```

```cpp
#include <hip/hip_runtime.h>
#include <cstdio>
#include <cstdint>
#ifndef MK_ONE_LAUNCH
#define MK_ONE_LAUNCH 1
#endif
#ifndef MK_PROBE_A
#define MK_PROBE_A -1
#endif
#ifndef MK_PROBE_B
#define MK_PROBE_B -1
#endif
namespace pg8 {
#define PG8_LAS __attribute__((address_space(3)))
typedef unsigned short bf16_t;
typedef short bf16x8 __attribute__((ext_vector_type(8)));
typedef float f32x4 __attribute__((ext_vector_type(4)));
typedef unsigned u32x4 __attribute__((ext_vector_type(4)));
constexpr int BM = 256, BK = 64, HALF = 128, HTB = HALF * BK * 2  , STAGE_BYTES = 8 * HTB, NXCD = 8, WGM = 8;

__host__ __device__ __forceinline__ int lds_byte(int r, int c) { const int st = (r >> 4) * 2 + (c >> 5), rr = r & 15, cc = c & 31, ob = rr * 64 + cc * 2; return st * 1024 + (ob ^ (((ob >> 9) & 1) << 5)); }
__host__ __device__ __forceinline__ void stage_rc(int b, int& R, int& C) { const int st = b / 1024, sb = b % 1024, swz = sb ^ (((sb >> 9) & 1) << 5); R = (st >> 1) * 16 + swz / 64; C = (st & 1) * 32 + (swz % 64) / 2; }
__host__ __device__ __forceinline__ int perm32(int rho) { const int n = rho >> 4, i = rho & 15; return 8 * (i >> 2) + 4 * n + (i & 3); }

struct Unit { int pm, pn; };
struct Gemm { const bf16_t* A; const bf16_t* Bt; int M, N, K; };

struct StaticOrder {
    int nM, nN, nwg, G, c;
    __host__ __device__ void init(int M, int N, int G_, int c_) { nM = M / BM; nN = N / BM; nwg = nM * nN; G = G_; c = c_; }
    __host__ __device__ bool next(int i, Unit& u) const {
        const long L = (long)i * G + c; if (L >= nwg) return false;
        int wgid = (int)L; { const int q = nwg / NXCD, r = nwg % NXCD, xcd = wgid % NXCD, off = wgid / NXCD; wgid = (xcd < r ? xcd * (q + 1) : r * (q + 1) + (xcd - r) * q) + off; }
        const int nig = WGM * nN, gid = wgid / nig, fm = gid * WGM, gsz = (nM - fm) < WGM ? (nM - fm) : WGM;
        u.pm = fm + ((wgid % nig) % gsz); u.pn = (wgid % nig) / gsz; return true;
    }
    __device__ __forceinline__ void a_ready(const Unit&) const {}
    __device__ __forceinline__ void done(const Unit&) const {}
};

__device__ __forceinline__ unsigned cvt_pk_bf16(float lo, float hi) { unsigned r; asm volatile("v_cvt_pk_bf16_f32 %0, %1, %2" : "=v"(r) : "v"(lo), "v"(hi)); return r; }
typedef float f32x2 __attribute__((ext_vector_type(2)));
template <class Epi, class Sched, bool ALIGN_EPI = false, bool SP2 = false>
__device__ __forceinline__ void gemm_phase(PG8_LAS unsigned char* lds, const Gemm g, const Sched& S, const Epi& E, const int tid_in) {
    const int tid = tid_in, wid = __builtin_amdgcn_readfirstlane(tid >> 6), lane = tid & 63, wr = wid >> 2, wc = wid & 3, fr = lane & 15, fq = lane >> 4;
    const int K = g.K, nt = K / BK;
    unsigned voffA[2], voffB[2];
#pragma unroll
    for (int i = 0; i < 2; ++i) { int R, C; stage_rc(tid * 16 + i * 8192, R, C); const int Rb = Epi::PERM ? ((R & ~31) + perm32(R & 31)) : R;
        voffA[i] = (unsigned)(R * K + C) * 2u; voffB[i] = (unsigned)(Rb * K + C) * 2u; }
    const size_t kstep = (size_t)(BK * 2);
    const size_t hstep = (size_t)HALF * K * 2;
    const size_t tstep = 2 * hstep;
    const unsigned ldsw = (unsigned)wid * 1024u;
    const int aoff = lds_byte(wr * 64 + fr, fq * 8), boff = lds_byte(wc * 32 + fr, fq * 8);
#define PG8_SA(b, h) (((b) * 2 + (h)) * HTB)
#define PG8_SB(b, h) ((4 + (b) * 2 + (h)) * HTB)
#define PG8_STAGE(bufoff, gbase, voff) do { _Pragma("unroll") for (int _i = 0; _i < 2; ++_i) \
        __builtin_amdgcn_global_load_lds((const unsigned*)((const char*)(gbase) + (voff)[_i]), (PG8_LAS unsigned*)(lds + (bufoff) + ldsw + _i * 8192), 16, 0, 0); } while (0)
#define PG8_LDA(dst, b, h) do { _Pragma("unroll") for (int m = 0; m < 4; ++m) _Pragma("unroll") for (int k = 0; k < 2; ++k) dst[m][k] = *(const PG8_LAS bf16x8*)(lds + PG8_SA(b, h) + aoff + m * 2048 + k * 1024); } while (0)
#define PG8_LDB(dst, b, h) do { _Pragma("unroll") for (int n = 0; n < 2; ++n) _Pragma("unroll") for (int k = 0; k < 2; ++k) dst[n][k] = *(const PG8_LAS bf16x8*)(lds + PG8_SB(b, h) + boff + n * 2048 + k * 1024); } while (0)
#define PG8_MMA(ai, bj, At, Bt) do { __builtin_amdgcn_s_setprio(1); _Pragma("unroll") for (int m = 0; m < 4; ++m) _Pragma("unroll") for (int n = 0; n < 2; ++n) _Pragma("unroll") for (int k = 0; k < 2; ++k) \
        acc[ai][bj][m][n] = __builtin_amdgcn_mfma_f32_16x16x32_bf16(Bt[n][k], At[m][k], acc[ai][bj][m][n], 0, 0, 0); __builtin_amdgcn_s_setprio(0); } while (0)
#define PG8_WAIT_V(n) asm volatile("s_waitcnt vmcnt(" #n ")" ::: "memory")
#define PG8_WAIT_L(n) asm volatile("s_waitcnt lgkmcnt(" #n ")" ::: "memory")
#define PG8_BAR __builtin_amdgcn_s_barrier()
#define PG8_SCHED __builtin_amdgcn_sched_barrier(0)
    Unit cur, nxt; int ui = 0;
    if (!S.next(0, cur)) return;
    f32x4 acc[2][2][4][2];
    float zf_ = 0.f; asm volatile("" : "+v"(zf_));
#pragma unroll
    for (int a = 0; a < 2; ++a)
#pragma unroll
        for (int b = 0; b < 2; ++b)
#pragma unroll
            for (int m = 0; m < 4; ++m)
#pragma unroll
                for (int n = 0; n < 2; ++n) acc[a][b][m][n] = (f32x4){zf_, zf_, zf_, zf_};
    bf16x8 At[4][2], B0[2][2], B1[2][2];
    const char* cA = (const char*)g.A + (size_t)cur.pm * tstep; const char* cB = (const char*)g.Bt + (size_t)cur.pn * tstep;
    S.a_ready(cur);
    if constexpr (SP2) {
        PG8_STAGE(PG8_SB(0, 0), cB, voffB); PG8_STAGE(PG8_SB(0, 1), cB + hstep, voffB); PG8_STAGE(PG8_SA(0, 0), cA, voffA); PG8_STAGE(PG8_SA(0, 1), cA + hstep, voffA);
        if (wr == 1) PG8_BAR;
        PG8_WAIT_V(2); PG8_BAR;
        PG8_STAGE(PG8_SB(1, 0), cB + kstep, voffB); PG8_STAGE(PG8_SA(1, 0), cA + kstep, voffA); PG8_STAGE(PG8_SB(1, 1), cB + hstep + kstep, voffB);
        PG8_WAIT_V(6); PG8_BAR;
    } else {
        PG8_STAGE(PG8_SB(0, 0), cB, voffB); PG8_STAGE(PG8_SA(0, 0), cA, voffA); PG8_STAGE(PG8_SB(0, 1), cB + hstep, voffB); PG8_STAGE(PG8_SA(0, 1), cA + hstep, voffA);
        if (wr == 1) PG8_BAR;
        PG8_WAIT_V(4); PG8_BAR;
        PG8_STAGE(PG8_SB(1, 0), cB + kstep, voffB); PG8_STAGE(PG8_SA(1, 0), cA + kstep, voffA); PG8_STAGE(PG8_SB(1, 1), cB + hstep + kstep, voffB);
        PG8_WAIT_V(6); PG8_BAR;
    }
    for (;;) {
        const bool has_next = S.next(ui + 1, nxt);
        const char* nA = has_next ? (const char*)g.A + (size_t)nxt.pm * tstep : cA; const char* nB = has_next ? (const char*)g.Bt + (size_t)nxt.pn * tstep : cB;
        for (int t = 0; t < nt; t += 2) {
            const bool last = (t == nt - 2);
            const char* a1 = cA + (size_t)(t + 1) * kstep;
            const char* a2 = last ? nA : cA + (size_t)(t + 2) * kstep; const char* b2 = last ? nB : cB + (size_t)(t + 2) * kstep;
            const char* a3 = a2 + kstep; const char* b3 = b2 + kstep;
            if (last && has_next) S.a_ready(nxt);
            if constexpr (SP2) {
            PG8_LDB(B0, 0, 0); PG8_LDB(B1, 0, 1); PG8_SCHED; PG8_LDA(At, 0, 0); PG8_STAGE(PG8_SA(1, 1), a1 + hstep, voffA);
            PG8_WAIT_V(8); PG8_WAIT_L(0); PG8_BAR; PG8_MMA(0, 0, At, B0); PG8_MMA(0, 1, At, B1); PG8_BAR; PG8_SCHED;
            PG8_LDA(At, 0, 1); PG8_STAGE(PG8_SB(0, 0), b2, voffB); PG8_STAGE(PG8_SB(0, 1), b2 + hstep, voffB); PG8_STAGE(PG8_SA(0, 0), a2, voffA);
            PG8_WAIT_V(8); PG8_WAIT_L(0); PG8_BAR; PG8_MMA(1, 0, At, B0); PG8_MMA(1, 1, At, B1); PG8_BAR; PG8_SCHED;
            PG8_LDB(B0, 1, 0); PG8_LDB(B1, 1, 1); PG8_SCHED; PG8_LDA(At, 1, 0); PG8_STAGE(PG8_SA(0, 1), a2 + hstep, voffA);
            PG8_WAIT_V(8); PG8_WAIT_L(0); PG8_BAR; PG8_MMA(0, 0, At, B0); PG8_MMA(0, 1, At, B1); PG8_BAR; PG8_SCHED;
            PG8_LDA(At, 1, 1); PG8_STAGE(PG8_SB(1, 0), b3, voffB); PG8_STAGE(PG8_SB(1, 1), b3 + hstep, voffB); PG8_STAGE(PG8_SA(1, 0), a3, voffA);
            PG8_WAIT_V(8); PG8_WAIT_L(0); PG8_BAR; PG8_MMA(1, 0, At, B0); PG8_MMA(1, 1, At, B1); PG8_BAR; PG8_SCHED;
            } else {
            PG8_LDB(B0, 0, 0); PG8_SCHED; PG8_LDA(At, 0, 0); PG8_STAGE(PG8_SA(1, 1), a1 + hstep, voffA);
            PG8_WAIT_L(8); PG8_BAR; PG8_WAIT_L(0); PG8_MMA(0, 0, At, B0); PG8_BAR; PG8_SCHED;
            PG8_LDB(B1, 0, 1); PG8_STAGE(PG8_SB(0, 0), b2, voffB);
            PG8_BAR; PG8_WAIT_L(0); PG8_MMA(0, 1, At, B1); PG8_BAR;
            PG8_LDA(At, 0, 1); PG8_STAGE(PG8_SA(0, 0), a2, voffA);
            PG8_BAR; PG8_WAIT_L(0); PG8_MMA(1, 0, At, B0); PG8_BAR; PG8_SCHED;
            PG8_STAGE(PG8_SB(0, 1), b2 + hstep, voffB);
            PG8_WAIT_V(6); PG8_BAR; PG8_MMA(1, 1, At, B1); PG8_BAR;
            PG8_LDB(B0, 1, 0); PG8_SCHED; PG8_LDA(At, 1, 0); PG8_STAGE(PG8_SA(0, 1), a2 + hstep, voffA);
            PG8_WAIT_L(8); PG8_BAR; PG8_WAIT_L(0); PG8_MMA(0, 0, At, B0); PG8_BAR; PG8_SCHED;
            PG8_LDB(B1, 1, 1); PG8_STAGE(PG8_SB(1, 0), b3, voffB);
            PG8_BAR; PG8_WAIT_L(0); PG8_MMA(0, 1, At, B1); PG8_BAR;
            PG8_LDA(At, 1, 1); PG8_STAGE(PG8_SA(1, 0), a3, voffA);
            PG8_BAR; PG8_WAIT_L(0); PG8_MMA(1, 0, At, B0); PG8_BAR; PG8_SCHED;
            PG8_STAGE(PG8_SB(1, 1), b3 + hstep, voffB);
            PG8_WAIT_V(6); PG8_BAR; PG8_MMA(1, 1, At, B1); PG8_BAR;
            }
        }
        if constexpr (ALIGN_EPI) { if (wr == 0) PG8_BAR; }
        if constexpr (!Epi::AFTER_DRAIN) { int te_ = tid_in; asm volatile("" : "+v"(te_)); E(acc, cur, wr, wc, te_ & 15, (te_ & 63) >> 4); S.done(cur); }
        if (!has_next) break;
        zf_ = 0.f; asm volatile("" : "+v"(zf_));
#pragma unroll
        for (int a = 0; a < 2; ++a)
#pragma unroll
            for (int b = 0; b < 2; ++b)
#pragma unroll
                for (int m = 0; m < 4; ++m)
#pragma unroll
                    for (int n = 0; n < 2; ++n) acc[a][b][m][n] = (f32x4){zf_, zf_, zf_, zf_};
        cur = nxt; cA = nA; cB = nB; ++ui;
        if constexpr (ALIGN_EPI) { if (wr == 1) PG8_BAR; }
    }
    PG8_WAIT_V(0);
    if constexpr (!ALIGN_EPI) { if (wr == 0) PG8_BAR; }
    PG8_BAR;
    if constexpr (Epi::AFTER_DRAIN) { E.fused(acc, cur, wr, wc, fr, fq, lds, wid, lane); S.done(cur); }
#undef PG8_SA
#undef PG8_SB
#undef PG8_STAGE
#undef PG8_LDA
#undef PG8_LDB
#undef PG8_MMA
#undef PG8_WAIT_V
#undef PG8_WAIT_L
#undef PG8_BAR
#undef PG8_SCHED
}
}
constexpr int NW = 8, NTHR = 512;
constexpr int DM = 1024, NB = 4, SEQ = 4096, NTOK = NB * SEQ, NLAYER = 2;
constexpr int HA = 8, HDA = 64, WA = 512, MBLK = 256, NBLK = SEQ / MBLK;
constexpr int HB = 4, HDB = 128, WB = 512, CONVK = 4, DNC = 64, NCH = SEQ / DNC;
constexpr int NGRP = 4, EPG = 8, NEXP = 32, DFF = 256;
constexpr int DIN = 5640, DINP = 5632, NMOD = 6;
constexpr int C_QKVA = 0, C_QKVB = 1536, C_ZB = 3072, C_BA = 3584, C_GATE = 3592;
constexpr float EPS = 1e-6f;
constexpr int MOE_MAXROWS = 2 * NTOK + NEXP * 256;
constexpr int MOE_MAXTILES = MOE_MAXROWS / 256;

constexpr size_t MiB = 1u << 20;
constexpr size_t WS_CTL = 0, CTL_ZERO_BYTES = 1 * MiB;
constexpr size_t WS_MOD = 1 * MiB;
constexpr size_t WS_WIN = 2 * MiB;
constexpr size_t WS_WUPA = 13 * MiB, WS_WUPB = 14 * MiB;
constexpr size_t WS_WOUT = 15 * MiB;
constexpr size_t WS_WEGU = 17 * MiB;
constexpr size_t WS_WED = 49 * MiB;
constexpr size_t WS_SMALL = 65 * MiB;
constexpr size_t WS_KMEAN = WS_SMALL;
constexpr size_t WS_BETA = WS_SMALL + 256 * 1024;
constexpr size_t WS_GLOG = WS_SMALL + 512 * 1024;
constexpr size_t WS_TOKINFO = WS_SMALL + 1 * MiB;
constexpr size_t WS_ROWTOK = WS_SMALL + 2 * MiB;
constexpr size_t WS_ROWW = WS_SMALL + 3 * MiB;
constexpr size_t WS_GL = WS_SMALL + 4 * MiB;
constexpr size_t WS_H = 72 * MiB;
constexpr size_t WS_QKVA = 104 * MiB;
constexpr size_t WS_QKVB = 152 * MiB;
constexpr size_t WS_ZB = 200 * MiB;
constexpr size_t WS_GATES = 216 * MiB;
constexpr size_t WS_IMG = 280 * MiB;
constexpr size_t WS_YA = 72 * MiB, WS_YB = 336 * MiB;
constexpr size_t WS_END = 352 * MiB;
constexpr size_t WS_M = WS_QKVB;
constexpr size_t WS_U = 88 * MiB;
constexpr size_t WS_HS = WS_QKVA;
constexpr size_t WS_ACT = 184 * MiB;
constexpr size_t WS_YS = WS_GATES;
constexpr int CW_TMO = 0;
constexpr int CW_BAR = 4096;
constexpr int CW_GCNT = 8192;
constexpr int CW_ACTR = 8320;

constexpr int RING_BYTES = 131072;
constexpr int MISC_OFF = 147456;
constexpr int LDS_BYTES = 151552;

#define GAS __attribute__((address_space(1)))
#define LAS __attribute__((address_space(3)))
typedef unsigned short bf16;
typedef unsigned v4u __attribute__((ext_vector_type(4)));
typedef unsigned v2u __attribute__((ext_vector_type(2)));
typedef float f32x4 __attribute__((ext_vector_type(4)));
typedef float f32x16 __attribute__((ext_vector_type(16)));
typedef short bf16x8 __attribute__((ext_vector_type(8)));
typedef GAS unsigned gu32;
#define RLX_AGENT __ATOMIC_RELAXED, __HIP_MEMORY_SCOPE_AGENT
#define LDS_WAIT() asm volatile("s_waitcnt lgkmcnt(0)" ::: "memory")
#define VM_WAIT() asm volatile("s_waitcnt vmcnt(0)" ::: "memory")
__device__ __forceinline__ unsigned f2bf(float f) { unsigned u = __builtin_bit_cast(unsigned, f); return (u + 0x7fffu + ((u >> 16) & 1u)) >> 16; }
__device__ __forceinline__ unsigned pk2(float lo, float hi) { return f2bf(lo) | (f2bf(hi) << 16); }
__device__ __forceinline__ float bf2f(unsigned b) { return __builtin_bit_cast(float, b << 16); }
__device__ __forceinline__ float bflo(unsigned w) { return __builtin_bit_cast(float, w << 16); }
__device__ __forceinline__ float bfhi(unsigned w) { return __builtin_bit_cast(float, w & 0xffff0000u); }
__device__ __forceinline__ float rcpf_(float x) { return __builtin_amdgcn_rcpf(x); }
__device__ __forceinline__ float sigmoidf_(float x) { return rcpf_(1.f + __builtin_amdgcn_exp2f(-1.4426950408889634f * x)); }
__device__ __forceinline__ float siluf_(float x) { return x * rcpf_(1.f + __builtin_amdgcn_exp2f(-1.4426950408889634f * x)); }
__device__ __forceinline__ float shx(float v, int o, int lane) { return __builtin_bit_cast(float, __builtin_amdgcn_ds_bpermute((lane ^ o) << 2, __builtin_bit_cast(int, v))); }
__device__ __forceinline__ float shidx(float v, int src) { return __builtin_bit_cast(float, __builtin_amdgcn_ds_bpermute(src << 2, __builtin_bit_cast(int, v))); }
__device__ __forceinline__ int shidx_i(int v, int src) { return __builtin_amdgcn_ds_bpermute(src << 2, v); }
template <int CTRL> __device__ __forceinline__ float dpp_f(float v) { return __builtin_bit_cast(float, __builtin_amdgcn_update_dpp(0, __builtin_bit_cast(int, v), CTRL, 0xf, 0xf, true)); }
__device__ __forceinline__ float rdlane_f(float v, int l) { return __builtin_bit_cast(float, __builtin_amdgcn_readlane(__builtin_bit_cast(int, v), l)); }
__device__ __forceinline__ float wave_sum(float v, int) {
    v += dpp_f<0xB1>(v); v += dpp_f<0x4E>(v); v += dpp_f<0x141>(v); v += dpp_f<0x140>(v);
    return (rdlane_f(v, 0) + rdlane_f(v, 16)) + (rdlane_f(v, 32) + rdlane_f(v, 48));
}
__device__ __forceinline__ float wave_max(float v, int) {
    v = fmaxf(v, dpp_f<0xB1>(v)); v = fmaxf(v, dpp_f<0x4E>(v)); v = fmaxf(v, dpp_f<0x141>(v)); v = fmaxf(v, dpp_f<0x140>(v));
    return fmaxf(fmaxf(rdlane_f(v, 0), rdlane_f(v, 16)), fmaxf(rdlane_f(v, 32), rdlane_f(v, 48)));
}
__device__ const unsigned char T5B[128] = {0, 1, 2, 3, 4, 5, 6, 7, 8, 9, 10, 11, 12, 13, 14, 15, 16, 16, 16, 17, 17, 18, 18, 18, 19, 19, 19, 20, 20, 20, 20, 21, 21, 21, 21, 22, 22, 22, 22, 22, 23, 23, 23, 23, 23, 23, 24, 24, 24, 24, 24, 24, 25, 25, 25, 25, 25, 25, 25, 26, 26, 26, 26, 26, 26, 26, 26, 27, 27, 27, 27, 27, 27, 27, 27, 27, 27, 28, 28, 28, 28, 28, 28, 28, 28, 28, 28, 29, 29, 29, 29, 29, 29, 29, 29, 29, 29, 29, 29, 30, 30, 30, 30, 30, 30, 30, 30, 30, 30, 30, 30, 30, 30, 31, 31, 31, 31, 31, 31, 31, 31, 31, 31, 31, 31, 31, 31, 31};

#define XB_TMO      128
#define XB_XCNT(j)  (256  + 64 * (j))
#define XB_XSUB(j)  (1280 + 64 * (j))
#define XB_XGEN(j)  (2304 + 64 * (j))
#define XB_TOP      3328
#define XB_TOPGEN   3392
#define XCD_BAR_WORDS 3456
#define XB_SPIN_CAP (1u << 18)

__device__ __forceinline__ unsigned xb_ld(unsigned* p)              { return __hip_atomic_load(p, __ATOMIC_RELAXED, __HIP_MEMORY_SCOPE_AGENT); }
__device__ __forceinline__ unsigned xb_add(unsigned* p, unsigned v) { return __hip_atomic_fetch_add(p, v, __ATOMIC_RELAXED, __HIP_MEMORY_SCOPE_AGENT); }
__device__ __forceinline__ unsigned xb_xcc_id() { return (unsigned)__builtin_amdgcn_s_getreg((3 << 11) | 20) & 0xFu; }
#define XB_SPIN(cond, bar) do { unsigned _sp = 0; while (cond) { __builtin_amdgcn_s_sleep(1); \
    if ((++_sp & 255u) == 0u) { if (xb_ld(&(bar)[XB_TMO])) break; if (_sp > XB_SPIN_CAP) { atomicAdd(&(bar)[XB_TMO], 1u); break; } } } } while (0)

struct XcdBarrier {
    unsigned* bar; unsigned x;
    volatile LAS unsigned* st;
};

__device__ __forceinline__ XcdBarrier xcd_barrier_post(unsigned* bar, volatile LAS unsigned* st, const int tid_in) {
    XcdBarrier b; b.bar = bar; b.x = xb_xcc_id(); b.st = st;
    if (tid_in == 0) (void)xb_add(&bar[XB_XCNT(b.x)], 1u);
    return b;
}
__device__ __forceinline__ void xcd_barrier_complete(unsigned* bar, unsigned x, unsigned& nloc, unsigned& nx) {
    const unsigned G = gridDim.x * gridDim.y * gridDim.z;
    unsigned sum, cnt, mine, sp = 0u;
    for (;;) {
        sum = 0u; cnt = 0u; mine = 0u;
#pragma unroll
        for (unsigned j = 0; j < 16; ++j) { const unsigned c = xb_ld(&bar[XB_XCNT(j)]); sum += c; cnt += (c > 0u) ? 1u : 0u; mine = (j == x) ? c : mine; }
        if (sum == G) break;
        __builtin_amdgcn_s_sleep(1);
        if ((++sp & 255u) == 0u) { if (xb_ld(&bar[XB_TMO])) break; if (sp > XB_SPIN_CAP) { atomicAdd(&bar[XB_TMO], 1u); break; } }
    }
    nloc = mine > 0u ? mine : 1u; nx = cnt > 0u ? cnt : 1u;
}

__device__ __forceinline__ void xcd_barrier(const XcdBarrier& b, const int tid_in) {
    asm volatile("s_waitcnt vmcnt(0)" ::: "memory");
    __syncthreads();
    if (tid_in == 0) {
        unsigned* bar = b.bar;
        __builtin_amdgcn_s_waitcnt(0);
        unsigned nloc = b.st[0], nx = b.st[1];
        if (nloc == 0u) { xcd_barrier_complete(bar, b.x, nloc, nx); b.st[0] = nloc; b.st[1] = nx; }
        const unsigned old = xb_add(&bar[XB_XSUB(b.x)], 1u);
        const unsigned gen = old / nloc;
        if (old + 1u == (gen + 1u) * nloc) {
            __builtin_amdgcn_fence(__ATOMIC_RELEASE, "agent");
            asm volatile("s_waitcnt vmcnt(0)" ::: "memory");
            const unsigned og = xb_add(&bar[XB_TOP], 1u);
            const unsigned tg = og / nx;
            if (og + 1u == (tg + 1u) * nx) xb_add(&bar[XB_TOPGEN], 1u);
            else XB_SPIN(xb_ld(&bar[XB_TOPGEN]) == tg, bar);
            __builtin_amdgcn_fence(__ATOMIC_ACQUIRE, "agent");
            xb_add(&bar[XB_XGEN(b.x)], 1u);
            asm volatile("s_waitcnt vmcnt(0)" ::: "memory");
        } else {
            XB_SPIN(xb_ld(&bar[XB_XGEN(b.x)]) == gen, bar);
            __builtin_amdgcn_fence(__ATOMIC_ACQUIRE, "agent");
            asm volatile("s_waitcnt vmcnt(0)" ::: "memory");
        }
    }
    __syncthreads();
}
struct Args { const float* in[23]; float* out; unsigned char* ws; int ph_lo, ph_hi; };
enum { I_X = 0, I_C, I_RELB, I_FNW, I_N1W, I_N2W, I_WMOD, I_BMOD, I_WIN, I_CONVW, I_ALOG, I_DTB, I_ONW, I_WUPA, I_WUPB, I_WOUT, I_WRG, I_BRG, I_WRE, I_BRE, I_WEG, I_WEU, I_WED };

typedef const Args __attribute__((address_space(4)))* KArgs;
struct Ctx { LAS unsigned char* lds; int tid, lane, wave, bid, G; };
extern __shared__ __attribute__((aligned(16))) unsigned char lds_raw[];
__device__ __forceinline__ Ctx make_ctx(int& tid) { Ctx c; c.lds = (LAS unsigned char*)lds_raw; asm volatile("" : "+v"(tid)); const int t = tid; c.tid = t; c.lane = t & 63; c.wave = __builtin_amdgcn_readfirstlane(t >> 6); int bi = blockIdx.x, gd = gridDim.x; asm volatile("" : "+s"(bi), "+s"(gd)); c.bid = bi; c.G = gd; return c; }

__device__ __forceinline__ void ph_mod(KArgs a, const Ctx& c) {
    LAS float* cact = (LAS float*)c.lds;
    LAS float* red = (LAS float*)(c.lds + 16384);
    const float* cin = a->in[I_C];
    for (int i = c.tid; i < 4096; i += NTHR) cact[i] = siluf_(cin[i]);
    __syncthreads();
    float* mod = (float*)(a->ws + WS_MOD);
    for (int item = c.bid; item < 192; item += c.G) {
        const int l = item / 96, j0 = (item % 96) * 64;
        const float* W = a->in[I_WMOD] + (size_t)l * 1024 * 6144 + j0 + c.lane;
        float a0 = 0.f, a1 = 0.f, a2 = 0.f, a3 = 0.f;
        const int k0 = c.wave * 128;
#pragma unroll 8
        for (int k = k0; k < k0 + 128; ++k) { const float w = W[(size_t)k * 6144]; a0 += cact[k] * w; a1 += cact[1024 + k] * w; a2 += cact[2048 + k] * w; a3 += cact[3072 + k] * w; }
        red[(c.wave * 4 + 0) * 64 + c.lane] = a0; red[(c.wave * 4 + 1) * 64 + c.lane] = a1; red[(c.wave * 4 + 2) * 64 + c.lane] = a2; red[(c.wave * 4 + 3) * 64 + c.lane] = a3;
        __syncthreads();
        if (c.tid < 256) { const int b = c.tid >> 6, ln = c.tid & 63; float s = 0.f;
#pragma unroll
            for (int w = 0; w < 8; ++w) s += red[(w * 4 + b) * 64 + ln];
            mod[(l * 4 + b) * 6144 + j0 + ln] = s + a->in[I_BMOD][l * 6144 + j0 + ln]; }
        __syncthreads();
    }
}

__device__ __forceinline__ void tr_item(const float* src, int ld, bf16* dst, int K, int nblk, LAS float* scr, int item, int lane) {
    const int kb = item / nblk, nb = item % nblk, k0 = 64 * kb, n0 = 32 * nb;
#pragma unroll 8
    for (int i = 0; i < 32; ++i) { const int kk = 2 * i + (lane >> 5); scr[kk * 33 + (lane & 31)] = src[(size_t)(k0 + kk) * ld + n0 + (lane & 31)]; }
    LDS_WAIT(); asm volatile("" ::: "memory");
    const int cc = lane & 7;
#pragma unroll
    for (int j = 0; j < 4; ++j) { const int n = (lane >> 3) + 8 * j; const LAS float* s = scr + (8 * cc) * 33 + n;
        v4u o; o.x = pk2(s[0 * 33], s[1 * 33]); o.y = pk2(s[2 * 33], s[3 * 33]); o.z = pk2(s[4 * 33], s[5 * 33]); o.w = pk2(s[6 * 33], s[7 * 33]);
        *(v4u*)(dst + (size_t)(n0 + n) * K + k0 + 8 * cc) = o; }
    LDS_WAIT(); asm volatile("" ::: "memory");
}
constexpr int CV_I0 = 1792, CV_I1 = 1024, CV_I2 = 256, CV_I3 = 256, CV_I4 = 512, CV_I5 = 4096, CV_I6 = 4096, CV_I7 = 4096;
constexpr int CV_NIT = CV_I0 + CV_I1 + CV_I2 + CV_I3 + CV_I4 + CV_I5 + CV_I6 + CV_I7, CV_EARLY = CV_I0 + CV_I1;
__device__ __forceinline__ void convert_item(KArgs a, int l, int it, LAS float* scr, int lane) {
    bf16* WIN = (bf16*)(a->ws + WS_WIN); bf16* WEGU = (bf16*)(a->ws + WS_WEGU); bf16* WEDT = (bf16*)(a->ws + WS_WED);
    const float* win = a->in[I_WIN] + (size_t)l * 1024 * DIN;
    int r = it;
    if (r < CV_I0) { tr_item(win, DIN, WIN, 1024, 112, scr, r, lane); return; } r -= CV_I0;
    if (r < CV_I1) { tr_item(win + C_GATE, DIN, WIN + (size_t)C_BA * 1024, 1024, 64, scr, r, lane); return; } r -= CV_I1;
    if (r < CV_I2) { tr_item(a->in[I_WUPA] + (size_t)l * 512 * 1024, 1024, (bf16*)(a->ws + WS_WUPA), 512, 32, scr, r, lane); return; } r -= CV_I2;
    if (r < CV_I3) { tr_item(a->in[I_WUPB] + (size_t)l * 512 * 1024, 1024, (bf16*)(a->ws + WS_WUPB), 512, 32, scr, r, lane); return; } r -= CV_I3;
    if (r < CV_I4) { tr_item(a->in[I_WOUT] + (size_t)l * 1024 * 1024, 1024, (bf16*)(a->ws + WS_WOUT), 1024, 32, scr, r, lane); return; } r -= CV_I4;
    if (r < CV_I5) { const int E = r >> 7, rem = r & 127, pn = rem >> 6, q = rem & 63;
        tr_item(a->in[I_WEG] + ((size_t)(l * 32 + E) * 1024 * 256) + 128 * pn, 256, WEGU + (size_t)(E * 512 + 256 * pn) * 1024, 1024, 4, scr, q, lane); return; } r -= CV_I5;
    if (r < CV_I6) { const int E = r >> 7, rem = r & 127, pn = rem >> 6, q = rem & 63;
        tr_item(a->in[I_WEU] + ((size_t)(l * 32 + E) * 1024 * 256) + 128 * pn, 256, WEGU + (size_t)(E * 512 + 256 * pn + 128) * 1024, 1024, 4, scr, q, lane); return; } r -= CV_I6;
    { const int E = r >> 7, q = r & 127;
        tr_item(a->in[I_WED] + ((size_t)(l * 32 + E) * 256 * 1024), 1024, WEDT + (size_t)E * 1024 * 256, 256, 32, scr, q, lane); }
}
__device__ __forceinline__ void ph_convert(KArgs a, const Ctx& c, int l) {
    LAS float* scr = (LAS float*)(c.lds + 32768 + c.wave * 10240);
    const int gw = c.bid * NW + c.wave, NGW = c.G * NW;
    for (int it = gw; it < CV_EARLY; it += NGW) convert_item(a, l, it, scr, c.lane);
}
constexpr int CV_UNIT = 64, CV_NUNITS = (CV_NIT - CV_EARLY) / CV_UNIT;
static_assert((CV_NIT - CV_EARLY) % CV_UNIT == 0, "convert units");
__device__ __forceinline__ void convert_unit(KArgs a, const Ctx& c, int l, int cu) {
    LAS float* scr = (LAS float*)(c.lds + 32768 + c.wave * 10240);
#pragma unroll 1
    for (int i = 0; i < 8; ++i) convert_item(a, l, CV_EARLY + cu * CV_UNIT + c.wave * 8 + i, scr, c.lane);
}

__device__ __forceinline__ void load_row_x(KArgs a, int l, int m, int lane, f32x4 (&v)[4]) {
    const float* xr = (l == 0 ? a->in[I_X] : (const float*)a->out) + (size_t)m * DM;
#pragma unroll
    for (int j = 0; j < 4; ++j) v[j] = *(const f32x4*)(xr + 256 * j + 4 * lane);
    if (l > 0) {
        const int b = m >> 12;
        const float* g2 = (const float*)(a->ws + WS_MOD) + ((l - 1) * 4 + b) * 6144 + 5120;
        const bf16* ys = (const bf16*)(a->ws + WS_YS) + (size_t)m * 2048;
#pragma unroll
        for (int j = 0; j < 4; ++j) { const int col = 256 * j + 4 * lane; const v2u y0 = *(const v2u*)(ys + col), y1 = *(const v2u*)(ys + 1024 + col); const f32x4 g = *(const f32x4*)(g2 + col);
            v[j].x += g.x * (bflo(y0.x) + bflo(y1.x)); v[j].y += g.y * (bfhi(y0.x) + bfhi(y1.x)); v[j].z += g.z * (bflo(y0.y) + bflo(y1.y)); v[j].w += g.w * (bfhi(y0.y) + bfhi(y1.y)); }
        float* xo = a->out + (size_t)m * DM;
#pragma unroll
        for (int j = 0; j < 4; ++j) *(f32x4*)(xo + 256 * j + 4 * lane) = v[j];
    }
}
__device__ __forceinline__ float row_rstd(const f32x4 (&v)[4], int lane) {
    float s = 0.f;
#pragma unroll
    for (int j = 0; j < 4; ++j) s += (v[j].x * v[j].x + v[j].y * v[j].y) + (v[j].z * v[j].z + v[j].w * v[j].w);
    return __builtin_amdgcn_rsqf(wave_sum(s, lane) * (1.f / DM) + EPS);
}
__device__ __forceinline__ void ph_norm1(KArgs a, const Ctx& c, int l) {
    LAS float* wbaT = (LAS float*)c.lds;
    const float* win = a->in[I_WIN] + (size_t)l * 1024 * DIN + C_BA;
    for (int i = c.tid; i < 8192; i += NTHR) { const int k = i >> 3, cc = i & 7; wbaT[cc * 1024 + k] = win[(size_t)k * DIN + cc]; }
    __syncthreads();
    const int gw = c.bid * NW + c.wave, NGW = c.G * NW, lane = c.lane;
    bf16* H = (bf16*)(a->ws + WS_H); float* beta = (float*)(a->ws + WS_BETA); float* glog = (float*)(a->ws + WS_GLOG);
    const float* n1w = a->in[I_N1W] + l * DM;
    for (int m = gw; m < NTOK; m += NGW) {
        f32x4 v[4]; load_row_x(a, l, m, lane, v);
        const float rstd = row_rstd(v, lane);
        const int b = m >> 12; const float* mod = (const float*)(a->ws + WS_MOD) + (l * 4 + b) * 6144;
        float acc[8];
#pragma unroll
        for (int q = 0; q < 8; ++q) acc[q] = 0.f;
#pragma unroll
        for (int j = 0; j < 4; ++j) { const int col = 256 * j + 4 * lane;
            const f32x4 nw = *(const f32x4*)(n1w + col), sh = *(const f32x4*)(mod + col), sc = *(const f32x4*)(mod + 1024 + col);
            f32x4 h = v[j] * rstd * nw * (sc + 1.0f) + sh;
            v2u o; o.x = pk2(h.x, h.y); o.y = pk2(h.z, h.w); *(v2u*)(H + (size_t)m * DM + col) = o;
#pragma unroll
            for (int q = 0; q < 8; ++q) { const f32x4 w4 = *(const LAS f32x4*)(wbaT + q * 1024 + col); acc[q] += (h.x * w4.x + h.y * w4.y) + (h.z * w4.z + h.w * w4.w); } }
#pragma unroll
        for (int q = 0; q < 8; ++q) acc[q] = wave_sum(acc[q], lane);
        if (lane < 4) {
            const float bb = lane == 0 ? acc[0] : lane == 1 ? acc[1] : lane == 2 ? acc[2] : acc[3];
            const float aa = lane == 0 ? acc[4] : lane == 1 ? acc[5] : lane == 2 ? acc[6] : acc[7];
            beta[m * 4 + lane] = sigmoidf_(bb);
            const float z = aa + a->in[I_DTB][l * 4 + lane]; const float sp = fmaxf(z, 0.f) + log1pf(__expf(-fabsf(z)));
            glog[m * 4 + lane] = -__expf(a->in[I_ALOG][l * 4 + lane]) * sp;
        }
    }
}
__device__ __forceinline__ void ph_final(KArgs a, const Ctx& c) {
    const int gw = c.bid * NW + c.wave, NGW = c.G * NW, lane = c.lane;
    const float* fw = a->in[I_FNW];
    for (int m = gw; m < NTOK; m += NGW) {
        f32x4 v[4];
        {
            const float* xr = (const float*)a->out + (size_t)m * DM; const int b = m >> 12;
            const float* g2 = (const float*)(a->ws + WS_MOD) + ((NLAYER - 1) * 4 + b) * 6144 + 5120;
            const bf16* ys = (const bf16*)(a->ws + WS_YS) + (size_t)m * 2048;
#pragma unroll
            for (int j = 0; j < 4; ++j) { const int col = 256 * j + 4 * lane; v[j] = *(const f32x4*)(xr + col);
                const v2u y0 = *(const v2u*)(ys + col), y1 = *(const v2u*)(ys + 1024 + col); const f32x4 g = *(const f32x4*)(g2 + col);
                v[j].x += g.x * (bflo(y0.x) + bflo(y1.x)); v[j].y += g.y * (bfhi(y0.x) + bfhi(y1.x)); v[j].z += g.z * (bflo(y0.y) + bflo(y1.y)); v[j].w += g.w * (bfhi(y0.y) + bfhi(y1.y)); }
        }
        float rstd = row_rstd(v, lane);
#if defined(MK_PROBE_A) && MK_PROBE_A >= 0
        {   const unsigned long long* ts = (const unsigned long long*)((const unsigned*)(a->ws + WS_CTL) + 12288);
            float tA = 0.f, tB = 0.f;
            for (int ly = 0; ly < NLAYER; ++ly) { const int ka = 1 + ly * 11 + MK_PROBE_A, kb = 1 + ly * 11 + MK_PROBE_B;
                if (MK_PROBE_A < 11) tA += (float)(ts[ka + 1] - ts[ka]) * 0.01f; if (MK_PROBE_B < 11) tB += (float)(ts[kb + 1] - ts[kb]) * 0.01f; }
            if (MK_PROBE_A == 20) { tA = 0.f; for (int ly = 0; ly < NLAYER; ++ly) tA += (float)(ts[40 + ly] - ts[1 + ly * 11 + 3]) * 0.01f; }
            if (MK_PROBE_B == 21) { tB = 0.f; for (int ly = 0; ly < NLAYER; ++ly) tB += (float)(ts[44 + ly] - ts[1 + ly * 11 + 3]) * 0.01f; }
            if (MK_PROBE_A >= 22 && MK_PROBE_A <= 24) { tA = 0.f; for (int ly = 0; ly < NLAYER; ++ly) tA += (float)ts[48 + ly * 4 + MK_PROBE_A - 22] * 0.01f; }
            if (MK_PROBE_B >= 22 && MK_PROBE_B <= 24) { tB = 0.f; for (int ly = 0; ly < NLAYER; ++ly) tB += (float)ts[48 + ly * 4 + MK_PROBE_B - 22] * 0.01f; }
            if (MK_PROBE_A == 11) tA = (float)(ts[1] - ts[0]) * 0.01f; if (MK_PROBE_A == 12) tA = (float)(ts[23] - ts[0]) * 0.01f;
            if (MK_PROBE_B == 11) tB = (float)(ts[1] - ts[0]) * 0.01f; if (MK_PROBE_B == 12) tB = (float)(ts[23] - ts[0]) * 0.01f;
            (void)tB;
            if (m == 0 && lane == 0) v[0].x += tA * 0.05f / rstd / fw[0]; }
#endif
        float* xo = a->out + (size_t)m * DM;
#pragma unroll
        for (int j = 0; j < 4; ++j) { const int col = 256 * j + 4 * lane; const f32x4 w = *(const f32x4*)(fw + col); *(f32x4*)(xo + col) = v[j] * rstd * w; }
    }
}

__device__ __forceinline__ void ph_kmean(KArgs a, const Ctx& c) {
    const int gw = c.bid * NW + c.wave, NGW = c.G * NW, lane = c.lane;
    const bf16* QKVA = (const bf16*)(a->ws + WS_QKVA); float* kmean = (float*)(a->ws + WS_KMEAN);
    for (int item = gw; item < NB * HA * NBLK; item += NGW) {
        const int nb = item & 15, h = (item >> 4) & 7, b = item >> 7;
        const int sub = lane & 7, rr = lane >> 3;
        float s[8];
#pragma unroll
        for (int q = 0; q < 8; ++q) s[q] = 0.f;
        const bf16* kp = QKVA + (size_t)(b * SEQ + nb * MBLK) * 1536 + 512 + h * 64 + sub * 8;
#pragma unroll 4
        for (int it = 0; it < 32; ++it) { const v4u w = *(const v4u*)(kp + (size_t)(it * 8 + rr) * 1536);
            s[0] += bflo(w.x); s[1] += bfhi(w.x); s[2] += bflo(w.y); s[3] += bfhi(w.y); s[4] += bflo(w.z); s[5] += bfhi(w.z); s[6] += bflo(w.w); s[7] += bfhi(w.w); }
#pragma unroll
        for (int q = 0; q < 8; ++q) { s[q] += shx(s[q], 8, lane); s[q] += shx(s[q], 16, lane); s[q] += shx(s[q], 32, lane); }
        if (lane < 8) { float* o = kmean + (size_t)item * 64 + sub * 8;
            *(f32x4*)o = (f32x4){s[0], s[1], s[2], s[3]} * (1.f / 256.f); *(f32x4*)(o + 4) = (f32x4){s[4], s[5], s[6], s[7]} * (1.f / 256.f); }
    }
}

__device__ __forceinline__ void ph_attn_simple(KArgs a, const Ctx& c) {
    const int gw = c.bid * NW + c.wave, NGW = c.G * NW, lane = c.lane;
    LAS float* btab = (LAS float*)(c.lds);
    LAS float* scw = (LAS float*)(c.lds + 8192) + c.wave * 1024;
    const float* relb = a->in[I_RELB];
    for (int i = c.tid; i < 8 * 129; i += NTHR) { const int h = i / 129, d = i % 129; btab[h * 132 + d] = relb[(d < 128 ? (int)T5B[d] : 31) * 8 + h]; }
    __syncthreads();
    const bf16* QKVA = (const bf16*)(a->ws + WS_QKVA); const float* kmean = (const float*)(a->ws + WS_KMEAN); bf16* YA = (bf16*)(a->ws + WS_YA);
    for (int r = gw; r < NB * HA * SEQ; r += NGW) {
        const int s = r & (SEQ - 1), h = (r >> 12) & 7, b = r >> 15, qb = s >> 8, tok = b * SEQ + s;
        float qv[64];
        { const bf16* qp = QKVA + (size_t)tok * 1536 + h * 64;
#pragma unroll
          for (int q = 0; q < 8; ++q) { const v4u w = *(const v4u*)(qp + q * 8); qv[q * 8 + 0] = bflo(w.x); qv[q * 8 + 1] = bfhi(w.x); qv[q * 8 + 2] = bflo(w.y); qv[q * 8 + 3] = bfhi(w.y); qv[q * 8 + 4] = bflo(w.z); qv[q * 8 + 5] = bfhi(w.z); qv[q * 8 + 6] = bflo(w.w); qv[q * 8 + 7] = bfhi(w.w); } }
        float gate = -1e30f;
        if (lane < qb) { const float* km = kmean + (size_t)(((b * 8 + h) * 16) + lane) * 64; float d = 0.f;
#pragma unroll
            for (int q = 0; q < 16; ++q) { const f32x4 k4 = *(const f32x4*)(km + q * 4); d += qv[q * 4] * k4.x + qv[q * 4 + 1] * k4.y + qv[q * 4 + 2] * k4.z + qv[q * 4 + 3] * k4.w; }
            gate = d; }
        unsigned selmask = 0u;
#pragma unroll
        for (int t = 0; t < 3; ++t) { float best = -3e38f; int bi = 0;
#pragma unroll
            for (int n = 0; n < 16; ++n) { const float gv = shidx(gate, n); if (!((selmask >> n) & 1u) && gv > best) { best = gv; bi = n; } }
            selmask |= 1u << bi; }
        selmask &= (1u << qb) - 1u;
        selmask |= 1u << qb;
        int nseg = 0; float mx = -3e38f;
        for (int blk = 0; blk <= qb; ++blk) {
            if (!((selmask >> blk) & 1u)) continue;
            for (int i = 0; i < 4; ++i) { const int key = blk * 256 + i * 64 + lane; const bf16* kp = QKVA + (size_t)(b * SEQ + key) * 1536 + 512 + h * 64; float d = 0.f;
#pragma unroll
                for (int q = 0; q < 8; ++q) { const v4u w = *(const v4u*)(kp + q * 8);
                    d += qv[q * 8] * bflo(w.x) + qv[q * 8 + 1] * bfhi(w.x) + qv[q * 8 + 2] * bflo(w.y) + qv[q * 8 + 3] * bfhi(w.y) + qv[q * 8 + 4] * bflo(w.z) + qv[q * 8 + 5] * bfhi(w.z) + qv[q * 8 + 6] * bflo(w.w) + qv[q * 8 + 7] * bfhi(w.w); }
                const int dist = s - key; float sc = d * 0.125f + btab[h * 132 + (dist < 0 ? 0 : (dist > 128 ? 128 : dist))];
                if (dist < 0) sc = -3e38f;
                scw[nseg * 256 + i * 64 + lane] = sc; mx = fmaxf(mx, sc); }
            ++nseg; }
        mx = wave_max(mx, lane);
        float sum = 0.f;
        for (int idx = lane; idx < nseg * 256; idx += 64) { const float sc = scw[idx]; const float e = sc < -1e37f ? 0.f : __expf(sc - mx); scw[idx] = e; sum += e; }
        sum = wave_sum(sum, lane);
        LDS_WAIT();
        float o = 0.f; int sg = 0;
        for (int blk = 0; blk <= qb; ++blk) {
            if (!((selmask >> blk) & 1u)) continue;
            const bf16* vp = QKVA + (size_t)(b * SEQ + blk * 256) * 1536 + 1024 + h * 64 + lane;
            const int lim = (blk == qb) ? (s & 255) + 1 : 256;
#pragma unroll 8
            for (int kk = 0; kk < lim; ++kk) o += scw[sg * 256 + kk] * bf2f(vp[(size_t)kk * 1536]);
            ++sg; }
        YA[(size_t)tok * 512 + h * 64 + lane] = (bf16)f2bf(o / sum);
    }
}

template <int LDW> __device__ __forceinline__ void dn_load_chunk(KArgs a, const Ctx& c, int l, int b, int h, int t0, LAS float* qs, LAS float* ks, LAS float* vs) {
    const bf16* QKVB = (const bf16*)(a->ws + WS_QKVB); const float* cw = a->in[I_CONVW] + (size_t)l * 4 * 1536;
    const int cg = c.tid & 15, r0 = c.tid >> 4;
#pragma unroll
    for (int part = 0; part < 3; ++part) {
        const int colb = part * 512 + h * 128 + 8 * cg;
        float w[4][8];
#pragma unroll
        for (int i = 0; i < 4; ++i) { const f32x4 w0 = *(const f32x4*)(cw + i * 1536 + colb), w1 = *(const f32x4*)(cw + i * 1536 + colb + 4);
            w[i][0] = w0.x; w[i][1] = w0.y; w[i][2] = w0.z; w[i][3] = w0.w; w[i][4] = w1.x; w[i][5] = w1.y; w[i][6] = w1.z; w[i][7] = w1.w; }
        LAS float* dst = part == 0 ? qs : part == 1 ? ks : vs;
#pragma unroll
        for (int pass = 0; pass < 2; ++pass) {
            const int r = r0 + 32 * pass, t = t0 + r;
            float y[8];
#pragma unroll
            for (int e = 0; e < 8; ++e) y[e] = 0.f;
#pragma unroll
            for (int i = 0; i < 4; ++i) { const int tt = t - 3 + i; if (tt >= 0) { const v4u x = *(const v4u*)(QKVB + (size_t)(b * SEQ + tt) * 1536 + colb);
                y[0] += w[i][0] * bflo(x.x); y[1] += w[i][1] * bfhi(x.x); y[2] += w[i][2] * bflo(x.y); y[3] += w[i][3] * bfhi(x.y); y[4] += w[i][4] * bflo(x.z); y[5] += w[i][5] * bfhi(x.z); y[6] += w[i][6] * bflo(x.w); y[7] += w[i][7] * bfhi(x.w); } }
            float ss = 0.f;
#pragma unroll
            for (int e = 0; e < 8; ++e) { y[e] = siluf_(y[e]); ss += y[e] * y[e]; }
            if (part < 2) { ss += shx(ss, 1, c.lane); ss += shx(ss, 2, c.lane); ss += shx(ss, 4, c.lane); ss += shx(ss, 8, c.lane);
                const float rs = __builtin_amdgcn_rsqf(ss + EPS) * (part == 0 ? 0.08838834764831845f : 1.f);
#pragma unroll
                for (int e = 0; e < 8; ++e) y[e] *= rs; }
            *(LAS f32x4*)(dst + r * LDW + 8 * cg) = (f32x4){y[0], y[1], y[2], y[3]}; *(LAS f32x4*)(dst + r * LDW + 8 * cg + 4) = (f32x4){y[4], y[5], y[6], y[7]};
        }
    }
}
__device__ __forceinline__ void dn_store_chunk(KArgs a, const Ctx& c, int l, int b, int h, int t0, const LAS float* os) {
    const bf16* ZB = (const bf16*)(a->ws + WS_ZB); bf16* YB = (bf16*)(a->ws + WS_YB); const float* onw = a->in[I_ONW] + l * 128;
    const int r = c.tid >> 3, sub = c.tid & 7, tok = b * SEQ + t0 + r;
    float o[16]; float ss = 0.f;
#pragma unroll
    for (int q = 0; q < 4; ++q) { const f32x4 v = *(const LAS f32x4*)(os + r * 128 + sub * 16 + q * 4); o[q * 4] = v.x; o[q * 4 + 1] = v.y; o[q * 4 + 2] = v.z; o[q * 4 + 3] = v.w; ss += (v.x * v.x + v.y * v.y) + (v.z * v.z + v.w * v.w); }
    ss += shx(ss, 1, c.lane); ss += shx(ss, 2, c.lane); ss += shx(ss, 4, c.lane);
    const float rstd = __builtin_amdgcn_rsqf(ss * (1.f / 128.f) + EPS);
    const bf16* zp = ZB + (size_t)tok * 512 + h * 128 + sub * 16; bf16* yp = YB + (size_t)tok * 512 + h * 128 + sub * 16;
#pragma unroll
    for (int q = 0; q < 2; ++q) { const v4u z = *(const v4u*)(zp + q * 8); const f32x4 w0 = *(const f32x4*)(onw + sub * 16 + q * 8), w1 = *(const f32x4*)(onw + sub * 16 + q * 8 + 4);
        v4u y; y.x = pk2(o[q * 8 + 0] * rstd * w0.x * siluf_(bflo(z.x)), o[q * 8 + 1] * rstd * w0.y * siluf_(bfhi(z.x)));
        y.y = pk2(o[q * 8 + 2] * rstd * w0.z * siluf_(bflo(z.y)), o[q * 8 + 3] * rstd * w0.w * siluf_(bfhi(z.y)));
        y.z = pk2(o[q * 8 + 4] * rstd * w1.x * siluf_(bflo(z.z)), o[q * 8 + 5] * rstd * w1.y * siluf_(bfhi(z.z)));
        y.w = pk2(o[q * 8 + 6] * rstd * w1.z * siluf_(bflo(z.w)), o[q * 8 + 7] * rstd * w1.w * siluf_(bfhi(z.w)));
        *(v4u*)(yp + q * 8) = y; }
}
__device__ __forceinline__ void ph_dn_simple(KArgs a, const Ctx& c, int l) {
    LAS float* qs = (LAS float*)c.lds; LAS float* ks = qs + 8192; LAS float* vs = ks + 8192; LAS float* os = vs + 8192;
    LAS float* bt = (LAS float*)(c.lds + MISC_OFF + 1024); LAS float* at = bt + 64;
    const float* beta = (const float*)(a->ws + WS_BETA); const float* glog = (const float*)(a->ws + WS_GLOG);
    const int v = c.tid >> 2, kq = c.tid & 3;
    for (int item = c.bid; item < NB * HB; item += c.G) {
        const int b = item >> 2, h = item & 3;
        float S[32];
#pragma unroll
        for (int q = 0; q < 32; ++q) S[q] = 0.f;
        for (int n = 0; n < NCH; ++n) {
            const int t0 = n * DNC;
            __syncthreads();
            dn_load_chunk<128>(a, c, l, b, h, t0, qs, ks, vs);
            if (c.tid < 64) { const int tok = b * SEQ + t0 + c.tid; bt[c.tid] = beta[tok * 4 + h]; at[c.tid] = __expf(glog[tok * 4 + h]); }
            __syncthreads();
            for (int tt = 0; tt < DNC; ++tt) {
                const float a_t = at[tt], b_t = bt[tt];
                float kr[32];
#pragma unroll
                for (int q = 0; q < 8; ++q) { const f32x4 k4 = *(const LAS f32x4*)(ks + tt * 128 + kq * 32 + q * 4); kr[q * 4] = k4.x; kr[q * 4 + 1] = k4.y; kr[q * 4 + 2] = k4.z; kr[q * 4 + 3] = k4.w; }
                float kS = 0.f;
#pragma unroll
                for (int q = 0; q < 32; ++q) kS += kr[q] * S[q];
                kS += shx(kS, 1, c.lane); kS += shx(kS, 2, c.lane);
                const float vn = b_t * (vs[tt * 128 + v] - a_t * kS);
                float o = 0.f;
#pragma unroll
                for (int q = 0; q < 8; ++q) { const f32x4 q4 = *(const LAS f32x4*)(qs + tt * 128 + kq * 32 + q * 4);
                    S[q * 4] = a_t * S[q * 4] + kr[q * 4] * vn; S[q * 4 + 1] = a_t * S[q * 4 + 1] + kr[q * 4 + 1] * vn; S[q * 4 + 2] = a_t * S[q * 4 + 2] + kr[q * 4 + 2] * vn; S[q * 4 + 3] = a_t * S[q * 4 + 3] + kr[q * 4 + 3] * vn;
                    o += (q4.x * S[q * 4] + q4.y * S[q * 4 + 1]) + (q4.z * S[q * 4 + 2] + q4.w * S[q * 4 + 3]); }
                o += shx(o, 1, c.lane); o += shx(o, 2, c.lane);
                if (kq == 0) os[tt * 128 + v] = o;
            }
            __syncthreads();
            dn_store_chunk(a, c, l, b, h, t0, os);
        }
    }
}

struct EpiProj {
    static constexpr bool PERM = true, AFTER_DRAIN = false; unsigned char* ws;
    __device__ __forceinline__ void operator()(const pg8::f32x4 (&acc)[2][2][4][2], const pg8::Unit& u, int wr, int wc, int fr, int fq) const {
        const int pn = u.pn; bf16* base; int ld, ct; bool sg = false;
        if (pn < 6) { base = (bf16*)(ws + WS_QKVA); ld = 1536; ct = pn; } else if (pn < 12) { base = (bf16*)(ws + WS_QKVB); ld = 1536; ct = pn - 6; }
        else if (pn < 14) { base = (bf16*)(ws + WS_ZB); ld = 512; ct = pn - 12; } else { base = (bf16*)(ws + WS_GATES); ld = 2048; ct = pn - 14; sg = true; }
        const int row0 = u.pm * 256 + wr * 64 + fr, col0 = ct * 256 + wc * 32 + 8 * fq;
#pragma unroll
        for (int ai = 0; ai < 2; ++ai)
#pragma unroll
            for (int m = 0; m < 4; ++m) { bf16* rowp = base + (size_t)(row0 + ai * 128 + m * 16) * ld + col0;
#pragma unroll
                for (int bj = 0; bj < 2; ++bj) { f32x4 v0 = acc[ai][bj][m][0], v1 = acc[ai][bj][m][1];
                    if (sg) { v0.x = sigmoidf_(v0.x); v0.y = sigmoidf_(v0.y); v0.z = sigmoidf_(v0.z); v0.w = sigmoidf_(v0.w); v1.x = sigmoidf_(v1.x); v1.y = sigmoidf_(v1.y); v1.z = sigmoidf_(v1.z); v1.w = sigmoidf_(v1.w); }
                    v4u w; w.x = pk2(v0.x, v0.y); w.y = pk2(v0.z, v0.w); w.z = pk2(v1.x, v1.y); w.w = pk2(v1.z, v1.w);
                    *(v4u*)(rowp + bj * 128) = w; } }
    }
};
template <bool SECOND> struct EpiMerge {
    static constexpr bool PERM = true, AFTER_DRAIN = false; unsigned char* ws;
    __device__ __forceinline__ void operator()(const pg8::f32x4 (&acc)[2][2][4][2], const pg8::Unit& u, int wr, int wc, int fr, int fq) const {
        bf16* M = (bf16*)(ws + WS_M); const bf16* GT = (const bf16*)(ws + WS_GATES) + (SECOND ? 1024 : 0);
        const int row0 = u.pm * 256 + wr * 64 + fr, col0 = u.pn * 256 + wc * 32 + 8 * fq;
#pragma unroll
        for (int ai = 0; ai < 2; ++ai)
#pragma unroll
            for (int m = 0; m < 4; ++m) { const size_t row = row0 + ai * 128 + m * 16;
#pragma unroll
                for (int bj = 0; bj < 2; ++bj) { const int col = col0 + bj * 128; const f32x4 v0 = acc[ai][bj][m][0], v1 = acc[ai][bj][m][1];
                    const v4u g = *(const v4u*)(GT + row * 2048 + col);
                    float o[8] = {bflo(g.x) * v0.x, bfhi(g.x) * v0.y, bflo(g.y) * v0.z, bfhi(g.y) * v0.w, bflo(g.z) * v1.x, bfhi(g.z) * v1.y, bflo(g.w) * v1.z, bfhi(g.w) * v1.w};
                    if (SECOND) { const v4u p = *(const v4u*)(M + row * 1024 + col); o[0] += bflo(p.x); o[1] += bfhi(p.x); o[2] += bflo(p.y); o[3] += bfhi(p.y); o[4] += bflo(p.z); o[5] += bfhi(p.z); o[6] += bflo(p.w); o[7] += bfhi(p.w); }
                    v4u w; w.x = pk2(o[0], o[1]); w.y = pk2(o[2], o[3]); w.z = pk2(o[4], o[5]); w.w = pk2(o[6], o[7]);
                    *(v4u*)(M + row * 1024 + col) = w; } }
    }
};
struct EpiOut {
    static constexpr bool PERM = true, AFTER_DRAIN = false; const float* xin; float* xout; const float* g1;
    __device__ __forceinline__ void operator()(const pg8::f32x4 (&acc)[2][2][4][2], const pg8::Unit& u, int wr, int wc, int fr, int fq) const {
        const int row0 = u.pm * 256 + wr * 64 + fr, col0 = u.pn * 256 + wc * 32 + 8 * fq; const int b = (u.pm * 256) >> 12;
#pragma unroll
        for (int bj = 0; bj < 2; ++bj) { const int col = col0 + bj * 128; const f32x4 ga = *(const f32x4*)(g1 + b * 6144 + col), gb = *(const f32x4*)(g1 + b * 6144 + col + 4);
#pragma unroll
            for (int ai = 0; ai < 2; ++ai)
#pragma unroll
                for (int m = 0; m < 4; ++m) { const size_t off = (size_t)(row0 + ai * 128 + m * 16) * DM + col;
                    const f32x4 x0 = *(const f32x4*)(xin + off), x1 = *(const f32x4*)(xin + off + 4);
                    *(f32x4*)(xout + off) = x0 + ga * acc[ai][bj][m][0]; *(f32x4*)(xout + off + 4) = x1 + gb * acc[ai][bj][m][1]; } }
    }
};
struct EpiMoeGU {
    static constexpr bool PERM = true, AFTER_DRAIN = false; unsigned char* ws;
    __device__ __forceinline__ void operator()(const pg8::f32x4 (&acc)[2][2][4][2], const pg8::Unit& u, int wr, int wc, int fr, int fq) const {
        bf16* ACT = (bf16*)(ws + WS_ACT);
        const int row0 = u.pm * 256 + wr * 64 + fr, col0 = (u.pn & 1) * 128 + wc * 32 + 8 * fq;
#pragma unroll
        for (int ai = 0; ai < 2; ++ai)
#pragma unroll
            for (int m = 0; m < 4; ++m) { const f32x4 g0 = acc[ai][0][m][0], g1 = acc[ai][0][m][1], u0 = acc[ai][1][m][0], u1 = acc[ai][1][m][1];
                v4u w; w.x = pk2(siluf_(g0.x) * u0.x, siluf_(g0.y) * u0.y); w.y = pk2(siluf_(g0.z) * u0.z, siluf_(g0.w) * u0.w); w.z = pk2(siluf_(g1.x) * u1.x, siluf_(g1.y) * u1.y); w.w = pk2(siluf_(g1.z) * u1.z, siluf_(g1.w) * u1.w);
                *(v4u*)(ACT + (size_t)(row0 + ai * 128 + m * 16) * 256 + col0) = w; }
    }
};
struct EpiMoeDown {
    static constexpr bool PERM = true, AFTER_DRAIN = false; unsigned char* ws;
    __device__ __forceinline__ void operator()(const pg8::f32x4 (&acc)[2][2][4][2], const pg8::Unit& u, int wr, int wc, int fr, int fq) const {
        bf16* YS = (bf16*)(ws + WS_YS); const int* rowtok = (const int*)(ws + WS_ROWTOK); const float* roww = (const float*)(ws + WS_ROWW);
        const int row0 = u.pm * 256 + wr * 64 + fr, col0 = (u.pn & 3) * 256 + wc * 32 + 8 * fq;
#pragma unroll
        for (int ai = 0; ai < 2; ++ai)
#pragma unroll
            for (int m = 0; m < 4; ++m) { const int row = row0 + ai * 128 + m * 16; const int rt = rowtok[row]; const float wgt = roww[row];
                if (rt >= 0) {
#pragma unroll
                    for (int bj = 0; bj < 2; ++bj) { const f32x4 v0 = acc[ai][bj][m][0] * wgt, v1 = acc[ai][bj][m][1] * wgt;
                        v4u w; w.x = pk2(v0.x, v0.y); w.y = pk2(v0.z, v0.w); w.z = pk2(v1.x, v1.y); w.w = pk2(v1.z, v1.w);
                        *(v4u*)(YS + (size_t)rt * 1024 + col0 + bj * 128) = w; } } }
    }
};
struct MoeOrder {
    const LAS int* tile_exp; int nunits, G, c, sh;
    __device__ __forceinline__ bool next(int i, pg8::Unit& u) const {
        const int L = i * G + c; if (L >= nunits) return false;
        const int r = L >> sh, j = L & ((1 << sh) - 1);
        u.pm = r; u.pn = __builtin_amdgcn_readfirstlane((tile_exp[r] << sh) + j); return true;
    }
    __device__ __forceinline__ void a_ready(const pg8::Unit&) const {}
    __device__ __forceinline__ void done(const pg8::Unit&) const {}
};

__device__ __forceinline__ void ph_router(KArgs a, const Ctx& c, int l) {
    LAS int* lcnt = (LAS int*)(c.lds + MISC_OFF + 1024);
    LAS int* lbase = lcnt + 32;
    LAS int* tinf = lcnt + 64;
    LAS float* wreT = (LAS float*)c.lds;
    const int lane = c.lane;
    bf16* H2 = (bf16*)(a->ws + WS_H); unsigned* tokinfo = (unsigned*)(a->ws + WS_TOKINFO); int* rowtok = (int*)(a->ws + WS_ROWTOK);
    unsigned* gcnt = (unsigned*)(a->ws + WS_CTL) + CW_GCNT + l * 32;
    const float* n2w = a->in[I_N2W] + l * DM; const float* wrg = a->in[I_WRG] + (size_t)l * 1024 * 4; const float* wre = a->in[I_WRE] + (size_t)l * 1024 * 32;
    for (int i = c.bid * NTHR + c.tid; i < MOE_MAXROWS; i += c.G * NTHR) rowtok[i] = -1;
    for (int i = c.tid; i < 8192; i += NTHR) { const int k = i >> 3, n4 = (i & 7) * 4; const f32x4 w = *(const f32x4*)(wre + (size_t)k * 32 + n4);
        wreT[(n4 + 0) * 1024 + k] = w.x; wreT[(n4 + 1) * 1024 + k] = w.y; wreT[(n4 + 2) * 1024 + k] = w.z; wreT[(n4 + 3) * 1024 + k] = w.w; }
    for (int tb = c.bid; tb < NTOK / 64; tb += c.G) {
        __syncthreads();
        if (c.tid < 32) lcnt[c.tid] = 0;
        __syncthreads();
        for (int i = 0; i < 8; ++i) {
            const int tl = c.wave * 8 + i, m = tb * 64 + tl, b = m >> 12;
            const float* xr = (const float*)a->out + (size_t)m * DM; const float* mod = (const float*)(a->ws + WS_MOD) + (l * 4 + b) * 6144;
            f32x4 h[4];
#pragma unroll
            for (int j = 0; j < 4; ++j) h[j] = *(const f32x4*)(xr + 256 * j + 4 * lane);
            const float rstd = row_rstd(h, lane);
            float ag[4] = {0.f, 0.f, 0.f, 0.f};
#pragma unroll
            for (int j = 0; j < 4; ++j) { const int col = 256 * j + 4 * lane;
                const f32x4 nw = *(const f32x4*)(n2w + col), sh = *(const f32x4*)(mod + 3072 + col), sc = *(const f32x4*)(mod + 4096 + col);
                h[j] = h[j] * rstd * nw * (sc + 1.0f) + sh;
                v2u o; o.x = pk2(h[j].x, h[j].y); o.y = pk2(h[j].z, h[j].w); *(v2u*)(H2 + (size_t)m * DM + col) = o;
                const f32x4 r0 = *(const f32x4*)(wrg + (size_t)(col + 0) * 4), r1 = *(const f32x4*)(wrg + (size_t)(col + 1) * 4), r2 = *(const f32x4*)(wrg + (size_t)(col + 2) * 4), r3 = *(const f32x4*)(wrg + (size_t)(col + 3) * 4);
                ag[0] += h[j].x * r0.x + h[j].y * r1.x + h[j].z * r2.x + h[j].w * r3.x; ag[1] += h[j].x * r0.y + h[j].y * r1.y + h[j].z * r2.y + h[j].w * r3.y;
                ag[2] += h[j].x * r0.z + h[j].y * r1.z + h[j].z * r2.z + h[j].w * r3.z; ag[3] += h[j].x * r0.w + h[j].y * r1.w + h[j].z * r2.w + h[j].w * r3.w; }
#pragma unroll
            for (int q = 0; q < 4; ++q) ag[q] = wave_sum(ag[q], lane) + a->in[I_BRG][l * 4 + q];
            int g = 0; float gm = ag[0];
#pragma unroll
            for (int q = 1; q < 4; ++q) if (ag[q] > gm) { gm = ag[q]; g = q; }
            float den = 0.f;
#pragma unroll
            for (int q = 0; q < 4; ++q) den += __expf(ag[q] - gm);
            const float ptop = 1.f / den;
            float ae[8] = {0.f, 0.f, 0.f, 0.f, 0.f, 0.f, 0.f, 0.f};
#pragma unroll
            for (int j = 0; j < 4; ++j) { const int col = 256 * j + 4 * lane;
#pragma unroll
                for (int e = 0; e < 8; ++e) { const f32x4 w = *(const LAS f32x4*)(wreT + (g * 8 + e) * 1024 + col); ae[e] += (h[j].x * w.x + h[j].y * w.y) + (h[j].z * w.z + h[j].w * w.w); } }
#pragma unroll
            for (int q = 0; q < 8; ++q) ae[q] = wave_sum(ae[q], lane) + a->in[I_BRE][l * 32 + g * 8 + q];
            int e0 = 0; float v0 = ae[0];
#pragma unroll
            for (int q = 1; q < 8; ++q) if (ae[q] > v0) { v0 = ae[q]; e0 = q; }
            int e1 = -1; float v1 = -3e38f;
#pragma unroll
            for (int q = 0; q < 8; ++q) if (q != e0 && ae[q] > v1) { v1 = ae[q]; e1 = q; }
            const float ex = __expf(v1 - v0); const float w0 = ptop / (1.f + ex), w1 = ptop * ex / (1.f + ex);
            if (lane == 0) { const int E0 = g * 8 + e0, E1 = g * 8 + e1;
                const int r0 = atomicAdd((int*)(lcnt + E0), 1), r1 = atomicAdd((int*)(lcnt + E1), 1);
                tinf[tl * 6 + 0] = E0; tinf[tl * 6 + 1] = E1; tinf[tl * 6 + 2] = r0; tinf[tl * 6 + 3] = r1; tinf[tl * 6 + 4] = __float_as_int(w0); tinf[tl * 6 + 5] = __float_as_int(w1); }
        }
        __syncthreads();
        if (c.tid < 32) lbase[c.tid] = (int)__hip_atomic_fetch_add(gcnt + c.tid, (unsigned)lcnt[c.tid], RLX_AGENT);
        __syncthreads();
        if (c.tid < 64) { const int m = tb * 64 + c.tid; const int E0 = tinf[c.tid * 6], E1 = tinf[c.tid * 6 + 1];
            v4u o; o.x = (unsigned)E0; o.y = (unsigned)E1; o.z = (unsigned)(lbase[E0] + tinf[c.tid * 6 + 2]); o.w = (unsigned)(lbase[E1] + tinf[c.tid * 6 + 3]);
            *(v4u*)(tokinfo + (size_t)m * 8) = o; *(v2u*)(tokinfo + (size_t)m * 8 + 4) = (v2u){(unsigned)tinf[c.tid * 6 + 4], (unsigned)tinf[c.tid * 6 + 5]}; }
    }
}
__device__ __forceinline__ void moe_table(KArgs a, const Ctx& c, int l) {
    LAS int* tile_exp = (LAS int*)(c.lds + MISC_OFF + 2048); LAS int* offs = tile_exp + 192; LAS int* ntl = offs + 32; LAS int* pre = ntl + 4;
    const unsigned* gcnt = (const unsigned*)(a->ws + WS_CTL) + CW_GCNT + l * 32;
    __syncthreads();
    if (c.tid < 64) { const int e = c.tid & 31; const int cnt = (int)__hip_atomic_load(gcnt + e, RLX_AGENT); const int nt = (cnt + 255) >> 8; int inc = nt;
#pragma unroll
        for (int o = 1; o < 32; o <<= 1) { const int v = shidx_i(inc, (c.lane - o) & 63); if (e >= o) inc += v; }
        if (c.tid < 32) { offs[e] = (inc - nt) * 256; pre[e] = inc; if (e == 31) ntl[0] = inc; } }
    __syncthreads();
    if (c.tid < MOE_MAXTILES) { int E = 0;
#pragma unroll
        for (int e = 0; e < 32; ++e) E += (pre[e] <= c.tid) ? 1 : 0;
        tile_exp[c.tid] = E < 31 ? E : 31; }
    __syncthreads();
}
__device__ __forceinline__ void ph_gather(KArgs a, const Ctx& c, int l) {
    moe_table(a, c, l);
    const LAS int* offs = (const LAS int*)(c.lds + MISC_OFF + 2048) + 192;
    const int gw = c.bid * NW + c.wave, NGW = c.G * NW, lane = c.lane;
    const bf16* H2 = (const bf16*)(a->ws + WS_H); bf16* HS = (bf16*)(a->ws + WS_HS); const unsigned* tokinfo = (const unsigned*)(a->ws + WS_TOKINFO);
    int* rowtok = (int*)(a->ws + WS_ROWTOK); float* roww = (float*)(a->ws + WS_ROWW);
    for (int m = gw; m < NTOK; m += NGW) {
        const v4u ti = *(const v4u*)(tokinfo + (size_t)m * 8); const v2u tw = *(const v2u*)(tokinfo + (size_t)m * 8 + 4);
        const int d0 = offs[ti.x] + (int)ti.z, d1 = offs[ti.y] + (int)ti.w;
        const v4u x0 = *(const v4u*)(H2 + (size_t)m * DM + lane * 8), x1 = *(const v4u*)(H2 + (size_t)m * DM + 512 + lane * 8);
        *(v4u*)(HS + (size_t)d0 * DM + lane * 8) = x0; *(v4u*)(HS + (size_t)d0 * DM + 512 + lane * 8) = x1;
        *(v4u*)(HS + (size_t)d1 * DM + lane * 8) = x0; *(v4u*)(HS + (size_t)d1 * DM + 512 + lane * 8) = x1;
        if (lane == 0) { rowtok[d0] = m * 2; rowtok[d1] = m * 2 + 1; roww[d0] = __uint_as_float(tw.x); roww[d1] = __uint_as_float(tw.y); }
    }
}
constexpr int DN_IMG = 57344, DN_LDW = 132, DN_LDA = 68;
typedef __bf16 bf16x2_t __attribute__((ext_vector_type(2)));
typedef float f32x2_t __attribute__((ext_vector_type(2)));
__device__ __forceinline__ unsigned cvtpk(float lo, float hi) { f32x2_t v = {lo, hi}; bf16x2_t b = __builtin_convertvector(v, bf16x2_t); return __builtin_bit_cast(unsigned, b); }
__device__ __forceinline__ bf16x8 pack8(f32x4 a, f32x4 b) { v4u w; w.x = cvtpk(a.x, a.y); w.y = cvtpk(a.z, a.w); w.z = cvtpk(b.x, b.y); w.w = cvtpk(b.z, b.w); return __builtin_bit_cast(bf16x8, w); }
#define MFMA16(a, b, c) __builtin_amdgcn_mfma_f32_16x16x32_bf16((a), (b), (c), 0, 0, 0)

__device__ __forceinline__ void dn_load_chunk2(KArgs a, const Ctx& c, int l, int b, int h, int t0, LAS float* qs, LAS float* ks, LAS float* vs) {
    const bf16* QKVB = (const bf16*)(a->ws + WS_QKVB); const float* cw = a->in[I_CONVW] + (size_t)l * 4 * 1536;
    const int cg = c.tid & 15, rg = c.tid >> 4, tA = t0 + 2 * rg - 3;
    v4u raw[3][5];
#pragma unroll
    for (int part = 0; part < 3; ++part)
#pragma unroll
        for (int i = 0; i < 5; ++i) { const int tt = tA + i; raw[part][i] = (v4u){0u, 0u, 0u, 0u};
            if (tt >= 0) raw[part][i] = *(const v4u*)(QKVB + (size_t)(b * SEQ + tt) * 1536 + part * 512 + h * 128 + 8 * cg); }
#pragma unroll
    for (int part = 0; part < 3; ++part) {
        const int colb = part * 512 + h * 128 + 8 * cg;
        float w[4][8];
#pragma unroll
        for (int i = 0; i < 4; ++i) { const f32x4 w0 = *(const f32x4*)(cw + i * 1536 + colb), w1 = *(const f32x4*)(cw + i * 1536 + colb + 4);
            w[i][0] = w0.x; w[i][1] = w0.y; w[i][2] = w0.z; w[i][3] = w0.w; w[i][4] = w1.x; w[i][5] = w1.y; w[i][6] = w1.z; w[i][7] = w1.w; }
        LAS float* dst = part == 0 ? qs : part == 1 ? ks : vs;
#pragma unroll
        for (int rr = 0; rr < 2; ++rr) {
            float y[8];
#pragma unroll
            for (int e = 0; e < 8; ++e) y[e] = 0.f;
#pragma unroll
            for (int i = 0; i < 4; ++i) { const v4u x = raw[part][rr + i];
                y[0] += w[i][0] * bflo(x.x); y[1] += w[i][1] * bfhi(x.x); y[2] += w[i][2] * bflo(x.y); y[3] += w[i][3] * bfhi(x.y); y[4] += w[i][4] * bflo(x.z); y[5] += w[i][5] * bfhi(x.z); y[6] += w[i][6] * bflo(x.w); y[7] += w[i][7] * bfhi(x.w); }
            float ss = 0.f;
#pragma unroll
            for (int e = 0; e < 8; ++e) { y[e] = siluf_(y[e]); ss += y[e] * y[e]; }
            if (part < 2) { ss += dpp_f<0xB1>(ss); ss += dpp_f<0x4E>(ss); ss += dpp_f<0x141>(ss); ss += dpp_f<0x140>(ss);
                const float rs = __builtin_amdgcn_rsqf(ss + EPS) * (part == 0 ? 0.08838834764831845f : 1.f);
#pragma unroll
                for (int e = 0; e < 8; ++e) y[e] *= rs; }
            const int r = 2 * rg + rr;
            *(LAS f32x4*)(dst + r * DN_LDW + 8 * cg) = (f32x4){y[0], y[1], y[2], y[3]}; *(LAS f32x4*)(dst + r * DN_LDW + 8 * cg + 4) = (f32x4){y[4], y[5], y[6], y[7]};
        }
    }
}

__device__ __forceinline__ void ph_dn_prep(KArgs a, const Ctx& c, int l) {
    LAS float* qs = (LAS float*)c.lds; LAS float* ks = qs + 64 * DN_LDW; LAS float* vs = ks + 64 * DN_LDW;
    LAS float* Am = vs + 64 * DN_LDW; LAS float* Pm = Am + 64 * DN_LDA;
    LAS float* bt = (LAS float*)(c.lds + MISC_OFF + 1024); LAS float* Gc = bt + 64;
    const float* beta = (const float*)(a->ws + WS_BETA); const float* glog = (const float*)(a->ws + WS_GLOG);
    for (int item = c.bid; item < NB * HB * NCH; item += c.G) {
        int tid = c.tid; asm volatile("" : "+v"(tid));
        const int lane = tid & 63, row = lane & 15, quad = lane >> 4;
        const int n = item & 63, h = (item >> 6) & 3, b = item >> 8, t0 = n * DNC;
        unsigned char* img = a->ws + WS_IMG + (size_t)item * DN_IMG;
        __syncthreads();
        dn_load_chunk2(a, c, l, b, h, t0, qs, ks, vs);
        if (tid < 64) { const int tok = b * SEQ + t0 + tid; bt[tid] = beta[tok * 4 + h]; float g = glog[tok * 4 + h];
#pragma unroll
            for (int o = 1; o < 64; o <<= 1) { const float v = shidx(g, (lane - o) & 63); if (lane >= o) g += v; }
            Gc[tid] = g; }
        __syncthreads();
        {   const int sel = c.wave >> 2, ti = c.wave & 3; const LAS float* rs = sel == 0 ? ks : qs; LAS float* dstm = sel == 0 ? Am : Pm;
            bf16x8 af[4];
#pragma unroll
            for (int s = 0; s < 4; ++s) { const LAS float* p = rs + (ti * 16 + row) * DN_LDW + 32 * s + 8 * quad; af[s] = pack8(*(const LAS f32x4*)p, *(const LAS f32x4*)(p + 4)); }
            for (int tj = 0; tj < 4; ++tj) {
                f32x4 acc = {0.f, 0.f, 0.f, 0.f};
                if (tj <= ti) {
#pragma unroll
                    for (int s = 0; s < 4; ++s) { const LAS float* p = ks + (tj * 16 + row) * DN_LDW + 32 * s + 8 * quad; const bf16x8 bfr = pack8(*(const LAS f32x4*)p, *(const LAS f32x4*)(p + 4)); acc = MFMA16(af[s], bfr, acc); }
                }
                const int j = tj * 16 + row; const float Gj = Gc[j];
#pragma unroll
                for (int r = 0; r < 4; ++r) { const int i = ti * 16 + 4 * quad + r; const float dec = __expf(fminf(Gc[i] - Gj, 0.f));
                    float v = acc[r] * dec; if (sel == 0) v = (j < i) ? v * bt[i] : 0.f; else v = (j <= i) ? v : 0.f;
                    dstm[i * DN_LDA + j] = v; }
            }
        }
        __syncthreads();
        const float Glast = Gc[63];
        {
            for (int q = 0; q < 5; ++q) { const int p = tid + 512 * q, blk = p >> 6; float v[8];
                if (blk < 16) { const int mt = blk >> 2, s = blk & 3, cr = 16 * mt + row, k0 = 32 * s + 4 * quad; const float e = __expf(Gc[cr]);
                    const f32x4 v0 = *(const LAS f32x4*)(qs + cr * DN_LDW + k0), v1 = *(const LAS f32x4*)(qs + cr * DN_LDW + k0 + 16);
                    v[0] = v0.x * e; v[1] = v0.y * e; v[2] = v0.z * e; v[3] = v0.w * e; v[4] = v1.x * e; v[5] = v1.y * e; v[6] = v1.z * e; v[7] = v1.w * e; }
                else if (blk < 32) { const int b2 = blk - 16, mt = b2 >> 1, s = b2 & 1, k = 16 * mt + row;
#pragma unroll
                    for (int j = 0; j < 8; ++j) { const int cj = 32 * s + 16 * (j >> 2) + 4 * quad + (j & 3); v[j] = ks[cj * DN_LDW + k] * __expf(Glast - Gc[cj]); } }
                else { const int b3 = blk - 32, mt = b3 >> 1, s = b3 & 1, i = 16 * mt + row, c0 = 32 * s + 4 * quad;
                    const f32x4 v0 = *(const LAS f32x4*)(Pm + i * DN_LDA + c0), v1 = *(const LAS f32x4*)(Pm + i * DN_LDA + c0 + 16);
                    v[0] = v0.x; v[1] = v0.y; v[2] = v0.z; v[3] = v0.w; v[4] = v1.x; v[5] = v1.y; v[6] = v1.z; v[7] = v1.w; }
                v4u w; w.x = cvtpk(v[0], v[1]); w.y = cvtpk(v[2], v[3]); w.z = cvtpk(v[4], v[5]); w.w = cvtpk(v[6], v[7]);
                *(v4u*)(img + 16384 + (size_t)p * 16) = w; }
            if (tid == 0) ((float*)(a->ws + WS_GL))[item] = __expf(Glast);
        }
        __syncthreads();
        for (int q = 0; q < 32; ++q) { const int e = tid + 512 * q, i = e >> 8, cc = e & 255; const float sc = bt[i];
            if (cc < 128) vs[i * DN_LDW + cc] *= sc; else ks[i * DN_LDW + cc - 128] *= sc * __expf(Gc[i]); }
        __syncthreads();
#pragma unroll
        for (int bI = 0; bI < 4; ++bI) {
            if (bI > 0) {
#pragma unroll
                for (int q = 0; q < 2; ++q) { const int nt = 2 * c.wave + q; LAS float* xb = (nt < 8 ? vs : ks) + (nt & 7) * 16;
                    f32x4 acc = {0.f, 0.f, 0.f, 0.f};
#pragma unroll
                    for (int s2 = 0; s2 < (bI == 3 ? 2 : 1); ++s2) { const int j0 = 32 * s2 + 8 * quad;
                        f32x4 a0 = *(const LAS f32x4*)(Am + (16 * bI + row) * DN_LDA + j0), a1 = *(const LAS f32x4*)(Am + (16 * bI + row) * DN_LDA + j0 + 4);
                        if (j0 >= 16 * bI) { a0 = (f32x4){0.f, 0.f, 0.f, 0.f}; a1 = a0; }
                        float xv[8];
#pragma unroll
                        for (int j = 0; j < 8; ++j) xv[j] = xb[(j0 + j) * DN_LDW + row];
                        const bf16x8 af = pack8(a0, a1), bfr = pack8((f32x4){xv[0], xv[1], xv[2], xv[3]}, (f32x4){xv[4], xv[5], xv[6], xv[7]});
                        acc = MFMA16(af, bfr, acc); }
#pragma unroll
                    for (int r = 0; r < 4; ++r) xb[(16 * bI + 4 * quad + r) * DN_LDW + row] -= acc[r]; }
                __syncthreads();
            }
            if (tid < 256) { LAS float* xc = (tid < 128 ? vs : ks) + (tid & 127); float sv[16];
                int vz = 0; asm volatile("" : "+v"(vz)); const LAS float* AmV = Am + vz;
#pragma unroll
                for (int r = 0; r < 16; ++r) sv[r] = xc[(16 * bI + r) * DN_LDW];
#pragma unroll
                for (int rp = 0; rp < 15; ++rp)
#pragma unroll
                    for (int r = rp + 1; r < 16; ++r) sv[r] -= AmV[(16 * bI + r) * DN_LDA + 16 * bI + rp] * sv[rp];
#pragma unroll
                for (int r = 1; r < 16; ++r) xc[(16 * bI + r) * DN_LDW] = sv[r]; }
            __syncthreads();
        }
#pragma unroll
        for (int q = 0; q < 2; ++q) { const int p = tid + 512 * q, blk = p >> 6, mt = blk >> 2, s = blk & 3, cr = 16 * mt + row, k0 = 32 * s + 4 * quad;
            const f32x4 v0 = *(const LAS f32x4*)(ks + cr * DN_LDW + k0), v1 = *(const LAS f32x4*)(ks + cr * DN_LDW + k0 + 16);
            v4u w; w.x = cvtpk(-v0.x, -v0.y); w.y = cvtpk(-v0.z, -v0.w); w.z = cvtpk(-v1.x, -v1.y); w.w = cvtpk(-v1.z, -v1.w);
            *(v4u*)(img + (size_t)p * 16) = w; }
        {   unsigned char* ug = a->ws + WS_U + (size_t)item * 16384;
#pragma unroll
            for (int q = 0; q < 2; ++q) { const int p = tid + 512 * q, sl = p >> 7, ln = (p >> 1) & 63, hh = p & 1, v = 16 * sl + (ln & 15), qd = ln >> 4; float u8[8];
#pragma unroll
                for (int e = 0; e < 8; ++e) u8[e] = vs[(16 * (2 * hh + (e >> 2)) + 4 * qd + (e & 3)) * DN_LDW + v];
                v4u w; w.x = cvtpk(u8[0], u8[1]); w.y = cvtpk(u8[2], u8[3]); w.z = cvtpk(u8[4], u8[5]); w.w = cvtpk(u8[6], u8[7]);
                *(v4u*)(ug + (size_t)(sl * 64 + ln) * 32 + hh * 16) = w; } }
    }
}

constexpr int DN_OS = 2 * DN_IMG;
__device__ __forceinline__ void ph_dn_scan(KArgs a, const Ctx& c, int l) {
    LAS unsigned char* lds = c.lds;
    const int lane = c.lane, wv = c.wave, tid = c.tid; const bool cw = wv < 4;
    const bf16* ZB = (const bf16*)(a->ws + WS_ZB); bf16* YB = (bf16*)(a->ws + WS_YB); const float* onw = a->in[I_ONW] + l * 128; const float* glp = (const float*)(a->ws + WS_GL);
    for (int item = c.bid; item < NB * HB; item += c.G) {
        const int b = item >> 2, h = item & 3;
        const unsigned char* img0 = a->ws + WS_IMG + (size_t)item * 64 * DN_IMG;
        __syncthreads();
        if (cw) {
            const unsigned char* ugb = a->ws + WS_U + (size_t)item * 64 * 16384; const unsigned uoff = (unsigned)(2 * wv * 64 + lane) * 32u;
            f32x4 S[8][2];
#pragma unroll
            for (int m = 0; m < 8; ++m) { S[m][0] = (f32x4){0.f, 0.f, 0.f, 0.f}; S[m][1] = (f32x4){0.f, 0.f, 0.f, 0.f}; }
            v4u uc[4];
#pragma unroll
            for (int q = 0; q < 4; ++q) uc[q] = *(const v4u*)(ugb + uoff + (q >> 1) * 2048 + (q & 1) * 16);
#if MK_PROBE_A == 22 || MK_PROBE_A == 23
            unsigned tpa = 0, tq = (unsigned)__builtin_amdgcn_s_memrealtime();
#define DN_TICK(w) do { const unsigned t_ = (unsigned)__builtin_amdgcn_s_memrealtime(); if ((w) == MK_PROBE_A - 22) tpa += t_ - tq; tq = t_; } while (0)
#else
#define DN_TICK(w) do {} while (0)
#endif
            for (int n = 0; n <= NCH; ++n) {
                asm volatile("s_waitcnt lgkmcnt(0)\n\ts_barrier" ::: "memory");
                DN_TICK(0);
                if (n == NCH) break;
                v4u un[4];
#pragma unroll
                for (int q = 0; q < 4; ++q) un[q] = uc[q];
                if (n + 1 < NCH) {
#pragma unroll
                    for (int q = 0; q < 4; ++q) un[q] = *(const v4u*)(ugb + (size_t)(n + 1) * 16384 + uoff + (q >> 1) * 2048 + (q & 1) * 16); }
                const float gl = glp[item * 64 + n];
                const LAS unsigned char* im = lds + (n & 1) * DN_IMG + lane * 16;
                bf16x8 Sb[4][2];
#pragma unroll
                for (int s = 0; s < 4; ++s) { Sb[s][0] = pack8(S[2 * s][0], S[2 * s + 1][0]); Sb[s][1] = pack8(S[2 * s][1], S[2 * s + 1][1]); }
                f32x4 X[4][2];
#pragma unroll
                for (int nt = 0; nt < 2; ++nt) { const v4u u0 = uc[2 * nt], u1 = uc[2 * nt + 1];
                    X[0][nt] = (f32x4){bflo(u0.x), bfhi(u0.x), bflo(u0.y), bfhi(u0.y)}; X[1][nt] = (f32x4){bflo(u0.z), bfhi(u0.z), bflo(u0.w), bfhi(u0.w)};
                    X[2][nt] = (f32x4){bflo(u1.x), bfhi(u1.x), bflo(u1.y), bfhi(u1.y)}; X[3][nt] = (f32x4){bflo(u1.z), bfhi(u1.z), bflo(u1.w), bfhi(u1.w)}; }
                bf16x8 fa[8], fb[8];
#define DN_LDF(arr, off) do { _Pragma("unroll") for (int q_ = 0; q_ < 8; ++q_) arr[q_] = *(const LAS bf16x8*)(im + (off) + q_ * 1024); } while (0)
                DN_LDF(fa, 0); DN_LDF(fb, 8192);
#pragma unroll
                for (int mt = 0; mt < 2; ++mt)
#pragma unroll
                    for (int s = 0; s < 4; ++s) { X[mt][0] = MFMA16(fa[mt * 4 + s], Sb[s][0], X[mt][0]); X[mt][1] = MFMA16(fa[mt * 4 + s], Sb[s][1], X[mt][1]); }
                DN_LDF(fa, 16384);
#pragma unroll
                for (int mt = 0; mt < 2; ++mt)
#pragma unroll
                    for (int s = 0; s < 4; ++s) { X[2 + mt][0] = MFMA16(fb[mt * 4 + s], Sb[s][0], X[2 + mt][0]); X[2 + mt][1] = MFMA16(fb[mt * 4 + s], Sb[s][1], X[2 + mt][1]); }
                DN_LDF(fb, 16384 + 8192);
                f32x4 O[4][2];
#pragma unroll
                for (int mt = 0; mt < 2; ++mt) { O[mt][0] = (f32x4){0.f, 0.f, 0.f, 0.f}; O[mt][1] = (f32x4){0.f, 0.f, 0.f, 0.f};
#pragma unroll
                    for (int s = 0; s < 4; ++s) { O[mt][0] = MFMA16(fa[mt * 4 + s], Sb[s][0], O[mt][0]); O[mt][1] = MFMA16(fa[mt * 4 + s], Sb[s][1], O[mt][1]); } }
                DN_LDF(fa, 32768);
#pragma unroll
                for (int mt = 0; mt < 2; ++mt) { O[2 + mt][0] = (f32x4){0.f, 0.f, 0.f, 0.f}; O[2 + mt][1] = (f32x4){0.f, 0.f, 0.f, 0.f};
#pragma unroll
                    for (int s = 0; s < 4; ++s) { O[2 + mt][0] = MFMA16(fb[mt * 4 + s], Sb[s][0], O[2 + mt][0]); O[2 + mt][1] = MFMA16(fb[mt * 4 + s], Sb[s][1], O[2 + mt][1]); } }
                DN_LDF(fb, 32768 + 8192);
                bf16x8 Xb[2][2];
#pragma unroll
                for (int nt = 0; nt < 2; ++nt) { Xb[0][nt] = pack8(X[0][nt], X[1][nt]); Xb[1][nt] = pack8(X[2][nt], X[3][nt]); }
#pragma unroll
                for (int m = 0; m < 4; ++m) { S[m][0] = S[m][0] * gl; S[m][1] = S[m][1] * gl;
#pragma unroll
                    for (int s = 0; s < 2; ++s) { S[m][0] = MFMA16(fa[m * 2 + s], Xb[s][0], S[m][0]); S[m][1] = MFMA16(fa[m * 2 + s], Xb[s][1], S[m][1]); } }
                DN_LDF(fa, 49152);
#pragma unroll
                for (int m = 0; m < 4; ++m) { S[4 + m][0] = S[4 + m][0] * gl; S[4 + m][1] = S[4 + m][1] * gl;
#pragma unroll
                    for (int s = 0; s < 2; ++s) { S[4 + m][0] = MFMA16(fb[m * 2 + s], Xb[s][0], S[4 + m][0]); S[4 + m][1] = MFMA16(fb[m * 2 + s], Xb[s][1], S[4 + m][1]); } }
#pragma unroll
                for (int mt = 0; mt < 4; ++mt)
#pragma unroll
                    for (int s = 0; s < 2; ++s) { O[mt][0] = MFMA16(fa[mt * 2 + s], Xb[s][0], O[mt][0]); O[mt][1] = MFMA16(fa[mt * 2 + s], Xb[s][1], O[mt][1]); }
#undef DN_LDF
                LAS unsigned short* os = (LAS unsigned short*)(lds + DN_OS + (n & 1) * 16384);
#pragma unroll
                for (int mt = 0; mt < 4; ++mt)
#pragma unroll
                    for (int nt = 0; nt < 2; ++nt)
#pragma unroll
                        for (int r = 0; r < 4; ++r) os[(16 * mt + 4 * (lane >> 4) + r) * 128 + 32 * wv + 16 * nt + (lane & 15)] = (unsigned short)(cvtpk(O[mt][nt][r], 0.f) & 0xffffu);
#pragma unroll
                for (int q = 0; q < 4; ++q) uc[q] = un[q];
                asm volatile("s_waitcnt lgkmcnt(0)" ::: "memory"); DN_TICK(1);
            }
#if MK_PROBE_A == 22 || MK_PROBE_A == 23
            if (blockIdx.x == 0 && tid == 0) { unsigned long long* tsx = (unsigned long long*)((unsigned*)(a->ws + WS_CTL) + 12288) + 48 + l * 4; tsx[MK_PROBE_A - 22] = tpa; }
#endif
        } else {
            const int ht = tid - 256, hw = wv - 4, nr = ht >> 2, nq = ht & 3;
            const bf16* zpb = ZB + (size_t)(b * SEQ) * 512 + h * 128; bf16* ypb = YB + (size_t)(b * SEQ) * 512 + h * 128; const unsigned zoff = (unsigned)(nr * 512 + nq * 32);
#define DN_DMA(n, buf) do { _Pragma("unroll") for (int q_ = 0; q_ < 14; ++q_) { const int pc_ = hw + 4 * q_; \
                __builtin_amdgcn_global_load_lds((const unsigned*)(img0 + (size_t)(n) * DN_IMG + pc_ * 1024 + lane * 16), (LAS unsigned*)(lds + (buf) * DN_IMG + pc_ * 1024), 16, 0, 0); } } while (0)
            DN_DMA(0, 0);
            v4u zc[4];
#pragma unroll
            for (int q = 0; q < 4; ++q) zc[q] = *(const v4u*)(zpb + zoff + q * 8);
            asm volatile("s_waitcnt vmcnt(0) lgkmcnt(0)\n\ts_barrier" ::: "memory");
            DN_DMA(1, 1);
            for (int n = 1; n <= NCH; ++n) {
                if (n == 1) asm volatile("s_waitcnt vmcnt(0) lgkmcnt(0)\n\ts_barrier" ::: "memory"); else asm volatile("s_waitcnt vmcnt(4) lgkmcnt(0)\n\ts_barrier" ::: "memory");
                v4u zn[4];
#pragma unroll
                for (int q = 0; q < 4; ++q) zn[q] = zc[q];
                if (n < NCH) {
#pragma unroll
                    for (int q = 0; q < 4; ++q) zn[q] = *(const v4u*)(zpb + (size_t)n * DNC * 512 + zoff + q * 8); }
                asm volatile("" ::: "memory");
                if (n + 1 < NCH) DN_DMA(n + 1, (n + 1) & 1);
                asm volatile("" ::: "memory");
                {
                    const LAS unsigned short* os = (const LAS unsigned short*)(lds + DN_OS + ((n - 1) & 1) * 16384) + nr * 128 + nq * 32;
                    float o[32]; float ss = 0.f;
#pragma unroll
                    for (int q = 0; q < 4; ++q) { const v4u w = *(const LAS v4u*)(os + q * 8);
                        o[q * 8 + 0] = bflo(w.x); o[q * 8 + 1] = bfhi(w.x); o[q * 8 + 2] = bflo(w.y); o[q * 8 + 3] = bfhi(w.y); o[q * 8 + 4] = bflo(w.z); o[q * 8 + 5] = bfhi(w.z); o[q * 8 + 6] = bflo(w.w); o[q * 8 + 7] = bfhi(w.w); }
#pragma unroll
                    for (int e = 0; e < 32; ++e) ss += o[e] * o[e];
                    ss += dpp_f<0xB1>(ss); ss += dpp_f<0x4E>(ss);
                    const float rstd = __builtin_amdgcn_rsqf(ss * (1.f / 128.f) + EPS);
                    bf16* yp = ypb + (size_t)(n - 1) * DNC * 512 + zoff;
#pragma unroll
                    for (int q = 0; q < 4; ++q) { const f32x4 w0 = *(const f32x4*)(onw + nq * 32 + q * 8), w1 = *(const f32x4*)(onw + nq * 32 + q * 8 + 4); const v4u z = zc[q];
                        v4u y; y.x = cvtpk(o[q * 8 + 0] * rstd * w0.x * siluf_(bflo(z.x)), o[q * 8 + 1] * rstd * w0.y * siluf_(bfhi(z.x))); y.y = cvtpk(o[q * 8 + 2] * rstd * w0.z * siluf_(bflo(z.y)), o[q * 8 + 3] * rstd * w0.w * siluf_(bfhi(z.y)));
                        y.z = cvtpk(o[q * 8 + 4] * rstd * w1.x * siluf_(bflo(z.z)), o[q * 8 + 5] * rstd * w1.y * siluf_(bfhi(z.z))); y.w = cvtpk(o[q * 8 + 6] * rstd * w1.z * siluf_(bflo(z.w)), o[q * 8 + 7] * rstd * w1.w * siluf_(bfhi(z.w)));
                        *(v4u*)(yp + q * 8) = y; }
                }
#pragma unroll
                for (int q = 0; q < 4; ++q) zc[q] = zn[q];
            }
#undef DN_DMA
        }
        asm volatile("s_waitcnt vmcnt(0)" ::: "memory"); __syncthreads();
    }
}
typedef short v4i16_t __attribute__((ext_vector_type(4)));
#define MFMA32(a, b, c) __builtin_amdgcn_mfma_f32_32x32x16_bf16((a), (b), (c), 0, 0, 0)
constexpr int AT_ROWB = 144;
constexpr int AT_K = 0, AT_V = 2 * 64 * AT_ROWB, AT_OST = 4 * 64 * AT_ROWB, AT_BT = AT_OST + 8 * 32 * AT_ROWB, AT_KM = AT_BT + 1024, AT_UW = AT_KM + 4096;
__device__ __forceinline__ int crow(int r, int hi) { return (r & 3) + 8 * (r >> 2) + 4 * hi; }
__device__ __forceinline__ bf16x8 vtr2(const LAS unsigned char* p) {
    const v4i16_t lo = __builtin_amdgcn_ds_read_tr16_b64_v4i16((LAS v4i16_t*)p), hi = __builtin_amdgcn_ds_read_tr16_b64_v4i16((LAS v4i16_t*)(p + 8 * AT_ROWB));
    return (bf16x8){lo[0], lo[1], lo[2], lo[3], hi[0], hi[1], hi[2], hi[3]};
}
__device__ __forceinline__ void ph_attn(KArgs a, const Ctx& c, int l) {
    LAS unsigned char* lds = c.lds; const int lane = c.lane, wv = c.wave, tid = c.tid, r32 = lane & 31, hi = lane >> 5;
    LAS float* btab = (LAS float*)(lds + AT_BT); LAS float* kms = (LAS float*)(lds + AT_KM); volatile LAS int* uw = (volatile LAS int*)(lds + AT_UW);
    const bf16* QKVA = (const bf16*)(a->ws + WS_QKVA); const float* kmean = (const float*)(a->ws + WS_KMEAN); bf16* YA = (bf16*)(a->ws + WS_YA); const float* relb = a->in[I_RELB];
    unsigned* ctr = (unsigned*)(a->ws + WS_CTL) + CW_ACTR + l * 64;
    const float LOG2E = 1.4426950408889634f, C2 = 0.125f * LOG2E, NINF = -__builtin_inff();
    const int srow = tid >> 3, sch = tid & 7; const unsigned sdst = srow * AT_ROWB + sch * 16;
    for (;;) {
        __syncthreads();
        if (tid == 0) uw[0] = (int)__hip_atomic_fetch_add(ctr, 1u, RLX_AGENT);
        __syncthreads();
        const int u = uw[0];
        if (u >= NB * HA * NBLK) { if (u >= NB * HA * NBLK + CV_NUNITS) break; convert_unit(a, c, l, u - NB * HA * NBLK); continue; }
        const int qb = 15 - (u >> 5), bh = u & 31, b = bh >> 3, h = bh & 7;
        const float c31 = relb[31 * 8 + h];
        for (int i = tid; i < 129; i += NTHR) btab[i] = (i < 128 ? (relb[(int)T5B[i] * 8 + h] - c31) : 0.f) * LOG2E;
        for (int i = tid; i < 1024; i += NTHR) kms[i] = kmean[(size_t)bh * 1024 + i];
        const int qrel = wv * 32 + r32, tokq = b * SEQ + qb * 256 + qrel;
        const bf16* kbase = QKVA + (size_t)(b * SEQ) * 1536 + 512 + h * 64 + sch * 8;
        {   const int key0 = qb * 256; const v4u kr = *(const v4u*)(kbase + (size_t)(key0 + srow) * 1536), vr = *(const v4u*)(kbase + (size_t)(key0 + srow) * 1536 + 512);
            *(LAS v4u*)(lds + AT_K + sdst) = kr; *(LAS v4u*)(lds + AT_V + sdst) = vr; }
        float qf[32];
        {   const bf16* qp = QKVA + (size_t)tokq * 1536 + h * 64 + 8 * hi;
#pragma unroll
            for (int s = 0; s < 4; ++s) { const v4u w = *(const v4u*)(qp + 16 * s); qf[s * 8 + 0] = bflo(w.x); qf[s * 8 + 1] = bfhi(w.x); qf[s * 8 + 2] = bflo(w.y); qf[s * 8 + 3] = bfhi(w.y); qf[s * 8 + 4] = bflo(w.z); qf[s * 8 + 5] = bfhi(w.z); qf[s * 8 + 6] = bflo(w.w); qf[s * 8 + 7] = bfhi(w.w); } }
        __syncthreads();
        unsigned selmask = 0u;
        {   float g[16];
#pragma unroll
            for (int n = 0; n < 16; ++n) { g[n] = -3e38f;
                if (n < qb) { float d = 0.f;
#pragma unroll
                    for (int s = 0; s < 4; ++s) { const f32x4 k0 = *(const LAS f32x4*)(kms + n * 64 + 16 * s + 8 * hi), k1 = *(const LAS f32x4*)(kms + n * 64 + 16 * s + 8 * hi + 4);
                        d += qf[s * 8] * k0.x + qf[s * 8 + 1] * k0.y + qf[s * 8 + 2] * k0.z + qf[s * 8 + 3] * k0.w + qf[s * 8 + 4] * k1.x + qf[s * 8 + 5] * k1.y + qf[s * 8 + 6] * k1.z + qf[s * 8 + 7] * k1.w; }
                    g[n] = d + shx(d, 32, lane); } }
#pragma unroll
            for (int t = 0; t < 3; ++t) { float best = -3.4e38f; int bi = 0;
#pragma unroll
                for (int n = 0; n < 16; ++n) { const bool ok = !((selmask >> n) & 1u) && g[n] > best; best = ok ? g[n] : best; bi = ok ? n : bi; }
                selmask |= 1u << bi; }
            selmask &= (1u << qb) - 1u; }
        bf16x8 qs[4];
#pragma unroll
        for (int s = 0; s < 4; ++s) { v4u w; w.x = cvtpk(qf[s * 8] * C2, qf[s * 8 + 1] * C2); w.y = cvtpk(qf[s * 8 + 2] * C2, qf[s * 8 + 3] * C2); w.z = cvtpk(qf[s * 8 + 4] * C2, qf[s * 8 + 5] * C2); w.w = cvtpk(qf[s * 8 + 6] * C2, qf[s * 8 + 7] * C2); qs[s] = __builtin_bit_cast(bf16x8, w); }
        float m = NINF, lsum = 0.f; f32x16 o0, o1;
#pragma unroll
        for (int r = 0; r < 16; ++r) { o0[r] = 0.f; o1[r] = 0.f; }
        const int NT = 4 * (qb + 1);
        for (int t = 0; t < NT; ++t) {
            const int blk = t < 4 ? qb : ((t - 4) >> 2), kt = t < 4 ? t : ((t - 4) & 3);
            v4u kr = {0u, 0u, 0u, 0u}, vr = {0u, 0u, 0u, 0u};
            if (t + 1 < NT) { const int t1 = t + 1, blk1 = t1 < 4 ? qb : ((t1 - 4) >> 2), kt1 = t1 < 4 ? t1 : ((t1 - 4) & 3); const size_t ro = (size_t)(blk1 * 256 + kt1 * 64 + srow) * 1536;
                kr = *(const v4u*)(kbase + ro); vr = *(const v4u*)(kbase + ro + 512); }
            const bool own = t < 4;
            const bool lane_act = own || ((selmask >> blk) & 1u);
            const bool wave_act = own ? (kt * 64 <= wv * 32 + 31) : (__builtin_amdgcn_ballot_w64(lane_act) != 0ull);
            if (wave_act) {
                const LAS unsigned char* Kb = lds + AT_K + (t & 1) * 64 * AT_ROWB; const LAS unsigned char* Vb = lds + AT_V + (t & 1) * 64 * AT_ROWB;
                f32x16 p0, p1;
#pragma unroll
                for (int r = 0; r < 16; ++r) { p0[r] = 0.f; p1[r] = 0.f; }
#pragma unroll
                for (int s = 0; s < 4; ++s) { const bf16x8 a0 = *(const LAS bf16x8*)(Kb + r32 * AT_ROWB + 32 * s + 16 * hi), a1 = *(const LAS bf16x8*)(Kb + (32 + r32) * AT_ROWB + 32 * s + 16 * hi);
                    p0 = MFMA32(a0, qs[s], p0); p1 = MFMA32(a1, qs[s], p1); }
                if (own) {
#pragma unroll
                    for (int r = 0; r < 16; ++r) { const int d0 = qrel - (kt * 64 + crow(r, hi)), d1 = d0 - 32;
                        p0[r] = d0 >= 0 ? p0[r] + btab[d0 > 128 ? 128 : d0] : NINF; p1[r] = d1 >= 0 ? p1[r] + btab[d1 > 128 ? 128 : d1] : NINF; }
                } else if (blk == qb - 1 && kt >= 1) {
#pragma unroll
                    for (int r = 0; r < 16; ++r) { const int d0 = qrel + 256 - (kt * 64 + crow(r, hi)), d1 = d0 - 32;
                        p0[r] += btab[d0 > 128 ? 128 : d0]; p1[r] += btab[d1 > 128 ? 128 : d1]; }
                }
                float mx = fmaxf(p0[0], p1[0]);
#pragma unroll
                for (int r = 1; r < 16; ++r) mx = fmaxf(mx, fmaxf(p0[r], p1[r]));
                mx = fmaxf(mx, shx(mx, 32, lane));
                const float tmax = lane_act ? mx : NINF, mnew = fmaxf(m, tmax), alpha = __builtin_amdgcn_exp2f(m - mnew), muse = lane_act ? mnew : __builtin_inff();
                float rs = 0.f;
#pragma unroll
                for (int r = 0; r < 16; ++r) { p0[r] = __builtin_amdgcn_exp2f(p0[r] - muse); p1[r] = __builtin_amdgcn_exp2f(p1[r] - muse); rs += p0[r] + p1[r]; }
                lsum = lsum * alpha + rs; m = mnew;
                if (__builtin_amdgcn_ballot_w64(alpha != 1.f) != 0ull) {
#pragma unroll
                    for (int r = 0; r < 16; ++r) { o0[r] *= alpha; o1[r] *= alpha; } }
                bf16x8 pa[4];
                { v4u w; w.x = cvtpk(p0[0], p0[1]); w.y = cvtpk(p0[2], p0[3]); w.z = cvtpk(p0[4], p0[5]); w.w = cvtpk(p0[6], p0[7]); pa[0] = __builtin_bit_cast(bf16x8, w);
                  w.x = cvtpk(p0[8], p0[9]); w.y = cvtpk(p0[10], p0[11]); w.z = cvtpk(p0[12], p0[13]); w.w = cvtpk(p0[14], p0[15]); pa[1] = __builtin_bit_cast(bf16x8, w);
                  w.x = cvtpk(p1[0], p1[1]); w.y = cvtpk(p1[2], p1[3]); w.z = cvtpk(p1[4], p1[5]); w.w = cvtpk(p1[6], p1[7]); pa[2] = __builtin_bit_cast(bf16x8, w);
                  w.x = cvtpk(p1[8], p1[9]); w.y = cvtpk(p1[10], p1[11]); w.z = cvtpk(p1[12], p1[13]); w.w = cvtpk(p1[14], p1[15]); pa[3] = __builtin_bit_cast(bf16x8, w); }
                const LAS unsigned char* vp = Vb + (4 * hi + ((lane & 15) >> 2)) * AT_ROWB + 2 * (16 * ((lane >> 4) & 1) + 4 * (lane & 3));
#pragma unroll
                for (int ks = 0; ks < 4; ++ks) { const bf16x8 v0 = vtr2(vp + 16 * ks * AT_ROWB), v1 = vtr2(vp + 16 * ks * AT_ROWB + 64);
                    o0 = MFMA32(v0, pa[ks], o0); o1 = MFMA32(v1, pa[ks], o1); }
            }
            if (t + 1 < NT) { *(LAS v4u*)(lds + AT_K + ((t + 1) & 1) * 64 * AT_ROWB + sdst) = kr; *(LAS v4u*)(lds + AT_V + ((t + 1) & 1) * 64 * AT_ROWB + sdst) = vr; }
            __syncthreads();
        }
        lsum += shx(lsum, 32, lane);
        const float inv = 1.f / lsum;
        LAS unsigned short* stg = (LAS unsigned short*)(lds + AT_OST + wv * 32 * AT_ROWB);
#pragma unroll
        for (int r = 0; r < 16; ++r) { stg[r32 * (AT_ROWB / 2) + crow(r, hi)] = (unsigned short)(cvtpk(o0[r] * inv, 0.f) & 0xffffu); stg[r32 * (AT_ROWB / 2) + 32 + crow(r, hi)] = (unsigned short)(cvtpk(o1[r] * inv, 0.f) & 0xffffu); }
        LDS_WAIT();
#pragma unroll
        for (int i = 0; i < 4; ++i) { const int row = i * 8 + (lane >> 3), ch = lane & 7; const v4u v = *(const LAS v4u*)((const LAS unsigned char*)stg + row * AT_ROWB + ch * 16);
            *(v4u*)(YA + (size_t)(b * SEQ + qb * 256 + wv * 32 + row) * 512 + h * 64 + ch * 8) = v; }
    }
}
constexpr int NPH_LAYER = 11, NPHASES = 2 + NLAYER * NPH_LAYER;
#ifndef DN_IMPL
#define DN_IMPL 1
#endif
#ifndef PH_MASK
#define PH_MASK 0xFFFF
#endif
#define PH_EN(k) ((PH_MASK >> (k)) & 1)
#define GEMM_PHASE(EPI, SCHED, g, S, E) pg8::gemm_phase<EPI, SCHED, true, true>(c.lds, g, S, E, c.tid)

#define PHASE_FN static __device__ __forceinline__ void
__device__ __forceinline__ KArgs launder_k(KArgs a) { unsigned long long v = (unsigned long long)a; asm volatile("" : "+s"(v)); return (KArgs)v; }
PHASE_FN f_mod(KArgs a, int& tid) { a = launder_k(a); Ctx c = make_ctx(tid); ph_mod(a, c); }
PHASE_FN f_norm1(KArgs a, int& tid, int l) { a = launder_k(a); Ctx c = make_ctx(tid); ph_norm1(a, c, l); __syncthreads(); ph_convert(a, c, l); }
PHASE_FN f_proj(KArgs a, int& tid) { a = launder_k(a); Ctx c = make_ctx(tid);
    pg8::Gemm g{(const bf16*)(a->ws + WS_H), (const bf16*)(a->ws + WS_WIN), NTOK, DINP, DM}; pg8::StaticOrder S; S.init(NTOK, DINP, c.G, c.bid);
    EpiProj E{a->ws}; GEMM_PHASE(EpiProj, pg8::StaticOrder, g, S, E); }
PHASE_FN f_kmean(KArgs a, int& tid) { a = launder_k(a); Ctx c = make_ctx(tid); ph_kmean(a, c); }
#ifndef ATTN_IMPL
#define ATTN_IMPL 1
#endif
#if ATTN_IMPL
PHASE_FN f_attn(KArgs a, int& tid, int l) { a = launder_k(a); Ctx c = make_ctx(tid); ph_attn(a, c, l); }
#else
PHASE_FN f_attn(KArgs a, int& tid, int l) { a = launder_k(a); Ctx c = make_ctx(tid); ph_attn_simple(a, c); }
#endif
PHASE_FN f_dn(KArgs a, int& tid, int l) { a = launder_k(a); Ctx c = make_ctx(tid); ph_dn_simple(a, c, l); }
PHASE_FN f_dn_prep(KArgs a, int& tid, int l) { a = launder_k(a); Ctx c = make_ctx(tid); ph_dn_prep(a, c, l); }
PHASE_FN f_dn_scan(KArgs a, int& tid, int l) { a = launder_k(a); Ctx c = make_ctx(tid); ph_dn_scan(a, c, l); }
PHASE_FN f_merge1(KArgs a, int& tid) { a = launder_k(a); Ctx c = make_ctx(tid);
    pg8::Gemm g{(const bf16*)(a->ws + WS_YA), (const bf16*)(a->ws + WS_WUPA), NTOK, DM, WA}; pg8::StaticOrder S; S.init(NTOK, DM, c.G, c.bid);
    EpiMerge<false> E{a->ws}; GEMM_PHASE(EpiMerge<false>, pg8::StaticOrder, g, S, E); }
PHASE_FN f_merge2(KArgs a, int& tid) { a = launder_k(a); Ctx c = make_ctx(tid);
    pg8::Gemm g{(const bf16*)(a->ws + WS_YB), (const bf16*)(a->ws + WS_WUPB), NTOK, DM, WB}; pg8::StaticOrder S; S.init(NTOK, DM, c.G, c.bid);
    EpiMerge<true> E{a->ws}; GEMM_PHASE(EpiMerge<true>, pg8::StaticOrder, g, S, E); }
PHASE_FN f_out(KArgs a, int& tid, int l) { a = launder_k(a); Ctx c = make_ctx(tid);
    pg8::Gemm g{(const bf16*)(a->ws + WS_M), (const bf16*)(a->ws + WS_WOUT), NTOK, DM, DM}; pg8::StaticOrder S; S.init(NTOK, DM, c.G, c.bid);
    EpiOut E{l == 0 ? a->in[I_X] : (const float*)a->out, a->out, (const float*)(a->ws + WS_MOD) + l * 4 * 6144 + 2048}; GEMM_PHASE(EpiOut, pg8::StaticOrder, g, S, E); }
PHASE_FN f_router(KArgs a, int& tid, int l) { a = launder_k(a); Ctx c = make_ctx(tid); ph_router(a, c, l); }
PHASE_FN f_gather(KArgs a, int& tid, int l) { a = launder_k(a); Ctx c = make_ctx(tid); ph_gather(a, c, l); }
PHASE_FN f_moe_gu(KArgs a, int& tid, int l) { a = launder_k(a); Ctx c = make_ctx(tid);
    moe_table(a, c, l); const LAS int* te = (const LAS int*)(c.lds + MISC_OFF + 2048);
    pg8::Gemm g{(const bf16*)(a->ws + WS_HS), (const bf16*)(a->ws + WS_WEGU), MOE_MAXROWS, NEXP * 512, DM}; MoeOrder S{te, te[192 + 32] * 2, c.G, c.bid, 1};
    EpiMoeGU E{a->ws}; GEMM_PHASE(EpiMoeGU, MoeOrder, g, S, E); }
PHASE_FN f_moe_down(KArgs a, int& tid, int l) { a = launder_k(a); Ctx c = make_ctx(tid);
    moe_table(a, c, l); const LAS int* te = (const LAS int*)(c.lds + MISC_OFF + 2048);
    pg8::Gemm g{(const bf16*)(a->ws + WS_ACT), (const bf16*)(a->ws + WS_WED), MOE_MAXROWS, NEXP * 1024, DFF}; MoeOrder S{te, te[192 + 32] * 4, c.G, c.bid, 2};
    EpiMoeDown E{a->ws}; GEMM_PHASE(EpiMoeDown, MoeOrder, g, S, E); }
PHASE_FN f_final(KArgs a, int& tid) { a = launder_k(a); Ctx c = make_ctx(tid); ph_final(a, c); }

#define KA() launder_k((KArgs)__builtin_amdgcn_kernarg_segment_ptr())
__device__ __forceinline__ bool ph_in(int k) { KArgs a = KA(); return a->ph_lo <= k && k < a->ph_hi; }
#ifndef MK_PROBE_A
#define MK_PROBE_A -1
#endif
#ifndef MK_PROBE_B
#define MK_PROBE_B -1
#endif
constexpr int CW_TS = 12288;
__device__ __forceinline__ void grid_bar(int& tid, int k) {
    asm volatile("" : "+v"(tid));
#if MK_ONE_LAUNCH
    KArgs a = KA(); XcdBarrier b; b.bar = (unsigned*)(a->ws + WS_CTL) + CW_BAR; b.x = xb_xcc_id(); b.st = (volatile LAS unsigned*)((LAS unsigned char*)lds_raw + MISC_OFF) + 8;
    xcd_barrier(b, tid);
    if (MK_PROBE_A >= 0 && blockIdx.x == 0 && tid == 0) ((unsigned long long*)((unsigned*)(a->ws + WS_CTL) + CW_TS))[k + 1] = __builtin_amdgcn_s_memrealtime();
#else
    __syncthreads();
#endif
}
__global__ void __launch_bounds__(NTHR, 2) mk_fwd(Args a_) {
    int tid = threadIdx.x;
    {   volatile LAS unsigned* MISC = (volatile LAS unsigned*)((LAS unsigned char*)lds_raw + MISC_OFF);
        if (tid < 64) MISC[tid] = 0u;
        __syncthreads();
#if MK_ONE_LAUNCH
        (void)xcd_barrier_post((unsigned*)(KA()->ws + WS_CTL) + CW_BAR, MISC + 8, tid);
#endif
        if (MK_PROBE_A >= 0 && blockIdx.x == 0 && tid == 0) ((unsigned long long*)((unsigned*)(KA()->ws + WS_CTL) + CW_TS))[0] = __builtin_amdgcn_s_memrealtime();
    }
#define IN(k) ph_in(k)
#define SEAM(k) do { if (IN(k) && IN((k) + 1)) grid_bar(tid, (k)); } while (0)
    if (IN(0)) f_mod(KA(), tid); SEAM(0);
    for (int l = 0; l < NLAYER; ++l) {
        const int pb = 1 + l * NPH_LAYER;
        if (PH_EN(0) && IN(pb + 0)) f_norm1(KA(), tid, l); SEAM(pb + 0);
        if (PH_EN(1) && IN(pb + 1)) f_proj(KA(), tid); SEAM(pb + 1);
#if DN_IMPL
        if (PH_EN(2) && IN(pb + 2)) { f_kmean(KA(), tid); f_dn_prep(KA(), tid, l); } SEAM(pb + 2);
        if (PH_EN(3) && IN(pb + 3)) { f_dn_scan(KA(), tid, l);
            if (MK_PROBE_A >= 0 && blockIdx.x == 0 && tid == 0) ((unsigned long long*)((unsigned*)(KA()->ws + WS_CTL) + CW_TS))[40 + l] = __builtin_amdgcn_s_memrealtime();
            __syncthreads(); f_attn(KA(), tid, l);
            if (MK_PROBE_A >= 0 && blockIdx.x == 255 && tid == 0) ((unsigned long long*)((unsigned*)(KA()->ws + WS_CTL) + CW_TS))[44 + l] = __builtin_amdgcn_s_memrealtime(); } SEAM(pb + 3);
#else
        if (PH_EN(2) && IN(pb + 2)) f_kmean(KA(), tid); SEAM(pb + 2);
        if (PH_EN(3) && IN(pb + 3)) { f_attn(KA(), tid, l); __syncthreads(); f_dn(KA(), tid, l); } SEAM(pb + 3);
#endif
        if (PH_EN(4) && IN(pb + 4)) f_merge1(KA(), tid); SEAM(pb + 4);
        if (PH_EN(5) && IN(pb + 5)) f_merge2(KA(), tid); SEAM(pb + 5);
        if (PH_EN(6) && IN(pb + 6)) f_out(KA(), tid, l); SEAM(pb + 6);
        if (PH_EN(7) && IN(pb + 7)) f_router(KA(), tid, l); SEAM(pb + 7);
        if (PH_EN(8) && IN(pb + 8)) f_gather(KA(), tid, l); SEAM(pb + 8);
        if (PH_EN(9) && IN(pb + 9)) f_moe_gu(KA(), tid, l); SEAM(pb + 9);
        if (PH_EN(10) && IN(pb + 10)) f_moe_down(KA(), tid, l); SEAM(pb + 10);
    }
    if (IN(NPHASES - 1)) f_final(KA(), tid);
#undef IN
#undef SEAM
}

extern "C" void kernel_launch(void* const* d_in, const int* in_sizes, int n_in, void* d_out, int out_size, void* d_ws, size_t ws_size, hipStream_t stream) {
    static int grid = 0;
    if (grid == 0) {
        if (n_in != 23 || out_size != NTOK * DM || ws_size < WS_END) { fprintf(stderr, "kernel_launch: unexpected shapes (n_in %d out %d ws %zu)\n", n_in, out_size, ws_size); grid = -1; return; }
        int dev = 0, cus = 0, per_cu = 0;
        if (hipGetDevice(&dev) != hipSuccess || hipDeviceGetAttribute(&cus, hipDeviceAttributeMultiprocessorCount, dev) != hipSuccess) { grid = -1; return; }
        if (hipFuncSetAttribute((const void*)mk_fwd, hipFuncAttributeMaxDynamicSharedMemorySize, LDS_BYTES) != hipSuccess) { fprintf(stderr, "kernel_launch: hipFuncSetAttribute failed\n"); grid = -1; return; }
        if (hipOccupancyMaxActiveBlocksPerMultiprocessor(&per_cu, (const void*)mk_fwd, NTHR, LDS_BYTES) != hipSuccess || per_cu < 1) { fprintf(stderr, "kernel_launch: occupancy query says %d\n", per_cu); (void)hipGetLastError(); grid = -1; return; }
        grid = cus;
    }
    if (grid < 0) return;
    (void)hipMemsetAsync((char*)d_ws + WS_CTL, 0, CTL_ZERO_BYTES, stream);
    Args a{};
    for (int i = 0; i < 23; ++i) a.in[i] = (const float*)d_in[i];
    a.out = (float*)d_out; a.ws = (unsigned char*)d_ws;
#if MK_ONE_LAUNCH
    a.ph_lo = 0; a.ph_hi = NPHASES;
    hipLaunchKernelGGL(mk_fwd, dim3(grid), dim3(NTHR), LDS_BYTES, stream, a);
#else
    for (int p = 0; p < NPHASES; ++p) { a.ph_lo = p; a.ph_hi = p + 1; hipLaunchKernelGGL(mk_fwd, dim3(grid), dim3(NTHR), LDS_BYTES, stream, a); }
#endif
}
```

```cpp
#include <hip/hip_runtime.h>
#include <cstdio>
#include <cstdint>
#ifndef MK_ONE_LAUNCH
#define MK_ONE_LAUNCH 1
#endif
#ifndef MK_PROBE_A
#define MK_PROBE_A -1
#endif
#ifndef MK_PROBE_B
#define MK_PROBE_B -1
#endif
namespace pg8 {
#define PG8_LAS __attribute__((address_space(3)))
typedef unsigned short bf16_t;
typedef short bf16x8 __attribute__((ext_vector_type(8)));
typedef float f32x4 __attribute__((ext_vector_type(4)));
typedef unsigned u32x4 __attribute__((ext_vector_type(4)));
constexpr int BM = 256, BK = 64, HALF = 128, HTB = HALF * BK * 2  , STAGE_BYTES = 8 * HTB, NXCD = 8, WGM = 8;

__host__ __device__ __forceinline__ int lds_byte(int r, int c) { const int st = (r >> 4) * 2 + (c >> 5), rr = r & 15, cc = c & 31, ob = rr * 64 + cc * 2; return st * 1024 + (ob ^ (((ob >> 9) & 1) << 5)); }
__host__ __device__ __forceinline__ void stage_rc(int b, int& R, int& C) { const int st = b / 1024, sb = b % 1024, swz = sb ^ (((sb >> 9) & 1) << 5); R = (st >> 1) * 16 + swz / 64; C = (st & 1) * 32 + (swz % 64) / 2; }
__host__ __device__ __forceinline__ int perm32(int rho) { const int n = rho >> 4, i = rho & 15; return 8 * (i >> 2) + 4 * n + (i & 3); }

struct Unit { int pm, pn; };
struct Gemm { const bf16_t* A; const bf16_t* Bt; int M, N, K; };

struct StaticOrder {
    int nM, nN, nwg, G, c;
    __host__ __device__ void init(int M, int N, int G_, int c_) { nM = M / BM; nN = N / BM; nwg = nM * nN; G = G_; c = c_; }
    __host__ __device__ bool next(int i, Unit& u) const {
        const long L = (long)i * G + c; if (L >= nwg) return false;
        int wgid = (int)L; { const int q = nwg / NXCD, r = nwg % NXCD, xcd = wgid % NXCD, off = wgid / NXCD; wgid = (xcd < r ? xcd * (q + 1) : r * (q + 1) + (xcd - r) * q) + off; }
        const int nig = WGM * nN, gid = wgid / nig, fm = gid * WGM, gsz = (nM - fm) < WGM ? (nM - fm) : WGM;
        u.pm = fm + ((wgid % nig) % gsz); u.pn = (wgid % nig) / gsz; return true;
    }
    __device__ __forceinline__ void a_ready(const Unit&) const {}
    __device__ __forceinline__ void done(const Unit&) const {}
};

__device__ __forceinline__ unsigned cvt_pk_bf16(float lo, float hi) { unsigned r; asm volatile("v_cvt_pk_bf16_f32 %0, %1, %2" : "=v"(r) : "v"(lo), "v"(hi)); return r; }
typedef float f32x2 __attribute__((ext_vector_type(2)));
template <class Epi, class Sched, bool ALIGN_EPI = false, bool SP2 = false>
__device__ __forceinline__ void gemm_phase(PG8_LAS unsigned char* lds, const Gemm g, const Sched& S, const Epi& E, const int tid_in) {
    const int tid = tid_in, wid = __builtin_amdgcn_readfirstlane(tid >> 6), lane = tid & 63, wr = wid >> 2, wc = wid & 3, fr = lane & 15, fq = lane >> 4;
    const int K = g.K, nt = K / BK;
    unsigned voffA[2], voffB[2];
#pragma unroll
    for (int i = 0; i < 2; ++i) { int R, C; stage_rc(tid * 16 + i * 8192, R, C); const int Rb = Epi::PERM ? ((R & ~31) + perm32(R & 31)) : R;
        voffA[i] = (unsigned)(R * K + C) * 2u; voffB[i] = (unsigned)(Rb * K + C) * 2u; }
    const size_t kstep = (size_t)(BK * 2);
    const size_t hstep = (size_t)HALF * K * 2;
    const size_t tstep = 2 * hstep;
    const unsigned ldsw = (unsigned)wid * 1024u;
    const int aoff = lds_byte(wr * 64 + fr, fq * 8), boff = lds_byte(wc * 32 + fr, fq * 8);
#define PG8_SA(b, h) (((b) * 2 + (h)) * HTB)
#define PG8_SB(b, h) ((4 + (b) * 2 + (h)) * HTB)
#define PG8_STAGE(bufoff, gbase, voff) do { _Pragma("unroll") for (int _i = 0; _i < 2; ++_i) \
        __builtin_amdgcn_global_load_lds((const unsigned*)((const char*)(gbase) + (voff)[_i]), (PG8_LAS unsigned*)(lds + (bufoff) + ldsw + _i * 8192), 16, 0, 0); } while (0)
#define PG8_LDA(dst, b, h) do { _Pragma("unroll") for (int m = 0; m < 4; ++m) _Pragma("unroll") for (int k = 0; k < 2; ++k) dst[m][k] = *(const PG8_LAS bf16x8*)(lds + PG8_SA(b, h) + aoff + m * 2048 + k * 1024); } while (0)
#define PG8_LDB(dst, b, h) do { _Pragma("unroll") for (int n = 0; n < 2; ++n) _Pragma("unroll") for (int k = 0; k < 2; ++k) dst[n][k] = *(const PG8_LAS bf16x8*)(lds + PG8_SB(b, h) + boff + n * 2048 + k * 1024); } while (0)
#define PG8_MMA(ai, bj, At, Bt) do { __builtin_amdgcn_s_setprio(1); _Pragma("unroll") for (int m = 0; m < 4; ++m) _Pragma("unroll") for (int n = 0; n < 2; ++n) _Pragma("unroll") for (int k = 0; k < 2; ++k) \
        acc[ai][bj][m][n] = __builtin_amdgcn_mfma_f32_16x16x32_bf16(Bt[n][k], At[m][k], acc[ai][bj][m][n], 0, 0, 0); __builtin_amdgcn_s_setprio(0); } while (0)
#define PG8_WAIT_V(n) asm volatile("s_waitcnt vmcnt(" #n ")" ::: "memory")
#define PG8_WAIT_L(n) asm volatile("s_waitcnt lgkmcnt(" #n ")" ::: "memory")
#define PG8_BAR __builtin_amdgcn_s_barrier()
#define PG8_SCHED __builtin_amdgcn_sched_barrier(0)
    Unit cur, nxt; int ui = 0;
    if (!S.next(0, cur)) return;
    f32x4 acc[2][2][4][2];
    float zf_ = 0.f; asm volatile("" : "+v"(zf_));
#pragma unroll
    for (int a = 0; a < 2; ++a)
#pragma unroll
        for (int b = 0; b < 2; ++b)
#pragma unroll
            for (int m = 0; m < 4; ++m)
#pragma unroll
                for (int n = 0; n < 2; ++n) acc[a][b][m][n] = (f32x4){zf_, zf_, zf_, zf_};
    bf16x8 At[4][2], B0[2][2], B1[2][2];
    const char* cA = (const char*)g.A + (size_t)cur.pm * tstep; const char* cB = (const char*)g.Bt + (size_t)cur.pn * tstep;
    S.a_ready(cur);
    if constexpr (SP2) {
        PG8_STAGE(PG8_SB(0, 0), cB, voffB); PG8_STAGE(PG8_SB(0, 1), cB + hstep, voffB); PG8_STAGE(PG8_SA(0, 0), cA, voffA); PG8_STAGE(PG8_SA(0, 1), cA + hstep, voffA);
        if (wr == 1) PG8_BAR;
        PG8_WAIT_V(2); PG8_BAR;
        PG8_STAGE(PG8_SB(1, 0), cB + kstep, voffB); PG8_STAGE(PG8_SA(1, 0), cA + kstep, voffA); PG8_STAGE(PG8_SB(1, 1), cB + hstep + kstep, voffB);
        PG8_WAIT_V(6); PG8_BAR;
    } else {
        PG8_STAGE(PG8_SB(0, 0), cB, voffB); PG8_STAGE(PG8_SA(0, 0), cA, voffA); PG8_STAGE(PG8_SB(0, 1), cB + hstep, voffB); PG8_STAGE(PG8_SA(0, 1), cA + hstep, voffA);
        if (wr == 1) PG8_BAR;
        PG8_WAIT_V(4); PG8_BAR;
        PG8_STAGE(PG8_SB(1, 0), cB + kstep, voffB); PG8_STAGE(PG8_SA(1, 0), cA + kstep, voffA); PG8_STAGE(PG8_SB(1, 1), cB + hstep + kstep, voffB);
        PG8_WAIT_V(6); PG8_BAR;
    }
    for (;;) {
        const bool has_next = S.next(ui + 1, nxt);
        const char* nA = has_next ? (const char*)g.A + (size_t)nxt.pm * tstep : cA; const char* nB = has_next ? (const char*)g.Bt + (size_t)nxt.pn * tstep : cB;
        for (int t = 0; t < nt; t += 2) {
            const bool last = (t == nt - 2);
            const char* a1 = cA + (size_t)(t + 1) * kstep;
            const char* a2 = last ? nA : cA + (size_t)(t + 2) * kstep; const char* b2 = last ? nB : cB + (size_t)(t + 2) * kstep;
            const char* a3 = a2 + kstep; const char* b3 = b2 + kstep;
            if (last && has_next) S.a_ready(nxt);
            if constexpr (SP2) {
            PG8_LDB(B0, 0, 0); PG8_LDB(B1, 0, 1); PG8_SCHED; PG8_LDA(At, 0, 0); PG8_STAGE(PG8_SA(1, 1), a1 + hstep, voffA);
            PG8_WAIT_V(8); PG8_WAIT_L(0); PG8_BAR; PG8_MMA(0, 0, At, B0); PG8_MMA(0, 1, At, B1); PG8_BAR; PG8_SCHED;
            PG8_LDA(At, 0, 1); PG8_STAGE(PG8_SB(0, 0), b2, voffB); PG8_STAGE(PG8_SB(0, 1), b2 + hstep, voffB); PG8_STAGE(PG8_SA(0, 0), a2, voffA);
            PG8_WAIT_V(8); PG8_WAIT_L(0); PG8_BAR; PG8_MMA(1, 0, At, B0); PG8_MMA(1, 1, At, B1); PG8_BAR; PG8_SCHED;
            PG8_LDB(B0, 1, 0); PG8_LDB(B1, 1, 1); PG8_SCHED; PG8_LDA(At, 1, 0); PG8_STAGE(PG8_SA(0, 1), a2 + hstep, voffA);
            PG8_WAIT_V(8); PG8_WAIT_L(0); PG8_BAR; PG8_MMA(0, 0, At, B0); PG8_MMA(0, 1, At, B1); PG8_BAR; PG8_SCHED;
            PG8_LDA(At, 1, 1); PG8_STAGE(PG8_SB(1, 0), b3, voffB); PG8_STAGE(PG8_SB(1, 1), b3 + hstep, voffB); PG8_STAGE(PG8_SA(1, 0), a3, voffA);
            PG8_WAIT_V(8); PG8_WAIT_L(0); PG8_BAR; PG8_MMA(1, 0, At, B0); PG8_MMA(1, 1, At, B1); PG8_BAR; PG8_SCHED;
            } else {
            PG8_LDB(B0, 0, 0); PG8_SCHED; PG8_LDA(At, 0, 0); PG8_STAGE(PG8_SA(1, 1), a1 + hstep, voffA);
            PG8_WAIT_L(8); PG8_BAR; PG8_WAIT_L(0); PG8_MMA(0, 0, At, B0); PG8_BAR; PG8_SCHED;
            PG8_LDB(B1, 0, 1); PG8_STAGE(PG8_SB(0, 0), b2, voffB);
            PG8_BAR; PG8_WAIT_L(0); PG8_MMA(0, 1, At, B1); PG8_BAR;
            PG8_LDA(At, 0, 1); PG8_STAGE(PG8_SA(0, 0), a2, voffA);
            PG8_BAR; PG8_WAIT_L(0); PG8_MMA(1, 0, At, B0); PG8_BAR; PG8_SCHED;
            PG8_STAGE(PG8_SB(0, 1), b2 + hstep, voffB);
            PG8_WAIT_V(6); PG8_BAR; PG8_MMA(1, 1, At, B1); PG8_BAR;
            PG8_LDB(B0, 1, 0); PG8_SCHED; PG8_LDA(At, 1, 0); PG8_STAGE(PG8_SA(0, 1), a2 + hstep, voffA);
            PG8_WAIT_L(8); PG8_BAR; PG8_WAIT_L(0); PG8_MMA(0, 0, At, B0); PG8_BAR; PG8_SCHED;
            PG8_LDB(B1, 1, 1); PG8_STAGE(PG8_SB(1, 0), b3, voffB);
            PG8_BAR; PG8_WAIT_L(0); PG8_MMA(0, 1, At, B1); PG8_BAR;
            PG8_LDA(At, 1, 1); PG8_STAGE(PG8_SA(1, 0), a3, voffA);
            PG8_BAR; PG8_WAIT_L(0); PG8_MMA(1, 0, At, B0); PG8_BAR; PG8_SCHED;
            PG8_STAGE(PG8_SB(1, 1), b3 + hstep, voffB);
            PG8_WAIT_V(6); PG8_BAR; PG8_MMA(1, 1, At, B1); PG8_BAR;
            }
        }
        if constexpr (ALIGN_EPI) { if (wr == 0) PG8_BAR; }
        if constexpr (!Epi::AFTER_DRAIN) { int te_ = tid_in; asm volatile("" : "+v"(te_)); E(acc, cur, wr, wc, te_ & 15, (te_ & 63) >> 4); S.done(cur); }
        if (!has_next) break;
        zf_ = 0.f; asm volatile("" : "+v"(zf_));
#pragma unroll
        for (int a = 0; a < 2; ++a)
#pragma unroll
            for (int b = 0; b < 2; ++b)
#pragma unroll
                for (int m = 0; m < 4; ++m)
#pragma unroll
                    for (int n = 0; n < 2; ++n) acc[a][b][m][n] = (f32x4){zf_, zf_, zf_, zf_};
        cur = nxt; cA = nA; cB = nB; ++ui;
        if constexpr (ALIGN_EPI) { if (wr == 1) PG8_BAR; }
    }
    PG8_WAIT_V(0);
    if constexpr (!ALIGN_EPI) { if (wr == 0) PG8_BAR; }
    PG8_BAR;
    if constexpr (Epi::AFTER_DRAIN) { E.fused(acc, cur, wr, wc, fr, fq, lds, wid, lane); S.done(cur); }
#undef PG8_SA
#undef PG8_SB
#undef PG8_STAGE
#undef PG8_LDA
#undef PG8_LDB
#undef PG8_MMA
#undef PG8_WAIT_V
#undef PG8_WAIT_L
#undef PG8_BAR
#undef PG8_SCHED
}
}
constexpr int NW = 8, NTHR = 512;
constexpr int DM = 1024, NB = 4, SEQ = 4096, NTOK = NB * SEQ, NLAYER = 2;
constexpr int HA = 8, HDA = 64, WA = 512, MBLK = 256, NBLK = SEQ / MBLK;
constexpr int HB = 4, HDB = 128, WB = 512, CONVK = 4, DNC = 64, NCH = SEQ / DNC;
constexpr int NGRP = 4, EPG = 8, NEXP = 32, DFF = 256;
constexpr int DIN = 5640, DINP = 5632, NMOD = 6;
constexpr int C_QKVA = 0, C_QKVB = 1536, C_ZB = 3072, C_BA = 3584, C_GATE = 3592;
constexpr float EPS = 1e-6f;
constexpr int MOE_MAXROWS = 2 * NTOK + NEXP * 256;
constexpr int MOE_MAXTILES = MOE_MAXROWS / 256;

constexpr size_t MiB = 1u << 20;
constexpr size_t WS_CTL = 0, CTL_ZERO_BYTES = 1 * MiB;
constexpr size_t WS_MOD = 1 * MiB;
constexpr size_t WS_WIN = 2 * MiB;
constexpr size_t WS_WUPA = 13 * MiB, WS_WUPB = 14 * MiB;
constexpr size_t WS_WOUT = 15 * MiB;
constexpr size_t WS_WEGU = 17 * MiB;
constexpr size_t WS_WED = 49 * MiB;
constexpr size_t WS_SMALL = 65 * MiB;
constexpr size_t WS_KMEAN = WS_SMALL;
constexpr size_t WS_BETA = WS_SMALL + 256 * 1024;
constexpr size_t WS_GLOG = WS_SMALL + 512 * 1024;
constexpr size_t WS_TOKINFO = WS_SMALL + 1 * MiB;
constexpr size_t WS_ROWTOK = WS_SMALL + 2 * MiB;
constexpr size_t WS_ROWW = WS_SMALL + 3 * MiB;
constexpr size_t WS_GL = WS_SMALL + 4 * MiB;
constexpr size_t WS_H = 72 * MiB;
constexpr size_t WS_QKVA = 104 * MiB;
constexpr size_t WS_QKVB = 152 * MiB;
constexpr size_t WS_ZB = 200 * MiB;
constexpr size_t WS_GATES = 216 * MiB;
constexpr size_t WS_IMG = 280 * MiB;
constexpr size_t WS_YA = 72 * MiB, WS_YB = 336 * MiB;
constexpr size_t WS_END = 352 * MiB;
constexpr size_t WS_M = WS_QKVB;
constexpr size_t WS_U = 88 * MiB;
constexpr size_t WS_HS = WS_QKVA;
constexpr size_t WS_ACT = 184 * MiB;
constexpr size_t WS_YS = WS_GATES;
constexpr int CW_TMO = 0;
constexpr int CW_BAR = 4096;
constexpr int CW_GCNT = 8192;
constexpr int CW_ACTR = 8320;

constexpr int RING_BYTES = 131072;
constexpr int MISC_OFF = 147456;
constexpr int LDS_BYTES = 151552;

#define GAS __attribute__((address_space(1)))
#define LAS __attribute__((address_space(3)))
typedef unsigned short bf16;
typedef unsigned v4u __attribute__((ext_vector_type(4)));
typedef unsigned v2u __attribute__((ext_vector_type(2)));
typedef float f32x4 __attribute__((ext_vector_type(4)));
typedef float f32x16 __attribute__((ext_vector_type(16)));
typedef short bf16x8 __attribute__((ext_vector_type(8)));
typedef GAS unsigned gu32;
#define RLX_AGENT __ATOMIC_RELAXED, __HIP_MEMORY_SCOPE_AGENT
#define LDS_WAIT() asm volatile("s_waitcnt lgkmcnt(0)" ::: "memory")
#define VM_WAIT() asm volatile("s_waitcnt vmcnt(0)" ::: "memory")
__device__ __forceinline__ unsigned f2bf(float f) { unsigned u = __builtin_bit_cast(unsigned, f); return (u + 0x7fffu + ((u >> 16) & 1u)) >> 16; }
__device__ __forceinline__ unsigned pk2(float lo, float hi) { return f2bf(lo) | (f2bf(hi) << 16); }
__device__ __forceinline__ float bf2f(unsigned b) { return __builtin_bit_cast(float, b << 16); }
__device__ __forceinline__ float bflo(unsigned w) { return __builtin_bit_cast(float, w << 16); }
__device__ __forceinline__ float bfhi(unsigned w) { return __builtin_bit_cast(float, w & 0xffff0000u); }
__device__ __forceinline__ float rcpf_(float x) { return __builtin_amdgcn_rcpf(x); }
__device__ __forceinline__ float sigmoidf_(float x) { return rcpf_(1.f + __builtin_amdgcn_exp2f(-1.4426950408889634f * x)); }
__device__ __forceinline__ float siluf_(float x) { return x * rcpf_(1.f + __builtin_amdgcn_exp2f(-1.4426950408889634f * x)); }
__device__ __forceinline__ float shx(float v, int o, int lane) { return __builtin_bit_cast(float, __builtin_amdgcn_ds_bpermute((lane ^ o) << 2, __builtin_bit_cast(int, v))); }
__device__ __forceinline__ float shidx(float v, int src) { return __builtin_bit_cast(float, __builtin_amdgcn_ds_bpermute(src << 2, __builtin_bit_cast(int, v))); }
__device__ __forceinline__ int shidx_i(int v, int src) { return __builtin_amdgcn_ds_bpermute(src << 2, v); }
template <int CTRL> __device__ __forceinline__ float dpp_f(float v) { return __builtin_bit_cast(float, __builtin_amdgcn_update_dpp(0, __builtin_bit_cast(int, v), CTRL, 0xf, 0xf, true)); }
__device__ __forceinline__ float rdlane_f(float v, int l) { return __builtin_bit_cast(float, __builtin_amdgcn_readlane(__builtin_bit_cast(int, v), l)); }
__device__ __forceinline__ float wave_sum(float v, int) {
    v += dpp_f<0xB1>(v); v += dpp_f<0x4E>(v); v += dpp_f<0x141>(v); v += dpp_f<0x140>(v);
    return (rdlane_f(v, 0) + rdlane_f(v, 16)) + (rdlane_f(v, 32) + rdlane_f(v, 48));
}
__device__ __forceinline__ float wave_max(float v, int) {
    v = fmaxf(v, dpp_f<0xB1>(v)); v = fmaxf(v, dpp_f<0x4E>(v)); v = fmaxf(v, dpp_f<0x141>(v)); v = fmaxf(v, dpp_f<0x140>(v));
    return fmaxf(fmaxf(rdlane_f(v, 0), rdlane_f(v, 16)), fmaxf(rdlane_f(v, 32), rdlane_f(v, 48)));
}
__device__ const unsigned char T5B[128] = {0, 1, 2, 3, 4, 5, 6, 7, 8, 9, 10, 11, 12, 13, 14, 15, 16, 16, 16, 17, 17, 18, 18, 18, 19, 19, 19, 20, 20, 20, 20, 21, 21, 21, 21, 22, 22, 22, 22, 22, 23, 23, 23, 23, 23, 23, 24, 24, 24, 24, 24, 24, 25, 25, 25, 25, 25, 25, 25, 26, 26, 26, 26, 26, 26, 26, 26, 27, 27, 27, 27, 27, 27, 27, 27, 27, 27, 28, 28, 28, 28, 28, 28, 28, 28, 28, 28, 29, 29, 29, 29, 29, 29, 29, 29, 29, 29, 29, 29, 30, 30, 30, 30, 30, 30, 30, 30, 30, 30, 30, 30, 30, 30, 31, 31, 31, 31, 31, 31, 31, 31, 31, 31, 31, 31, 31, 31, 31};

#define XB_TMO      128
#define XB_XCNT(j)  (256  + 64 * (j))
#define XB_XSUB(j)  (1280 + 64 * (j))
#define XB_XGEN(j)  (2304 + 64 * (j))
#define XB_TOP      3328
#define XB_TOPGEN   3392
#define XCD_BAR_WORDS 3456
#define XB_SPIN_CAP (1u << 18)

__device__ __forceinline__ unsigned xb_ld(unsigned* p)              { return __hip_atomic_load(p, __ATOMIC_RELAXED, __HIP_MEMORY_SCOPE_AGENT); }
__device__ __forceinline__ unsigned xb_add(unsigned* p, unsigned v) { return __hip_atomic_fetch_add(p, v, __ATOMIC_RELAXED, __HIP_MEMORY_SCOPE_AGENT); }
__device__ __forceinline__ unsigned xb_xcc_id() { return (unsigned)__builtin_amdgcn_s_getreg((3 << 11) | 20) & 0xFu; }
#define XB_SPIN(cond, bar) do { unsigned _sp = 0; while (cond) { __builtin_amdgcn_s_sleep(1); \
    if ((++_sp & 255u) == 0u) { if (xb_ld(&(bar)[XB_TMO])) break; if (_sp > XB_SPIN_CAP) { atomicAdd(&(bar)[XB_TMO], 1u); break; } } } } while (0)

struct XcdBarrier {
    unsigned* bar; unsigned x;
    volatile LAS unsigned* st;
};

__device__ __forceinline__ XcdBarrier xcd_barrier_post(unsigned* bar, volatile LAS unsigned* st, const int tid_in) {
    XcdBarrier b; b.bar = bar; b.x = xb_xcc_id(); b.st = st;
    if (tid_in == 0) (void)xb_add(&bar[XB_XCNT(b.x)], 1u);
    return b;
}
__device__ __forceinline__ void xcd_barrier_complete(unsigned* bar, unsigned x, unsigned& nloc, unsigned& nx) {
    const unsigned G = gridDim.x * gridDim.y * gridDim.z;
    unsigned sum, cnt, mine, sp = 0u;
    for (;;) {
        sum = 0u; cnt = 0u; mine = 0u;
#pragma unroll
        for (unsigned j = 0; j < 16; ++j) { const unsigned c = xb_ld(&bar[XB_XCNT(j)]); sum += c; cnt += (c > 0u) ? 1u : 0u; mine = (j == x) ? c : mine; }
        if (sum == G) break;
        __builtin_amdgcn_s_sleep(1);
        if ((++sp & 255u) == 0u) { if (xb_ld(&bar[XB_TMO])) break; if (sp > XB_SPIN_CAP) { atomicAdd(&bar[XB_TMO], 1u); break; } }
    }
    nloc = mine > 0u ? mine : 1u; nx = cnt > 0u ? cnt : 1u;
}

__device__ __forceinline__ void xcd_barrier(const XcdBarrier& b, const int tid_in) {
    asm volatile("s_waitcnt vmcnt(0)" ::: "memory");
    __syncthreads();
    if (tid_in == 0) {
        unsigned* bar = b.bar;
        __builtin_amdgcn_s_waitcnt(0);
        unsigned nloc = b.st[0], nx = b.st[1];
        if (nloc == 0u) { xcd_barrier_complete(bar, b.x, nloc, nx); b.st[0] = nloc; b.st[1] = nx; }
        const unsigned old = xb_add(&bar[XB_XSUB(b.x)], 1u);
        const unsigned gen = old / nloc;
        if (old + 1u == (gen + 1u) * nloc) {
            __builtin_amdgcn_fence(__ATOMIC_RELEASE, "agent");
            asm volatile("s_waitcnt vmcnt(0)" ::: "memory");
            const unsigned og = xb_add(&bar[XB_TOP], 1u);
            const unsigned tg = og / nx;
            if (og + 1u == (tg + 1u) * nx) xb_add(&bar[XB_TOPGEN], 1u);
            else XB_SPIN(xb_ld(&bar[XB_TOPGEN]) == tg, bar);
            __builtin_amdgcn_fence(__ATOMIC_ACQUIRE, "agent");
            xb_add(&bar[XB_XGEN(b.x)], 1u);
            asm volatile("s_waitcnt vmcnt(0)" ::: "memory");
        } else {
            XB_SPIN(xb_ld(&bar[XB_XGEN(b.x)]) == gen, bar);
            __builtin_amdgcn_fence(__ATOMIC_ACQUIRE, "agent");
            asm volatile("s_waitcnt vmcnt(0)" ::: "memory");
        }
    }
    __syncthreads();
}
struct Args { const float* in[23]; float* out; unsigned char* ws; int ph_lo, ph_hi; };
enum { I_X = 0, I_C, I_RELB, I_FNW, I_N1W, I_N2W, I_WMOD, I_BMOD, I_WIN, I_CONVW, I_ALOG, I_DTB, I_ONW, I_WUPA, I_WUPB, I_WOUT, I_WRG, I_BRG, I_WRE, I_BRE, I_WEG, I_WEU, I_WED };

typedef const Args __attribute__((address_space(4)))* KArgs;
struct Ctx { LAS unsigned char* lds; int tid, lane, wave, bid, G; };
extern __shared__ __attribute__((aligned(16))) unsigned char lds_raw[];
__device__ __forceinline__ Ctx make_ctx(int& tid) { Ctx c; c.lds = (LAS unsigned char*)lds_raw; asm volatile("" : "+v"(tid)); const int t = tid; c.tid = t; c.lane = t & 63; c.wave = __builtin_amdgcn_readfirstlane(t >> 6); int bi = blockIdx.x, gd = gridDim.x; asm volatile("" : "+s"(bi), "+s"(gd)); c.bid = bi; c.G = gd; return c; }

__device__ __forceinline__ void ph_mod(KArgs a, const Ctx& c) {
    LAS float* cact = (LAS float*)c.lds;
    LAS float* red = (LAS float*)(c.lds + 16384);
    const float* cin = a->in[I_C];
    for (int i = c.tid; i < 4096; i += NTHR) cact[i] = siluf_(cin[i]);
    __syncthreads();
    float* mod = (float*)(a->ws + WS_MOD);
    for (int item = c.bid; item < 192; item += c.G) {
        const int l = item / 96, j0 = (item % 96) * 64;
        const float* W = a->in[I_WMOD] + (size_t)l * 1024 * 6144 + j0 + c.lane;
        float a0 = 0.f, a1 = 0.f, a2 = 0.f, a3 = 0.f;
        const int k0 = c.wave * 128;
#pragma unroll 8
        for (int k = k0; k < k0 + 128; ++k) { const float w = W[(size_t)k * 6144]; a0 += cact[k] * w; a1 += cact[1024 + k] * w; a2 += cact[2048 + k] * w; a3 += cact[3072 + k] * w; }
        red[(c.wave * 4 + 0) * 64 + c.lane] = a0; red[(c.wave * 4 + 1) * 64 + c.lane] = a1; red[(c.wave * 4 + 2) * 64 + c.lane] = a2; red[(c.wave * 4 + 3) * 64 + c.lane] = a3;
        __syncthreads();
        if (c.tid < 256) { const int b = c.tid >> 6, ln = c.tid & 63; float s = 0.f;
#pragma unroll
            for (int w = 0; w < 8; ++w) s += red[(w * 4 + b) * 64 + ln];
            mod[(l * 4 + b) * 6144 + j0 + ln] = s + a->in[I_BMOD][l * 6144 + j0 + ln]; }
        __syncthreads();
    }
}

__device__ __forceinline__ void tr_item(const float* src, int ld, bf16* dst, int K, int nblk, LAS float* scr, int item, int lane) {
    const int kb = item / nblk, nb = item % nblk, k0 = 64 * kb, n0 = 32 * nb;
#pragma unroll 8
    for (int i = 0; i < 32; ++i) { const int kk = 2 * i + (lane >> 5); scr[kk * 33 + (lane & 31)] = src[(size_t)(k0 + kk) * ld + n0 + (lane & 31)]; }
    LDS_WAIT(); asm volatile("" ::: "memory");
    const int cc = lane & 7;
#pragma unroll
    for (int j = 0; j < 4; ++j) { const int n = (lane >> 3) + 8 * j; const LAS float* s = scr + (8 * cc) * 33 + n;
        v4u o; o.x = pk2(s[0 * 33], s[1 * 33]); o.y = pk2(s[2 * 33], s[3 * 33]); o.z = pk2(s[4 * 33], s[5 * 33]); o.w = pk2(s[6 * 33], s[7 * 33]);
        *(v4u*)(dst + (size_t)(n0 + n) * K + k0 + 8 * cc) = o; }
    LDS_WAIT(); asm volatile("" ::: "memory");
}
constexpr int CV_I0 = 1792, CV_I1 = 1024, CV_I2 = 256, CV_I3 = 256, CV_I4 = 512, CV_I5 = 4096, CV_I6 = 4096, CV_I7 = 4096;
constexpr int CV_NIT = CV_I0 + CV_I1 + CV_I2 + CV_I3 + CV_I4 + CV_I5 + CV_I6 + CV_I7, CV_EARLY = CV_I0 + CV_I1;
__device__ __forceinline__ void convert_item(KArgs a, int l, int it, LAS float* scr, int lane) {
    bf16* WIN = (bf16*)(a->ws + WS_WIN); bf16* WEGU = (bf16*)(a->ws + WS_WEGU); bf16* WEDT = (bf16*)(a->ws + WS_WED);
    const float* win = a->in[I_WIN] + (size_t)l * 1024 * DIN;
    int r = it;
    if (r < CV_I0) { tr_item(win, DIN, WIN, 1024, 112, scr, r, lane); return; } r -= CV_I0;
    if (r < CV_I1) { tr_item(win + C_GATE, DIN, WIN + (size_t)C_BA * 1024, 1024, 64, scr, r, lane); return; } r -= CV_I1;
    if (r < CV_I2) { tr_item(a->in[I_WUPA] + (size_t)l * 512 * 1024, 1024, (bf16*)(a->ws + WS_WUPA), 512, 32, scr, r, lane); return; } r -= CV_I2;
    if (r < CV_I3) { tr_item(a->in[I_WUPB] + (size_t)l * 512 * 1024, 1024, (bf16*)(a->ws + WS_WUPB), 512, 32, scr, r, lane); return; } r -= CV_I3;
    if (r < CV_I4) { tr_item(a->in[I_WOUT] + (size_t)l * 1024 * 1024, 1024, (bf16*)(a->ws + WS_WOUT), 1024, 32, scr, r, lane); return; } r -= CV_I4;
    if (r < CV_I5) { const int E = r >> 7, rem = r & 127, pn = rem >> 6, q = rem & 63;
        tr_item(a->in[I_WEG] + ((size_t)(l * 32 + E) * 1024 * 256) + 128 * pn, 256, WEGU + (size_t)(E * 512 + 256 * pn) * 1024, 1024, 4, scr, q, lane); return; } r -= CV_I5;
    if (r < CV_I6) { const int E = r >> 7, rem = r & 127, pn = rem >> 6, q = rem & 63;
        tr_item(a->in[I_WEU] + ((size_t)(l * 32 + E) * 1024 * 256) + 128 * pn, 256, WEGU + (size_t)(E * 512 + 256 * pn + 128) * 1024, 1024, 4, scr, q, lane); return; } r -= CV_I6;
    { const int E = r >> 7, q = r & 127;
        tr_item(a->in[I_WED] + ((size_t)(l * 32 + E) * 256 * 1024), 1024, WEDT + (size_t)E * 1024 * 256, 256, 32, scr, q, lane); }
}
__device__ __forceinline__ void ph_convert(KArgs a, const Ctx& c, int l) {
    LAS float* scr = (LAS float*)(c.lds + 32768 + c.wave * 10240);
    const int gw = c.bid * NW + c.wave, NGW = c.G * NW;
    for (int it = gw; it < CV_EARLY; it += NGW) convert_item(a, l, it, scr, c.lane);
}
constexpr int CV_UNIT = 64, CV_NUNITS = (CV_NIT - CV_EARLY) / CV_UNIT;
static_assert((CV_NIT - CV_EARLY) % CV_UNIT == 0, "convert units");
__device__ __forceinline__ void convert_unit(KArgs a, const Ctx& c, int l, int cu) {
    LAS float* scr = (LAS float*)(c.lds + 32768 + c.wave * 10240);
#pragma unroll 1
    for (int i = 0; i < 8; ++i) convert_item(a, l, CV_EARLY + cu * CV_UNIT + c.wave * 8 + i, scr, c.lane);
}

__device__ __forceinline__ void load_row_x(KArgs a, int l, int m, int lane, f32x4 (&v)[4]) {
    const float* xr = (l == 0 ? a->in[I_X] : (const float*)a->out) + (size_t)m * DM;
#pragma unroll
    for (int j = 0; j < 4; ++j) v[j] = *(const f32x4*)(xr + 256 * j + 4 * lane);
    if (l > 0) {
        const int b = m >> 12;
        const float* g2 = (const float*)(a->ws + WS_MOD) + ((l - 1) * 4 + b) * 6144 + 5120;
        const bf16* ys = (const bf16*)(a->ws + WS_YS) + (size_t)m * 2048;
#pragma unroll
        for (int j = 0; j < 4; ++j) { const int col = 256 * j + 4 * lane; const v2u y0 = *(const v2u*)(ys + col), y1 = *(const v2u*)(ys + 1024 + col); const f32x4 g = *(const f32x4*)(g2 + col);
            v[j].x += g.x * (bflo(y0.x) + bflo(y1.x)); v[j].y += g.y * (bfhi(y0.x) + bfhi(y1.x)); v[j].z += g.z * (bflo(y0.y) + bflo(y1.y)); v[j].w += g.w * (bfhi(y0.y) + bfhi(y1.y)); }
        float* xo = a->out + (size_t)m * DM;
#pragma unroll
        for (int j = 0; j < 4; ++j) *(f32x4*)(xo + 256 * j + 4 * lane) = v[j];
    }
}
__device__ __forceinline__ float row_rstd(const f32x4 (&v)[4], int lane) {
    float s = 0.f;
#pragma unroll
    for (int j = 0; j < 4; ++j) s += (v[j].x * v[j].x + v[j].y * v[j].y) + (v[j].z * v[j].z + v[j].w * v[j].w);
    return __builtin_amdgcn_rsqf(wave_sum(s, lane) * (1.f / DM) + EPS);
}
__device__ __forceinline__ void ph_norm1(KArgs a, const Ctx& c, int l) {
    LAS float* wbaT = (LAS float*)c.lds;
    const float* win = a->in[I_WIN] + (size_t)l * 1024 * DIN + C_BA;
    for (int i = c.tid; i < 8192; i += NTHR) { const int k = i >> 3, cc = i & 7; wbaT[cc * 1024 + k] = win[(size_t)k * DIN + cc]; }
    __syncthreads();
    const int gw = c.bid * NW + c.wave, NGW = c.G * NW, lane = c.lane;
    bf16* H = (bf16*)(a->ws + WS_H); float* beta = (float*)(a->ws + WS_BETA); float* glog = (float*)(a->ws + WS_GLOG);
    const float* n1w = a->in[I_N1W] + l * DM;
    for (int m = gw; m < NTOK; m += NGW) {
        f32x4 v[4]; load_row_x(a, l, m, lane, v);
        const float rstd = row_rstd(v, lane);
        const int b = m >> 12; const float* mod = (const float*)(a->ws + WS_MOD) + (l * 4 + b) * 6144;
        float acc[8];
#pragma unroll
        for (int q = 0; q < 8; ++q) acc[q] = 0.f;
#pragma unroll
        for (int j = 0; j < 4; ++j) { const int col = 256 * j + 4 * lane;
            const f32x4 nw = *(const f32x4*)(n1w + col), sh = *(const f32x4*)(mod + col), sc = *(const f32x4*)(mod + 1024 + col);
            f32x4 h = v[j] * rstd * nw * (sc + 1.0f) + sh;
            v2u o; o.x = pk2(h.x, h.y); o.y = pk2(h.z, h.w); *(v2u*)(H + (size_t)m * DM + col) = o;
#pragma unroll
            for (int q = 0; q < 8; ++q) { const f32x4 w4 = *(const LAS f32x4*)(wbaT + q * 1024 + col); acc[q] += (h.x * w4.x + h.y * w4.y) + (h.z * w4.z + h.w * w4.w); } }
#pragma unroll
        for (int q = 0; q < 8; ++q) acc[q] = wave_sum(acc[q], lane);
        if (lane < 4) {
            const float bb = lane == 0 ? acc[0] : lane == 1 ? acc[1] : lane == 2 ? acc[2] : acc[3];
            const float aa = lane == 0 ? acc[4] : lane == 1 ? acc[5] : lane == 2 ? acc[6] : acc[7];
            beta[m * 4 + lane] = sigmoidf_(bb);
            const float z = aa + a->in[I_DTB][l * 4 + lane]; const float sp = fmaxf(z, 0.f) + log1pf(__expf(-fabsf(z)));
            glog[m * 4 + lane] = -__expf(a->in[I_ALOG][l * 4 + lane]) * sp;
        }
    }
}
__device__ __forceinline__ void ph_final(KArgs a, const Ctx& c) {
    const int gw = c.bid * NW + c.wave, NGW = c.G * NW, lane = c.lane;
    const float* fw = a->in[I_FNW];
    for (int m = gw; m < NTOK; m += NGW) {
        f32x4 v[4];
        {
            const float* xr = (const float*)a->out + (size_t)m * DM; const int b = m >> 12;
            const float* g2 = (const float*)(a->ws + WS_MOD) + ((NLAYER - 1) * 4 + b) * 6144 + 5120;
            const bf16* ys = (const bf16*)(a->ws + WS_YS) + (size_t)m * 2048;
#pragma unroll
            for (int j = 0; j < 4; ++j) { const int col = 256 * j + 4 * lane; v[j] = *(const f32x4*)(xr + col);
                const v2u y0 = *(const v2u*)(ys + col), y1 = *(const v2u*)(ys + 1024 + col); const f32x4 g = *(const f32x4*)(g2 + col);
                v[j].x += g.x * (bflo(y0.x) + bflo(y1.x)); v[j].y += g.y * (bfhi(y0.x) + bfhi(y1.x)); v[j].z += g.z * (bflo(y0.y) + bflo(y1.y)); v[j].w += g.w * (bfhi(y0.y) + bfhi(y1.y)); }
        }
        float rstd = row_rstd(v, lane);
#if defined(MK_PROBE_A) && MK_PROBE_A >= 0
        {   const unsigned long long* ts = (const unsigned long long*)((const unsigned*)(a->ws + WS_CTL) + 12288);
            float tA = 0.f, tB = 0.f;
            for (int ly = 0; ly < NLAYER; ++ly) { const int ka = 1 + ly * 11 + MK_PROBE_A, kb = 1 + ly * 11 + MK_PROBE_B;
                if (MK_PROBE_A < 11) tA += (float)(ts[ka + 1] - ts[ka]) * 0.01f; if (MK_PROBE_B < 11) tB += (float)(ts[kb + 1] - ts[kb]) * 0.01f; }
            if (MK_PROBE_A == 20) { tA = 0.f; for (int ly = 0; ly < NLAYER; ++ly) tA += (float)(ts[40 + ly] - ts[1 + ly * 11 + 3]) * 0.01f; }
            if (MK_PROBE_B == 21) { tB = 0.f; for (int ly = 0; ly < NLAYER; ++ly) tB += (float)(ts[44 + ly] - ts[1 + ly * 11 + 3]) * 0.01f; }
            if (MK_PROBE_A >= 22 && MK_PROBE_A <= 24) { tA = 0.f; for (int ly = 0; ly < NLAYER; ++ly) tA += (float)ts[48 + ly * 4 + MK_PROBE_A - 22] * 0.01f; }
            if (MK_PROBE_B >= 22 && MK_PROBE_B <= 24) { tB = 0.f; for (int ly = 0; ly < NLAYER; ++ly) tB += (float)ts[48 + ly * 4 + MK_PROBE_B - 22] * 0.01f; }
            if (MK_PROBE_A >= 30 && MK_PROBE_A <= 36) { tA = 0.f; for (int ly = 0; ly < NLAYER; ++ly) tA += (float)ts[56 + ly] * 0.01f; }
            if (MK_PROBE_A == 11) tA = (float)(ts[1] - ts[0]) * 0.01f; if (MK_PROBE_A == 12) tA = (float)(ts[23] - ts[0]) * 0.01f;
            if (MK_PROBE_B == 11) tB = (float)(ts[1] - ts[0]) * 0.01f; if (MK_PROBE_B == 12) tB = (float)(ts[23] - ts[0]) * 0.01f;
            (void)tB;
            if (m == 0 && lane == 0) v[0].x += tA * 0.05f / rstd / fw[0]; }
#endif
        float* xo = a->out + (size_t)m * DM;
#pragma unroll
        for (int j = 0; j < 4; ++j) { const int col = 256 * j + 4 * lane; const f32x4 w = *(const f32x4*)(fw + col); *(f32x4*)(xo + col) = v[j] * rstd * w; }
    }
}

__device__ __forceinline__ void ph_kmean(KArgs a, const Ctx& c) {
    const int gw = c.bid * NW + c.wave, NGW = c.G * NW, lane = c.lane;
    const bf16* QKVA = (const bf16*)(a->ws + WS_QKVA); float* kmean = (float*)(a->ws + WS_KMEAN);
    for (int item = gw; item < NB * HA * NBLK; item += NGW) {
        const int nb = item & 15, h = (item >> 4) & 7, b = item >> 7;
        const int sub = lane & 7, rr = lane >> 3;
        float s[8];
#pragma unroll
        for (int q = 0; q < 8; ++q) s[q] = 0.f;
        const bf16* kp = QKVA + (size_t)(b * SEQ + nb * MBLK) * 1536 + 512 + h * 64 + sub * 8;
#pragma unroll 4
        for (int it = 0; it < 32; ++it) { const v4u w = *(const v4u*)(kp + (size_t)(it * 8 + rr) * 1536);
            s[0] += bflo(w.x); s[1] += bfhi(w.x); s[2] += bflo(w.y); s[3] += bfhi(w.y); s[4] += bflo(w.z); s[5] += bfhi(w.z); s[6] += bflo(w.w); s[7] += bfhi(w.w); }
#pragma unroll
        for (int q = 0; q < 8; ++q) { s[q] += shx(s[q], 8, lane); s[q] += shx(s[q], 16, lane); s[q] += shx(s[q], 32, lane); }
        if (lane < 8) { float* o = kmean + (size_t)item * 64 + sub * 8;
            *(f32x4*)o = (f32x4){s[0], s[1], s[2], s[3]} * (1.f / 256.f); *(f32x4*)(o + 4) = (f32x4){s[4], s[5], s[6], s[7]} * (1.f / 256.f); }
    }
}

__device__ __forceinline__ void ph_attn_simple(KArgs a, const Ctx& c) {
    const int gw = c.bid * NW + c.wave, NGW = c.G * NW, lane = c.lane;
    LAS float* btab = (LAS float*)(c.lds);
    LAS float* scw = (LAS float*)(c.lds + 8192) + c.wave * 1024;
    const float* relb = a->in[I_RELB];
    for (int i = c.tid; i < 8 * 129; i += NTHR) { const int h = i / 129, d = i % 129; btab[h * 132 + d] = relb[(d < 128 ? (int)T5B[d] : 31) * 8 + h]; }
    __syncthreads();
    const bf16* QKVA = (const bf16*)(a->ws + WS_QKVA); const float* kmean = (const float*)(a->ws + WS_KMEAN); bf16* YA = (bf16*)(a->ws + WS_YA);
    for (int r = gw; r < NB * HA * SEQ; r += NGW) {
        const int s = r & (SEQ - 1), h = (r >> 12) & 7, b = r >> 15, qb = s >> 8, tok = b * SEQ + s;
        float qv[64];
        { const bf16* qp = QKVA + (size_t)tok * 1536 + h * 64;
#pragma unroll
          for (int q = 0; q < 8; ++q) { const v4u w = *(const v4u*)(qp + q * 8); qv[q * 8 + 0] = bflo(w.x); qv[q * 8 + 1] = bfhi(w.x); qv[q * 8 + 2] = bflo(w.y); qv[q * 8 + 3] = bfhi(w.y); qv[q * 8 + 4] = bflo(w.z); qv[q * 8 + 5] = bfhi(w.z); qv[q * 8 + 6] = bflo(w.w); qv[q * 8 + 7] = bfhi(w.w); } }
        float gate = -1e30f;
        if (lane < qb) { const float* km = kmean + (size_t)(((b * 8 + h) * 16) + lane) * 64; float d = 0.f;
#pragma unroll
            for (int q = 0; q < 16; ++q) { const f32x4 k4 = *(const f32x4*)(km + q * 4); d += qv[q * 4] * k4.x + qv[q * 4 + 1] * k4.y + qv[q * 4 + 2] * k4.z + qv[q * 4 + 3] * k4.w; }
            gate = d; }
        unsigned selmask = 0u;
#pragma unroll
        for (int t = 0; t < 3; ++t) { float best = -3e38f; int bi = 0;
#pragma unroll
            for (int n = 0; n < 16; ++n) { const float gv = shidx(gate, n); if (!((selmask >> n) & 1u) && gv > best) { best = gv; bi = n; } }
            selmask |= 1u << bi; }
        selmask &= (1u << qb) - 1u;
        selmask |= 1u << qb;
        int nseg = 0; float mx = -3e38f;
        for (int blk = 0; blk <= qb; ++blk) {
            if (!((selmask >> blk) & 1u)) continue;
            for (int i = 0; i < 4; ++i) { const int key = blk * 256 + i * 64 + lane; const bf16* kp = QKVA + (size_t)(b * SEQ + key) * 1536 + 512 + h * 64; float d = 0.f;
#pragma unroll
                for (int q = 0; q < 8; ++q) { const v4u w = *(const v4u*)(kp + q * 8);
                    d += qv[q * 8] * bflo(w.x) + qv[q * 8 + 1] * bfhi(w.x) + qv[q * 8 + 2] * bflo(w.y) + qv[q * 8 + 3] * bfhi(w.y) + qv[q * 8 + 4] * bflo(w.z) + qv[q * 8 + 5] * bfhi(w.z) + qv[q * 8 + 6] * bflo(w.w) + qv[q * 8 + 7] * bfhi(w.w); }
                const int dist = s - key; float sc = d * 0.125f + btab[h * 132 + (dist < 0 ? 0 : (dist > 128 ? 128 : dist))];
                if (dist < 0) sc = -3e38f;
                scw[nseg * 256 + i * 64 + lane] = sc; mx = fmaxf(mx, sc); }
            ++nseg; }
        mx = wave_max(mx, lane);
        float sum = 0.f;
        for (int idx = lane; idx < nseg * 256; idx += 64) { const float sc = scw[idx]; const float e = sc < -1e37f ? 0.f : __expf(sc - mx); scw[idx] = e; sum += e; }
        sum = wave_sum(sum, lane);
        LDS_WAIT();
        float o = 0.f; int sg = 0;
        for (int blk = 0; blk <= qb; ++blk) {
            if (!((selmask >> blk) & 1u)) continue;
            const bf16* vp = QKVA + (size_t)(b * SEQ + blk * 256) * 1536 + 1024 + h * 64 + lane;
            const int lim = (blk == qb) ? (s & 255) + 1 : 256;
#pragma unroll 8
            for (int kk = 0; kk < lim; ++kk) o += scw[sg * 256 + kk] * bf2f(vp[(size_t)kk * 1536]);
            ++sg; }
        YA[(size_t)tok * 512 + h * 64 + lane] = (bf16)f2bf(o / sum);
    }
}

template <int LDW> __device__ __forceinline__ void dn_load_chunk(KArgs a, const Ctx& c, int l, int b, int h, int t0, LAS float* qs, LAS float* ks, LAS float* vs) {
    const bf16* QKVB = (const bf16*)(a->ws + WS_QKVB); const float* cw = a->in[I_CONVW] + (size_t)l * 4 * 1536;
    const int cg = c.tid & 15, r0 = c.tid >> 4;
#pragma unroll
    for (int part = 0; part < 3; ++part) {
        const int colb = part * 512 + h * 128 + 8 * cg;
        float w[4][8];
#pragma unroll
        for (int i = 0; i < 4; ++i) { const f32x4 w0 = *(const f32x4*)(cw + i * 1536 + colb), w1 = *(const f32x4*)(cw + i * 1536 + colb + 4);
            w[i][0] = w0.x; w[i][1] = w0.y; w[i][2] = w0.z; w[i][3] = w0.w; w[i][4] = w1.x; w[i][5] = w1.y; w[i][6] = w1.z; w[i][7] = w1.w; }
        LAS float* dst = part == 0 ? qs : part == 1 ? ks : vs;
#pragma unroll
        for (int pass = 0; pass < 2; ++pass) {
            const int r = r0 + 32 * pass, t = t0 + r;
            float y[8];
#pragma unroll
            for (int e = 0; e < 8; ++e) y[e] = 0.f;
#pragma unroll
            for (int i = 0; i < 4; ++i) { const int tt = t - 3 + i; if (tt >= 0) { const v4u x = *(const v4u*)(QKVB + (size_t)(b * SEQ + tt) * 1536 + colb);
                y[0] += w[i][0] * bflo(x.x); y[1] += w[i][1] * bfhi(x.x); y[2] += w[i][2] * bflo(x.y); y[3] += w[i][3] * bfhi(x.y); y[4] += w[i][4] * bflo(x.z); y[5] += w[i][5] * bfhi(x.z); y[6] += w[i][6] * bflo(x.w); y[7] += w[i][7] * bfhi(x.w); } }
            float ss = 0.f;
#pragma unroll
            for (int e = 0; e < 8; ++e) { y[e] = siluf_(y[e]); ss += y[e] * y[e]; }
            if (part < 2) { ss += shx(ss, 1, c.lane); ss += shx(ss, 2, c.lane); ss += shx(ss, 4, c.lane); ss += shx(ss, 8, c.lane);
                const float rs = __builtin_amdgcn_rsqf(ss + EPS) * (part == 0 ? 0.08838834764831845f : 1.f);
#pragma unroll
                for (int e = 0; e < 8; ++e) y[e] *= rs; }
            *(LAS f32x4*)(dst + r * LDW + 8 * cg) = (f32x4){y[0], y[1], y[2], y[3]}; *(LAS f32x4*)(dst + r * LDW + 8 * cg + 4) = (f32x4){y[4], y[5], y[6], y[7]};
        }
    }
}
__device__ __forceinline__ void dn_store_chunk(KArgs a, const Ctx& c, int l, int b, int h, int t0, const LAS float* os) {
    const bf16* ZB = (const bf16*)(a->ws + WS_ZB); bf16* YB = (bf16*)(a->ws + WS_YB); const float* onw = a->in[I_ONW] + l * 128;
    const int r = c.tid >> 3, sub = c.tid & 7, tok = b * SEQ + t0 + r;
    float o[16]; float ss = 0.f;
#pragma unroll
    for (int q = 0; q < 4; ++q) { const f32x4 v = *(const LAS f32x4*)(os + r * 128 + sub * 16 + q * 4); o[q * 4] = v.x; o[q * 4 + 1] = v.y; o[q * 4 + 2] = v.z; o[q * 4 + 3] = v.w; ss += (v.x * v.x + v.y * v.y) + (v.z * v.z + v.w * v.w); }
    ss += shx(ss, 1, c.lane); ss += shx(ss, 2, c.lane); ss += shx(ss, 4, c.lane);
    const float rstd = __builtin_amdgcn_rsqf(ss * (1.f / 128.f) + EPS);
    const bf16* zp = ZB + (size_t)tok * 512 + h * 128 + sub * 16; bf16* yp = YB + (size_t)tok * 512 + h * 128 + sub * 16;
#pragma unroll
    for (int q = 0; q < 2; ++q) { const v4u z = *(const v4u*)(zp + q * 8); const f32x4 w0 = *(const f32x4*)(onw + sub * 16 + q * 8), w1 = *(const f32x4*)(onw + sub * 16 + q * 8 + 4);
        v4u y; y.x = pk2(o[q * 8 + 0] * rstd * w0.x * siluf_(bflo(z.x)), o[q * 8 + 1] * rstd * w0.y * siluf_(bfhi(z.x)));
        y.y = pk2(o[q * 8 + 2] * rstd * w0.z * siluf_(bflo(z.y)), o[q * 8 + 3] * rstd * w0.w * siluf_(bfhi(z.y)));
        y.z = pk2(o[q * 8 + 4] * rstd * w1.x * siluf_(bflo(z.z)), o[q * 8 + 5] * rstd * w1.y * siluf_(bfhi(z.z)));
        y.w = pk2(o[q * 8 + 6] * rstd * w1.z * siluf_(bflo(z.w)), o[q * 8 + 7] * rstd * w1.w * siluf_(bfhi(z.w)));
        *(v4u*)(yp + q * 8) = y; }
}
__device__ __forceinline__ void ph_dn_simple(KArgs a, const Ctx& c, int l) {
    LAS float* qs = (LAS float*)c.lds; LAS float* ks = qs + 8192; LAS float* vs = ks + 8192; LAS float* os = vs + 8192;
    LAS float* bt = (LAS float*)(c.lds + MISC_OFF + 1024); LAS float* at = bt + 64;
    const float* beta = (const float*)(a->ws + WS_BETA); const float* glog = (const float*)(a->ws + WS_GLOG);
    const int v = c.tid >> 2, kq = c.tid & 3;
    for (int item = c.bid; item < NB * HB; item += c.G) {
        const int b = item >> 2, h = item & 3;
        float S[32];
#pragma unroll
        for (int q = 0; q < 32; ++q) S[q] = 0.f;
        for (int n = 0; n < NCH; ++n) {
            const int t0 = n * DNC;
            __syncthreads();
            dn_load_chunk<128>(a, c, l, b, h, t0, qs, ks, vs);
            if (c.tid < 64) { const int tok = b * SEQ + t0 + c.tid; bt[c.tid] = beta[tok * 4 + h]; at[c.tid] = __expf(glog[tok * 4 + h]); }
            __syncthreads();
            for (int tt = 0; tt < DNC; ++tt) {
                const float a_t = at[tt], b_t = bt[tt];
                float kr[32];
#pragma unroll
                for (int q = 0; q < 8; ++q) { const f32x4 k4 = *(const LAS f32x4*)(ks + tt * 128 + kq * 32 + q * 4); kr[q * 4] = k4.x; kr[q * 4 + 1] = k4.y; kr[q * 4 + 2] = k4.z; kr[q * 4 + 3] = k4.w; }
                float kS = 0.f;
#pragma unroll
                for (int q = 0; q < 32; ++q) kS += kr[q] * S[q];
                kS += shx(kS, 1, c.lane); kS += shx(kS, 2, c.lane);
                const float vn = b_t * (vs[tt * 128 + v] - a_t * kS);
                float o = 0.f;
#pragma unroll
                for (int q = 0; q < 8; ++q) { const f32x4 q4 = *(const LAS f32x4*)(qs + tt * 128 + kq * 32 + q * 4);
                    S[q * 4] = a_t * S[q * 4] + kr[q * 4] * vn; S[q * 4 + 1] = a_t * S[q * 4 + 1] + kr[q * 4 + 1] * vn; S[q * 4 + 2] = a_t * S[q * 4 + 2] + kr[q * 4 + 2] * vn; S[q * 4 + 3] = a_t * S[q * 4 + 3] + kr[q * 4 + 3] * vn;
                    o += (q4.x * S[q * 4] + q4.y * S[q * 4 + 1]) + (q4.z * S[q * 4 + 2] + q4.w * S[q * 4 + 3]); }
                o += shx(o, 1, c.lane); o += shx(o, 2, c.lane);
                if (kq == 0) os[tt * 128 + v] = o;
            }
            __syncthreads();
            dn_store_chunk(a, c, l, b, h, t0, os);
        }
    }
}

struct EpiProj {
    static constexpr bool PERM = true, AFTER_DRAIN = false; unsigned char* ws;
    __device__ __forceinline__ void operator()(const pg8::f32x4 (&acc)[2][2][4][2], const pg8::Unit& u, int wr, int wc, int fr, int fq) const {
        const int pn = u.pn; bf16* base; int ld, ct; bool sg = false;
        if (pn < 6) { base = (bf16*)(ws + WS_QKVA); ld = 1536; ct = pn; } else if (pn < 12) { base = (bf16*)(ws + WS_QKVB); ld = 1536; ct = pn - 6; }
        else if (pn < 14) { base = (bf16*)(ws + WS_ZB); ld = 512; ct = pn - 12; } else { base = (bf16*)(ws + WS_GATES); ld = 2048; ct = pn - 14; sg = true; }
        const int row0 = u.pm * 256 + wr * 64 + fr, col0 = ct * 256 + wc * 32 + 8 * fq;
#pragma unroll
        for (int ai = 0; ai < 2; ++ai)
#pragma unroll
            for (int m = 0; m < 4; ++m) { bf16* rowp = base + (size_t)(row0 + ai * 128 + m * 16) * ld + col0;
#pragma unroll
                for (int bj = 0; bj < 2; ++bj) { f32x4 v0 = acc[ai][bj][m][0], v1 = acc[ai][bj][m][1];
                    if (sg) { v0.x = sigmoidf_(v0.x); v0.y = sigmoidf_(v0.y); v0.z = sigmoidf_(v0.z); v0.w = sigmoidf_(v0.w); v1.x = sigmoidf_(v1.x); v1.y = sigmoidf_(v1.y); v1.z = sigmoidf_(v1.z); v1.w = sigmoidf_(v1.w); }
                    v4u w; w.x = pk2(v0.x, v0.y); w.y = pk2(v0.z, v0.w); w.z = pk2(v1.x, v1.y); w.w = pk2(v1.z, v1.w);
                    *(v4u*)(rowp + bj * 128) = w; } }
    }
};
template <bool SECOND> struct EpiMerge {
    static constexpr bool PERM = true, AFTER_DRAIN = false; unsigned char* ws;
    __device__ __forceinline__ void operator()(const pg8::f32x4 (&acc)[2][2][4][2], const pg8::Unit& u, int wr, int wc, int fr, int fq) const {
        bf16* M = (bf16*)(ws + WS_M); const bf16* GT = (const bf16*)(ws + WS_GATES) + (SECOND ? 1024 : 0);
        const int row0 = u.pm * 256 + wr * 64 + fr, col0 = u.pn * 256 + wc * 32 + 8 * fq;
#pragma unroll
        for (int ai = 0; ai < 2; ++ai)
#pragma unroll
            for (int m = 0; m < 4; ++m) { const size_t row = row0 + ai * 128 + m * 16;
#pragma unroll
                for (int bj = 0; bj < 2; ++bj) { const int col = col0 + bj * 128; const f32x4 v0 = acc[ai][bj][m][0], v1 = acc[ai][bj][m][1];
                    const v4u g = *(const v4u*)(GT + row * 2048 + col);
                    float o[8] = {bflo(g.x) * v0.x, bfhi(g.x) * v0.y, bflo(g.y) * v0.z, bfhi(g.y) * v0.w, bflo(g.z) * v1.x, bfhi(g.z) * v1.y, bflo(g.w) * v1.z, bfhi(g.w) * v1.w};
                    if (SECOND) { const v4u p = *(const v4u*)(M + row * 1024 + col); o[0] += bflo(p.x); o[1] += bfhi(p.x); o[2] += bflo(p.y); o[3] += bfhi(p.y); o[4] += bflo(p.z); o[5] += bfhi(p.z); o[6] += bflo(p.w); o[7] += bfhi(p.w); }
                    v4u w; w.x = pk2(o[0], o[1]); w.y = pk2(o[2], o[3]); w.z = pk2(o[4], o[5]); w.w = pk2(o[6], o[7]);
                    *(v4u*)(M + row * 1024 + col) = w; } }
    }
};
struct EpiOut {
    static constexpr bool PERM = true, AFTER_DRAIN = false; const float* xin; float* xout; const float* g1;
    __device__ __forceinline__ void operator()(const pg8::f32x4 (&acc)[2][2][4][2], const pg8::Unit& u, int wr, int wc, int fr, int fq) const {
        const int row0 = u.pm * 256 + wr * 64 + fr, col0 = u.pn * 256 + wc * 32 + 8 * fq; const int b = (u.pm * 256) >> 12;
#pragma unroll
        for (int bj = 0; bj < 2; ++bj) { const int col = col0 + bj * 128; const f32x4 ga = *(const f32x4*)(g1 + b * 6144 + col), gb = *(const f32x4*)(g1 + b * 6144 + col + 4);
#pragma unroll
            for (int ai = 0; ai < 2; ++ai)
#pragma unroll
                for (int m = 0; m < 4; ++m) { const size_t off = (size_t)(row0 + ai * 128 + m * 16) * DM + col;
                    const f32x4 x0 = *(const f32x4*)(xin + off), x1 = *(const f32x4*)(xin + off + 4);
                    *(f32x4*)(xout + off) = x0 + ga * acc[ai][bj][m][0]; *(f32x4*)(xout + off + 4) = x1 + gb * acc[ai][bj][m][1]; } }
    }
};
struct EpiMoeGU {
    static constexpr bool PERM = true, AFTER_DRAIN = false; unsigned char* ws;
    __device__ __forceinline__ void operator()(const pg8::f32x4 (&acc)[2][2][4][2], const pg8::Unit& u, int wr, int wc, int fr, int fq) const {
        bf16* ACT = (bf16*)(ws + WS_ACT);
        const int row0 = u.pm * 256 + wr * 64 + fr, col0 = (u.pn & 1) * 128 + wc * 32 + 8 * fq;
#pragma unroll
        for (int ai = 0; ai < 2; ++ai)
#pragma unroll
            for (int m = 0; m < 4; ++m) { const f32x4 g0 = acc[ai][0][m][0], g1 = acc[ai][0][m][1], u0 = acc[ai][1][m][0], u1 = acc[ai][1][m][1];
                v4u w; w.x = pk2(siluf_(g0.x) * u0.x, siluf_(g0.y) * u0.y); w.y = pk2(siluf_(g0.z) * u0.z, siluf_(g0.w) * u0.w); w.z = pk2(siluf_(g1.x) * u1.x, siluf_(g1.y) * u1.y); w.w = pk2(siluf_(g1.z) * u1.z, siluf_(g1.w) * u1.w);
                *(v4u*)(ACT + (size_t)(row0 + ai * 128 + m * 16) * 256 + col0) = w; }
    }
};
struct EpiMoeDown {
    static constexpr bool PERM = true, AFTER_DRAIN = false; unsigned char* ws;
    __device__ __forceinline__ void operator()(const pg8::f32x4 (&acc)[2][2][4][2], const pg8::Unit& u, int wr, int wc, int fr, int fq) const {
        bf16* YS = (bf16*)(ws + WS_YS); const int* rowtok = (const int*)(ws + WS_ROWTOK); const float* roww = (const float*)(ws + WS_ROWW);
        const int row0 = u.pm * 256 + wr * 64 + fr, col0 = (u.pn & 3) * 256 + wc * 32 + 8 * fq;
#pragma unroll
        for (int ai = 0; ai < 2; ++ai)
#pragma unroll
            for (int m = 0; m < 4; ++m) { const int row = row0 + ai * 128 + m * 16; const int rt = rowtok[row]; const float wgt = roww[row];
                if (rt >= 0) {
#pragma unroll
                    for (int bj = 0; bj < 2; ++bj) { const f32x4 v0 = acc[ai][bj][m][0] * wgt, v1 = acc[ai][bj][m][1] * wgt;
                        v4u w; w.x = pk2(v0.x, v0.y); w.y = pk2(v0.z, v0.w); w.z = pk2(v1.x, v1.y); w.w = pk2(v1.z, v1.w);
                        *(v4u*)(YS + (size_t)rt * 1024 + col0 + bj * 128) = w; } } }
    }
};
struct MoeOrder {
    const LAS int* tile_exp; int nunits, G, c, sh;
    __device__ __forceinline__ bool next(int i, pg8::Unit& u) const {
        const int L = i * G + c; if (L >= nunits) return false;
        const int r = L >> sh, j = L & ((1 << sh) - 1);
        u.pm = r; u.pn = __builtin_amdgcn_readfirstlane((tile_exp[r] << sh) + j); return true;
    }
    __device__ __forceinline__ void a_ready(const pg8::Unit&) const {}
    __device__ __forceinline__ void done(const pg8::Unit&) const {}
};

__device__ __forceinline__ void ph_router(KArgs a, const Ctx& c, int l) {
    LAS int* lcnt = (LAS int*)(c.lds + MISC_OFF + 1024);
    LAS int* lbase = lcnt + 32;
    LAS int* tinf = lcnt + 64;
    LAS float* wreT = (LAS float*)c.lds;
    const int lane = c.lane;
    bf16* H2 = (bf16*)(a->ws + WS_H); unsigned* tokinfo = (unsigned*)(a->ws + WS_TOKINFO); int* rowtok = (int*)(a->ws + WS_ROWTOK);
    unsigned* gcnt = (unsigned*)(a->ws + WS_CTL) + CW_GCNT + l * 32;
    const float* n2w = a->in[I_N2W] + l * DM; const float* wrg = a->in[I_WRG] + (size_t)l * 1024 * 4; const float* wre = a->in[I_WRE] + (size_t)l * 1024 * 32;
    for (int i = c.bid * NTHR + c.tid; i < MOE_MAXROWS; i += c.G * NTHR) rowtok[i] = -1;
    for (int i = c.tid; i < 8192; i += NTHR) { const int k = i >> 3, n4 = (i & 7) * 4; const f32x4 w = *(const f32x4*)(wre + (size_t)k * 32 + n4);
        wreT[(n4 + 0) * 1024 + k] = w.x; wreT[(n4 + 1) * 1024 + k] = w.y; wreT[(n4 + 2) * 1024 + k] = w.z; wreT[(n4 + 3) * 1024 + k] = w.w; }
    for (int tb = c.bid; tb < NTOK / 64; tb += c.G) {
        __syncthreads();
        if (c.tid < 32) lcnt[c.tid] = 0;
        __syncthreads();
        for (int i = 0; i < 8; ++i) {
            const int tl = c.wave * 8 + i, m = tb * 64 + tl, b = m >> 12;
            const float* xr = (const float*)a->out + (size_t)m * DM; const float* mod = (const float*)(a->ws + WS_MOD) + (l * 4 + b) * 6144;
            f32x4 h[4];
#pragma unroll
            for (int j = 0; j < 4; ++j) h[j] = *(const f32x4*)(xr + 256 * j + 4 * lane);
            const float rstd = row_rstd(h, lane);
            float ag[4] = {0.f, 0.f, 0.f, 0.f};
#pragma unroll
            for (int j = 0; j < 4; ++j) { const int col = 256 * j + 4 * lane;
                const f32x4 nw = *(const f32x4*)(n2w + col), sh = *(const f32x4*)(mod + 3072 + col), sc = *(const f32x4*)(mod + 4096 + col);
                h[j] = h[j] * rstd * nw * (sc + 1.0f) + sh;
                v2u o; o.x = pk2(h[j].x, h[j].y); o.y = pk2(h[j].z, h[j].w); *(v2u*)(H2 + (size_t)m * DM + col) = o;
                const f32x4 r0 = *(const f32x4*)(wrg + (size_t)(col + 0) * 4), r1 = *(const f32x4*)(wrg + (size_t)(col + 1) * 4), r2 = *(const f32x4*)(wrg + (size_t)(col + 2) * 4), r3 = *(const f32x4*)(wrg + (size_t)(col + 3) * 4);
                ag[0] += h[j].x * r0.x + h[j].y * r1.x + h[j].z * r2.x + h[j].w * r3.x; ag[1] += h[j].x * r0.y + h[j].y * r1.y + h[j].z * r2.y + h[j].w * r3.y;
                ag[2] += h[j].x * r0.z + h[j].y * r1.z + h[j].z * r2.z + h[j].w * r3.z; ag[3] += h[j].x * r0.w + h[j].y * r1.w + h[j].z * r2.w + h[j].w * r3.w; }
#pragma unroll
            for (int q = 0; q < 4; ++q) ag[q] = wave_sum(ag[q], lane) + a->in[I_BRG][l * 4 + q];
            int g = 0; float gm = ag[0];
#pragma unroll
            for (int q = 1; q < 4; ++q) if (ag[q] > gm) { gm = ag[q]; g = q; }
            float den = 0.f;
#pragma unroll
            for (int q = 0; q < 4; ++q) den += __expf(ag[q] - gm);
            const float ptop = 1.f / den;
            float ae[8] = {0.f, 0.f, 0.f, 0.f, 0.f, 0.f, 0.f, 0.f};
#pragma unroll
            for (int j = 0; j < 4; ++j) { const int col = 256 * j + 4 * lane;
#pragma unroll
                for (int e = 0; e < 8; ++e) { const f32x4 w = *(const LAS f32x4*)(wreT + (g * 8 + e) * 1024 + col); ae[e] += (h[j].x * w.x + h[j].y * w.y) + (h[j].z * w.z + h[j].w * w.w); } }
#pragma unroll
            for (int q = 0; q < 8; ++q) ae[q] = wave_sum(ae[q], lane) + a->in[I_BRE][l * 32 + g * 8 + q];
            int e0 = 0; float v0 = ae[0];
#pragma unroll
            for (int q = 1; q < 8; ++q) if (ae[q] > v0) { v0 = ae[q]; e0 = q; }
            int e1 = -1; float v1 = -3e38f;
#pragma unroll
            for (int q = 0; q < 8; ++q) if (q != e0 && ae[q] > v1) { v1 = ae[q]; e1 = q; }
            const float ex = __expf(v1 - v0); const float w0 = ptop / (1.f + ex), w1 = ptop * ex / (1.f + ex);
            if (lane == 0) { const int E0 = g * 8 + e0, E1 = g * 8 + e1;
                const int r0 = atomicAdd((int*)(lcnt + E0), 1), r1 = atomicAdd((int*)(lcnt + E1), 1);
                tinf[tl * 6 + 0] = E0; tinf[tl * 6 + 1] = E1; tinf[tl * 6 + 2] = r0; tinf[tl * 6 + 3] = r1; tinf[tl * 6 + 4] = __float_as_int(w0); tinf[tl * 6 + 5] = __float_as_int(w1); }
        }
        __syncthreads();
        if (c.tid < 32) lbase[c.tid] = (int)__hip_atomic_fetch_add(gcnt + c.tid, (unsigned)lcnt[c.tid], RLX_AGENT);
        __syncthreads();
        if (c.tid < 64) { const int m = tb * 64 + c.tid; const int E0 = tinf[c.tid * 6], E1 = tinf[c.tid * 6 + 1];
            v4u o; o.x = (unsigned)E0; o.y = (unsigned)E1; o.z = (unsigned)(lbase[E0] + tinf[c.tid * 6 + 2]); o.w = (unsigned)(lbase[E1] + tinf[c.tid * 6 + 3]);
            *(v4u*)(tokinfo + (size_t)m * 8) = o; *(v2u*)(tokinfo + (size_t)m * 8 + 4) = (v2u){(unsigned)tinf[c.tid * 6 + 4], (unsigned)tinf[c.tid * 6 + 5]}; }
    }
}
__device__ __forceinline__ void moe_table(KArgs a, const Ctx& c, int l) {
    LAS int* tile_exp = (LAS int*)(c.lds + MISC_OFF + 2048); LAS int* offs = tile_exp + 192; LAS int* ntl = offs + 32; LAS int* pre = ntl + 4;
    const unsigned* gcnt = (const unsigned*)(a->ws + WS_CTL) + CW_GCNT + l * 32;
    __syncthreads();
    if (c.tid < 64) { const int e = c.tid & 31; const int cnt = (int)__hip_atomic_load(gcnt + e, RLX_AGENT); const int nt = (cnt + 255) >> 8; int inc = nt;
#pragma unroll
        for (int o = 1; o < 32; o <<= 1) { const int v = shidx_i(inc, (c.lane - o) & 63); if (e >= o) inc += v; }
        if (c.tid < 32) { offs[e] = (inc - nt) * 256; pre[e] = inc; if (e == 31) ntl[0] = inc; } }
    __syncthreads();
    if (c.tid < MOE_MAXTILES) { int E = 0;
#pragma unroll
        for (int e = 0; e < 32; ++e) E += (pre[e] <= c.tid) ? 1 : 0;
        tile_exp[c.tid] = E < 31 ? E : 31; }
    __syncthreads();
}
__device__ __forceinline__ void ph_gather(KArgs a, const Ctx& c, int l) {
    moe_table(a, c, l);
    const LAS int* offs = (const LAS int*)(c.lds + MISC_OFF + 2048) + 192;
    const int gw = c.bid * NW + c.wave, NGW = c.G * NW, lane = c.lane;
    const bf16* H2 = (const bf16*)(a->ws + WS_H); bf16* HS = (bf16*)(a->ws + WS_HS); const unsigned* tokinfo = (const unsigned*)(a->ws + WS_TOKINFO);
    int* rowtok = (int*)(a->ws + WS_ROWTOK); float* roww = (float*)(a->ws + WS_ROWW);
    for (int m = gw; m < NTOK; m += NGW) {
        const v4u ti = *(const v4u*)(tokinfo + (size_t)m * 8); const v2u tw = *(const v2u*)(tokinfo + (size_t)m * 8 + 4);
        const int d0 = offs[ti.x] + (int)ti.z, d1 = offs[ti.y] + (int)ti.w;
        const v4u x0 = *(const v4u*)(H2 + (size_t)m * DM + lane * 8), x1 = *(const v4u*)(H2 + (size_t)m * DM + 512 + lane * 8);
        *(v4u*)(HS + (size_t)d0 * DM + lane * 8) = x0; *(v4u*)(HS + (size_t)d0 * DM + 512 + lane * 8) = x1;
        *(v4u*)(HS + (size_t)d1 * DM + lane * 8) = x0; *(v4u*)(HS + (size_t)d1 * DM + 512 + lane * 8) = x1;
        if (lane == 0) { rowtok[d0] = m * 2; rowtok[d1] = m * 2 + 1; roww[d0] = __uint_as_float(tw.x); roww[d1] = __uint_as_float(tw.y); }
    }
}
constexpr int DN_IMG = 57344, DN_LDW = 132, DN_LDA = 68;
typedef __bf16 bf16x2_t __attribute__((ext_vector_type(2)));
typedef float f32x2_t __attribute__((ext_vector_type(2)));
__device__ __forceinline__ unsigned cvtpk(float lo, float hi) { f32x2_t v = {lo, hi}; bf16x2_t b = __builtin_convertvector(v, bf16x2_t); return __builtin_bit_cast(unsigned, b); }
__device__ __forceinline__ bf16x8 pack8(f32x4 a, f32x4 b) { v4u w; w.x = cvtpk(a.x, a.y); w.y = cvtpk(a.z, a.w); w.z = cvtpk(b.x, b.y); w.w = cvtpk(b.z, b.w); return __builtin_bit_cast(bf16x8, w); }
#define MFMA16(a, b, c) __builtin_amdgcn_mfma_f32_16x16x32_bf16((a), (b), (c), 0, 0, 0)

__device__ __forceinline__ void dn_raw_load(KArgs a, const Ctx& c, int item, v4u (&raw)[3][5]) {
    const bf16* QKVB = (const bf16*)(a->ws + WS_QKVB);
    const int n = item & 63, h = (item >> 6) & 3, b = item >> 8, t0 = n * DNC;
    const int cg = c.tid & 15, rg = c.tid >> 4, tA = t0 + 2 * rg - 3;
#pragma unroll
    for (int part = 0; part < 3; ++part)
#pragma unroll
        for (int i = 0; i < 5; ++i) { const int tt = tA + i; raw[part][i] = (v4u){0u, 0u, 0u, 0u};
            if (tt >= 0) raw[part][i] = *(const v4u*)(QKVB + (size_t)(b * SEQ + tt) * 1536 + part * 512 + h * 128 + 8 * cg); }
}
__device__ __forceinline__ void dn_conv_store(KArgs a, const Ctx& c, int l, int h, const v4u (&raw)[3][5], LAS float* qs, LAS float* ks, LAS float* vs) {
    const float* cw = a->in[I_CONVW] + (size_t)l * 4 * 1536;
    const int cg = c.tid & 15, rg = c.tid >> 4;
#pragma unroll
    for (int part = 0; part < 3; ++part) {
        const int colb = part * 512 + h * 128 + 8 * cg;
        float w[4][8];
#pragma unroll
        for (int i = 0; i < 4; ++i) { const f32x4 w0 = *(const f32x4*)(cw + i * 1536 + colb), w1 = *(const f32x4*)(cw + i * 1536 + colb + 4);
            w[i][0] = w0.x; w[i][1] = w0.y; w[i][2] = w0.z; w[i][3] = w0.w; w[i][4] = w1.x; w[i][5] = w1.y; w[i][6] = w1.z; w[i][7] = w1.w; }
        LAS float* dst = part == 0 ? qs : part == 1 ? ks : vs;
#pragma unroll
        for (int rr = 0; rr < 2; ++rr) {
            float y[8];
#pragma unroll
            for (int e = 0; e < 8; ++e) y[e] = 0.f;
#pragma unroll
            for (int i = 0; i < 4; ++i) { const v4u x = raw[part][rr + i];
                y[0] += w[i][0] * bflo(x.x); y[1] += w[i][1] * bfhi(x.x); y[2] += w[i][2] * bflo(x.y); y[3] += w[i][3] * bfhi(x.y); y[4] += w[i][4] * bflo(x.z); y[5] += w[i][5] * bfhi(x.z); y[6] += w[i][6] * bflo(x.w); y[7] += w[i][7] * bfhi(x.w); }
            float ss = 0.f;
#pragma unroll
            for (int e = 0; e < 8; ++e) { y[e] = siluf_(y[e]); ss += y[e] * y[e]; }
            if (part < 2) { ss += dpp_f<0xB1>(ss); ss += dpp_f<0x4E>(ss); ss += dpp_f<0x141>(ss); ss += dpp_f<0x140>(ss);
                const float rs = __builtin_amdgcn_rsqf(ss + EPS) * (part == 0 ? 0.08838834764831845f : 1.f);
#pragma unroll
                for (int e = 0; e < 8; ++e) y[e] *= rs; }
            const int r = 2 * rg + rr;
            *(LAS f32x4*)(dst + r * DN_LDW + 8 * cg) = (f32x4){y[0], y[1], y[2], y[3]}; *(LAS f32x4*)(dst + r * DN_LDW + 8 * cg + 4) = (f32x4){y[4], y[5], y[6], y[7]};
        }
    }
}

__device__ __forceinline__ void ph_dn_prep(KArgs a, const Ctx& c, int l) {
    LAS float* qs = (LAS float*)c.lds; LAS float* ks = qs + 64 * DN_LDW; LAS float* vs = ks + 64 * DN_LDW;
    LAS float* Am = vs + 64 * DN_LDW; LAS float* Pm = Am + 64 * DN_LDA;
    LAS float* bt = (LAS float*)(c.lds + MISC_OFF + 1024); LAS float* Gc = bt + 64;
    const float* beta = (const float*)(a->ws + WS_BETA); const float* glog = (const float*)(a->ws + WS_GLOG);
#if MK_PROBE_A >= 30 && MK_PROBE_A <= 36
    unsigned ppa = 0, pq = (unsigned)__builtin_amdgcn_s_memrealtime();
#define PP_TICK(w) do { const unsigned t_ = (unsigned)__builtin_amdgcn_s_memrealtime(); if ((w) == MK_PROBE_A - 30) ppa += t_ - pq; pq = t_; } while (0)
#else
#define PP_TICK(w) do {} while (0)
#endif
    v4u raw[3][5];
    if (c.bid < NB * HB * NCH) dn_raw_load(a, c, c.bid, raw);
    for (int item = c.bid; item < NB * HB * NCH; item += c.G) {
        int tid = c.tid; asm volatile("" : "+v"(tid));
        const int lane = tid & 63, row = lane & 15, quad = lane >> 4;
        const int n = item & 63, h = (item >> 6) & 3, b = item >> 8, t0 = n * DNC;
        unsigned char* img = a->ws + WS_IMG + (size_t)item * DN_IMG;
        __syncthreads();
        PP_TICK(6);
        dn_conv_store(a, c, l, h, raw, qs, ks, vs);
        { const int nxt = item + c.G; if (nxt < NB * HB * NCH) dn_raw_load(a, c, nxt, raw); }
        if (tid < 64) { const int tok = b * SEQ + t0 + tid; bt[tid] = beta[tok * 4 + h]; float g = glog[tok * 4 + h];
#pragma unroll
            for (int o = 1; o < 64; o <<= 1) { const float v = shidx(g, (lane - o) & 63); if (lane >= o) g += v; }
            Gc[tid] = g; }
        __syncthreads();
        PP_TICK(0);
        {   const int sel = c.wave >> 2, ti = c.wave & 3; const LAS float* rs = sel == 0 ? ks : qs; LAS float* dstm = sel == 0 ? Am : Pm;
            bf16x8 af[4];
#pragma unroll
            for (int s = 0; s < 4; ++s) { const LAS float* p = rs + (ti * 16 + row) * DN_LDW + 32 * s + 8 * quad; af[s] = pack8(*(const LAS f32x4*)p, *(const LAS f32x4*)(p + 4)); }
            for (int tj = 0; tj < 4; ++tj) {
                f32x4 acc = {0.f, 0.f, 0.f, 0.f};
                if (tj <= ti) {
#pragma unroll
                    for (int s = 0; s < 4; ++s) { const LAS float* p = ks + (tj * 16 + row) * DN_LDW + 32 * s + 8 * quad; const bf16x8 bfr = pack8(*(const LAS f32x4*)p, *(const LAS f32x4*)(p + 4)); acc = MFMA16(af[s], bfr, acc); }
                }
                const int j = tj * 16 + row; const float Gj = Gc[j];
#pragma unroll
                for (int r = 0; r < 4; ++r) { const int i = ti * 16 + 4 * quad + r; const float dec = __expf(fminf(Gc[i] - Gj, 0.f));
                    float v = acc[r] * dec; if (sel == 0) v = (j < i) ? v * bt[i] : 0.f; else v = (j <= i) ? v : 0.f;
                    dstm[i * DN_LDA + j] = v; }
            }
        }
        __syncthreads();
        PP_TICK(1);
        const float Glast = Gc[63];
        {
            for (int q = 0; q < 5; ++q) { const int p = tid + 512 * q, blk = p >> 6; float v[8];
                if (blk < 16) { const int mt = blk >> 2, s = blk & 3, cr = 16 * mt + row, k0 = 32 * s + 4 * quad; const float e = __expf(Gc[cr]);
                    const f32x4 v0 = *(const LAS f32x4*)(qs + cr * DN_LDW + k0), v1 = *(const LAS f32x4*)(qs + cr * DN_LDW + k0 + 16);
                    v[0] = v0.x * e; v[1] = v0.y * e; v[2] = v0.z * e; v[3] = v0.w * e; v[4] = v1.x * e; v[5] = v1.y * e; v[6] = v1.z * e; v[7] = v1.w * e; }
                else if (blk < 32) { const int b2 = blk - 16, mt = b2 >> 1, s = b2 & 1, k = 16 * mt + row;
#pragma unroll
                    for (int j = 0; j < 8; ++j) { const int cj = 32 * s + 16 * (j >> 2) + 4 * quad + (j & 3); v[j] = ks[cj * DN_LDW + k] * __expf(Glast - Gc[cj]); } }
                else { const int b3 = blk - 32, mt = b3 >> 1, s = b3 & 1, i = 16 * mt + row, c0 = 32 * s + 4 * quad;
                    const f32x4 v0 = *(const LAS f32x4*)(Pm + i * DN_LDA + c0), v1 = *(const LAS f32x4*)(Pm + i * DN_LDA + c0 + 16);
                    v[0] = v0.x; v[1] = v0.y; v[2] = v0.z; v[3] = v0.w; v[4] = v1.x; v[5] = v1.y; v[6] = v1.z; v[7] = v1.w; }
                v4u w; w.x = cvtpk(v[0], v[1]); w.y = cvtpk(v[2], v[3]); w.z = cvtpk(v[4], v[5]); w.w = cvtpk(v[6], v[7]);
                *(v4u*)(img + 16384 + (size_t)p * 16) = w; }
            if (tid == 0) ((float*)(a->ws + WS_GL))[item] = __expf(Glast);
        }
        __syncthreads();
        PP_TICK(2);
        LAS float* Ti = Pm;
        if (c.wave < 4 && lane < 16) { const int bI = c.wave; float sv[16];
            int vz = 0; asm volatile("" : "+v"(vz)); const LAS float* AmV = Am + vz + (16 * bI) * DN_LDA + 16 * bI;
#pragma unroll
            for (int r = 0; r < 16; ++r) sv[r] = (r == lane) ? 1.f : 0.f;
#pragma unroll
            for (int rp = 0; rp < 15; ++rp)
#pragma unroll
                for (int r = rp + 1; r < 16; ++r) sv[r] -= AmV[r * DN_LDA + rp] * sv[rp];
#pragma unroll
            for (int r = 0; r < 16; ++r) Ti[(bI * 16 + r) * 20 + lane] = sv[r]; }
        __syncthreads();
        PP_TICK(3);
        {   const float isw0 = 0.f; (void)isw0;
#pragma unroll
            for (int bI = 0; bI < 4; ++bI) {
#pragma unroll
                for (int q = 0; q < 2; ++q) { const int nt = 2 * c.wave + q; const bool isw = nt >= 8; LAS float* xb = (isw ? ks : vs) + (nt & 7) * 16;
                    if (bI > 0) {
                        f32x4 acc = {0.f, 0.f, 0.f, 0.f};
#pragma unroll
                        for (int s2 = 0; s2 < (bI == 3 ? 2 : 1); ++s2) { const int j0 = 32 * s2 + 8 * quad;
                            f32x4 a0 = *(const LAS f32x4*)(Am + (16 * bI + row) * DN_LDA + j0), a1 = *(const LAS f32x4*)(Am + (16 * bI + row) * DN_LDA + j0 + 4);
                            if (j0 >= 16 * bI) { a0 = (f32x4){0.f, 0.f, 0.f, 0.f}; a1 = a0; }
                            float xv[8];
#pragma unroll
                            for (int j = 0; j < 8; ++j) xv[j] = xb[(j0 + j) * DN_LDW + row];
                            acc = MFMA16(pack8(a0, a1), pack8((f32x4){xv[0], xv[1], xv[2], xv[3]}, (f32x4){xv[4], xv[5], xv[6], xv[7]}), acc); }
#pragma unroll
                        for (int r = 0; r < 4; ++r) { const int i = 16 * bI + 4 * quad + r; const float sc = isw ? bt[i] * __expf(Gc[i]) : bt[i]; xb[i * DN_LDW + row] = xb[i * DN_LDW + row] * sc - acc[r]; }
                    }
                }
                if (bI > 0) __syncthreads();
#pragma unroll
                for (int q = 0; q < 2; ++q) { const int nt = 2 * c.wave + q; const bool isw = nt >= 8; LAS float* xb = (isw ? ks : vs) + (nt & 7) * 16;
                    f32x4 a0 = {0.f, 0.f, 0.f, 0.f}, a1 = a0; float xv[8];
                    if (quad < 2) { a0 = *(const LAS f32x4*)(Ti + (bI * 16 + row) * 20 + 8 * quad); a1 = *(const LAS f32x4*)(Ti + (bI * 16 + row) * 20 + 8 * quad + 4); }
#pragma unroll
                    for (int j = 0; j < 8; ++j) { const int i = 16 * bI + ((8 * quad + j) & 15); float v = xb[i * DN_LDW + row];
                        if (bI == 0) v *= isw ? bt[i] * __expf(Gc[i]) : bt[i];
                        xv[j] = v; }
                    f32x4 acc = {0.f, 0.f, 0.f, 0.f};
                    acc = MFMA16(pack8(a0, a1), pack8((f32x4){xv[0], xv[1], xv[2], xv[3]}, (f32x4){xv[4], xv[5], xv[6], xv[7]}), acc);
#pragma unroll
                    for (int r = 0; r < 4; ++r) xb[(16 * bI + 4 * quad + r) * DN_LDW + row] = acc[r]; }
                __syncthreads();
            }
        }
        PP_TICK(4);
#pragma unroll
        for (int q = 0; q < 2; ++q) { const int p = tid + 512 * q, blk = p >> 6, mt = blk >> 2, s = blk & 3, cr = 16 * mt + row, k0 = 32 * s + 4 * quad;
            const f32x4 v0 = *(const LAS f32x4*)(ks + cr * DN_LDW + k0), v1 = *(const LAS f32x4*)(ks + cr * DN_LDW + k0 + 16);
            v4u w; w.x = cvtpk(-v0.x, -v0.y); w.y = cvtpk(-v0.z, -v0.w); w.z = cvtpk(-v1.x, -v1.y); w.w = cvtpk(-v1.z, -v1.w);
            *(v4u*)(img + (size_t)p * 16) = w; }
        {   unsigned char* ug = a->ws + WS_U + (size_t)item * 16384;
#pragma unroll
            for (int q = 0; q < 2; ++q) { const int p = tid + 512 * q, sl = p >> 7, ln = (p >> 1) & 63, hh = p & 1, v = 16 * sl + (ln & 15), qd = ln >> 4; float u8[8];
#pragma unroll
                for (int e = 0; e < 8; ++e) u8[e] = vs[(16 * (2 * hh + (e >> 2)) + 4 * qd + (e & 3)) * DN_LDW + v];
                v4u w; w.x = cvtpk(u8[0], u8[1]); w.y = cvtpk(u8[2], u8[3]); w.z = cvtpk(u8[4], u8[5]); w.w = cvtpk(u8[6], u8[7]);
                *(v4u*)(ug + (size_t)(sl * 64 + ln) * 32 + hh * 16) = w; } }
        PP_TICK(5);
    }
#if MK_PROBE_A >= 30 && MK_PROBE_A <= 36
    if (blockIdx.x == 0 && c.tid == 0) ((unsigned long long*)((unsigned*)(a->ws + WS_CTL) + 12288))[56 + l] = ppa;
#endif
}

constexpr int DN_OS = 2 * DN_IMG;
__device__ __forceinline__ void ph_dn_scan(KArgs a, const Ctx& c, int l) {
    LAS unsigned char* lds = c.lds;
    const int lane = c.lane, wv = c.wave, tid = c.tid; const bool cw = wv < 4;
    const bf16* ZB = (const bf16*)(a->ws + WS_ZB); bf16* YB = (bf16*)(a->ws + WS_YB); const float* onw = a->in[I_ONW] + l * 128; const float* glp = (const float*)(a->ws + WS_GL);
    for (int item = c.bid; item < NB * HB; item += c.G) {
        const int b = item >> 2, h = item & 3;
        const unsigned char* img0 = a->ws + WS_IMG + (size_t)item * 64 * DN_IMG;
        __syncthreads();
        if (cw) {
            const unsigned char* ugb = a->ws + WS_U + (size_t)item * 64 * 16384; const unsigned uoff = (unsigned)(2 * wv * 64 + lane) * 32u;
            f32x4 S[8][2];
#pragma unroll
            for (int m = 0; m < 8; ++m) { S[m][0] = (f32x4){0.f, 0.f, 0.f, 0.f}; S[m][1] = (f32x4){0.f, 0.f, 0.f, 0.f}; }
            v4u uc[4];
#pragma unroll
            for (int q = 0; q < 4; ++q) uc[q] = *(const v4u*)(ugb + uoff + (q >> 1) * 2048 + (q & 1) * 16);
#if MK_PROBE_A == 22 || MK_PROBE_A == 23
            unsigned tpa = 0, tq = (unsigned)__builtin_amdgcn_s_memrealtime();
#define DN_TICK(w) do { const unsigned t_ = (unsigned)__builtin_amdgcn_s_memrealtime(); if ((w) == MK_PROBE_A - 22) tpa += t_ - tq; tq = t_; } while (0)
#else
#define DN_TICK(w) do {} while (0)
#endif
            for (int n = 0; n <= NCH; ++n) {
                asm volatile("s_waitcnt lgkmcnt(0)\n\ts_barrier" ::: "memory");
                DN_TICK(0);
                if (n == NCH) break;
                v4u un[4];
#pragma unroll
                for (int q = 0; q < 4; ++q) un[q] = uc[q];
                if (n + 1 < NCH) {
#pragma unroll
                    for (int q = 0; q < 4; ++q) un[q] = *(const v4u*)(ugb + (size_t)(n + 1) * 16384 + uoff + (q >> 1) * 2048 + (q & 1) * 16); }
                const float gl = glp[item * 64 + n];
                const LAS unsigned char* im = lds + (n & 1) * DN_IMG + lane * 16;
                bf16x8 Sb[4][2];
#pragma unroll
                for (int s = 0; s < 4; ++s) { Sb[s][0] = pack8(S[2 * s][0], S[2 * s + 1][0]); Sb[s][1] = pack8(S[2 * s][1], S[2 * s + 1][1]); }
                f32x4 X[4][2];
#pragma unroll
                for (int nt = 0; nt < 2; ++nt) { const v4u u0 = uc[2 * nt], u1 = uc[2 * nt + 1];
                    X[0][nt] = (f32x4){bflo(u0.x), bfhi(u0.x), bflo(u0.y), bfhi(u0.y)}; X[1][nt] = (f32x4){bflo(u0.z), bfhi(u0.z), bflo(u0.w), bfhi(u0.w)};
                    X[2][nt] = (f32x4){bflo(u1.x), bfhi(u1.x), bflo(u1.y), bfhi(u1.y)}; X[3][nt] = (f32x4){bflo(u1.z), bfhi(u1.z), bflo(u1.w), bfhi(u1.w)}; }
                bf16x8 fa[8], fb[8];
#define DN_LDF(arr, off) do { _Pragma("unroll") for (int q_ = 0; q_ < 8; ++q_) arr[q_] = *(const LAS bf16x8*)(im + (off) + q_ * 1024); } while (0)
                DN_LDF(fa, 0); DN_LDF(fb, 8192);
#pragma unroll
                for (int mt = 0; mt < 2; ++mt)
#pragma unroll
                    for (int s = 0; s < 4; ++s) { X[mt][0] = MFMA16(fa[mt * 4 + s], Sb[s][0], X[mt][0]); X[mt][1] = MFMA16(fa[mt * 4 + s], Sb[s][1], X[mt][1]); }
                DN_LDF(fa, 16384);
#pragma unroll
                for (int mt = 0; mt < 2; ++mt)
#pragma unroll
                    for (int s = 0; s < 4; ++s) { X[2 + mt][0] = MFMA16(fb[mt * 4 + s], Sb[s][0], X[2 + mt][0]); X[2 + mt][1] = MFMA16(fb[mt * 4 + s], Sb[s][1], X[2 + mt][1]); }
                DN_LDF(fb, 16384 + 8192);
                f32x4 O[4][2];
#pragma unroll
                for (int mt = 0; mt < 2; ++mt) { O[mt][0] = (f32x4){0.f, 0.f, 0.f, 0.f}; O[mt][1] = (f32x4){0.f, 0.f, 0.f, 0.f};
#pragma unroll
                    for (int s = 0; s < 4; ++s) { O[mt][0] = MFMA16(fa[mt * 4 + s], Sb[s][0], O[mt][0]); O[mt][1] = MFMA16(fa[mt * 4 + s], Sb[s][1], O[mt][1]); } }
                DN_LDF(fa, 32768);
#pragma unroll
                for (int mt = 0; mt < 2; ++mt) { O[2 + mt][0] = (f32x4){0.f, 0.f, 0.f, 0.f}; O[2 + mt][1] = (f32x4){0.f, 0.f, 0.f, 0.f};
#pragma unroll
                    for (int s = 0; s < 4; ++s) { O[2 + mt][0] = MFMA16(fb[mt * 4 + s], Sb[s][0], O[2 + mt][0]); O[2 + mt][1] = MFMA16(fb[mt * 4 + s], Sb[s][1], O[2 + mt][1]); } }
                DN_LDF(fb, 32768 + 8192);
                bf16x8 Xb[2][2];
#pragma unroll
                for (int nt = 0; nt < 2; ++nt) { Xb[0][nt] = pack8(X[0][nt], X[1][nt]); Xb[1][nt] = pack8(X[2][nt], X[3][nt]); }
#pragma unroll
                for (int m = 0; m < 4; ++m) { S[m][0] = S[m][0] * gl; S[m][1] = S[m][1] * gl;
#pragma unroll
                    for (int s = 0; s < 2; ++s) { S[m][0] = MFMA16(fa[m * 2 + s], Xb[s][0], S[m][0]); S[m][1] = MFMA16(fa[m * 2 + s], Xb[s][1], S[m][1]); } }
                DN_LDF(fa, 49152);
#pragma unroll
                for (int m = 0; m < 4; ++m) { S[4 + m][0] = S[4 + m][0] * gl; S[4 + m][1] = S[4 + m][1] * gl;
#pragma unroll
                    for (int s = 0; s < 2; ++s) { S[4 + m][0] = MFMA16(fb[m * 2 + s], Xb[s][0], S[4 + m][0]); S[4 + m][1] = MFMA16(fb[m * 2 + s], Xb[s][1], S[4 + m][1]); } }
#pragma unroll
                for (int mt = 0; mt < 4; ++mt)
#pragma unroll
                    for (int s = 0; s < 2; ++s) { O[mt][0] = MFMA16(fa[mt * 2 + s], Xb[s][0], O[mt][0]); O[mt][1] = MFMA16(fa[mt * 2 + s], Xb[s][1], O[mt][1]); }
#undef DN_LDF
                LAS unsigned short* os = (LAS unsigned short*)(lds + DN_OS + (n & 1) * 16384);
#pragma unroll
                for (int mt = 0; mt < 4; ++mt)
#pragma unroll
                    for (int nt = 0; nt < 2; ++nt)
#pragma unroll
                        for (int r = 0; r < 4; ++r) os[(16 * mt + 4 * (lane >> 4) + r) * 128 + 32 * wv + 16 * nt + (lane & 15)] = (unsigned short)(cvtpk(O[mt][nt][r], 0.f) & 0xffffu);
#pragma unroll
                for (int q = 0; q < 4; ++q) uc[q] = un[q];
                asm volatile("s_waitcnt lgkmcnt(0)" ::: "memory"); DN_TICK(1);
            }
#if MK_PROBE_A == 22 || MK_PROBE_A == 23
            if (blockIdx.x == 0 && tid == 0) { unsigned long long* tsx = (unsigned long long*)((unsigned*)(a->ws + WS_CTL) + 12288) + 48 + l * 4; tsx[MK_PROBE_A - 22] = tpa; }
#endif
        } else {
            const int ht = tid - 256, hw = wv - 4, nr = ht >> 2, nq = ht & 3;
            const bf16* zpb = ZB + (size_t)(b * SEQ) * 512 + h * 128; bf16* ypb = YB + (size_t)(b * SEQ) * 512 + h * 128; const unsigned zoff = (unsigned)(nr * 512 + nq * 32);
#define DN_DMA(n, buf) do { _Pragma("unroll") for (int q_ = 0; q_ < 14; ++q_) { const int pc_ = hw + 4 * q_; \
                __builtin_amdgcn_global_load_lds((const unsigned*)(img0 + (size_t)(n) * DN_IMG + pc_ * 1024 + lane * 16), (LAS unsigned*)(lds + (buf) * DN_IMG + pc_ * 1024), 16, 0, 0); } } while (0)
            DN_DMA(0, 0);
            v4u zc[4];
#pragma unroll
            for (int q = 0; q < 4; ++q) zc[q] = *(const v4u*)(zpb + zoff + q * 8);
            asm volatile("s_waitcnt vmcnt(0) lgkmcnt(0)\n\ts_barrier" ::: "memory");
            DN_DMA(1, 1);
            for (int n = 1; n <= NCH; ++n) {
                if (n == 1) asm volatile("s_waitcnt vmcnt(0) lgkmcnt(0)\n\ts_barrier" ::: "memory"); else asm volatile("s_waitcnt vmcnt(4) lgkmcnt(0)\n\ts_barrier" ::: "memory");
                v4u zn[4];
#pragma unroll
                for (int q = 0; q < 4; ++q) zn[q] = zc[q];
                if (n < NCH) {
#pragma unroll
                    for (int q = 0; q < 4; ++q) zn[q] = *(const v4u*)(zpb + (size_t)n * DNC * 512 + zoff + q * 8); }
                asm volatile("" ::: "memory");
                if (n + 1 < NCH) DN_DMA(n + 1, (n + 1) & 1);
                asm volatile("" ::: "memory");
                {
                    const LAS unsigned short* os = (const LAS unsigned short*)(lds + DN_OS + ((n - 1) & 1) * 16384) + nr * 128 + nq * 32;
                    float o[32]; float ss = 0.f;
#pragma unroll
                    for (int q = 0; q < 4; ++q) { const v4u w = *(const LAS v4u*)(os + q * 8);
                        o[q * 8 + 0] = bflo(w.x); o[q * 8 + 1] = bfhi(w.x); o[q * 8 + 2] = bflo(w.y); o[q * 8 + 3] = bfhi(w.y); o[q * 8 + 4] = bflo(w.z); o[q * 8 + 5] = bfhi(w.z); o[q * 8 + 6] = bflo(w.w); o[q * 8 + 7] = bfhi(w.w); }
#pragma unroll
                    for (int e = 0; e < 32; ++e) ss += o[e] * o[e];
                    ss += dpp_f<0xB1>(ss); ss += dpp_f<0x4E>(ss);
                    const float rstd = __builtin_amdgcn_rsqf(ss * (1.f / 128.f) + EPS);
                    bf16* yp = ypb + (size_t)(n - 1) * DNC * 512 + zoff;
#pragma unroll
                    for (int q = 0; q < 4; ++q) { const f32x4 w0 = *(const f32x4*)(onw + nq * 32 + q * 8), w1 = *(const f32x4*)(onw + nq * 32 + q * 8 + 4); const v4u z = zc[q];
                        v4u y; y.x = cvtpk(o[q * 8 + 0] * rstd * w0.x * siluf_(bflo(z.x)), o[q * 8 + 1] * rstd * w0.y * siluf_(bfhi(z.x))); y.y = cvtpk(o[q * 8 + 2] * rstd * w0.z * siluf_(bflo(z.y)), o[q * 8 + 3] * rstd * w0.w * siluf_(bfhi(z.y)));
                        y.z = cvtpk(o[q * 8 + 4] * rstd * w1.x * siluf_(bflo(z.z)), o[q * 8 + 5] * rstd * w1.y * siluf_(bfhi(z.z))); y.w = cvtpk(o[q * 8 + 6] * rstd * w1.z * siluf_(bflo(z.w)), o[q * 8 + 7] * rstd * w1.w * siluf_(bfhi(z.w)));
                        *(v4u*)(yp + q * 8) = y; }
                }
#pragma unroll
                for (int q = 0; q < 4; ++q) zc[q] = zn[q];
            }
#undef DN_DMA
        }
        asm volatile("s_waitcnt vmcnt(0)" ::: "memory"); __syncthreads();
    }
}
typedef short v4i16_t __attribute__((ext_vector_type(4)));
#define MFMA32(a, b, c) __builtin_amdgcn_mfma_f32_32x32x16_bf16((a), (b), (c), 0, 0, 0)
constexpr int AT_ROWB = 144;
constexpr int AT_K = 0, AT_V = 2 * 64 * AT_ROWB, AT_OST = 4 * 64 * AT_ROWB, AT_BT = AT_OST + 8 * 32 * AT_ROWB, AT_KM = AT_BT + 1024, AT_UW = AT_KM + 4096;
__device__ __forceinline__ int crow(int r, int hi) { return (r & 3) + 8 * (r >> 2) + 4 * hi; }
__device__ __forceinline__ bf16x8 vtr2(const LAS unsigned char* p) {
    const v4i16_t lo = __builtin_amdgcn_ds_read_tr16_b64_v4i16((LAS v4i16_t*)p), hi = __builtin_amdgcn_ds_read_tr16_b64_v4i16((LAS v4i16_t*)(p + 8 * AT_ROWB));
    return (bf16x8){lo[0], lo[1], lo[2], lo[3], hi[0], hi[1], hi[2], hi[3]};
}
__device__ __forceinline__ void ph_attn(KArgs a, const Ctx& c, int l) {
    LAS unsigned char* lds = c.lds; const int lane = c.lane, wv = c.wave, tid = c.tid, r32 = lane & 31, hi = lane >> 5;
    LAS float* btab = (LAS float*)(lds + AT_BT); LAS float* kms = (LAS float*)(lds + AT_KM); volatile LAS int* uw = (volatile LAS int*)(lds + AT_UW);
    const bf16* QKVA = (const bf16*)(a->ws + WS_QKVA); const float* kmean = (const float*)(a->ws + WS_KMEAN); bf16* YA = (bf16*)(a->ws + WS_YA); const float* relb = a->in[I_RELB];
    unsigned* ctr = (unsigned*)(a->ws + WS_CTL) + CW_ACTR + l * 64;
    const float LOG2E = 1.4426950408889634f, C2 = 0.125f * LOG2E, NINF = -__builtin_inff();
    const int srow = tid >> 3, sch = tid & 7; const unsigned sdst = srow * AT_ROWB + sch * 16;
    for (;;) {
        __syncthreads();
        if (tid == 0) uw[0] = (int)__hip_atomic_fetch_add(ctr, 1u, RLX_AGENT);
        __syncthreads();
        const int u = uw[0];
        if (u >= NB * HA * NBLK) { if (u >= NB * HA * NBLK + CV_NUNITS) break; convert_unit(a, c, l, u - NB * HA * NBLK); continue; }
        const int qb = 15 - (u >> 5), bh = u & 31, b = bh >> 3, h = bh & 7;
        const float c31 = relb[31 * 8 + h];
        for (int i = tid; i < 129; i += NTHR) btab[i] = (i < 128 ? (relb[(int)T5B[i] * 8 + h] - c31) : 0.f) * LOG2E;
        for (int i = tid; i < 1024; i += NTHR) kms[i] = kmean[(size_t)bh * 1024 + i];
        const int qrel = wv * 32 + r32, tokq = b * SEQ + qb * 256 + qrel;
        const bf16* kbase = QKVA + (size_t)(b * SEQ) * 1536 + 512 + h * 64 + sch * 8;
        {   const int key0 = qb * 256; const v4u kr = *(const v4u*)(kbase + (size_t)(key0 + srow) * 1536), vr = *(const v4u*)(kbase + (size_t)(key0 + srow) * 1536 + 512);
            *(LAS v4u*)(lds + AT_K + sdst) = kr; *(LAS v4u*)(lds + AT_V + sdst) = vr; }
        float qf[32];
        {   const bf16* qp = QKVA + (size_t)tokq * 1536 + h * 64 + 8 * hi;
#pragma unroll
            for (int s = 0; s < 4; ++s) { const v4u w = *(const v4u*)(qp + 16 * s); qf[s * 8 + 0] = bflo(w.x); qf[s * 8 + 1] = bfhi(w.x); qf[s * 8 + 2] = bflo(w.y); qf[s * 8 + 3] = bfhi(w.y); qf[s * 8 + 4] = bflo(w.z); qf[s * 8 + 5] = bfhi(w.z); qf[s * 8 + 6] = bflo(w.w); qf[s * 8 + 7] = bfhi(w.w); } }
        __syncthreads();
        unsigned selmask = 0u;
        {   float g[16];
#pragma unroll
            for (int n = 0; n < 16; ++n) { g[n] = -3e38f;
                if (n < qb) { float d = 0.f;
#pragma unroll
                    for (int s = 0; s < 4; ++s) { const f32x4 k0 = *(const LAS f32x4*)(kms + n * 64 + 16 * s + 8 * hi), k1 = *(const LAS f32x4*)(kms + n * 64 + 16 * s + 8 * hi + 4);
                        d += qf[s * 8] * k0.x + qf[s * 8 + 1] * k0.y + qf[s * 8 + 2] * k0.z + qf[s * 8 + 3] * k0.w + qf[s * 8 + 4] * k1.x + qf[s * 8 + 5] * k1.y + qf[s * 8 + 6] * k1.z + qf[s * 8 + 7] * k1.w; }
                    g[n] = d + shx(d, 32, lane); } }
#pragma unroll
            for (int t = 0; t < 3; ++t) { float best = -3.4e38f; int bi = 0;
#pragma unroll
                for (int n = 0; n < 16; ++n) { const bool ok = !((selmask >> n) & 1u) && g[n] > best; best = ok ? g[n] : best; bi = ok ? n : bi; }
                selmask |= 1u << bi; }
            selmask &= (1u << qb) - 1u; }
        bf16x8 qs[4];
#pragma unroll
        for (int s = 0; s < 4; ++s) { v4u w; w.x = cvtpk(qf[s * 8] * C2, qf[s * 8 + 1] * C2); w.y = cvtpk(qf[s * 8 + 2] * C2, qf[s * 8 + 3] * C2); w.z = cvtpk(qf[s * 8 + 4] * C2, qf[s * 8 + 5] * C2); w.w = cvtpk(qf[s * 8 + 6] * C2, qf[s * 8 + 7] * C2); qs[s] = __builtin_bit_cast(bf16x8, w); }
        float m = NINF, lsum = 0.f; f32x16 o0, o1;
#pragma unroll
        for (int r = 0; r < 16; ++r) { o0[r] = 0.f; o1[r] = 0.f; }
        const int NT = 4 * (qb + 1);
        for (int t = 0; t < NT; ++t) {
            const int blk = t < 4 ? qb : ((t - 4) >> 2), kt = t < 4 ? t : ((t - 4) & 3);
            v4u kr = {0u, 0u, 0u, 0u}, vr = {0u, 0u, 0u, 0u};
            if (t + 1 < NT) { const int t1 = t + 1, blk1 = t1 < 4 ? qb : ((t1 - 4) >> 2), kt1 = t1 < 4 ? t1 : ((t1 - 4) & 3); const size_t ro = (size_t)(blk1 * 256 + kt1 * 64 + srow) * 1536;
                kr = *(const v4u*)(kbase + ro); vr = *(const v4u*)(kbase + ro + 512); }
            const bool own = t < 4;
            const bool lane_act = own || ((selmask >> blk) & 1u);
            const bool wave_act = own ? (kt * 64 <= wv * 32 + 31) : (__builtin_amdgcn_ballot_w64(lane_act) != 0ull);
            if (wave_act) {
                const LAS unsigned char* Kb = lds + AT_K + (t & 1) * 64 * AT_ROWB; const LAS unsigned char* Vb = lds + AT_V + (t & 1) * 64 * AT_ROWB;
                f32x16 p0, p1;
#pragma unroll
                for (int r = 0; r < 16; ++r) { p0[r] = 0.f; p1[r] = 0.f; }
#pragma unroll
                for (int s = 0; s < 4; ++s) { const bf16x8 a0 = *(const LAS bf16x8*)(Kb + r32 * AT_ROWB + 32 * s + 16 * hi), a1 = *(const LAS bf16x8*)(Kb + (32 + r32) * AT_ROWB + 32 * s + 16 * hi);
                    p0 = MFMA32(a0, qs[s], p0); p1 = MFMA32(a1, qs[s], p1); }
                if (own) {
#pragma unroll
                    for (int r = 0; r < 16; ++r) { const int d0 = qrel - (kt * 64 + crow(r, hi)), d1 = d0 - 32;
                        p0[r] = d0 >= 0 ? p0[r] + btab[d0 > 128 ? 128 : d0] : NINF; p1[r] = d1 >= 0 ? p1[r] + btab[d1 > 128 ? 128 : d1] : NINF; }
                } else if (blk == qb - 1 && kt >= 1) {
#pragma unroll
                    for (int r = 0; r < 16; ++r) { const int d0 = qrel + 256 - (kt * 64 + crow(r, hi)), d1 = d0 - 32;
                        p0[r] += btab[d0 > 128 ? 128 : d0]; p1[r] += btab[d1 > 128 ? 128 : d1]; }
                }
                float mx = fmaxf(p0[0], p1[0]);
#pragma unroll
                for (int r = 1; r < 16; ++r) mx = fmaxf(mx, fmaxf(p0[r], p1[r]));
                mx = fmaxf(mx, shx(mx, 32, lane));
                const float tmax = lane_act ? mx : NINF, mnew = fmaxf(m, tmax), alpha = __builtin_amdgcn_exp2f(m - mnew), muse = lane_act ? mnew : __builtin_inff();
                float rs = 0.f;
#pragma unroll
                for (int r = 0; r < 16; ++r) { p0[r] = __builtin_amdgcn_exp2f(p0[r] - muse); p1[r] = __builtin_amdgcn_exp2f(p1[r] - muse); rs += p0[r] + p1[r]; }
                lsum = lsum * alpha + rs; m = mnew;
                if (__builtin_amdgcn_ballot_w64(alpha != 1.f) != 0ull) {
#pragma unroll
                    for (int r = 0; r < 16; ++r) { o0[r] *= alpha; o1[r] *= alpha; } }
                bf16x8 pa[4];
                { v4u w; w.x = cvtpk(p0[0], p0[1]); w.y = cvtpk(p0[2], p0[3]); w.z = cvtpk(p0[4], p0[5]); w.w = cvtpk(p0[6], p0[7]); pa[0] = __builtin_bit_cast(bf16x8, w);
                  w.x = cvtpk(p0[8], p0[9]); w.y = cvtpk(p0[10], p0[11]); w.z = cvtpk(p0[12], p0[13]); w.w = cvtpk(p0[14], p0[15]); pa[1] = __builtin_bit_cast(bf16x8, w);
                  w.x = cvtpk(p1[0], p1[1]); w.y = cvtpk(p1[2], p1[3]); w.z = cvtpk(p1[4], p1[5]); w.w = cvtpk(p1[6], p1[7]); pa[2] = __builtin_bit_cast(bf16x8, w);
                  w.x = cvtpk(p1[8], p1[9]); w.y = cvtpk(p1[10], p1[11]); w.z = cvtpk(p1[12], p1[13]); w.w = cvtpk(p1[14], p1[15]); pa[3] = __builtin_bit_cast(bf16x8, w); }
                const LAS unsigned char* vp = Vb + (4 * hi + ((lane & 15) >> 2)) * AT_ROWB + 2 * (16 * ((lane >> 4) & 1) + 4 * (lane & 3));
#pragma unroll
                for (int ks = 0; ks < 4; ++ks) { const bf16x8 v0 = vtr2(vp + 16 * ks * AT_ROWB), v1 = vtr2(vp + 16 * ks * AT_ROWB + 64);
                    o0 = MFMA32(v0, pa[ks], o0); o1 = MFMA32(v1, pa[ks], o1); }
            }
            if (t + 1 < NT) { *(LAS v4u*)(lds + AT_K + ((t + 1) & 1) * 64 * AT_ROWB + sdst) = kr; *(LAS v4u*)(lds + AT_V + ((t + 1) & 1) * 64 * AT_ROWB + sdst) = vr; }
            __syncthreads();
        }
        lsum += shx(lsum, 32, lane);
        const float inv = 1.f / lsum;
        LAS unsigned short* stg = (LAS unsigned short*)(lds + AT_OST + wv * 32 * AT_ROWB);
#pragma unroll
        for (int r = 0; r < 16; ++r) { stg[r32 * (AT_ROWB / 2) + crow(r, hi)] = (unsigned short)(cvtpk(o0[r] * inv, 0.f) & 0xffffu); stg[r32 * (AT_ROWB / 2) + 32 + crow(r, hi)] = (unsigned short)(cvtpk(o1[r] * inv, 0.f) & 0xffffu); }
        LDS_WAIT();
#pragma unroll
        for (int i = 0; i < 4; ++i) { const int row = i * 8 + (lane >> 3), ch = lane & 7; const v4u v = *(const LAS v4u*)((const LAS unsigned char*)stg + row * AT_ROWB + ch * 16);
            *(v4u*)(YA + (size_t)(b * SEQ + qb * 256 + wv * 32 + row) * 512 + h * 64 + ch * 8) = v; }
    }
}
constexpr int NPH_LAYER = 11, NPHASES = 2 + NLAYER * NPH_LAYER;
#ifndef DN_IMPL
#define DN_IMPL 1
#endif
#ifndef PH_MASK
#define PH_MASK 0xFFFF
#endif
#define PH_EN(k) ((PH_MASK >> (k)) & 1)
#define GEMM_PHASE(EPI, SCHED, g, S, E) pg8::gemm_phase<EPI, SCHED, true, true>(c.lds, g, S, E, c.tid)

#define PHASE_FN static __device__ __forceinline__ void
__device__ __forceinline__ KArgs launder_k(KArgs a) { unsigned long long v = (unsigned long long)a; asm volatile("" : "+s"(v)); return (KArgs)v; }
PHASE_FN f_mod(KArgs a, int& tid) { a = launder_k(a); Ctx c = make_ctx(tid); ph_mod(a, c); }
PHASE_FN f_norm1(KArgs a, int& tid, int l) { a = launder_k(a); Ctx c = make_ctx(tid); ph_norm1(a, c, l); __syncthreads(); ph_convert(a, c, l); }
PHASE_FN f_proj(KArgs a, int& tid) { a = launder_k(a); Ctx c = make_ctx(tid);
    pg8::Gemm g{(const bf16*)(a->ws + WS_H), (const bf16*)(a->ws + WS_WIN), NTOK, DINP, DM}; pg8::StaticOrder S; S.init(NTOK, DINP, c.G, c.bid);
    EpiProj E{a->ws}; GEMM_PHASE(EpiProj, pg8::StaticOrder, g, S, E); }
PHASE_FN f_kmean(KArgs a, int& tid) { a = launder_k(a); Ctx c = make_ctx(tid); ph_kmean(a, c); }
#ifndef ATTN_IMPL
#define ATTN_IMPL 1
#endif
#if ATTN_IMPL
PHASE_FN f_attn(KArgs a, int& tid, int l) { a = launder_k(a); Ctx c = make_ctx(tid); ph_attn(a, c, l); }
#else
PHASE_FN f_attn(KArgs a, int& tid, int l) { a = launder_k(a); Ctx c = make_ctx(tid); ph_attn_simple(a, c); }
#endif
PHASE_FN f_dn(KArgs a, int& tid, int l) { a = launder_k(a); Ctx c = make_ctx(tid); ph_dn_simple(a, c, l); }
PHASE_FN f_dn_prep(KArgs a, int& tid, int l) { a = launder_k(a); Ctx c = make_ctx(tid); ph_dn_prep(a, c, l); }
PHASE_FN f_dn_scan(KArgs a, int& tid, int l) { a = launder_k(a); Ctx c = make_ctx(tid); ph_dn_scan(a, c, l); }
PHASE_FN f_merge1(KArgs a, int& tid) { a = launder_k(a); Ctx c = make_ctx(tid);
    pg8::Gemm g{(const bf16*)(a->ws + WS_YA), (const bf16*)(a->ws + WS_WUPA), NTOK, DM, WA}; pg8::StaticOrder S; S.init(NTOK, DM, c.G, c.bid);
    EpiMerge<false> E{a->ws}; GEMM_PHASE(EpiMerge<false>, pg8::StaticOrder, g, S, E); }
PHASE_FN f_merge2(KArgs a, int& tid) { a = launder_k(a); Ctx c = make_ctx(tid);
    pg8::Gemm g{(const bf16*)(a->ws + WS_YB), (const bf16*)(a->ws + WS_WUPB), NTOK, DM, WB}; pg8::StaticOrder S; S.init(NTOK, DM, c.G, c.bid);
    EpiMerge<true> E{a->ws}; GEMM_PHASE(EpiMerge<true>, pg8::StaticOrder, g, S, E); }
PHASE_FN f_out(KArgs a, int& tid, int l) { a = launder_k(a); Ctx c = make_ctx(tid);
    pg8::Gemm g{(const bf16*)(a->ws + WS_M), (const bf16*)(a->ws + WS_WOUT), NTOK, DM, DM}; pg8::StaticOrder S; S.init(NTOK, DM, c.G, c.bid);
    EpiOut E{l == 0 ? a->in[I_X] : (const float*)a->out, a->out, (const float*)(a->ws + WS_MOD) + l * 4 * 6144 + 2048}; GEMM_PHASE(EpiOut, pg8::StaticOrder, g, S, E); }
PHASE_FN f_router(KArgs a, int& tid, int l) { a = launder_k(a); Ctx c = make_ctx(tid); ph_router(a, c, l); }
PHASE_FN f_gather(KArgs a, int& tid, int l) { a = launder_k(a); Ctx c = make_ctx(tid); ph_gather(a, c, l); }
PHASE_FN f_moe_gu(KArgs a, int& tid, int l) { a = launder_k(a); Ctx c = make_ctx(tid);
    moe_table(a, c, l); const LAS int* te = (const LAS int*)(c.lds + MISC_OFF + 2048);
    pg8::Gemm g{(const bf16*)(a->ws + WS_HS), (const bf16*)(a->ws + WS_WEGU), MOE_MAXROWS, NEXP * 512, DM}; MoeOrder S{te, te[192 + 32] * 2, c.G, c.bid, 1};
    EpiMoeGU E{a->ws}; GEMM_PHASE(EpiMoeGU, MoeOrder, g, S, E); }
PHASE_FN f_moe_down(KArgs a, int& tid, int l) { a = launder_k(a); Ctx c = make_ctx(tid);
    moe_table(a, c, l); const LAS int* te = (const LAS int*)(c.lds + MISC_OFF + 2048);
    pg8::Gemm g{(const bf16*)(a->ws + WS_ACT), (const bf16*)(a->ws + WS_WED), MOE_MAXROWS, NEXP * 1024, DFF}; MoeOrder S{te, te[192 + 32] * 4, c.G, c.bid, 2};
    EpiMoeDown E{a->ws}; GEMM_PHASE(EpiMoeDown, MoeOrder, g, S, E); }
PHASE_FN f_final(KArgs a, int& tid) { a = launder_k(a); Ctx c = make_ctx(tid); ph_final(a, c); }

#define KA() launder_k((KArgs)__builtin_amdgcn_kernarg_segment_ptr())
__device__ __forceinline__ bool ph_in(int k) { KArgs a = KA(); return a->ph_lo <= k && k < a->ph_hi; }
#ifndef MK_PROBE_A
#define MK_PROBE_A -1
#endif
#ifndef MK_PROBE_B
#define MK_PROBE_B -1
#endif
constexpr int CW_TS = 12288;
__device__ __forceinline__ void grid_bar(int& tid, int k) {
    asm volatile("" : "+v"(tid));
#if MK_ONE_LAUNCH
    KArgs a = KA(); XcdBarrier b; b.bar = (unsigned*)(a->ws + WS_CTL) + CW_BAR; b.x = xb_xcc_id(); b.st = (volatile LAS unsigned*)((LAS unsigned char*)lds_raw + MISC_OFF) + 8;
    xcd_barrier(b, tid);
    if (MK_PROBE_A >= 0 && blockIdx.x == 0 && tid == 0) ((unsigned long long*)((unsigned*)(a->ws + WS_CTL) + CW_TS))[k + 1] = __builtin_amdgcn_s_memrealtime();
#else
    __syncthreads();
#endif
}
__global__ void __launch_bounds__(NTHR, 2) mk_fwd(Args a_) {
    int tid = threadIdx.x;
    {   volatile LAS unsigned* MISC = (volatile LAS unsigned*)((LAS unsigned char*)lds_raw + MISC_OFF);
        if (tid < 64) MISC[tid] = 0u;
        __syncthreads();
#if MK_ONE_LAUNCH
        (void)xcd_barrier_post((unsigned*)(KA()->ws + WS_CTL) + CW_BAR, MISC + 8, tid);
#endif
        if (MK_PROBE_A >= 0 && blockIdx.x == 0 && tid == 0) ((unsigned long long*)((unsigned*)(KA()->ws + WS_CTL) + CW_TS))[0] = __builtin_amdgcn_s_memrealtime();
    }
#define IN(k) ph_in(k)
#define SEAM(k) do { if (IN(k) && IN((k) + 1)) grid_bar(tid, (k)); } while (0)
    if (IN(0)) f_mod(KA(), tid); SEAM(0);
    for (int l = 0; l < NLAYER; ++l) {
        const int pb = 1 + l * NPH_LAYER;
        if (PH_EN(0) && IN(pb + 0)) f_norm1(KA(), tid, l); SEAM(pb + 0);
        if (PH_EN(1) && IN(pb + 1)) f_proj(KA(), tid); SEAM(pb + 1);
#if DN_IMPL
        if (PH_EN(2) && IN(pb + 2)) { f_kmean(KA(), tid); f_dn_prep(KA(), tid, l); } SEAM(pb + 2);
        if (PH_EN(3) && IN(pb + 3)) { f_dn_scan(KA(), tid, l);
            if (MK_PROBE_A >= 0 && blockIdx.x == 0 && tid == 0) ((unsigned long long*)((unsigned*)(KA()->ws + WS_CTL) + CW_TS))[40 + l] = __builtin_amdgcn_s_memrealtime();
            __syncthreads(); f_attn(KA(), tid, l);
            if (MK_PROBE_A >= 0 && blockIdx.x == 255 && tid == 0) ((unsigned long long*)((unsigned*)(KA()->ws + WS_CTL) + CW_TS))[44 + l] = __builtin_amdgcn_s_memrealtime(); } SEAM(pb + 3);
#else
        if (PH_EN(2) && IN(pb + 2)) f_kmean(KA(), tid); SEAM(pb + 2);
        if (PH_EN(3) && IN(pb + 3)) { f_attn(KA(), tid, l); __syncthreads(); f_dn(KA(), tid, l); } SEAM(pb + 3);
#endif
        if (PH_EN(4) && IN(pb + 4)) f_merge1(KA(), tid); SEAM(pb + 4);
        if (PH_EN(5) && IN(pb + 5)) f_merge2(KA(), tid); SEAM(pb + 5);
        if (PH_EN(6) && IN(pb + 6)) f_out(KA(), tid, l); SEAM(pb + 6);
        if (PH_EN(7) && IN(pb + 7)) f_router(KA(), tid, l); SEAM(pb + 7);
        if (PH_EN(8) && IN(pb + 8)) f_gather(KA(), tid, l); SEAM(pb + 8);
        if (PH_EN(9) && IN(pb + 9)) f_moe_gu(KA(), tid, l); SEAM(pb + 9);
        if (PH_EN(10) && IN(pb + 10)) f_moe_down(KA(), tid, l); SEAM(pb + 10);
    }
    if (IN(NPHASES - 1)) f_final(KA(), tid);
#undef IN
#undef SEAM
}

extern "C" void kernel_launch(void* const* d_in, const int* in_sizes, int n_in, void* d_out, int out_size, void* d_ws, size_t ws_size, hipStream_t stream) {
    static int grid = 0;
    if (grid == 0) {
        if (n_in != 23 || out_size != NTOK * DM || ws_size < WS_END) { fprintf(stderr, "kernel_launch: unexpected shapes (n_in %d out %d ws %zu)\n", n_in, out_size, ws_size); grid = -1; return; }
        int dev = 0, cus = 0, per_cu = 0;
        if (hipGetDevice(&dev) != hipSuccess || hipDeviceGetAttribute(&cus, hipDeviceAttributeMultiprocessorCount, dev) != hipSuccess) { grid = -1; return; }
        if (hipFuncSetAttribute((const void*)mk_fwd, hipFuncAttributeMaxDynamicSharedMemorySize, LDS_BYTES) != hipSuccess) { fprintf(stderr, "kernel_launch: hipFuncSetAttribute failed\n"); grid = -1; return; }
        if (hipOccupancyMaxActiveBlocksPerMultiprocessor(&per_cu, (const void*)mk_fwd, NTHR, LDS_BYTES) != hipSuccess || per_cu < 1) { fprintf(stderr, "kernel_launch: occupancy query says %d\n", per_cu); (void)hipGetLastError(); grid = -1; return; }
        grid = cus;
    }
    if (grid < 0) return;
    (void)hipMemsetAsync((char*)d_ws + WS_CTL, 0, CTL_ZERO_BYTES, stream);
    Args a{};
    for (int i = 0; i < 23; ++i) a.in[i] = (const float*)d_in[i];
    a.out = (float*)d_out; a.ws = (unsigned char*)d_ws;
#if MK_ONE_LAUNCH
    a.ph_lo = 0; a.ph_hi = NPHASES;
    hipLaunchKernelGGL(mk_fwd, dim3(grid), dim3(NTHR), LDS_BYTES, stream, a);
#else
    for (int p = 0; p < NPHASES; ++p) { a.ph_lo = p; a.ph_hi = p + 1; hipLaunchKernelGGL(mk_fwd, dim3(grid), dim3(NTHR), LDS_BYTES, stream, a); }
#endif
}
```

```cpp
#include <hip/hip_runtime.h>
#include <cstdio>
#include <cstdint>
#ifndef MK_ONE_LAUNCH
#define MK_ONE_LAUNCH 1
#endif
#ifndef MK_PROBE_A
#define MK_PROBE_A -1
#endif
#ifndef MK_PROBE_B
#define MK_PROBE_B -1
#endif
namespace pg8 {
#define PG8_LAS __attribute__((address_space(3)))
typedef unsigned short bf16_t;
typedef short bf16x8 __attribute__((ext_vector_type(8)));
typedef float f32x4 __attribute__((ext_vector_type(4)));
typedef unsigned u32x4 __attribute__((ext_vector_type(4)));
constexpr int BM = 256, BK = 64, HALF = 128, HTB = HALF * BK * 2  , STAGE_BYTES = 8 * HTB, NXCD = 8, WGM = 8;

__host__ __device__ __forceinline__ int lds_byte(int r, int c) { const int st = (r >> 4) * 2 + (c >> 5), rr = r & 15, cc = c & 31, ob = rr * 64 + cc * 2; return st * 1024 + (ob ^ (((ob >> 9) & 1) << 5)); }
__host__ __device__ __forceinline__ void stage_rc(int b, int& R, int& C) { const int st = b / 1024, sb = b % 1024, swz = sb ^ (((sb >> 9) & 1) << 5); R = (st >> 1) * 16 + swz / 64; C = (st & 1) * 32 + (swz % 64) / 2; }
__host__ __device__ __forceinline__ int perm32(int rho) { const int n = rho >> 4, i = rho & 15; return 8 * (i >> 2) + 4 * n + (i & 3); }

struct Unit { int pm, pn; };
struct Gemm { const bf16_t* A; const bf16_t* Bt; int M, N, K; };

struct StaticOrder {
    int nM, nN, nwg, G, c;
    __host__ __device__ void init(int M, int N, int G_, int c_) { nM = M / BM; nN = N / BM; nwg = nM * nN; G = G_; c = c_; }
    __host__ __device__ bool next(int i, Unit& u) const {
        const long L = (long)i * G + c; if (L >= nwg) return false;
        int wgid = (int)L; { const int q = nwg / NXCD, r = nwg % NXCD, xcd = wgid % NXCD, off = wgid / NXCD; wgid = (xcd < r ? xcd * (q + 1) : r * (q + 1) + (xcd - r) * q) + off; }
        const int nig = WGM * nN, gid = wgid / nig, fm = gid * WGM, gsz = (nM - fm) < WGM ? (nM - fm) : WGM;
        u.pm = fm + ((wgid % nig) % gsz); u.pn = (wgid % nig) / gsz; return true;
    }
    __device__ __forceinline__ void a_ready(const Unit&) const {}
    __device__ __forceinline__ void done(const Unit&) const {}
};

__device__ __forceinline__ unsigned cvt_pk_bf16(float lo, float hi) { unsigned r; asm volatile("v_cvt_pk_bf16_f32 %0, %1, %2" : "=v"(r) : "v"(lo), "v"(hi)); return r; }
typedef float f32x2 __attribute__((ext_vector_type(2)));
template <class Epi, class Sched, bool ALIGN_EPI = false, bool SP2 = false>
__device__ __forceinline__ void gemm_phase(PG8_LAS unsigned char* lds, const Gemm g, const Sched& S, const Epi& E, const int tid_in) {
    const int tid = tid_in, wid = __builtin_amdgcn_readfirstlane(tid >> 6), lane = tid & 63, wr = wid >> 2, wc = wid & 3, fr = lane & 15, fq = lane >> 4;
    const int K = g.K, nt = K / BK;
    unsigned voffA[2], voffB[2];
#pragma unroll
    for (int i = 0; i < 2; ++i) { int R, C; stage_rc(tid * 16 + i * 8192, R, C); const int Rb = Epi::PERM ? ((R & ~31) + perm32(R & 31)) : R;
        voffA[i] = (unsigned)(R * K + C) * 2u; voffB[i] = (unsigned)(Rb * K + C) * 2u; }
    const size_t kstep = (size_t)(BK * 2);
    const size_t hstep = (size_t)HALF * K * 2;
    const size_t tstep = 2 * hstep;
    const unsigned ldsw = (unsigned)wid * 1024u;
    const int aoff = lds_byte(wr * 64 + fr, fq * 8), boff = lds_byte(wc * 32 + fr, fq * 8);
#define PG8_SA(b, h) (((b) * 2 + (h)) * HTB)
#define PG8_SB(b, h) ((4 + (b) * 2 + (h)) * HTB)
#define PG8_STAGE(bufoff, gbase, voff) do { _Pragma("unroll") for (int _i = 0; _i < 2; ++_i) \
        __builtin_amdgcn_global_load_lds((const unsigned*)((const char*)(gbase) + (voff)[_i]), (PG8_LAS unsigned*)(lds + (bufoff) + ldsw + _i * 8192), 16, 0, 0); } while (0)
#define PG8_LDA(dst, b, h) do { _Pragma("unroll") for (int m = 0; m < 4; ++m) _Pragma("unroll") for (int k = 0; k < 2; ++k) dst[m][k] = *(const PG8_LAS bf16x8*)(lds + PG8_SA(b, h) + aoff + m * 2048 + k * 1024); } while (0)
#define PG8_LDB(dst, b, h) do { _Pragma("unroll") for (int n = 0; n < 2; ++n) _Pragma("unroll") for (int k = 0; k < 2; ++k) dst[n][k] = *(const PG8_LAS bf16x8*)(lds + PG8_SB(b, h) + boff + n * 2048 + k * 1024); } while (0)
#define PG8_MMA(ai, bj, At, Bt) do { __builtin_amdgcn_s_setprio(1); _Pragma("unroll") for (int m = 0; m < 4; ++m) _Pragma("unroll") for (int n = 0; n < 2; ++n) _Pragma("unroll") for (int k = 0; k < 2; ++k) \
        acc[ai][bj][m][n] = __builtin_amdgcn_mfma_f32_16x16x32_bf16(Bt[n][k], At[m][k], acc[ai][bj][m][n], 0, 0, 0); __builtin_amdgcn_s_setprio(0); } while (0)
#define PG8_WAIT_V(n) asm volatile("s_waitcnt vmcnt(" #n ")" ::: "memory")
#define PG8_WAIT_L(n) asm volatile("s_waitcnt lgkmcnt(" #n ")" ::: "memory")
#define PG8_BAR __builtin_amdgcn_s_barrier()
#define PG8_SCHED __builtin_amdgcn_sched_barrier(0)
    Unit cur, nxt; int ui = 0;
    if (!S.next(0, cur)) return;
    f32x4 acc[2][2][4][2];
    float zf_ = 0.f; asm volatile("" : "+v"(zf_));
#pragma unroll
    for (int a = 0; a < 2; ++a)
#pragma unroll
        for (int b = 0; b < 2; ++b)
#pragma unroll
            for (int m = 0; m < 4; ++m)
#pragma unroll
                for (int n = 0; n < 2; ++n) acc[a][b][m][n] = (f32x4){zf_, zf_, zf_, zf_};
    bf16x8 At[4][2], B0[2][2], B1[2][2];
    const char* cA = (const char*)g.A + (size_t)cur.pm * tstep; const char* cB = (const char*)g.Bt + (size_t)cur.pn * tstep;
    S.a_ready(cur);
    if constexpr (SP2) {
        PG8_STAGE(PG8_SB(0, 0), cB, voffB); PG8_STAGE(PG8_SB(0, 1), cB + hstep, voffB); PG8_STAGE(PG8_SA(0, 0), cA, voffA); PG8_STAGE(PG8_SA(0, 1), cA + hstep, voffA);
        if (wr == 1) PG8_BAR;
        PG8_WAIT_V(2); PG8_BAR;
        PG8_STAGE(PG8_SB(1, 0), cB + kstep, voffB); PG8_STAGE(PG8_SA(1, 0), cA + kstep, voffA); PG8_STAGE(PG8_SB(1, 1), cB + hstep + kstep, voffB);
        PG8_WAIT_V(6); PG8_BAR;
    } else {
        PG8_STAGE(PG8_SB(0, 0), cB, voffB); PG8_STAGE(PG8_SA(0, 0), cA, voffA); PG8_STAGE(PG8_SB(0, 1), cB + hstep, voffB); PG8_STAGE(PG8_SA(0, 1), cA + hstep, voffA);
        if (wr == 1) PG8_BAR;
        PG8_WAIT_V(4); PG8_BAR;
        PG8_STAGE(PG8_SB(1, 0), cB + kstep, voffB); PG8_STAGE(PG8_SA(1, 0), cA + kstep, voffA); PG8_STAGE(PG8_SB(1, 1), cB + hstep + kstep, voffB);
        PG8_WAIT_V(6); PG8_BAR;
    }
    for (;;) {
        const bool has_next = S.next(ui + 1, nxt);
        const char* nA = has_next ? (const char*)g.A + (size_t)nxt.pm * tstep : cA; const char* nB = has_next ? (const char*)g.Bt + (size_t)nxt.pn * tstep : cB;
        for (int t = 0; t < nt; t += 2) {
            const bool last = (t == nt - 2);
            const char* a1 = cA + (size_t)(t + 1) * kstep;
            const char* a2 = last ? nA : cA + (size_t)(t + 2) * kstep; const char* b2 = last ? nB : cB + (size_t)(t + 2) * kstep;
            const char* a3 = a2 + kstep; const char* b3 = b2 + kstep;
            if (last && has_next) S.a_ready(nxt);
            if constexpr (SP2) {
            PG8_LDB(B0, 0, 0); PG8_LDB(B1, 0, 1); PG8_SCHED; PG8_LDA(At, 0, 0); PG8_STAGE(PG8_SA(1, 1), a1 + hstep, voffA);
            PG8_WAIT_V(8); PG8_WAIT_L(0); PG8_BAR; PG8_MMA(0, 0, At, B0); PG8_MMA(0, 1, At, B1); PG8_BAR; PG8_SCHED;
            PG8_LDA(At, 0, 1); PG8_STAGE(PG8_SB(0, 0), b2, voffB); PG8_STAGE(PG8_SB(0, 1), b2 + hstep, voffB); PG8_STAGE(PG8_SA(0, 0), a2, voffA);
            PG8_WAIT_V(8); PG8_WAIT_L(0); PG8_BAR; PG8_MMA(1, 0, At, B0); PG8_MMA(1, 1, At, B1); PG8_BAR; PG8_SCHED;
            PG8_LDB(B0, 1, 0); PG8_LDB(B1, 1, 1); PG8_SCHED; PG8_LDA(At, 1, 0); PG8_STAGE(PG8_SA(0, 1), a2 + hstep, voffA);
            PG8_WAIT_V(8); PG8_WAIT_L(0); PG8_BAR; PG8_MMA(0, 0, At, B0); PG8_MMA(0, 1, At, B1); PG8_BAR; PG8_SCHED;
            PG8_LDA(At, 1, 1); PG8_STAGE(PG8_SB(1, 0), b3, voffB); PG8_STAGE(PG8_SB(1, 1), b3 + hstep, voffB); PG8_STAGE(PG8_SA(1, 0), a3, voffA);
            PG8_WAIT_V(8); PG8_WAIT_L(0); PG8_BAR; PG8_MMA(1, 0, At, B0); PG8_MMA(1, 1, At, B1); PG8_BAR; PG8_SCHED;
            } else {
            PG8_LDB(B0, 0, 0); PG8_SCHED; PG8_LDA(At, 0, 0); PG8_STAGE(PG8_SA(1, 1), a1 + hstep, voffA);
            PG8_WAIT_L(8); PG8_BAR; PG8_WAIT_L(0); PG8_MMA(0, 0, At, B0); PG8_BAR; PG8_SCHED;
            PG8_LDB(B1, 0, 1); PG8_STAGE(PG8_SB(0, 0), b2, voffB);
            PG8_BAR; PG8_WAIT_L(0); PG8_MMA(0, 1, At, B1); PG8_BAR;
            PG8_LDA(At, 0, 1); PG8_STAGE(PG8_SA(0, 0), a2, voffA);
            PG8_BAR; PG8_WAIT_L(0); PG8_MMA(1, 0, At, B0); PG8_BAR; PG8_SCHED;
            PG8_STAGE(PG8_SB(0, 1), b2 + hstep, voffB);
            PG8_WAIT_V(6); PG8_BAR; PG8_MMA(1, 1, At, B1); PG8_BAR;
            PG8_LDB(B0, 1, 0); PG8_SCHED; PG8_LDA(At, 1, 0); PG8_STAGE(PG8_SA(0, 1), a2 + hstep, voffA);
            PG8_WAIT_L(8); PG8_BAR; PG8_WAIT_L(0); PG8_MMA(0, 0, At, B0); PG8_BAR; PG8_SCHED;
            PG8_LDB(B1, 1, 1); PG8_STAGE(PG8_SB(1, 0), b3, voffB);
            PG8_BAR; PG8_WAIT_L(0); PG8_MMA(0, 1, At, B1); PG8_BAR;
            PG8_LDA(At, 1, 1); PG8_STAGE(PG8_SA(1, 0), a3, voffA);
            PG8_BAR; PG8_WAIT_L(0); PG8_MMA(1, 0, At, B0); PG8_BAR; PG8_SCHED;
            PG8_STAGE(PG8_SB(1, 1), b3 + hstep, voffB);
            PG8_WAIT_V(6); PG8_BAR; PG8_MMA(1, 1, At, B1); PG8_BAR;
            }
        }
        if constexpr (ALIGN_EPI) { if (wr == 0) PG8_BAR; }
        if constexpr (!Epi::AFTER_DRAIN) { int te_ = tid_in; asm volatile("" : "+v"(te_)); E(acc, cur, wr, wc, te_ & 15, (te_ & 63) >> 4); S.done(cur); }
        if (!has_next) break;
        zf_ = 0.f; asm volatile("" : "+v"(zf_));
#pragma unroll
        for (int a = 0; a < 2; ++a)
#pragma unroll
            for (int b = 0; b < 2; ++b)
#pragma unroll
                for (int m = 0; m < 4; ++m)
#pragma unroll
                    for (int n = 0; n < 2; ++n) acc[a][b][m][n] = (f32x4){zf_, zf_, zf_, zf_};
        cur = nxt; cA = nA; cB = nB; ++ui;
        if constexpr (ALIGN_EPI) { if (wr == 1) PG8_BAR; }
    }
    PG8_WAIT_V(0);
    if constexpr (!ALIGN_EPI) { if (wr == 0) PG8_BAR; }
    PG8_BAR;
    if constexpr (Epi::AFTER_DRAIN) { E.fused(acc, cur, wr, wc, fr, fq, lds, wid, lane); S.done(cur); }
#undef PG8_SA
#undef PG8_SB
#undef PG8_STAGE
#undef PG8_LDA
#undef PG8_LDB
#undef PG8_MMA
#undef PG8_WAIT_V
#undef PG8_WAIT_L
#undef PG8_BAR
#undef PG8_SCHED
}
}
constexpr int NW = 8, NTHR = 512;
constexpr int DM = 1024, NB = 4, SEQ = 4096, NTOK = NB * SEQ, NLAYER = 2;
constexpr int HA = 8, HDA = 64, WA = 512, MBLK = 256, NBLK = SEQ / MBLK;
constexpr int HB = 4, HDB = 128, WB = 512, CONVK = 4, DNC = 64, NCH = SEQ / DNC;
constexpr int NGRP = 4, EPG = 8, NEXP = 32, DFF = 256;
constexpr int DIN = 5640, DINP = 5632, NMOD = 6;
constexpr int C_QKVA = 0, C_QKVB = 1536, C_ZB = 3072, C_BA = 3584, C_GATE = 3592;
constexpr float EPS = 1e-6f;
constexpr int MOE_MAXROWS = 2 * NTOK + NEXP * 256;
constexpr int MOE_MAXTILES = MOE_MAXROWS / 256;

constexpr size_t MiB = 1u << 20;
constexpr size_t WS_CTL = 0, CTL_ZERO_BYTES = 1 * MiB;
constexpr size_t WS_MOD = 1 * MiB;
constexpr size_t WS_WIN = 2 * MiB;
constexpr size_t WS_WUPA = 13 * MiB, WS_WUPB = 14 * MiB;
constexpr size_t WS_WOUT = 15 * MiB;
constexpr size_t WS_WEGU = 17 * MiB;
constexpr size_t WS_WED = 49 * MiB;
constexpr size_t WS_SMALL = 65 * MiB;
constexpr size_t WS_KMEAN = WS_SMALL;
constexpr size_t WS_BETA = WS_SMALL + 256 * 1024;
constexpr size_t WS_GLOG = WS_SMALL + 512 * 1024;
constexpr size_t WS_TOKINFO = WS_SMALL + 1 * MiB;
constexpr size_t WS_ROWTOK = WS_SMALL + 2 * MiB;
constexpr size_t WS_ROWW = WS_SMALL + 3 * MiB;
constexpr size_t WS_GL = WS_SMALL + 4 * MiB;
constexpr size_t WS_SSQ = WS_SMALL + 5 * MiB;
constexpr size_t WS_H = 72 * MiB;
constexpr size_t WS_QKVA = 104 * MiB;
constexpr size_t WS_QKVB = 152 * MiB;
constexpr size_t WS_ZB = 200 * MiB;
constexpr size_t WS_GATES = 216 * MiB;
constexpr size_t WS_IMG = 280 * MiB;
constexpr size_t WS_YA = 72 * MiB, WS_YB = 336 * MiB;
constexpr size_t WS_END = 352 * MiB;
constexpr size_t WS_M = WS_QKVB;
constexpr size_t WS_U = 88 * MiB;
constexpr size_t WS_HS = WS_QKVA;
constexpr size_t WS_ACT = 184 * MiB;
constexpr size_t WS_YS = WS_GATES;
constexpr int CW_TMO = 0;
constexpr int CW_BAR = 4096;
constexpr int CW_GCNT = 8192;
constexpr int CW_ACTR = 8320;

constexpr int RING_BYTES = 131072;
constexpr int MISC_OFF = 147456;
constexpr int LDS_BYTES = 151552;

#define GAS __attribute__((address_space(1)))
#define LAS __attribute__((address_space(3)))
typedef unsigned short bf16;
typedef unsigned v4u __attribute__((ext_vector_type(4)));
typedef unsigned v2u __attribute__((ext_vector_type(2)));
typedef float f32x4 __attribute__((ext_vector_type(4)));
typedef float f32x16 __attribute__((ext_vector_type(16)));
typedef short bf16x8 __attribute__((ext_vector_type(8)));
typedef GAS unsigned gu32;
#define RLX_AGENT __ATOMIC_RELAXED, __HIP_MEMORY_SCOPE_AGENT
#define LDS_WAIT() asm volatile("s_waitcnt lgkmcnt(0)" ::: "memory")
#define VM_WAIT() asm volatile("s_waitcnt vmcnt(0)" ::: "memory")
__device__ __forceinline__ unsigned f2bf(float f) { unsigned u = __builtin_bit_cast(unsigned, f); return (u + 0x7fffu + ((u >> 16) & 1u)) >> 16; }
__device__ __forceinline__ unsigned pk2(float lo, float hi) { return f2bf(lo) | (f2bf(hi) << 16); }
__device__ __forceinline__ float bf2f(unsigned b) { return __builtin_bit_cast(float, b << 16); }
__device__ __forceinline__ float bflo(unsigned w) { return __builtin_bit_cast(float, w << 16); }
__device__ __forceinline__ float bfhi(unsigned w) { return __builtin_bit_cast(float, w & 0xffff0000u); }
__device__ __forceinline__ float rcpf_(float x) { return __builtin_amdgcn_rcpf(x); }
__device__ __forceinline__ float sigmoidf_(float x) { return rcpf_(1.f + __builtin_amdgcn_exp2f(-1.4426950408889634f * x)); }
__device__ __forceinline__ float siluf_(float x) { return x * rcpf_(1.f + __builtin_amdgcn_exp2f(-1.4426950408889634f * x)); }
__device__ __forceinline__ float shx(float v, int o, int lane) { return __builtin_bit_cast(float, __builtin_amdgcn_ds_bpermute((lane ^ o) << 2, __builtin_bit_cast(int, v))); }
__device__ __forceinline__ float shidx(float v, int src) { return __builtin_bit_cast(float, __builtin_amdgcn_ds_bpermute(src << 2, __builtin_bit_cast(int, v))); }
__device__ __forceinline__ int shidx_i(int v, int src) { return __builtin_amdgcn_ds_bpermute(src << 2, v); }
template <int CTRL> __device__ __forceinline__ float dpp_f(float v) { return __builtin_bit_cast(float, __builtin_amdgcn_update_dpp(0, __builtin_bit_cast(int, v), CTRL, 0xf, 0xf, true)); }
__device__ __forceinline__ float rdlane_f(float v, int l) { return __builtin_bit_cast(float, __builtin_amdgcn_readlane(__builtin_bit_cast(int, v), l)); }
__device__ __forceinline__ float wave_sum(float v, int) {
    v += dpp_f<0xB1>(v); v += dpp_f<0x4E>(v); v += dpp_f<0x141>(v); v += dpp_f<0x140>(v);
    return (rdlane_f(v, 0) + rdlane_f(v, 16)) + (rdlane_f(v, 32) + rdlane_f(v, 48));
}
__device__ __forceinline__ float wave_max(float v, int) {
    v = fmaxf(v, dpp_f<0xB1>(v)); v = fmaxf(v, dpp_f<0x4E>(v)); v = fmaxf(v, dpp_f<0x141>(v)); v = fmaxf(v, dpp_f<0x140>(v));
    return fmaxf(fmaxf(rdlane_f(v, 0), rdlane_f(v, 16)), fmaxf(rdlane_f(v, 32), rdlane_f(v, 48)));
}
__device__ const unsigned char T5B[128] = {0, 1, 2, 3, 4, 5, 6, 7, 8, 9, 10, 11, 12, 13, 14, 15, 16, 16, 16, 17, 17, 18, 18, 18, 19, 19, 19, 20, 20, 20, 20, 21, 21, 21, 21, 22, 22, 22, 22, 22, 23, 23, 23, 23, 23, 23, 24, 24, 24, 24, 24, 24, 25, 25, 25, 25, 25, 25, 25, 26, 26, 26, 26, 26, 26, 26, 26, 27, 27, 27, 27, 27, 27, 27, 27, 27, 27, 28, 28, 28, 28, 28, 28, 28, 28, 28, 28, 29, 29, 29, 29, 29, 29, 29, 29, 29, 29, 29, 29, 30, 30, 30, 30, 30, 30, 30, 30, 30, 30, 30, 30, 30, 30, 31, 31, 31, 31, 31, 31, 31, 31, 31, 31, 31, 31, 31, 31, 31};

#define XB_TMO      128
#define XB_XCNT(j)  (256  + 64 * (j))
#define XB_XSUB(j)  (1280 + 64 * (j))
#define XB_XGEN(j)  (2304 + 64 * (j))
#define XB_TOP      3328
#define XB_TOPGEN   3392
#define XCD_BAR_WORDS 3456
#define XB_SPIN_CAP (1u << 18)

__device__ __forceinline__ unsigned xb_ld(unsigned* p)              { return __hip_atomic_load(p, __ATOMIC_RELAXED, __HIP_MEMORY_SCOPE_AGENT); }
__device__ __forceinline__ unsigned xb_add(unsigned* p, unsigned v) { return __hip_atomic_fetch_add(p, v, __ATOMIC_RELAXED, __HIP_MEMORY_SCOPE_AGENT); }
__device__ __forceinline__ unsigned xb_xcc_id() { return (unsigned)__builtin_amdgcn_s_getreg((3 << 11) | 20) & 0xFu; }
#define XB_SPIN(cond, bar) do { unsigned _sp = 0; while (cond) { __builtin_amdgcn_s_sleep(1); \
    if ((++_sp & 255u) == 0u) { if (xb_ld(&(bar)[XB_TMO])) break; if (_sp > XB_SPIN_CAP) { atomicAdd(&(bar)[XB_TMO], 1u); break; } } } } while (0)

struct XcdBarrier {
    unsigned* bar; unsigned x;
    volatile LAS unsigned* st;
};

__device__ __forceinline__ XcdBarrier xcd_barrier_post(unsigned* bar, volatile LAS unsigned* st, const int tid_in) {
    XcdBarrier b; b.bar = bar; b.x = xb_xcc_id(); b.st = st;
    if (tid_in == 0) (void)xb_add(&bar[XB_XCNT(b.x)], 1u);
    return b;
}
__device__ __forceinline__ void xcd_barrier_complete(unsigned* bar, unsigned x, unsigned& nloc, unsigned& nx) {
    const unsigned G = gridDim.x * gridDim.y * gridDim.z;
    unsigned sum, cnt, mine, sp = 0u;
    for (;;) {
        sum = 0u; cnt = 0u; mine = 0u;
#pragma unroll
        for (unsigned j = 0; j < 16; ++j) { const unsigned c = xb_ld(&bar[XB_XCNT(j)]); sum += c; cnt += (c > 0u) ? 1u : 0u; mine = (j == x) ? c : mine; }
        if (sum == G) break;
        __builtin_amdgcn_s_sleep(1);
        if ((++sp & 255u) == 0u) { if (xb_ld(&bar[XB_TMO])) break; if (sp > XB_SPIN_CAP) { atomicAdd(&bar[XB_TMO], 1u); break; } }
    }
    nloc = mine > 0u ? mine : 1u; nx = cnt > 0u ? cnt : 1u;
}

__device__ __forceinline__ void xcd_barrier(const XcdBarrier& b, const int tid_in) {
    asm volatile("s_waitcnt vmcnt(0)" ::: "memory");
    __syncthreads();
    if (tid_in == 0) {
        unsigned* bar = b.bar;
        __builtin_amdgcn_s_waitcnt(0);
        unsigned nloc = b.st[0], nx = b.st[1];
        if (nloc == 0u) { xcd_barrier_complete(bar, b.x, nloc, nx); b.st[0] = nloc; b.st[1] = nx; }
        const unsigned old = xb_add(&bar[XB_XSUB(b.x)], 1u);
        const unsigned gen = old / nloc;
        if (old + 1u == (gen + 1u) * nloc) {
            __builtin_amdgcn_fence(__ATOMIC_RELEASE, "agent");
            asm volatile("s_waitcnt vmcnt(0)" ::: "memory");
            const unsigned og = xb_add(&bar[XB_TOP], 1u);
            const unsigned tg = og / nx;
            if (og + 1u == (tg + 1u) * nx) xb_add(&bar[XB_TOPGEN], 1u);
            else XB_SPIN(xb_ld(&bar[XB_TOPGEN]) == tg, bar);
            __builtin_amdgcn_fence(__ATOMIC_ACQUIRE, "agent");
            xb_add(&bar[XB_XGEN(b.x)], 1u);
            asm volatile("s_waitcnt vmcnt(0)" ::: "memory");
        } else {
            XB_SPIN(xb_ld(&bar[XB_XGEN(b.x)]) == gen, bar);
            __builtin_amdgcn_fence(__ATOMIC_ACQUIRE, "agent");
            asm volatile("s_waitcnt vmcnt(0)" ::: "memory");
        }
    }
    __syncthreads();
}
struct Args { const float* in[23]; float* out; unsigned char* ws; int ph_lo, ph_hi; };
enum { I_X = 0, I_C, I_RELB, I_FNW, I_N1W, I_N2W, I_WMOD, I_BMOD, I_WIN, I_CONVW, I_ALOG, I_DTB, I_ONW, I_WUPA, I_WUPB, I_WOUT, I_WRG, I_BRG, I_WRE, I_BRE, I_WEG, I_WEU, I_WED };

typedef const Args __attribute__((address_space(4)))* KArgs;
struct Ctx { LAS unsigned char* lds; int tid, lane, wave, bid, G; };
extern __shared__ __attribute__((aligned(16))) unsigned char lds_raw[];
__device__ __forceinline__ Ctx make_ctx(int& tid) { Ctx c; c.lds = (LAS unsigned char*)lds_raw; asm volatile("" : "+v"(tid)); const int t = tid; c.tid = t; c.lane = t & 63; c.wave = __builtin_amdgcn_readfirstlane(t >> 6); int bi = blockIdx.x, gd = gridDim.x; asm volatile("" : "+s"(bi), "+s"(gd)); c.bid = bi; c.G = gd; return c; }

__device__ __forceinline__ void ph_mod(KArgs a, const Ctx& c) {
    LAS float* cact = (LAS float*)c.lds;
    LAS float* red = (LAS float*)(c.lds + 16384);
    const float* cin = a->in[I_C];
    for (int i = c.tid; i < 4096; i += NTHR) cact[i] = siluf_(cin[i]);
    __syncthreads();
    float* mod = (float*)(a->ws + WS_MOD);
    for (int item = c.bid; item < 192; item += c.G) {
        const int l = item / 96, j0 = (item % 96) * 64;
        const float* W = a->in[I_WMOD] + (size_t)l * 1024 * 6144 + j0 + c.lane;
        float a0 = 0.f, a1 = 0.f, a2 = 0.f, a3 = 0.f;
        const int k0 = c.wave * 128;
#pragma unroll 8
        for (int k = k0; k < k0 + 128; ++k) { const float w = W[(size_t)k * 6144]; a0 += cact[k] * w; a1 += cact[1024 + k] * w; a2 += cact[2048 + k] * w; a3 += cact[3072 + k] * w; }
        red[(c.wave * 4 + 0) * 64 + c.lane] = a0; red[(c.wave * 4 + 1) * 64 + c.lane] = a1; red[(c.wave * 4 + 2) * 64 + c.lane] = a2; red[(c.wave * 4 + 3) * 64 + c.lane] = a3;
        __syncthreads();
        if (c.tid < 256) { const int b = c.tid >> 6, ln = c.tid & 63; float s = 0.f;
#pragma unroll
            for (int w = 0; w < 8; ++w) s += red[(w * 4 + b) * 64 + ln];
            mod[(l * 4 + b) * 6144 + j0 + ln] = s + a->in[I_BMOD][l * 6144 + j0 + ln]; }
        __syncthreads();
    }
}

__device__ __forceinline__ void tr_item(const float* src, int ld, bf16* dst, int K, int nblk, LAS float* scr, int item, int lane) {
    const int kb = item / nblk, nb = item % nblk, k0 = 64 * kb, n0 = 32 * nb;
    float tv[32];
#pragma unroll
    for (int i = 0; i < 32; ++i) tv[i] = src[(size_t)(k0 + 2 * i + (lane >> 5)) * ld + n0 + (lane & 31)];
#pragma unroll
    for (int i = 0; i < 32; ++i) scr[(2 * i + (lane >> 5)) * 33 + (lane & 31)] = tv[i];
    LDS_WAIT(); asm volatile("" ::: "memory");
    const int cc = lane & 7;
#pragma unroll
    for (int j = 0; j < 4; ++j) { const int n = (lane >> 3) + 8 * j; const LAS float* s = scr + (8 * cc) * 33 + n;
        v4u o; o.x = pk2(s[0 * 33], s[1 * 33]); o.y = pk2(s[2 * 33], s[3 * 33]); o.z = pk2(s[4 * 33], s[5 * 33]); o.w = pk2(s[6 * 33], s[7 * 33]);
        *(v4u*)(dst + (size_t)(n0 + n) * K + k0 + 8 * cc) = o; }
    LDS_WAIT(); asm volatile("" ::: "memory");
}
constexpr int CV_I0 = 1792, CV_I1 = 1024, CV_I2 = 256, CV_I3 = 256, CV_I4 = 512, CV_I5 = 4096, CV_I6 = 4096, CV_I7 = 4096;
constexpr int CV_NIT = CV_I0 + CV_I1 + CV_I2 + CV_I3 + CV_I4 + CV_I5 + CV_I6 + CV_I7, CV_EARLY = CV_I0 + CV_I1;
__device__ __forceinline__ void convert_item(KArgs a, int l, int it, LAS float* scr, int lane) {
    bf16* WIN = (bf16*)(a->ws + WS_WIN); bf16* WEGU = (bf16*)(a->ws + WS_WEGU); bf16* WEDT = (bf16*)(a->ws + WS_WED);
    const float* win = a->in[I_WIN] + (size_t)l * 1024 * DIN;
    int r = it;
    if (r < CV_I0) { tr_item(win, DIN, WIN, 1024, 112, scr, r, lane); return; } r -= CV_I0;
    if (r < CV_I1) { tr_item(win + C_GATE, DIN, WIN + (size_t)C_BA * 1024, 1024, 64, scr, r, lane); return; } r -= CV_I1;
    if (r < CV_I2) { tr_item(a->in[I_WUPA] + (size_t)l * 512 * 1024, 1024, (bf16*)(a->ws + WS_WUPA), 512, 32, scr, r, lane); return; } r -= CV_I2;
    if (r < CV_I3) { tr_item(a->in[I_WUPB] + (size_t)l * 512 * 1024, 1024, (bf16*)(a->ws + WS_WUPB), 512, 32, scr, r, lane); return; } r -= CV_I3;
    if (r < CV_I4) { tr_item(a->in[I_WOUT] + (size_t)l * 1024 * 1024, 1024, (bf16*)(a->ws + WS_WOUT), 1024, 32, scr, r, lane); return; } r -= CV_I4;
    if (r < CV_I5) { const int E = r >> 7, rem = r & 127, pn = rem >> 6, q = rem & 63;
        tr_item(a->in[I_WEG] + ((size_t)(l * 32 + E) * 1024 * 256) + 128 * pn, 256, WEGU + (size_t)(E * 512 + 256 * pn) * 1024, 1024, 4, scr, q, lane); return; } r -= CV_I5;
    if (r < CV_I6) { const int E = r >> 7, rem = r & 127, pn = rem >> 6, q = rem & 63;
        tr_item(a->in[I_WEU] + ((size_t)(l * 32 + E) * 1024 * 256) + 128 * pn, 256, WEGU + (size_t)(E * 512 + 256 * pn + 128) * 1024, 1024, 4, scr, q, lane); return; } r -= CV_I6;
    { const int E = r >> 7, q = r & 127;
        tr_item(a->in[I_WED] + ((size_t)(l * 32 + E) * 256 * 1024), 1024, WEDT + (size_t)E * 1024 * 256, 256, 32, scr, q, lane); }
}
__device__ __forceinline__ void ph_convert(KArgs a, const Ctx& c, int l) {
    LAS float* scr = (LAS float*)(c.lds + 32768 + c.wave * 10240);
    const int gw = c.bid * NW + c.wave, NGW = c.G * NW;
    for (int it = gw; it < CV_EARLY; it += NGW) convert_item(a, l, it, scr, c.lane);
}
constexpr int CV_UNIT = 64, CV_NUNITS = (CV_NIT - CV_EARLY) / CV_UNIT;
static_assert((CV_NIT - CV_EARLY) % CV_UNIT == 0, "convert units");
__device__ __forceinline__ void convert_unit(KArgs a, const Ctx& c, int l, int cu) {
    LAS float* scr = (LAS float*)(c.lds + 32768 + c.wave * 10240);
#pragma unroll 1
    for (int i = 0; i < 8; ++i) convert_item(a, l, CV_EARLY + cu * CV_UNIT + c.wave * 8 + i, scr, c.lane);
}

__device__ __forceinline__ void load_row_x(KArgs a, int l, int m, int lane, f32x4 (&v)[4]) {
    const float* xr = (l == 0 ? a->in[I_X] : (const float*)a->out) + (size_t)m * DM;
#pragma unroll
    for (int j = 0; j < 4; ++j) v[j] = *(const f32x4*)(xr + 256 * j + 4 * lane);
    if (l > 0) {
        const int b = m >> 12;
        const float* g2 = (const float*)(a->ws + WS_MOD) + ((l - 1) * 4 + b) * 6144 + 5120;
        const bf16* ys = (const bf16*)(a->ws + WS_YS) + (size_t)m * 2048;
#pragma unroll
        for (int j = 0; j < 4; ++j) { const int col = 256 * j + 4 * lane; const v2u y0 = *(const v2u*)(ys + col), y1 = *(const v2u*)(ys + 1024 + col); const f32x4 g = *(const f32x4*)(g2 + col);
            v[j].x += g.x * (bflo(y0.x) + bflo(y1.x)); v[j].y += g.y * (bfhi(y0.x) + bfhi(y1.x)); v[j].z += g.z * (bflo(y0.y) + bflo(y1.y)); v[j].w += g.w * (bfhi(y0.y) + bfhi(y1.y)); }
        float* xo = a->out + (size_t)m * DM;
#pragma unroll
        for (int j = 0; j < 4; ++j) *(f32x4*)(xo + 256 * j + 4 * lane) = v[j];
    }
}
__device__ __forceinline__ float row_rstd(const f32x4 (&v)[4], int lane) {
    float s = 0.f;
#pragma unroll
    for (int j = 0; j < 4; ++j) s += (v[j].x * v[j].x + v[j].y * v[j].y) + (v[j].z * v[j].z + v[j].w * v[j].w);
    return __builtin_amdgcn_rsqf(wave_sum(s, lane) * (1.f / DM) + EPS);
}
__device__ __forceinline__ void ph_norm1(KArgs a, const Ctx& c, int l) {
    LAS float* wbaT = (LAS float*)c.lds;
    const float* win = a->in[I_WIN] + (size_t)l * 1024 * DIN + C_BA;
    for (int i = c.tid; i < 8192; i += NTHR) { const int k = i >> 3, cc = i & 7; wbaT[cc * 1024 + k] = win[(size_t)k * DIN + cc]; }
    __syncthreads();
    const int gw = c.bid * NW + c.wave, NGW = c.G * NW, lane = c.lane;
    bf16* H = (bf16*)(a->ws + WS_H); float* beta = (float*)(a->ws + WS_BETA); float* glog = (float*)(a->ws + WS_GLOG);
    const float* n1w = a->in[I_N1W] + l * DM;
    for (int m = gw; m < NTOK; m += NGW) {
        f32x4 v[4]; load_row_x(a, l, m, lane, v);
        const float rstd = row_rstd(v, lane);
        const int b = m >> 12; const float* mod = (const float*)(a->ws + WS_MOD) + (l * 4 + b) * 6144;
        float acc[8];
#pragma unroll
        for (int q = 0; q < 8; ++q) acc[q] = 0.f;
#pragma unroll
        for (int j = 0; j < 4; ++j) { const int col = 256 * j + 4 * lane;
            const f32x4 nw = *(const f32x4*)(n1w + col), sh = *(const f32x4*)(mod + col), sc = *(const f32x4*)(mod + 1024 + col);
            f32x4 h = v[j] * rstd * nw * (sc + 1.0f) + sh;
            v2u o; o.x = pk2(h.x, h.y); o.y = pk2(h.z, h.w); *(v2u*)(H + (size_t)m * DM + col) = o;
#pragma unroll
            for (int q = 0; q < 8; ++q) { const f32x4 w4 = *(const LAS f32x4*)(wbaT + q * 1024 + col); acc[q] += (h.x * w4.x + h.y * w4.y) + (h.z * w4.z + h.w * w4.w); } }
#pragma unroll
        for (int q = 0; q < 8; ++q) acc[q] = wave_sum(acc[q], lane);
        if (lane < 4) {
            const float bb = lane == 0 ? acc[0] : lane == 1 ? acc[1] : lane == 2 ? acc[2] : acc[3];
            const float aa = lane == 0 ? acc[4] : lane == 1 ? acc[5] : lane == 2 ? acc[6] : acc[7];
            beta[m * 4 + lane] = sigmoidf_(bb);
            const float z = aa + a->in[I_DTB][l * 4 + lane]; const float sp = fmaxf(z, 0.f) + log1pf(__expf(-fabsf(z)));
            glog[m * 4 + lane] = -__expf(a->in[I_ALOG][l * 4 + lane]) * sp;
        }
    }
}
__device__ __forceinline__ void ph_final(KArgs a, const Ctx& c) {
    const int gw = c.bid * NW + c.wave, NGW = c.G * NW, lane = c.lane;
    const float* fw = a->in[I_FNW];
    for (int m = gw; m < NTOK; m += NGW) {
        f32x4 v[4];
        {
            const float* xr = (const float*)a->out + (size_t)m * DM; const int b = m >> 12;
            const float* g2 = (const float*)(a->ws + WS_MOD) + ((NLAYER - 1) * 4 + b) * 6144 + 5120;
            const bf16* ys = (const bf16*)(a->ws + WS_YS) + (size_t)m * 2048;
#pragma unroll
            for (int j = 0; j < 4; ++j) { const int col = 256 * j + 4 * lane; v[j] = *(const f32x4*)(xr + col);
                const v2u y0 = *(const v2u*)(ys + col), y1 = *(const v2u*)(ys + 1024 + col); const f32x4 g = *(const f32x4*)(g2 + col);
                v[j].x += g.x * (bflo(y0.x) + bflo(y1.x)); v[j].y += g.y * (bfhi(y0.x) + bfhi(y1.x)); v[j].z += g.z * (bflo(y0.y) + bflo(y1.y)); v[j].w += g.w * (bfhi(y0.y) + bfhi(y1.y)); }
        }
        float rstd = row_rstd(v, lane);
#if defined(MK_PROBE_A) && MK_PROBE_A >= 0
        {   const unsigned long long* ts = (const unsigned long long*)((const unsigned*)(a->ws + WS_CTL) + 12288);
            float tA = 0.f, tB = 0.f;
            for (int ly = 0; ly < NLAYER; ++ly) { const int ka = 1 + ly * 11 + MK_PROBE_A, kb = 1 + ly * 11 + MK_PROBE_B;
                if (MK_PROBE_A < 11) tA += (float)(ts[ka + 1] - ts[ka]) * 0.01f; if (MK_PROBE_B < 11) tB += (float)(ts[kb + 1] - ts[kb]) * 0.01f; }
            if (MK_PROBE_A == 20) { tA = 0.f; for (int ly = 0; ly < NLAYER; ++ly) tA += (float)(ts[40 + ly] - ts[1 + ly * 11 + 3]) * 0.01f; }
            if (MK_PROBE_B == 21) { tB = 0.f; for (int ly = 0; ly < NLAYER; ++ly) tB += (float)(ts[44 + ly] - ts[1 + ly * 11 + 3]) * 0.01f; }
            if (MK_PROBE_A >= 22 && MK_PROBE_A <= 24) { tA = 0.f; for (int ly = 0; ly < NLAYER; ++ly) tA += (float)ts[48 + ly * 4 + MK_PROBE_A - 22] * 0.01f; }
            if (MK_PROBE_B >= 22 && MK_PROBE_B <= 24) { tB = 0.f; for (int ly = 0; ly < NLAYER; ++ly) tB += (float)ts[48 + ly * 4 + MK_PROBE_B - 22] * 0.01f; }
            if (MK_PROBE_A >= 30 && MK_PROBE_A <= 36) { tA = 0.f; for (int ly = 0; ly < NLAYER; ++ly) tA += (float)ts[56 + ly] * 0.01f; }
            if (MK_PROBE_A == 11) tA = (float)(ts[1] - ts[0]) * 0.01f; if (MK_PROBE_A == 12) tA = (float)(ts[23] - ts[0]) * 0.01f;
            if (MK_PROBE_B == 11) tB = (float)(ts[1] - ts[0]) * 0.01f; if (MK_PROBE_B == 12) tB = (float)(ts[23] - ts[0]) * 0.01f;
            (void)tB;
            if (m == 0 && lane == 0) v[0].x += tA * 0.05f / rstd / fw[0]; }
#endif
        float* xo = a->out + (size_t)m * DM;
#pragma unroll
        for (int j = 0; j < 4; ++j) { const int col = 256 * j + 4 * lane; const f32x4 w = *(const f32x4*)(fw + col); *(f32x4*)(xo + col) = v[j] * rstd * w; }
    }
}

__device__ __forceinline__ void ph_kmean(KArgs a, const Ctx& c) {
    const int gw = c.bid * NW + c.wave, NGW = c.G * NW, lane = c.lane;
    const bf16* QKVA = (const bf16*)(a->ws + WS_QKVA); float* kmean = (float*)(a->ws + WS_KMEAN);
    for (int item = gw; item < NB * HA * NBLK; item += NGW) {
        const int nb = item & 15, h = (item >> 4) & 7, b = item >> 7;
        const int sub = lane & 7, rr = lane >> 3;
        float s[8];
#pragma unroll
        for (int q = 0; q < 8; ++q) s[q] = 0.f;
        const bf16* kp = QKVA + (size_t)(b * SEQ + nb * MBLK) * 1536 + 512 + h * 64 + sub * 8;
#pragma unroll 4
        for (int it = 0; it < 32; ++it) { const v4u w = *(const v4u*)(kp + (size_t)(it * 8 + rr) * 1536);
            s[0] += bflo(w.x); s[1] += bfhi(w.x); s[2] += bflo(w.y); s[3] += bfhi(w.y); s[4] += bflo(w.z); s[5] += bfhi(w.z); s[6] += bflo(w.w); s[7] += bfhi(w.w); }
#pragma unroll
        for (int q = 0; q < 8; ++q) { s[q] += shx(s[q], 8, lane); s[q] += shx(s[q], 16, lane); s[q] += shx(s[q], 32, lane); }
        if (lane < 8) { float* o = kmean + (size_t)item * 64 + sub * 8;
            *(f32x4*)o = (f32x4){s[0], s[1], s[2], s[3]} * (1.f / 256.f); *(f32x4*)(o + 4) = (f32x4){s[4], s[5], s[6], s[7]} * (1.f / 256.f); }
    }
}

__device__ __forceinline__ void ph_attn_simple(KArgs a, const Ctx& c) {
    const int gw = c.bid * NW + c.wave, NGW = c.G * NW, lane = c.lane;
    LAS float* btab = (LAS float*)(c.lds);
    LAS float* scw = (LAS float*)(c.lds + 8192) + c.wave * 1024;
    const float* relb = a->in[I_RELB];
    for (int i = c.tid; i < 8 * 129; i += NTHR) { const int h = i / 129, d = i % 129; btab[h * 132 + d] = relb[(d < 128 ? (int)T5B[d] : 31) * 8 + h]; }
    __syncthreads();
    const bf16* QKVA = (const bf16*)(a->ws + WS_QKVA); const float* kmean = (const float*)(a->ws + WS_KMEAN); bf16* YA = (bf16*)(a->ws + WS_YA);
    for (int r = gw; r < NB * HA * SEQ; r += NGW) {
        const int s = r & (SEQ - 1), h = (r >> 12) & 7, b = r >> 15, qb = s >> 8, tok = b * SEQ + s;
        float qv[64];
        { const bf16* qp = QKVA + (size_t)tok * 1536 + h * 64;
#pragma unroll
          for (int q = 0; q < 8; ++q) { const v4u w = *(const v4u*)(qp + q * 8); qv[q * 8 + 0] = bflo(w.x); qv[q * 8 + 1] = bfhi(w.x); qv[q * 8 + 2] = bflo(w.y); qv[q * 8 + 3] = bfhi(w.y); qv[q * 8 + 4] = bflo(w.z); qv[q * 8 + 5] = bfhi(w.z); qv[q * 8 + 6] = bflo(w.w); qv[q * 8 + 7] = bfhi(w.w); } }
        float gate = -1e30f;
        if (lane < qb) { const float* km = kmean + (size_t)(((b * 8 + h) * 16) + lane) * 64; float d = 0.f;
#pragma unroll
            for (int q = 0; q < 16; ++q) { const f32x4 k4 = *(const f32x4*)(km + q * 4); d += qv[q * 4] * k4.x + qv[q * 4 + 1] * k4.y + qv[q * 4 + 2] * k4.z + qv[q * 4 + 3] * k4.w; }
            gate = d; }
        unsigned selmask = 0u;
#pragma unroll
        for (int t = 0; t < 3; ++t) { float best = -3e38f; int bi = 0;
#pragma unroll
            for (int n = 0; n < 16; ++n) { const float gv = shidx(gate, n); if (!((selmask >> n) & 1u) && gv > best) { best = gv; bi = n; } }
            selmask |= 1u << bi; }
        selmask &= (1u << qb) - 1u;
        selmask |= 1u << qb;
        int nseg = 0; float mx = -3e38f;
        for (int blk = 0; blk <= qb; ++blk) {
            if (!((selmask >> blk) & 1u)) continue;
            for (int i = 0; i < 4; ++i) { const int key = blk * 256 + i * 64 + lane; const bf16* kp = QKVA + (size_t)(b * SEQ + key) * 1536 + 512 + h * 64; float d = 0.f;
#pragma unroll
                for (int q = 0; q < 8; ++q) { const v4u w = *(const v4u*)(kp + q * 8);
                    d += qv[q * 8] * bflo(w.x) + qv[q * 8 + 1] * bfhi(w.x) + qv[q * 8 + 2] * bflo(w.y) + qv[q * 8 + 3] * bfhi(w.y) + qv[q * 8 + 4] * bflo(w.z) + qv[q * 8 + 5] * bfhi(w.z) + qv[q * 8 + 6] * bflo(w.w) + qv[q * 8 + 7] * bfhi(w.w); }
                const int dist = s - key; float sc = d * 0.125f + btab[h * 132 + (dist < 0 ? 0 : (dist > 128 ? 128 : dist))];
                if (dist < 0) sc = -3e38f;
                scw[nseg * 256 + i * 64 + lane] = sc; mx = fmaxf(mx, sc); }
            ++nseg; }
        mx = wave_max(mx, lane);
        float sum = 0.f;
        for (int idx = lane; idx < nseg * 256; idx += 64) { const float sc = scw[idx]; const float e = sc < -1e37f ? 0.f : __expf(sc - mx); scw[idx] = e; sum += e; }
        sum = wave_sum(sum, lane);
        LDS_WAIT();
        float o = 0.f; int sg = 0;
        for (int blk = 0; blk <= qb; ++blk) {
            if (!((selmask >> blk) & 1u)) continue;
            const bf16* vp = QKVA + (size_t)(b * SEQ + blk * 256) * 1536 + 1024 + h * 64 + lane;
            const int lim = (blk == qb) ? (s & 255) + 1 : 256;
#pragma unroll 8
            for (int kk = 0; kk < lim; ++kk) o += scw[sg * 256 + kk] * bf2f(vp[(size_t)kk * 1536]);
            ++sg; }
        YA[(size_t)tok * 512 + h * 64 + lane] = (bf16)f2bf(o / sum);
    }
}

template <int LDW> __device__ __forceinline__ void dn_load_chunk(KArgs a, const Ctx& c, int l, int b, int h, int t0, LAS float* qs, LAS float* ks, LAS float* vs) {
    const bf16* QKVB = (const bf16*)(a->ws + WS_QKVB); const float* cw = a->in[I_CONVW] + (size_t)l * 4 * 1536;
    const int cg = c.tid & 15, r0 = c.tid >> 4;
#pragma unroll
    for (int part = 0; part < 3; ++part) {
        const int colb = part * 512 + h * 128 + 8 * cg;
        float w[4][8];
#pragma unroll
        for (int i = 0; i < 4; ++i) { const f32x4 w0 = *(const f32x4*)(cw + i * 1536 + colb), w1 = *(const f32x4*)(cw + i * 1536 + colb + 4);
            w[i][0] = w0.x; w[i][1] = w0.y; w[i][2] = w0.z; w[i][3] = w0.w; w[i][4] = w1.x; w[i][5] = w1.y; w[i][6] = w1.z; w[i][7] = w1.w; }
        LAS float* dst = part == 0 ? qs : part == 1 ? ks : vs;
#pragma unroll
        for (int pass = 0; pass < 2; ++pass) {
            const int r = r0 + 32 * pass, t = t0 + r;
            float y[8];
#pragma unroll
            for (int e = 0; e < 8; ++e) y[e] = 0.f;
#pragma unroll
            for (int i = 0; i < 4; ++i) { const int tt = t - 3 + i; if (tt >= 0) { const v4u x = *(const v4u*)(QKVB + (size_t)(b * SEQ + tt) * 1536 + colb);
                y[0] += w[i][0] * bflo(x.x); y[1] += w[i][1] * bfhi(x.x); y[2] += w[i][2] * bflo(x.y); y[3] += w[i][3] * bfhi(x.y); y[4] += w[i][4] * bflo(x.z); y[5] += w[i][5] * bfhi(x.z); y[6] += w[i][6] * bflo(x.w); y[7] += w[i][7] * bfhi(x.w); } }
            float ss = 0.f;
#pragma unroll
            for (int e = 0; e < 8; ++e) { y[e] = siluf_(y[e]); ss += y[e] * y[e]; }
            if (part < 2) { ss += shx(ss, 1, c.lane); ss += shx(ss, 2, c.lane); ss += shx(ss, 4, c.lane); ss += shx(ss, 8, c.lane);
                const float rs = __builtin_amdgcn_rsqf(ss + EPS) * (part == 0 ? 0.08838834764831845f : 1.f);
#pragma unroll
                for (int e = 0; e < 8; ++e) y[e] *= rs; }
            *(LAS f32x4*)(dst + r * LDW + 8 * cg) = (f32x4){y[0], y[1], y[2], y[3]}; *(LAS f32x4*)(dst + r * LDW + 8 * cg + 4) = (f32x4){y[4], y[5], y[6], y[7]};
        }
    }
}
__device__ __forceinline__ void dn_store_chunk(KArgs a, const Ctx& c, int l, int b, int h, int t0, const LAS float* os) {
    const bf16* ZB = (const bf16*)(a->ws + WS_ZB); bf16* YB = (bf16*)(a->ws + WS_YB); const float* onw = a->in[I_ONW] + l * 128;
    const int r = c.tid >> 3, sub = c.tid & 7, tok = b * SEQ + t0 + r;
    float o[16]; float ss = 0.f;
#pragma unroll
    for (int q = 0; q < 4; ++q) { const f32x4 v = *(const LAS f32x4*)(os + r * 128 + sub * 16 + q * 4); o[q * 4] = v.x; o[q * 4 + 1] = v.y; o[q * 4 + 2] = v.z; o[q * 4 + 3] = v.w; ss += (v.x * v.x + v.y * v.y) + (v.z * v.z + v.w * v.w); }
    ss += shx(ss, 1, c.lane); ss += shx(ss, 2, c.lane); ss += shx(ss, 4, c.lane);
    const float rstd = __builtin_amdgcn_rsqf(ss * (1.f / 128.f) + EPS);
    const bf16* zp = ZB + (size_t)tok * 512 + h * 128 + sub * 16; bf16* yp = YB + (size_t)tok * 512 + h * 128 + sub * 16;
#pragma unroll
    for (int q = 0; q < 2; ++q) { const v4u z = *(const v4u*)(zp + q * 8); const f32x4 w0 = *(const f32x4*)(onw + sub * 16 + q * 8), w1 = *(const f32x4*)(onw + sub * 16 + q * 8 + 4);
        v4u y; y.x = pk2(o[q * 8 + 0] * rstd * w0.x * siluf_(bflo(z.x)), o[q * 8 + 1] * rstd * w0.y * siluf_(bfhi(z.x)));
        y.y = pk2(o[q * 8 + 2] * rstd * w0.z * siluf_(bflo(z.y)), o[q * 8 + 3] * rstd * w0.w * siluf_(bfhi(z.y)));
        y.z = pk2(o[q * 8 + 4] * rstd * w1.x * siluf_(bflo(z.z)), o[q * 8 + 5] * rstd * w1.y * siluf_(bfhi(z.z)));
        y.w = pk2(o[q * 8 + 6] * rstd * w1.z * siluf_(bflo(z.w)), o[q * 8 + 7] * rstd * w1.w * siluf_(bfhi(z.w)));
        *(v4u*)(yp + q * 8) = y; }
}
__device__ __forceinline__ void ph_dn_simple(KArgs a, const Ctx& c, int l) {
    LAS float* qs = (LAS float*)c.lds; LAS float* ks = qs + 8192; LAS float* vs = ks + 8192; LAS float* os = vs + 8192;
    LAS float* bt = (LAS float*)(c.lds + MISC_OFF + 1024); LAS float* at = bt + 64;
    const float* beta = (const float*)(a->ws + WS_BETA); const float* glog = (const float*)(a->ws + WS_GLOG);
    const int v = c.tid >> 2, kq = c.tid & 3;
    for (int item = c.bid; item < NB * HB; item += c.G) {
        const int b = item >> 2, h = item & 3;
        float S[32];
#pragma unroll
        for (int q = 0; q < 32; ++q) S[q] = 0.f;
        for (int n = 0; n < NCH; ++n) {
            const int t0 = n * DNC;
            __syncthreads();
            dn_load_chunk<128>(a, c, l, b, h, t0, qs, ks, vs);
            if (c.tid < 64) { const int tok = b * SEQ + t0 + c.tid; bt[c.tid] = beta[tok * 4 + h]; at[c.tid] = __expf(glog[tok * 4 + h]); }
            __syncthreads();
            for (int tt = 0; tt < DNC; ++tt) {
                const float a_t = at[tt], b_t = bt[tt];
                float kr[32];
#pragma unroll
                for (int q = 0; q < 8; ++q) { const f32x4 k4 = *(const LAS f32x4*)(ks + tt * 128 + kq * 32 + q * 4); kr[q * 4] = k4.x; kr[q * 4 + 1] = k4.y; kr[q * 4 + 2] = k4.z; kr[q * 4 + 3] = k4.w; }
                float kS = 0.f;
#pragma unroll
                for (int q = 0; q < 32; ++q) kS += kr[q] * S[q];
                kS += shx(kS, 1, c.lane); kS += shx(kS, 2, c.lane);
                const float vn = b_t * (vs[tt * 128 + v] - a_t * kS);
                float o = 0.f;
#pragma unroll
                for (int q = 0; q < 8; ++q) { const f32x4 q4 = *(const LAS f32x4*)(qs + tt * 128 + kq * 32 + q * 4);
                    S[q * 4] = a_t * S[q * 4] + kr[q * 4] * vn; S[q * 4 + 1] = a_t * S[q * 4 + 1] + kr[q * 4 + 1] * vn; S[q * 4 + 2] = a_t * S[q * 4 + 2] + kr[q * 4 + 2] * vn; S[q * 4 + 3] = a_t * S[q * 4 + 3] + kr[q * 4 + 3] * vn;
                    o += (q4.x * S[q * 4] + q4.y * S[q * 4 + 1]) + (q4.z * S[q * 4 + 2] + q4.w * S[q * 4 + 3]); }
                o += shx(o, 1, c.lane); o += shx(o, 2, c.lane);
                if (kq == 0) os[tt * 128 + v] = o;
            }
            __syncthreads();
            dn_store_chunk(a, c, l, b, h, t0, os);
        }
    }
}

struct EpiProj {
    static constexpr bool PERM = true, AFTER_DRAIN = false; unsigned char* ws;
    __device__ __forceinline__ void operator()(const pg8::f32x4 (&acc)[2][2][4][2], const pg8::Unit& u, int wr, int wc, int fr, int fq) const {
        const int pn = u.pn; bf16* base; int ld, ct; bool sg = false;
        if (pn < 6) { base = (bf16*)(ws + WS_QKVA); ld = 1536; ct = pn; } else if (pn < 12) { base = (bf16*)(ws + WS_QKVB); ld = 1536; ct = pn - 6; }
        else if (pn < 14) { base = (bf16*)(ws + WS_ZB); ld = 512; ct = pn - 12; } else { base = (bf16*)(ws + WS_GATES); ld = 2048; ct = pn - 14; sg = true; }
        const int row0 = u.pm * 256 + wr * 64 + fr, col0 = ct * 256 + wc * 32 + 8 * fq;
#pragma unroll
        for (int ai = 0; ai < 2; ++ai)
#pragma unroll
            for (int m = 0; m < 4; ++m) { bf16* rowp = base + (size_t)(row0 + ai * 128 + m * 16) * ld + col0;
#pragma unroll
                for (int bj = 0; bj < 2; ++bj) { f32x4 v0 = acc[ai][bj][m][0], v1 = acc[ai][bj][m][1];
                    if (sg) { v0.x = sigmoidf_(v0.x); v0.y = sigmoidf_(v0.y); v0.z = sigmoidf_(v0.z); v0.w = sigmoidf_(v0.w); v1.x = sigmoidf_(v1.x); v1.y = sigmoidf_(v1.y); v1.z = sigmoidf_(v1.z); v1.w = sigmoidf_(v1.w); }
                    v4u w; w.x = pk2(v0.x, v0.y); w.y = pk2(v0.z, v0.w); w.z = pk2(v1.x, v1.y); w.w = pk2(v1.z, v1.w);
                    *(v4u*)(rowp + bj * 128) = w; } }
    }
};
template <bool SECOND> struct EpiMerge {
    static constexpr bool PERM = true, AFTER_DRAIN = false; unsigned char* ws;
    __device__ __forceinline__ void operator()(const pg8::f32x4 (&acc)[2][2][4][2], const pg8::Unit& u, int wr, int wc, int fr, int fq) const {
        bf16* M = (bf16*)(ws + WS_M); const bf16* GT = (const bf16*)(ws + WS_GATES) + (SECOND ? 1024 : 0);
        const int row0 = u.pm * 256 + wr * 64 + fr, col0 = u.pn * 256 + wc * 32 + 8 * fq;
#pragma unroll
        for (int ai = 0; ai < 2; ++ai)
#pragma unroll
            for (int m = 0; m < 4; ++m) { const size_t row = row0 + ai * 128 + m * 16;
#pragma unroll
                for (int bj = 0; bj < 2; ++bj) { const int col = col0 + bj * 128; const f32x4 v0 = acc[ai][bj][m][0], v1 = acc[ai][bj][m][1];
                    const v4u g = *(const v4u*)(GT + row * 2048 + col);
                    float o[8] = {bflo(g.x) * v0.x, bfhi(g.x) * v0.y, bflo(g.y) * v0.z, bfhi(g.y) * v0.w, bflo(g.z) * v1.x, bfhi(g.z) * v1.y, bflo(g.w) * v1.z, bfhi(g.w) * v1.w};
                    if (SECOND) { const v4u p = *(const v4u*)(M + row * 1024 + col); o[0] += bflo(p.x); o[1] += bfhi(p.x); o[2] += bflo(p.y); o[3] += bfhi(p.y); o[4] += bflo(p.z); o[5] += bfhi(p.z); o[6] += bflo(p.w); o[7] += bfhi(p.w); }
                    v4u w; w.x = pk2(o[0], o[1]); w.y = pk2(o[2], o[3]); w.z = pk2(o[4], o[5]); w.w = pk2(o[6], o[7]);
                    *(v4u*)(M + row * 1024 + col) = w; } }
    }
};
struct EpiOut {
    static constexpr bool PERM = true, AFTER_DRAIN = false; const float* xin; float* xout; const float* g1;
    __device__ __forceinline__ void operator()(const pg8::f32x4 (&acc)[2][2][4][2], const pg8::Unit& u, int wr, int wc, int fr, int fq) const {
        const int row0 = u.pm * 256 + wr * 64 + fr, col0 = u.pn * 256 + wc * 32 + 8 * fq; const int b = (u.pm * 256) >> 12;
#pragma unroll
        for (int bj = 0; bj < 2; ++bj) { const int col = col0 + bj * 128; const f32x4 ga = *(const f32x4*)(g1 + b * 6144 + col), gb = *(const f32x4*)(g1 + b * 6144 + col + 4);
#pragma unroll
            for (int ai = 0; ai < 2; ++ai)
#pragma unroll
                for (int m = 0; m < 4; ++m) { const size_t off = (size_t)(row0 + ai * 128 + m * 16) * DM + col;
                    const f32x4 x0 = *(const f32x4*)(xin + off), x1 = *(const f32x4*)(xin + off + 4);
                    *(f32x4*)(xout + off) = x0 + ga * acc[ai][bj][m][0]; *(f32x4*)(xout + off + 4) = x1 + gb * acc[ai][bj][m][1]; } }
    }
};
struct EpiMoeGU {
    static constexpr bool PERM = true, AFTER_DRAIN = false; unsigned char* ws;
    __device__ __forceinline__ void operator()(const pg8::f32x4 (&acc)[2][2][4][2], const pg8::Unit& u, int wr, int wc, int fr, int fq) const {
        bf16* ACT = (bf16*)(ws + WS_ACT);
        const int row0 = u.pm * 256 + wr * 64 + fr, col0 = (u.pn & 1) * 128 + wc * 32 + 8 * fq;
#pragma unroll
        for (int ai = 0; ai < 2; ++ai)
#pragma unroll
            for (int m = 0; m < 4; ++m) { const f32x4 g0 = acc[ai][0][m][0], g1 = acc[ai][0][m][1], u0 = acc[ai][1][m][0], u1 = acc[ai][1][m][1];
                v4u w; w.x = pk2(siluf_(g0.x) * u0.x, siluf_(g0.y) * u0.y); w.y = pk2(siluf_(g0.z) * u0.z, siluf_(g0.w) * u0.w); w.z = pk2(siluf_(g1.x) * u1.x, siluf_(g1.y) * u1.y); w.w = pk2(siluf_(g1.z) * u1.z, siluf_(g1.w) * u1.w);
                *(v4u*)(ACT + (size_t)(row0 + ai * 128 + m * 16) * 256 + col0) = w; }
    }
};
struct EpiMoeDown {
    static constexpr bool PERM = true, AFTER_DRAIN = false; unsigned char* ws;
    __device__ __forceinline__ void operator()(const pg8::f32x4 (&acc)[2][2][4][2], const pg8::Unit& u, int wr, int wc, int fr, int fq) const {
        bf16* YS = (bf16*)(ws + WS_YS); const int* rowtok = (const int*)(ws + WS_ROWTOK); const float* roww = (const float*)(ws + WS_ROWW);
        const int row0 = u.pm * 256 + wr * 64 + fr, col0 = (u.pn & 3) * 256 + wc * 32 + 8 * fq;
#pragma unroll
        for (int ai = 0; ai < 2; ++ai)
#pragma unroll
            for (int m = 0; m < 4; ++m) { const int row = row0 + ai * 128 + m * 16; const int rt = rowtok[row]; const float wgt = roww[row];
                if (rt >= 0) {
#pragma unroll
                    for (int bj = 0; bj < 2; ++bj) { const f32x4 v0 = acc[ai][bj][m][0] * wgt, v1 = acc[ai][bj][m][1] * wgt;
                        v4u w; w.x = pk2(v0.x, v0.y); w.y = pk2(v0.z, v0.w); w.z = pk2(v1.x, v1.y); w.w = pk2(v1.z, v1.w);
                        *(v4u*)(YS + (size_t)rt * 1024 + col0 + bj * 128) = w; } } }
    }
};
struct MoeOrder {
    const LAS int* tile_exp; int nunits, G, c, sh;
    __device__ __forceinline__ bool next(int i, pg8::Unit& u) const {
        const int L = i * G + c; if (L >= nunits) return false;
        const int r = L >> sh, j = L & ((1 << sh) - 1);
        u.pm = r; u.pn = __builtin_amdgcn_readfirstlane((tile_exp[r] << sh) + j); return true;
    }
    __device__ __forceinline__ void a_ready(const pg8::Unit&) const {}
    __device__ __forceinline__ void done(const pg8::Unit&) const {}
};

__device__ __forceinline__ void ph_router(KArgs a, const Ctx& c, int l) {
    LAS int* lcnt = (LAS int*)(c.lds + MISC_OFF + 1024);
    LAS int* lbase = lcnt + 32;
    LAS int* tinf = lcnt + 64;
    LAS float* wreT = (LAS float*)c.lds;
    const int lane = c.lane;
    bf16* H2 = (bf16*)(a->ws + WS_H); unsigned* tokinfo = (unsigned*)(a->ws + WS_TOKINFO); int* rowtok = (int*)(a->ws + WS_ROWTOK);
    unsigned* gcnt = (unsigned*)(a->ws + WS_CTL) + CW_GCNT + l * 32;
    const float* n2w = a->in[I_N2W] + l * DM; const float* wrg = a->in[I_WRG] + (size_t)l * 1024 * 4; const float* wre = a->in[I_WRE] + (size_t)l * 1024 * 32;
    for (int i = c.bid * NTHR + c.tid; i < MOE_MAXROWS; i += c.G * NTHR) rowtok[i] = -1;
    for (int i = c.tid; i < 8192; i += NTHR) { const int k = i >> 3, n4 = (i & 7) * 4; const f32x4 w = *(const f32x4*)(wre + (size_t)k * 32 + n4);
        wreT[(n4 + 0) * 1024 + k] = w.x; wreT[(n4 + 1) * 1024 + k] = w.y; wreT[(n4 + 2) * 1024 + k] = w.z; wreT[(n4 + 3) * 1024 + k] = w.w; }
    for (int tb = c.bid; tb < NTOK / 64; tb += c.G) {
        __syncthreads();
        if (c.tid < 32) lcnt[c.tid] = 0;
        __syncthreads();
        for (int i = 0; i < 8; ++i) {
            const int tl = c.wave * 8 + i, m = tb * 64 + tl, b = m >> 12;
            const float* xr = (const float*)a->out + (size_t)m * DM; const float* mod = (const float*)(a->ws + WS_MOD) + (l * 4 + b) * 6144;
            f32x4 h[4];
#pragma unroll
            for (int j = 0; j < 4; ++j) h[j] = *(const f32x4*)(xr + 256 * j + 4 * lane);
            const float rstd = row_rstd(h, lane);
            float ag[4] = {0.f, 0.f, 0.f, 0.f};
#pragma unroll
            for (int j = 0; j < 4; ++j) { const int col = 256 * j + 4 * lane;
                const f32x4 nw = *(const f32x4*)(n2w + col), sh = *(const f32x4*)(mod + 3072 + col), sc = *(const f32x4*)(mod + 4096 + col);
                h[j] = h[j] * rstd * nw * (sc + 1.0f) + sh;
                v2u o; o.x = pk2(h[j].x, h[j].y); o.y = pk2(h[j].z, h[j].w); *(v2u*)(H2 + (size_t)m * DM + col) = o;
                const f32x4 r0 = *(const f32x4*)(wrg + (size_t)(col + 0) * 4), r1 = *(const f32x4*)(wrg + (size_t)(col + 1) * 4), r2 = *(const f32x4*)(wrg + (size_t)(col + 2) * 4), r3 = *(const f32x4*)(wrg + (size_t)(col + 3) * 4);
                ag[0] += h[j].x * r0.x + h[j].y * r1.x + h[j].z * r2.x + h[j].w * r3.x; ag[1] += h[j].x * r0.y + h[j].y * r1.y + h[j].z * r2.y + h[j].w * r3.y;
                ag[2] += h[j].x * r0.z + h[j].y * r1.z + h[j].z * r2.z + h[j].w * r3.z; ag[3] += h[j].x * r0.w + h[j].y * r1.w + h[j].z * r2.w + h[j].w * r3.w; }
#pragma unroll
            for (int q = 0; q < 4; ++q) ag[q] = wave_sum(ag[q], lane) + a->in[I_BRG][l * 4 + q];
            int g = 0; float gm = ag[0];
#pragma unroll
            for (int q = 1; q < 4; ++q) if (ag[q] > gm) { gm = ag[q]; g = q; }
            float den = 0.f;
#pragma unroll
            for (int q = 0; q < 4; ++q) den += __expf(ag[q] - gm);
            const float ptop = 1.f / den;
            float ae[8] = {0.f, 0.f, 0.f, 0.f, 0.f, 0.f, 0.f, 0.f};
#pragma unroll
            for (int j = 0; j < 4; ++j) { const int col = 256 * j + 4 * lane;
#pragma unroll
                for (int e = 0; e < 8; ++e) { const f32x4 w = *(const LAS f32x4*)(wreT + (g * 8 + e) * 1024 + col); ae[e] += (h[j].x * w.x + h[j].y * w.y) + (h[j].z * w.z + h[j].w * w.w); } }
#pragma unroll
            for (int q = 0; q < 8; ++q) ae[q] = wave_sum(ae[q], lane) + a->in[I_BRE][l * 32 + g * 8 + q];
            int e0 = 0; float v0 = ae[0];
#pragma unroll
            for (int q = 1; q < 8; ++q) if (ae[q] > v0) { v0 = ae[q]; e0 = q; }
            int e1 = -1; float v1 = -3e38f;
#pragma unroll
            for (int q = 0; q < 8; ++q) if (q != e0 && ae[q] > v1) { v1 = ae[q]; e1 = q; }
            const float ex = __expf(v1 - v0); const float w0 = ptop / (1.f + ex), w1 = ptop * ex / (1.f + ex);
            if (lane == 0) { const int E0 = g * 8 + e0, E1 = g * 8 + e1;
                const int r0 = atomicAdd((int*)(lcnt + E0), 1), r1 = atomicAdd((int*)(lcnt + E1), 1);
                tinf[tl * 6 + 0] = E0; tinf[tl * 6 + 1] = E1; tinf[tl * 6 + 2] = r0; tinf[tl * 6 + 3] = r1; tinf[tl * 6 + 4] = __float_as_int(w0); tinf[tl * 6 + 5] = __float_as_int(w1); }
        }
        __syncthreads();
        if (c.tid < 32) lbase[c.tid] = (int)__hip_atomic_fetch_add(gcnt + c.tid, (unsigned)lcnt[c.tid], RLX_AGENT);
        __syncthreads();
        if (c.tid < 64) { const int m = tb * 64 + c.tid; const int E0 = tinf[c.tid * 6], E1 = tinf[c.tid * 6 + 1];
            v4u o; o.x = (unsigned)E0; o.y = (unsigned)E1; o.z = (unsigned)(lbase[E0] + tinf[c.tid * 6 + 2]); o.w = (unsigned)(lbase[E1] + tinf[c.tid * 6 + 3]);
            *(v4u*)(tokinfo + (size_t)m * 8) = o; *(v2u*)(tokinfo + (size_t)m * 8 + 4) = (v2u){(unsigned)tinf[c.tid * 6 + 4], (unsigned)tinf[c.tid * 6 + 5]}; }
    }
}
__device__ __forceinline__ void moe_table(KArgs a, const Ctx& c, int l) {
    LAS int* tile_exp = (LAS int*)(c.lds + MISC_OFF + 2048); LAS int* offs = tile_exp + 192; LAS int* ntl = offs + 32; LAS int* pre = ntl + 4;
    const unsigned* gcnt = (const unsigned*)(a->ws + WS_CTL) + CW_GCNT + l * 32;
    __syncthreads();
    if (c.tid < 64) { const int e = c.tid & 31; const int cnt = (int)__hip_atomic_load(gcnt + e, RLX_AGENT); const int nt = (cnt + 255) >> 8; int inc = nt;
#pragma unroll
        for (int o = 1; o < 32; o <<= 1) { const int v = shidx_i(inc, (c.lane - o) & 63); if (e >= o) inc += v; }
        if (c.tid < 32) { offs[e] = (inc - nt) * 256; pre[e] = inc; if (e == 31) ntl[0] = inc; } }
    __syncthreads();
    if (c.tid < MOE_MAXTILES) { int E = 0;
#pragma unroll
        for (int e = 0; e < 32; ++e) E += (pre[e] <= c.tid) ? 1 : 0;
        tile_exp[c.tid] = E < 31 ? E : 31; }
    __syncthreads();
}
__device__ __forceinline__ void ph_gather(KArgs a, const Ctx& c, int l) {
    moe_table(a, c, l);
    const LAS int* offs = (const LAS int*)(c.lds + MISC_OFF + 2048) + 192;
    const int gw = c.bid * NW + c.wave, NGW = c.G * NW, lane = c.lane;
    const bf16* H2 = (const bf16*)(a->ws + WS_H); bf16* HS = (bf16*)(a->ws + WS_HS); const unsigned* tokinfo = (const unsigned*)(a->ws + WS_TOKINFO);
    int* rowtok = (int*)(a->ws + WS_ROWTOK); float* roww = (float*)(a->ws + WS_ROWW);
    for (int m = gw; m < NTOK; m += NGW) {
        const v4u ti = *(const v4u*)(tokinfo + (size_t)m * 8); const v2u tw = *(const v2u*)(tokinfo + (size_t)m * 8 + 4);
        const int d0 = offs[ti.x] + (int)ti.z, d1 = offs[ti.y] + (int)ti.w;
        const v4u x0 = *(const v4u*)(H2 + (size_t)m * DM + lane * 8), x1 = *(const v4u*)(H2 + (size_t)m * DM + 512 + lane * 8);
        *(v4u*)(HS + (size_t)d0 * DM + lane * 8) = x0; *(v4u*)(HS + (size_t)d0 * DM + 512 + lane * 8) = x1;
        *(v4u*)(HS + (size_t)d1 * DM + lane * 8) = x0; *(v4u*)(HS + (size_t)d1 * DM + 512 + lane * 8) = x1;
        if (lane == 0) { rowtok[d0] = m * 2; rowtok[d1] = m * 2 + 1; roww[d0] = __uint_as_float(tw.x); roww[d1] = __uint_as_float(tw.y); }
    }
}
constexpr int DN_IMG = 57344, DN_LDW = 132, DN_LDA = 68;
typedef __bf16 bf16x2_t __attribute__((ext_vector_type(2)));
typedef float f32x2_t __attribute__((ext_vector_type(2)));
__device__ __forceinline__ unsigned cvtpk(float lo, float hi) { f32x2_t v = {lo, hi}; bf16x2_t b = __builtin_convertvector(v, bf16x2_t); return __builtin_bit_cast(unsigned, b); }
__device__ __forceinline__ bf16x8 pack8(f32x4 a, f32x4 b) { v4u w; w.x = cvtpk(a.x, a.y); w.y = cvtpk(a.z, a.w); w.z = cvtpk(b.x, b.y); w.w = cvtpk(b.z, b.w); return __builtin_bit_cast(bf16x8, w); }
#define MFMA16(a, b, c) __builtin_amdgcn_mfma_f32_16x16x32_bf16((a), (b), (c), 0, 0, 0)

__device__ __forceinline__ void dn_raw_load(KArgs a, const Ctx& c, int item, v4u (&raw)[3][5]) {
    const bf16* QKVB = (const bf16*)(a->ws + WS_QKVB);
    const int n = item & 63, h = (item >> 6) & 3, b = item >> 8, t0 = n * DNC;
    const int cg = c.tid & 15, rg = c.tid >> 4, tA = t0 + 2 * rg - 3;
#pragma unroll
    for (int part = 0; part < 3; ++part)
#pragma unroll
        for (int i = 0; i < 5; ++i) { const int tt = tA + i; raw[part][i] = (v4u){0u, 0u, 0u, 0u};
            if (tt >= 0) raw[part][i] = *(const v4u*)(QKVB + (size_t)(b * SEQ + tt) * 1536 + part * 512 + h * 128 + 8 * cg); }
}
__device__ __forceinline__ void dn_conv_store(KArgs a, const Ctx& c, int l, int h, const v4u (&raw)[3][5], LAS float* qs, LAS float* ks, LAS float* vs) {
    const float* cw = a->in[I_CONVW] + (size_t)l * 4 * 1536;
    const int cg = c.tid & 15, rg = c.tid >> 4;
#pragma unroll
    for (int part = 0; part < 3; ++part) {
        const int colb = part * 512 + h * 128 + 8 * cg;
        float w[4][8];
#pragma unroll
        for (int i = 0; i < 4; ++i) { const f32x4 w0 = *(const f32x4*)(cw + i * 1536 + colb), w1 = *(const f32x4*)(cw + i * 1536 + colb + 4);
            w[i][0] = w0.x; w[i][1] = w0.y; w[i][2] = w0.z; w[i][3] = w0.w; w[i][4] = w1.x; w[i][5] = w1.y; w[i][6] = w1.z; w[i][7] = w1.w; }
        LAS float* dst = part == 0 ? qs : part == 1 ? ks : vs;
#pragma unroll
        for (int rr = 0; rr < 2; ++rr) {
            float y[8];
#pragma unroll
            for (int e = 0; e < 8; ++e) y[e] = 0.f;
#pragma unroll
            for (int i = 0; i < 4; ++i) { const v4u x = raw[part][rr + i];
                y[0] += w[i][0] * bflo(x.x); y[1] += w[i][1] * bfhi(x.x); y[2] += w[i][2] * bflo(x.y); y[3] += w[i][3] * bfhi(x.y); y[4] += w[i][4] * bflo(x.z); y[5] += w[i][5] * bfhi(x.z); y[6] += w[i][6] * bflo(x.w); y[7] += w[i][7] * bfhi(x.w); }
            float ss = 0.f;
#pragma unroll
            for (int e = 0; e < 8; ++e) { y[e] = siluf_(y[e]); ss += y[e] * y[e]; }
            if (part < 2) { ss += dpp_f<0xB1>(ss); ss += dpp_f<0x4E>(ss); ss += dpp_f<0x141>(ss); ss += dpp_f<0x140>(ss);
                const float rs = __builtin_amdgcn_rsqf(ss + EPS) * (part == 0 ? 0.08838834764831845f : 1.f);
#pragma unroll
                for (int e = 0; e < 8; ++e) y[e] *= rs; }
            const int r = 2 * rg + rr;
            *(LAS f32x4*)(dst + r * DN_LDW + 8 * cg) = (f32x4){y[0], y[1], y[2], y[3]}; *(LAS f32x4*)(dst + r * DN_LDW + 8 * cg + 4) = (f32x4){y[4], y[5], y[6], y[7]};
        }
    }
}

__device__ __forceinline__ void ph_dn_prep(KArgs a, const Ctx& c, int l) {
    LAS float* qs = (LAS float*)c.lds; LAS float* ks = qs + 64 * DN_LDW; LAS float* vs = ks + 64 * DN_LDW;
    LAS float* Am = vs + 64 * DN_LDW; LAS float* Pm = Am + 64 * DN_LDA;
    LAS float* bt = (LAS float*)(c.lds + MISC_OFF + 1024); LAS float* Gc = bt + 64;
    const float* beta = (const float*)(a->ws + WS_BETA); const float* glog = (const float*)(a->ws + WS_GLOG);
#if MK_PROBE_A >= 30 && MK_PROBE_A <= 36
    unsigned ppa = 0, pq = (unsigned)__builtin_amdgcn_s_memrealtime();
#define PP_TICK(w) do { const unsigned t_ = (unsigned)__builtin_amdgcn_s_memrealtime(); if ((w) == MK_PROBE_A - 30) ppa += t_ - pq; pq = t_; } while (0)
#else
#define PP_TICK(w) do {} while (0)
#endif
    v4u raw[3][5];
    if (c.bid < NB * HB * NCH) dn_raw_load(a, c, c.bid, raw);
    for (int item = c.bid; item < NB * HB * NCH; item += c.G) {
        int tid = c.tid; asm volatile("" : "+v"(tid));
        const int lane = tid & 63, row = lane & 15, quad = lane >> 4;
        const int n = item & 63, h = (item >> 6) & 3, b = item >> 8, t0 = n * DNC;
        unsigned char* img = a->ws + WS_IMG + (size_t)item * DN_IMG;
        __syncthreads();
        PP_TICK(6);
        dn_conv_store(a, c, l, h, raw, qs, ks, vs);
        { const int nxt = item + c.G; if (nxt < NB * HB * NCH) dn_raw_load(a, c, nxt, raw); }
        if (tid < 64) { const int tok = b * SEQ + t0 + tid; bt[tid] = beta[tok * 4 + h]; float g = glog[tok * 4 + h];
#pragma unroll
            for (int o = 1; o < 64; o <<= 1) { const float v = shidx(g, (lane - o) & 63); if (lane >= o) g += v; }
            Gc[tid] = g; }
        __syncthreads();
        PP_TICK(0);
        {   const int sel = c.wave >> 2, ti = c.wave & 3; const LAS float* rs = sel == 0 ? ks : qs; LAS float* dstm = sel == 0 ? Am : Pm;
            bf16x8 af[4];
#pragma unroll
            for (int s = 0; s < 4; ++s) { const LAS float* p = rs + (ti * 16 + row) * DN_LDW + 32 * s + 8 * quad; af[s] = pack8(*(const LAS f32x4*)p, *(const LAS f32x4*)(p + 4)); }
            for (int tj = 0; tj < 4; ++tj) {
                f32x4 acc = {0.f, 0.f, 0.f, 0.f};
                if (tj <= ti) {
#pragma unroll
                    for (int s = 0; s < 4; ++s) { const LAS float* p = ks + (tj * 16 + row) * DN_LDW + 32 * s + 8 * quad; const bf16x8 bfr = pack8(*(const LAS f32x4*)p, *(const LAS f32x4*)(p + 4)); acc = MFMA16(af[s], bfr, acc); }
                }
                const int j = tj * 16 + row; const float Gj = Gc[j];
#pragma unroll
                for (int r = 0; r < 4; ++r) { const int i = ti * 16 + 4 * quad + r; const float dec = __expf(fminf(Gc[i] - Gj, 0.f));
                    float v = acc[r] * dec; if (sel == 0) v = (j < i) ? v * bt[i] : 0.f; else v = (j <= i) ? v : 0.f;
                    dstm[i * DN_LDA + j] = v; }
            }
        }
        __syncthreads();
        PP_TICK(1);
        const float Glast = Gc[63];
        {
            for (int q = 0; q < 5; ++q) { const int p = tid + 512 * q, blk = p >> 6; float v[8];
                if (blk < 16) { const int mt = blk >> 2, s = blk & 3, cr = 16 * mt + row, k0 = 32 * s + 4 * quad; const float e = __expf(Gc[cr]);
                    const f32x4 v0 = *(const LAS f32x4*)(qs + cr * DN_LDW + k0), v1 = *(const LAS f32x4*)(qs + cr * DN_LDW + k0 + 16);
                    v[0] = v0.x * e; v[1] = v0.y * e; v[2] = v0.z * e; v[3] = v0.w * e; v[4] = v1.x * e; v[5] = v1.y * e; v[6] = v1.z * e; v[7] = v1.w * e; }
                else if (blk < 32) { const int b2 = blk - 16, mt = b2 >> 1, s = b2 & 1, k = 16 * mt + row;
#pragma unroll
                    for (int j = 0; j < 8; ++j) { const int cj = 32 * s + 16 * (j >> 2) + 4 * quad + (j & 3); v[j] = ks[cj * DN_LDW + k] * __expf(Glast - Gc[cj]); } }
                else { const int b3 = blk - 32, mt = b3 >> 1, s = b3 & 1, i = 16 * mt + row, c0 = 32 * s + 4 * quad;
                    const f32x4 v0 = *(const LAS f32x4*)(Pm + i * DN_LDA + c0), v1 = *(const LAS f32x4*)(Pm + i * DN_LDA + c0 + 16);
                    v[0] = v0.x; v[1] = v0.y; v[2] = v0.z; v[3] = v0.w; v[4] = v1.x; v[5] = v1.y; v[6] = v1.z; v[7] = v1.w; }
                v4u w; w.x = cvtpk(v[0], v[1]); w.y = cvtpk(v[2], v[3]); w.z = cvtpk(v[4], v[5]); w.w = cvtpk(v[6], v[7]);
                *(v4u*)(img + 16384 + (size_t)p * 16) = w; }
            if (tid == 0) ((float*)(a->ws + WS_GL))[item] = __expf(Glast);
        }
        __syncthreads();
        PP_TICK(2);
        LAS float* Ti = Pm;
        if (c.wave < 4 && lane < 16) { const int bI = c.wave; float sv[16];
            int vz = 0; asm volatile("" : "+v"(vz)); const LAS float* AmV = Am + vz + (16 * bI) * DN_LDA + 16 * bI;
#pragma unroll
            for (int r = 0; r < 16; ++r) sv[r] = (r == lane) ? 1.f : 0.f;
#pragma unroll
            for (int rp = 0; rp < 15; ++rp)
#pragma unroll
                for (int r = rp + 1; r < 16; ++r) sv[r] -= AmV[r * DN_LDA + rp] * sv[rp];
#pragma unroll
            for (int r = 0; r < 16; ++r) Ti[(bI * 16 + r) * 20 + lane] = sv[r]; }
        __syncthreads();
        PP_TICK(3);
        {   const float isw0 = 0.f; (void)isw0;
#pragma unroll
            for (int bI = 0; bI < 4; ++bI) {
#pragma unroll
                for (int q = 0; q < 2; ++q) { const int nt = 2 * c.wave + q; const bool isw = nt >= 8; LAS float* xb = (isw ? ks : vs) + (nt & 7) * 16;
                    if (bI > 0) {
                        f32x4 acc = {0.f, 0.f, 0.f, 0.f};
#pragma unroll
                        for (int s2 = 0; s2 < (bI == 3 ? 2 : 1); ++s2) { const int j0 = 32 * s2 + 8 * quad;
                            f32x4 a0 = *(const LAS f32x4*)(Am + (16 * bI + row) * DN_LDA + j0), a1 = *(const LAS f32x4*)(Am + (16 * bI + row) * DN_LDA + j0 + 4);
                            if (j0 >= 16 * bI) { a0 = (f32x4){0.f, 0.f, 0.f, 0.f}; a1 = a0; }
                            float xv[8];
#pragma unroll
                            for (int j = 0; j < 8; ++j) xv[j] = xb[(j0 + j) * DN_LDW + row];
                            acc = MFMA16(pack8(a0, a1), pack8((f32x4){xv[0], xv[1], xv[2], xv[3]}, (f32x4){xv[4], xv[5], xv[6], xv[7]}), acc); }
#pragma unroll
                        for (int r = 0; r < 4; ++r) { const int i = 16 * bI + 4 * quad + r; const float sc = isw ? bt[i] * __expf(Gc[i]) : bt[i]; xb[i * DN_LDW + row] = xb[i * DN_LDW + row] * sc - acc[r]; }
                    }
                }
                if (bI > 0) __syncthreads();
#pragma unroll
                for (int q = 0; q < 2; ++q) { const int nt = 2 * c.wave + q; const bool isw = nt >= 8; LAS float* xb = (isw ? ks : vs) + (nt & 7) * 16;
                    f32x4 a0 = {0.f, 0.f, 0.f, 0.f}, a1 = a0; float xv[8];
                    if (quad < 2) { a0 = *(const LAS f32x4*)(Ti + (bI * 16 + row) * 20 + 8 * quad); a1 = *(const LAS f32x4*)(Ti + (bI * 16 + row) * 20 + 8 * quad + 4); }
#pragma unroll
                    for (int j = 0; j < 8; ++j) { const int i = 16 * bI + ((8 * quad + j) & 15); float v = xb[i * DN_LDW + row];
                        if (bI == 0) v *= isw ? bt[i] * __expf(Gc[i]) : bt[i];
                        xv[j] = v; }
                    f32x4 acc = {0.f, 0.f, 0.f, 0.f};
                    acc = MFMA16(pack8(a0, a1), pack8((f32x4){xv[0], xv[1], xv[2], xv[3]}, (f32x4){xv[4], xv[5], xv[6], xv[7]}), acc);
#pragma unroll
                    for (int r = 0; r < 4; ++r) xb[(16 * bI + 4 * quad + r) * DN_LDW + row] = acc[r]; }
                __syncthreads();
            }
        }
        PP_TICK(4);
#pragma unroll
        for (int q = 0; q < 2; ++q) { const int p = tid + 512 * q, blk = p >> 6, mt = blk >> 2, s = blk & 3, cr = 16 * mt + row, k0 = 32 * s + 4 * quad;
            const f32x4 v0 = *(const LAS f32x4*)(ks + cr * DN_LDW + k0), v1 = *(const LAS f32x4*)(ks + cr * DN_LDW + k0 + 16);
            v4u w; w.x = cvtpk(-v0.x, -v0.y); w.y = cvtpk(-v0.z, -v0.w); w.z = cvtpk(-v1.x, -v1.y); w.w = cvtpk(-v1.z, -v1.w);
            *(v4u*)(img + (size_t)p * 16) = w; }
        {   unsigned char* ug = a->ws + WS_U + (size_t)item * 16384;
#pragma unroll
            for (int q = 0; q < 2; ++q) { const int p = tid + 512 * q, sl = p >> 7, ln = (p >> 1) & 63, hh = p & 1, v = 16 * sl + (ln & 15), qd = ln >> 4; float u8[8];
#pragma unroll
                for (int e = 0; e < 8; ++e) u8[e] = vs[(16 * (2 * hh + (e >> 2)) + 4 * qd + (e & 3)) * DN_LDW + v];
                v4u w; w.x = cvtpk(u8[0], u8[1]); w.y = cvtpk(u8[2], u8[3]); w.z = cvtpk(u8[4], u8[5]); w.w = cvtpk(u8[6], u8[7]);
                *(v4u*)(ug + (size_t)(sl * 64 + ln) * 32 + hh * 16) = w; } }
        PP_TICK(5);
    }
#if MK_PROBE_A >= 30 && MK_PROBE_A <= 36
    if (blockIdx.x == 0 && c.tid == 0) ((unsigned long long*)((unsigned*)(a->ws + WS_CTL) + 12288))[56 + l] = ppa;
#endif
}

constexpr int DN_OS = 2 * DN_IMG;
__device__ __forceinline__ void ph_dn_scan(KArgs a, const Ctx& c, int l) {
    LAS unsigned char* lds = c.lds;
    const int lane = c.lane, wv = c.wave, tid = c.tid; const bool cw = wv < 4;
    const bf16* ZB = (const bf16*)(a->ws + WS_ZB); bf16* YB = (bf16*)(a->ws + WS_YB); const float* onw = a->in[I_ONW] + l * 128; const float* glp = (const float*)(a->ws + WS_GL);
    float* ssq = (float*)(a->ws + WS_SSQ);
    for (int item = c.bid; item < 2 * NB * HB; item += c.G) {
        const int bh = item >> 1, half = item & 1, b = bh >> 2, h = bh & 3;
        const unsigned char* img0 = a->ws + WS_IMG + (size_t)bh * 64 * DN_IMG;
        __syncthreads();
        if (cw) {
            const unsigned char* ugb = a->ws + WS_U + (size_t)bh * 64 * 16384; const unsigned uoff = (unsigned)((half * 4 + wv) * 64 + lane) * 32u;
            f32x4 S[8];
#pragma unroll
            for (int m = 0; m < 8; ++m) S[m] = (f32x4){0.f, 0.f, 0.f, 0.f};
            v4u uc0 = *(const v4u*)(ugb + uoff), uc1 = *(const v4u*)(ugb + uoff + 16);
            for (int n = 0; n <= NCH; ++n) {
                asm volatile("s_waitcnt lgkmcnt(0)\n\ts_barrier" ::: "memory");
                if (n == NCH) break;
                v4u un0 = uc0, un1 = uc1;
                if (n + 1 < NCH) { un0 = *(const v4u*)(ugb + (size_t)(n + 1) * 16384 + uoff); un1 = *(const v4u*)(ugb + (size_t)(n + 1) * 16384 + uoff + 16); }
                const float gl = glp[bh * 64 + n];
                const LAS unsigned char* im = lds + (n & 1) * DN_IMG + lane * 16;
                bf16x8 Sb[4];
#pragma unroll
                for (int s = 0; s < 4; ++s) Sb[s] = pack8(S[2 * s], S[2 * s + 1]);
                f32x4 X[4], O[4];
                X[0] = (f32x4){bflo(uc0.x), bfhi(uc0.x), bflo(uc0.y), bfhi(uc0.y)}; X[1] = (f32x4){bflo(uc0.z), bfhi(uc0.z), bflo(uc0.w), bfhi(uc0.w)};
                X[2] = (f32x4){bflo(uc1.x), bfhi(uc1.x), bflo(uc1.y), bfhi(uc1.y)}; X[3] = (f32x4){bflo(uc1.z), bfhi(uc1.z), bflo(uc1.w), bfhi(uc1.w)};
                bf16x8 fa[8], fb[8];
#define DN_LDF(arr, off) do { _Pragma("unroll") for (int q_ = 0; q_ < 8; ++q_) arr[q_] = *(const LAS bf16x8*)(im + (off) + q_ * 1024); } while (0)
                DN_LDF(fa, 0); DN_LDF(fb, 8192);
#pragma unroll
                for (int mt = 0; mt < 2; ++mt)
#pragma unroll
                    for (int s = 0; s < 4; ++s) X[mt] = MFMA16(fa[mt * 4 + s], Sb[s], X[mt]);
                DN_LDF(fa, 16384);
#pragma unroll
                for (int mt = 0; mt < 2; ++mt)
#pragma unroll
                    for (int s = 0; s < 4; ++s) X[2 + mt] = MFMA16(fb[mt * 4 + s], Sb[s], X[2 + mt]);
                DN_LDF(fb, 16384 + 8192);
#pragma unroll
                for (int mt = 0; mt < 2; ++mt) { O[mt] = (f32x4){0.f, 0.f, 0.f, 0.f};
#pragma unroll
                    for (int s = 0; s < 4; ++s) O[mt] = MFMA16(fa[mt * 4 + s], Sb[s], O[mt]); }
                DN_LDF(fa, 32768);
#pragma unroll
                for (int mt = 0; mt < 2; ++mt) { O[2 + mt] = (f32x4){0.f, 0.f, 0.f, 0.f};
#pragma unroll
                    for (int s = 0; s < 4; ++s) O[2 + mt] = MFMA16(fb[mt * 4 + s], Sb[s], O[2 + mt]); }
                DN_LDF(fb, 32768 + 8192);
                bf16x8 Xb[2];
                Xb[0] = pack8(X[0], X[1]); Xb[1] = pack8(X[2], X[3]);
#pragma unroll
                for (int m = 0; m < 4; ++m) { S[m] = S[m] * gl;
#pragma unroll
                    for (int s = 0; s < 2; ++s) S[m] = MFMA16(fa[m * 2 + s], Xb[s], S[m]); }
                DN_LDF(fa, 49152);
#pragma unroll
                for (int m = 0; m < 4; ++m) { S[4 + m] = S[4 + m] * gl;
#pragma unroll
                    for (int s = 0; s < 2; ++s) S[4 + m] = MFMA16(fb[m * 2 + s], Xb[s], S[4 + m]); }
#pragma unroll
                for (int mt = 0; mt < 4; ++mt)
#pragma unroll
                    for (int s = 0; s < 2; ++s) O[mt] = MFMA16(fa[mt * 2 + s], Xb[s], O[mt]);
#undef DN_LDF
                LAS unsigned short* os = (LAS unsigned short*)(lds + DN_OS + (n & 1) * 8192);
#pragma unroll
                for (int mt = 0; mt < 4; ++mt)
#pragma unroll
                    for (int r = 0; r < 4; ++r) os[(16 * mt + 4 * (lane >> 4) + r) * 64 + 16 * wv + (lane & 15)] = (unsigned short)(cvtpk(O[mt][r], 0.f) & 0xffffu);
                uc0 = un0; uc1 = un1;
            }
        } else {
            const int ht = tid - 256, hw = wv - 4, nr = ht >> 2, nq = ht & 3;
            const bf16* zpb = ZB + (size_t)(b * SEQ) * 512 + h * 128 + half * 64; bf16* ypb = YB + (size_t)(b * SEQ) * 512 + h * 128 + half * 64; const unsigned zoff = (unsigned)(nr * 512 + nq * 16);
            float* sqp = ssq + ((size_t)(b * SEQ + nr) * 4 + h) * 2 + half;
#define DN_DMA(n, buf) do { _Pragma("unroll") for (int q_ = 0; q_ < 14; ++q_) { const int pc_ = hw + 4 * q_; \
                __builtin_amdgcn_global_load_lds((const unsigned*)(img0 + (size_t)(n) * DN_IMG + pc_ * 1024 + lane * 16), (LAS unsigned*)(lds + (buf) * DN_IMG + pc_ * 1024), 16, 0, 0); } } while (0)
            DN_DMA(0, 0);
            v4u zc0 = *(const v4u*)(zpb + zoff), zc1 = *(const v4u*)(zpb + zoff + 8);
            f32x4 ow[4];
#pragma unroll
            for (int q = 0; q < 4; ++q) ow[q] = *(const f32x4*)(onw + half * 64 + nq * 16 + q * 4);
            asm volatile("s_waitcnt vmcnt(0) lgkmcnt(0)\n\ts_barrier" ::: "memory");
            DN_DMA(1, 1);
            for (int n = 1; n <= NCH; ++n) {
                if (n == 1) asm volatile("s_waitcnt vmcnt(0) lgkmcnt(0)\n\ts_barrier" ::: "memory"); else asm volatile("s_waitcnt vmcnt(3) lgkmcnt(0)\n\ts_barrier" ::: "memory");
                v4u zn0 = zc0, zn1 = zc1;
                if (n < NCH) { zn0 = *(const v4u*)(zpb + (size_t)n * DNC * 512 + zoff); zn1 = *(const v4u*)(zpb + (size_t)n * DNC * 512 + zoff + 8); }
                asm volatile("" ::: "memory");
                if (n + 1 < NCH) DN_DMA(n + 1, (n + 1) & 1);
                asm volatile("" ::: "memory");
                {
                    const LAS unsigned short* os = (const LAS unsigned short*)(lds + DN_OS + ((n - 1) & 1) * 8192) + nr * 64 + nq * 16;
                    float o[16]; float ss = 0.f;
                    const v4u o0 = *(const LAS v4u*)os, o1 = *(const LAS v4u*)(os + 8);
                    o[0] = bflo(o0.x); o[1] = bfhi(o0.x); o[2] = bflo(o0.y); o[3] = bfhi(o0.y); o[4] = bflo(o0.z); o[5] = bfhi(o0.z); o[6] = bflo(o0.w); o[7] = bfhi(o0.w);
                    o[8] = bflo(o1.x); o[9] = bfhi(o1.x); o[10] = bflo(o1.y); o[11] = bfhi(o1.y); o[12] = bflo(o1.z); o[13] = bfhi(o1.z); o[14] = bflo(o1.w); o[15] = bfhi(o1.w);
#pragma unroll
                    for (int e = 0; e < 16; ++e) ss += o[e] * o[e];
                    ss += dpp_f<0xB1>(ss); ss += dpp_f<0x4E>(ss);
                    bf16* yp = ypb + (size_t)(n - 1) * DNC * 512 + zoff;
                    v4u y; y.x = cvtpk(o[0] * ow[0].x * siluf_(bflo(zc0.x)), o[1] * ow[0].y * siluf_(bfhi(zc0.x))); y.y = cvtpk(o[2] * ow[0].z * siluf_(bflo(zc0.y)), o[3] * ow[0].w * siluf_(bfhi(zc0.y)));
                    y.z = cvtpk(o[4] * ow[1].x * siluf_(bflo(zc0.z)), o[5] * ow[1].y * siluf_(bfhi(zc0.z))); y.w = cvtpk(o[6] * ow[1].z * siluf_(bflo(zc0.w)), o[7] * ow[1].w * siluf_(bfhi(zc0.w)));
                    *(v4u*)yp = y;
                    y.x = cvtpk(o[8] * ow[2].x * siluf_(bflo(zc1.x)), o[9] * ow[2].y * siluf_(bfhi(zc1.x))); y.y = cvtpk(o[10] * ow[2].z * siluf_(bflo(zc1.y)), o[11] * ow[2].w * siluf_(bfhi(zc1.y)));
                    y.z = cvtpk(o[12] * ow[3].x * siluf_(bflo(zc1.z)), o[13] * ow[3].y * siluf_(bfhi(zc1.z))); y.w = cvtpk(o[14] * ow[3].z * siluf_(bflo(zc1.w)), o[15] * ow[3].w * siluf_(bfhi(zc1.w)));
                    *(v4u*)(yp + 8) = y;
                    sqp[(size_t)(n - 1) * DNC * 8] = ss;
                }
                zc0 = zn0; zc1 = zn1;
            }
#undef DN_DMA
        }
        asm volatile("s_waitcnt vmcnt(0)" ::: "memory"); __syncthreads();
    }
}
__device__ __forceinline__ void ph_yb_norm(KArgs a, const Ctx& c) {
    const int gw = c.bid * NW + c.wave, NGW = c.G * NW, lane = c.lane; bf16* YB = (bf16*)(a->ws + WS_YB); const float* ssq = (const float*)(a->ws + WS_SSQ);
    for (int m = gw; m < NTOK; m += NGW) {
        const f32x2_t sq = *(const f32x2_t*)(ssq + (size_t)m * 8 + (lane >> 4) * 2); const float rstd = __builtin_amdgcn_rsqf((sq.x + sq.y) * (1.f / 128.f) + EPS);
        v4u w = *(const v4u*)(YB + (size_t)m * 512 + lane * 8);
        w.x = cvtpk(bflo(w.x) * rstd, bfhi(w.x) * rstd); w.y = cvtpk(bflo(w.y) * rstd, bfhi(w.y) * rstd); w.z = cvtpk(bflo(w.z) * rstd, bfhi(w.z) * rstd); w.w = cvtpk(bflo(w.w) * rstd, bfhi(w.w) * rstd);
        *(v4u*)(YB + (size_t)m * 512 + lane * 8) = w;
    }
}
typedef short v4i16_t __attribute__((ext_vector_type(4)));
#define MFMA32(a, b, c) __builtin_amdgcn_mfma_f32_32x32x16_bf16((a), (b), (c), 0, 0, 0)
constexpr int AT_ROWB = 144;
constexpr int AT_TILE = 64 * AT_ROWB, AT_K = 0, AT_V = 3 * AT_TILE, AT_OST = 6 * AT_TILE, AT_BT = AT_OST + 8 * 32 * AT_ROWB, AT_KM = AT_BT + 1024, AT_UW = MISC_OFF + 512;
__device__ __forceinline__ int crow(int r, int hi) { return (r & 3) + 8 * (r >> 2) + 4 * hi; }
__device__ __forceinline__ bf16x8 vtr2(const LAS unsigned char* p) {
    const v4i16_t lo = __builtin_amdgcn_ds_read_tr16_b64_v4i16((LAS v4i16_t*)p), hi = __builtin_amdgcn_ds_read_tr16_b64_v4i16((LAS v4i16_t*)(p + 8 * AT_ROWB));
    return (bf16x8){lo[0], lo[1], lo[2], lo[3], hi[0], hi[1], hi[2], hi[3]};
}
__device__ __forceinline__ void ph_attn(KArgs a, const Ctx& c, int l) {
    LAS unsigned char* lds = c.lds; const int lane = c.lane, wv = c.wave, tid = c.tid, r32 = lane & 31, hi = lane >> 5;
    LAS float* btab = (LAS float*)(lds + AT_BT); LAS float* kms = (LAS float*)(lds + AT_KM); volatile LAS int* uw = (volatile LAS int*)(lds + AT_UW);
    const bf16* QKVA = (const bf16*)(a->ws + WS_QKVA); const float* kmean = (const float*)(a->ws + WS_KMEAN); bf16* YA = (bf16*)(a->ws + WS_YA); const float* relb = a->in[I_RELB];
    unsigned* ctr = (unsigned*)(a->ws + WS_CTL) + CW_ACTR + l * 64;
    const float LOG2E = 1.4426950408889634f, C2 = 0.125f * LOG2E, NINF = -__builtin_inff();
    const int srow = tid >> 3, sch = tid & 7; const unsigned sdst = srow * AT_ROWB + sch * 16;
    for (;;) {
        __syncthreads();
        if (tid == 0) uw[0] = (int)__hip_atomic_fetch_add(ctr, 1u, RLX_AGENT);
        __syncthreads();
        const int u = uw[0];
        if (u >= NB * HA * NBLK) { if (u >= NB * HA * NBLK + CV_NUNITS) break; convert_unit(a, c, l, u - NB * HA * NBLK); continue; }
        const int qb = 15 - (u >> 5), bh = u & 31, b = bh >> 3, h = bh & 7;
        const float c31 = relb[31 * 8 + h];
        for (int i = tid; i < 129; i += NTHR) btab[i] = (i < 128 ? (relb[(int)T5B[i] * 8 + h] - c31) : 0.f) * LOG2E;
        for (int i = tid; i < 1024; i += NTHR) kms[i] = kmean[(size_t)bh * 1024 + i];
        const int qrel = wv * 32 + r32, tokq = b * SEQ + qb * 256 + qrel;
        const bf16* kbase = QKVA + (size_t)(b * SEQ) * 1536 + 512 + h * 64 + sch * 8;
#define AT_LOAD(tt, KR, VR) do { const int t1_ = (tt), blk1_ = t1_ < 4 ? qb : ((t1_ - 4) >> 2), kt1_ = t1_ < 4 ? t1_ : ((t1_ - 4) & 3); const size_t ro_ = (size_t)(blk1_ * 256 + kt1_ * 64 + srow) * 1536; \
            KR = *(const v4u*)(kbase + ro_); VR = *(const v4u*)(kbase + ro_ + 512); } while (0)
#define AT_STORE(tt, KR, VR) do { const int bo_ = ((tt) % 3) * AT_TILE; *(LAS v4u*)(lds + AT_K + bo_ + sdst) = KR; *(LAS v4u*)(lds + AT_V + bo_ + sdst) = VR; } while (0)
        v4u krA, vrA, krB, vrB;
        AT_LOAD(0, krA, vrA); AT_LOAD(1, krB, vrB);
        float qf[32];
        {   const bf16* qp = QKVA + (size_t)tokq * 1536 + h * 64 + 8 * hi;
#pragma unroll
            for (int s = 0; s < 4; ++s) { const v4u w = *(const v4u*)(qp + 16 * s); qf[s * 8 + 0] = bflo(w.x); qf[s * 8 + 1] = bfhi(w.x); qf[s * 8 + 2] = bflo(w.y); qf[s * 8 + 3] = bfhi(w.y); qf[s * 8 + 4] = bflo(w.z); qf[s * 8 + 5] = bfhi(w.z); qf[s * 8 + 6] = bflo(w.w); qf[s * 8 + 7] = bfhi(w.w); } }
        AT_STORE(0, krA, vrA); AT_STORE(1, krB, vrB); AT_LOAD(2, krA, vrA);
        __syncthreads();
        unsigned selmask = 0u;
        {   float g[16];
#pragma unroll
            for (int n = 0; n < 16; ++n) { g[n] = -3e38f;
                if (n < qb) { float d = 0.f;
#pragma unroll
                    for (int s = 0; s < 4; ++s) { const f32x4 k0 = *(const LAS f32x4*)(kms + n * 64 + 16 * s + 8 * hi), k1 = *(const LAS f32x4*)(kms + n * 64 + 16 * s + 8 * hi + 4);
                        d += qf[s * 8] * k0.x + qf[s * 8 + 1] * k0.y + qf[s * 8 + 2] * k0.z + qf[s * 8 + 3] * k0.w + qf[s * 8 + 4] * k1.x + qf[s * 8 + 5] * k1.y + qf[s * 8 + 6] * k1.z + qf[s * 8 + 7] * k1.w; }
                    g[n] = d + shx(d, 32, lane); } }
#pragma unroll
            for (int t = 0; t < 3; ++t) { float best = -3.4e38f; int bi = 0;
#pragma unroll
                for (int n = 0; n < 16; ++n) { const bool ok = !((selmask >> n) & 1u) && g[n] > best; best = ok ? g[n] : best; bi = ok ? n : bi; }
                selmask |= 1u << bi; }
            selmask &= (1u << qb) - 1u; }
        bf16x8 qs[4];
#pragma unroll
        for (int s = 0; s < 4; ++s) { v4u w; w.x = cvtpk(qf[s * 8] * C2, qf[s * 8 + 1] * C2); w.y = cvtpk(qf[s * 8 + 2] * C2, qf[s * 8 + 3] * C2); w.z = cvtpk(qf[s * 8 + 4] * C2, qf[s * 8 + 5] * C2); w.w = cvtpk(qf[s * 8 + 6] * C2, qf[s * 8 + 7] * C2); qs[s] = __builtin_bit_cast(bf16x8, w); }
        float m = NINF, lsum = 0.f; f32x16 o0, o1;
#pragma unroll
        for (int r = 0; r < 16; ++r) { o0[r] = 0.f; o1[r] = 0.f; }
        const int NT = 4 * (qb + 1);
        for (int t0 = 0; t0 < NT; t0 += 2) {
#pragma unroll
            for (int hf = 0; hf < 2; ++hf) {
                const int t = t0 + hf;
                const int blk = t < 4 ? qb : ((t - 4) >> 2), kt = t < 4 ? t : ((t - 4) & 3);
                if (hf == 0) { if (t + 3 < NT) AT_LOAD(t + 3, krB, vrB); } else { if (t + 3 < NT) AT_LOAD(t + 3, krA, vrA); }
                const bool own = t < 4;
                const bool lane_act = own || ((selmask >> blk) & 1u);
                const bool wave_act = own ? (kt * 64 <= wv * 32 + 31) : (__builtin_amdgcn_ballot_w64(lane_act) != 0ull);
                if (wave_act) {
                    const LAS unsigned char* Kb = lds + AT_K + (t % 3) * AT_TILE; const LAS unsigned char* Vb = lds + AT_V + (t % 3) * AT_TILE;
                    f32x16 p0, p1;
    #pragma unroll
                    for (int r = 0; r < 16; ++r) { p0[r] = 0.f; p1[r] = 0.f; }
    #pragma unroll
                    for (int s = 0; s < 4; ++s) { const bf16x8 a0 = *(const LAS bf16x8*)(Kb + r32 * AT_ROWB + 32 * s + 16 * hi), a1 = *(const LAS bf16x8*)(Kb + (32 + r32) * AT_ROWB + 32 * s + 16 * hi);
                        p0 = MFMA32(a0, qs[s], p0); p1 = MFMA32(a1, qs[s], p1); }
                    if (own) {
    #pragma unroll
                        for (int r = 0; r < 16; ++r) { const int d0 = qrel - (kt * 64 + crow(r, hi)), d1 = d0 - 32;
                            p0[r] = d0 >= 0 ? p0[r] + btab[d0 > 128 ? 128 : d0] : NINF; p1[r] = d1 >= 0 ? p1[r] + btab[d1 > 128 ? 128 : d1] : NINF; }
                    } else if (blk == qb - 1 && kt >= 1) {
    #pragma unroll
                        for (int r = 0; r < 16; ++r) { const int d0 = qrel + 256 - (kt * 64 + crow(r, hi)), d1 = d0 - 32;
                            p0[r] += btab[d0 > 128 ? 128 : d0]; p1[r] += btab[d1 > 128 ? 128 : d1]; }
                    }
                    float mx = fmaxf(p0[0], p1[0]);
    #pragma unroll
                    for (int r = 1; r < 16; ++r) mx = fmaxf(mx, fmaxf(p0[r], p1[r]));
                    mx = fmaxf(mx, shx(mx, 32, lane));
                    const float tmax = lane_act ? mx : NINF, mnew = fmaxf(m, tmax), alpha = __builtin_amdgcn_exp2f(m - mnew), muse = lane_act ? mnew : __builtin_inff();
                    float rs = 0.f;
    #pragma unroll
                    for (int r = 0; r < 16; ++r) { p0[r] = __builtin_amdgcn_exp2f(p0[r] - muse); p1[r] = __builtin_amdgcn_exp2f(p1[r] - muse); rs += p0[r] + p1[r]; }
                    lsum = lsum * alpha + rs; m = mnew;
                    if (__builtin_amdgcn_ballot_w64(alpha != 1.f) != 0ull) {
    #pragma unroll
                        for (int r = 0; r < 16; ++r) { o0[r] *= alpha; o1[r] *= alpha; } }
                    bf16x8 pa[4];
                    { v4u w; w.x = cvtpk(p0[0], p0[1]); w.y = cvtpk(p0[2], p0[3]); w.z = cvtpk(p0[4], p0[5]); w.w = cvtpk(p0[6], p0[7]); pa[0] = __builtin_bit_cast(bf16x8, w);
                      w.x = cvtpk(p0[8], p0[9]); w.y = cvtpk(p0[10], p0[11]); w.z = cvtpk(p0[12], p0[13]); w.w = cvtpk(p0[14], p0[15]); pa[1] = __builtin_bit_cast(bf16x8, w);
                      w.x = cvtpk(p1[0], p1[1]); w.y = cvtpk(p1[2], p1[3]); w.z = cvtpk(p1[4], p1[5]); w.w = cvtpk(p1[6], p1[7]); pa[2] = __builtin_bit_cast(bf16x8, w);
                      w.x = cvtpk(p1[8], p1[9]); w.y = cvtpk(p1[10], p1[11]); w.z = cvtpk(p1[12], p1[13]); w.w = cvtpk(p1[14], p1[15]); pa[3] = __builtin_bit_cast(bf16x8, w); }
                    const LAS unsigned char* vp = Vb + (4 * hi + ((lane & 15) >> 2)) * AT_ROWB + 2 * (16 * ((lane >> 4) & 1) + 4 * (lane & 3));
    #pragma unroll
                    for (int ks = 0; ks < 4; ++ks) { const bf16x8 v0 = vtr2(vp + 16 * ks * AT_ROWB), v1 = vtr2(vp + 16 * ks * AT_ROWB + 64);
                        o0 = MFMA32(v0, pa[ks], o0); o1 = MFMA32(v1, pa[ks], o1); }
                }

                if (hf == 0) { if (t + 2 < NT) AT_STORE(t + 2, krA, vrA); } else { if (t + 2 < NT) AT_STORE(t + 2, krB, vrB); }
                asm volatile("s_waitcnt lgkmcnt(0)\n\ts_barrier" ::: "memory");
            }
        }
#undef AT_LOAD
#undef AT_STORE
        lsum += shx(lsum, 32, lane);
        const float inv = 1.f / lsum;
        LAS unsigned short* stg = (LAS unsigned short*)(lds + AT_OST + wv * 32 * AT_ROWB);
#pragma unroll
        for (int r = 0; r < 16; ++r) { stg[r32 * (AT_ROWB / 2) + crow(r, hi)] = (unsigned short)(cvtpk(o0[r] * inv, 0.f) & 0xffffu); stg[r32 * (AT_ROWB / 2) + 32 + crow(r, hi)] = (unsigned short)(cvtpk(o1[r] * inv, 0.f) & 0xffffu); }
        LDS_WAIT();
#pragma unroll
        for (int i = 0; i < 4; ++i) { const int row = i * 8 + (lane >> 3), ch = lane & 7; const v4u v = *(const LAS v4u*)((const LAS unsigned char*)stg + row * AT_ROWB + ch * 16);
            *(v4u*)(YA + (size_t)(b * SEQ + qb * 256 + wv * 32 + row) * 512 + h * 64 + ch * 8) = v; }
    }
}
constexpr int NPH_LAYER = 11, NPHASES = 2 + NLAYER * NPH_LAYER;
#ifndef DN_IMPL
#define DN_IMPL 1
#endif
#ifndef PH_MASK
#define PH_MASK 0xFFFF
#endif
#define PH_EN(k) ((PH_MASK >> (k)) & 1)
#define GEMM_PHASE(EPI, SCHED, g, S, E) pg8::gemm_phase<EPI, SCHED, true, true>(c.lds, g, S, E, c.tid)

#define PHASE_FN static __device__ __forceinline__ void
__device__ __forceinline__ KArgs launder_k(KArgs a) { unsigned long long v = (unsigned long long)a; asm volatile("" : "+s"(v)); return (KArgs)v; }
PHASE_FN f_mod(KArgs a, int& tid) { a = launder_k(a); Ctx c = make_ctx(tid); ph_mod(a, c); }
PHASE_FN f_norm1(KArgs a, int& tid, int l) { a = launder_k(a); Ctx c = make_ctx(tid); ph_norm1(a, c, l); __syncthreads(); ph_convert(a, c, l); }
PHASE_FN f_proj(KArgs a, int& tid) { a = launder_k(a); Ctx c = make_ctx(tid);
    pg8::Gemm g{(const bf16*)(a->ws + WS_H), (const bf16*)(a->ws + WS_WIN), NTOK, DINP, DM}; pg8::StaticOrder S; S.init(NTOK, DINP, c.G, c.bid);
    EpiProj E{a->ws}; GEMM_PHASE(EpiProj, pg8::StaticOrder, g, S, E); }
PHASE_FN f_kmean(KArgs a, int& tid) { a = launder_k(a); Ctx c = make_ctx(tid); ph_kmean(a, c); }
#ifndef ATTN_IMPL
#define ATTN_IMPL 1
#endif
#if ATTN_IMPL
PHASE_FN f_attn(KArgs a, int& tid, int l) { a = launder_k(a); Ctx c = make_ctx(tid); ph_attn(a, c, l); }
#else
PHASE_FN f_attn(KArgs a, int& tid, int l) { a = launder_k(a); Ctx c = make_ctx(tid); ph_attn_simple(a, c); }
#endif
PHASE_FN f_dn(KArgs a, int& tid, int l) { a = launder_k(a); Ctx c = make_ctx(tid); ph_dn_simple(a, c, l); }
PHASE_FN f_dn_prep(KArgs a, int& tid, int l) { a = launder_k(a); Ctx c = make_ctx(tid); ph_dn_prep(a, c, l); }
PHASE_FN f_dn_scan(KArgs a, int& tid, int l) { a = launder_k(a); Ctx c = make_ctx(tid); ph_dn_scan(a, c, l); }
PHASE_FN f_merge1(KArgs a, int& tid) { a = launder_k(a); Ctx c = make_ctx(tid);
    ph_yb_norm(a, c);
    pg8::Gemm g{(const bf16*)(a->ws + WS_YA), (const bf16*)(a->ws + WS_WUPA), NTOK, DM, WA}; pg8::StaticOrder S; S.init(NTOK, DM, c.G, c.bid);
    EpiMerge<false> E{a->ws}; GEMM_PHASE(EpiMerge<false>, pg8::StaticOrder, g, S, E); }
PHASE_FN f_merge2(KArgs a, int& tid) { a = launder_k(a); Ctx c = make_ctx(tid);
    pg8::Gemm g{(const bf16*)(a->ws + WS_YB), (const bf16*)(a->ws + WS_WUPB), NTOK, DM, WB}; pg8::StaticOrder S; S.init(NTOK, DM, c.G, c.bid);
    EpiMerge<true> E{a->ws}; GEMM_PHASE(EpiMerge<true>, pg8::StaticOrder, g, S, E); }
PHASE_FN f_out(KArgs a, int& tid, int l) { a = launder_k(a); Ctx c = make_ctx(tid);
    pg8::Gemm g{(const bf16*)(a->ws + WS_M), (const bf16*)(a->ws + WS_WOUT), NTOK, DM, DM}; pg8::StaticOrder S; S.init(NTOK, DM, c.G, c.bid);
    EpiOut E{l == 0 ? a->in[I_X] : (const float*)a->out, a->out, (const float*)(a->ws + WS_MOD) + l * 4 * 6144 + 2048}; GEMM_PHASE(EpiOut, pg8::StaticOrder, g, S, E); }
PHASE_FN f_router(KArgs a, int& tid, int l) { a = launder_k(a); Ctx c = make_ctx(tid); ph_router(a, c, l); }
PHASE_FN f_gather(KArgs a, int& tid, int l) { a = launder_k(a); Ctx c = make_ctx(tid); ph_gather(a, c, l); }
PHASE_FN f_moe_gu(KArgs a, int& tid, int l) { a = launder_k(a); Ctx c = make_ctx(tid);
    moe_table(a, c, l); const LAS int* te = (const LAS int*)(c.lds + MISC_OFF + 2048);
    pg8::Gemm g{(const bf16*)(a->ws + WS_HS), (const bf16*)(a->ws + WS_WEGU), MOE_MAXROWS, NEXP * 512, DM}; MoeOrder S{te, te[192 + 32] * 2, c.G, c.bid, 1};
    EpiMoeGU E{a->ws}; GEMM_PHASE(EpiMoeGU, MoeOrder, g, S, E); }
PHASE_FN f_moe_down(KArgs a, int& tid, int l) { a = launder_k(a); Ctx c = make_ctx(tid);
    moe_table(a, c, l); const LAS int* te = (const LAS int*)(c.lds + MISC_OFF + 2048);
    pg8::Gemm g{(const bf16*)(a->ws + WS_ACT), (const bf16*)(a->ws + WS_WED), MOE_MAXROWS, NEXP * 1024, DFF}; MoeOrder S{te, te[192 + 32] * 4, c.G, c.bid, 2};
    EpiMoeDown E{a->ws}; GEMM_PHASE(EpiMoeDown, MoeOrder, g, S, E); }
PHASE_FN f_final(KArgs a, int& tid) { a = launder_k(a); Ctx c = make_ctx(tid); ph_final(a, c); }

#define KA() launder_k((KArgs)__builtin_amdgcn_kernarg_segment_ptr())
__device__ __forceinline__ bool ph_in(int k) { KArgs a = KA(); return a->ph_lo <= k && k < a->ph_hi; }
#ifndef MK_PROBE_A
#define MK_PROBE_A -1
#endif
#ifndef MK_PROBE_B
#define MK_PROBE_B -1
#endif
constexpr int CW_TS = 12288;
__device__ __forceinline__ void grid_bar(int& tid, int k) {
    asm volatile("" : "+v"(tid));
#if MK_ONE_LAUNCH
    KArgs a = KA(); XcdBarrier b; b.bar = (unsigned*)(a->ws + WS_CTL) + CW_BAR; b.x = xb_xcc_id(); b.st = (volatile LAS unsigned*)((LAS unsigned char*)lds_raw + MISC_OFF) + 8;
    xcd_barrier(b, tid);
    if (MK_PROBE_A >= 0 && blockIdx.x == 0 && tid == 0) ((unsigned long long*)((unsigned*)(a->ws + WS_CTL) + CW_TS))[k + 1] = __builtin_amdgcn_s_memrealtime();
#else
    __syncthreads();
#endif
}
__global__ void __launch_bounds__(NTHR, 2) mk_fwd(Args a_) {
    int tid = threadIdx.x;
    {   volatile LAS unsigned* MISC = (volatile LAS unsigned*)((LAS unsigned char*)lds_raw + MISC_OFF);
        if (tid < 64) MISC[tid] = 0u;
        __syncthreads();
#if MK_ONE_LAUNCH
        (void)xcd_barrier_post((unsigned*)(KA()->ws + WS_CTL) + CW_BAR, MISC + 8, tid);
#endif
        if (MK_PROBE_A >= 0 && blockIdx.x == 0 && tid == 0) ((unsigned long long*)((unsigned*)(KA()->ws + WS_CTL) + CW_TS))[0] = __builtin_amdgcn_s_memrealtime();
    }
#define IN(k) ph_in(k)
#define SEAM(k) do { if (IN(k) && IN((k) + 1)) grid_bar(tid, (k)); } while (0)
    if (IN(0)) f_mod(KA(), tid); SEAM(0);
    for (int l = 0; l < NLAYER; ++l) {
        const int pb = 1 + l * NPH_LAYER;
        if (PH_EN(0) && IN(pb + 0)) f_norm1(KA(), tid, l); SEAM(pb + 0);
        if (PH_EN(1) && IN(pb + 1)) f_proj(KA(), tid); SEAM(pb + 1);
#if DN_IMPL
        if (PH_EN(2) && IN(pb + 2)) { f_kmean(KA(), tid); f_dn_prep(KA(), tid, l); } SEAM(pb + 2);
        if (PH_EN(3) && IN(pb + 3)) { f_dn_scan(KA(), tid, l);
            if (MK_PROBE_A >= 0 && blockIdx.x == 0 && tid == 0) ((unsigned long long*)((unsigned*)(KA()->ws + WS_CTL) + CW_TS))[40 + l] = __builtin_amdgcn_s_memrealtime();
            __syncthreads(); f_attn(KA(), tid, l);
            if (MK_PROBE_A >= 0 && blockIdx.x == 255 && tid == 0) ((unsigned long long*)((unsigned*)(KA()->ws + WS_CTL) + CW_TS))[44 + l] = __builtin_amdgcn_s_memrealtime(); } SEAM(pb + 3);
#else
        if (PH_EN(2) && IN(pb + 2)) f_kmean(KA(), tid); SEAM(pb + 2);
        if (PH_EN(3) && IN(pb + 3)) { f_attn(KA(), tid, l); __syncthreads(); f_dn(KA(), tid, l); } SEAM(pb + 3);
#endif
        if (PH_EN(4) && IN(pb + 4)) f_merge1(KA(), tid); SEAM(pb + 4);
        if (PH_EN(5) && IN(pb + 5)) f_merge2(KA(), tid); SEAM(pb + 5);
        if (PH_EN(6) && IN(pb + 6)) f_out(KA(), tid, l); SEAM(pb + 6);
        if (PH_EN(7) && IN(pb + 7)) f_router(KA(), tid, l); SEAM(pb + 7);
        if (PH_EN(8) && IN(pb + 8)) f_gather(KA(), tid, l); SEAM(pb + 8);
        if (PH_EN(9) && IN(pb + 9)) f_moe_gu(KA(), tid, l); SEAM(pb + 9);
        if (PH_EN(10) && IN(pb + 10)) f_moe_down(KA(), tid, l); SEAM(pb + 10);
    }
    if (IN(NPHASES - 1)) f_final(KA(), tid);
#undef IN
#undef SEAM
}

extern "C" void kernel_launch(void* const* d_in, const int* in_sizes, int n_in, void* d_out, int out_size, void* d_ws, size_t ws_size, hipStream_t stream) {
    static int grid = 0;
    if (grid == 0) {
        if (n_in != 23 || out_size != NTOK * DM || ws_size < WS_END) { fprintf(stderr, "kernel_launch: unexpected shapes (n_in %d out %d ws %zu)\n", n_in, out_size, ws_size); grid = -1; return; }
        int dev = 0, cus = 0, per_cu = 0;
        if (hipGetDevice(&dev) != hipSuccess || hipDeviceGetAttribute(&cus, hipDeviceAttributeMultiprocessorCount, dev) != hipSuccess) { grid = -1; return; }
        if (hipFuncSetAttribute((const void*)mk_fwd, hipFuncAttributeMaxDynamicSharedMemorySize, LDS_BYTES) != hipSuccess) { fprintf(stderr, "kernel_launch: hipFuncSetAttribute failed\n"); grid = -1; return; }
        if (hipOccupancyMaxActiveBlocksPerMultiprocessor(&per_cu, (const void*)mk_fwd, NTHR, LDS_BYTES) != hipSuccess || per_cu < 1) { fprintf(stderr, "kernel_launch: occupancy query says %d\n", per_cu); (void)hipGetLastError(); grid = -1; return; }
        grid = cus;
    }
    if (grid < 0) return;
    (void)hipMemsetAsync((char*)d_ws + WS_CTL, 0, CTL_ZERO_BYTES, stream);
    Args a{};
    for (int i = 0; i < 23; ++i) a.in[i] = (const float*)d_in[i];
    a.out = (float*)d_out; a.ws = (unsigned char*)d_ws;
#if MK_ONE_LAUNCH
    a.ph_lo = 0; a.ph_hi = NPHASES;
    hipLaunchKernelGGL(mk_fwd, dim3(grid), dim3(NTHR), LDS_BYTES, stream, a);
#else
    for (int p = 0; p < NPHASES; ++p) { a.ph_lo = p; a.ph_hi = p + 1; hipLaunchKernelGGL(mk_fwd, dim3(grid), dim3(NTHR), LDS_BYTES, stream, a); }
#endif
}
```

```cpp
#include <hip/hip_runtime.h>
#include <cstdio>
#include <cstdint>
#ifndef MK_ONE_LAUNCH
#define MK_ONE_LAUNCH 1
#endif
#ifndef MK_PROBE_A
#define MK_PROBE_A -1
#endif
#ifndef MK_PROBE_B
#define MK_PROBE_B -1
#endif
namespace pg8 {
#define PG8_LAS __attribute__((address_space(3)))
typedef unsigned short bf16_t;
typedef short bf16x8 __attribute__((ext_vector_type(8)));
typedef float f32x4 __attribute__((ext_vector_type(4)));
typedef unsigned u32x4 __attribute__((ext_vector_type(4)));
constexpr int BM = 256, BK = 64, HALF = 128, HTB = HALF * BK * 2  , STAGE_BYTES = 8 * HTB, NXCD = 8, WGM = 8;

__host__ __device__ __forceinline__ int lds_byte(int r, int c) { const int st = (r >> 4) * 2 + (c >> 5), rr = r & 15, cc = c & 31, ob = rr * 64 + cc * 2; return st * 1024 + (ob ^ (((ob >> 9) & 1) << 5)); }
__host__ __device__ __forceinline__ void stage_rc(int b, int& R, int& C) { const int st = b / 1024, sb = b % 1024, swz = sb ^ (((sb >> 9) & 1) << 5); R = (st >> 1) * 16 + swz / 64; C = (st & 1) * 32 + (swz % 64) / 2; }
__host__ __device__ __forceinline__ int perm32(int rho) { const int n = rho >> 4, i = rho & 15; return 8 * (i >> 2) + 4 * n + (i & 3); }

struct Unit { int pm, pn; };
struct Gemm { const bf16_t* A; const bf16_t* Bt; int M, N, K; };

struct StaticOrder {
    int nM, nN, nwg, G, c;
    __host__ __device__ void init(int M, int N, int G_, int c_) { nM = M / BM; nN = N / BM; nwg = nM * nN; G = G_; c = c_; }
    __host__ __device__ bool next(int i, Unit& u) const {
        const long L = (long)i * G + c; if (L >= nwg) return false;
        int wgid = (int)L; { const int q = nwg / NXCD, r = nwg % NXCD, xcd = wgid % NXCD, off = wgid / NXCD; wgid = (xcd < r ? xcd * (q + 1) : r * (q + 1) + (xcd - r) * q) + off; }
        const int nig = WGM * nN, gid = wgid / nig, fm = gid * WGM, gsz = (nM - fm) < WGM ? (nM - fm) : WGM;
        u.pm = fm + ((wgid % nig) % gsz); u.pn = (wgid % nig) / gsz; return true;
    }
    __device__ __forceinline__ void a_ready(const Unit&) const {}
    __device__ __forceinline__ void done(const Unit&) const {}
};

__device__ __forceinline__ unsigned cvt_pk_bf16(float lo, float hi) { unsigned r; asm volatile("v_cvt_pk_bf16_f32 %0, %1, %2" : "=v"(r) : "v"(lo), "v"(hi)); return r; }
typedef float f32x2 __attribute__((ext_vector_type(2)));
template <class Epi, class Sched, bool ALIGN_EPI = false, bool SP2 = false>
__device__ __forceinline__ void gemm_phase(PG8_LAS unsigned char* lds, const Gemm g, const Sched& S, const Epi& E, const int tid_in) {
    const int tid = tid_in, wid = __builtin_amdgcn_readfirstlane(tid >> 6), lane = tid & 63, wr = wid >> 2, wc = wid & 3, fr = lane & 15, fq = lane >> 4;
    const int K = g.K, nt = K / BK;
    unsigned voffA[2], voffB[2];
#pragma unroll
    for (int i = 0; i < 2; ++i) { int R, C; stage_rc(tid * 16 + i * 8192, R, C); const int Rb = Epi::PERM ? ((R & ~31) + perm32(R & 31)) : R;
        voffA[i] = (unsigned)(R * K + C) * 2u; voffB[i] = (unsigned)(Rb * K + C) * 2u; }
    const size_t kstep = (size_t)(BK * 2);
    const size_t hstep = (size_t)HALF * K * 2;
    const size_t tstep = 2 * hstep;
    const unsigned ldsw = (unsigned)wid * 1024u;
    const int aoff = lds_byte(wr * 64 + fr, fq * 8), boff = lds_byte(wc * 32 + fr, fq * 8);
#define PG8_SA(b, h) (((b) * 2 + (h)) * HTB)
#define PG8_SB(b, h) ((4 + (b) * 2 + (h)) * HTB)
#define PG8_STAGE(bufoff, gbase, voff) do { _Pragma("unroll") for (int _i = 0; _i < 2; ++_i) \
        __builtin_amdgcn_global_load_lds((const unsigned*)((const char*)(gbase) + (voff)[_i]), (PG8_LAS unsigned*)(lds + (bufoff) + ldsw + _i * 8192), 16, 0, 0); } while (0)
#define PG8_LDA(dst, b, h) do { _Pragma("unroll") for (int m = 0; m < 4; ++m) _Pragma("unroll") for (int k = 0; k < 2; ++k) dst[m][k] = *(const PG8_LAS bf16x8*)(lds + PG8_SA(b, h) + aoff + m * 2048 + k * 1024); } while (0)
#define PG8_LDB(dst, b, h) do { _Pragma("unroll") for (int n = 0; n < 2; ++n) _Pragma("unroll") for (int k = 0; k < 2; ++k) dst[n][k] = *(const PG8_LAS bf16x8*)(lds + PG8_SB(b, h) + boff + n * 2048 + k * 1024); } while (0)
#define PG8_MMA(ai, bj, At, Bt) do { __builtin_amdgcn_s_setprio(1); _Pragma("unroll") for (int m = 0; m < 4; ++m) _Pragma("unroll") for (int n = 0; n < 2; ++n) _Pragma("unroll") for (int k = 0; k < 2; ++k) \
        acc[ai][bj][m][n] = __builtin_amdgcn_mfma_f32_16x16x32_bf16(Bt[n][k], At[m][k], acc[ai][bj][m][n], 0, 0, 0); __builtin_amdgcn_s_setprio(0); } while (0)
#define PG8_WAIT_V(n) asm volatile("s_waitcnt vmcnt(" #n ")" ::: "memory")
#define PG8_WAIT_L(n) asm volatile("s_waitcnt lgkmcnt(" #n ")" ::: "memory")
#define PG8_BAR __builtin_amdgcn_s_barrier()
#define PG8_SCHED __builtin_amdgcn_sched_barrier(0)
    Unit cur, nxt; int ui = 0;
    if (!S.next(0, cur)) return;
    f32x4 acc[2][2][4][2];
    float zf_ = 0.f; asm volatile("" : "+v"(zf_));
#pragma unroll
    for (int a = 0; a < 2; ++a)
#pragma unroll
        for (int b = 0; b < 2; ++b)
#pragma unroll
            for (int m = 0; m < 4; ++m)
#pragma unroll
                for (int n = 0; n < 2; ++n) acc[a][b][m][n] = (f32x4){zf_, zf_, zf_, zf_};
    bf16x8 At[4][2], B0[2][2], B1[2][2];
    const char* cA = (const char*)g.A + (size_t)cur.pm * tstep; const char* cB = (const char*)g.Bt + (size_t)cur.pn * tstep;
    S.a_ready(cur);
    if constexpr (SP2) {
        PG8_STAGE(PG8_SB(0, 0), cB, voffB); PG8_STAGE(PG8_SB(0, 1), cB + hstep, voffB); PG8_STAGE(PG8_SA(0, 0), cA, voffA); PG8_STAGE(PG8_SA(0, 1), cA + hstep, voffA);
        if (wr == 1) PG8_BAR;
        PG8_WAIT_V(2); PG8_BAR;
        PG8_STAGE(PG8_SB(1, 0), cB + kstep, voffB); PG8_STAGE(PG8_SA(1, 0), cA + kstep, voffA); PG8_STAGE(PG8_SB(1, 1), cB + hstep + kstep, voffB);
        PG8_WAIT_V(6); PG8_BAR;
    } else {
        PG8_STAGE(PG8_SB(0, 0), cB, voffB); PG8_STAGE(PG8_SA(0, 0), cA, voffA); PG8_STAGE(PG8_SB(0, 1), cB + hstep, voffB); PG8_STAGE(PG8_SA(0, 1), cA + hstep, voffA);
        if (wr == 1) PG8_BAR;
        PG8_WAIT_V(4); PG8_BAR;
        PG8_STAGE(PG8_SB(1, 0), cB + kstep, voffB); PG8_STAGE(PG8_SA(1, 0), cA + kstep, voffA); PG8_STAGE(PG8_SB(1, 1), cB + hstep + kstep, voffB);
        PG8_WAIT_V(6); PG8_BAR;
    }
    for (;;) {
        const bool has_next = S.next(ui + 1, nxt);
        const char* nA = has_next ? (const char*)g.A + (size_t)nxt.pm * tstep : cA; const char* nB = has_next ? (const char*)g.Bt + (size_t)nxt.pn * tstep : cB;
        for (int t = 0; t < nt; t += 2) {
            const bool last = (t == nt - 2);
            const char* a1 = cA + (size_t)(t + 1) * kstep;
            const char* a2 = last ? nA : cA + (size_t)(t + 2) * kstep; const char* b2 = last ? nB : cB + (size_t)(t + 2) * kstep;
            const char* a3 = a2 + kstep; const char* b3 = b2 + kstep;
            if (last && has_next) S.a_ready(nxt);
            if constexpr (SP2) {
            PG8_LDB(B0, 0, 0); PG8_LDB(B1, 0, 1); PG8_SCHED; PG8_LDA(At, 0, 0); PG8_STAGE(PG8_SA(1, 1), a1 + hstep, voffA);
            PG8_WAIT_V(8); PG8_WAIT_L(0); PG8_BAR; PG8_MMA(0, 0, At, B0); PG8_MMA(0, 1, At, B1); PG8_BAR; PG8_SCHED;
            PG8_LDA(At, 0, 1); PG8_STAGE(PG8_SB(0, 0), b2, voffB); PG8_STAGE(PG8_SB(0, 1), b2 + hstep, voffB); PG8_STAGE(PG8_SA(0, 0), a2, voffA);
            PG8_WAIT_V(8); PG8_WAIT_L(0); PG8_BAR; PG8_MMA(1, 0, At, B0); PG8_MMA(1, 1, At, B1); PG8_BAR; PG8_SCHED;
            PG8_LDB(B0, 1, 0); PG8_LDB(B1, 1, 1); PG8_SCHED; PG8_LDA(At, 1, 0); PG8_STAGE(PG8_SA(0, 1), a2 + hstep, voffA);
            PG8_WAIT_V(8); PG8_WAIT_L(0); PG8_BAR; PG8_MMA(0, 0, At, B0); PG8_MMA(0, 1, At, B1); PG8_BAR; PG8_SCHED;
            PG8_LDA(At, 1, 1); PG8_STAGE(PG8_SB(1, 0), b3, voffB); PG8_STAGE(PG8_SB(1, 1), b3 + hstep, voffB); PG8_STAGE(PG8_SA(1, 0), a3, voffA);
            PG8_WAIT_V(8); PG8_WAIT_L(0); PG8_BAR; PG8_MMA(1, 0, At, B0); PG8_MMA(1, 1, At, B1); PG8_BAR; PG8_SCHED;
            } else {
            PG8_LDB(B0, 0, 0); PG8_SCHED; PG8_LDA(At, 0, 0); PG8_STAGE(PG8_SA(1, 1), a1 + hstep, voffA);
            PG8_WAIT_L(8); PG8_BAR; PG8_WAIT_L(0); PG8_MMA(0, 0, At, B0); PG8_BAR; PG8_SCHED;
            PG8_LDB(B1, 0, 1); PG8_STAGE(PG8_SB(0, 0), b2, voffB);
            PG8_BAR; PG8_WAIT_L(0); PG8_MMA(0, 1, At, B1); PG8_BAR;
            PG8_LDA(At, 0, 1); PG8_STAGE(PG8_SA(0, 0), a2, voffA);
            PG8_BAR; PG8_WAIT_L(0); PG8_MMA(1, 0, At, B0); PG8_BAR; PG8_SCHED;
            PG8_STAGE(PG8_SB(0, 1), b2 + hstep, voffB);
            PG8_WAIT_V(6); PG8_BAR; PG8_MMA(1, 1, At, B1); PG8_BAR;
            PG8_LDB(B0, 1, 0); PG8_SCHED; PG8_LDA(At, 1, 0); PG8_STAGE(PG8_SA(0, 1), a2 + hstep, voffA);
            PG8_WAIT_L(8); PG8_BAR; PG8_WAIT_L(0); PG8_MMA(0, 0, At, B0); PG8_BAR; PG8_SCHED;
            PG8_LDB(B1, 1, 1); PG8_STAGE(PG8_SB(1, 0), b3, voffB);
            PG8_BAR; PG8_WAIT_L(0); PG8_MMA(0, 1, At, B1); PG8_BAR;
            PG8_LDA(At, 1, 1); PG8_STAGE(PG8_SA(1, 0), a3, voffA);
            PG8_BAR; PG8_WAIT_L(0); PG8_MMA(1, 0, At, B0); PG8_BAR; PG8_SCHED;
            PG8_STAGE(PG8_SB(1, 1), b3 + hstep, voffB);
            PG8_WAIT_V(6); PG8_BAR; PG8_MMA(1, 1, At, B1); PG8_BAR;
            }
        }
        if constexpr (ALIGN_EPI) { if (wr == 0) PG8_BAR; }
        if constexpr (!Epi::AFTER_DRAIN) { int te_ = tid_in; asm volatile("" : "+v"(te_)); E(acc, cur, wr, wc, te_ & 15, (te_ & 63) >> 4); S.done(cur); }
        if (!has_next) break;
        zf_ = 0.f; asm volatile("" : "+v"(zf_));
#pragma unroll
        for (int a = 0; a < 2; ++a)
#pragma unroll
            for (int b = 0; b < 2; ++b)
#pragma unroll
                for (int m = 0; m < 4; ++m)
#pragma unroll
                    for (int n = 0; n < 2; ++n) acc[a][b][m][n] = (f32x4){zf_, zf_, zf_, zf_};
        cur = nxt; cA = nA; cB = nB; ++ui;
        if constexpr (ALIGN_EPI) { if (wr == 1) PG8_BAR; }
    }
    PG8_WAIT_V(0);
    if constexpr (!ALIGN_EPI) { if (wr == 0) PG8_BAR; }
    PG8_BAR;
    if constexpr (Epi::AFTER_DRAIN) { E.fused(acc, cur, wr, wc, fr, fq, lds, wid, lane); S.done(cur); }
#undef PG8_SA
#undef PG8_SB
#undef PG8_STAGE
#undef PG8_LDA
#undef PG8_LDB
#undef PG8_MMA
#undef PG8_WAIT_V
#undef PG8_WAIT_L
#undef PG8_BAR
#undef PG8_SCHED
}
}
constexpr int NW = 8, NTHR = 512;
constexpr int DM = 1024, NB = 4, SEQ = 4096, NTOK = NB * SEQ, NLAYER = 2;
constexpr int HA = 8, HDA = 64, WA = 512, MBLK = 256, NBLK = SEQ / MBLK;
constexpr int HB = 4, HDB = 128, WB = 512, CONVK = 4, DNC = 64, NCH = SEQ / DNC;
constexpr int NGRP = 4, EPG = 8, NEXP = 32, DFF = 256;
constexpr int DIN = 5640, DINP = 5632, NMOD = 6;
constexpr int C_QKVA = 0, C_QKVB = 1536, C_ZB = 3072, C_BA = 3584, C_GATE = 3592;
constexpr float EPS = 1e-6f;
constexpr int MOE_MAXROWS = 2 * NTOK + NEXP * 256;
constexpr int MOE_MAXTILES = MOE_MAXROWS / 256;

constexpr size_t MiB = 1u << 20;
constexpr size_t WS_CTL = 0, CTL_ZERO_BYTES = 1 * MiB;
constexpr size_t WS_MOD = 1 * MiB;
constexpr size_t WS_WIN = 2 * MiB;
constexpr size_t WS_WUPA = 13 * MiB, WS_WUPB = 14 * MiB;
constexpr size_t WS_WOUT = 15 * MiB;
constexpr size_t WS_WEGU = 17 * MiB;
constexpr size_t WS_WED = 49 * MiB;
constexpr size_t WS_SMALL = 65 * MiB;
constexpr size_t WS_KMEAN = WS_SMALL;
constexpr size_t WS_BETA = WS_SMALL + 256 * 1024;
constexpr size_t WS_GLOG = WS_SMALL + 512 * 1024;
constexpr size_t WS_TOKINFO = WS_SMALL + 1 * MiB;
constexpr size_t WS_ROWTOK = WS_SMALL + 2 * MiB;
constexpr size_t WS_ROWW = WS_SMALL + 3 * MiB;
constexpr size_t WS_GL = WS_SMALL + 4 * MiB;
constexpr size_t WS_SSQ = WS_SMALL + 5 * MiB;
constexpr size_t WS_H = 72 * MiB;
constexpr size_t WS_QKVA = 104 * MiB;
constexpr size_t WS_QKVB = 152 * MiB;
constexpr size_t WS_ZB = 200 * MiB;
constexpr size_t WS_GATES = 216 * MiB;
constexpr size_t WS_IMG = 280 * MiB;
constexpr size_t WS_YA = 72 * MiB, WS_YB = 336 * MiB;
constexpr size_t WS_END = 352 * MiB;
constexpr size_t WS_M = WS_QKVB;
constexpr size_t WS_U = 88 * MiB;
constexpr size_t WS_HS = WS_QKVA;
constexpr size_t WS_ACT = 184 * MiB;
constexpr size_t WS_YS = WS_GATES;
constexpr int CW_TMO = 0;
constexpr int CW_BAR = 4096;
constexpr int CW_GCNT = 8192;
constexpr int CW_CCTR = 8448;
constexpr int CW_ACTR = 8320;

constexpr int RING_BYTES = 131072;
constexpr int MISC_OFF = 147456;
constexpr int LDS_BYTES = 151552;

#define GAS __attribute__((address_space(1)))
#define LAS __attribute__((address_space(3)))
typedef unsigned short bf16;
typedef unsigned v4u __attribute__((ext_vector_type(4)));
typedef unsigned v2u __attribute__((ext_vector_type(2)));
typedef float f32x4 __attribute__((ext_vector_type(4)));
typedef float f32x16 __attribute__((ext_vector_type(16)));
typedef short bf16x8 __attribute__((ext_vector_type(8)));
typedef GAS unsigned gu32;
#define RLX_AGENT __ATOMIC_RELAXED, __HIP_MEMORY_SCOPE_AGENT
#define LDS_WAIT() asm volatile("s_waitcnt lgkmcnt(0)" ::: "memory")
#define VM_WAIT() asm volatile("s_waitcnt vmcnt(0)" ::: "memory")
__device__ __forceinline__ unsigned f2bf(float f) { unsigned u = __builtin_bit_cast(unsigned, f); return (u + 0x7fffu + ((u >> 16) & 1u)) >> 16; }
__device__ __forceinline__ unsigned pk2(float lo, float hi) { return f2bf(lo) | (f2bf(hi) << 16); }
__device__ __forceinline__ float bf2f(unsigned b) { return __builtin_bit_cast(float, b << 16); }
__device__ __forceinline__ float bflo(unsigned w) { return __builtin_bit_cast(float, w << 16); }
__device__ __forceinline__ float bfhi(unsigned w) { return __builtin_bit_cast(float, w & 0xffff0000u); }
__device__ __forceinline__ float rcpf_(float x) { return __builtin_amdgcn_rcpf(x); }
__device__ __forceinline__ float sigmoidf_(float x) { return rcpf_(1.f + __builtin_amdgcn_exp2f(-1.4426950408889634f * x)); }
__device__ __forceinline__ float siluf_(float x) { return x * rcpf_(1.f + __builtin_amdgcn_exp2f(-1.4426950408889634f * x)); }
__device__ __forceinline__ float shx(float v, int o, int lane) { return __builtin_bit_cast(float, __builtin_amdgcn_ds_bpermute((lane ^ o) << 2, __builtin_bit_cast(int, v))); }
__device__ __forceinline__ float shidx(float v, int src) { return __builtin_bit_cast(float, __builtin_amdgcn_ds_bpermute(src << 2, __builtin_bit_cast(int, v))); }
__device__ __forceinline__ int shidx_i(int v, int src) { return __builtin_amdgcn_ds_bpermute(src << 2, v); }
template <int CTRL> __device__ __forceinline__ float dpp_f(float v) { return __builtin_bit_cast(float, __builtin_amdgcn_update_dpp(0, __builtin_bit_cast(int, v), CTRL, 0xf, 0xf, true)); }
__device__ __forceinline__ float rdlane_f(float v, int l) { return __builtin_bit_cast(float, __builtin_amdgcn_readlane(__builtin_bit_cast(int, v), l)); }
__device__ __forceinline__ float wave_sum(float v, int) {
    v += dpp_f<0xB1>(v); v += dpp_f<0x4E>(v); v += dpp_f<0x141>(v); v += dpp_f<0x140>(v);
    return (rdlane_f(v, 0) + rdlane_f(v, 16)) + (rdlane_f(v, 32) + rdlane_f(v, 48));
}
__device__ __forceinline__ float wave_max(float v, int) {
    v = fmaxf(v, dpp_f<0xB1>(v)); v = fmaxf(v, dpp_f<0x4E>(v)); v = fmaxf(v, dpp_f<0x141>(v)); v = fmaxf(v, dpp_f<0x140>(v));
    return fmaxf(fmaxf(rdlane_f(v, 0), rdlane_f(v, 16)), fmaxf(rdlane_f(v, 32), rdlane_f(v, 48)));
}
__device__ const unsigned char T5B[128] = {0, 1, 2, 3, 4, 5, 6, 7, 8, 9, 10, 11, 12, 13, 14, 15, 16, 16, 16, 17, 17, 18, 18, 18, 19, 19, 19, 20, 20, 20, 20, 21, 21, 21, 21, 22, 22, 22, 22, 22, 23, 23, 23, 23, 23, 23, 24, 24, 24, 24, 24, 24, 25, 25, 25, 25, 25, 25, 25, 26, 26, 26, 26, 26, 26, 26, 26, 27, 27, 27, 27, 27, 27, 27, 27, 27, 27, 28, 28, 28, 28, 28, 28, 28, 28, 28, 28, 29, 29, 29, 29, 29, 29, 29, 29, 29, 29, 29, 29, 30, 30, 30, 30, 30, 30, 30, 30, 30, 30, 30, 30, 30, 30, 31, 31, 31, 31, 31, 31, 31, 31, 31, 31, 31, 31, 31, 31, 31};

#define XB_TMO      128
#define XB_XCNT(j)  (256  + 64 * (j))
#define XB_XSUB(j)  (1280 + 64 * (j))
#define XB_XGEN(j)  (2304 + 64 * (j))
#define XB_TOP      3328
#define XB_TOPGEN   3392
#define XCD_BAR_WORDS 3456
#define XB_SPIN_CAP (1u << 18)

__device__ __forceinline__ unsigned xb_ld(unsigned* p)              { return __hip_atomic_load(p, __ATOMIC_RELAXED, __HIP_MEMORY_SCOPE_AGENT); }
__device__ __forceinline__ unsigned xb_add(unsigned* p, unsigned v) { return __hip_atomic_fetch_add(p, v, __ATOMIC_RELAXED, __HIP_MEMORY_SCOPE_AGENT); }
__device__ __forceinline__ unsigned xb_xcc_id() { return (unsigned)__builtin_amdgcn_s_getreg((3 << 11) | 20) & 0xFu; }
#define XB_SPIN(cond, bar) do { unsigned _sp = 0; while (cond) { __builtin_amdgcn_s_sleep(1); \
    if ((++_sp & 255u) == 0u) { if (xb_ld(&(bar)[XB_TMO])) break; if (_sp > XB_SPIN_CAP) { atomicAdd(&(bar)[XB_TMO], 1u); break; } } } } while (0)

struct XcdBarrier {
    unsigned* bar; unsigned x;
    volatile LAS unsigned* st;
};

__device__ __forceinline__ XcdBarrier xcd_barrier_post(unsigned* bar, volatile LAS unsigned* st, const int tid_in) {
    XcdBarrier b; b.bar = bar; b.x = xb_xcc_id(); b.st = st;
    if (tid_in == 0) (void)xb_add(&bar[XB_XCNT(b.x)], 1u);
    return b;
}
__device__ __forceinline__ void xcd_barrier_complete(unsigned* bar, unsigned x, unsigned& nloc, unsigned& nx) {
    const unsigned G = gridDim.x * gridDim.y * gridDim.z;
    unsigned sum, cnt, mine, sp = 0u;
    for (;;) {
        sum = 0u; cnt = 0u; mine = 0u;
#pragma unroll
        for (unsigned j = 0; j < 16; ++j) { const unsigned c = xb_ld(&bar[XB_XCNT(j)]); sum += c; cnt += (c > 0u) ? 1u : 0u; mine = (j == x) ? c : mine; }
        if (sum == G) break;
        __builtin_amdgcn_s_sleep(1);
        if ((++sp & 255u) == 0u) { if (xb_ld(&bar[XB_TMO])) break; if (sp > XB_SPIN_CAP) { atomicAdd(&bar[XB_TMO], 1u); break; } }
    }
    nloc = mine > 0u ? mine : 1u; nx = cnt > 0u ? cnt : 1u;
}

__device__ __forceinline__ void xcd_barrier(const XcdBarrier& b, const int tid_in) {
    asm volatile("s_waitcnt vmcnt(0)" ::: "memory");
    __syncthreads();
    if (tid_in == 0) {
        unsigned* bar = b.bar;
        __builtin_amdgcn_s_waitcnt(0);
        unsigned nloc = b.st[0], nx = b.st[1];
        if (nloc == 0u) { xcd_barrier_complete(bar, b.x, nloc, nx); b.st[0] = nloc; b.st[1] = nx; }
        const unsigned old = xb_add(&bar[XB_XSUB(b.x)], 1u);
        const unsigned gen = old / nloc;
        if (old + 1u == (gen + 1u) * nloc) {
            __builtin_amdgcn_fence(__ATOMIC_RELEASE, "agent");
            asm volatile("s_waitcnt vmcnt(0)" ::: "memory");
            const unsigned og = xb_add(&bar[XB_TOP], 1u);
            const unsigned tg = og / nx;
            if (og + 1u == (tg + 1u) * nx) xb_add(&bar[XB_TOPGEN], 1u);
            else XB_SPIN(xb_ld(&bar[XB_TOPGEN]) == tg, bar);
            __builtin_amdgcn_fence(__ATOMIC_ACQUIRE, "agent");
            xb_add(&bar[XB_XGEN(b.x)], 1u);
            asm volatile("s_waitcnt vmcnt(0)" ::: "memory");
        } else {
            XB_SPIN(xb_ld(&bar[XB_XGEN(b.x)]) == gen, bar);
            __builtin_amdgcn_fence(__ATOMIC_ACQUIRE, "agent");
            asm volatile("s_waitcnt vmcnt(0)" ::: "memory");
        }
    }
    __syncthreads();
}
struct Args { const float* in[23]; float* out; unsigned char* ws; int ph_lo, ph_hi; };
enum { I_X = 0, I_C, I_RELB, I_FNW, I_N1W, I_N2W, I_WMOD, I_BMOD, I_WIN, I_CONVW, I_ALOG, I_DTB, I_ONW, I_WUPA, I_WUPB, I_WOUT, I_WRG, I_BRG, I_WRE, I_BRE, I_WEG, I_WEU, I_WED };

typedef const Args __attribute__((address_space(4)))* KArgs;
struct Ctx { LAS unsigned char* lds; int tid, lane, wave, bid, G; };
extern __shared__ __attribute__((aligned(16))) unsigned char lds_raw[];
__device__ __forceinline__ Ctx make_ctx(int& tid) { Ctx c; c.lds = (LAS unsigned char*)lds_raw; asm volatile("" : "+v"(tid)); const int t = tid; c.tid = t; c.lane = t & 63; c.wave = __builtin_amdgcn_readfirstlane(t >> 6); int bi = blockIdx.x, gd = gridDim.x; asm volatile("" : "+s"(bi), "+s"(gd)); c.bid = bi; c.G = gd; return c; }

__device__ __forceinline__ void ph_mod(KArgs a, const Ctx& c) {
    LAS float* cact = (LAS float*)c.lds;
    LAS float* red = (LAS float*)(c.lds + 16384);
    const float* cin = a->in[I_C];
    for (int i = c.tid; i < 4096; i += NTHR) cact[i] = siluf_(cin[i]);
    __syncthreads();
    float* mod = (float*)(a->ws + WS_MOD);
    for (int item = c.bid; item < 192; item += c.G) {
        const int l = item / 96, j0 = (item % 96) * 64;
        const float* W = a->in[I_WMOD] + (size_t)l * 1024 * 6144 + j0 + c.lane;
        float a0 = 0.f, a1 = 0.f, a2 = 0.f, a3 = 0.f;
        const int k0 = c.wave * 128;
#pragma unroll 8
        for (int k = k0; k < k0 + 128; ++k) { const float w = W[(size_t)k * 6144]; a0 += cact[k] * w; a1 += cact[1024 + k] * w; a2 += cact[2048 + k] * w; a3 += cact[3072 + k] * w; }
        red[(c.wave * 4 + 0) * 64 + c.lane] = a0; red[(c.wave * 4 + 1) * 64 + c.lane] = a1; red[(c.wave * 4 + 2) * 64 + c.lane] = a2; red[(c.wave * 4 + 3) * 64 + c.lane] = a3;
        __syncthreads();
        if (c.tid < 256) { const int b = c.tid >> 6, ln = c.tid & 63; float s = 0.f;
#pragma unroll
            for (int w = 0; w < 8; ++w) s += red[(w * 4 + b) * 64 + ln];
            mod[(l * 4 + b) * 6144 + j0 + ln] = s + a->in[I_BMOD][l * 6144 + j0 + ln]; }
        __syncthreads();
    }
}

__device__ __forceinline__ void tr_item(const float* src, int ld, bf16* dst, int K, int nblk, LAS float* scr, int item, int lane) {
    const int kb = item / nblk, nb = item % nblk, k0 = 64 * kb, n0 = 32 * nb;
    float tv[32];
    const unsigned voff = (unsigned)((lane >> 5) * ld + (lane & 31));
#pragma unroll
    for (int i = 0; i < 32; ++i) { const float* rowp = src + (size_t)(k0 + 2 * i) * ld + n0; tv[i] = rowp[voff]; }
#pragma unroll
    for (int i = 0; i < 32; ++i) scr[(2 * i + (lane >> 5)) * 33 + (lane & 31)] = tv[i];
    LDS_WAIT(); asm volatile("" ::: "memory");
    const int cc = lane & 7;
#pragma unroll
    for (int j = 0; j < 4; ++j) { const int n = (lane >> 3) + 8 * j; const LAS float* s = scr + (8 * cc) * 33 + n;
        v4u o; o.x = pk2(s[0 * 33], s[1 * 33]); o.y = pk2(s[2 * 33], s[3 * 33]); o.z = pk2(s[4 * 33], s[5 * 33]); o.w = pk2(s[6 * 33], s[7 * 33]);
        *(v4u*)(dst + (size_t)(n0 + n) * K + k0 + 8 * cc) = o; }
    LDS_WAIT(); asm volatile("" ::: "memory");
}
constexpr int CV_I0 = 1792, CV_I1 = 1024, CV_I2 = 256, CV_I3 = 256, CV_I4 = 512, CV_I5 = 4096, CV_I6 = 4096, CV_I7 = 4096;
constexpr int CV_NIT = CV_I0 + CV_I1 + CV_I2 + CV_I3 + CV_I4 + CV_I5 + CV_I6 + CV_I7, CV_EARLY = CV_I0 + CV_I1;
__device__ __forceinline__ void convert_item(KArgs a, int l, int it, LAS float* scr, int lane) {
    bf16* WIN = (bf16*)(a->ws + WS_WIN); bf16* WEGU = (bf16*)(a->ws + WS_WEGU); bf16* WEDT = (bf16*)(a->ws + WS_WED);
    const float* win = a->in[I_WIN] + (size_t)l * 1024 * DIN;
    int r = it;
    if (r < CV_I0) { tr_item(win, DIN, WIN, 1024, 112, scr, r, lane); return; } r -= CV_I0;
    if (r < CV_I1) { tr_item(win + C_GATE, DIN, WIN + (size_t)C_BA * 1024, 1024, 64, scr, r, lane); return; } r -= CV_I1;
    if (r < CV_I2) { tr_item(a->in[I_WUPA] + (size_t)l * 512 * 1024, 1024, (bf16*)(a->ws + WS_WUPA), 512, 32, scr, r, lane); return; } r -= CV_I2;
    if (r < CV_I3) { tr_item(a->in[I_WUPB] + (size_t)l * 512 * 1024, 1024, (bf16*)(a->ws + WS_WUPB), 512, 32, scr, r, lane); return; } r -= CV_I3;
    if (r < CV_I4) { tr_item(a->in[I_WOUT] + (size_t)l * 1024 * 1024, 1024, (bf16*)(a->ws + WS_WOUT), 1024, 32, scr, r, lane); return; } r -= CV_I4;
    if (r < CV_I5) { const int E = r >> 7, rem = r & 127, pn = rem >> 6, q = rem & 63;
        tr_item(a->in[I_WEG] + ((size_t)(l * 32 + E) * 1024 * 256) + 128 * pn, 256, WEGU + (size_t)(E * 512 + 256 * pn) * 1024, 1024, 4, scr, q, lane); return; } r -= CV_I5;
    if (r < CV_I6) { const int E = r >> 7, rem = r & 127, pn = rem >> 6, q = rem & 63;
        tr_item(a->in[I_WEU] + ((size_t)(l * 32 + E) * 1024 * 256) + 128 * pn, 256, WEGU + (size_t)(E * 512 + 256 * pn + 128) * 1024, 1024, 4, scr, q, lane); return; } r -= CV_I6;
    { const int E = r >> 7, q = r & 127;
        tr_item(a->in[I_WED] + ((size_t)(l * 32 + E) * 256 * 1024), 1024, WEDT + (size_t)E * 1024 * 256, 256, 32, scr, q, lane); }
}
__device__ __forceinline__ void ph_convert(KArgs a, const Ctx& c, int l) {
    LAS float* scr = (LAS float*)(c.lds + 32768 + c.wave * 10240);
    const int gw = c.bid * NW + c.wave, NGW = c.G * NW;
    for (int it = gw; it < CV_EARLY; it += NGW) convert_item(a, l, it, scr, c.lane);
}
constexpr int CV_UNIT = 64, CV_NUNITS = (CV_NIT - CV_EARLY) / CV_UNIT;
static_assert((CV_NIT - CV_EARLY) % CV_UNIT == 0, "convert units");
constexpr int CV_EARLYQ = 112;
__device__ __forceinline__ void convert_unit(KArgs a, const Ctx& c, int l, int cu) {
    LAS float* scr = (LAS float*)(c.lds + 32768 + c.wave * 10240);
    int ln = c.lane; asm volatile("" : "+v"(ln));
#pragma unroll 1
    for (int i = 0; i < 8; ++i) convert_item(a, l, CV_EARLY + cu * CV_UNIT + c.wave * 8 + i, scr, ln);
}

__device__ __forceinline__ void load_row_x(KArgs a, int l, int m, int lane, f32x4 (&v)[4]) {
    const float* xr = (l == 0 ? a->in[I_X] : (const float*)a->out) + (size_t)m * DM;
#pragma unroll
    for (int j = 0; j < 4; ++j) v[j] = *(const f32x4*)(xr + 256 * j + 4 * lane);
    if (l > 0) {
        const int b = m >> 12;
        const float* g2 = (const float*)(a->ws + WS_MOD) + ((l - 1) * 4 + b) * 6144 + 5120;
        const bf16* ys = (const bf16*)(a->ws + WS_YS) + (size_t)m * 2048;
#pragma unroll
        for (int j = 0; j < 4; ++j) { const int col = 256 * j + 4 * lane; const v2u y0 = *(const v2u*)(ys + col), y1 = *(const v2u*)(ys + 1024 + col); const f32x4 g = *(const f32x4*)(g2 + col);
            v[j].x += g.x * (bflo(y0.x) + bflo(y1.x)); v[j].y += g.y * (bfhi(y0.x) + bfhi(y1.x)); v[j].z += g.z * (bflo(y0.y) + bflo(y1.y)); v[j].w += g.w * (bfhi(y0.y) + bfhi(y1.y)); }
        float* xo = a->out + (size_t)m * DM;
#pragma unroll
        for (int j = 0; j < 4; ++j) *(f32x4*)(xo + 256 * j + 4 * lane) = v[j];
    }
}
__device__ __forceinline__ float row_rstd(const f32x4 (&v)[4], int lane) {
    float s = 0.f;
#pragma unroll
    for (int j = 0; j < 4; ++j) s += (v[j].x * v[j].x + v[j].y * v[j].y) + (v[j].z * v[j].z + v[j].w * v[j].w);
    return __builtin_amdgcn_rsqf(wave_sum(s, lane) * (1.f / DM) + EPS);
}
__device__ __forceinline__ void ph_norm1(KArgs a, const Ctx& c, int l) {
    LAS float* wbaT = (LAS float*)c.lds;
    const float* win = a->in[I_WIN] + (size_t)l * 1024 * DIN + C_BA;
    for (int i = c.tid; i < 8192; i += NTHR) { const int k = i >> 3, cc = i & 7; wbaT[cc * 1024 + k] = win[(size_t)k * DIN + cc]; }
    __syncthreads();
    const int gw = c.bid * NW + c.wave, NGW = c.G * NW, lane = c.lane;
    bf16* H = (bf16*)(a->ws + WS_H); float* beta = (float*)(a->ws + WS_BETA); float* glog = (float*)(a->ws + WS_GLOG);
    const float* n1w = a->in[I_N1W] + l * DM;
    for (int m = gw; m < NTOK; m += NGW) {
        f32x4 v[4]; load_row_x(a, l, m, lane, v);
        const float rstd = row_rstd(v, lane);
        const int b = m >> 12; const float* mod = (const float*)(a->ws + WS_MOD) + (l * 4 + b) * 6144;
        float acc[8];
#pragma unroll
        for (int q = 0; q < 8; ++q) acc[q] = 0.f;
#pragma unroll
        for (int j = 0; j < 4; ++j) { const int col = 256 * j + 4 * lane;
            const f32x4 nw = *(const f32x4*)(n1w + col), sh = *(const f32x4*)(mod + col), sc = *(const f32x4*)(mod + 1024 + col);
            f32x4 h = v[j] * rstd * nw * (sc + 1.0f) + sh;
            v2u o; o.x = pk2(h.x, h.y); o.y = pk2(h.z, h.w); *(v2u*)(H + (size_t)m * DM + col) = o;
#pragma unroll
            for (int q = 0; q < 8; ++q) { const f32x4 w4 = *(const LAS f32x4*)(wbaT + q * 1024 + col); acc[q] += (h.x * w4.x + h.y * w4.y) + (h.z * w4.z + h.w * w4.w); } }
#pragma unroll
        for (int q = 0; q < 8; ++q) acc[q] = wave_sum(acc[q], lane);
        if (lane < 4) {
            const float bb = lane == 0 ? acc[0] : lane == 1 ? acc[1] : lane == 2 ? acc[2] : acc[3];
            const float aa = lane == 0 ? acc[4] : lane == 1 ? acc[5] : lane == 2 ? acc[6] : acc[7];
            beta[m * 4 + lane] = sigmoidf_(bb);
            const float z = aa + a->in[I_DTB][l * 4 + lane]; const float sp = fmaxf(z, 0.f) + log1pf(__expf(-fabsf(z)));
            glog[m * 4 + lane] = -__expf(a->in[I_ALOG][l * 4 + lane]) * sp;
        }
    }
}
__device__ __forceinline__ void ph_final(KArgs a, const Ctx& c) {
    const int gw = c.bid * NW + c.wave, NGW = c.G * NW, lane = c.lane;
    const float* fw = a->in[I_FNW];
    for (int m = gw; m < NTOK; m += NGW) {
        f32x4 v[4];
        {
            const float* xr = (const float*)a->out + (size_t)m * DM; const int b = m >> 12;
            const float* g2 = (const float*)(a->ws + WS_MOD) + ((NLAYER - 1) * 4 + b) * 6144 + 5120;
            const bf16* ys = (const bf16*)(a->ws + WS_YS) + (size_t)m * 2048;
#pragma unroll
            for (int j = 0; j < 4; ++j) { const int col = 256 * j + 4 * lane; v[j] = *(const f32x4*)(xr + col);
                const v2u y0 = *(const v2u*)(ys + col), y1 = *(const v2u*)(ys + 1024 + col); const f32x4 g = *(const f32x4*)(g2 + col);
                v[j].x += g.x * (bflo(y0.x) + bflo(y1.x)); v[j].y += g.y * (bfhi(y0.x) + bfhi(y1.x)); v[j].z += g.z * (bflo(y0.y) + bflo(y1.y)); v[j].w += g.w * (bfhi(y0.y) + bfhi(y1.y)); }
        }
        float rstd = row_rstd(v, lane);
#if defined(MK_PROBE_A) && MK_PROBE_A >= 0
        {   const unsigned long long* ts = (const unsigned long long*)((const unsigned*)(a->ws + WS_CTL) + 12288);
            float tA = 0.f, tB = 0.f;
            for (int ly = 0; ly < NLAYER; ++ly) { const int ka = 1 + ly * 11 + MK_PROBE_A, kb = 1 + ly * 11 + MK_PROBE_B;
                if (MK_PROBE_A < 11) tA += (float)(ts[ka + 1] - ts[ka]) * 0.01f; if (MK_PROBE_B < 11) tB += (float)(ts[kb + 1] - ts[kb]) * 0.01f; }
            if (MK_PROBE_A == 20) { tA = 0.f; for (int ly = 0; ly < NLAYER; ++ly) tA += (float)(ts[40 + ly] - ts[1 + ly * 11 + 3]) * 0.01f; }
            if (MK_PROBE_A == 21) { tA = 0.f; for (int ly = 0; ly < NLAYER; ++ly) tA += (float)(ts[44 + ly] - ts[1 + ly * 11 + 3]) * 0.01f; }
            if (MK_PROBE_A >= 22 && MK_PROBE_A <= 24) { tA = 0.f; for (int ly = 0; ly < NLAYER; ++ly) tA += (float)ts[48 + ly * 4 + MK_PROBE_A - 22] * 0.01f; }
            if (MK_PROBE_B >= 22 && MK_PROBE_B <= 24) { tB = 0.f; for (int ly = 0; ly < NLAYER; ++ly) tB += (float)ts[48 + ly * 4 + MK_PROBE_B - 22] * 0.01f; }
            if (MK_PROBE_A >= 30 && MK_PROBE_A <= 36) { tA = 0.f; for (int ly = 0; ly < NLAYER; ++ly) tA += (float)ts[56 + ly] * 0.01f; }
            if (MK_PROBE_A == 11) tA = (float)(ts[1] - ts[0]) * 0.01f; if (MK_PROBE_A == 12) tA = (float)(ts[23] - ts[0]) * 0.01f;
            if (MK_PROBE_B == 11) tB = (float)(ts[1] - ts[0]) * 0.01f; if (MK_PROBE_B == 12) tB = (float)(ts[23] - ts[0]) * 0.01f;
            (void)tB;
            if (m == 0 && lane == 0) v[0].x += tA * 0.05f / rstd / fw[0]; }
#endif
        float* xo = a->out + (size_t)m * DM;
#pragma unroll
        for (int j = 0; j < 4; ++j) { const int col = 256 * j + 4 * lane; const f32x4 w = *(const f32x4*)(fw + col); *(f32x4*)(xo + col) = v[j] * rstd * w; }
    }
}

__device__ __forceinline__ void ph_kmean(KArgs a, const Ctx& c) {
    const int gw = c.bid * NW + c.wave, NGW = c.G * NW, lane = c.lane;
    const bf16* QKVA = (const bf16*)(a->ws + WS_QKVA); float* kmean = (float*)(a->ws + WS_KMEAN);
    for (int item = gw; item < NB * HA * NBLK; item += NGW) {
        const int nb = item & 15, h = (item >> 4) & 7, b = item >> 7;
        const int sub = lane & 7, rr = lane >> 3;
        float s[8];
#pragma unroll
        for (int q = 0; q < 8; ++q) s[q] = 0.f;
        const bf16* kp = QKVA + (size_t)(b * SEQ + nb * MBLK) * 1536 + 512 + h * 64 + sub * 8;
#pragma unroll 4
        for (int it = 0; it < 32; ++it) { const v4u w = *(const v4u*)(kp + (size_t)(it * 8 + rr) * 1536);
            s[0] += bflo(w.x); s[1] += bfhi(w.x); s[2] += bflo(w.y); s[3] += bfhi(w.y); s[4] += bflo(w.z); s[5] += bfhi(w.z); s[6] += bflo(w.w); s[7] += bfhi(w.w); }
#pragma unroll
        for (int q = 0; q < 8; ++q) { s[q] += shx(s[q], 8, lane); s[q] += shx(s[q], 16, lane); s[q] += shx(s[q], 32, lane); }
        if (lane < 8) { float* o = kmean + (size_t)item * 64 + sub * 8;
            *(f32x4*)o = (f32x4){s[0], s[1], s[2], s[3]} * (1.f / 256.f); *(f32x4*)(o + 4) = (f32x4){s[4], s[5], s[6], s[7]} * (1.f / 256.f); }
    }
}

__device__ __forceinline__ void ph_attn_simple(KArgs a, const Ctx& c) {
    const int gw = c.bid * NW + c.wave, NGW = c.G * NW, lane = c.lane;
    LAS float* btab = (LAS float*)(c.lds);
    LAS float* scw = (LAS float*)(c.lds + 8192) + c.wave * 1024;
    const float* relb = a->in[I_RELB];
    for (int i = c.tid; i < 8 * 129; i += NTHR) { const int h = i / 129, d = i % 129; btab[h * 132 + d] = relb[(d < 128 ? (int)T5B[d] : 31) * 8 + h]; }
    __syncthreads();
    const bf16* QKVA = (const bf16*)(a->ws + WS_QKVA); const float* kmean = (const float*)(a->ws + WS_KMEAN); bf16* YA = (bf16*)(a->ws + WS_YA);
    for (int r = gw; r < NB * HA * SEQ; r += NGW) {
        const int s = r & (SEQ - 1), h = (r >> 12) & 7, b = r >> 15, qb = s >> 8, tok = b * SEQ + s;
        float qv[64];
        { const bf16* qp = QKVA + (size_t)tok * 1536 + h * 64;
#pragma unroll
          for (int q = 0; q < 8; ++q) { const v4u w = *(const v4u*)(qp + q * 8); qv[q * 8 + 0] = bflo(w.x); qv[q * 8 + 1] = bfhi(w.x); qv[q * 8 + 2] = bflo(w.y); qv[q * 8 + 3] = bfhi(w.y); qv[q * 8 + 4] = bflo(w.z); qv[q * 8 + 5] = bfhi(w.z); qv[q * 8 + 6] = bflo(w.w); qv[q * 8 + 7] = bfhi(w.w); } }
        float gate = -1e30f;
        if (lane < qb) { const float* km = kmean + (size_t)(((b * 8 + h) * 16) + lane) * 64; float d = 0.f;
#pragma unroll
            for (int q = 0; q < 16; ++q) { const f32x4 k4 = *(const f32x4*)(km + q * 4); d += qv[q * 4] * k4.x + qv[q * 4 + 1] * k4.y + qv[q * 4 + 2] * k4.z + qv[q * 4 + 3] * k4.w; }
            gate = d; }
        unsigned selmask = 0u;
#pragma unroll
        for (int t = 0; t < 3; ++t) { float best = -3e38f; int bi = 0;
#pragma unroll
            for (int n = 0; n < 16; ++n) { const float gv = shidx(gate, n); if (!((selmask >> n) & 1u) && gv > best) { best = gv; bi = n; } }
            selmask |= 1u << bi; }
        selmask &= (1u << qb) - 1u;
        selmask |= 1u << qb;
        int nseg = 0; float mx = -3e38f;
        for (int blk = 0; blk <= qb; ++blk) {
            if (!((selmask >> blk) & 1u)) continue;
            for (int i = 0; i < 4; ++i) { const int key = blk * 256 + i * 64 + lane; const bf16* kp = QKVA + (size_t)(b * SEQ + key) * 1536 + 512 + h * 64; float d = 0.f;
#pragma unroll
                for (int q = 0; q < 8; ++q) { const v4u w = *(const v4u*)(kp + q * 8);
                    d += qv[q * 8] * bflo(w.x) + qv[q * 8 + 1] * bfhi(w.x) + qv[q * 8 + 2] * bflo(w.y) + qv[q * 8 + 3] * bfhi(w.y) + qv[q * 8 + 4] * bflo(w.z) + qv[q * 8 + 5] * bfhi(w.z) + qv[q * 8 + 6] * bflo(w.w) + qv[q * 8 + 7] * bfhi(w.w); }
                const int dist = s - key; float sc = d * 0.125f + btab[h * 132 + (dist < 0 ? 0 : (dist > 128 ? 128 : dist))];
                if (dist < 0) sc = -3e38f;
                scw[nseg * 256 + i * 64 + lane] = sc; mx = fmaxf(mx, sc); }
            ++nseg; }
        mx = wave_max(mx, lane);
        float sum = 0.f;
        for (int idx = lane; idx < nseg * 256; idx += 64) { const float sc = scw[idx]; const float e = sc < -1e37f ? 0.f : __expf(sc - mx); scw[idx] = e; sum += e; }
        sum = wave_sum(sum, lane);
        LDS_WAIT();
        float o = 0.f; int sg = 0;
        for (int blk = 0; blk <= qb; ++blk) {
            if (!((selmask >> blk) & 1u)) continue;
            const bf16* vp = QKVA + (size_t)(b * SEQ + blk * 256) * 1536 + 1024 + h * 64 + lane;
            const int lim = (blk == qb) ? (s & 255) + 1 : 256;
#pragma unroll 8
            for (int kk = 0; kk < lim; ++kk) o += scw[sg * 256 + kk] * bf2f(vp[(size_t)kk * 1536]);
            ++sg; }
        YA[(size_t)tok * 512 + h * 64 + lane] = (bf16)f2bf(o / sum);
    }
}

template <int LDW> __device__ __forceinline__ void dn_load_chunk(KArgs a, const Ctx& c, int l, int b, int h, int t0, LAS float* qs, LAS float* ks, LAS float* vs) {
    const bf16* QKVB = (const bf16*)(a->ws + WS_QKVB); const float* cw = a->in[I_CONVW] + (size_t)l * 4 * 1536;
    const int cg = c.tid & 15, r0 = c.tid >> 4;
#pragma unroll
    for (int part = 0; part < 3; ++part) {
        const int colb = part * 512 + h * 128 + 8 * cg;
        float w[4][8];
#pragma unroll
        for (int i = 0; i < 4; ++i) { const f32x4 w0 = *(const f32x4*)(cw + i * 1536 + colb), w1 = *(const f32x4*)(cw + i * 1536 + colb + 4);
            w[i][0] = w0.x; w[i][1] = w0.y; w[i][2] = w0.z; w[i][3] = w0.w; w[i][4] = w1.x; w[i][5] = w1.y; w[i][6] = w1.z; w[i][7] = w1.w; }
        LAS float* dst = part == 0 ? qs : part == 1 ? ks : vs;
#pragma unroll
        for (int pass = 0; pass < 2; ++pass) {
            const int r = r0 + 32 * pass, t = t0 + r;
            float y[8];
#pragma unroll
            for (int e = 0; e < 8; ++e) y[e] = 0.f;
#pragma unroll
            for (int i = 0; i < 4; ++i) { const int tt = t - 3 + i; if (tt >= 0) { const v4u x = *(const v4u*)(QKVB + (size_t)(b * SEQ + tt) * 1536 + colb);
                y[0] += w[i][0] * bflo(x.x); y[1] += w[i][1] * bfhi(x.x); y[2] += w[i][2] * bflo(x.y); y[3] += w[i][3] * bfhi(x.y); y[4] += w[i][4] * bflo(x.z); y[5] += w[i][5] * bfhi(x.z); y[6] += w[i][6] * bflo(x.w); y[7] += w[i][7] * bfhi(x.w); } }
            float ss = 0.f;
#pragma unroll
            for (int e = 0; e < 8; ++e) { y[e] = siluf_(y[e]); ss += y[e] * y[e]; }
            if (part < 2) { ss += shx(ss, 1, c.lane); ss += shx(ss, 2, c.lane); ss += shx(ss, 4, c.lane); ss += shx(ss, 8, c.lane);
                const float rs = __builtin_amdgcn_rsqf(ss + EPS) * (part == 0 ? 0.08838834764831845f : 1.f);
#pragma unroll
                for (int e = 0; e < 8; ++e) y[e] *= rs; }
            *(LAS f32x4*)(dst + r * LDW + 8 * cg) = (f32x4){y[0], y[1], y[2], y[3]}; *(LAS f32x4*)(dst + r * LDW + 8 * cg + 4) = (f32x4){y[4], y[5], y[6], y[7]};
        }
    }
}
__device__ __forceinline__ void dn_store_chunk(KArgs a, const Ctx& c, int l, int b, int h, int t0, const LAS float* os) {
    const bf16* ZB = (const bf16*)(a->ws + WS_ZB); bf16* YB = (bf16*)(a->ws + WS_YB); const float* onw = a->in[I_ONW] + l * 128;
    const int r = c.tid >> 3, sub = c.tid & 7, tok = b * SEQ + t0 + r;
    float o[16]; float ss = 0.f;
#pragma unroll
    for (int q = 0; q < 4; ++q) { const f32x4 v = *(const LAS f32x4*)(os + r * 128 + sub * 16 + q * 4); o[q * 4] = v.x; o[q * 4 + 1] = v.y; o[q * 4 + 2] = v.z; o[q * 4 + 3] = v.w; ss += (v.x * v.x + v.y * v.y) + (v.z * v.z + v.w * v.w); }
    ss += shx(ss, 1, c.lane); ss += shx(ss, 2, c.lane); ss += shx(ss, 4, c.lane);
    const float rstd = __builtin_amdgcn_rsqf(ss * (1.f / 128.f) + EPS);
    const bf16* zp = ZB + (size_t)tok * 512 + h * 128 + sub * 16; bf16* yp = YB + (size_t)tok * 512 + h * 128 + sub * 16;
#pragma unroll
    for (int q = 0; q < 2; ++q) { const v4u z = *(const v4u*)(zp + q * 8); const f32x4 w0 = *(const f32x4*)(onw + sub * 16 + q * 8), w1 = *(const f32x4*)(onw + sub * 16 + q * 8 + 4);
        v4u y; y.x = pk2(o[q * 8 + 0] * rstd * w0.x * siluf_(bflo(z.x)), o[q * 8 + 1] * rstd * w0.y * siluf_(bfhi(z.x)));
        y.y = pk2(o[q * 8 + 2] * rstd * w0.z * siluf_(bflo(z.y)), o[q * 8 + 3] * rstd * w0.w * siluf_(bfhi(z.y)));
        y.z = pk2(o[q * 8 + 4] * rstd * w1.x * siluf_(bflo(z.z)), o[q * 8 + 5] * rstd * w1.y * siluf_(bfhi(z.z)));
        y.w = pk2(o[q * 8 + 6] * rstd * w1.z * siluf_(bflo(z.w)), o[q * 8 + 7] * rstd * w1.w * siluf_(bfhi(z.w)));
        *(v4u*)(yp + q * 8) = y; }
}
__device__ __forceinline__ void ph_dn_simple(KArgs a, const Ctx& c, int l) {
    LAS float* qs = (LAS float*)c.lds; LAS float* ks = qs + 8192; LAS float* vs = ks + 8192; LAS float* os = vs + 8192;
    LAS float* bt = (LAS float*)(c.lds + MISC_OFF + 1024); LAS float* at = bt + 64;
    const float* beta = (const float*)(a->ws + WS_BETA); const float* glog = (const float*)(a->ws + WS_GLOG);
    const int v = c.tid >> 2, kq = c.tid & 3;
    for (int item = c.bid; item < NB * HB; item += c.G) {
        const int b = item >> 2, h = item & 3;
        float S[32];
#pragma unroll
        for (int q = 0; q < 32; ++q) S[q] = 0.f;
        for (int n = 0; n < NCH; ++n) {
            const int t0 = n * DNC;
            __syncthreads();
            dn_load_chunk<128>(a, c, l, b, h, t0, qs, ks, vs);
            if (c.tid < 64) { const int tok = b * SEQ + t0 + c.tid; bt[c.tid] = beta[tok * 4 + h]; at[c.tid] = __expf(glog[tok * 4 + h]); }
            __syncthreads();
            for (int tt = 0; tt < DNC; ++tt) {
                const float a_t = at[tt], b_t = bt[tt];
                float kr[32];
#pragma unroll
                for (int q = 0; q < 8; ++q) { const f32x4 k4 = *(const LAS f32x4*)(ks + tt * 128 + kq * 32 + q * 4); kr[q * 4] = k4.x; kr[q * 4 + 1] = k4.y; kr[q * 4 + 2] = k4.z; kr[q * 4 + 3] = k4.w; }
                float kS = 0.f;
#pragma unroll
                for (int q = 0; q < 32; ++q) kS += kr[q] * S[q];
                kS += shx(kS, 1, c.lane); kS += shx(kS, 2, c.lane);
                const float vn = b_t * (vs[tt * 128 + v] - a_t * kS);
                float o = 0.f;
#pragma unroll
                for (int q = 0; q < 8; ++q) { const f32x4 q4 = *(const LAS f32x4*)(qs + tt * 128 + kq * 32 + q * 4);
                    S[q * 4] = a_t * S[q * 4] + kr[q * 4] * vn; S[q * 4 + 1] = a_t * S[q * 4 + 1] + kr[q * 4 + 1] * vn; S[q * 4 + 2] = a_t * S[q * 4 + 2] + kr[q * 4 + 2] * vn; S[q * 4 + 3] = a_t * S[q * 4 + 3] + kr[q * 4 + 3] * vn;
                    o += (q4.x * S[q * 4] + q4.y * S[q * 4 + 1]) + (q4.z * S[q * 4 + 2] + q4.w * S[q * 4 + 3]); }
                o += shx(o, 1, c.lane); o += shx(o, 2, c.lane);
                if (kq == 0) os[tt * 128 + v] = o;
            }
            __syncthreads();
            dn_store_chunk(a, c, l, b, h, t0, os);
        }
    }
}

struct EpiProj {
    static constexpr bool PERM = true, AFTER_DRAIN = false; unsigned char* ws;
    __device__ __forceinline__ void operator()(const pg8::f32x4 (&acc)[2][2][4][2], const pg8::Unit& u, int wr, int wc, int fr, int fq) const {
        const int pn = u.pn; bf16* base; int ld, ct; bool sg = false;
        if (pn < 6) { base = (bf16*)(ws + WS_QKVA); ld = 1536; ct = pn; } else if (pn < 12) { base = (bf16*)(ws + WS_QKVB); ld = 1536; ct = pn - 6; }
        else if (pn < 14) { base = (bf16*)(ws + WS_ZB); ld = 512; ct = pn - 12; } else { base = (bf16*)(ws + WS_GATES); ld = 2048; ct = pn - 14; sg = true; }
        const int row0 = u.pm * 256 + wr * 64 + fr, col0 = ct * 256 + wc * 32 + 8 * fq;
#pragma unroll
        for (int ai = 0; ai < 2; ++ai)
#pragma unroll
            for (int m = 0; m < 4; ++m) { bf16* rowp = base + (size_t)(row0 + ai * 128 + m * 16) * ld + col0;
#pragma unroll
                for (int bj = 0; bj < 2; ++bj) { f32x4 v0 = acc[ai][bj][m][0], v1 = acc[ai][bj][m][1];
                    if (sg) { v0.x = sigmoidf_(v0.x); v0.y = sigmoidf_(v0.y); v0.z = sigmoidf_(v0.z); v0.w = sigmoidf_(v0.w); v1.x = sigmoidf_(v1.x); v1.y = sigmoidf_(v1.y); v1.z = sigmoidf_(v1.z); v1.w = sigmoidf_(v1.w); }
                    v4u w; w.x = pk2(v0.x, v0.y); w.y = pk2(v0.z, v0.w); w.z = pk2(v1.x, v1.y); w.w = pk2(v1.z, v1.w);
                    *(v4u*)(rowp + bj * 128) = w; } }
    }
};
template <bool SECOND> struct EpiMerge {
    static constexpr bool PERM = true, AFTER_DRAIN = false; unsigned char* ws;
    __device__ __forceinline__ void operator()(const pg8::f32x4 (&acc)[2][2][4][2], const pg8::Unit& u, int wr, int wc, int fr, int fq) const {
        bf16* M = (bf16*)(ws + WS_M); const bf16* GT = (const bf16*)(ws + WS_GATES) + (SECOND ? 1024 : 0);
        const int row0 = u.pm * 256 + wr * 64 + fr, col0 = u.pn * 256 + wc * 32 + 8 * fq;
#pragma unroll
        for (int ai = 0; ai < 2; ++ai)
#pragma unroll
            for (int m = 0; m < 4; ++m) { const size_t row = row0 + ai * 128 + m * 16;
#pragma unroll
                for (int bj = 0; bj < 2; ++bj) { const int col = col0 + bj * 128; const f32x4 v0 = acc[ai][bj][m][0], v1 = acc[ai][bj][m][1];
                    const v4u g = *(const v4u*)(GT + row * 2048 + col);
                    float o[8] = {bflo(g.x) * v0.x, bfhi(g.x) * v0.y, bflo(g.y) * v0.z, bfhi(g.y) * v0.w, bflo(g.z) * v1.x, bfhi(g.z) * v1.y, bflo(g.w) * v1.z, bfhi(g.w) * v1.w};
                    if (SECOND) { const v4u p = *(const v4u*)(M + row * 1024 + col); o[0] += bflo(p.x); o[1] += bfhi(p.x); o[2] += bflo(p.y); o[3] += bfhi(p.y); o[4] += bflo(p.z); o[5] += bfhi(p.z); o[6] += bflo(p.w); o[7] += bfhi(p.w); }
                    v4u w; w.x = pk2(o[0], o[1]); w.y = pk2(o[2], o[3]); w.z = pk2(o[4], o[5]); w.w = pk2(o[6], o[7]);
                    *(v4u*)(M + row * 1024 + col) = w; } }
    }
};
struct EpiOut {
    static constexpr bool PERM = true, AFTER_DRAIN = false; const float* xin; float* xout; const float* g1;
    __device__ __forceinline__ void operator()(const pg8::f32x4 (&acc)[2][2][4][2], const pg8::Unit& u, int wr, int wc, int fr, int fq) const {
        const int row0 = u.pm * 256 + wr * 64 + fr, col0 = u.pn * 256 + wc * 32 + 8 * fq; const int b = (u.pm * 256) >> 12;
#pragma unroll
        for (int bj = 0; bj < 2; ++bj) { const int col = col0 + bj * 128; const f32x4 ga = *(const f32x4*)(g1 + b * 6144 + col), gb = *(const f32x4*)(g1 + b * 6144 + col + 4);
#pragma unroll
            for (int ai = 0; ai < 2; ++ai)
#pragma unroll
                for (int m = 0; m < 4; ++m) { const size_t off = (size_t)(row0 + ai * 128 + m * 16) * DM + col;
                    const f32x4 x0 = *(const f32x4*)(xin + off), x1 = *(const f32x4*)(xin + off + 4);
                    *(f32x4*)(xout + off) = x0 + ga * acc[ai][bj][m][0]; *(f32x4*)(xout + off + 4) = x1 + gb * acc[ai][bj][m][1]; } }
    }
};
struct EpiMoeGU {
    static constexpr bool PERM = true, AFTER_DRAIN = false; unsigned char* ws;
    __device__ __forceinline__ void operator()(const pg8::f32x4 (&acc)[2][2][4][2], const pg8::Unit& u, int wr, int wc, int fr, int fq) const {
        bf16* ACT = (bf16*)(ws + WS_ACT);
        const int row0 = u.pm * 256 + wr * 64 + fr, col0 = (u.pn & 1) * 128 + wc * 32 + 8 * fq;
#pragma unroll
        for (int ai = 0; ai < 2; ++ai)
#pragma unroll
            for (int m = 0; m < 4; ++m) { const f32x4 g0 = acc[ai][0][m][0], g1 = acc[ai][0][m][1], u0 = acc[ai][1][m][0], u1 = acc[ai][1][m][1];
                v4u w; w.x = pk2(siluf_(g0.x) * u0.x, siluf_(g0.y) * u0.y); w.y = pk2(siluf_(g0.z) * u0.z, siluf_(g0.w) * u0.w); w.z = pk2(siluf_(g1.x) * u1.x, siluf_(g1.y) * u1.y); w.w = pk2(siluf_(g1.z) * u1.z, siluf_(g1.w) * u1.w);
                *(v4u*)(ACT + (size_t)(row0 + ai * 128 + m * 16) * 256 + col0) = w; }
    }
};
struct EpiMoeDown {
    static constexpr bool PERM = true, AFTER_DRAIN = false; unsigned char* ws;
    __device__ __forceinline__ void operator()(const pg8::f32x4 (&acc)[2][2][4][2], const pg8::Unit& u, int wr, int wc, int fr, int fq) const {
        bf16* YS = (bf16*)(ws + WS_YS); const int* rowtok = (const int*)(ws + WS_ROWTOK); const float* roww = (const float*)(ws + WS_ROWW);
        const int row0 = u.pm * 256 + wr * 64 + fr, col0 = (u.pn & 3) * 256 + wc * 32 + 8 * fq;
#pragma unroll
        for (int ai = 0; ai < 2; ++ai)
#pragma unroll
            for (int m = 0; m < 4; ++m) { const int row = row0 + ai * 128 + m * 16; const int rt = rowtok[row]; const float wgt = roww[row];
                if (rt >= 0) {
#pragma unroll
                    for (int bj = 0; bj < 2; ++bj) { const f32x4 v0 = acc[ai][bj][m][0] * wgt, v1 = acc[ai][bj][m][1] * wgt;
                        v4u w; w.x = pk2(v0.x, v0.y); w.y = pk2(v0.z, v0.w); w.z = pk2(v1.x, v1.y); w.w = pk2(v1.z, v1.w);
                        *(v4u*)(YS + (size_t)rt * 1024 + col0 + bj * 128) = w; } } }
    }
};
struct MoeOrder {
    const LAS int* tile_exp; int nunits, G, c, sh;
    __device__ __forceinline__ bool next(int i, pg8::Unit& u) const {
        const int L = i * G + c; if (L >= nunits) return false;
        const int r = L >> sh, j = L & ((1 << sh) - 1);
        u.pm = r; u.pn = __builtin_amdgcn_readfirstlane((tile_exp[r] << sh) + j); return true;
    }
    __device__ __forceinline__ void a_ready(const pg8::Unit&) const {}
    __device__ __forceinline__ void done(const pg8::Unit&) const {}
};

__device__ __forceinline__ void ph_router(KArgs a, const Ctx& c, int l) {
    LAS int* lcnt = (LAS int*)(c.lds + MISC_OFF + 1024);
    LAS int* lbase = lcnt + 32;
    LAS int* tinf = lcnt + 64;
    LAS float* wreT = (LAS float*)c.lds;
    const int lane = c.lane;
    bf16* H2 = (bf16*)(a->ws + WS_H); unsigned* tokinfo = (unsigned*)(a->ws + WS_TOKINFO); int* rowtok = (int*)(a->ws + WS_ROWTOK);
    unsigned* gcnt = (unsigned*)(a->ws + WS_CTL) + CW_GCNT + l * 32;
    const float* n2w = a->in[I_N2W] + l * DM; const float* wrg = a->in[I_WRG] + (size_t)l * 1024 * 4; const float* wre = a->in[I_WRE] + (size_t)l * 1024 * 32;
    for (int i = c.bid * NTHR + c.tid; i < MOE_MAXROWS; i += c.G * NTHR) rowtok[i] = -1;
    for (int i = c.tid; i < 8192; i += NTHR) { const int k = i >> 3, n4 = (i & 7) * 4; const f32x4 w = *(const f32x4*)(wre + (size_t)k * 32 + n4);
        wreT[(n4 + 0) * 1024 + k] = w.x; wreT[(n4 + 1) * 1024 + k] = w.y; wreT[(n4 + 2) * 1024 + k] = w.z; wreT[(n4 + 3) * 1024 + k] = w.w; }
    for (int tb = c.bid; tb < NTOK / 64; tb += c.G) {
        __syncthreads();
        if (c.tid < 32) lcnt[c.tid] = 0;
        __syncthreads();
        f32x4 hn[4];
        { const float* xr0 = (const float*)a->out + (size_t)(tb * 64 + c.wave * 8) * DM;
#pragma unroll
          for (int j = 0; j < 4; ++j) hn[j] = *(const f32x4*)(xr0 + 256 * j + 4 * lane); }
        for (int i = 0; i < 8; ++i) {
            const int tl = c.wave * 8 + i, m = tb * 64 + tl, b = m >> 12;
            const float* mod = (const float*)(a->ws + WS_MOD) + (l * 4 + b) * 6144;
            f32x4 h[4];
#pragma unroll
            for (int j = 0; j < 4; ++j) h[j] = hn[j];
            if (i < 7) { const float* xr1 = (const float*)a->out + (size_t)(m + 1) * DM;
#pragma unroll
                for (int j = 0; j < 4; ++j) hn[j] = *(const f32x4*)(xr1 + 256 * j + 4 * lane); }
            const float rstd = row_rstd(h, lane);
            float ag[4] = {0.f, 0.f, 0.f, 0.f};
#pragma unroll
            for (int j = 0; j < 4; ++j) { const int col = 256 * j + 4 * lane;
                const f32x4 nw = *(const f32x4*)(n2w + col), sh = *(const f32x4*)(mod + 3072 + col), sc = *(const f32x4*)(mod + 4096 + col);
                h[j] = h[j] * rstd * nw * (sc + 1.0f) + sh;
                v2u o; o.x = pk2(h[j].x, h[j].y); o.y = pk2(h[j].z, h[j].w); *(v2u*)(H2 + (size_t)m * DM + col) = o;
                const f32x4 r0 = *(const f32x4*)(wrg + (size_t)(col + 0) * 4), r1 = *(const f32x4*)(wrg + (size_t)(col + 1) * 4), r2 = *(const f32x4*)(wrg + (size_t)(col + 2) * 4), r3 = *(const f32x4*)(wrg + (size_t)(col + 3) * 4);
                ag[0] += h[j].x * r0.x + h[j].y * r1.x + h[j].z * r2.x + h[j].w * r3.x; ag[1] += h[j].x * r0.y + h[j].y * r1.y + h[j].z * r2.y + h[j].w * r3.y;
                ag[2] += h[j].x * r0.z + h[j].y * r1.z + h[j].z * r2.z + h[j].w * r3.z; ag[3] += h[j].x * r0.w + h[j].y * r1.w + h[j].z * r2.w + h[j].w * r3.w; }
#pragma unroll
            for (int q = 0; q < 4; ++q) ag[q] = wave_sum(ag[q], lane) + a->in[I_BRG][l * 4 + q];
            int g = 0; float gm = ag[0];
#pragma unroll
            for (int q = 1; q < 4; ++q) if (ag[q] > gm) { gm = ag[q]; g = q; }
            float den = 0.f;
#pragma unroll
            for (int q = 0; q < 4; ++q) den += __expf(ag[q] - gm);
            const float ptop = 1.f / den;
            float ae[8] = {0.f, 0.f, 0.f, 0.f, 0.f, 0.f, 0.f, 0.f};
#pragma unroll
            for (int j = 0; j < 4; ++j) { const int col = 256 * j + 4 * lane;
#pragma unroll
                for (int e = 0; e < 8; ++e) { const f32x4 w = *(const LAS f32x4*)(wreT + (g * 8 + e) * 1024 + col); ae[e] += (h[j].x * w.x + h[j].y * w.y) + (h[j].z * w.z + h[j].w * w.w); } }
#pragma unroll
            for (int q = 0; q < 8; ++q) ae[q] = wave_sum(ae[q], lane) + a->in[I_BRE][l * 32 + g * 8 + q];
            int e0 = 0; float v0 = ae[0];
#pragma unroll
            for (int q = 1; q < 8; ++q) if (ae[q] > v0) { v0 = ae[q]; e0 = q; }
            int e1 = -1; float v1 = -3e38f;
#pragma unroll
            for (int q = 0; q < 8; ++q) if (q != e0 && ae[q] > v1) { v1 = ae[q]; e1 = q; }
            const float ex = __expf(v1 - v0); const float w0 = ptop / (1.f + ex), w1 = ptop * ex / (1.f + ex);
            if (lane == 0) { const int E0 = g * 8 + e0, E1 = g * 8 + e1;
                const int r0 = atomicAdd((int*)(lcnt + E0), 1), r1 = atomicAdd((int*)(lcnt + E1), 1);
                tinf[tl * 6 + 0] = E0; tinf[tl * 6 + 1] = E1; tinf[tl * 6 + 2] = r0; tinf[tl * 6 + 3] = r1; tinf[tl * 6 + 4] = __float_as_int(w0); tinf[tl * 6 + 5] = __float_as_int(w1); }
        }
        __syncthreads();
        if (c.tid < 32) lbase[c.tid] = (int)__hip_atomic_fetch_add(gcnt + c.tid, (unsigned)lcnt[c.tid], RLX_AGENT);
        __syncthreads();
        if (c.tid < 64) { const int m = tb * 64 + c.tid; const int E0 = tinf[c.tid * 6], E1 = tinf[c.tid * 6 + 1];
            v4u o; o.x = (unsigned)E0; o.y = (unsigned)E1; o.z = (unsigned)(lbase[E0] + tinf[c.tid * 6 + 2]); o.w = (unsigned)(lbase[E1] + tinf[c.tid * 6 + 3]);
            *(v4u*)(tokinfo + (size_t)m * 8) = o; *(v2u*)(tokinfo + (size_t)m * 8 + 4) = (v2u){(unsigned)tinf[c.tid * 6 + 4], (unsigned)tinf[c.tid * 6 + 5]}; }
    }
}
__device__ __forceinline__ void moe_table(KArgs a, const Ctx& c, int l) {
    LAS int* tile_exp = (LAS int*)(c.lds + MISC_OFF + 2048); LAS int* offs = tile_exp + 192; LAS int* ntl = offs + 32; LAS int* pre = ntl + 4;
    const unsigned* gcnt = (const unsigned*)(a->ws + WS_CTL) + CW_GCNT + l * 32;
    __syncthreads();
    if (c.tid < 64) { const int e = c.tid & 31; const int cnt = (int)__hip_atomic_load(gcnt + e, RLX_AGENT); const int nt = (cnt + 255) >> 8; int inc = nt;
#pragma unroll
        for (int o = 1; o < 32; o <<= 1) { const int v = shidx_i(inc, (c.lane - o) & 63); if (e >= o) inc += v; }
        if (c.tid < 32) { offs[e] = (inc - nt) * 256; pre[e] = inc; if (e == 31) ntl[0] = inc; } }
    __syncthreads();
    if (c.tid < MOE_MAXTILES) { int E = 0;
#pragma unroll
        for (int e = 0; e < 32; ++e) E += (pre[e] <= c.tid) ? 1 : 0;
        tile_exp[c.tid] = E < 31 ? E : 31; }
    __syncthreads();
}
__device__ __forceinline__ void ph_gather(KArgs a, const Ctx& c, int l) {
    moe_table(a, c, l);
    const LAS int* offs = (const LAS int*)(c.lds + MISC_OFF + 2048) + 192;
    const int gw = c.bid * NW + c.wave, NGW = c.G * NW, lane = c.lane;
    const bf16* H2 = (const bf16*)(a->ws + WS_H); bf16* HS = (bf16*)(a->ws + WS_HS); const unsigned* tokinfo = (const unsigned*)(a->ws + WS_TOKINFO);
    int* rowtok = (int*)(a->ws + WS_ROWTOK); float* roww = (float*)(a->ws + WS_ROWW);
    for (int m = gw; m < NTOK; m += NGW) {
        const v4u ti = *(const v4u*)(tokinfo + (size_t)m * 8); const v2u tw = *(const v2u*)(tokinfo + (size_t)m * 8 + 4);
        const int d0 = offs[ti.x] + (int)ti.z, d1 = offs[ti.y] + (int)ti.w;
        const v4u x0 = *(const v4u*)(H2 + (size_t)m * DM + lane * 8), x1 = *(const v4u*)(H2 + (size_t)m * DM + 512 + lane * 8);
        *(v4u*)(HS + (size_t)d0 * DM + lane * 8) = x0; *(v4u*)(HS + (size_t)d0 * DM + 512 + lane * 8) = x1;
        *(v4u*)(HS + (size_t)d1 * DM + lane * 8) = x0; *(v4u*)(HS + (size_t)d1 * DM + 512 + lane * 8) = x1;
        if (lane == 0) { rowtok[d0] = m * 2; rowtok[d1] = m * 2 + 1; roww[d0] = __uint_as_float(tw.x); roww[d1] = __uint_as_float(tw.y); }
    }
}
constexpr int DN_IMG = 57344, DN_LDW = 132, DN_LDA = 68;
typedef __bf16 bf16x2_t __attribute__((ext_vector_type(2)));
typedef float f32x2_t __attribute__((ext_vector_type(2)));
__device__ __forceinline__ unsigned cvtpk(float lo, float hi) { f32x2_t v = {lo, hi}; bf16x2_t b = __builtin_convertvector(v, bf16x2_t); return __builtin_bit_cast(unsigned, b); }
__device__ __forceinline__ bf16x8 pack8(f32x4 a, f32x4 b) { v4u w; w.x = cvtpk(a.x, a.y); w.y = cvtpk(a.z, a.w); w.z = cvtpk(b.x, b.y); w.w = cvtpk(b.z, b.w); return __builtin_bit_cast(bf16x8, w); }
#define MFMA16(a, b, c) __builtin_amdgcn_mfma_f32_16x16x32_bf16((a), (b), (c), 0, 0, 0)

__device__ __forceinline__ void dn_raw_load(KArgs a, const Ctx& c, int item, v4u (&raw)[3][5]) {
    const bf16* QKVB = (const bf16*)(a->ws + WS_QKVB);
    const int n = item & 63, h = (item >> 6) & 3, b = item >> 8, t0 = n * DNC;
    const int cg = c.tid & 15, rg = c.tid >> 4, tA = t0 + 2 * rg - 3;
#pragma unroll
    for (int part = 0; part < 3; ++part)
#pragma unroll
        for (int i = 0; i < 5; ++i) { const int tt = tA + i; raw[part][i] = (v4u){0u, 0u, 0u, 0u};
            if (tt >= 0) raw[part][i] = *(const v4u*)(QKVB + (size_t)(b * SEQ + tt) * 1536 + part * 512 + h * 128 + 8 * cg); }
}
__device__ __forceinline__ void dn_conv_store(KArgs a, const Ctx& c, int l, int h, const v4u (&raw)[3][5], LAS float* qs, LAS float* ks, LAS float* vs) {
    const float* cw = a->in[I_CONVW] + (size_t)l * 4 * 1536;
    const int cg = c.tid & 15, rg = c.tid >> 4;
#pragma unroll
    for (int part = 0; part < 3; ++part) {
        const int colb = part * 512 + h * 128 + 8 * cg;
        float w[4][8];
#pragma unroll
        for (int i = 0; i < 4; ++i) { const f32x4 w0 = *(const f32x4*)(cw + i * 1536 + colb), w1 = *(const f32x4*)(cw + i * 1536 + colb + 4);
            w[i][0] = w0.x; w[i][1] = w0.y; w[i][2] = w0.z; w[i][3] = w0.w; w[i][4] = w1.x; w[i][5] = w1.y; w[i][6] = w1.z; w[i][7] = w1.w; }
        LAS float* dst = part == 0 ? qs : part == 1 ? ks : vs;
#pragma unroll
        for (int rr = 0; rr < 2; ++rr) {
            float y[8];
#pragma unroll
            for (int e = 0; e < 8; ++e) y[e] = 0.f;
#pragma unroll
            for (int i = 0; i < 4; ++i) { const v4u x = raw[part][rr + i];
                y[0] += w[i][0] * bflo(x.x); y[1] += w[i][1] * bfhi(x.x); y[2] += w[i][2] * bflo(x.y); y[3] += w[i][3] * bfhi(x.y); y[4] += w[i][4] * bflo(x.z); y[5] += w[i][5] * bfhi(x.z); y[6] += w[i][6] * bflo(x.w); y[7] += w[i][7] * bfhi(x.w); }
            float ss = 0.f;
#pragma unroll
            for (int e = 0; e < 8; ++e) { y[e] = siluf_(y[e]); ss += y[e] * y[e]; }
            if (part < 2) { ss += dpp_f<0xB1>(ss); ss += dpp_f<0x4E>(ss); ss += dpp_f<0x141>(ss); ss += dpp_f<0x140>(ss);
                const float rs = __builtin_amdgcn_rsqf(ss + EPS) * (part == 0 ? 0.08838834764831845f : 1.f);
#pragma unroll
                for (int e = 0; e < 8; ++e) y[e] *= rs; }
            const int r = 2 * rg + rr;
            *(LAS f32x4*)(dst + r * DN_LDW + 8 * cg) = (f32x4){y[0], y[1], y[2], y[3]}; *(LAS f32x4*)(dst + r * DN_LDW + 8 * cg + 4) = (f32x4){y[4], y[5], y[6], y[7]};
        }
    }
}

__device__ __forceinline__ void ph_dn_prep(KArgs a, const Ctx& c, int l) {
    LAS float* qs = (LAS float*)c.lds; LAS float* ks = qs + 64 * DN_LDW; LAS float* vs = ks + 64 * DN_LDW;
    LAS float* Am = vs + 64 * DN_LDW; LAS float* Pm = Am + 64 * DN_LDA;
    LAS float* bt = (LAS float*)(c.lds + MISC_OFF + 1024); LAS float* Gc = bt + 64;
    const float* beta = (const float*)(a->ws + WS_BETA); const float* glog = (const float*)(a->ws + WS_GLOG);
#if MK_PROBE_A >= 30 && MK_PROBE_A <= 36
    unsigned ppa = 0, pq = (unsigned)__builtin_amdgcn_s_memrealtime();
#define PP_TICK(w) do { const unsigned t_ = (unsigned)__builtin_amdgcn_s_memrealtime(); if ((w) == MK_PROBE_A - 30) ppa += t_ - pq; pq = t_; } while (0)
#else
#define PP_TICK(w) do {} while (0)
#endif
    v4u raw[3][5];
    if (c.bid < NB * HB * NCH) dn_raw_load(a, c, c.bid, raw);
    for (int item = c.bid; item < NB * HB * NCH; item += c.G) {
        int tid = c.tid; asm volatile("" : "+v"(tid));
        const int lane = tid & 63, row = lane & 15, quad = lane >> 4;
        const int n = item & 63, h = (item >> 6) & 3, b = item >> 8, t0 = n * DNC;
        unsigned char* img = a->ws + WS_IMG + (size_t)item * DN_IMG;
        __syncthreads();
        PP_TICK(6);
        dn_conv_store(a, c, l, h, raw, qs, ks, vs);
        { const int nxt = item + c.G; if (nxt < NB * HB * NCH) dn_raw_load(a, c, nxt, raw); }
        if (tid < 64) { const int tok = b * SEQ + t0 + tid; bt[tid] = beta[tok * 4 + h]; float g = glog[tok * 4 + h];
#pragma unroll
            for (int o = 1; o < 64; o <<= 1) { const float v = shidx(g, (lane - o) & 63); if (lane >= o) g += v; }
            Gc[tid] = g; }
        __syncthreads();
        PP_TICK(0);
        {   const int sel = c.wave >> 2, ti = c.wave & 3; const LAS float* rs = sel == 0 ? ks : qs; LAS float* dstm = sel == 0 ? Am : Pm;
            bf16x8 af[4];
#pragma unroll
            for (int s = 0; s < 4; ++s) { const LAS float* p = rs + (ti * 16 + row) * DN_LDW + 32 * s + 8 * quad; af[s] = pack8(*(const LAS f32x4*)p, *(const LAS f32x4*)(p + 4)); }
            for (int tj = 0; tj < 4; ++tj) {
                f32x4 acc = {0.f, 0.f, 0.f, 0.f};
                if (tj <= ti) {
#pragma unroll
                    for (int s = 0; s < 4; ++s) { const LAS float* p = ks + (tj * 16 + row) * DN_LDW + 32 * s + 8 * quad; const bf16x8 bfr = pack8(*(const LAS f32x4*)p, *(const LAS f32x4*)(p + 4)); acc = MFMA16(af[s], bfr, acc); }
                }
                const int j = tj * 16 + row; const float Gj = Gc[j];
#pragma unroll
                for (int r = 0; r < 4; ++r) { const int i = ti * 16 + 4 * quad + r; const float dec = __expf(fminf(Gc[i] - Gj, 0.f));
                    float v = acc[r] * dec; if (sel == 0) v = (j < i) ? v * bt[i] : 0.f; else v = (j <= i) ? v : 0.f;
                    dstm[i * DN_LDA + j] = v; }
            }
        }
        __syncthreads();
        PP_TICK(1);
        const float Glast = Gc[63];
        {
            for (int q = 0; q < 5; ++q) { const int p = tid + 512 * q, blk = p >> 6; float v[8];
                if (blk < 16) { const int mt = blk >> 2, s = blk & 3, cr = 16 * mt + row, k0 = 32 * s + 4 * quad; const float e = __expf(Gc[cr]);
                    const f32x4 v0 = *(const LAS f32x4*)(qs + cr * DN_LDW + k0), v1 = *(const LAS f32x4*)(qs + cr * DN_LDW + k0 + 16);
                    v[0] = v0.x * e; v[1] = v0.y * e; v[2] = v0.z * e; v[3] = v0.w * e; v[4] = v1.x * e; v[5] = v1.y * e; v[6] = v1.z * e; v[7] = v1.w * e; }
                else if (blk < 32) { const int b2 = blk - 16, mt = b2 >> 1, s = b2 & 1, k = 16 * mt + row;
#pragma unroll
                    for (int j = 0; j < 8; ++j) { const int cj = 32 * s + 16 * (j >> 2) + 4 * quad + (j & 3); v[j] = ks[cj * DN_LDW + k] * __expf(Glast - Gc[cj]); } }
                else { const int b3 = blk - 32, mt = b3 >> 1, s = b3 & 1, i = 16 * mt + row, c0 = 32 * s + 4 * quad;
                    const f32x4 v0 = *(const LAS f32x4*)(Pm + i * DN_LDA + c0), v1 = *(const LAS f32x4*)(Pm + i * DN_LDA + c0 + 16);
                    v[0] = v0.x; v[1] = v0.y; v[2] = v0.z; v[3] = v0.w; v[4] = v1.x; v[5] = v1.y; v[6] = v1.z; v[7] = v1.w; }
                v4u w; w.x = cvtpk(v[0], v[1]); w.y = cvtpk(v[2], v[3]); w.z = cvtpk(v[4], v[5]); w.w = cvtpk(v[6], v[7]);
                *(v4u*)(img + 16384 + (size_t)p * 16) = w; }
            if (tid == 0) ((float*)(a->ws + WS_GL))[item] = __expf(Glast);
        }
        __syncthreads();
        PP_TICK(2);
        LAS float* Ti = Pm;
        if (c.wave < 4 && lane < 16) { const int bI = c.wave; float sv[16];
            int vz = 0; asm volatile("" : "+v"(vz)); const LAS float* AmV = Am + vz + (16 * bI) * DN_LDA + 16 * bI;
#pragma unroll
            for (int r = 0; r < 16; ++r) sv[r] = (r == lane) ? 1.f : 0.f;
#pragma unroll
            for (int rp = 0; rp < 15; ++rp)
#pragma unroll
                for (int r = rp + 1; r < 16; ++r) sv[r] -= AmV[r * DN_LDA + rp] * sv[rp];
#pragma unroll
            for (int r = 0; r < 16; ++r) Ti[(bI * 16 + r) * 20 + lane] = sv[r]; }
        __syncthreads();
        PP_TICK(3);
        {   const float isw0 = 0.f; (void)isw0;
#pragma unroll
            for (int bI = 0; bI < 4; ++bI) {
#pragma unroll
                for (int q = 0; q < 2; ++q) { const int nt = 2 * c.wave + q; const bool isw = nt >= 8; LAS float* xb = (isw ? ks : vs) + (nt & 7) * 16;
                    if (bI > 0) {
                        f32x4 acc = {0.f, 0.f, 0.f, 0.f};
#pragma unroll
                        for (int s2 = 0; s2 < (bI == 3 ? 2 : 1); ++s2) { const int j0 = 32 * s2 + 8 * quad;
                            f32x4 a0 = *(const LAS f32x4*)(Am + (16 * bI + row) * DN_LDA + j0), a1 = *(const LAS f32x4*)(Am + (16 * bI + row) * DN_LDA + j0 + 4);
                            if (j0 >= 16 * bI) { a0 = (f32x4){0.f, 0.f, 0.f, 0.f}; a1 = a0; }
                            float xv[8];
#pragma unroll
                            for (int j = 0; j < 8; ++j) xv[j] = xb[(j0 + j) * DN_LDW + row];
                            acc = MFMA16(pack8(a0, a1), pack8((f32x4){xv[0], xv[1], xv[2], xv[3]}, (f32x4){xv[4], xv[5], xv[6], xv[7]}), acc); }
#pragma unroll
                        for (int r = 0; r < 4; ++r) { const int i = 16 * bI + 4 * quad + r; const float sc = isw ? bt[i] * __expf(Gc[i]) : bt[i]; xb[i * DN_LDW + row] = xb[i * DN_LDW + row] * sc - acc[r]; }
                    }
                }
                if (bI > 0) __syncthreads();
#pragma unroll
                for (int q = 0; q < 2; ++q) { const int nt = 2 * c.wave + q; const bool isw = nt >= 8; LAS float* xb = (isw ? ks : vs) + (nt & 7) * 16;
                    f32x4 a0 = {0.f, 0.f, 0.f, 0.f}, a1 = a0; float xv[8];
                    if (quad < 2) { a0 = *(const LAS f32x4*)(Ti + (bI * 16 + row) * 20 + 8 * quad); a1 = *(const LAS f32x4*)(Ti + (bI * 16 + row) * 20 + 8 * quad + 4); }
#pragma unroll
                    for (int j = 0; j < 8; ++j) { const int i = 16 * bI + ((8 * quad + j) & 15); float v = xb[i * DN_LDW + row];
                        if (bI == 0) v *= isw ? bt[i] * __expf(Gc[i]) : bt[i];
                        xv[j] = v; }
                    f32x4 acc = {0.f, 0.f, 0.f, 0.f};
                    acc = MFMA16(pack8(a0, a1), pack8((f32x4){xv[0], xv[1], xv[2], xv[3]}, (f32x4){xv[4], xv[5], xv[6], xv[7]}), acc);
#pragma unroll
                    for (int r = 0; r < 4; ++r) xb[(16 * bI + 4 * quad + r) * DN_LDW + row] = acc[r]; }
                __syncthreads();
            }
        }
        PP_TICK(4);
#pragma unroll
        for (int q = 0; q < 2; ++q) { const int p = tid + 512 * q, blk = p >> 6, mt = blk >> 2, s = blk & 3, cr = 16 * mt + row, k0 = 32 * s + 4 * quad;
            const f32x4 v0 = *(const LAS f32x4*)(ks + cr * DN_LDW + k0), v1 = *(const LAS f32x4*)(ks + cr * DN_LDW + k0 + 16);
            v4u w; w.x = cvtpk(-v0.x, -v0.y); w.y = cvtpk(-v0.z, -v0.w); w.z = cvtpk(-v1.x, -v1.y); w.w = cvtpk(-v1.z, -v1.w);
            *(v4u*)(img + (size_t)p * 16) = w; }
        {   unsigned char* ug = a->ws + WS_U + (size_t)item * 16384;
#pragma unroll
            for (int q = 0; q < 2; ++q) { const int p = tid + 512 * q, sl = p >> 7, ln = (p >> 1) & 63, hh = p & 1, v = 16 * sl + (ln & 15), qd = ln >> 4; float u8[8];
#pragma unroll
                for (int e = 0; e < 8; ++e) u8[e] = vs[(16 * (2 * hh + (e >> 2)) + 4 * qd + (e & 3)) * DN_LDW + v];
                v4u w; w.x = cvtpk(u8[0], u8[1]); w.y = cvtpk(u8[2], u8[3]); w.z = cvtpk(u8[4], u8[5]); w.w = cvtpk(u8[6], u8[7]);
                *(v4u*)(ug + (size_t)(sl * 64 + ln) * 32 + hh * 16) = w; } }
        PP_TICK(5);
    }
#if MK_PROBE_A >= 30 && MK_PROBE_A <= 36
    if (blockIdx.x == 0 && c.tid == 0) ((unsigned long long*)((unsigned*)(a->ws + WS_CTL) + 12288))[56 + l] = ppa;
#endif
}

constexpr int DN_OS = 2 * DN_IMG;
__device__ __forceinline__ void ph_dn_scan(KArgs a, const Ctx& c, int l) {
    LAS unsigned char* lds = c.lds;
    const int lane = c.lane, wv = c.wave, tid = c.tid; const bool cw = wv < 4;
    const bf16* ZB = (const bf16*)(a->ws + WS_ZB); bf16* YB = (bf16*)(a->ws + WS_YB); const float* onw = a->in[I_ONW] + l * 128; const float* glp = (const float*)(a->ws + WS_GL);
    float* ssq = (float*)(a->ws + WS_SSQ);
    for (int item = c.bid; item < 2 * NB * HB; item += c.G) {
        const int bh = item >> 1, half = item & 1, b = bh >> 2, h = bh & 3;
        const unsigned char* img0 = a->ws + WS_IMG + (size_t)bh * 64 * DN_IMG;
        __syncthreads();
        if (cw) {
            const unsigned char* ugb = a->ws + WS_U + (size_t)bh * 64 * 16384; const unsigned uoff = (unsigned)((half * 4 + wv) * 64 + lane) * 32u;
            f32x4 S[8];
#pragma unroll
            for (int m = 0; m < 8; ++m) S[m] = (f32x4){0.f, 0.f, 0.f, 0.f};
            v4u uc0 = *(const v4u*)(ugb + uoff), uc1 = *(const v4u*)(ugb + uoff + 16);
            for (int n = 0; n <= NCH; ++n) {
                asm volatile("s_waitcnt lgkmcnt(0)\n\ts_barrier" ::: "memory");
                if (n == NCH) break;
                v4u un0 = uc0, un1 = uc1;
                if (n + 1 < NCH) { un0 = *(const v4u*)(ugb + (size_t)(n + 1) * 16384 + uoff); un1 = *(const v4u*)(ugb + (size_t)(n + 1) * 16384 + uoff + 16); }
                const float gl = glp[bh * 64 + n];
                const LAS unsigned char* im = lds + (n & 1) * DN_IMG + lane * 16;
                bf16x8 Sb[4];
#pragma unroll
                for (int s = 0; s < 4; ++s) Sb[s] = pack8(S[2 * s], S[2 * s + 1]);
                f32x4 X[4], O[4];
                X[0] = (f32x4){bflo(uc0.x), bfhi(uc0.x), bflo(uc0.y), bfhi(uc0.y)}; X[1] = (f32x4){bflo(uc0.z), bfhi(uc0.z), bflo(uc0.w), bfhi(uc0.w)};
                X[2] = (f32x4){bflo(uc1.x), bfhi(uc1.x), bflo(uc1.y), bfhi(uc1.y)}; X[3] = (f32x4){bflo(uc1.z), bfhi(uc1.z), bflo(uc1.w), bfhi(uc1.w)};
                bf16x8 fa[8], fb[8];
#define DN_LDF(arr, off) do { _Pragma("unroll") for (int q_ = 0; q_ < 8; ++q_) arr[q_] = *(const LAS bf16x8*)(im + (off) + q_ * 1024); } while (0)
                DN_LDF(fa, 0); DN_LDF(fb, 8192);
#pragma unroll
                for (int mt = 0; mt < 2; ++mt)
#pragma unroll
                    for (int s = 0; s < 4; ++s) X[mt] = MFMA16(fa[mt * 4 + s], Sb[s], X[mt]);
                DN_LDF(fa, 16384);
#pragma unroll
                for (int mt = 0; mt < 2; ++mt)
#pragma unroll
                    for (int s = 0; s < 4; ++s) X[2 + mt] = MFMA16(fb[mt * 4 + s], Sb[s], X[2 + mt]);
                DN_LDF(fb, 16384 + 8192);
#pragma unroll
                for (int mt = 0; mt < 2; ++mt) { O[mt] = (f32x4){0.f, 0.f, 0.f, 0.f};
#pragma unroll
                    for (int s = 0; s < 4; ++s) O[mt] = MFMA16(fa[mt * 4 + s], Sb[s], O[mt]); }
                DN_LDF(fa, 32768);
#pragma unroll
                for (int mt = 0; mt < 2; ++mt) { O[2 + mt] = (f32x4){0.f, 0.f, 0.f, 0.f};
#pragma unroll
                    for (int s = 0; s < 4; ++s) O[2 + mt] = MFMA16(fb[mt * 4 + s], Sb[s], O[2 + mt]); }
                DN_LDF(fb, 32768 + 8192);
                bf16x8 Xb[2];
                Xb[0] = pack8(X[0], X[1]); Xb[1] = pack8(X[2], X[3]);
#pragma unroll
                for (int m = 0; m < 4; ++m) { S[m] = S[m] * gl;
#pragma unroll
                    for (int s = 0; s < 2; ++s) S[m] = MFMA16(fa[m * 2 + s], Xb[s], S[m]); }
                DN_LDF(fa, 49152);
#pragma unroll
                for (int m = 0; m < 4; ++m) { S[4 + m] = S[4 + m] * gl;
#pragma unroll
                    for (int s = 0; s < 2; ++s) S[4 + m] = MFMA16(fb[m * 2 + s], Xb[s], S[4 + m]); }
#pragma unroll
                for (int mt = 0; mt < 4; ++mt)
#pragma unroll
                    for (int s = 0; s < 2; ++s) O[mt] = MFMA16(fa[mt * 2 + s], Xb[s], O[mt]);
#undef DN_LDF
                LAS unsigned short* os = (LAS unsigned short*)(lds + DN_OS + (n & 1) * 8192);
#pragma unroll
                for (int mt = 0; mt < 4; ++mt)
#pragma unroll
                    for (int r = 0; r < 4; ++r) os[(16 * mt + 4 * (lane >> 4) + r) * 64 + 16 * wv + (lane & 15)] = (unsigned short)(cvtpk(O[mt][r], 0.f) & 0xffffu);
                uc0 = un0; uc1 = un1;
            }
        } else {
            const int ht = tid - 256, hw = wv - 4, nr = ht >> 2, nq = ht & 3;
            const bf16* zpb = ZB + (size_t)(b * SEQ) * 512 + h * 128 + half * 64; bf16* ypb = YB + (size_t)(b * SEQ) * 512 + h * 128 + half * 64; const unsigned zoff = (unsigned)(nr * 512 + nq * 16);
            float* sqp = ssq + ((size_t)(b * SEQ + nr) * 4 + h) * 2 + half;
#define DN_DMA(n, buf) do { _Pragma("unroll") for (int q_ = 0; q_ < 14; ++q_) { const int pc_ = hw + 4 * q_; \
                __builtin_amdgcn_global_load_lds((const unsigned*)(img0 + (size_t)(n) * DN_IMG + pc_ * 1024 + lane * 16), (LAS unsigned*)(lds + (buf) * DN_IMG + pc_ * 1024), 16, 0, 0); } } while (0)
            DN_DMA(0, 0);
            v4u zc0 = *(const v4u*)(zpb + zoff), zc1 = *(const v4u*)(zpb + zoff + 8);
            f32x4 ow[4];
#pragma unroll
            for (int q = 0; q < 4; ++q) ow[q] = *(const f32x4*)(onw + half * 64 + nq * 16 + q * 4);
            asm volatile("s_waitcnt vmcnt(0) lgkmcnt(0)\n\ts_barrier" ::: "memory");
            DN_DMA(1, 1);
            for (int n = 1; n <= NCH; ++n) {
                if (n == 1) asm volatile("s_waitcnt vmcnt(0) lgkmcnt(0)\n\ts_barrier" ::: "memory"); else asm volatile("s_waitcnt vmcnt(3) lgkmcnt(0)\n\ts_barrier" ::: "memory");
                v4u zn0 = zc0, zn1 = zc1;
                if (n < NCH) { zn0 = *(const v4u*)(zpb + (size_t)n * DNC * 512 + zoff); zn1 = *(const v4u*)(zpb + (size_t)n * DNC * 512 + zoff + 8); }
                asm volatile("" ::: "memory");
                if (n + 1 < NCH) DN_DMA(n + 1, (n + 1) & 1);
                asm volatile("" ::: "memory");
                {
                    const LAS unsigned short* os = (const LAS unsigned short*)(lds + DN_OS + ((n - 1) & 1) * 8192) + nr * 64 + nq * 16;
                    float o[16]; float ss = 0.f;
                    const v4u o0 = *(const LAS v4u*)os, o1 = *(const LAS v4u*)(os + 8);
                    o[0] = bflo(o0.x); o[1] = bfhi(o0.x); o[2] = bflo(o0.y); o[3] = bfhi(o0.y); o[4] = bflo(o0.z); o[5] = bfhi(o0.z); o[6] = bflo(o0.w); o[7] = bfhi(o0.w);
                    o[8] = bflo(o1.x); o[9] = bfhi(o1.x); o[10] = bflo(o1.y); o[11] = bfhi(o1.y); o[12] = bflo(o1.z); o[13] = bfhi(o1.z); o[14] = bflo(o1.w); o[15] = bfhi(o1.w);
#pragma unroll
                    for (int e = 0; e < 16; ++e) ss += o[e] * o[e];
                    ss += dpp_f<0xB1>(ss); ss += dpp_f<0x4E>(ss);
                    bf16* yp = ypb + (size_t)(n - 1) * DNC * 512 + zoff;
                    v4u y; y.x = cvtpk(o[0] * ow[0].x * siluf_(bflo(zc0.x)), o[1] * ow[0].y * siluf_(bfhi(zc0.x))); y.y = cvtpk(o[2] * ow[0].z * siluf_(bflo(zc0.y)), o[3] * ow[0].w * siluf_(bfhi(zc0.y)));
                    y.z = cvtpk(o[4] * ow[1].x * siluf_(bflo(zc0.z)), o[5] * ow[1].y * siluf_(bfhi(zc0.z))); y.w = cvtpk(o[6] * ow[1].z * siluf_(bflo(zc0.w)), o[7] * ow[1].w * siluf_(bfhi(zc0.w)));
                    *(v4u*)yp = y;
                    y.x = cvtpk(o[8] * ow[2].x * siluf_(bflo(zc1.x)), o[9] * ow[2].y * siluf_(bfhi(zc1.x))); y.y = cvtpk(o[10] * ow[2].z * siluf_(bflo(zc1.y)), o[11] * ow[2].w * siluf_(bfhi(zc1.y)));
                    y.z = cvtpk(o[12] * ow[3].x * siluf_(bflo(zc1.z)), o[13] * ow[3].y * siluf_(bfhi(zc1.z))); y.w = cvtpk(o[14] * ow[3].z * siluf_(bflo(zc1.w)), o[15] * ow[3].w * siluf_(bfhi(zc1.w)));
                    *(v4u*)(yp + 8) = y;
                    sqp[(size_t)(n - 1) * DNC * 8] = ss;
                }
                zc0 = zn0; zc1 = zn1;
            }
#undef DN_DMA
        }
        asm volatile("s_waitcnt vmcnt(0)" ::: "memory"); __syncthreads();
    }
}
__device__ __forceinline__ void ph_yb_norm(KArgs a, const Ctx& c) {
    const int gw = c.bid * NW + c.wave, NGW = c.G * NW, lane = c.lane; bf16* YB = (bf16*)(a->ws + WS_YB); const float* ssq = (const float*)(a->ws + WS_SSQ);
    for (int m = gw; m < NTOK; m += NGW) {
        const f32x2_t sq = *(const f32x2_t*)(ssq + (size_t)m * 8 + (lane >> 4) * 2); const float rstd = __builtin_amdgcn_rsqf((sq.x + sq.y) * (1.f / 128.f) + EPS);
        v4u w = *(const v4u*)(YB + (size_t)m * 512 + lane * 8);
        w.x = cvtpk(bflo(w.x) * rstd, bfhi(w.x) * rstd); w.y = cvtpk(bflo(w.y) * rstd, bfhi(w.y) * rstd); w.z = cvtpk(bflo(w.z) * rstd, bfhi(w.z) * rstd); w.w = cvtpk(bflo(w.w) * rstd, bfhi(w.w) * rstd);
        *(v4u*)(YB + (size_t)m * 512 + lane * 8) = w;
    }
}
typedef short v4i16_t __attribute__((ext_vector_type(4)));
#define MFMA32(a, b, c) __builtin_amdgcn_mfma_f32_32x32x16_bf16((a), (b), (c), 0, 0, 0)
constexpr int AT_ROWB = 144;
constexpr int AT_TILE = 64 * AT_ROWB, AT_K = 0, AT_V = 3 * AT_TILE, AT_OST = 6 * AT_TILE, AT_BT = AT_OST + 8 * 32 * AT_ROWB, AT_KM = AT_BT + 1024, AT_UW = MISC_OFF + 512;
__device__ __forceinline__ int crow(int r, int hi) { return (r & 3) + 8 * (r >> 2) + 4 * hi; }
__device__ __forceinline__ bf16x8 vtr2(const LAS unsigned char* p) {
    const v4i16_t lo = __builtin_amdgcn_ds_read_tr16_b64_v4i16((LAS v4i16_t*)p), hi = __builtin_amdgcn_ds_read_tr16_b64_v4i16((LAS v4i16_t*)(p + 8 * AT_ROWB));
    return (bf16x8){lo[0], lo[1], lo[2], lo[3], hi[0], hi[1], hi[2], hi[3]};
}
__device__ __forceinline__ void ph_attn(KArgs a, const Ctx& c, int l) {
    LAS unsigned char* lds = c.lds; const int lane = c.lane, wv = c.wave, tid = c.tid, r32 = lane & 31, hi = lane >> 5;
    LAS float* btab = (LAS float*)(lds + AT_BT); LAS float* kms = (LAS float*)(lds + AT_KM); volatile LAS int* uw = (volatile LAS int*)(lds + AT_UW);
    const bf16* QKVA = (const bf16*)(a->ws + WS_QKVA); const float* kmean = (const float*)(a->ws + WS_KMEAN); bf16* YA = (bf16*)(a->ws + WS_YA); const float* relb = a->in[I_RELB];
    unsigned* ctr = (unsigned*)(a->ws + WS_CTL) + CW_ACTR + l * 64;
    const float LOG2E = 1.4426950408889634f, C2 = 0.125f * LOG2E, NINF = -__builtin_inff();
    const int srow = tid >> 3, sch = tid & 7; const unsigned sdst = srow * AT_ROWB + sch * 16;
    for (;;) {
        __syncthreads();
        if (tid == 0) uw[0] = (int)__hip_atomic_fetch_add(ctr, 1u, RLX_AGENT);
        __syncthreads();
        const int u = uw[0];
        if (u >= NB * HA * NBLK) { if (u >= NB * HA * NBLK + CV_NUNITS - CV_EARLYQ) break; convert_unit(a, c, l, CV_EARLYQ + u - NB * HA * NBLK); continue; }
        const int qb = 15 - (u >> 5), bh = u & 31, b = bh >> 3, h = bh & 7;
        const float c31 = relb[31 * 8 + h];
        for (int i = tid; i < 129; i += NTHR) btab[i] = (i < 128 ? (relb[(int)T5B[i] * 8 + h] - c31) : 0.f) * LOG2E;
        for (int i = tid; i < 1024; i += NTHR) kms[i] = kmean[(size_t)bh * 1024 + i];
        const int qrel = wv * 32 + r32, tokq = b * SEQ + qb * 256 + qrel;
        const bf16* kbase = QKVA + (size_t)(b * SEQ) * 1536 + 512 + h * 64 + sch * 8;
#define AT_LOAD(tt, KR, VR) do { const int t1_ = (tt), blk1_ = t1_ < 4 ? qb : ((t1_ - 4) >> 2), kt1_ = t1_ < 4 ? t1_ : ((t1_ - 4) & 3); const size_t ro_ = (size_t)(blk1_ * 256 + kt1_ * 64 + srow) * 1536; \
            KR = *(const v4u*)(kbase + ro_); VR = *(const v4u*)(kbase + ro_ + 512); } while (0)
#define AT_STORE(tt, KR, VR) do { const int bo_ = ((tt) % 3) * AT_TILE; *(LAS v4u*)(lds + AT_K + bo_ + sdst) = KR; *(LAS v4u*)(lds + AT_V + bo_ + sdst) = VR; } while (0)
        v4u krA, vrA, krB, vrB;
        AT_LOAD(0, krA, vrA); AT_LOAD(1, krB, vrB);
        float qf[32];
        {   const bf16* qp = QKVA + (size_t)tokq * 1536 + h * 64 + 8 * hi;
#pragma unroll
            for (int s = 0; s < 4; ++s) { const v4u w = *(const v4u*)(qp + 16 * s); qf[s * 8 + 0] = bflo(w.x); qf[s * 8 + 1] = bfhi(w.x); qf[s * 8 + 2] = bflo(w.y); qf[s * 8 + 3] = bfhi(w.y); qf[s * 8 + 4] = bflo(w.z); qf[s * 8 + 5] = bfhi(w.z); qf[s * 8 + 6] = bflo(w.w); qf[s * 8 + 7] = bfhi(w.w); } }
        AT_STORE(0, krA, vrA); AT_STORE(1, krB, vrB); AT_LOAD(2, krA, vrA);
        __syncthreads();
        unsigned selmask = 0u;
        {   float g[16];
#pragma unroll
            for (int n = 0; n < 16; ++n) { g[n] = -3e38f;
                if (n < qb) { float d = 0.f;
#pragma unroll
                    for (int s = 0; s < 4; ++s) { const f32x4 k0 = *(const LAS f32x4*)(kms + n * 64 + 16 * s + 8 * hi), k1 = *(const LAS f32x4*)(kms + n * 64 + 16 * s + 8 * hi + 4);
                        d += qf[s * 8] * k0.x + qf[s * 8 + 1] * k0.y + qf[s * 8 + 2] * k0.z + qf[s * 8 + 3] * k0.w + qf[s * 8 + 4] * k1.x + qf[s * 8 + 5] * k1.y + qf[s * 8 + 6] * k1.z + qf[s * 8 + 7] * k1.w; }
                    g[n] = d + shx(d, 32, lane); } }
#pragma unroll
            for (int t = 0; t < 3; ++t) { float best = -3.4e38f; int bi = 0;
#pragma unroll
                for (int n = 0; n < 16; ++n) { const bool ok = !((selmask >> n) & 1u) && g[n] > best; best = ok ? g[n] : best; bi = ok ? n : bi; }
                selmask |= 1u << bi; }
            selmask &= (1u << qb) - 1u; }
        bf16x8 qs[4];
#pragma unroll
        for (int s = 0; s < 4; ++s) { v4u w; w.x = cvtpk(qf[s * 8] * C2, qf[s * 8 + 1] * C2); w.y = cvtpk(qf[s * 8 + 2] * C2, qf[s * 8 + 3] * C2); w.z = cvtpk(qf[s * 8 + 4] * C2, qf[s * 8 + 5] * C2); w.w = cvtpk(qf[s * 8 + 6] * C2, qf[s * 8 + 7] * C2); qs[s] = __builtin_bit_cast(bf16x8, w); }
        float mref = 0.f, lsum = 0.f; f32x16 o0, o1;
#pragma unroll
        for (int r = 0; r < 16; ++r) { o0[r] = 0.f; o1[r] = 0.f; }
        const int NT = 4 * (qb + 1);
        for (int t0 = 0; t0 < NT; t0 += 2) {
#pragma unroll
            for (int hf = 0; hf < 2; ++hf) {
                const int t = t0 + hf;
                const int blk = t < 4 ? qb : ((t - 4) >> 2), kt = t < 4 ? t : ((t - 4) & 3);
                if (hf == 0) { if (t + 3 < NT) AT_LOAD(t + 3, krB, vrB); } else { if (t + 3 < NT) AT_LOAD(t + 3, krA, vrA); }
                const bool own = t < 4;
                const bool lane_act = own || ((selmask >> blk) & 1u);
                const bool wave_act = own ? (kt * 64 <= wv * 32 + 31) : (__builtin_amdgcn_ballot_w64(lane_act) != 0ull);
                if (wave_act) {
                    const LAS unsigned char* Kb = lds + AT_K + (t % 3) * AT_TILE; const LAS unsigned char* Vb = lds + AT_V + (t % 3) * AT_TILE;
                    const float nm = lane_act ? -mref : NINF;
                    f32x16 p0, p1;
#pragma unroll
                    for (int r = 0; r < 16; ++r) { p0[r] = nm; p1[r] = nm; }
#pragma unroll
                    for (int s = 0; s < 4; ++s) { const bf16x8 a0 = *(const LAS bf16x8*)(Kb + r32 * AT_ROWB + 32 * s + 16 * hi), a1 = *(const LAS bf16x8*)(Kb + (32 + r32) * AT_ROWB + 32 * s + 16 * hi);
                        p0 = MFMA32(a0, qs[s], p0); p1 = MFMA32(a1, qs[s], p1); }
                    if (own) {
#pragma unroll
                        for (int r = 0; r < 16; ++r) { const int d0 = qrel - (kt * 64 + crow(r, hi)), d1 = d0 - 32;
                            const float b0 = btab[d0 < 0 ? 0 : (d0 > 128 ? 128 : d0)], b1 = btab[d1 < 0 ? 0 : (d1 > 128 ? 128 : d1)];
                            p0[r] = d0 >= 0 ? p0[r] + b0 : NINF; p1[r] = d1 >= 0 ? p1[r] + b1 : NINF; }
                    } else if (blk == qb - 1 && kt >= 1) {
#pragma unroll
                        for (int r = 0; r < 16; ++r) { const int d0 = qrel + 256 - (kt * 64 + crow(r, hi)), d1 = d0 - 32;
                            p0[r] += btab[d0 > 128 ? 128 : d0]; p1[r] += btab[d1 > 128 ? 128 : d1]; }
                    }
#define MX3_(a_, b_, c_) __builtin_fmaxf(__builtin_fmaxf((a_), (b_)), (c_))
                    float mxa = MX3_(p0[0], p0[1], p1[0]), mxb = MX3_(p0[2], p0[3], p1[1]); mxa = MX3_(mxa, p1[2], p1[3]);
#pragma unroll
                    for (int r = 4; r < 16; r += 4) { mxa = MX3_(mxa, p0[r], p0[r + 1]); mxb = MX3_(mxb, p0[r + 2], p0[r + 3]); mxa = MX3_(mxa, p1[r], p1[r + 1]); mxb = MX3_(mxb, p1[r + 2], p1[r + 3]); }
#undef MX3_
                    float mx = __builtin_fmaxf(mxa, mxb); mx = __builtin_fmaxf(mx, shx(mx, 32, lane));
                    if (__builtin_amdgcn_ballot_w64(mx > 8.f) != 0ull) { const float dl = __builtin_fmaxf(mx, 0.f); mref += dl; const float f = __builtin_amdgcn_exp2f(-dl);
#pragma unroll
                        for (int r = 0; r < 16; ++r) { p0[r] -= dl; p1[r] -= dl; o0[r] *= f; o1[r] *= f; }
                        lsum *= f; }
                    float rs0 = 0.f, rs1 = 0.f;
#pragma unroll
                    for (int r = 0; r < 16; ++r) { p0[r] = __builtin_amdgcn_exp2f(p0[r]); p1[r] = __builtin_amdgcn_exp2f(p1[r]); rs0 += p0[r]; rs1 += p1[r]; }
                    lsum += rs0 + rs1;
                    bf16x8 pa[4];
                    { v4u w; w.x = cvtpk(p0[0], p0[1]); w.y = cvtpk(p0[2], p0[3]); w.z = cvtpk(p0[4], p0[5]); w.w = cvtpk(p0[6], p0[7]); pa[0] = __builtin_bit_cast(bf16x8, w);
                      w.x = cvtpk(p0[8], p0[9]); w.y = cvtpk(p0[10], p0[11]); w.z = cvtpk(p0[12], p0[13]); w.w = cvtpk(p0[14], p0[15]); pa[1] = __builtin_bit_cast(bf16x8, w);
                      w.x = cvtpk(p1[0], p1[1]); w.y = cvtpk(p1[2], p1[3]); w.z = cvtpk(p1[4], p1[5]); w.w = cvtpk(p1[6], p1[7]); pa[2] = __builtin_bit_cast(bf16x8, w);
                      w.x = cvtpk(p1[8], p1[9]); w.y = cvtpk(p1[10], p1[11]); w.z = cvtpk(p1[12], p1[13]); w.w = cvtpk(p1[14], p1[15]); pa[3] = __builtin_bit_cast(bf16x8, w); }
                    const LAS unsigned char* vp = Vb + (4 * hi + ((lane & 15) >> 2)) * AT_ROWB + 2 * (16 * ((lane >> 4) & 1) + 4 * (lane & 3));
#pragma unroll
                    for (int ks = 0; ks < 4; ++ks) { const bf16x8 v0 = vtr2(vp + 16 * ks * AT_ROWB), v1 = vtr2(vp + 16 * ks * AT_ROWB + 64);
                        o0 = MFMA32(v0, pa[ks], o0); o1 = MFMA32(v1, pa[ks], o1); }
                }

                if (hf == 0) { if (t + 2 < NT) AT_STORE(t + 2, krA, vrA); } else { if (t + 2 < NT) AT_STORE(t + 2, krB, vrB); }
                asm volatile("s_waitcnt lgkmcnt(0)\n\ts_barrier" ::: "memory");
            }
        }
#undef AT_LOAD
#undef AT_STORE
        lsum += shx(lsum, 32, lane);
        const float inv = rcpf_(lsum);
        LAS unsigned short* stg = (LAS unsigned short*)(lds + AT_OST + wv * 32 * AT_ROWB);
#pragma unroll
        for (int r = 0; r < 16; ++r) { stg[r32 * (AT_ROWB / 2) + crow(r, hi)] = (unsigned short)(cvtpk(o0[r] * inv, 0.f) & 0xffffu); stg[r32 * (AT_ROWB / 2) + 32 + crow(r, hi)] = (unsigned short)(cvtpk(o1[r] * inv, 0.f) & 0xffffu); }
        LDS_WAIT();
#pragma unroll
        for (int i = 0; i < 4; ++i) { const int row = i * 8 + (lane >> 3), ch = lane & 7; const v4u v = *(const LAS v4u*)((const LAS unsigned char*)stg + row * AT_ROWB + ch * 16);
            *(v4u*)(YA + (size_t)(b * SEQ + qb * 256 + wv * 32 + row) * 512 + h * 64 + ch * 8) = v; }
    }
}
constexpr int NPH_LAYER = 11, NPHASES = 2 + NLAYER * NPH_LAYER;
#ifndef DN_IMPL
#define DN_IMPL 1
#endif
#ifndef PH_MASK
#define PH_MASK 0xFFFF
#endif
#define PH_EN(k) ((PH_MASK >> (k)) & 1)
#define GEMM_PHASE(EPI, SCHED, g, S, E) pg8::gemm_phase<EPI, SCHED, true, true>(c.lds, g, S, E, c.tid)

#define PHASE_FN static __device__ __forceinline__ void
__device__ __forceinline__ KArgs launder_k(KArgs a) { unsigned long long v = (unsigned long long)a; asm volatile("" : "+s"(v)); return (KArgs)v; }
PHASE_FN f_mod(KArgs a, int& tid) { a = launder_k(a); Ctx c = make_ctx(tid); ph_mod(a, c); }
PHASE_FN f_norm1(KArgs a, int& tid, int l) { a = launder_k(a); Ctx c = make_ctx(tid); ph_norm1(a, c, l); __syncthreads(); ph_convert(a, c, l); }
PHASE_FN f_proj(KArgs a, int& tid, int l) { a = launder_k(a); Ctx c = make_ctx(tid);
    pg8::Gemm g{(const bf16*)(a->ws + WS_H), (const bf16*)(a->ws + WS_WIN), NTOK, DINP, DM}; pg8::StaticOrder S; S.init(NTOK, DINP, c.G, c.bid);
    EpiProj E{a->ws}; GEMM_PHASE(EpiProj, pg8::StaticOrder, g, S, E);
    {   volatile LAS int* uw = (volatile LAS int*)(c.lds + MISC_OFF + 512); unsigned* ctr = (unsigned*)(a->ws + WS_CTL) + CW_CCTR + l * 64;
        for (;;) { __syncthreads(); if (c.tid == 0) uw[0] = (int)__hip_atomic_fetch_add(ctr, 1u, RLX_AGENT); __syncthreads();
            const int u = uw[0]; if (u >= CV_EARLYQ) break; convert_unit(a, c, l, u); } } }
PHASE_FN f_kmean(KArgs a, int& tid) { a = launder_k(a); Ctx c = make_ctx(tid); ph_kmean(a, c); }
#ifndef ATTN_IMPL
#define ATTN_IMPL 1
#endif
#if ATTN_IMPL
PHASE_FN f_attn(KArgs a, int& tid, int l) { a = launder_k(a); Ctx c = make_ctx(tid); ph_attn(a, c, l); }
#else
PHASE_FN f_attn(KArgs a, int& tid, int l) { a = launder_k(a); Ctx c = make_ctx(tid); ph_attn_simple(a, c); }
#endif
PHASE_FN f_dn(KArgs a, int& tid, int l) { a = launder_k(a); Ctx c = make_ctx(tid); ph_dn_simple(a, c, l); }
PHASE_FN f_dn_prep(KArgs a, int& tid, int l) { a = launder_k(a); Ctx c = make_ctx(tid); ph_dn_prep(a, c, l); }
PHASE_FN f_dn_scan(KArgs a, int& tid, int l) { a = launder_k(a); Ctx c = make_ctx(tid); ph_dn_scan(a, c, l); }
PHASE_FN f_merge1(KArgs a, int& tid) { a = launder_k(a); Ctx c = make_ctx(tid);
    ph_yb_norm(a, c);
    pg8::Gemm g{(const bf16*)(a->ws + WS_YA), (const bf16*)(a->ws + WS_WUPA), NTOK, DM, WA}; pg8::StaticOrder S; S.init(NTOK, DM, c.G, c.bid);
    EpiMerge<false> E{a->ws}; GEMM_PHASE(EpiMerge<false>, pg8::StaticOrder, g, S, E); }
PHASE_FN f_merge2(KArgs a, int& tid) { a = launder_k(a); Ctx c = make_ctx(tid);
    pg8::Gemm g{(const bf16*)(a->ws + WS_YB), (const bf16*)(a->ws + WS_WUPB), NTOK, DM, WB}; pg8::StaticOrder S; S.init(NTOK, DM, c.G, c.bid);
    EpiMerge<true> E{a->ws}; GEMM_PHASE(EpiMerge<true>, pg8::StaticOrder, g, S, E); }
PHASE_FN f_out(KArgs a, int& tid, int l) { a = launder_k(a); Ctx c = make_ctx(tid);
    pg8::Gemm g{(const bf16*)(a->ws + WS_M), (const bf16*)(a->ws + WS_WOUT), NTOK, DM, DM}; pg8::StaticOrder S; S.init(NTOK, DM, c.G, c.bid);
    EpiOut E{l == 0 ? a->in[I_X] : (const float*)a->out, a->out, (const float*)(a->ws + WS_MOD) + l * 4 * 6144 + 2048}; GEMM_PHASE(EpiOut, pg8::StaticOrder, g, S, E); }
PHASE_FN f_router(KArgs a, int& tid, int l) { a = launder_k(a); Ctx c = make_ctx(tid); ph_router(a, c, l); }
PHASE_FN f_gather(KArgs a, int& tid, int l) { a = launder_k(a); Ctx c = make_ctx(tid); ph_gather(a, c, l); }
PHASE_FN f_moe_gu(KArgs a, int& tid, int l) { a = launder_k(a); Ctx c = make_ctx(tid);
    moe_table(a, c, l); const LAS int* te = (const LAS int*)(c.lds + MISC_OFF + 2048);
    pg8::Gemm g{(const bf16*)(a->ws + WS_HS), (const bf16*)(a->ws + WS_WEGU), MOE_MAXROWS, NEXP * 512, DM}; MoeOrder S{te, te[192 + 32] * 2, c.G, c.bid, 1};
    EpiMoeGU E{a->ws}; GEMM_PHASE(EpiMoeGU, MoeOrder, g, S, E); }
PHASE_FN f_moe_down(KArgs a, int& tid, int l) { a = launder_k(a); Ctx c = make_ctx(tid);
    moe_table(a, c, l); const LAS int* te = (const LAS int*)(c.lds + MISC_OFF + 2048);
    pg8::Gemm g{(const bf16*)(a->ws + WS_ACT), (const bf16*)(a->ws + WS_WED), MOE_MAXROWS, NEXP * 1024, DFF}; MoeOrder S{te, te[192 + 32] * 4, c.G, c.bid, 2};
    EpiMoeDown E{a->ws}; GEMM_PHASE(EpiMoeDown, MoeOrder, g, S, E); }
PHASE_FN f_final(KArgs a, int& tid) { a = launder_k(a); Ctx c = make_ctx(tid); ph_final(a, c); }

#define KA() launder_k((KArgs)__builtin_amdgcn_kernarg_segment_ptr())
__device__ __forceinline__ bool ph_in(int k) { KArgs a = KA(); return a->ph_lo <= k && k < a->ph_hi; }
#ifndef MK_PROBE_A
#define MK_PROBE_A -1
#endif
#ifndef MK_PROBE_B
#define MK_PROBE_B -1
#endif
constexpr int CW_TS = 12288;
__device__ __forceinline__ void grid_bar(int& tid, int k) {
    asm volatile("" : "+v"(tid));
#if MK_ONE_LAUNCH
    KArgs a = KA(); XcdBarrier b; b.bar = (unsigned*)(a->ws + WS_CTL) + CW_BAR; b.x = xb_xcc_id(); b.st = (volatile LAS unsigned*)((LAS unsigned char*)lds_raw + MISC_OFF) + 8;
    xcd_barrier(b, tid);
    if (MK_PROBE_A >= 0 && blockIdx.x == 0 && tid == 0) ((unsigned long long*)((unsigned*)(a->ws + WS_CTL) + CW_TS))[k + 1] = __builtin_amdgcn_s_memrealtime();
#else
    __syncthreads();
#endif
}
__global__ void __launch_bounds__(NTHR, 2) mk_fwd(Args a_) {
    int tid = threadIdx.x;
    {   volatile LAS unsigned* MISC = (volatile LAS unsigned*)((LAS unsigned char*)lds_raw + MISC_OFF);
        if (tid < 64) MISC[tid] = 0u;
        __syncthreads();
#if MK_ONE_LAUNCH
        (void)xcd_barrier_post((unsigned*)(KA()->ws + WS_CTL) + CW_BAR, MISC + 8, tid);
#endif
        if (MK_PROBE_A >= 0 && blockIdx.x == 0 && tid == 0) ((unsigned long long*)((unsigned*)(KA()->ws + WS_CTL) + CW_TS))[0] = __builtin_amdgcn_s_memrealtime();
    }
#define IN(k) ph_in(k)
#define SEAM(k) do { if (IN(k) && IN((k) + 1)) grid_bar(tid, (k)); } while (0)
    if (IN(0)) f_mod(KA(), tid); SEAM(0);
    for (int l = 0; l < NLAYER; ++l) {
        const int pb = 1 + l * NPH_LAYER;
        if (PH_EN(0) && IN(pb + 0)) f_norm1(KA(), tid, l); SEAM(pb + 0);
        if (PH_EN(1) && IN(pb + 1)) f_proj(KA(), tid, l); SEAM(pb + 1);
#if DN_IMPL
        if (PH_EN(2) && IN(pb + 2)) { f_kmean(KA(), tid); f_dn_prep(KA(), tid, l); } SEAM(pb + 2);
        if (PH_EN(3) && IN(pb + 3)) { f_dn_scan(KA(), tid, l);
            if (MK_PROBE_A == 20 && blockIdx.x == 0 && tid == 0) ((unsigned long long*)((unsigned*)(KA()->ws + WS_CTL) + CW_TS))[40 + l] = __builtin_amdgcn_s_memrealtime();
            __syncthreads(); f_attn(KA(), tid, l);
            if (MK_PROBE_A == 21 && blockIdx.x == 255 && tid == 0) ((unsigned long long*)((unsigned*)(KA()->ws + WS_CTL) + CW_TS))[44 + l] = __builtin_amdgcn_s_memrealtime(); } SEAM(pb + 3);
#else
        if (PH_EN(2) && IN(pb + 2)) f_kmean(KA(), tid); SEAM(pb + 2);
        if (PH_EN(3) && IN(pb + 3)) { f_attn(KA(), tid, l); __syncthreads(); f_dn(KA(), tid, l); } SEAM(pb + 3);
#endif
        if (PH_EN(4) && IN(pb + 4)) f_merge1(KA(), tid); SEAM(pb + 4);
        if (PH_EN(5) && IN(pb + 5)) f_merge2(KA(), tid); SEAM(pb + 5);
        if (PH_EN(6) && IN(pb + 6)) f_out(KA(), tid, l); SEAM(pb + 6);
        if (PH_EN(7) && IN(pb + 7)) f_router(KA(), tid, l); SEAM(pb + 7);
        if (PH_EN(8) && IN(pb + 8)) f_gather(KA(), tid, l); SEAM(pb + 8);
        if (PH_EN(9) && IN(pb + 9)) f_moe_gu(KA(), tid, l); SEAM(pb + 9);
        if (PH_EN(10) && IN(pb + 10)) f_moe_down(KA(), tid, l); SEAM(pb + 10);
    }
    if (IN(NPHASES - 1)) f_final(KA(), tid);
#undef IN
#undef SEAM
}

extern "C" void kernel_launch(void* const* d_in, const int* in_sizes, int n_in, void* d_out, int out_size, void* d_ws, size_t ws_size, hipStream_t stream) {
    static int grid = 0;
    if (grid == 0) {
        if (n_in != 23 || out_size != NTOK * DM || ws_size < WS_END) { fprintf(stderr, "kernel_launch: unexpected shapes (n_in %d out %d ws %zu)\n", n_in, out_size, ws_size); grid = -1; return; }
        int dev = 0, cus = 0, per_cu = 0;
        if (hipGetDevice(&dev) != hipSuccess || hipDeviceGetAttribute(&cus, hipDeviceAttributeMultiprocessorCount, dev) != hipSuccess) { grid = -1; return; }
        if (hipFuncSetAttribute((const void*)mk_fwd, hipFuncAttributeMaxDynamicSharedMemorySize, LDS_BYTES) != hipSuccess) { fprintf(stderr, "kernel_launch: hipFuncSetAttribute failed\n"); grid = -1; return; }
        if (hipOccupancyMaxActiveBlocksPerMultiprocessor(&per_cu, (const void*)mk_fwd, NTHR, LDS_BYTES) != hipSuccess || per_cu < 1) { fprintf(stderr, "kernel_launch: occupancy query says %d\n", per_cu); (void)hipGetLastError(); grid = -1; return; }
        grid = cus;
    }
    if (grid < 0) return;
    (void)hipMemsetAsync((char*)d_ws + WS_CTL, 0, CTL_ZERO_BYTES, stream);
    Args a{};
    for (int i = 0; i < 23; ++i) a.in[i] = (const float*)d_in[i];
    a.out = (float*)d_out; a.ws = (unsigned char*)d_ws;
#if MK_ONE_LAUNCH
    a.ph_lo = 0; a.ph_hi = NPHASES;
    hipLaunchKernelGGL(mk_fwd, dim3(grid), dim3(NTHR), LDS_BYTES, stream, a);
#else
    for (int p = 0; p < NPHASES; ++p) { a.ph_lo = p; a.ph_hi = p + 1; hipLaunchKernelGGL(mk_fwd, dim3(grid), dim3(NTHR), LDS_BYTES, stream, a); }
#endif
}
```

```cpp
#include <hip/hip_runtime.h>
#include <cstdio>
#include <cstdint>
#ifndef MK_ONE_LAUNCH
#define MK_ONE_LAUNCH 1
#endif
#ifndef MK_PROBE_A
#define MK_PROBE_A -1
#endif
#ifndef MK_PROBE_B
#define MK_PROBE_B -1
#endif
namespace pg8 {
#define PG8_LAS __attribute__((address_space(3)))
typedef unsigned short bf16_t;
typedef short bf16x8 __attribute__((ext_vector_type(8)));
typedef float f32x4 __attribute__((ext_vector_type(4)));
typedef unsigned u32x4 __attribute__((ext_vector_type(4)));
constexpr int BM = 256, BK = 64, HALF = 128, HTB = HALF * BK * 2  , STAGE_BYTES = 8 * HTB, NXCD = 8, WGM = 8;

__host__ __device__ __forceinline__ int lds_byte(int r, int c) { const int st = (r >> 4) * 2 + (c >> 5), rr = r & 15, cc = c & 31, ob = rr * 64 + cc * 2; return st * 1024 + (ob ^ (((ob >> 9) & 1) << 5)); }
__host__ __device__ __forceinline__ void stage_rc(int b, int& R, int& C) { const int st = b / 1024, sb = b % 1024, swz = sb ^ (((sb >> 9) & 1) << 5); R = (st >> 1) * 16 + swz / 64; C = (st & 1) * 32 + (swz % 64) / 2; }
__host__ __device__ __forceinline__ int perm32(int rho) { const int n = rho >> 4, i = rho & 15; return 8 * (i >> 2) + 4 * n + (i & 3); }

struct Unit { int pm, pn; };
struct Gemm { const bf16_t* A; const bf16_t* Bt; int M, N, K; };

struct StaticOrder {
    int nM, nN, nwg, G, c;
    __host__ __device__ void init(int M, int N, int G_, int c_) { nM = M / BM; nN = N / BM; nwg = nM * nN; G = G_; c = c_; }
    __host__ __device__ bool next(int i, Unit& u) const {
        const long L = (long)i * G + c; if (L >= nwg) return false;
        int wgid = (int)L; { const int q = nwg / NXCD, r = nwg % NXCD, xcd = wgid % NXCD, off = wgid / NXCD; wgid = (xcd < r ? xcd * (q + 1) : r * (q + 1) + (xcd - r) * q) + off; }
        const int nig = WGM * nN, gid = wgid / nig, fm = gid * WGM, gsz = (nM - fm) < WGM ? (nM - fm) : WGM;
        u.pm = fm + ((wgid % nig) % gsz); u.pn = (wgid % nig) / gsz; return true;
    }
    __device__ __forceinline__ void a_ready(const Unit&) const {}
    __device__ __forceinline__ void done(const Unit&) const {}
};

__device__ __forceinline__ unsigned cvt_pk_bf16(float lo, float hi) { unsigned r; asm volatile("v_cvt_pk_bf16_f32 %0, %1, %2" : "=v"(r) : "v"(lo), "v"(hi)); return r; }
typedef float f32x2 __attribute__((ext_vector_type(2)));
template <class Epi, class Sched, bool ALIGN_EPI = false, bool SP2 = false>
__device__ __forceinline__ void gemm_phase(PG8_LAS unsigned char* lds, const Gemm g, const Sched& S, const Epi& E, const int tid_in) {
    const int tid = tid_in, wid = __builtin_amdgcn_readfirstlane(tid >> 6), lane = tid & 63, wr = wid >> 2, wc = wid & 3, fr = lane & 15, fq = lane >> 4;
    const int K = g.K, nt = K / BK;
    unsigned voffA[2], voffB[2];
#pragma unroll
    for (int i = 0; i < 2; ++i) { int R, C; stage_rc(tid * 16 + i * 8192, R, C); const int Rb = Epi::PERM ? ((R & ~31) + perm32(R & 31)) : R;
        voffA[i] = (unsigned)(R * K + C) * 2u; voffB[i] = (unsigned)(Rb * K + C) * 2u; }
    const size_t kstep = (size_t)(BK * 2);
    const size_t hstep = (size_t)HALF * K * 2;
    const size_t tstep = 2 * hstep;
    const unsigned ldsw = (unsigned)wid * 1024u;
    const int aoff = lds_byte(wr * 64 + fr, fq * 8), boff = lds_byte(wc * 32 + fr, fq * 8);
#define PG8_SA(b, h) (((b) * 2 + (h)) * HTB)
#define PG8_SB(b, h) ((4 + (b) * 2 + (h)) * HTB)
#define PG8_STAGE(bufoff, gbase, voff) do { _Pragma("unroll") for (int _i = 0; _i < 2; ++_i) \
        __builtin_amdgcn_global_load_lds((const unsigned*)((const char*)(gbase) + (voff)[_i]), (PG8_LAS unsigned*)(lds + (bufoff) + ldsw + _i * 8192), 16, 0, 0); } while (0)
#define PG8_LDA(dst, b, h) do { _Pragma("unroll") for (int m = 0; m < 4; ++m) _Pragma("unroll") for (int k = 0; k < 2; ++k) dst[m][k] = *(const PG8_LAS bf16x8*)(lds + PG8_SA(b, h) + aoff + m * 2048 + k * 1024); } while (0)
#define PG8_LDB(dst, b, h) do { _Pragma("unroll") for (int n = 0; n < 2; ++n) _Pragma("unroll") for (int k = 0; k < 2; ++k) dst[n][k] = *(const PG8_LAS bf16x8*)(lds + PG8_SB(b, h) + boff + n * 2048 + k * 1024); } while (0)
#define PG8_MMA(ai, bj, At, Bt) do { __builtin_amdgcn_s_setprio(1); _Pragma("unroll") for (int m = 0; m < 4; ++m) _Pragma("unroll") for (int n = 0; n < 2; ++n) _Pragma("unroll") for (int k = 0; k < 2; ++k) \
        acc[ai][bj][m][n] = __builtin_amdgcn_mfma_f32_16x16x32_bf16(Bt[n][k], At[m][k], acc[ai][bj][m][n], 0, 0, 0); __builtin_amdgcn_s_setprio(0); } while (0)
#define PG8_WAIT_V(n) asm volatile("s_waitcnt vmcnt(" #n ")" ::: "memory")
#define PG8_WAIT_L(n) asm volatile("s_waitcnt lgkmcnt(" #n ")" ::: "memory")
#define PG8_BAR __builtin_amdgcn_s_barrier()
#define PG8_SCHED __builtin_amdgcn_sched_barrier(0)
    Unit cur, nxt; int ui = 0;
    if (!S.next(0, cur)) return;
    f32x4 acc[2][2][4][2];
    float zf_ = 0.f; asm volatile("" : "+v"(zf_));
#pragma unroll
    for (int a = 0; a < 2; ++a)
#pragma unroll
        for (int b = 0; b < 2; ++b)
#pragma unroll
            for (int m = 0; m < 4; ++m)
#pragma unroll
                for (int n = 0; n < 2; ++n) acc[a][b][m][n] = (f32x4){zf_, zf_, zf_, zf_};
    bf16x8 At[4][2], B0[2][2], B1[2][2];
    const char* cA = (const char*)g.A + (size_t)cur.pm * tstep; const char* cB = (const char*)g.Bt + (size_t)cur.pn * tstep;
    S.a_ready(cur);
    if constexpr (SP2) {
        PG8_STAGE(PG8_SB(0, 0), cB, voffB); PG8_STAGE(PG8_SB(0, 1), cB + hstep, voffB); PG8_STAGE(PG8_SA(0, 0), cA, voffA); PG8_STAGE(PG8_SA(0, 1), cA + hstep, voffA);
        if (wr == 1) PG8_BAR;
        PG8_WAIT_V(2); PG8_BAR;
        PG8_STAGE(PG8_SB(1, 0), cB + kstep, voffB); PG8_STAGE(PG8_SA(1, 0), cA + kstep, voffA); PG8_STAGE(PG8_SB(1, 1), cB + hstep + kstep, voffB);
        PG8_WAIT_V(6); PG8_BAR;
    } else {
        PG8_STAGE(PG8_SB(0, 0), cB, voffB); PG8_STAGE(PG8_SA(0, 0), cA, voffA); PG8_STAGE(PG8_SB(0, 1), cB + hstep, voffB); PG8_STAGE(PG8_SA(0, 1), cA + hstep, voffA);
        if (wr == 1) PG8_BAR;
        PG8_WAIT_V(4); PG8_BAR;
        PG8_STAGE(PG8_SB(1, 0), cB + kstep, voffB); PG8_STAGE(PG8_SA(1, 0), cA + kstep, voffA); PG8_STAGE(PG8_SB(1, 1), cB + hstep + kstep, voffB);
        PG8_WAIT_V(6); PG8_BAR;
    }
    for (;;) {
        const bool has_next = S.next(ui + 1, nxt);
        const char* nA = has_next ? (const char*)g.A + (size_t)nxt.pm * tstep : cA; const char* nB = has_next ? (const char*)g.Bt + (size_t)nxt.pn * tstep : cB;
        for (int t = 0; t < nt; t += 2) {
            const bool last = (t == nt - 2);
            const char* a1 = cA + (size_t)(t + 1) * kstep;
            const char* a2 = last ? nA : cA + (size_t)(t + 2) * kstep; const char* b2 = last ? nB : cB + (size_t)(t + 2) * kstep;
            const char* a3 = a2 + kstep; const char* b3 = b2 + kstep;
            if (last && has_next) S.a_ready(nxt);
            if constexpr (SP2) {
            PG8_LDB(B0, 0, 0); PG8_LDB(B1, 0, 1); PG8_SCHED; PG8_LDA(At, 0, 0); PG8_STAGE(PG8_SA(1, 1), a1 + hstep, voffA);
            PG8_WAIT_V(8); PG8_WAIT_L(0); PG8_BAR; PG8_MMA(0, 0, At, B0); PG8_MMA(0, 1, At, B1); PG8_BAR; PG8_SCHED;
            PG8_LDA(At, 0, 1); PG8_STAGE(PG8_SB(0, 0), b2, voffB); PG8_STAGE(PG8_SB(0, 1), b2 + hstep, voffB); PG8_STAGE(PG8_SA(0, 0), a2, voffA);
            PG8_WAIT_V(8); PG8_WAIT_L(0); PG8_BAR; PG8_MMA(1, 0, At, B0); PG8_MMA(1, 1, At, B1); PG8_BAR; PG8_SCHED;
            PG8_LDB(B0, 1, 0); PG8_LDB(B1, 1, 1); PG8_SCHED; PG8_LDA(At, 1, 0); PG8_STAGE(PG8_SA(0, 1), a2 + hstep, voffA);
            PG8_WAIT_V(8); PG8_WAIT_L(0); PG8_BAR; PG8_MMA(0, 0, At, B0); PG8_MMA(0, 1, At, B1); PG8_BAR; PG8_SCHED;
            PG8_LDA(At, 1, 1); PG8_STAGE(PG8_SB(1, 0), b3, voffB); PG8_STAGE(PG8_SB(1, 1), b3 + hstep, voffB); PG8_STAGE(PG8_SA(1, 0), a3, voffA);
            PG8_WAIT_V(8); PG8_WAIT_L(0); PG8_BAR; PG8_MMA(1, 0, At, B0); PG8_MMA(1, 1, At, B1); PG8_BAR; PG8_SCHED;
            } else {
            PG8_LDB(B0, 0, 0); PG8_SCHED; PG8_LDA(At, 0, 0); PG8_STAGE(PG8_SA(1, 1), a1 + hstep, voffA);
            PG8_WAIT_L(8); PG8_BAR; PG8_WAIT_L(0); PG8_MMA(0, 0, At, B0); PG8_BAR; PG8_SCHED;
            PG8_LDB(B1, 0, 1); PG8_STAGE(PG8_SB(0, 0), b2, voffB);
            PG8_BAR; PG8_WAIT_L(0); PG8_MMA(0, 1, At, B1); PG8_BAR;
            PG8_LDA(At, 0, 1); PG8_STAGE(PG8_SA(0, 0), a2, voffA);
            PG8_BAR; PG8_WAIT_L(0); PG8_MMA(1, 0, At, B0); PG8_BAR; PG8_SCHED;
            PG8_STAGE(PG8_SB(0, 1), b2 + hstep, voffB);
            PG8_WAIT_V(6); PG8_BAR; PG8_MMA(1, 1, At, B1); PG8_BAR;
            PG8_LDB(B0, 1, 0); PG8_SCHED; PG8_LDA(At, 1, 0); PG8_STAGE(PG8_SA(0, 1), a2 + hstep, voffA);
            PG8_WAIT_L(8); PG8_BAR; PG8_WAIT_L(0); PG8_MMA(0, 0, At, B0); PG8_BAR; PG8_SCHED;
            PG8_LDB(B1, 1, 1); PG8_STAGE(PG8_SB(1, 0), b3, voffB);
            PG8_BAR; PG8_WAIT_L(0); PG8_MMA(0, 1, At, B1); PG8_BAR;
            PG8_LDA(At, 1, 1); PG8_STAGE(PG8_SA(1, 0), a3, voffA);
            PG8_BAR; PG8_WAIT_L(0); PG8_MMA(1, 0, At, B0); PG8_BAR; PG8_SCHED;
            PG8_STAGE(PG8_SB(1, 1), b3 + hstep, voffB);
            PG8_WAIT_V(6); PG8_BAR; PG8_MMA(1, 1, At, B1); PG8_BAR;
            }
        }
        if constexpr (ALIGN_EPI) { if (wr == 0) PG8_BAR; }
        if constexpr (!Epi::AFTER_DRAIN) { int te_ = tid_in; asm volatile("" : "+v"(te_)); E(acc, cur, wr, wc, te_ & 15, (te_ & 63) >> 4); S.done(cur); }
        if (!has_next) break;
        zf_ = 0.f; asm volatile("" : "+v"(zf_));
#pragma unroll
        for (int a = 0; a < 2; ++a)
#pragma unroll
            for (int b = 0; b < 2; ++b)
#pragma unroll
                for (int m = 0; m < 4; ++m)
#pragma unroll
                    for (int n = 0; n < 2; ++n) acc[a][b][m][n] = (f32x4){zf_, zf_, zf_, zf_};
        cur = nxt; cA = nA; cB = nB; ++ui;
        if constexpr (ALIGN_EPI) { if (wr == 1) PG8_BAR; }
    }
    PG8_WAIT_V(0);
    if constexpr (!ALIGN_EPI) { if (wr == 0) PG8_BAR; }
    PG8_BAR;
    if constexpr (Epi::AFTER_DRAIN) { E.fused(acc, cur, wr, wc, fr, fq, lds, wid, lane); S.done(cur); }
#undef PG8_SA
#undef PG8_SB
#undef PG8_STAGE
#undef PG8_LDA
#undef PG8_LDB
#undef PG8_MMA
#undef PG8_WAIT_V
#undef PG8_WAIT_L
#undef PG8_BAR
#undef PG8_SCHED
}
}
constexpr int NW = 8, NTHR = 512;
constexpr int DM = 1024, NB = 4, SEQ = 4096, NTOK = NB * SEQ, NLAYER = 2;
constexpr int HA = 8, HDA = 64, WA = 512, MBLK = 256, NBLK = SEQ / MBLK;
constexpr int HB = 4, HDB = 128, WB = 512, CONVK = 4, DNC = 64, NCH = SEQ / DNC;
constexpr int NGRP = 4, EPG = 8, NEXP = 32, DFF = 256;
constexpr int DIN = 5640, DINP = 5632, NMOD = 6;
constexpr int C_QKVA = 0, C_QKVB = 1536, C_ZB = 3072, C_BA = 3584, C_GATE = 3592;
constexpr float EPS = 1e-6f;
constexpr int MOE_MAXROWS = 2 * NTOK + NEXP * 256;
constexpr int MOE_MAXTILES = MOE_MAXROWS / 256;

constexpr size_t MiB = 1u << 20;
constexpr size_t WS_CTL = 0, CTL_ZERO_BYTES = 1 * MiB;
constexpr size_t WS_MOD = 1 * MiB;
constexpr size_t WS_WIN = 2 * MiB;
constexpr size_t WS_WUPA = 13 * MiB, WS_WUPB = 14 * MiB;
constexpr size_t WS_WOUT = 15 * MiB;
constexpr size_t WS_WEGU = 17 * MiB;
constexpr size_t WS_WED = 49 * MiB;
constexpr size_t WS_SMALL = 65 * MiB;
constexpr size_t WS_KMEAN = WS_SMALL;
constexpr size_t WS_BETA = WS_SMALL + 256 * 1024;
constexpr size_t WS_GLOG = WS_SMALL + 512 * 1024;
constexpr size_t WS_TOKINFO = WS_SMALL + 1 * MiB;
constexpr size_t WS_ROWTOK = WS_SMALL + 2 * MiB;
constexpr size_t WS_ROWW = WS_SMALL + 3 * MiB;
constexpr size_t WS_GL = WS_SMALL + 4 * MiB;
constexpr size_t WS_SSQ = WS_SMALL + 5 * MiB;
constexpr size_t WS_H = 72 * MiB;
constexpr size_t WS_QKVA = 104 * MiB;
constexpr size_t WS_QKVB = 152 * MiB;
constexpr size_t WS_ZB = 200 * MiB;
constexpr size_t WS_GATES = 216 * MiB;
constexpr size_t WS_IMG = 280 * MiB;
constexpr size_t WS_YA = 72 * MiB, WS_YB = 336 * MiB;
constexpr size_t WS_END = 352 * MiB;
constexpr size_t WS_M = WS_QKVB;
constexpr size_t WS_U = 88 * MiB;
constexpr size_t WS_HS = WS_QKVA;
constexpr size_t WS_ACT = 184 * MiB;
constexpr size_t WS_YS = WS_GATES;
constexpr int CW_TMO = 0;
constexpr int CW_BAR = 4096;
constexpr int CW_GCNT = 8192;
constexpr int CW_CCTR = 8448;
constexpr int CW_ACTR = 8320;

constexpr int RING_BYTES = 131072;
constexpr int MISC_OFF = 147456;
constexpr int LDS_BYTES = 151552;

#define GAS __attribute__((address_space(1)))
#define LAS __attribute__((address_space(3)))
typedef unsigned short bf16;
typedef unsigned v4u __attribute__((ext_vector_type(4)));
typedef unsigned v2u __attribute__((ext_vector_type(2)));
typedef float f32x4 __attribute__((ext_vector_type(4)));
typedef float f32x16 __attribute__((ext_vector_type(16)));
typedef short bf16x8 __attribute__((ext_vector_type(8)));
typedef GAS unsigned gu32;
#define RLX_AGENT __ATOMIC_RELAXED, __HIP_MEMORY_SCOPE_AGENT
#define LDS_WAIT() asm volatile("s_waitcnt lgkmcnt(0)" ::: "memory")
#define VM_WAIT() asm volatile("s_waitcnt vmcnt(0)" ::: "memory")
__device__ __forceinline__ unsigned f2bf(float f) { unsigned u = __builtin_bit_cast(unsigned, f); return (u + 0x7fffu + ((u >> 16) & 1u)) >> 16; }
__device__ __forceinline__ unsigned pk2(float lo, float hi) { return f2bf(lo) | (f2bf(hi) << 16); }
__device__ __forceinline__ float bf2f(unsigned b) { return __builtin_bit_cast(float, b << 16); }
__device__ __forceinline__ float bflo(unsigned w) { return __builtin_bit_cast(float, w << 16); }
__device__ __forceinline__ float bfhi(unsigned w) { return __builtin_bit_cast(float, w & 0xffff0000u); }
__device__ __forceinline__ float rcpf_(float x) { return __builtin_amdgcn_rcpf(x); }
__device__ __forceinline__ float sigmoidf_(float x) { return rcpf_(1.f + __builtin_amdgcn_exp2f(-1.4426950408889634f * x)); }
__device__ __forceinline__ float siluf_(float x) { return x * rcpf_(1.f + __builtin_amdgcn_exp2f(-1.4426950408889634f * x)); }
__device__ __forceinline__ float shx(float v, int o, int lane) { return __builtin_bit_cast(float, __builtin_amdgcn_ds_bpermute((lane ^ o) << 2, __builtin_bit_cast(int, v))); }
__device__ __forceinline__ float shidx(float v, int src) { return __builtin_bit_cast(float, __builtin_amdgcn_ds_bpermute(src << 2, __builtin_bit_cast(int, v))); }
__device__ __forceinline__ int shidx_i(int v, int src) { return __builtin_amdgcn_ds_bpermute(src << 2, v); }
template <int CTRL> __device__ __forceinline__ float dpp_f(float v) { return __builtin_bit_cast(float, __builtin_amdgcn_update_dpp(0, __builtin_bit_cast(int, v), CTRL, 0xf, 0xf, true)); }
__device__ __forceinline__ float rdlane_f(float v, int l) { return __builtin_bit_cast(float, __builtin_amdgcn_readlane(__builtin_bit_cast(int, v), l)); }
__device__ __forceinline__ float wave_sum(float v, int) {
    v += dpp_f<0xB1>(v); v += dpp_f<0x4E>(v); v += dpp_f<0x141>(v); v += dpp_f<0x140>(v);
    return (rdlane_f(v, 0) + rdlane_f(v, 16)) + (rdlane_f(v, 32) + rdlane_f(v, 48));
}
__device__ __forceinline__ float wave_max(float v, int) {
    v = fmaxf(v, dpp_f<0xB1>(v)); v = fmaxf(v, dpp_f<0x4E>(v)); v = fmaxf(v, dpp_f<0x141>(v)); v = fmaxf(v, dpp_f<0x140>(v));
    return fmaxf(fmaxf(rdlane_f(v, 0), rdlane_f(v, 16)), fmaxf(rdlane_f(v, 32), rdlane_f(v, 48)));
}
__device__ const unsigned char T5B[128] = {0, 1, 2, 3, 4, 5, 6, 7, 8, 9, 10, 11, 12, 13, 14, 15, 16, 16, 16, 17, 17, 18, 18, 18, 19, 19, 19, 20, 20, 20, 20, 21, 21, 21, 21, 22, 22, 22, 22, 22, 23, 23, 23, 23, 23, 23, 24, 24, 24, 24, 24, 24, 25, 25, 25, 25, 25, 25, 25, 26, 26, 26, 26, 26, 26, 26, 26, 27, 27, 27, 27, 27, 27, 27, 27, 27, 27, 28, 28, 28, 28, 28, 28, 28, 28, 28, 28, 29, 29, 29, 29, 29, 29, 29, 29, 29, 29, 29, 29, 30, 30, 30, 30, 30, 30, 30, 30, 30, 30, 30, 30, 30, 30, 31, 31, 31, 31, 31, 31, 31, 31, 31, 31, 31, 31, 31, 31, 31};

#define XB_TMO      128
#define XB_XCNT(j)  (256  + 64 * (j))
#define XB_XSUB(j)  (1280 + 64 * (j))
#define XB_XGEN(j)  (2304 + 64 * (j))
#define XB_TOP      3328
#define XB_TOPGEN   3392
#define XCD_BAR_WORDS 3456
#define XB_SPIN_CAP (1u << 18)

__device__ __forceinline__ unsigned xb_ld(unsigned* p)              { return __hip_atomic_load(p, __ATOMIC_RELAXED, __HIP_MEMORY_SCOPE_AGENT); }
__device__ __forceinline__ unsigned xb_add(unsigned* p, unsigned v) { return __hip_atomic_fetch_add(p, v, __ATOMIC_RELAXED, __HIP_MEMORY_SCOPE_AGENT); }
__device__ __forceinline__ unsigned xb_xcc_id() { return (unsigned)__builtin_amdgcn_s_getreg((3 << 11) | 20) & 0xFu; }
#define XB_SPIN(cond, bar) do { unsigned _sp = 0; while (cond) { __builtin_amdgcn_s_sleep(1); \
    if ((++_sp & 255u) == 0u) { if (xb_ld(&(bar)[XB_TMO])) break; if (_sp > XB_SPIN_CAP) { atomicAdd(&(bar)[XB_TMO], 1u); break; } } } } while (0)

struct XcdBarrier {
    unsigned* bar; unsigned x;
    volatile LAS unsigned* st;
};

__device__ __forceinline__ XcdBarrier xcd_barrier_post(unsigned* bar, volatile LAS unsigned* st, const int tid_in) {
    XcdBarrier b; b.bar = bar; b.x = xb_xcc_id(); b.st = st;
    if (tid_in == 0) (void)xb_add(&bar[XB_XCNT(b.x)], 1u);
    return b;
}
__device__ __forceinline__ void xcd_barrier_complete(unsigned* bar, unsigned x, unsigned& nloc, unsigned& nx) {
    const unsigned G = gridDim.x * gridDim.y * gridDim.z;
    unsigned sum, cnt, mine, sp = 0u;
    for (;;) {
        sum = 0u; cnt = 0u; mine = 0u;
#pragma unroll
        for (unsigned j = 0; j < 16; ++j) { const unsigned c = xb_ld(&bar[XB_XCNT(j)]); sum += c; cnt += (c > 0u) ? 1u : 0u; mine = (j == x) ? c : mine; }
        if (sum == G) break;
        __builtin_amdgcn_s_sleep(1);
        if ((++sp & 255u) == 0u) { if (xb_ld(&bar[XB_TMO])) break; if (sp > XB_SPIN_CAP) { atomicAdd(&bar[XB_TMO], 1u); break; } }
    }
    nloc = mine > 0u ? mine : 1u; nx = cnt > 0u ? cnt : 1u;
}

__device__ __forceinline__ void xcd_barrier(const XcdBarrier& b, const int tid_in) {
    asm volatile("s_waitcnt vmcnt(0)" ::: "memory");
    __syncthreads();
    if (tid_in == 0) {
        unsigned* bar = b.bar;
        __builtin_amdgcn_s_waitcnt(0);
        unsigned nloc = b.st[0], nx = b.st[1];
        if (nloc == 0u) { xcd_barrier_complete(bar, b.x, nloc, nx); b.st[0] = nloc; b.st[1] = nx; }
        const unsigned old = xb_add(&bar[XB_XSUB(b.x)], 1u);
        const unsigned gen = old / nloc;
        if (old + 1u == (gen + 1u) * nloc) {
            __builtin_amdgcn_fence(__ATOMIC_RELEASE, "agent");
            asm volatile("s_waitcnt vmcnt(0)" ::: "memory");
            const unsigned og = xb_add(&bar[XB_TOP], 1u);
            const unsigned tg = og / nx;
            if (og + 1u == (tg + 1u) * nx) xb_add(&bar[XB_TOPGEN], 1u);
            else XB_SPIN(xb_ld(&bar[XB_TOPGEN]) == tg, bar);
            __builtin_amdgcn_fence(__ATOMIC_ACQUIRE, "agent");
            xb_add(&bar[XB_XGEN(b.x)], 1u);
            asm volatile("s_waitcnt vmcnt(0)" ::: "memory");
        } else {
            XB_SPIN(xb_ld(&bar[XB_XGEN(b.x)]) == gen, bar);
            __builtin_amdgcn_fence(__ATOMIC_ACQUIRE, "agent");
            asm volatile("s_waitcnt vmcnt(0)" ::: "memory");
        }
    }
    __syncthreads();
}
struct Args { const float* in[23]; float* out; unsigned char* ws; int ph_lo, ph_hi; };
enum { I_X = 0, I_C, I_RELB, I_FNW, I_N1W, I_N2W, I_WMOD, I_BMOD, I_WIN, I_CONVW, I_ALOG, I_DTB, I_ONW, I_WUPA, I_WUPB, I_WOUT, I_WRG, I_BRG, I_WRE, I_BRE, I_WEG, I_WEU, I_WED };

typedef const Args __attribute__((address_space(4)))* KArgs;
struct Ctx { LAS unsigned char* lds; int tid, lane, wave, bid, G; };
extern __shared__ __attribute__((aligned(16))) unsigned char lds_raw[];
__device__ __forceinline__ Ctx make_ctx(int& tid) { Ctx c; c.lds = (LAS unsigned char*)lds_raw; asm volatile("" : "+v"(tid)); const int t = tid; c.tid = t; c.lane = t & 63; c.wave = __builtin_amdgcn_readfirstlane(t >> 6); int bi = blockIdx.x, gd = gridDim.x; asm volatile("" : "+s"(bi), "+s"(gd)); c.bid = bi; c.G = gd; return c; }

__device__ __forceinline__ void ph_mod(KArgs a, const Ctx& c) {
    LAS float* cact = (LAS float*)c.lds;
    LAS float* red = (LAS float*)(c.lds + 16384);
    const float* cin = a->in[I_C];
    for (int i = c.tid; i < 4096; i += NTHR) cact[i] = siluf_(cin[i]);
    __syncthreads();
    float* mod = (float*)(a->ws + WS_MOD);
    for (int item = c.bid; item < 192; item += c.G) {
        const int l = item / 96, j0 = (item % 96) * 64;
        const float* W = a->in[I_WMOD] + (size_t)l * 1024 * 6144 + j0 + c.lane;
        float a0 = 0.f, a1 = 0.f, a2 = 0.f, a3 = 0.f;
        const int k0 = c.wave * 128;
#pragma unroll 8
        for (int k = k0; k < k0 + 128; ++k) { const float w = W[(size_t)k * 6144]; a0 += cact[k] * w; a1 += cact[1024 + k] * w; a2 += cact[2048 + k] * w; a3 += cact[3072 + k] * w; }
        red[(c.wave * 4 + 0) * 64 + c.lane] = a0; red[(c.wave * 4 + 1) * 64 + c.lane] = a1; red[(c.wave * 4 + 2) * 64 + c.lane] = a2; red[(c.wave * 4 + 3) * 64 + c.lane] = a3;
        __syncthreads();
        if (c.tid < 256) { const int b = c.tid >> 6, ln = c.tid & 63; float s = 0.f;
#pragma unroll
            for (int w = 0; w < 8; ++w) s += red[(w * 4 + b) * 64 + ln];
            mod[(l * 4 + b) * 6144 + j0 + ln] = s + a->in[I_BMOD][l * 6144 + j0 + ln]; }
        __syncthreads();
    }
}

__device__ __forceinline__ void tr_item(const float* src, int ld, bf16* dst, int K, int nblk, LAS float* scr, int item, int lane) {
    const int kb = item / nblk, nb = item % nblk, k0 = 64 * kb, n0 = 32 * nb;
    float tv[32];
    const unsigned voff = (unsigned)((lane >> 5) * ld + (lane & 31));
#pragma unroll
    for (int i = 0; i < 32; ++i) { const float* rowp = src + (size_t)(k0 + 2 * i) * ld + n0; tv[i] = rowp[voff]; }
#pragma unroll
    for (int i = 0; i < 32; ++i) scr[(2 * i + (lane >> 5)) * 33 + (lane & 31)] = tv[i];
    LDS_WAIT(); asm volatile("" ::: "memory");
    const int cc = lane & 7;
#pragma unroll
    for (int j = 0; j < 4; ++j) { const int n = (lane >> 3) + 8 * j; const LAS float* s = scr + (8 * cc) * 33 + n;
        v4u o; o.x = pk2(s[0 * 33], s[1 * 33]); o.y = pk2(s[2 * 33], s[3 * 33]); o.z = pk2(s[4 * 33], s[5 * 33]); o.w = pk2(s[6 * 33], s[7 * 33]);
        *(v4u*)(dst + (size_t)(n0 + n) * K + k0 + 8 * cc) = o; }
    LDS_WAIT(); asm volatile("" ::: "memory");
}
constexpr int CV_I0 = 1792, CV_I1 = 1024, CV_I2 = 256, CV_I3 = 256, CV_I4 = 512, CV_I5 = 4096, CV_I6 = 4096, CV_I7 = 4096;
constexpr int CV_NIT = CV_I0 + CV_I1 + CV_I2 + CV_I3 + CV_I4 + CV_I5 + CV_I6 + CV_I7, CV_EARLY = CV_I0 + CV_I1;
__device__ __forceinline__ void convert_item(KArgs a, int l, int it, LAS float* scr, int lane) {
    bf16* WIN = (bf16*)(a->ws + WS_WIN); bf16* WEGU = (bf16*)(a->ws + WS_WEGU); bf16* WEDT = (bf16*)(a->ws + WS_WED);
    const float* win = a->in[I_WIN] + (size_t)l * 1024 * DIN;
    int r = it;
    if (r < CV_I0) { tr_item(win, DIN, WIN, 1024, 112, scr, r, lane); return; } r -= CV_I0;
    if (r < CV_I1) { tr_item(win + C_GATE, DIN, WIN + (size_t)C_BA * 1024, 1024, 64, scr, r, lane); return; } r -= CV_I1;
    if (r < CV_I2) { tr_item(a->in[I_WUPA] + (size_t)l * 512 * 1024, 1024, (bf16*)(a->ws + WS_WUPA), 512, 32, scr, r, lane); return; } r -= CV_I2;
    if (r < CV_I3) { tr_item(a->in[I_WUPB] + (size_t)l * 512 * 1024, 1024, (bf16*)(a->ws + WS_WUPB), 512, 32, scr, r, lane); return; } r -= CV_I3;
    if (r < CV_I4) { tr_item(a->in[I_WOUT] + (size_t)l * 1024 * 1024, 1024, (bf16*)(a->ws + WS_WOUT), 1024, 32, scr, r, lane); return; } r -= CV_I4;
    if (r < CV_I5) { const int E = r >> 7, rem = r & 127, pn = rem >> 6, q = rem & 63;
        tr_item(a->in[I_WEG] + ((size_t)(l * 32 + E) * 1024 * 256) + 128 * pn, 256, WEGU + (size_t)(E * 512 + 256 * pn) * 1024, 1024, 4, scr, q, lane); return; } r -= CV_I5;
    if (r < CV_I6) { const int E = r >> 7, rem = r & 127, pn = rem >> 6, q = rem & 63;
        tr_item(a->in[I_WEU] + ((size_t)(l * 32 + E) * 1024 * 256) + 128 * pn, 256, WEGU + (size_t)(E * 512 + 256 * pn + 128) * 1024, 1024, 4, scr, q, lane); return; } r -= CV_I6;
    { const int E = r >> 7, q = r & 127;
        tr_item(a->in[I_WED] + ((size_t)(l * 32 + E) * 256 * 1024), 1024, WEDT + (size_t)E * 1024 * 256, 256, 32, scr, q, lane); }
}
__device__ __forceinline__ void ph_convert(KArgs a, const Ctx& c, int l) {
    LAS float* scr = (LAS float*)(c.lds + 32768 + c.wave * 10240);
    const int gw = c.bid * NW + c.wave, NGW = c.G * NW;
    for (int it = gw; it < CV_EARLY; it += NGW) convert_item(a, l, it, scr, c.lane);
}
constexpr int CV_UNIT = 64, CV_NUNITS = (CV_NIT - CV_EARLY) / CV_UNIT;
static_assert((CV_NIT - CV_EARLY) % CV_UNIT == 0, "convert units");
constexpr int CV_EARLYQ = 112;
__device__ __forceinline__ void convert_unit(KArgs a, const Ctx& c, int l, int cu) {
    LAS float* scr = (LAS float*)(c.lds + 32768 + c.wave * 10240);
    int ln = c.lane; asm volatile("" : "+v"(ln));
#pragma unroll 1
    for (int i = 0; i < 8; ++i) convert_item(a, l, CV_EARLY + cu * CV_UNIT + c.wave * 8 + i, scr, ln);
}

__device__ __forceinline__ void load_row_x(KArgs a, int l, int m, int lane, f32x4 (&v)[4]) {
    const float* xr = (l == 0 ? a->in[I_X] : (const float*)a->out) + (size_t)m * DM;
#pragma unroll
    for (int j = 0; j < 4; ++j) v[j] = *(const f32x4*)(xr + 256 * j + 4 * lane);
    if (l > 0) {
        const int b = m >> 12;
        const float* g2 = (const float*)(a->ws + WS_MOD) + ((l - 1) * 4 + b) * 6144 + 5120;
        const bf16* ys = (const bf16*)(a->ws + WS_YS) + (size_t)m * 2048;
#pragma unroll
        for (int j = 0; j < 4; ++j) { const int col = 256 * j + 4 * lane; const v2u y0 = *(const v2u*)(ys + col), y1 = *(const v2u*)(ys + 1024 + col); const f32x4 g = *(const f32x4*)(g2 + col);
            v[j].x += g.x * (bflo(y0.x) + bflo(y1.x)); v[j].y += g.y * (bfhi(y0.x) + bfhi(y1.x)); v[j].z += g.z * (bflo(y0.y) + bflo(y1.y)); v[j].w += g.w * (bfhi(y0.y) + bfhi(y1.y)); }
        float* xo = a->out + (size_t)m * DM;
#pragma unroll
        for (int j = 0; j < 4; ++j) *(f32x4*)(xo + 256 * j + 4 * lane) = v[j];
    }
}
__device__ __forceinline__ float row_rstd(const f32x4 (&v)[4], int lane) {
    float s = 0.f;
#pragma unroll
    for (int j = 0; j < 4; ++j) s += (v[j].x * v[j].x + v[j].y * v[j].y) + (v[j].z * v[j].z + v[j].w * v[j].w);
    return __builtin_amdgcn_rsqf(wave_sum(s, lane) * (1.f / DM) + EPS);
}
__device__ __forceinline__ void ph_norm1(KArgs a, const Ctx& c, int l) {
    LAS float* wbaT = (LAS float*)c.lds;
    const float* win = a->in[I_WIN] + (size_t)l * 1024 * DIN + C_BA;
    for (int i = c.tid; i < 8192; i += NTHR) { const int k = i >> 3, cc = i & 7; wbaT[cc * 1024 + k] = win[(size_t)k * DIN + cc]; }
    __syncthreads();
    const int gw = c.bid * NW + c.wave, NGW = c.G * NW, lane = c.lane;
    bf16* H = (bf16*)(a->ws + WS_H); float* beta = (float*)(a->ws + WS_BETA); float* glog = (float*)(a->ws + WS_GLOG);
    const float* n1w = a->in[I_N1W] + l * DM;
    for (int m = gw; m < NTOK; m += NGW) {
        f32x4 v[4]; load_row_x(a, l, m, lane, v);
        const float rstd = row_rstd(v, lane);
        const int b = m >> 12; const float* mod = (const float*)(a->ws + WS_MOD) + (l * 4 + b) * 6144;
        float acc[8];
#pragma unroll
        for (int q = 0; q < 8; ++q) acc[q] = 0.f;
#pragma unroll
        for (int j = 0; j < 4; ++j) { const int col = 256 * j + 4 * lane;
            const f32x4 nw = *(const f32x4*)(n1w + col), sh = *(const f32x4*)(mod + col), sc = *(const f32x4*)(mod + 1024 + col);
            f32x4 h = v[j] * rstd * nw * (sc + 1.0f) + sh;
            v2u o; o.x = pk2(h.x, h.y); o.y = pk2(h.z, h.w); *(v2u*)(H + (size_t)m * DM + col) = o;
#pragma unroll
            for (int q = 0; q < 8; ++q) { const f32x4 w4 = *(const LAS f32x4*)(wbaT + q * 1024 + col); acc[q] += (h.x * w4.x + h.y * w4.y) + (h.z * w4.z + h.w * w4.w); } }
#pragma unroll
        for (int q = 0; q < 8; ++q) acc[q] = wave_sum(acc[q], lane);
        if (lane < 4) {
            const float bb = lane == 0 ? acc[0] : lane == 1 ? acc[1] : lane == 2 ? acc[2] : acc[3];
            const float aa = lane == 0 ? acc[4] : lane == 1 ? acc[5] : lane == 2 ? acc[6] : acc[7];
            beta[m * 4 + lane] = sigmoidf_(bb);
            const float z = aa + a->in[I_DTB][l * 4 + lane]; const float sp = fmaxf(z, 0.f) + log1pf(__expf(-fabsf(z)));
            glog[m * 4 + lane] = -__expf(a->in[I_ALOG][l * 4 + lane]) * sp;
        }
    }
}
__device__ __forceinline__ void ph_final(KArgs a, const Ctx& c) {
    const int gw = c.bid * NW + c.wave, NGW = c.G * NW, lane = c.lane;
    const float* fw = a->in[I_FNW];
    for (int m = gw; m < NTOK; m += NGW) {
        f32x4 v[4];
        {
            const float* xr = (const float*)a->out + (size_t)m * DM; const int b = m >> 12;
            const float* g2 = (const float*)(a->ws + WS_MOD) + ((NLAYER - 1) * 4 + b) * 6144 + 5120;
            const bf16* ys = (const bf16*)(a->ws + WS_YS) + (size_t)m * 2048;
#pragma unroll
            for (int j = 0; j < 4; ++j) { const int col = 256 * j + 4 * lane; v[j] = *(const f32x4*)(xr + col);
                const v2u y0 = *(const v2u*)(ys + col), y1 = *(const v2u*)(ys + 1024 + col); const f32x4 g = *(const f32x4*)(g2 + col);
                v[j].x += g.x * (bflo(y0.x) + bflo(y1.x)); v[j].y += g.y * (bfhi(y0.x) + bfhi(y1.x)); v[j].z += g.z * (bflo(y0.y) + bflo(y1.y)); v[j].w += g.w * (bfhi(y0.y) + bfhi(y1.y)); }
        }
        float rstd = row_rstd(v, lane);
#if defined(MK_PROBE_A) && MK_PROBE_A >= 0
        {   const unsigned long long* ts = (const unsigned long long*)((const unsigned*)(a->ws + WS_CTL) + 12288);
            float tA = 0.f, tB = 0.f;
            for (int ly = 0; ly < NLAYER; ++ly) { const int ka = 1 + ly * 11 + MK_PROBE_A, kb = 1 + ly * 11 + MK_PROBE_B;
                if (MK_PROBE_A < 11) tA += (float)(ts[ka + 1] - ts[ka]) * 0.01f; if (MK_PROBE_B < 11) tB += (float)(ts[kb + 1] - ts[kb]) * 0.01f; }
            if (MK_PROBE_A == 20) { tA = 0.f; for (int ly = 0; ly < NLAYER; ++ly) tA += (float)(ts[40 + ly] - ts[1 + ly * 11 + 3]) * 0.01f; }
            if (MK_PROBE_A == 21) { tA = 0.f; for (int ly = 0; ly < NLAYER; ++ly) tA += (float)(ts[44 + ly] - ts[1 + ly * 11 + 3]) * 0.01f; }
            if (MK_PROBE_A >= 22 && MK_PROBE_A <= 24) { tA = 0.f; for (int ly = 0; ly < NLAYER; ++ly) tA += (float)ts[48 + ly * 4 + MK_PROBE_A - 22] * 0.01f; }
            if (MK_PROBE_B >= 22 && MK_PROBE_B <= 24) { tB = 0.f; for (int ly = 0; ly < NLAYER; ++ly) tB += (float)ts[48 + ly * 4 + MK_PROBE_B - 22] * 0.01f; }
            if (MK_PROBE_A >= 30 && MK_PROBE_A <= 36) { tA = 0.f; for (int ly = 0; ly < NLAYER; ++ly) tA += (float)ts[56 + ly] * 0.01f; }
            if (MK_PROBE_A >= 40 && MK_PROBE_A <= 42) { tA = 0.f; for (int ly = 0; ly < NLAYER; ++ly) tA += (float)ts[60 + ly] * 0.01f; }
            if (MK_PROBE_A == 11) tA = (float)(ts[1] - ts[0]) * 0.01f; if (MK_PROBE_A == 12) tA = (float)(ts[23] - ts[0]) * 0.01f;
            if (MK_PROBE_B == 11) tB = (float)(ts[1] - ts[0]) * 0.01f; if (MK_PROBE_B == 12) tB = (float)(ts[23] - ts[0]) * 0.01f;
            (void)tB;
            if (m == 0 && lane == 0) v[0].x += tA * 0.05f / rstd / fw[0]; }
#endif
        float* xo = a->out + (size_t)m * DM;
#pragma unroll
        for (int j = 0; j < 4; ++j) { const int col = 256 * j + 4 * lane; const f32x4 w = *(const f32x4*)(fw + col); *(f32x4*)(xo + col) = v[j] * rstd * w; }
    }
}

__device__ __forceinline__ void ph_kmean(KArgs a, const Ctx& c) {
    const int gw = c.bid * NW + c.wave, NGW = c.G * NW, lane = c.lane;
    const bf16* QKVA = (const bf16*)(a->ws + WS_QKVA); float* kmean = (float*)(a->ws + WS_KMEAN);
    for (int item = gw; item < NB * HA * NBLK; item += NGW) {
        const int nb = item & 15, h = (item >> 4) & 7, b = item >> 7;
        const int sub = lane & 7, rr = lane >> 3;
        float s[8];
#pragma unroll
        for (int q = 0; q < 8; ++q) s[q] = 0.f;
        const bf16* kp = QKVA + (size_t)(b * SEQ + nb * MBLK) * 1536 + 512 + h * 64 + sub * 8;
#pragma unroll 4
        for (int it = 0; it < 32; ++it) { const v4u w = *(const v4u*)(kp + (size_t)(it * 8 + rr) * 1536);
            s[0] += bflo(w.x); s[1] += bfhi(w.x); s[2] += bflo(w.y); s[3] += bfhi(w.y); s[4] += bflo(w.z); s[5] += bfhi(w.z); s[6] += bflo(w.w); s[7] += bfhi(w.w); }
#pragma unroll
        for (int q = 0; q < 8; ++q) { s[q] += shx(s[q], 8, lane); s[q] += shx(s[q], 16, lane); s[q] += shx(s[q], 32, lane); }
        if (lane < 8) { float* o = kmean + (size_t)item * 64 + sub * 8;
            *(f32x4*)o = (f32x4){s[0], s[1], s[2], s[3]} * (1.f / 256.f); *(f32x4*)(o + 4) = (f32x4){s[4], s[5], s[6], s[7]} * (1.f / 256.f); }
    }
}

__device__ __forceinline__ void ph_attn_simple(KArgs a, const Ctx& c) {
    const int gw = c.bid * NW + c.wave, NGW = c.G * NW, lane = c.lane;
    LAS float* btab = (LAS float*)(c.lds);
    LAS float* scw = (LAS float*)(c.lds + 8192) + c.wave * 1024;
    const float* relb = a->in[I_RELB];
    for (int i = c.tid; i < 8 * 129; i += NTHR) { const int h = i / 129, d = i % 129; btab[h * 132 + d] = relb[(d < 128 ? (int)T5B[d] : 31) * 8 + h]; }
    __syncthreads();
    const bf16* QKVA = (const bf16*)(a->ws + WS_QKVA); const float* kmean = (const float*)(a->ws + WS_KMEAN); bf16* YA = (bf16*)(a->ws + WS_YA);
    for (int r = gw; r < NB * HA * SEQ; r += NGW) {
        const int s = r & (SEQ - 1), h = (r >> 12) & 7, b = r >> 15, qb = s >> 8, tok = b * SEQ + s;
        float qv[64];
        { const bf16* qp = QKVA + (size_t)tok * 1536 + h * 64;
#pragma unroll
          for (int q = 0; q < 8; ++q) { const v4u w = *(const v4u*)(qp + q * 8); qv[q * 8 + 0] = bflo(w.x); qv[q * 8 + 1] = bfhi(w.x); qv[q * 8 + 2] = bflo(w.y); qv[q * 8 + 3] = bfhi(w.y); qv[q * 8 + 4] = bflo(w.z); qv[q * 8 + 5] = bfhi(w.z); qv[q * 8 + 6] = bflo(w.w); qv[q * 8 + 7] = bfhi(w.w); } }
        float gate = -1e30f;
        if (lane < qb) { const float* km = kmean + (size_t)(((b * 8 + h) * 16) + lane) * 64; float d = 0.f;
#pragma unroll
            for (int q = 0; q < 16; ++q) { const f32x4 k4 = *(const f32x4*)(km + q * 4); d += qv[q * 4] * k4.x + qv[q * 4 + 1] * k4.y + qv[q * 4 + 2] * k4.z + qv[q * 4 + 3] * k4.w; }
            gate = d; }
        unsigned selmask = 0u;
#pragma unroll
        for (int t = 0; t < 3; ++t) { float best = -3e38f; int bi = 0;
#pragma unroll
            for (int n = 0; n < 16; ++n) { const float gv = shidx(gate, n); if (!((selmask >> n) & 1u) && gv > best) { best = gv; bi = n; } }
            selmask |= 1u << bi; }
        selmask &= (1u << qb) - 1u;
        selmask |= 1u << qb;
        int nseg = 0; float mx = -3e38f;
        for (int blk = 0; blk <= qb; ++blk) {
            if (!((selmask >> blk) & 1u)) continue;
            for (int i = 0; i < 4; ++i) { const int key = blk * 256 + i * 64 + lane; const bf16* kp = QKVA + (size_t)(b * SEQ + key) * 1536 + 512 + h * 64; float d = 0.f;
#pragma unroll
                for (int q = 0; q < 8; ++q) { const v4u w = *(const v4u*)(kp + q * 8);
                    d += qv[q * 8] * bflo(w.x) + qv[q * 8 + 1] * bfhi(w.x) + qv[q * 8 + 2] * bflo(w.y) + qv[q * 8 + 3] * bfhi(w.y) + qv[q * 8 + 4] * bflo(w.z) + qv[q * 8 + 5] * bfhi(w.z) + qv[q * 8 + 6] * bflo(w.w) + qv[q * 8 + 7] * bfhi(w.w); }
                const int dist = s - key; float sc = d * 0.125f + btab[h * 132 + (dist < 0 ? 0 : (dist > 128 ? 128 : dist))];
                if (dist < 0) sc = -3e38f;
                scw[nseg * 256 + i * 64 + lane] = sc; mx = fmaxf(mx, sc); }
            ++nseg; }
        mx = wave_max(mx, lane);
        float sum = 0.f;
        for (int idx = lane; idx < nseg * 256; idx += 64) { const float sc = scw[idx]; const float e = sc < -1e37f ? 0.f : __expf(sc - mx); scw[idx] = e; sum += e; }
        sum = wave_sum(sum, lane);
        LDS_WAIT();
        float o = 0.f; int sg = 0;
        for (int blk = 0; blk <= qb; ++blk) {
            if (!((selmask >> blk) & 1u)) continue;
            const bf16* vp = QKVA + (size_t)(b * SEQ + blk * 256) * 1536 + 1024 + h * 64 + lane;
            const int lim = (blk == qb) ? (s & 255) + 1 : 256;
#pragma unroll 8
            for (int kk = 0; kk < lim; ++kk) o += scw[sg * 256 + kk] * bf2f(vp[(size_t)kk * 1536]);
            ++sg; }
        YA[(size_t)tok * 512 + h * 64 + lane] = (bf16)f2bf(o / sum);
    }
}

template <int LDW> __device__ __forceinline__ void dn_load_chunk(KArgs a, const Ctx& c, int l, int b, int h, int t0, LAS float* qs, LAS float* ks, LAS float* vs) {
    const bf16* QKVB = (const bf16*)(a->ws + WS_QKVB); const float* cw = a->in[I_CONVW] + (size_t)l * 4 * 1536;
    const int cg = c.tid & 15, r0 = c.tid >> 4;
#pragma unroll
    for (int part = 0; part < 3; ++part) {
        const int colb = part * 512 + h * 128 + 8 * cg;
        float w[4][8];
#pragma unroll
        for (int i = 0; i < 4; ++i) { const f32x4 w0 = *(const f32x4*)(cw + i * 1536 + colb), w1 = *(const f32x4*)(cw + i * 1536 + colb + 4);
            w[i][0] = w0.x; w[i][1] = w0.y; w[i][2] = w0.z; w[i][3] = w0.w; w[i][4] = w1.x; w[i][5] = w1.y; w[i][6] = w1.z; w[i][7] = w1.w; }
        LAS float* dst = part == 0 ? qs : part == 1 ? ks : vs;
#pragma unroll
        for (int pass = 0; pass < 2; ++pass) {
            const int r = r0 + 32 * pass, t = t0 + r;
            float y[8];
#pragma unroll
            for (int e = 0; e < 8; ++e) y[e] = 0.f;
#pragma unroll
            for (int i = 0; i < 4; ++i) { const int tt = t - 3 + i; if (tt >= 0) { const v4u x = *(const v4u*)(QKVB + (size_t)(b * SEQ + tt) * 1536 + colb);
                y[0] += w[i][0] * bflo(x.x); y[1] += w[i][1] * bfhi(x.x); y[2] += w[i][2] * bflo(x.y); y[3] += w[i][3] * bfhi(x.y); y[4] += w[i][4] * bflo(x.z); y[5] += w[i][5] * bfhi(x.z); y[6] += w[i][6] * bflo(x.w); y[7] += w[i][7] * bfhi(x.w); } }
            float ss = 0.f;
#pragma unroll
            for (int e = 0; e < 8; ++e) { y[e] = siluf_(y[e]); ss += y[e] * y[e]; }
            if (part < 2) { ss += shx(ss, 1, c.lane); ss += shx(ss, 2, c.lane); ss += shx(ss, 4, c.lane); ss += shx(ss, 8, c.lane);
                const float rs = __builtin_amdgcn_rsqf(ss + EPS) * (part == 0 ? 0.08838834764831845f : 1.f);
#pragma unroll
                for (int e = 0; e < 8; ++e) y[e] *= rs; }
            *(LAS f32x4*)(dst + r * LDW + 8 * cg) = (f32x4){y[0], y[1], y[2], y[3]}; *(LAS f32x4*)(dst + r * LDW + 8 * cg + 4) = (f32x4){y[4], y[5], y[6], y[7]};
        }
    }
}
__device__ __forceinline__ void dn_store_chunk(KArgs a, const Ctx& c, int l, int b, int h, int t0, const LAS float* os) {
    const bf16* ZB = (const bf16*)(a->ws + WS_ZB); bf16* YB = (bf16*)(a->ws + WS_YB); const float* onw = a->in[I_ONW] + l * 128;
    const int r = c.tid >> 3, sub = c.tid & 7, tok = b * SEQ + t0 + r;
    float o[16]; float ss = 0.f;
#pragma unroll
    for (int q = 0; q < 4; ++q) { const f32x4 v = *(const LAS f32x4*)(os + r * 128 + sub * 16 + q * 4); o[q * 4] = v.x; o[q * 4 + 1] = v.y; o[q * 4 + 2] = v.z; o[q * 4 + 3] = v.w; ss += (v.x * v.x + v.y * v.y) + (v.z * v.z + v.w * v.w); }
    ss += shx(ss, 1, c.lane); ss += shx(ss, 2, c.lane); ss += shx(ss, 4, c.lane);
    const float rstd = __builtin_amdgcn_rsqf(ss * (1.f / 128.f) + EPS);
    const bf16* zp = ZB + (size_t)tok * 512 + h * 128 + sub * 16; bf16* yp = YB + (size_t)tok * 512 + h * 128 + sub * 16;
#pragma unroll
    for (int q = 0; q < 2; ++q) { const v4u z = *(const v4u*)(zp + q * 8); const f32x4 w0 = *(const f32x4*)(onw + sub * 16 + q * 8), w1 = *(const f32x4*)(onw + sub * 16 + q * 8 + 4);
        v4u y; y.x = pk2(o[q * 8 + 0] * rstd * w0.x * siluf_(bflo(z.x)), o[q * 8 + 1] * rstd * w0.y * siluf_(bfhi(z.x)));
        y.y = pk2(o[q * 8 + 2] * rstd * w0.z * siluf_(bflo(z.y)), o[q * 8 + 3] * rstd * w0.w * siluf_(bfhi(z.y)));
        y.z = pk2(o[q * 8 + 4] * rstd * w1.x * siluf_(bflo(z.z)), o[q * 8 + 5] * rstd * w1.y * siluf_(bfhi(z.z)));
        y.w = pk2(o[q * 8 + 6] * rstd * w1.z * siluf_(bflo(z.w)), o[q * 8 + 7] * rstd * w1.w * siluf_(bfhi(z.w)));
        *(v4u*)(yp + q * 8) = y; }
}
__device__ __forceinline__ void ph_dn_simple(KArgs a, const Ctx& c, int l) {
    LAS float* qs = (LAS float*)c.lds; LAS float* ks = qs + 8192; LAS float* vs = ks + 8192; LAS float* os = vs + 8192;
    LAS float* bt = (LAS float*)(c.lds + MISC_OFF + 1024); LAS float* at = bt + 64;
    const float* beta = (const float*)(a->ws + WS_BETA); const float* glog = (const float*)(a->ws + WS_GLOG);
    const int v = c.tid >> 2, kq = c.tid & 3;
    for (int item = c.bid; item < NB * HB; item += c.G) {
        const int b = item >> 2, h = item & 3;
        float S[32];
#pragma unroll
        for (int q = 0; q < 32; ++q) S[q] = 0.f;
        for (int n = 0; n < NCH; ++n) {
            const int t0 = n * DNC;
            __syncthreads();
            dn_load_chunk<128>(a, c, l, b, h, t0, qs, ks, vs);
            if (c.tid < 64) { const int tok = b * SEQ + t0 + c.tid; bt[c.tid] = beta[tok * 4 + h]; at[c.tid] = __expf(glog[tok * 4 + h]); }
            __syncthreads();
            for (int tt = 0; tt < DNC; ++tt) {
                const float a_t = at[tt], b_t = bt[tt];
                float kr[32];
#pragma unroll
                for (int q = 0; q < 8; ++q) { const f32x4 k4 = *(const LAS f32x4*)(ks + tt * 128 + kq * 32 + q * 4); kr[q * 4] = k4.x; kr[q * 4 + 1] = k4.y; kr[q * 4 + 2] = k4.z; kr[q * 4 + 3] = k4.w; }
                float kS = 0.f;
#pragma unroll
                for (int q = 0; q < 32; ++q) kS += kr[q] * S[q];
                kS += shx(kS, 1, c.lane); kS += shx(kS, 2, c.lane);
                const float vn = b_t * (vs[tt * 128 + v] - a_t * kS);
                float o = 0.f;
#pragma unroll
                for (int q = 0; q < 8; ++q) { const f32x4 q4 = *(const LAS f32x4*)(qs + tt * 128 + kq * 32 + q * 4);
                    S[q * 4] = a_t * S[q * 4] + kr[q * 4] * vn; S[q * 4 + 1] = a_t * S[q * 4 + 1] + kr[q * 4 + 1] * vn; S[q * 4 + 2] = a_t * S[q * 4 + 2] + kr[q * 4 + 2] * vn; S[q * 4 + 3] = a_t * S[q * 4 + 3] + kr[q * 4 + 3] * vn;
                    o += (q4.x * S[q * 4] + q4.y * S[q * 4 + 1]) + (q4.z * S[q * 4 + 2] + q4.w * S[q * 4 + 3]); }
                o += shx(o, 1, c.lane); o += shx(o, 2, c.lane);
                if (kq == 0) os[tt * 128 + v] = o;
            }
            __syncthreads();
            dn_store_chunk(a, c, l, b, h, t0, os);
        }
    }
}

struct EpiProj {
    static constexpr bool PERM = true, AFTER_DRAIN = false; unsigned char* ws;
    __device__ __forceinline__ void operator()(const pg8::f32x4 (&acc)[2][2][4][2], const pg8::Unit& u, int wr, int wc, int fr, int fq) const {
        const int pn = u.pn; bf16* base; int ld, ct; bool sg = false;
        if (pn < 6) { base = (bf16*)(ws + WS_QKVA); ld = 1536; ct = pn; } else if (pn < 12) { base = (bf16*)(ws + WS_QKVB); ld = 1536; ct = pn - 6; }
        else if (pn < 14) { base = (bf16*)(ws + WS_ZB); ld = 512; ct = pn - 12; } else { base = (bf16*)(ws + WS_GATES); ld = 2048; ct = pn - 14; sg = true; }
        const int row0 = u.pm * 256 + wr * 64 + fr, col0 = ct * 256 + wc * 32 + 8 * fq;
#pragma unroll
        for (int ai = 0; ai < 2; ++ai)
#pragma unroll
            for (int m = 0; m < 4; ++m) { bf16* rowp = base + (size_t)(row0 + ai * 128 + m * 16) * ld + col0;
#pragma unroll
                for (int bj = 0; bj < 2; ++bj) { f32x4 v0 = acc[ai][bj][m][0], v1 = acc[ai][bj][m][1];
                    if (sg) { v0.x = sigmoidf_(v0.x); v0.y = sigmoidf_(v0.y); v0.z = sigmoidf_(v0.z); v0.w = sigmoidf_(v0.w); v1.x = sigmoidf_(v1.x); v1.y = sigmoidf_(v1.y); v1.z = sigmoidf_(v1.z); v1.w = sigmoidf_(v1.w); }
                    v4u w; w.x = pk2(v0.x, v0.y); w.y = pk2(v0.z, v0.w); w.z = pk2(v1.x, v1.y); w.w = pk2(v1.z, v1.w);
                    *(v4u*)(rowp + bj * 128) = w; } }
    }
};
template <bool SECOND> struct EpiMerge {
    static constexpr bool PERM = true, AFTER_DRAIN = false; unsigned char* ws;
    __device__ __forceinline__ void operator()(const pg8::f32x4 (&acc)[2][2][4][2], const pg8::Unit& u, int wr, int wc, int fr, int fq) const {
        bf16* M = (bf16*)(ws + WS_M); const bf16* GT = (const bf16*)(ws + WS_GATES) + (SECOND ? 1024 : 0);
        const int row0 = u.pm * 256 + wr * 64 + fr, col0 = u.pn * 256 + wc * 32 + 8 * fq;
#pragma unroll
        for (int ai = 0; ai < 2; ++ai)
#pragma unroll
            for (int m = 0; m < 4; ++m) { const size_t row = row0 + ai * 128 + m * 16;
#pragma unroll
                for (int bj = 0; bj < 2; ++bj) { const int col = col0 + bj * 128; const f32x4 v0 = acc[ai][bj][m][0], v1 = acc[ai][bj][m][1];
                    const v4u g = *(const v4u*)(GT + row * 2048 + col);
                    float o[8] = {bflo(g.x) * v0.x, bfhi(g.x) * v0.y, bflo(g.y) * v0.z, bfhi(g.y) * v0.w, bflo(g.z) * v1.x, bfhi(g.z) * v1.y, bflo(g.w) * v1.z, bfhi(g.w) * v1.w};
                    if (SECOND) { const v4u p = *(const v4u*)(M + row * 1024 + col); o[0] += bflo(p.x); o[1] += bfhi(p.x); o[2] += bflo(p.y); o[3] += bfhi(p.y); o[4] += bflo(p.z); o[5] += bfhi(p.z); o[6] += bflo(p.w); o[7] += bfhi(p.w); }
                    v4u w; w.x = pk2(o[0], o[1]); w.y = pk2(o[2], o[3]); w.z = pk2(o[4], o[5]); w.w = pk2(o[6], o[7]);
                    *(v4u*)(M + row * 1024 + col) = w; } }
    }
};
struct EpiOut {
    static constexpr bool PERM = true, AFTER_DRAIN = false; const float* xin; float* xout; const float* g1;
    __device__ __forceinline__ void operator()(const pg8::f32x4 (&acc)[2][2][4][2], const pg8::Unit& u, int wr, int wc, int fr, int fq) const {
        const int row0 = u.pm * 256 + wr * 64 + fr, col0 = u.pn * 256 + wc * 32 + 8 * fq; const int b = (u.pm * 256) >> 12;
#pragma unroll
        for (int bj = 0; bj < 2; ++bj) { const int col = col0 + bj * 128; const f32x4 ga = *(const f32x4*)(g1 + b * 6144 + col), gb = *(const f32x4*)(g1 + b * 6144 + col + 4);
#pragma unroll
            for (int ai = 0; ai < 2; ++ai)
#pragma unroll
                for (int m = 0; m < 4; ++m) { const size_t off = (size_t)(row0 + ai * 128 + m * 16) * DM + col;
                    const f32x4 x0 = *(const f32x4*)(xin + off), x1 = *(const f32x4*)(xin + off + 4);
                    *(f32x4*)(xout + off) = x0 + ga * acc[ai][bj][m][0]; *(f32x4*)(xout + off + 4) = x1 + gb * acc[ai][bj][m][1]; } }
    }
};
struct EpiMoeGU {
    static constexpr bool PERM = true, AFTER_DRAIN = false; unsigned char* ws;
    __device__ __forceinline__ void operator()(const pg8::f32x4 (&acc)[2][2][4][2], const pg8::Unit& u, int wr, int wc, int fr, int fq) const {
        bf16* ACT = (bf16*)(ws + WS_ACT);
        const int row0 = u.pm * 256 + wr * 64 + fr, col0 = (u.pn & 1) * 128 + wc * 32 + 8 * fq;
#pragma unroll
        for (int ai = 0; ai < 2; ++ai)
#pragma unroll
            for (int m = 0; m < 4; ++m) { const f32x4 g0 = acc[ai][0][m][0], g1 = acc[ai][0][m][1], u0 = acc[ai][1][m][0], u1 = acc[ai][1][m][1];
                v4u w; w.x = pk2(siluf_(g0.x) * u0.x, siluf_(g0.y) * u0.y); w.y = pk2(siluf_(g0.z) * u0.z, siluf_(g0.w) * u0.w); w.z = pk2(siluf_(g1.x) * u1.x, siluf_(g1.y) * u1.y); w.w = pk2(siluf_(g1.z) * u1.z, siluf_(g1.w) * u1.w);
                *(v4u*)(ACT + (size_t)(row0 + ai * 128 + m * 16) * 256 + col0) = w; }
    }
};
struct EpiMoeDown {
    static constexpr bool PERM = true, AFTER_DRAIN = false; unsigned char* ws;
    __device__ __forceinline__ void operator()(const pg8::f32x4 (&acc)[2][2][4][2], const pg8::Unit& u, int wr, int wc, int fr, int fq) const {
        bf16* YS = (bf16*)(ws + WS_YS); const int* rowtok = (const int*)(ws + WS_ROWTOK); const float* roww = (const float*)(ws + WS_ROWW);
        const int row0 = u.pm * 256 + wr * 64 + fr, col0 = (u.pn & 3) * 256 + wc * 32 + 8 * fq;
#pragma unroll
        for (int ai = 0; ai < 2; ++ai)
#pragma unroll
            for (int m = 0; m < 4; ++m) { const int row = row0 + ai * 128 + m * 16; const int rt = rowtok[row]; const float wgt = roww[row];
                if (rt >= 0) {
#pragma unroll
                    for (int bj = 0; bj < 2; ++bj) { const f32x4 v0 = acc[ai][bj][m][0] * wgt, v1 = acc[ai][bj][m][1] * wgt;
                        v4u w; w.x = pk2(v0.x, v0.y); w.y = pk2(v0.z, v0.w); w.z = pk2(v1.x, v1.y); w.w = pk2(v1.z, v1.w);
                        *(v4u*)(YS + (size_t)rt * 1024 + col0 + bj * 128) = w; } } }
    }
};
struct MoeOrder {
    const LAS int* tile_exp; int nunits, G, c, sh;
    __device__ __forceinline__ bool next(int i, pg8::Unit& u) const {
        const int L = i * G + c; if (L >= nunits) return false;
        const int r = L >> sh, j = L & ((1 << sh) - 1);
        u.pm = r; u.pn = __builtin_amdgcn_readfirstlane((tile_exp[r] << sh) + j); return true;
    }
    __device__ __forceinline__ void a_ready(const pg8::Unit&) const {}
    __device__ __forceinline__ void done(const pg8::Unit&) const {}
};

__device__ __forceinline__ void ph_router(KArgs a, const Ctx& c, int l) {
    LAS int* lcnt = (LAS int*)(c.lds + MISC_OFF + 1024);
    LAS int* lbase = lcnt + 32;
    LAS int* tinf = lcnt + 64;
    LAS float* wreT = (LAS float*)c.lds;
    const int lane = c.lane;
    bf16* H2 = (bf16*)(a->ws + WS_H); unsigned* tokinfo = (unsigned*)(a->ws + WS_TOKINFO); int* rowtok = (int*)(a->ws + WS_ROWTOK);
    unsigned* gcnt = (unsigned*)(a->ws + WS_CTL) + CW_GCNT + l * 32;
    const float* n2w = a->in[I_N2W] + l * DM; const float* wrg = a->in[I_WRG] + (size_t)l * 1024 * 4; const float* wre = a->in[I_WRE] + (size_t)l * 1024 * 32;
    for (int i = c.bid * NTHR + c.tid; i < MOE_MAXROWS; i += c.G * NTHR) rowtok[i] = -1;
    for (int i = c.tid; i < 8192; i += NTHR) { const int k = i >> 3, n4 = (i & 7) * 4; const f32x4 w = *(const f32x4*)(wre + (size_t)k * 32 + n4);
        wreT[(n4 + 0) * 1024 + k] = w.x; wreT[(n4 + 1) * 1024 + k] = w.y; wreT[(n4 + 2) * 1024 + k] = w.z; wreT[(n4 + 3) * 1024 + k] = w.w; }
    LAS float* wrgT = (LAS float*)(c.lds + 131072);
    LAS float* rbias = (LAS float*)(c.lds + MISC_OFF + 3072);
    for (int i = c.tid; i < 1024; i += NTHR) { const f32x4 w = *(const f32x4*)(wrg + (size_t)i * 4); wrgT[i] = w.x; wrgT[1024 + i] = w.y; wrgT[2048 + i] = w.z; wrgT[3072 + i] = w.w; }
    if (c.tid < 36) rbias[c.tid] = c.tid < 4 ? a->in[I_BRG][l * 4 + c.tid] : a->in[I_BRE][l * 32 + c.tid - 4];
#if MK_PROBE_A >= 40 && MK_PROBE_A <= 42
    unsigned rpa = 0, rq = (unsigned)__builtin_amdgcn_s_memrealtime();
#define RP_TICK(w) do { const unsigned t_ = (unsigned)__builtin_amdgcn_s_memrealtime(); if ((w) == MK_PROBE_A - 40) rpa += t_ - rq; rq = t_; } while (0)
#else
#define RP_TICK(w) do {} while (0)
#endif
    for (int tb = c.bid; tb < NTOK / 64; tb += c.G) {
        __syncthreads();
        RP_TICK(0);
        if (c.tid < 32) lcnt[c.tid] = 0;
        __syncthreads();
        f32x4 cnw[4], csh[4], csc[4];
        { const float* mod = (const float*)(a->ws + WS_MOD) + (l * 4 + ((tb * 64) >> 12)) * 6144;
#pragma unroll
          for (int j = 0; j < 4; ++j) { const int col = 256 * j + 4 * lane; cnw[j] = *(const f32x4*)(n2w + col); csh[j] = *(const f32x4*)(mod + 3072 + col); csc[j] = *(const f32x4*)(mod + 4096 + col) + 1.0f; } }
        f32x4 hn[4];
        { const float* xr0 = (const float*)a->out + (size_t)(tb * 64 + c.wave * 8) * DM;
#pragma unroll
          for (int j = 0; j < 4; ++j) hn[j] = *(const f32x4*)(xr0 + 256 * j + 4 * lane); }
        for (int i = 0; i < 8; ++i) {
            const int tl = c.wave * 8 + i, m = tb * 64 + tl;
            f32x4 h[4];
#pragma unroll
            for (int j = 0; j < 4; ++j) h[j] = hn[j];
            if (i < 7) { const float* xr1 = (const float*)a->out + (size_t)(m + 1) * DM;
#pragma unroll
                for (int j = 0; j < 4; ++j) hn[j] = *(const f32x4*)(xr1 + 256 * j + 4 * lane); }
            const float rstd = row_rstd(h, lane);
            float ag[4] = {0.f, 0.f, 0.f, 0.f};
#pragma unroll
            for (int j = 0; j < 4; ++j) { const int col = 256 * j + 4 * lane;
                h[j] = h[j] * rstd * cnw[j] * csc[j] + csh[j];
                v2u o; o.x = pk2(h[j].x, h[j].y); o.y = pk2(h[j].z, h[j].w); *(v2u*)(H2 + (size_t)m * DM + col) = o;
#pragma unroll
                for (int q = 0; q < 4; ++q) { const f32x4 w = *(const LAS f32x4*)(wrgT + q * 1024 + col); ag[q] += (h[j].x * w.x + h[j].y * w.y) + (h[j].z * w.z + h[j].w * w.w); } }
#pragma unroll
            for (int q = 0; q < 4; ++q) ag[q] = wave_sum(ag[q], lane) + rbias[q];
            int g = 0; float gm = ag[0];
#pragma unroll
            for (int q = 1; q < 4; ++q) if (ag[q] > gm) { gm = ag[q]; g = q; }
            float den = 0.f;
#pragma unroll
            for (int q = 0; q < 4; ++q) den += __expf(ag[q] - gm);
            const float ptop = 1.f / den;
            float ae[8] = {0.f, 0.f, 0.f, 0.f, 0.f, 0.f, 0.f, 0.f};
#pragma unroll
            for (int j = 0; j < 4; ++j) { const int col = 256 * j + 4 * lane;
#pragma unroll
                for (int e = 0; e < 8; ++e) { const f32x4 w = *(const LAS f32x4*)(wreT + (g * 8 + e) * 1024 + col); ae[e] += (h[j].x * w.x + h[j].y * w.y) + (h[j].z * w.z + h[j].w * w.w); } }
#pragma unroll
            for (int q = 0; q < 8; ++q) ae[q] = wave_sum(ae[q], lane) + rbias[4 + g * 8 + q];
            int e0 = 0; float v0 = ae[0];
#pragma unroll
            for (int q = 1; q < 8; ++q) if (ae[q] > v0) { v0 = ae[q]; e0 = q; }
            int e1 = -1; float v1 = -3e38f;
#pragma unroll
            for (int q = 0; q < 8; ++q) if (q != e0 && ae[q] > v1) { v1 = ae[q]; e1 = q; }
            const float ex = __expf(v1 - v0); const float w0 = ptop / (1.f + ex), w1 = ptop * ex / (1.f + ex);
            if (lane == 0) { const int E0 = g * 8 + e0, E1 = g * 8 + e1;
                const int r0 = atomicAdd((int*)(lcnt + E0), 1), r1 = atomicAdd((int*)(lcnt + E1), 1);
                tinf[tl * 6 + 0] = E0; tinf[tl * 6 + 1] = E1; tinf[tl * 6 + 2] = r0; tinf[tl * 6 + 3] = r1; tinf[tl * 6 + 4] = __float_as_int(w0); tinf[tl * 6 + 5] = __float_as_int(w1); }
        }
        __syncthreads();
        RP_TICK(1);
        if (c.tid < 32) lbase[c.tid] = (int)__hip_atomic_fetch_add(gcnt + c.tid, (unsigned)lcnt[c.tid], RLX_AGENT);
        __syncthreads();
        if (c.tid < 64) { const int m = tb * 64 + c.tid; const int E0 = tinf[c.tid * 6], E1 = tinf[c.tid * 6 + 1];
            v4u o; o.x = (unsigned)E0; o.y = (unsigned)E1; o.z = (unsigned)(lbase[E0] + tinf[c.tid * 6 + 2]); o.w = (unsigned)(lbase[E1] + tinf[c.tid * 6 + 3]);
            *(v4u*)(tokinfo + (size_t)m * 8) = o; *(v2u*)(tokinfo + (size_t)m * 8 + 4) = (v2u){(unsigned)tinf[c.tid * 6 + 4], (unsigned)tinf[c.tid * 6 + 5]}; }
        RP_TICK(2);
    }
#if MK_PROBE_A >= 40 && MK_PROBE_A <= 42
    if (blockIdx.x == 0 && c.tid == 0) ((unsigned long long*)((unsigned*)(a->ws + WS_CTL) + 12288))[60 + l] = rpa;
#endif
}
__device__ __forceinline__ void moe_table(KArgs a, const Ctx& c, int l) {
    LAS int* tile_exp = (LAS int*)(c.lds + MISC_OFF + 2048); LAS int* offs = tile_exp + 192; LAS int* ntl = offs + 32; LAS int* pre = ntl + 4;
    const unsigned* gcnt = (const unsigned*)(a->ws + WS_CTL) + CW_GCNT + l * 32;
    __syncthreads();
    if (c.tid < 64) { const int e = c.tid & 31; const int cnt = (int)__hip_atomic_load(gcnt + e, RLX_AGENT); const int nt = (cnt + 255) >> 8; int inc = nt;
#pragma unroll
        for (int o = 1; o < 32; o <<= 1) { const int v = shidx_i(inc, (c.lane - o) & 63); if (e >= o) inc += v; }
        if (c.tid < 32) { offs[e] = (inc - nt) * 256; pre[e] = inc; if (e == 31) ntl[0] = inc; } }
    __syncthreads();
    if (c.tid < MOE_MAXTILES) { int E = 0;
#pragma unroll
        for (int e = 0; e < 32; ++e) E += (pre[e] <= c.tid) ? 1 : 0;
        tile_exp[c.tid] = E < 31 ? E : 31; }
    __syncthreads();
}
__device__ __forceinline__ void ph_gather(KArgs a, const Ctx& c, int l) {
    moe_table(a, c, l);
    const LAS int* offs = (const LAS int*)(c.lds + MISC_OFF + 2048) + 192;
    const int gw = c.bid * NW + c.wave, NGW = c.G * NW, lane = c.lane;
    const bf16* H2 = (const bf16*)(a->ws + WS_H); bf16* HS = (bf16*)(a->ws + WS_HS); const unsigned* tokinfo = (const unsigned*)(a->ws + WS_TOKINFO);
    int* rowtok = (int*)(a->ws + WS_ROWTOK); float* roww = (float*)(a->ws + WS_ROWW);
    for (int m = gw; m < NTOK; m += NGW) {
        const v4u ti = *(const v4u*)(tokinfo + (size_t)m * 8); const v2u tw = *(const v2u*)(tokinfo + (size_t)m * 8 + 4);
        const int d0 = offs[ti.x] + (int)ti.z, d1 = offs[ti.y] + (int)ti.w;
        const v4u x0 = *(const v4u*)(H2 + (size_t)m * DM + lane * 8), x1 = *(const v4u*)(H2 + (size_t)m * DM + 512 + lane * 8);
        *(v4u*)(HS + (size_t)d0 * DM + lane * 8) = x0; *(v4u*)(HS + (size_t)d0 * DM + 512 + lane * 8) = x1;
        *(v4u*)(HS + (size_t)d1 * DM + lane * 8) = x0; *(v4u*)(HS + (size_t)d1 * DM + 512 + lane * 8) = x1;
        if (lane == 0) { rowtok[d0] = m * 2; rowtok[d1] = m * 2 + 1; roww[d0] = __uint_as_float(tw.x); roww[d1] = __uint_as_float(tw.y); }
    }
}
constexpr int DN_IMG = 57344, DN_LDW = 132, DN_LDA = 68;
typedef __bf16 bf16x2_t __attribute__((ext_vector_type(2)));
typedef float f32x2_t __attribute__((ext_vector_type(2)));
__device__ __forceinline__ unsigned cvtpk(float lo, float hi) { f32x2_t v = {lo, hi}; bf16x2_t b = __builtin_convertvector(v, bf16x2_t); return __builtin_bit_cast(unsigned, b); }
__device__ __forceinline__ bf16x8 pack8(f32x4 a, f32x4 b) { v4u w; w.x = cvtpk(a.x, a.y); w.y = cvtpk(a.z, a.w); w.z = cvtpk(b.x, b.y); w.w = cvtpk(b.z, b.w); return __builtin_bit_cast(bf16x8, w); }
#define MFMA16(a, b, c) __builtin_amdgcn_mfma_f32_16x16x32_bf16((a), (b), (c), 0, 0, 0)

__device__ __forceinline__ void dn_raw_load(KArgs a, const Ctx& c, int item, v4u (&raw)[3][5]) {
    const bf16* QKVB = (const bf16*)(a->ws + WS_QKVB);
    const int n = item & 63, h = (item >> 6) & 3, b = item >> 8, t0 = n * DNC;
    const int cg = c.tid & 15, rg = c.tid >> 4, tA = t0 + 2 * rg - 3;
#pragma unroll
    for (int part = 0; part < 3; ++part)
#pragma unroll
        for (int i = 0; i < 5; ++i) { const int tt = tA + i; raw[part][i] = (v4u){0u, 0u, 0u, 0u};
            if (tt >= 0) raw[part][i] = *(const v4u*)(QKVB + (size_t)(b * SEQ + tt) * 1536 + part * 512 + h * 128 + 8 * cg); }
}
__device__ __forceinline__ void dn_conv_store(KArgs a, const Ctx& c, int l, int h, const v4u (&raw)[3][5], LAS float* qs, LAS float* ks, LAS float* vs) {
    const float* cw = a->in[I_CONVW] + (size_t)l * 4 * 1536;
    const int cg = c.tid & 15, rg = c.tid >> 4;
#pragma unroll
    for (int part = 0; part < 3; ++part) {
        const int colb = part * 512 + h * 128 + 8 * cg;
        float w[4][8];
#pragma unroll
        for (int i = 0; i < 4; ++i) { const f32x4 w0 = *(const f32x4*)(cw + i * 1536 + colb), w1 = *(const f32x4*)(cw + i * 1536 + colb + 4);
            w[i][0] = w0.x; w[i][1] = w0.y; w[i][2] = w0.z; w[i][3] = w0.w; w[i][4] = w1.x; w[i][5] = w1.y; w[i][6] = w1.z; w[i][7] = w1.w; }
        LAS float* dst = part == 0 ? qs : part == 1 ? ks : vs;
#pragma unroll
        for (int rr = 0; rr < 2; ++rr) {
            float y[8];
#pragma unroll
            for (int e = 0; e < 8; ++e) y[e] = 0.f;
#pragma unroll
            for (int i = 0; i < 4; ++i) { const v4u x = raw[part][rr + i];
                y[0] += w[i][0] * bflo(x.x); y[1] += w[i][1] * bfhi(x.x); y[2] += w[i][2] * bflo(x.y); y[3] += w[i][3] * bfhi(x.y); y[4] += w[i][4] * bflo(x.z); y[5] += w[i][5] * bfhi(x.z); y[6] += w[i][6] * bflo(x.w); y[7] += w[i][7] * bfhi(x.w); }
            float ss = 0.f;
#pragma unroll
            for (int e = 0; e < 8; ++e) { y[e] = siluf_(y[e]); ss += y[e] * y[e]; }
            if (part < 2) { ss += dpp_f<0xB1>(ss); ss += dpp_f<0x4E>(ss); ss += dpp_f<0x141>(ss); ss += dpp_f<0x140>(ss);
                const float rs = __builtin_amdgcn_rsqf(ss + EPS) * (part == 0 ? 0.08838834764831845f : 1.f);
#pragma unroll
                for (int e = 0; e < 8; ++e) y[e] *= rs; }
            const int r = 2 * rg + rr;
            *(LAS f32x4*)(dst + r * DN_LDW + 8 * cg) = (f32x4){y[0], y[1], y[2], y[3]}; *(LAS f32x4*)(dst + r * DN_LDW + 8 * cg + 4) = (f32x4){y[4], y[5], y[6], y[7]};
        }
    }
}

__device__ __forceinline__ void ph_dn_prep(KArgs a, const Ctx& c, int l) {
    LAS float* qs = (LAS float*)c.lds; LAS float* ks = qs + 64 * DN_LDW; LAS float* vs = ks + 64 * DN_LDW;
    LAS float* Am = vs + 64 * DN_LDW; LAS float* Pm = Am + 64 * DN_LDA;
    LAS float* bt = (LAS float*)(c.lds + MISC_OFF + 1024); LAS float* Gc = bt + 64;
    const float* beta = (const float*)(a->ws + WS_BETA); const float* glog = (const float*)(a->ws + WS_GLOG);
#if MK_PROBE_A >= 30 && MK_PROBE_A <= 36
    unsigned ppa = 0, pq = (unsigned)__builtin_amdgcn_s_memrealtime();
#define PP_TICK(w) do { const unsigned t_ = (unsigned)__builtin_amdgcn_s_memrealtime(); if ((w) == MK_PROBE_A - 30) ppa += t_ - pq; pq = t_; } while (0)
#else
#define PP_TICK(w) do {} while (0)
#endif
    v4u raw[3][5];
    if (c.bid < NB * HB * NCH) dn_raw_load(a, c, c.bid, raw);
    for (int item = c.bid; item < NB * HB * NCH; item += c.G) {
        int tid = c.tid; asm volatile("" : "+v"(tid));
        const int lane = tid & 63, row = lane & 15, quad = lane >> 4;
        const int n = item & 63, h = (item >> 6) & 3, b = item >> 8, t0 = n * DNC;
        unsigned char* img = a->ws + WS_IMG + (size_t)item * DN_IMG;
        __syncthreads();
        PP_TICK(6);
        dn_conv_store(a, c, l, h, raw, qs, ks, vs);
        { const int nxt = item + c.G; if (nxt < NB * HB * NCH) dn_raw_load(a, c, nxt, raw); }
        if (tid < 64) { const int tok = b * SEQ + t0 + tid; bt[tid] = beta[tok * 4 + h]; float g = glog[tok * 4 + h];
#pragma unroll
            for (int o = 1; o < 64; o <<= 1) { const float v = shidx(g, (lane - o) & 63); if (lane >= o) g += v; }
            Gc[tid] = g; }
        __syncthreads();
        PP_TICK(0);
        {   const int sel = c.wave >> 2, ti = c.wave & 3; const LAS float* rs = sel == 0 ? ks : qs; LAS float* dstm = sel == 0 ? Am : Pm;
            bf16x8 af[4];
#pragma unroll
            for (int s = 0; s < 4; ++s) { const LAS float* p = rs + (ti * 16 + row) * DN_LDW + 32 * s + 8 * quad; af[s] = pack8(*(const LAS f32x4*)p, *(const LAS f32x4*)(p + 4)); }
            for (int tj = 0; tj < 4; ++tj) {
                f32x4 acc = {0.f, 0.f, 0.f, 0.f};
                if (tj <= ti) {
#pragma unroll
                    for (int s = 0; s < 4; ++s) { const LAS float* p = ks + (tj * 16 + row) * DN_LDW + 32 * s + 8 * quad; const bf16x8 bfr = pack8(*(const LAS f32x4*)p, *(const LAS f32x4*)(p + 4)); acc = MFMA16(af[s], bfr, acc); }
                }
                const int j = tj * 16 + row; const float Gj = Gc[j];
#pragma unroll
                for (int r = 0; r < 4; ++r) { const int i = ti * 16 + 4 * quad + r; const float dec = __expf(fminf(Gc[i] - Gj, 0.f));
                    float v = acc[r] * dec; if (sel == 0) v = (j < i) ? v * bt[i] : 0.f; else v = (j <= i) ? v : 0.f;
                    dstm[i * DN_LDA + j] = v; }
            }
        }
        __syncthreads();
        PP_TICK(1);
        const float Glast = Gc[63];
        {
            for (int q = 0; q < 5; ++q) { const int p = tid + 512 * q, blk = p >> 6; float v[8];
                if (blk < 16) { const int mt = blk >> 2, s = blk & 3, cr = 16 * mt + row, k0 = 32 * s + 4 * quad; const float e = __expf(Gc[cr]);
                    const f32x4 v0 = *(const LAS f32x4*)(qs + cr * DN_LDW + k0), v1 = *(const LAS f32x4*)(qs + cr * DN_LDW + k0 + 16);
                    v[0] = v0.x * e; v[1] = v0.y * e; v[2] = v0.z * e; v[3] = v0.w * e; v[4] = v1.x * e; v[5] = v1.y * e; v[6] = v1.z * e; v[7] = v1.w * e; }
                else if (blk < 32) { const int b2 = blk - 16, mt = b2 >> 1, s = b2 & 1, k = 16 * mt + row;
#pragma unroll
                    for (int j = 0; j < 8; ++j) { const int cj = 32 * s + 16 * (j >> 2) + 4 * quad + (j & 3); v[j] = ks[cj * DN_LDW + k] * __expf(Glast - Gc[cj]); } }
                else { const int b3 = blk - 32, mt = b3 >> 1, s = b3 & 1, i = 16 * mt + row, c0 = 32 * s + 4 * quad;
                    const f32x4 v0 = *(const LAS f32x4*)(Pm + i * DN_LDA + c0), v1 = *(const LAS f32x4*)(Pm + i * DN_LDA + c0 + 16);
                    v[0] = v0.x; v[1] = v0.y; v[2] = v0.z; v[3] = v0.w; v[4] = v1.x; v[5] = v1.y; v[6] = v1.z; v[7] = v1.w; }
                v4u w; w.x = cvtpk(v[0], v[1]); w.y = cvtpk(v[2], v[3]); w.z = cvtpk(v[4], v[5]); w.w = cvtpk(v[6], v[7]);
                *(v4u*)(img + 16384 + (size_t)p * 16) = w; }
            if (tid == 0) ((float*)(a->ws + WS_GL))[item] = __expf(Glast);
        }
        __syncthreads();
        PP_TICK(2);
        LAS float* Ti = Pm;
        if (c.wave < 4 && lane < 16) { const int bI = c.wave; float sv[16];
            int vz = 0; asm volatile("" : "+v"(vz)); const LAS float* AmV = Am + vz + (16 * bI) * DN_LDA + 16 * bI;
#pragma unroll
            for (int r = 0; r < 16; ++r) sv[r] = (r == lane) ? 1.f : 0.f;
#pragma unroll
            for (int rp = 0; rp < 15; ++rp)
#pragma unroll
                for (int r = rp + 1; r < 16; ++r) sv[r] -= AmV[r * DN_LDA + rp] * sv[rp];
#pragma unroll
            for (int r = 0; r < 16; ++r) Ti[(bI * 16 + r) * 20 + lane] = sv[r]; }
        __syncthreads();
        PP_TICK(3);
        {   const float isw0 = 0.f; (void)isw0;
#pragma unroll
            for (int bI = 0; bI < 4; ++bI) {
#pragma unroll
                for (int q = 0; q < 2; ++q) { const int nt = 2 * c.wave + q; const bool isw = nt >= 8; LAS float* xb = (isw ? ks : vs) + (nt & 7) * 16;
                    if (bI > 0) {
                        f32x4 acc = {0.f, 0.f, 0.f, 0.f};
#pragma unroll
                        for (int s2 = 0; s2 < (bI == 3 ? 2 : 1); ++s2) { const int j0 = 32 * s2 + 8 * quad;
                            f32x4 a0 = *(const LAS f32x4*)(Am + (16 * bI + row) * DN_LDA + j0), a1 = *(const LAS f32x4*)(Am + (16 * bI + row) * DN_LDA + j0 + 4);
                            if (j0 >= 16 * bI) { a0 = (f32x4){0.f, 0.f, 0.f, 0.f}; a1 = a0; }
                            float xv[8];
#pragma unroll
                            for (int j = 0; j < 8; ++j) xv[j] = xb[(j0 + j) * DN_LDW + row];
                            acc = MFMA16(pack8(a0, a1), pack8((f32x4){xv[0], xv[1], xv[2], xv[3]}, (f32x4){xv[4], xv[5], xv[6], xv[7]}), acc); }
#pragma unroll
                        for (int r = 0; r < 4; ++r) { const int i = 16 * bI + 4 * quad + r; const float sc = isw ? bt[i] * __expf(Gc[i]) : bt[i]; xb[i * DN_LDW + row] = xb[i * DN_LDW + row] * sc - acc[r]; }
                    }
                }
                if (bI > 0) __syncthreads();
#pragma unroll
                for (int q = 0; q < 2; ++q) { const int nt = 2 * c.wave + q; const bool isw = nt >= 8; LAS float* xb = (isw ? ks : vs) + (nt & 7) * 16;
                    f32x4 a0 = {0.f, 0.f, 0.f, 0.f}, a1 = a0; float xv[8];
                    if (quad < 2) { a0 = *(const LAS f32x4*)(Ti + (bI * 16 + row) * 20 + 8 * quad); a1 = *(const LAS f32x4*)(Ti + (bI * 16 + row) * 20 + 8 * quad + 4); }
#pragma unroll
                    for (int j = 0; j < 8; ++j) { const int i = 16 * bI + ((8 * quad + j) & 15); float v = xb[i * DN_LDW + row];
                        if (bI == 0) v *= isw ? bt[i] * __expf(Gc[i]) : bt[i];
                        xv[j] = v; }
                    f32x4 acc = {0.f, 0.f, 0.f, 0.f};
                    acc = MFMA16(pack8(a0, a1), pack8((f32x4){xv[0], xv[1], xv[2], xv[3]}, (f32x4){xv[4], xv[5], xv[6], xv[7]}), acc);
#pragma unroll
                    for (int r = 0; r < 4; ++r) xb[(16 * bI + 4 * quad + r) * DN_LDW + row] = acc[r]; }
                __syncthreads();
            }
        }
        PP_TICK(4);
#pragma unroll
        for (int q = 0; q < 2; ++q) { const int p = tid + 512 * q, blk = p >> 6, mt = blk >> 2, s = blk & 3, cr = 16 * mt + row, k0 = 32 * s + 4 * quad;
            const f32x4 v0 = *(const LAS f32x4*)(ks + cr * DN_LDW + k0), v1 = *(const LAS f32x4*)(ks + cr * DN_LDW + k0 + 16);
            v4u w; w.x = cvtpk(-v0.x, -v0.y); w.y = cvtpk(-v0.z, -v0.w); w.z = cvtpk(-v1.x, -v1.y); w.w = cvtpk(-v1.z, -v1.w);
            *(v4u*)(img + (size_t)p * 16) = w; }
        {   unsigned char* ug = a->ws + WS_U + (size_t)item * 16384;
#pragma unroll
            for (int q = 0; q < 2; ++q) { const int p = tid + 512 * q, sl = p >> 7, ln = (p >> 1) & 63, hh = p & 1, v = 16 * sl + (ln & 15), qd = ln >> 4; float u8[8];
#pragma unroll
                for (int e = 0; e < 8; ++e) u8[e] = vs[(16 * (2 * hh + (e >> 2)) + 4 * qd + (e & 3)) * DN_LDW + v];
                v4u w; w.x = cvtpk(u8[0], u8[1]); w.y = cvtpk(u8[2], u8[3]); w.z = cvtpk(u8[4], u8[5]); w.w = cvtpk(u8[6], u8[7]);
                *(v4u*)(ug + (size_t)(sl * 64 + ln) * 32 + hh * 16) = w; } }
        PP_TICK(5);
    }
#if MK_PROBE_A >= 30 && MK_PROBE_A <= 36
    if (blockIdx.x == 0 && c.tid == 0) ((unsigned long long*)((unsigned*)(a->ws + WS_CTL) + 12288))[56 + l] = ppa;
#endif
}

constexpr int DN_OS = 2 * DN_IMG;
__device__ __forceinline__ void ph_dn_scan(KArgs a, const Ctx& c, int l) {
    LAS unsigned char* lds = c.lds;
    const int lane = c.lane, wv = c.wave, tid = c.tid; const bool cw = wv < 4;
    const bf16* ZB = (const bf16*)(a->ws + WS_ZB); bf16* YB = (bf16*)(a->ws + WS_YB); const float* onw = a->in[I_ONW] + l * 128; const float* glp = (const float*)(a->ws + WS_GL);
    float* ssq = (float*)(a->ws + WS_SSQ);
    for (int item = c.bid; item < 2 * NB * HB; item += c.G) {
        const int bh = item >> 1, half = item & 1, b = bh >> 2, h = bh & 3;
        const unsigned char* img0 = a->ws + WS_IMG + (size_t)bh * 64 * DN_IMG;
        __syncthreads();
        if (cw) {
            const unsigned char* ugb = a->ws + WS_U + (size_t)bh * 64 * 16384; const unsigned uoff = (unsigned)((half * 4 + wv) * 64 + lane) * 32u;
            f32x4 S[8];
#pragma unroll
            for (int m = 0; m < 8; ++m) S[m] = (f32x4){0.f, 0.f, 0.f, 0.f};
            v4u uc0 = *(const v4u*)(ugb + uoff), uc1 = *(const v4u*)(ugb + uoff + 16);
            for (int n = 0; n <= NCH; ++n) {
                asm volatile("s_waitcnt lgkmcnt(0)\n\ts_barrier" ::: "memory");
                if (n == NCH) break;
                v4u un0 = uc0, un1 = uc1;
                if (n + 1 < NCH) { un0 = *(const v4u*)(ugb + (size_t)(n + 1) * 16384 + uoff); un1 = *(const v4u*)(ugb + (size_t)(n + 1) * 16384 + uoff + 16); }
                const float gl = glp[bh * 64 + n];
                const LAS unsigned char* im = lds + (n & 1) * DN_IMG + lane * 16;
                bf16x8 Sb[4];
#pragma unroll
                for (int s = 0; s < 4; ++s) Sb[s] = pack8(S[2 * s], S[2 * s + 1]);
                f32x4 X[4], O[4];
                X[0] = (f32x4){bflo(uc0.x), bfhi(uc0.x), bflo(uc0.y), bfhi(uc0.y)}; X[1] = (f32x4){bflo(uc0.z), bfhi(uc0.z), bflo(uc0.w), bfhi(uc0.w)};
                X[2] = (f32x4){bflo(uc1.x), bfhi(uc1.x), bflo(uc1.y), bfhi(uc1.y)}; X[3] = (f32x4){bflo(uc1.z), bfhi(uc1.z), bflo(uc1.w), bfhi(uc1.w)};
                bf16x8 fa[8], fb[8];
#define DN_LDF(arr, off) do { _Pragma("unroll") for (int q_ = 0; q_ < 8; ++q_) arr[q_] = *(const LAS bf16x8*)(im + (off) + q_ * 1024); } while (0)
                DN_LDF(fa, 0); DN_LDF(fb, 8192);
#pragma unroll
                for (int mt = 0; mt < 2; ++mt)
#pragma unroll
                    for (int s = 0; s < 4; ++s) X[mt] = MFMA16(fa[mt * 4 + s], Sb[s], X[mt]);
                DN_LDF(fa, 16384);
#pragma unroll
                for (int mt = 0; mt < 2; ++mt)
#pragma unroll
                    for (int s = 0; s < 4; ++s) X[2 + mt] = MFMA16(fb[mt * 4 + s], Sb[s], X[2 + mt]);
                DN_LDF(fb, 16384 + 8192);
#pragma unroll
                for (int mt = 0; mt < 2; ++mt) { O[mt] = (f32x4){0.f, 0.f, 0.f, 0.f};
#pragma unroll
                    for (int s = 0; s < 4; ++s) O[mt] = MFMA16(fa[mt * 4 + s], Sb[s], O[mt]); }
                DN_LDF(fa, 32768);
#pragma unroll
                for (int mt = 0; mt < 2; ++mt) { O[2 + mt] = (f32x4){0.f, 0.f, 0.f, 0.f};
#pragma unroll
                    for (int s = 0; s < 4; ++s) O[2 + mt] = MFMA16(fb[mt * 4 + s], Sb[s], O[2 + mt]); }
                DN_LDF(fb, 32768 + 8192);
                bf16x8 Xb[2];
                Xb[0] = pack8(X[0], X[1]); Xb[1] = pack8(X[2], X[3]);
#pragma unroll
                for (int m = 0; m < 4; ++m) { S[m] = S[m] * gl;
#pragma unroll
                    for (int s = 0; s < 2; ++s) S[m] = MFMA16(fa[m * 2 + s], Xb[s], S[m]); }
                DN_LDF(fa, 49152);
#pragma unroll
                for (int m = 0; m < 4; ++m) { S[4 + m] = S[4 + m] * gl;
#pragma unroll
                    for (int s = 0; s < 2; ++s) S[4 + m] = MFMA16(fb[m * 2 + s], Xb[s], S[4 + m]); }
#pragma unroll
                for (int mt = 0; mt < 4; ++mt)
#pragma unroll
                    for (int s = 0; s < 2; ++s) O[mt] = MFMA16(fa[mt * 2 + s], Xb[s], O[mt]);
#undef DN_LDF
                LAS unsigned short* os = (LAS unsigned short*)(lds + DN_OS + (n & 1) * 8192);
#pragma unroll
                for (int mt = 0; mt < 4; ++mt)
#pragma unroll
                    for (int r = 0; r < 4; ++r) os[(16 * mt + 4 * (lane >> 4) + r) * 64 + 16 * wv + (lane & 15)] = (unsigned short)(cvtpk(O[mt][r], 0.f) & 0xffffu);
                uc0 = un0; uc1 = un1;
            }
        } else {
            const int ht = tid - 256, hw = wv - 4, nr = ht >> 2, nq = ht & 3;
            const bf16* zpb = ZB + (size_t)(b * SEQ) * 512 + h * 128 + half * 64; bf16* ypb = YB + (size_t)(b * SEQ) * 512 + h * 128 + half * 64; const unsigned zoff = (unsigned)(nr * 512 + nq * 16);
            float* sqp = ssq + ((size_t)(b * SEQ + nr) * 4 + h) * 2 + half;
#define DN_DMA(n, buf) do { _Pragma("unroll") for (int q_ = 0; q_ < 14; ++q_) { const int pc_ = hw + 4 * q_; \
                __builtin_amdgcn_global_load_lds((const unsigned*)(img0 + (size_t)(n) * DN_IMG + pc_ * 1024 + lane * 16), (LAS unsigned*)(lds + (buf) * DN_IMG + pc_ * 1024), 16, 0, 0); } } while (0)
            DN_DMA(0, 0);
            v4u zc0 = *(const v4u*)(zpb + zoff), zc1 = *(const v4u*)(zpb + zoff + 8);
            f32x4 ow[4];
#pragma unroll
            for (int q = 0; q < 4; ++q) ow[q] = *(const f32x4*)(onw + half * 64 + nq * 16 + q * 4);
            asm volatile("s_waitcnt vmcnt(0) lgkmcnt(0)\n\ts_barrier" ::: "memory");
            DN_DMA(1, 1);
            for (int n = 1; n <= NCH; ++n) {
                if (n == 1) asm volatile("s_waitcnt vmcnt(0) lgkmcnt(0)\n\ts_barrier" ::: "memory"); else asm volatile("s_waitcnt vmcnt(3) lgkmcnt(0)\n\ts_barrier" ::: "memory");
                v4u zn0 = zc0, zn1 = zc1;
                if (n < NCH) { zn0 = *(const v4u*)(zpb + (size_t)n * DNC * 512 + zoff); zn1 = *(const v4u*)(zpb + (size_t)n * DNC * 512 + zoff + 8); }
                asm volatile("" ::: "memory");
                if (n + 1 < NCH) DN_DMA(n + 1, (n + 1) & 1);
                asm volatile("" ::: "memory");
                {
                    const LAS unsigned short* os = (const LAS unsigned short*)(lds + DN_OS + ((n - 1) & 1) * 8192) + nr * 64 + nq * 16;
                    float o[16]; float ss = 0.f;
                    const v4u o0 = *(const LAS v4u*)os, o1 = *(const LAS v4u*)(os + 8);
                    o[0] = bflo(o0.x); o[1] = bfhi(o0.x); o[2] = bflo(o0.y); o[3] = bfhi(o0.y); o[4] = bflo(o0.z); o[5] = bfhi(o0.z); o[6] = bflo(o0.w); o[7] = bfhi(o0.w);
                    o[8] = bflo(o1.x); o[9] = bfhi(o1.x); o[10] = bflo(o1.y); o[11] = bfhi(o1.y); o[12] = bflo(o1.z); o[13] = bfhi(o1.z); o[14] = bflo(o1.w); o[15] = bfhi(o1.w);
#pragma unroll
                    for (int e = 0; e < 16; ++e) ss += o[e] * o[e];
                    ss += dpp_f<0xB1>(ss); ss += dpp_f<0x4E>(ss);
                    bf16* yp = ypb + (size_t)(n - 1) * DNC * 512 + zoff;
                    v4u y; y.x = cvtpk(o[0] * ow[0].x * siluf_(bflo(zc0.x)), o[1] * ow[0].y * siluf_(bfhi(zc0.x))); y.y = cvtpk(o[2] * ow[0].z * siluf_(bflo(zc0.y)), o[3] * ow[0].w * siluf_(bfhi(zc0.y)));
                    y.z = cvtpk(o[4] * ow[1].x * siluf_(bflo(zc0.z)), o[5] * ow[1].y * siluf_(bfhi(zc0.z))); y.w = cvtpk(o[6] * ow[1].z * siluf_(bflo(zc0.w)), o[7] * ow[1].w * siluf_(bfhi(zc0.w)));
                    *(v4u*)yp = y;
                    y.x = cvtpk(o[8] * ow[2].x * siluf_(bflo(zc1.x)), o[9] * ow[2].y * siluf_(bfhi(zc1.x))); y.y = cvtpk(o[10] * ow[2].z * siluf_(bflo(zc1.y)), o[11] * ow[2].w * siluf_(bfhi(zc1.y)));
                    y.z = cvtpk(o[12] * ow[3].x * siluf_(bflo(zc1.z)), o[13] * ow[3].y * siluf_(bfhi(zc1.z))); y.w = cvtpk(o[14] * ow[3].z * siluf_(bflo(zc1.w)), o[15] * ow[3].w * siluf_(bfhi(zc1.w)));
                    *(v4u*)(yp + 8) = y;
                    sqp[(size_t)(n - 1) * DNC * 8] = ss;
                }
                zc0 = zn0; zc1 = zn1;
            }
#undef DN_DMA
        }
        asm volatile("s_waitcnt vmcnt(0)" ::: "memory"); __syncthreads();
    }
}
__device__ __forceinline__ void ph_yb_norm(KArgs a, const Ctx& c) {
    const int gw = c.bid * NW + c.wave, NGW = c.G * NW, lane = c.lane; bf16* YB = (bf16*)(a->ws + WS_YB); const float* ssq = (const float*)(a->ws + WS_SSQ);
    for (int m = gw; m < NTOK; m += NGW) {
        const f32x2_t sq = *(const f32x2_t*)(ssq + (size_t)m * 8 + (lane >> 4) * 2); const float rstd = __builtin_amdgcn_rsqf((sq.x + sq.y) * (1.f / 128.f) + EPS);
        v4u w = *(const v4u*)(YB + (size_t)m * 512 + lane * 8);
        w.x = cvtpk(bflo(w.x) * rstd, bfhi(w.x) * rstd); w.y = cvtpk(bflo(w.y) * rstd, bfhi(w.y) * rstd); w.z = cvtpk(bflo(w.z) * rstd, bfhi(w.z) * rstd); w.w = cvtpk(bflo(w.w) * rstd, bfhi(w.w) * rstd);
        *(v4u*)(YB + (size_t)m * 512 + lane * 8) = w;
    }
}
typedef short v4i16_t __attribute__((ext_vector_type(4)));
#define MFMA32(a, b, c) __builtin_amdgcn_mfma_f32_32x32x16_bf16((a), (b), (c), 0, 0, 0)
constexpr int AT_ROWB = 144;
constexpr int AT_TILE = 64 * AT_ROWB, AT_K = 0, AT_V = 3 * AT_TILE, AT_OST = 6 * AT_TILE, AT_BT = AT_OST + 8 * 32 * AT_ROWB, AT_KM = AT_BT + 1024, AT_UW = MISC_OFF + 512;
__device__ __forceinline__ int crow(int r, int hi) { return (r & 3) + 8 * (r >> 2) + 4 * hi; }
__device__ __forceinline__ bf16x8 vtr2(const LAS unsigned char* p) {
    const v4i16_t lo = __builtin_amdgcn_ds_read_tr16_b64_v4i16((LAS v4i16_t*)p), hi = __builtin_amdgcn_ds_read_tr16_b64_v4i16((LAS v4i16_t*)(p + 8 * AT_ROWB));
    return (bf16x8){lo[0], lo[1], lo[2], lo[3], hi[0], hi[1], hi[2], hi[3]};
}
__device__ __forceinline__ void ph_attn(KArgs a, const Ctx& c, int l) {
    LAS unsigned char* lds = c.lds; const int lane = c.lane, wv = c.wave, tid = c.tid, r32 = lane & 31, hi = lane >> 5;
    LAS float* btab = (LAS float*)(lds + AT_BT); LAS float* kms = (LAS float*)(lds + AT_KM); volatile LAS int* uw = (volatile LAS int*)(lds + AT_UW);
    const bf16* QKVA = (const bf16*)(a->ws + WS_QKVA); const float* kmean = (const float*)(a->ws + WS_KMEAN); bf16* YA = (bf16*)(a->ws + WS_YA); const float* relb = a->in[I_RELB];
    unsigned* ctr = (unsigned*)(a->ws + WS_CTL) + CW_ACTR + l * 64;
    const float LOG2E = 1.4426950408889634f, C2 = 0.125f * LOG2E, NINF = -__builtin_inff();
    const int srow = tid >> 3, sch = tid & 7; const unsigned sdst = srow * AT_ROWB + sch * 16;
    for (;;) {
        __syncthreads();
        if (tid == 0) uw[0] = (int)__hip_atomic_fetch_add(ctr, 1u, RLX_AGENT);
        __syncthreads();
        const int u0 = uw[0];
        constexpr int NCVQ = CV_NUNITS - CV_EARLYQ;
        if (u0 < NCVQ) { convert_unit(a, c, l, CV_EARLYQ + u0); continue; }
        const int u = u0 - NCVQ; if (u >= NB * HA * NBLK) break;
        const int qb = 15 - (u >> 5), bh = u & 31, b = bh >> 3, h = bh & 7;
        const float c31 = relb[31 * 8 + h];
        for (int i = tid; i < 129; i += NTHR) btab[i] = (i < 128 ? (relb[(int)T5B[i] * 8 + h] - c31) : 0.f) * LOG2E;
        for (int i = tid; i < 1024; i += NTHR) kms[i] = kmean[(size_t)bh * 1024 + i];
        const int qrel = wv * 32 + r32, tokq = b * SEQ + qb * 256 + qrel;
        const bf16* kbase = QKVA + (size_t)(b * SEQ) * 1536 + 512 + h * 64 + sch * 8;
#define AT_LOAD(tt, KR, VR) do { const int t1_ = (tt), blk1_ = t1_ < 4 ? qb : ((t1_ - 4) >> 2), kt1_ = t1_ < 4 ? t1_ : ((t1_ - 4) & 3); const size_t ro_ = (size_t)(blk1_ * 256 + kt1_ * 64 + srow) * 1536; \
            KR = *(const v4u*)(kbase + ro_); VR = *(const v4u*)(kbase + ro_ + 512); } while (0)
#define AT_STORE(tt, KR, VR) do { const int bo_ = ((tt) % 3) * AT_TILE; *(LAS v4u*)(lds + AT_K + bo_ + sdst) = KR; *(LAS v4u*)(lds + AT_V + bo_ + sdst) = VR; } while (0)
        v4u krA, vrA, krB, vrB;
        AT_LOAD(0, krA, vrA); AT_LOAD(1, krB, vrB);
        float qf[32];
        {   const bf16* qp = QKVA + (size_t)tokq * 1536 + h * 64 + 8 * hi;
#pragma unroll
            for (int s = 0; s < 4; ++s) { const v4u w = *(const v4u*)(qp + 16 * s); qf[s * 8 + 0] = bflo(w.x); qf[s * 8 + 1] = bfhi(w.x); qf[s * 8 + 2] = bflo(w.y); qf[s * 8 + 3] = bfhi(w.y); qf[s * 8 + 4] = bflo(w.z); qf[s * 8 + 5] = bfhi(w.z); qf[s * 8 + 6] = bflo(w.w); qf[s * 8 + 7] = bfhi(w.w); } }
        AT_STORE(0, krA, vrA); AT_STORE(1, krB, vrB); AT_LOAD(2, krA, vrA);
        __syncthreads();
        unsigned selmask = 0u;
        {   float g[16];
#pragma unroll
            for (int n = 0; n < 16; ++n) { g[n] = -3e38f;
                if (n < qb) { float d = 0.f;
#pragma unroll
                    for (int s = 0; s < 4; ++s) { const f32x4 k0 = *(const LAS f32x4*)(kms + n * 64 + 16 * s + 8 * hi), k1 = *(const LAS f32x4*)(kms + n * 64 + 16 * s + 8 * hi + 4);
                        d += qf[s * 8] * k0.x + qf[s * 8 + 1] * k0.y + qf[s * 8 + 2] * k0.z + qf[s * 8 + 3] * k0.w + qf[s * 8 + 4] * k1.x + qf[s * 8 + 5] * k1.y + qf[s * 8 + 6] * k1.z + qf[s * 8 + 7] * k1.w; }
                    g[n] = d + shx(d, 32, lane); } }
#pragma unroll
            for (int t = 0; t < 3; ++t) { float best = -3.4e38f; int bi = 0;
#pragma unroll
                for (int n = 0; n < 16; ++n) { const bool ok = !((selmask >> n) & 1u) && g[n] > best; best = ok ? g[n] : best; bi = ok ? n : bi; }
                selmask |= 1u << bi; }
            selmask &= (1u << qb) - 1u; }
        bf16x8 qs[4];
#pragma unroll
        for (int s = 0; s < 4; ++s) { v4u w; w.x = cvtpk(qf[s * 8] * C2, qf[s * 8 + 1] * C2); w.y = cvtpk(qf[s * 8 + 2] * C2, qf[s * 8 + 3] * C2); w.z = cvtpk(qf[s * 8 + 4] * C2, qf[s * 8 + 5] * C2); w.w = cvtpk(qf[s * 8 + 6] * C2, qf[s * 8 + 7] * C2); qs[s] = __builtin_bit_cast(bf16x8, w); }
        float mref = 0.f, lsum = 0.f; f32x16 o0, o1;
#pragma unroll
        for (int r = 0; r < 16; ++r) { o0[r] = 0.f; o1[r] = 0.f; }
        const int NT = 4 * (qb + 1);
        for (int t0 = 0; t0 < NT; t0 += 2) {
#pragma unroll
            for (int hf = 0; hf < 2; ++hf) {
                const int t = t0 + hf;
                const int blk = t < 4 ? qb : ((t - 4) >> 2), kt = t < 4 ? t : ((t - 4) & 3);
                if (hf == 0) { if (t + 3 < NT) AT_LOAD(t + 3, krB, vrB); } else { if (t + 3 < NT) AT_LOAD(t + 3, krA, vrA); }
                const bool own = t < 4;
                const bool lane_act = own || ((selmask >> blk) & 1u);
                const bool wave_act = own ? (kt * 64 <= wv * 32 + 31) : (__builtin_amdgcn_ballot_w64(lane_act) != 0ull);
                if (wave_act) {
                    const LAS unsigned char* Kb = lds + AT_K + (t % 3) * AT_TILE; const LAS unsigned char* Vb = lds + AT_V + (t % 3) * AT_TILE;
                    const float nm = lane_act ? -mref : NINF;
                    f32x16 p0, p1;
#pragma unroll
                    for (int r = 0; r < 16; ++r) { p0[r] = nm; p1[r] = nm; }
#pragma unroll
                    for (int s = 0; s < 4; ++s) { const bf16x8 a0 = *(const LAS bf16x8*)(Kb + r32 * AT_ROWB + 32 * s + 16 * hi), a1 = *(const LAS bf16x8*)(Kb + (32 + r32) * AT_ROWB + 32 * s + 16 * hi);
                        p0 = MFMA32(a0, qs[s], p0); p1 = MFMA32(a1, qs[s], p1); }
                    if (own) {
#pragma unroll
                        for (int r = 0; r < 16; ++r) { const int d0 = qrel - (kt * 64 + crow(r, hi)), d1 = d0 - 32;
                            const float b0 = btab[d0 < 0 ? 0 : (d0 > 128 ? 128 : d0)], b1 = btab[d1 < 0 ? 0 : (d1 > 128 ? 128 : d1)];
                            p0[r] = d0 >= 0 ? p0[r] + b0 : NINF; p1[r] = d1 >= 0 ? p1[r] + b1 : NINF; }
                    } else if (blk == qb - 1 && kt >= 1) {
#pragma unroll
                        for (int r = 0; r < 16; ++r) { const int d0 = qrel + 256 - (kt * 64 + crow(r, hi)), d1 = d0 - 32;
                            p0[r] += btab[d0 > 128 ? 128 : d0]; p1[r] += btab[d1 > 128 ? 128 : d1]; }
                    }
#define MX3_(a_, b_, c_) __builtin_fmaxf(__builtin_fmaxf((a_), (b_)), (c_))
                    float mxa = MX3_(p0[0], p0[1], p1[0]), mxb = MX3_(p0[2], p0[3], p1[1]); mxa = MX3_(mxa, p1[2], p1[3]);
#pragma unroll
                    for (int r = 4; r < 16; r += 4) { mxa = MX3_(mxa, p0[r], p0[r + 1]); mxb = MX3_(mxb, p0[r + 2], p0[r + 3]); mxa = MX3_(mxa, p1[r], p1[r + 1]); mxb = MX3_(mxb, p1[r + 2], p1[r + 3]); }
#undef MX3_
                    float mx = __builtin_fmaxf(mxa, mxb); mx = __builtin_fmaxf(mx, shx(mx, 32, lane));
                    if (__builtin_amdgcn_ballot_w64(mx > 8.f) != 0ull) { const float dl = __builtin_fmaxf(mx, 0.f); mref += dl; const float f = __builtin_amdgcn_exp2f(-dl);
#pragma unroll
                        for (int r = 0; r < 16; ++r) { p0[r] -= dl; p1[r] -= dl; o0[r] *= f; o1[r] *= f; }
                        lsum *= f; }
                    float rs0 = 0.f, rs1 = 0.f;
#pragma unroll
                    for (int r = 0; r < 16; ++r) { p0[r] = __builtin_amdgcn_exp2f(p0[r]); p1[r] = __builtin_amdgcn_exp2f(p1[r]); rs0 += p0[r]; rs1 += p1[r]; }
                    lsum += rs0 + rs1;
                    bf16x8 pa[4];
                    { v4u w; w.x = cvtpk(p0[0], p0[1]); w.y = cvtpk(p0[2], p0[3]); w.z = cvtpk(p0[4], p0[5]); w.w = cvtpk(p0[6], p0[7]); pa[0] = __builtin_bit_cast(bf16x8, w);
                      w.x = cvtpk(p0[8], p0[9]); w.y = cvtpk(p0[10], p0[11]); w.z = cvtpk(p0[12], p0[13]); w.w = cvtpk(p0[14], p0[15]); pa[1] = __builtin_bit_cast(bf16x8, w);
                      w.x = cvtpk(p1[0], p1[1]); w.y = cvtpk(p1[2], p1[3]); w.z = cvtpk(p1[4], p1[5]); w.w = cvtpk(p1[6], p1[7]); pa[2] = __builtin_bit_cast(bf16x8, w);
                      w.x = cvtpk(p1[8], p1[9]); w.y = cvtpk(p1[10], p1[11]); w.z = cvtpk(p1[12], p1[13]); w.w = cvtpk(p1[14], p1[15]); pa[3] = __builtin_bit_cast(bf16x8, w); }
                    const LAS unsigned char* vp = Vb + (4 * hi + ((lane & 15) >> 2)) * AT_ROWB + 2 * (16 * ((lane >> 4) & 1) + 4 * (lane & 3));
#pragma unroll
                    for (int ks = 0; ks < 4; ++ks) { const bf16x8 v0 = vtr2(vp + 16 * ks * AT_ROWB), v1 = vtr2(vp + 16 * ks * AT_ROWB + 64);
                        o0 = MFMA32(v0, pa[ks], o0); o1 = MFMA32(v1, pa[ks], o1); }
                }

                if (hf == 0) { if (t + 2 < NT) AT_STORE(t + 2, krA, vrA); } else { if (t + 2 < NT) AT_STORE(t + 2, krB, vrB); }
                asm volatile("s_waitcnt lgkmcnt(0)\n\ts_barrier" ::: "memory");
            }
        }
#undef AT_LOAD
#undef AT_STORE
        lsum += shx(lsum, 32, lane);
        const float inv = rcpf_(lsum);
        LAS unsigned short* stg = (LAS unsigned short*)(lds + AT_OST + wv * 32 * AT_ROWB);
#pragma unroll
        for (int r = 0; r < 16; ++r) { stg[r32 * (AT_ROWB / 2) + crow(r, hi)] = (unsigned short)(cvtpk(o0[r] * inv, 0.f) & 0xffffu); stg[r32 * (AT_ROWB / 2) + 32 + crow(r, hi)] = (unsigned short)(cvtpk(o1[r] * inv, 0.f) & 0xffffu); }
        LDS_WAIT();
#pragma unroll
        for (int i = 0; i < 4; ++i) { const int row = i * 8 + (lane >> 3), ch = lane & 7; const v4u v = *(const LAS v4u*)((const LAS unsigned char*)stg + row * AT_ROWB + ch * 16);
            *(v4u*)(YA + (size_t)(b * SEQ + qb * 256 + wv * 32 + row) * 512 + h * 64 + ch * 8) = v; }
    }
}
constexpr int NPH_LAYER = 11, NPHASES = 2 + NLAYER * NPH_LAYER;
#ifndef DN_IMPL
#define DN_IMPL 1
#endif
#ifndef PH_MASK
#define PH_MASK 0xFFFF
#endif
#define PH_EN(k) ((PH_MASK >> (k)) & 1)
#define GEMM_PHASE(EPI, SCHED, g, S, E) pg8::gemm_phase<EPI, SCHED, true, true>(c.lds, g, S, E, c.tid)

#define PHASE_FN static __device__ __forceinline__ void
__device__ __forceinline__ KArgs launder_k(KArgs a) { unsigned long long v = (unsigned long long)a; asm volatile("" : "+s"(v)); return (KArgs)v; }
PHASE_FN f_mod(KArgs a, int& tid) { a = launder_k(a); Ctx c = make_ctx(tid); ph_mod(a, c); }
PHASE_FN f_norm1(KArgs a, int& tid, int l) { a = launder_k(a); Ctx c = make_ctx(tid); ph_norm1(a, c, l); __syncthreads(); ph_convert(a, c, l); }
PHASE_FN f_proj(KArgs a, int& tid, int l) { a = launder_k(a); Ctx c = make_ctx(tid);
    pg8::Gemm g{(const bf16*)(a->ws + WS_H), (const bf16*)(a->ws + WS_WIN), NTOK, DINP, DM}; pg8::StaticOrder S; S.init(NTOK, DINP, c.G, c.bid);
    EpiProj E{a->ws}; GEMM_PHASE(EpiProj, pg8::StaticOrder, g, S, E);
    {   volatile LAS int* uw = (volatile LAS int*)(c.lds + MISC_OFF + 512); unsigned* ctr = (unsigned*)(a->ws + WS_CTL) + CW_CCTR + l * 64;
        for (;;) { __syncthreads(); if (c.tid == 0) uw[0] = (int)__hip_atomic_fetch_add(ctr, 1u, RLX_AGENT); __syncthreads();
            const int u = uw[0]; if (u >= CV_EARLYQ) break; convert_unit(a, c, l, u); } } }
PHASE_FN f_kmean(KArgs a, int& tid) { a = launder_k(a); Ctx c = make_ctx(tid); ph_kmean(a, c); }
#ifndef ATTN_IMPL
#define ATTN_IMPL 1
#endif
#if ATTN_IMPL
PHASE_FN f_attn(KArgs a, int& tid, int l) { a = launder_k(a); Ctx c = make_ctx(tid); ph_attn(a, c, l); }
#else
PHASE_FN f_attn(KArgs a, int& tid, int l) { a = launder_k(a); Ctx c = make_ctx(tid); ph_attn_simple(a, c); }
#endif
PHASE_FN f_dn(KArgs a, int& tid, int l) { a = launder_k(a); Ctx c = make_ctx(tid); ph_dn_simple(a, c, l); }
PHASE_FN f_dn_prep(KArgs a, int& tid, int l) { a = launder_k(a); Ctx c = make_ctx(tid); ph_dn_prep(a, c, l); }
PHASE_FN f_dn_scan(KArgs a, int& tid, int l) { a = launder_k(a); Ctx c = make_ctx(tid); ph_dn_scan(a, c, l); }
PHASE_FN f_merge1(KArgs a, int& tid) { a = launder_k(a); Ctx c = make_ctx(tid);
    ph_yb_norm(a, c);
    pg8::Gemm g{(const bf16*)(a->ws + WS_YA), (const bf16*)(a->ws + WS_WUPA), NTOK, DM, WA}; pg8::StaticOrder S; S.init(NTOK, DM, c.G, c.bid);
    EpiMerge<false> E{a->ws}; GEMM_PHASE(EpiMerge<false>, pg8::StaticOrder, g, S, E); }
PHASE_FN f_merge2(KArgs a, int& tid) { a = launder_k(a); Ctx c = make_ctx(tid);
    pg8::Gemm g{(const bf16*)(a->ws + WS_YB), (const bf16*)(a->ws + WS_WUPB), NTOK, DM, WB}; pg8::StaticOrder S; S.init(NTOK, DM, c.G, c.bid);
    EpiMerge<true> E{a->ws}; GEMM_PHASE(EpiMerge<true>, pg8::StaticOrder, g, S, E); }
PHASE_FN f_out(KArgs a, int& tid, int l) { a = launder_k(a); Ctx c = make_ctx(tid);
    pg8::Gemm g{(const bf16*)(a->ws + WS_M), (const bf16*)(a->ws + WS_WOUT), NTOK, DM, DM}; pg8::StaticOrder S; S.init(NTOK, DM, c.G, c.bid);
    EpiOut E{l == 0 ? a->in[I_X] : (const float*)a->out, a->out, (const float*)(a->ws + WS_MOD) + l * 4 * 6144 + 2048}; GEMM_PHASE(EpiOut, pg8::StaticOrder, g, S, E); }
PHASE_FN f_router(KArgs a, int& tid, int l) { a = launder_k(a); Ctx c = make_ctx(tid); ph_router(a, c, l); }
PHASE_FN f_gather(KArgs a, int& tid, int l) { a = launder_k(a); Ctx c = make_ctx(tid); ph_gather(a, c, l); }
PHASE_FN f_moe_gu(KArgs a, int& tid, int l) { a = launder_k(a); Ctx c = make_ctx(tid);
    moe_table(a, c, l); const LAS int* te = (const LAS int*)(c.lds + MISC_OFF + 2048);
    pg8::Gemm g{(const bf16*)(a->ws + WS_HS), (const bf16*)(a->ws + WS_WEGU), MOE_MAXROWS, NEXP * 512, DM}; MoeOrder S{te, te[192 + 32] * 2, c.G, c.bid, 1};
    EpiMoeGU E{a->ws}; GEMM_PHASE(EpiMoeGU, MoeOrder, g, S, E); }
PHASE_FN f_moe_down(KArgs a, int& tid, int l) { a = launder_k(a); Ctx c = make_ctx(tid);
    moe_table(a, c, l); const LAS int* te = (const LAS int*)(c.lds + MISC_OFF + 2048);
    pg8::Gemm g{(const bf16*)(a->ws + WS_ACT), (const bf16*)(a->ws + WS_WED), MOE_MAXROWS, NEXP * 1024, DFF}; MoeOrder S{te, te[192 + 32] * 4, c.G, c.bid, 2};
    EpiMoeDown E{a->ws}; GEMM_PHASE(EpiMoeDown, MoeOrder, g, S, E); }
PHASE_FN f_final(KArgs a, int& tid) { a = launder_k(a); Ctx c = make_ctx(tid); ph_final(a, c); }

#define KA() launder_k((KArgs)__builtin_amdgcn_kernarg_segment_ptr())
__device__ __forceinline__ bool ph_in(int k) { KArgs a = KA(); return a->ph_lo <= k && k < a->ph_hi; }
#ifndef MK_PROBE_A
#define MK_PROBE_A -1
#endif
#ifndef MK_PROBE_B
#define MK_PROBE_B -1
#endif
constexpr int CW_TS = 12288;
__device__ __forceinline__ void grid_bar(int& tid, int k) {
    asm volatile("" : "+v"(tid));
#if MK_ONE_LAUNCH
    KArgs a = KA(); XcdBarrier b; b.bar = (unsigned*)(a->ws + WS_CTL) + CW_BAR; b.x = xb_xcc_id(); b.st = (volatile LAS unsigned*)((LAS unsigned char*)lds_raw + MISC_OFF) + 8;
    xcd_barrier(b, tid);
    if (MK_PROBE_A >= 0 && blockIdx.x == 0 && tid == 0) ((unsigned long long*)((unsigned*)(a->ws + WS_CTL) + CW_TS))[k + 1] = __builtin_amdgcn_s_memrealtime();
#else
    __syncthreads();
#endif
}
__global__ void __launch_bounds__(NTHR, 2) mk_fwd(Args a_) {
    int tid = threadIdx.x;
    {   volatile LAS unsigned* MISC = (volatile LAS unsigned*)((LAS unsigned char*)lds_raw + MISC_OFF);
        if (tid < 64) MISC[tid] = 0u;
        __syncthreads();
#if MK_ONE_LAUNCH
        (void)xcd_barrier_post((unsigned*)(KA()->ws + WS_CTL) + CW_BAR, MISC + 8, tid);
#endif
        if (MK_PROBE_A >= 0 && blockIdx.x == 0 && tid == 0) ((unsigned long long*)((unsigned*)(KA()->ws + WS_CTL) + CW_TS))[0] = __builtin_amdgcn_s_memrealtime();
    }
#define IN(k) ph_in(k)
#define SEAM(k) do { if (IN(k) && IN((k) + 1)) grid_bar(tid, (k)); } while (0)
    if (IN(0)) f_mod(KA(), tid); SEAM(0);
    for (int l = 0; l < NLAYER; ++l) {
        const int pb = 1 + l * NPH_LAYER;
        if (PH_EN(0) && IN(pb + 0)) f_norm1(KA(), tid, l); SEAM(pb + 0);
        if (PH_EN(1) && IN(pb + 1)) f_proj(KA(), tid, l); SEAM(pb + 1);
#if DN_IMPL
        if (PH_EN(2) && IN(pb + 2)) { f_kmean(KA(), tid); f_dn_prep(KA(), tid, l); } SEAM(pb + 2);
        if (PH_EN(3) && IN(pb + 3)) { f_dn_scan(KA(), tid, l);
            if (MK_PROBE_A == 20 && blockIdx.x == 0 && tid == 0) ((unsigned long long*)((unsigned*)(KA()->ws + WS_CTL) + CW_TS))[40 + l] = __builtin_amdgcn_s_memrealtime();
            __syncthreads(); f_attn(KA(), tid, l);
            if (MK_PROBE_A == 21 && blockIdx.x == 255 && tid == 0) ((unsigned long long*)((unsigned*)(KA()->ws + WS_CTL) + CW_TS))[44 + l] = __builtin_amdgcn_s_memrealtime(); } SEAM(pb + 3);
#else
        if (PH_EN(2) && IN(pb + 2)) f_kmean(KA(), tid); SEAM(pb + 2);
        if (PH_EN(3) && IN(pb + 3)) { f_attn(KA(), tid, l); __syncthreads(); f_dn(KA(), tid, l); } SEAM(pb + 3);
#endif
        if (PH_EN(4) && IN(pb + 4)) f_merge1(KA(), tid); SEAM(pb + 4);
        if (PH_EN(5) && IN(pb + 5)) f_merge2(KA(), tid); SEAM(pb + 5);
        if (PH_EN(6) && IN(pb + 6)) f_out(KA(), tid, l); SEAM(pb + 6);
        if (PH_EN(7) && IN(pb + 7)) f_router(KA(), tid, l); SEAM(pb + 7);
        if (PH_EN(8) && IN(pb + 8)) f_gather(KA(), tid, l); SEAM(pb + 8);
        if (PH_EN(9) && IN(pb + 9)) f_moe_gu(KA(), tid, l); SEAM(pb + 9);
        if (PH_EN(10) && IN(pb + 10)) f_moe_down(KA(), tid, l); SEAM(pb + 10);
    }
    if (IN(NPHASES - 1)) f_final(KA(), tid);
#undef IN
#undef SEAM
}

extern "C" void kernel_launch(void* const* d_in, const int* in_sizes, int n_in, void* d_out, int out_size, void* d_ws, size_t ws_size, hipStream_t stream) {
    static int grid = 0;
    if (grid == 0) {
        if (n_in != 23 || out_size != NTOK * DM || ws_size < WS_END) { fprintf(stderr, "kernel_launch: unexpected shapes (n_in %d out %d ws %zu)\n", n_in, out_size, ws_size); grid = -1; return; }
        int dev = 0, cus = 0, per_cu = 0;
        if (hipGetDevice(&dev) != hipSuccess || hipDeviceGetAttribute(&cus, hipDeviceAttributeMultiprocessorCount, dev) != hipSuccess) { grid = -1; return; }
        if (hipFuncSetAttribute((const void*)mk_fwd, hipFuncAttributeMaxDynamicSharedMemorySize, LDS_BYTES) != hipSuccess) { fprintf(stderr, "kernel_launch: hipFuncSetAttribute failed\n"); grid = -1; return; }
        if (hipOccupancyMaxActiveBlocksPerMultiprocessor(&per_cu, (const void*)mk_fwd, NTHR, LDS_BYTES) != hipSuccess || per_cu < 1) { fprintf(stderr, "kernel_launch: occupancy query says %d\n", per_cu); (void)hipGetLastError(); grid = -1; return; }
        grid = cus;
    }
    if (grid < 0) return;
    (void)hipMemsetAsync((char*)d_ws + WS_CTL, 0, CTL_ZERO_BYTES, stream);
    Args a{};
    for (int i = 0; i < 23; ++i) a.in[i] = (const float*)d_in[i];
    a.out = (float*)d_out; a.ws = (unsigned char*)d_ws;
#if MK_ONE_LAUNCH
    a.ph_lo = 0; a.ph_hi = NPHASES;
    hipLaunchKernelGGL(mk_fwd, dim3(grid), dim3(NTHR), LDS_BYTES, stream, a);
#else
    for (int p = 0; p < NPHASES; ++p) { a.ph_lo = p; a.ph_hi = p + 1; hipLaunchKernelGGL(mk_fwd, dim3(grid), dim3(NTHR), LDS_BYTES, stream, a); }
#endif
}
```

```cpp
#include <hip/hip_runtime.h>
#include <cstdio>
#include <cstdint>
#ifndef MK_ONE_LAUNCH
#define MK_ONE_LAUNCH 1
#endif
#ifndef MK_PROBE_A
#define MK_PROBE_A -1
#endif
#ifndef MK_PROBE_B
#define MK_PROBE_B -1
#endif
namespace pg8 {
#define PG8_LAS __attribute__((address_space(3)))
typedef unsigned short bf16_t;
typedef short bf16x8 __attribute__((ext_vector_type(8)));
typedef float f32x4 __attribute__((ext_vector_type(4)));
typedef unsigned u32x4 __attribute__((ext_vector_type(4)));
constexpr int BM = 256, BK = 64, HALF = 128, HTB = HALF * BK * 2  , STAGE_BYTES = 8 * HTB, NXCD = 8, WGM = 8;

__host__ __device__ __forceinline__ int lds_byte(int r, int c) { const int st = (r >> 4) * 2 + (c >> 5), rr = r & 15, cc = c & 31, ob = rr * 64 + cc * 2; return st * 1024 + (ob ^ (((ob >> 9) & 1) << 5)); }
__host__ __device__ __forceinline__ void stage_rc(int b, int& R, int& C) { const int st = b / 1024, sb = b % 1024, swz = sb ^ (((sb >> 9) & 1) << 5); R = (st >> 1) * 16 + swz / 64; C = (st & 1) * 32 + (swz % 64) / 2; }
__host__ __device__ __forceinline__ int perm32(int rho) { const int n = rho >> 4, i = rho & 15; return 8 * (i >> 2) + 4 * n + (i & 3); }

struct Unit { int pm, pn; };
struct Gemm { const bf16_t* A; const bf16_t* Bt; int M, N, K; };

struct StaticOrder {
    int nM, nN, nwg, G, c;
    __host__ __device__ void init(int M, int N, int G_, int c_) { nM = M / BM; nN = N / BM; nwg = nM * nN; G = G_; c = c_; }
    __host__ __device__ bool next(int i, Unit& u) const {
        const long L = (long)i * G + c; if (L >= nwg) return false;
        int wgid = (int)L; { const int q = nwg / NXCD, r = nwg % NXCD, xcd = wgid % NXCD, off = wgid / NXCD; wgid = (xcd < r ? xcd * (q + 1) : r * (q + 1) + (xcd - r) * q) + off; }
        const int nig = WGM * nN, gid = wgid / nig, fm = gid * WGM, gsz = (nM - fm) < WGM ? (nM - fm) : WGM;
        u.pm = fm + ((wgid % nig) % gsz); u.pn = (wgid % nig) / gsz; return true;
    }
    __device__ __forceinline__ void a_ready(const Unit&) const {}
    __device__ __forceinline__ void done(const Unit&) const {}
};

__device__ __forceinline__ unsigned cvt_pk_bf16(float lo, float hi) { unsigned r; asm volatile("v_cvt_pk_bf16_f32 %0, %1, %2" : "=v"(r) : "v"(lo), "v"(hi)); return r; }
typedef float f32x2 __attribute__((ext_vector_type(2)));
template <class Epi, class Sched, bool ALIGN_EPI = false, bool SP2 = false>
__device__ __forceinline__ void gemm_phase(PG8_LAS unsigned char* lds, const Gemm g, const Sched& S, const Epi& E, const int tid_in) {
    const int tid = tid_in, wid = __builtin_amdgcn_readfirstlane(tid >> 6), lane = tid & 63, wr = wid >> 2, wc = wid & 3, fr = lane & 15, fq = lane >> 4;
    const int K = g.K, nt = K / BK;
    unsigned voffA[2], voffB[2];
#pragma unroll
    for (int i = 0; i < 2; ++i) { int R, C; stage_rc(tid * 16 + i * 8192, R, C); const int Rb = Epi::PERM ? ((R & ~31) + perm32(R & 31)) : R;
        voffA[i] = (unsigned)(R * K + C) * 2u; voffB[i] = (unsigned)(Rb * K + C) * 2u; }
    const size_t kstep = (size_t)(BK * 2);
    const size_t hstep = (size_t)HALF * K * 2;
    const size_t tstep = 2 * hstep;
    const unsigned ldsw = (unsigned)wid * 1024u;
    const int aoff = lds_byte(wr * 64 + fr, fq * 8), boff = lds_byte(wc * 32 + fr, fq * 8);
#define PG8_SA(b, h) (((b) * 2 + (h)) * HTB)
#define PG8_SB(b, h) ((4 + (b) * 2 + (h)) * HTB)
#define PG8_STAGE(bufoff, gbase, voff) do { _Pragma("unroll") for (int _i = 0; _i < 2; ++_i) \
        __builtin_amdgcn_global_load_lds((const unsigned*)((const char*)(gbase) + (voff)[_i]), (PG8_LAS unsigned*)(lds + (bufoff) + ldsw + _i * 8192), 16, 0, 0); } while (0)
#define PG8_LDA(dst, b, h) do { _Pragma("unroll") for (int m = 0; m < 4; ++m) _Pragma("unroll") for (int k = 0; k < 2; ++k) dst[m][k] = *(const PG8_LAS bf16x8*)(lds + PG8_SA(b, h) + aoff + m * 2048 + k * 1024); } while (0)
#define PG8_LDB(dst, b, h) do { _Pragma("unroll") for (int n = 0; n < 2; ++n) _Pragma("unroll") for (int k = 0; k < 2; ++k) dst[n][k] = *(const PG8_LAS bf16x8*)(lds + PG8_SB(b, h) + boff + n * 2048 + k * 1024); } while (0)
#define PG8_MMA(ai, bj, At, Bt) do { __builtin_amdgcn_s_setprio(1); _Pragma("unroll") for (int m = 0; m < 4; ++m) _Pragma("unroll") for (int n = 0; n < 2; ++n) _Pragma("unroll") for (int k = 0; k < 2; ++k) \
        acc[ai][bj][m][n] = __builtin_amdgcn_mfma_f32_16x16x32_bf16(Bt[n][k], At[m][k], acc[ai][bj][m][n], 0, 0, 0); __builtin_amdgcn_s_setprio(0); } while (0)
#define PG8_WAIT_V(n) asm volatile("s_waitcnt vmcnt(" #n ")" ::: "memory")
#define PG8_WAIT_L(n) asm volatile("s_waitcnt lgkmcnt(" #n ")" ::: "memory")
#define PG8_BAR __builtin_amdgcn_s_barrier()
#define PG8_SCHED __builtin_amdgcn_sched_barrier(0)
    Unit cur, nxt; int ui = 0;
    if (!S.next(0, cur)) return;
    f32x4 acc[2][2][4][2];
    float zf_ = 0.f; asm volatile("" : "+v"(zf_));
#pragma unroll
    for (int a = 0; a < 2; ++a)
#pragma unroll
        for (int b = 0; b < 2; ++b)
#pragma unroll
            for (int m = 0; m < 4; ++m)
#pragma unroll
                for (int n = 0; n < 2; ++n) acc[a][b][m][n] = (f32x4){zf_, zf_, zf_, zf_};
    bf16x8 At[4][2], B0[2][2], B1[2][2];
    const char* cA = (const char*)g.A + (size_t)cur.pm * tstep; const char* cB = (const char*)g.Bt + (size_t)cur.pn * tstep;
    S.a_ready(cur);
    if constexpr (SP2) {
        PG8_STAGE(PG8_SB(0, 0), cB, voffB); PG8_STAGE(PG8_SB(0, 1), cB + hstep, voffB); PG8_STAGE(PG8_SA(0, 0), cA, voffA); PG8_STAGE(PG8_SA(0, 1), cA + hstep, voffA);
        if (wr == 1) PG8_BAR;
        PG8_WAIT_V(2); PG8_BAR;
        PG8_STAGE(PG8_SB(1, 0), cB + kstep, voffB); PG8_STAGE(PG8_SA(1, 0), cA + kstep, voffA); PG8_STAGE(PG8_SB(1, 1), cB + hstep + kstep, voffB);
        PG8_WAIT_V(6); PG8_BAR;
    } else {
        PG8_STAGE(PG8_SB(0, 0), cB, voffB); PG8_STAGE(PG8_SA(0, 0), cA, voffA); PG8_STAGE(PG8_SB(0, 1), cB + hstep, voffB); PG8_STAGE(PG8_SA(0, 1), cA + hstep, voffA);
        if (wr == 1) PG8_BAR;
        PG8_WAIT_V(4); PG8_BAR;
        PG8_STAGE(PG8_SB(1, 0), cB + kstep, voffB); PG8_STAGE(PG8_SA(1, 0), cA + kstep, voffA); PG8_STAGE(PG8_SB(1, 1), cB + hstep + kstep, voffB);
        PG8_WAIT_V(6); PG8_BAR;
    }
    for (;;) {
        const bool has_next = S.next(ui + 1, nxt);
        const char* nA = has_next ? (const char*)g.A + (size_t)nxt.pm * tstep : cA; const char* nB = has_next ? (const char*)g.Bt + (size_t)nxt.pn * tstep : cB;
        for (int t = 0; t < nt; t += 2) {
            const bool last = (t == nt - 2);
            const char* a1 = cA + (size_t)(t + 1) * kstep;
            const char* a2 = last ? nA : cA + (size_t)(t + 2) * kstep; const char* b2 = last ? nB : cB + (size_t)(t + 2) * kstep;
            const char* a3 = a2 + kstep; const char* b3 = b2 + kstep;
            if (last && has_next) S.a_ready(nxt);
            if constexpr (SP2) {
            PG8_LDB(B0, 0, 0); PG8_LDB(B1, 0, 1); PG8_SCHED; PG8_LDA(At, 0, 0); PG8_STAGE(PG8_SA(1, 1), a1 + hstep, voffA);
            PG8_WAIT_V(8); PG8_WAIT_L(0); PG8_BAR; PG8_MMA(0, 0, At, B0); PG8_MMA(0, 1, At, B1); PG8_BAR; PG8_SCHED;
            PG8_LDA(At, 0, 1); PG8_STAGE(PG8_SB(0, 0), b2, voffB); PG8_STAGE(PG8_SB(0, 1), b2 + hstep, voffB); PG8_STAGE(PG8_SA(0, 0), a2, voffA);
            PG8_WAIT_V(8); PG8_WAIT_L(0); PG8_BAR; PG8_MMA(1, 0, At, B0); PG8_MMA(1, 1, At, B1); PG8_BAR; PG8_SCHED;
            PG8_LDB(B0, 1, 0); PG8_LDB(B1, 1, 1); PG8_SCHED; PG8_LDA(At, 1, 0); PG8_STAGE(PG8_SA(0, 1), a2 + hstep, voffA);
            PG8_WAIT_V(8); PG8_WAIT_L(0); PG8_BAR; PG8_MMA(0, 0, At, B0); PG8_MMA(0, 1, At, B1); PG8_BAR; PG8_SCHED;
            PG8_LDA(At, 1, 1); PG8_STAGE(PG8_SB(1, 0), b3, voffB); PG8_STAGE(PG8_SB(1, 1), b3 + hstep, voffB); PG8_STAGE(PG8_SA(1, 0), a3, voffA);
            PG8_WAIT_V(8); PG8_WAIT_L(0); PG8_BAR; PG8_MMA(1, 0, At, B0); PG8_MMA(1, 1, At, B1); PG8_BAR; PG8_SCHED;
            } else {
            PG8_LDB(B0, 0, 0); PG8_SCHED; PG8_LDA(At, 0, 0); PG8_STAGE(PG8_SA(1, 1), a1 + hstep, voffA);
            PG8_WAIT_L(8); PG8_BAR; PG8_WAIT_L(0); PG8_MMA(0, 0, At, B0); PG8_BAR; PG8_SCHED;
            PG8_LDB(B1, 0, 1); PG8_STAGE(PG8_SB(0, 0), b2, voffB);
            PG8_BAR; PG8_WAIT_L(0); PG8_MMA(0, 1, At, B1); PG8_BAR;
            PG8_LDA(At, 0, 1); PG8_STAGE(PG8_SA(0, 0), a2, voffA);
            PG8_BAR; PG8_WAIT_L(0); PG8_MMA(1, 0, At, B0); PG8_BAR; PG8_SCHED;
            PG8_STAGE(PG8_SB(0, 1), b2 + hstep, voffB);
            PG8_WAIT_V(6); PG8_BAR; PG8_MMA(1, 1, At, B1); PG8_BAR;
            PG8_LDB(B0, 1, 0); PG8_SCHED; PG8_LDA(At, 1, 0); PG8_STAGE(PG8_SA(0, 1), a2 + hstep, voffA);
            PG8_WAIT_L(8); PG8_BAR; PG8_WAIT_L(0); PG8_MMA(0, 0, At, B0); PG8_BAR; PG8_SCHED;
            PG8_LDB(B1, 1, 1); PG8_STAGE(PG8_SB(1, 0), b3, voffB);
            PG8_BAR; PG8_WAIT_L(0); PG8_MMA(0, 1, At, B1); PG8_BAR;
            PG8_LDA(At, 1, 1); PG8_STAGE(PG8_SA(1, 0), a3, voffA);
            PG8_BAR; PG8_WAIT_L(0); PG8_MMA(1, 0, At, B0); PG8_BAR; PG8_SCHED;
            PG8_STAGE(PG8_SB(1, 1), b3 + hstep, voffB);
            PG8_WAIT_V(6); PG8_BAR; PG8_MMA(1, 1, At, B1); PG8_BAR;
            }
        }
        if constexpr (ALIGN_EPI) { if (wr == 0) PG8_BAR; }
        if constexpr (!Epi::AFTER_DRAIN) { int te_ = tid_in; asm volatile("" : "+v"(te_)); E(acc, cur, wr, wc, te_ & 15, (te_ & 63) >> 4); S.done(cur); }
        if (!has_next) break;
        zf_ = 0.f; asm volatile("" : "+v"(zf_));
#pragma unroll
        for (int a = 0; a < 2; ++a)
#pragma unroll
            for (int b = 0; b < 2; ++b)
#pragma unroll
                for (int m = 0; m < 4; ++m)
#pragma unroll
                    for (int n = 0; n < 2; ++n) acc[a][b][m][n] = (f32x4){zf_, zf_, zf_, zf_};
        cur = nxt; cA = nA; cB = nB; ++ui;
        if constexpr (ALIGN_EPI) { if (wr == 1) PG8_BAR; }
    }
    PG8_WAIT_V(0);
    if constexpr (!ALIGN_EPI) { if (wr == 0) PG8_BAR; }
    PG8_BAR;
    if constexpr (Epi::AFTER_DRAIN) { E.fused(acc, cur, wr, wc, fr, fq, lds, wid, lane); S.done(cur); }
#undef PG8_SA
#undef PG8_SB
#undef PG8_STAGE
#undef PG8_LDA
#undef PG8_LDB
#undef PG8_MMA
#undef PG8_WAIT_V
#undef PG8_WAIT_L
#undef PG8_BAR
#undef PG8_SCHED
}
}
constexpr int NW = 8, NTHR = 512;
constexpr int DM = 1024, NB = 4, SEQ = 4096, NTOK = NB * SEQ, NLAYER = 2;
constexpr int HA = 8, HDA = 64, WA = 512, MBLK = 256, NBLK = SEQ / MBLK;
constexpr int HB = 4, HDB = 128, WB = 512, CONVK = 4, DNC = 64, NCH = SEQ / DNC;
constexpr int NGRP = 4, EPG = 8, NEXP = 32, DFF = 256;
constexpr int DIN = 5640, DINP = 5632, NMOD = 6;
constexpr int C_QKVA = 0, C_QKVB = 1536, C_ZB = 3072, C_BA = 3584, C_GATE = 3592;
constexpr float EPS = 1e-6f;
constexpr int MOE_MAXROWS = 2 * NTOK + NEXP * 256;
constexpr int MOE_MAXTILES = MOE_MAXROWS / 256;

constexpr size_t MiB = 1u << 20;
constexpr size_t WS_CTL = 0, CTL_ZERO_BYTES = 1 * MiB;
constexpr size_t WS_MOD = 1 * MiB;
constexpr size_t WS_WIN = 2 * MiB;
constexpr size_t WS_WUPA = 13 * MiB, WS_WUPB = 14 * MiB;
constexpr size_t WS_WOUT = 15 * MiB;
constexpr size_t WS_WEGU = 17 * MiB;
constexpr size_t WS_WED = 49 * MiB;
constexpr size_t WS_SMALL = 65 * MiB;
constexpr size_t WS_KMEAN = WS_SMALL;
constexpr size_t WS_BETA = WS_SMALL + 256 * 1024;
constexpr size_t WS_GLOG = WS_SMALL + 512 * 1024;
constexpr size_t WS_TOKINFO = WS_SMALL + 1 * MiB;
constexpr size_t WS_ROWTOK = WS_SMALL + 2 * MiB;
constexpr size_t WS_ROWW = WS_SMALL + 3 * MiB;
constexpr size_t WS_GL = WS_SMALL + 4 * MiB;
constexpr size_t WS_SSQ = WS_SMALL + 5 * MiB;
constexpr size_t WS_H = 72 * MiB;
constexpr size_t WS_QKVA = 104 * MiB;
constexpr size_t WS_QKVB = 152 * MiB;
constexpr size_t WS_ZB = 200 * MiB;
constexpr size_t WS_GATES = 216 * MiB;
constexpr size_t WS_IMG = 280 * MiB;
constexpr size_t WS_YA = 72 * MiB, WS_YB = 336 * MiB;
constexpr size_t WS_END = 352 * MiB;
constexpr size_t WS_M = WS_QKVB;
constexpr size_t WS_U = 88 * MiB;
constexpr size_t WS_HS = WS_QKVA;
constexpr size_t WS_ACT = 184 * MiB;
constexpr size_t WS_YS = WS_GATES;
constexpr int CW_TMO = 0;
constexpr int CW_BAR = 4096;
constexpr int CW_GCNT = 8192;
constexpr int CW_CCTR = 8448;
constexpr int CW_ACTR = 8320;

constexpr int RING_BYTES = 131072;
constexpr int MISC_OFF = 147456;
constexpr int LDS_BYTES = 151552;

#define GAS __attribute__((address_space(1)))
#define LAS __attribute__((address_space(3)))
typedef unsigned short bf16;
typedef unsigned v4u __attribute__((ext_vector_type(4)));
typedef unsigned v2u __attribute__((ext_vector_type(2)));
typedef float f32x4 __attribute__((ext_vector_type(4)));
typedef float f32x16 __attribute__((ext_vector_type(16)));
typedef short bf16x8 __attribute__((ext_vector_type(8)));
typedef GAS unsigned gu32;
#define RLX_AGENT __ATOMIC_RELAXED, __HIP_MEMORY_SCOPE_AGENT
#define LDS_WAIT() asm volatile("s_waitcnt lgkmcnt(0)" ::: "memory")
#define VM_WAIT() asm volatile("s_waitcnt vmcnt(0)" ::: "memory")
__device__ __forceinline__ unsigned f2bf(float f) { unsigned u = __builtin_bit_cast(unsigned, f); return (u + 0x7fffu + ((u >> 16) & 1u)) >> 16; }
__device__ __forceinline__ unsigned pk2(float lo, float hi) { return f2bf(lo) | (f2bf(hi) << 16); }
__device__ __forceinline__ float bf2f(unsigned b) { return __builtin_bit_cast(float, b << 16); }
__device__ __forceinline__ float bflo(unsigned w) { return __builtin_bit_cast(float, w << 16); }
__device__ __forceinline__ float bfhi(unsigned w) { return __builtin_bit_cast(float, w & 0xffff0000u); }
__device__ __forceinline__ float rcpf_(float x) { return __builtin_amdgcn_rcpf(x); }
__device__ __forceinline__ float sigmoidf_(float x) { return rcpf_(1.f + __builtin_amdgcn_exp2f(-1.4426950408889634f * x)); }
__device__ __forceinline__ float siluf_(float x) { return x * rcpf_(1.f + __builtin_amdgcn_exp2f(-1.4426950408889634f * x)); }
__device__ __forceinline__ float shx(float v, int o, int lane) { return __builtin_bit_cast(float, __builtin_amdgcn_ds_bpermute((lane ^ o) << 2, __builtin_bit_cast(int, v))); }
__device__ __forceinline__ float shidx(float v, int src) { return __builtin_bit_cast(float, __builtin_amdgcn_ds_bpermute(src << 2, __builtin_bit_cast(int, v))); }
__device__ __forceinline__ int shidx_i(int v, int src) { return __builtin_amdgcn_ds_bpermute(src << 2, v); }
template <int CTRL> __device__ __forceinline__ float dpp_f(float v) { return __builtin_bit_cast(float, __builtin_amdgcn_update_dpp(0, __builtin_bit_cast(int, v), CTRL, 0xf, 0xf, true)); }
__device__ __forceinline__ float rdlane_f(float v, int l) { return __builtin_bit_cast(float, __builtin_amdgcn_readlane(__builtin_bit_cast(int, v), l)); }
__device__ __forceinline__ float wave_sum(float v, int) {
    v += dpp_f<0xB1>(v); v += dpp_f<0x4E>(v); v += dpp_f<0x141>(v); v += dpp_f<0x140>(v);
    return (rdlane_f(v, 0) + rdlane_f(v, 16)) + (rdlane_f(v, 32) + rdlane_f(v, 48));
}
__device__ __forceinline__ float wave_max(float v, int) {
    v = fmaxf(v, dpp_f<0xB1>(v)); v = fmaxf(v, dpp_f<0x4E>(v)); v = fmaxf(v, dpp_f<0x141>(v)); v = fmaxf(v, dpp_f<0x140>(v));
    return fmaxf(fmaxf(rdlane_f(v, 0), rdlane_f(v, 16)), fmaxf(rdlane_f(v, 32), rdlane_f(v, 48)));
}
__device__ const unsigned char T5B[128] = {0, 1, 2, 3, 4, 5, 6, 7, 8, 9, 10, 11, 12, 13, 14, 15, 16, 16, 16, 17, 17, 18, 18, 18, 19, 19, 19, 20, 20, 20, 20, 21, 21, 21, 21, 22, 22, 22, 22, 22, 23, 23, 23, 23, 23, 23, 24, 24, 24, 24, 24, 24, 25, 25, 25, 25, 25, 25, 25, 26, 26, 26, 26, 26, 26, 26, 26, 27, 27, 27, 27, 27, 27, 27, 27, 27, 27, 28, 28, 28, 28, 28, 28, 28, 28, 28, 28, 29, 29, 29, 29, 29, 29, 29, 29, 29, 29, 29, 29, 30, 30, 30, 30, 30, 30, 30, 30, 30, 30, 30, 30, 30, 30, 31, 31, 31, 31, 31, 31, 31, 31, 31, 31, 31, 31, 31, 31, 31};

#define XB_TMO      128
#define XB_XCNT(j)  (256  + 64 * (j))
#define XB_XSUB(j)  (1280 + 64 * (j))
#define XB_XGEN(j)  (2304 + 64 * (j))
#define XB_TOP      3328
#define XB_TOPGEN   3392
#define XCD_BAR_WORDS 3456
#define XB_SPIN_CAP (1u << 18)

__device__ __forceinline__ unsigned xb_ld(unsigned* p)              { return __hip_atomic_load(p, __ATOMIC_RELAXED, __HIP_MEMORY_SCOPE_AGENT); }
__device__ __forceinline__ unsigned xb_add(unsigned* p, unsigned v) { return __hip_atomic_fetch_add(p, v, __ATOMIC_RELAXED, __HIP_MEMORY_SCOPE_AGENT); }
__device__ __forceinline__ unsigned xb_xcc_id() { return (unsigned)__builtin_amdgcn_s_getreg((3 << 11) | 20) & 0xFu; }
#define XB_SPIN(cond, bar) do { unsigned _sp = 0; while (cond) { __builtin_amdgcn_s_sleep(1); \
    if ((++_sp & 255u) == 0u) { if (xb_ld(&(bar)[XB_TMO])) break; if (_sp > XB_SPIN_CAP) { atomicAdd(&(bar)[XB_TMO], 1u); break; } } } } while (0)

struct XcdBarrier {
    unsigned* bar; unsigned x;
    volatile LAS unsigned* st;
};

__device__ __forceinline__ XcdBarrier xcd_barrier_post(unsigned* bar, volatile LAS unsigned* st, const int tid_in) {
    XcdBarrier b; b.bar = bar; b.x = xb_xcc_id(); b.st = st;
    if (tid_in == 0) (void)xb_add(&bar[XB_XCNT(b.x)], 1u);
    return b;
}
__device__ __forceinline__ void xcd_barrier_complete(unsigned* bar, unsigned x, unsigned& nloc, unsigned& nx) {
    const unsigned G = gridDim.x * gridDim.y * gridDim.z;
    unsigned sum, cnt, mine, sp = 0u;
    for (;;) {
        sum = 0u; cnt = 0u; mine = 0u;
#pragma unroll
        for (unsigned j = 0; j < 16; ++j) { const unsigned c = xb_ld(&bar[XB_XCNT(j)]); sum += c; cnt += (c > 0u) ? 1u : 0u; mine = (j == x) ? c : mine; }
        if (sum == G) break;
        __builtin_amdgcn_s_sleep(1);
        if ((++sp & 255u) == 0u) { if (xb_ld(&bar[XB_TMO])) break; if (sp > XB_SPIN_CAP) { atomicAdd(&bar[XB_TMO], 1u); break; } }
    }
    nloc = mine > 0u ? mine : 1u; nx = cnt > 0u ? cnt : 1u;
}

__device__ __forceinline__ void xcd_barrier(const XcdBarrier& b, const int tid_in) {
    asm volatile("s_waitcnt vmcnt(0)" ::: "memory");
    __syncthreads();
    if (tid_in == 0) {
        unsigned* bar = b.bar;
        __builtin_amdgcn_s_waitcnt(0);
        unsigned nloc = b.st[0], nx = b.st[1];
        if (nloc == 0u) { xcd_barrier_complete(bar, b.x, nloc, nx); b.st[0] = nloc; b.st[1] = nx; }
        const unsigned old = xb_add(&bar[XB_XSUB(b.x)], 1u);
        const unsigned gen = old / nloc;
        if (old + 1u == (gen + 1u) * nloc) {
            __builtin_amdgcn_fence(__ATOMIC_RELEASE, "agent");
            asm volatile("s_waitcnt vmcnt(0)" ::: "memory");
            const unsigned og = xb_add(&bar[XB_TOP], 1u);
            const unsigned tg = og / nx;
            if (og + 1u == (tg + 1u) * nx) xb_add(&bar[XB_TOPGEN], 1u);
            else XB_SPIN(xb_ld(&bar[XB_TOPGEN]) == tg, bar);
            __builtin_amdgcn_fence(__ATOMIC_ACQUIRE, "agent");
            xb_add(&bar[XB_XGEN(b.x)], 1u);
            asm volatile("s_waitcnt vmcnt(0)" ::: "memory");
        } else {
            XB_SPIN(xb_ld(&bar[XB_XGEN(b.x)]) == gen, bar);
            __builtin_amdgcn_fence(__ATOMIC_ACQUIRE, "agent");
            asm volatile("s_waitcnt vmcnt(0)" ::: "memory");
        }
    }
    __syncthreads();
}
struct Args { const float* in[23]; float* out; unsigned char* ws; int ph_lo, ph_hi; };
enum { I_X = 0, I_C, I_RELB, I_FNW, I_N1W, I_N2W, I_WMOD, I_BMOD, I_WIN, I_CONVW, I_ALOG, I_DTB, I_ONW, I_WUPA, I_WUPB, I_WOUT, I_WRG, I_BRG, I_WRE, I_BRE, I_WEG, I_WEU, I_WED };

typedef const Args __attribute__((address_space(4)))* KArgs;
struct Ctx { LAS unsigned char* lds; int tid, lane, wave, bid, G; };
extern __shared__ __attribute__((aligned(16))) unsigned char lds_raw[];
__device__ __forceinline__ Ctx make_ctx(int& tid) { Ctx c; c.lds = (LAS unsigned char*)lds_raw; asm volatile("" : "+v"(tid)); const int t = tid; c.tid = t; c.lane = t & 63; c.wave = __builtin_amdgcn_readfirstlane(t >> 6); int bi = blockIdx.x, gd = gridDim.x; asm volatile("" : "+s"(bi), "+s"(gd)); c.bid = bi; c.G = gd; return c; }

__device__ __forceinline__ void ph_mod(KArgs a, const Ctx& c) {
    LAS float* cact = (LAS float*)c.lds;
    LAS float* red = (LAS float*)(c.lds + 16384);
    const float* cin = a->in[I_C];
    for (int i = c.tid; i < 4096; i += NTHR) cact[i] = siluf_(cin[i]);
    __syncthreads();
    float* mod = (float*)(a->ws + WS_MOD);
    for (int item = c.bid; item < 192; item += c.G) {
        const int l = item / 96, j0 = (item % 96) * 64;
        const float* W = a->in[I_WMOD] + (size_t)l * 1024 * 6144 + j0 + c.lane;
        float a0 = 0.f, a1 = 0.f, a2 = 0.f, a3 = 0.f;
        const int k0 = c.wave * 128;
#pragma unroll 8
        for (int k = k0; k < k0 + 128; ++k) { const float w = W[(size_t)k * 6144]; a0 += cact[k] * w; a1 += cact[1024 + k] * w; a2 += cact[2048 + k] * w; a3 += cact[3072 + k] * w; }
        red[(c.wave * 4 + 0) * 64 + c.lane] = a0; red[(c.wave * 4 + 1) * 64 + c.lane] = a1; red[(c.wave * 4 + 2) * 64 + c.lane] = a2; red[(c.wave * 4 + 3) * 64 + c.lane] = a3;
        __syncthreads();
        if (c.tid < 256) { const int b = c.tid >> 6, ln = c.tid & 63; float s = 0.f;
#pragma unroll
            for (int w = 0; w < 8; ++w) s += red[(w * 4 + b) * 64 + ln];
            mod[(l * 4 + b) * 6144 + j0 + ln] = s + a->in[I_BMOD][l * 6144 + j0 + ln]; }
        __syncthreads();
    }
}

__device__ __forceinline__ void tr_item(const float* src, int ld, bf16* dst, int K, int nblk, LAS float* scr, int item, int lane) {
    const int kb = item / nblk, nb = item % nblk, k0 = 64 * kb, n0 = 32 * nb;
    float tv[32];
    const unsigned voff = (unsigned)((lane >> 5) * ld + (lane & 31));
#pragma unroll
    for (int i = 0; i < 32; ++i) { const float* rowp = src + (size_t)(k0 + 2 * i) * ld + n0; tv[i] = rowp[voff]; }
#pragma unroll
    for (int i = 0; i < 32; ++i) scr[(2 * i + (lane >> 5)) * 33 + (lane & 31)] = tv[i];
    LDS_WAIT(); asm volatile("" ::: "memory");
    const int cc = lane & 7;
#pragma unroll
    for (int j = 0; j < 4; ++j) { const int n = (lane >> 3) + 8 * j; const LAS float* s = scr + (8 * cc) * 33 + n;
        v4u o; o.x = pk2(s[0 * 33], s[1 * 33]); o.y = pk2(s[2 * 33], s[3 * 33]); o.z = pk2(s[4 * 33], s[5 * 33]); o.w = pk2(s[6 * 33], s[7 * 33]);
        *(v4u*)(dst + (size_t)(n0 + n) * K + k0 + 8 * cc) = o; }
    LDS_WAIT(); asm volatile("" ::: "memory");
}
constexpr int CV_I0 = 1792, CV_I1 = 1024, CV_I2 = 256, CV_I3 = 256, CV_I4 = 512, CV_I5 = 4096, CV_I6 = 4096, CV_I7 = 4096;
constexpr int CV_NIT = CV_I0 + CV_I1 + CV_I2 + CV_I3 + CV_I4 + CV_I5 + CV_I6 + CV_I7, CV_EARLY = CV_I0 + CV_I1;
__device__ __forceinline__ void convert_item(KArgs a, int l, int it, LAS float* scr, int lane) {
    bf16* WIN = (bf16*)(a->ws + WS_WIN); bf16* WEGU = (bf16*)(a->ws + WS_WEGU); bf16* WEDT = (bf16*)(a->ws + WS_WED);
    const float* win = a->in[I_WIN] + (size_t)l * 1024 * DIN;
    int r = it;
    if (r < CV_I0) { tr_item(win, DIN, WIN, 1024, 112, scr, r, lane); return; } r -= CV_I0;
    if (r < CV_I1) { tr_item(win + C_GATE, DIN, WIN + (size_t)C_BA * 1024, 1024, 64, scr, r, lane); return; } r -= CV_I1;
    if (r < CV_I2) { tr_item(a->in[I_WUPA] + (size_t)l * 512 * 1024, 1024, (bf16*)(a->ws + WS_WUPA), 512, 32, scr, r, lane); return; } r -= CV_I2;
    if (r < CV_I3) { tr_item(a->in[I_WUPB] + (size_t)l * 512 * 1024, 1024, (bf16*)(a->ws + WS_WUPB), 512, 32, scr, r, lane); return; } r -= CV_I3;
    if (r < CV_I4) { tr_item(a->in[I_WOUT] + (size_t)l * 1024 * 1024, 1024, (bf16*)(a->ws + WS_WOUT), 1024, 32, scr, r, lane); return; } r -= CV_I4;
    if (r < CV_I5) { const int E = r >> 7, rem = r & 127, pn = rem >> 6, q = rem & 63;
        tr_item(a->in[I_WEG] + ((size_t)(l * 32 + E) * 1024 * 256) + 128 * pn, 256, WEGU + (size_t)(E * 512 + 256 * pn) * 1024, 1024, 4, scr, q, lane); return; } r -= CV_I5;
    if (r < CV_I6) { const int E = r >> 7, rem = r & 127, pn = rem >> 6, q = rem & 63;
        tr_item(a->in[I_WEU] + ((size_t)(l * 32 + E) * 1024 * 256) + 128 * pn, 256, WEGU + (size_t)(E * 512 + 256 * pn + 128) * 1024, 1024, 4, scr, q, lane); return; } r -= CV_I6;
    { const int E = r >> 7, q = r & 127;
        tr_item(a->in[I_WED] + ((size_t)(l * 32 + E) * 256 * 1024), 1024, WEDT + (size_t)E * 1024 * 256, 256, 32, scr, q, lane); }
}
__device__ __forceinline__ void ph_convert(KArgs a, const Ctx& c, int l) {
    LAS float* scr = (LAS float*)(c.lds + 32768 + c.wave * 10240);
    const int gw = c.bid * NW + c.wave, NGW = c.G * NW;
    for (int it = gw; it < CV_EARLY; it += NGW) convert_item(a, l, it, scr, c.lane);
}
constexpr int CV_UNIT = 64, CV_NUNITS = (CV_NIT - CV_EARLY) / CV_UNIT;
static_assert((CV_NIT - CV_EARLY) % CV_UNIT == 0, "convert units");
constexpr int CV_EARLYQ = 112;
__device__ __forceinline__ void convert_unit(KArgs a, const Ctx& c, int l, int cu) {
    LAS float* scr = (LAS float*)(c.lds + 32768 + c.wave * 10240);
    int ln = c.lane; asm volatile("" : "+v"(ln));
#pragma unroll 1
    for (int i = 0; i < 8; ++i) convert_item(a, l, CV_EARLY + cu * CV_UNIT + c.wave * 8 + i, scr, ln);
}

__device__ __forceinline__ void load_row_x(KArgs a, int l, int m, int lane, f32x4 (&v)[4]) {
    const float* xr = (l == 0 ? a->in[I_X] : (const float*)a->out) + (size_t)m * DM;
#pragma unroll
    for (int j = 0; j < 4; ++j) v[j] = *(const f32x4*)(xr + 256 * j + 4 * lane);
    if (l > 0) {
        const int b = m >> 12;
        const float* g2 = (const float*)(a->ws + WS_MOD) + ((l - 1) * 4 + b) * 6144 + 5120;
        const bf16* ys = (const bf16*)(a->ws + WS_YS) + (size_t)m * 2048;
#pragma unroll
        for (int j = 0; j < 4; ++j) { const int col = 256 * j + 4 * lane; const v2u y0 = *(const v2u*)(ys + col), y1 = *(const v2u*)(ys + 1024 + col); const f32x4 g = *(const f32x4*)(g2 + col);
            v[j].x += g.x * (bflo(y0.x) + bflo(y1.x)); v[j].y += g.y * (bfhi(y0.x) + bfhi(y1.x)); v[j].z += g.z * (bflo(y0.y) + bflo(y1.y)); v[j].w += g.w * (bfhi(y0.y) + bfhi(y1.y)); }
        float* xo = a->out + (size_t)m * DM;
#pragma unroll
        for (int j = 0; j < 4; ++j) *(f32x4*)(xo + 256 * j + 4 * lane) = v[j];
    }
}
__device__ __forceinline__ float row_rstd(const f32x4 (&v)[4], int lane) {
    float s = 0.f;
#pragma unroll
    for (int j = 0; j < 4; ++j) s += (v[j].x * v[j].x + v[j].y * v[j].y) + (v[j].z * v[j].z + v[j].w * v[j].w);
    return __builtin_amdgcn_rsqf(wave_sum(s, lane) * (1.f / DM) + EPS);
}
__device__ __forceinline__ void ph_norm1(KArgs a, const Ctx& c, int l) {
    LAS float* wbaT = (LAS float*)c.lds;
    const float* win = a->in[I_WIN] + (size_t)l * 1024 * DIN + C_BA;
    for (int i = c.tid; i < 8192; i += NTHR) { const int k = i >> 3, cc = i & 7; wbaT[cc * 1024 + k] = win[(size_t)k * DIN + cc]; }
    __syncthreads();
    const int gw = c.bid * NW + c.wave, NGW = c.G * NW, lane = c.lane;
    bf16* H = (bf16*)(a->ws + WS_H); float* beta = (float*)(a->ws + WS_BETA); float* glog = (float*)(a->ws + WS_GLOG);
    const float* n1w = a->in[I_N1W] + l * DM;
    const float dtb = lane < 4 ? a->in[I_DTB][l * 4 + lane] : 0.f, nea = lane < 4 ? -__expf(a->in[I_ALOG][l * 4 + lane]) : 0.f;
    for (int blk8 = gw; blk8 < NTOK / 8; blk8 += NGW) {
        const int m0 = blk8 * 8, b = m0 >> 12; const float* mod = (const float*)(a->ws + WS_MOD) + (l * 4 + b) * 6144;
        f32x4 cw_[4], csh[4];
#pragma unroll
        for (int j = 0; j < 4; ++j) { const int col = 256 * j + 4 * lane; cw_[j] = *(const f32x4*)(n1w + col) * (*(const f32x4*)(mod + 1024 + col) + 1.0f); csh[j] = *(const f32x4*)(mod + col); }
        f32x4 vn[4]; load_row_x(a, l, m0, lane, vn);
        for (int i = 0; i < 8; ++i) {
            const int m = m0 + i;
            f32x4 v[4];
#pragma unroll
            for (int j = 0; j < 4; ++j) v[j] = vn[j];
            if (i < 7) load_row_x(a, l, m + 1, lane, vn);
            const float rstd = row_rstd(v, lane);
            float acc[8];
#pragma unroll
            for (int q = 0; q < 8; ++q) acc[q] = 0.f;
#pragma unroll
            for (int j = 0; j < 4; ++j) { const int col = 256 * j + 4 * lane;
                f32x4 h = v[j] * rstd * cw_[j] + csh[j];
                v2u o; o.x = pk2(h.x, h.y); o.y = pk2(h.z, h.w); *(v2u*)(H + (size_t)m * DM + col) = o;
#pragma unroll
                for (int q = 0; q < 8; ++q) { const f32x4 w4 = *(const LAS f32x4*)(wbaT + q * 1024 + col); acc[q] += (h.x * w4.x + h.y * w4.y) + (h.z * w4.z + h.w * w4.w); } }
#pragma unroll
            for (int q = 0; q < 8; ++q) acc[q] = wave_sum(acc[q], lane);
            if (lane < 4) {
                const float bb = lane == 0 ? acc[0] : lane == 1 ? acc[1] : lane == 2 ? acc[2] : acc[3];
                const float aa = lane == 0 ? acc[4] : lane == 1 ? acc[5] : lane == 2 ? acc[6] : acc[7];
                beta[m * 4 + lane] = sigmoidf_(bb);
                const float z = aa + dtb; const float sp = fmaxf(z, 0.f) + log1pf(__expf(-fabsf(z)));
                glog[m * 4 + lane] = nea * sp;
            }
        }
    }
}
__device__ __forceinline__ void ph_final(KArgs a, const Ctx& c) {
    const int gw = c.bid * NW + c.wave, NGW = c.G * NW, lane = c.lane;
    const float* fw = a->in[I_FNW];
    for (int m = gw; m < NTOK; m += NGW) {
        f32x4 v[4];
        {
            const float* xr = (const float*)a->out + (size_t)m * DM; const int b = m >> 12;
            const float* g2 = (const float*)(a->ws + WS_MOD) + ((NLAYER - 1) * 4 + b) * 6144 + 5120;
            const bf16* ys = (const bf16*)(a->ws + WS_YS) + (size_t)m * 2048;
#pragma unroll
            for (int j = 0; j < 4; ++j) { const int col = 256 * j + 4 * lane; v[j] = *(const f32x4*)(xr + col);
                const v2u y0 = *(const v2u*)(ys + col), y1 = *(const v2u*)(ys + 1024 + col); const f32x4 g = *(const f32x4*)(g2 + col);
                v[j].x += g.x * (bflo(y0.x) + bflo(y1.x)); v[j].y += g.y * (bfhi(y0.x) + bfhi(y1.x)); v[j].z += g.z * (bflo(y0.y) + bflo(y1.y)); v[j].w += g.w * (bfhi(y0.y) + bfhi(y1.y)); }
        }
        float rstd = row_rstd(v, lane);
#if defined(MK_PROBE_A) && MK_PROBE_A >= 0
        {   const unsigned long long* ts = (const unsigned long long*)((const unsigned*)(a->ws + WS_CTL) + 12288);
            float tA = 0.f, tB = 0.f;
            for (int ly = 0; ly < NLAYER; ++ly) { const int ka = 1 + ly * 11 + MK_PROBE_A, kb = 1 + ly * 11 + MK_PROBE_B;
                if (MK_PROBE_A < 11) tA += (float)(ts[ka + 1] - ts[ka]) * 0.01f; if (MK_PROBE_B < 11) tB += (float)(ts[kb + 1] - ts[kb]) * 0.01f; }
            if (MK_PROBE_A == 20) { tA = 0.f; for (int ly = 0; ly < NLAYER; ++ly) tA += (float)(ts[40 + ly] - ts[1 + ly * 11 + 3]) * 0.01f; }
            if (MK_PROBE_A == 21) { tA = 0.f; for (int ly = 0; ly < NLAYER; ++ly) tA += (float)(ts[44 + ly] - ts[1 + ly * 11 + 3]) * 0.01f; }
            if (MK_PROBE_A >= 22 && MK_PROBE_A <= 24) { tA = 0.f; for (int ly = 0; ly < NLAYER; ++ly) tA += (float)ts[48 + ly * 4 + MK_PROBE_A - 22] * 0.01f; }
            if (MK_PROBE_B >= 22 && MK_PROBE_B <= 24) { tB = 0.f; for (int ly = 0; ly < NLAYER; ++ly) tB += (float)ts[48 + ly * 4 + MK_PROBE_B - 22] * 0.01f; }
            if (MK_PROBE_A >= 30 && MK_PROBE_A <= 36) { tA = 0.f; for (int ly = 0; ly < NLAYER; ++ly) tA += (float)ts[56 + ly] * 0.01f; }
            if (MK_PROBE_A >= 40 && MK_PROBE_A <= 42) { tA = 0.f; for (int ly = 0; ly < NLAYER; ++ly) tA += (float)ts[60 + ly] * 0.01f; }
            if (MK_PROBE_A == 11) tA = (float)(ts[1] - ts[0]) * 0.01f; if (MK_PROBE_A == 12) tA = (float)(ts[23] - ts[0]) * 0.01f;
            if (MK_PROBE_B == 11) tB = (float)(ts[1] - ts[0]) * 0.01f; if (MK_PROBE_B == 12) tB = (float)(ts[23] - ts[0]) * 0.01f;
            (void)tB;
            if (m == 0 && lane == 0) v[0].x += tA * 0.05f / rstd / fw[0]; }
#endif
        float* xo = a->out + (size_t)m * DM;
#pragma unroll
        for (int j = 0; j < 4; ++j) { const int col = 256 * j + 4 * lane; const f32x4 w = *(const f32x4*)(fw + col); *(f32x4*)(xo + col) = v[j] * rstd * w; }
    }
}

__device__ __forceinline__ void ph_kmean(KArgs a, const Ctx& c) {
    const int gw = c.bid * NW + c.wave, NGW = c.G * NW, lane = c.lane;
    const bf16* QKVA = (const bf16*)(a->ws + WS_QKVA); float* kmean = (float*)(a->ws + WS_KMEAN);
    for (int item = gw; item < NB * HA * NBLK; item += NGW) {
        const int nb = item & 15, h = (item >> 4) & 7, b = item >> 7;
        const int sub = lane & 7, rr = lane >> 3;
        float s[8];
#pragma unroll
        for (int q = 0; q < 8; ++q) s[q] = 0.f;
        const bf16* kp = QKVA + (size_t)(b * SEQ + nb * MBLK) * 1536 + 512 + h * 64 + sub * 8;
#pragma unroll 4
        for (int it = 0; it < 32; ++it) { const v4u w = *(const v4u*)(kp + (size_t)(it * 8 + rr) * 1536);
            s[0] += bflo(w.x); s[1] += bfhi(w.x); s[2] += bflo(w.y); s[3] += bfhi(w.y); s[4] += bflo(w.z); s[5] += bfhi(w.z); s[6] += bflo(w.w); s[7] += bfhi(w.w); }
#pragma unroll
        for (int q = 0; q < 8; ++q) { s[q] += shx(s[q], 8, lane); s[q] += shx(s[q], 16, lane); s[q] += shx(s[q], 32, lane); }
        if (lane < 8) { float* o = kmean + (size_t)item * 64 + sub * 8;
            *(f32x4*)o = (f32x4){s[0], s[1], s[2], s[3]} * (1.f / 256.f); *(f32x4*)(o + 4) = (f32x4){s[4], s[5], s[6], s[7]} * (1.f / 256.f); }
    }
}

__device__ __forceinline__ void ph_attn_simple(KArgs a, const Ctx& c) {
    const int gw = c.bid * NW + c.wave, NGW = c.G * NW, lane = c.lane;
    LAS float* btab = (LAS float*)(c.lds);
    LAS float* scw = (LAS float*)(c.lds + 8192) + c.wave * 1024;
    const float* relb = a->in[I_RELB];
    for (int i = c.tid; i < 8 * 129; i += NTHR) { const int h = i / 129, d = i % 129; btab[h * 132 + d] = relb[(d < 128 ? (int)T5B[d] : 31) * 8 + h]; }
    __syncthreads();
    const bf16* QKVA = (const bf16*)(a->ws + WS_QKVA); const float* kmean = (const float*)(a->ws + WS_KMEAN); bf16* YA = (bf16*)(a->ws + WS_YA);
    for (int r = gw; r < NB * HA * SEQ; r += NGW) {
        const int s = r & (SEQ - 1), h = (r >> 12) & 7, b = r >> 15, qb = s >> 8, tok = b * SEQ + s;
        float qv[64];
        { const bf16* qp = QKVA + (size_t)tok * 1536 + h * 64;
#pragma unroll
          for (int q = 0; q < 8; ++q) { const v4u w = *(const v4u*)(qp + q * 8); qv[q * 8 + 0] = bflo(w.x); qv[q * 8 + 1] = bfhi(w.x); qv[q * 8 + 2] = bflo(w.y); qv[q * 8 + 3] = bfhi(w.y); qv[q * 8 + 4] = bflo(w.z); qv[q * 8 + 5] = bfhi(w.z); qv[q * 8 + 6] = bflo(w.w); qv[q * 8 + 7] = bfhi(w.w); } }
        float gate = -1e30f;
        if (lane < qb) { const float* km = kmean + (size_t)(((b * 8 + h) * 16) + lane) * 64; float d = 0.f;
#pragma unroll
            for (int q = 0; q < 16; ++q) { const f32x4 k4 = *(const f32x4*)(km + q * 4); d += qv[q * 4] * k4.x + qv[q * 4 + 1] * k4.y + qv[q * 4 + 2] * k4.z + qv[q * 4 + 3] * k4.w; }
            gate = d; }
        unsigned selmask = 0u;
#pragma unroll
        for (int t = 0; t < 3; ++t) { float best = -3e38f; int bi = 0;
#pragma unroll
            for (int n = 0; n < 16; ++n) { const float gv = shidx(gate, n); if (!((selmask >> n) & 1u) && gv > best) { best = gv; bi = n; } }
            selmask |= 1u << bi; }
        selmask &= (1u << qb) - 1u;
        selmask |= 1u << qb;
        int nseg = 0; float mx = -3e38f;
        for (int blk = 0; blk <= qb; ++blk) {
            if (!((selmask >> blk) & 1u)) continue;
            for (int i = 0; i < 4; ++i) { const int key = blk * 256 + i * 64 + lane; const bf16* kp = QKVA + (size_t)(b * SEQ + key) * 1536 + 512 + h * 64; float d = 0.f;
#pragma unroll
                for (int q = 0; q < 8; ++q) { const v4u w = *(const v4u*)(kp + q * 8);
                    d += qv[q * 8] * bflo(w.x) + qv[q * 8 + 1] * bfhi(w.x) + qv[q * 8 + 2] * bflo(w.y) + qv[q * 8 + 3] * bfhi(w.y) + qv[q * 8 + 4] * bflo(w.z) + qv[q * 8 + 5] * bfhi(w.z) + qv[q * 8 + 6] * bflo(w.w) + qv[q * 8 + 7] * bfhi(w.w); }
                const int dist = s - key; float sc = d * 0.125f + btab[h * 132 + (dist < 0 ? 0 : (dist > 128 ? 128 : dist))];
                if (dist < 0) sc = -3e38f;
                scw[nseg * 256 + i * 64 + lane] = sc; mx = fmaxf(mx, sc); }
            ++nseg; }
        mx = wave_max(mx, lane);
        float sum = 0.f;
        for (int idx = lane; idx < nseg * 256; idx += 64) { const float sc = scw[idx]; const float e = sc < -1e37f ? 0.f : __expf(sc - mx); scw[idx] = e; sum += e; }
        sum = wave_sum(sum, lane);
        LDS_WAIT();
        float o = 0.f; int sg = 0;
        for (int blk = 0; blk <= qb; ++blk) {
            if (!((selmask >> blk) & 1u)) continue;
            const bf16* vp = QKVA + (size_t)(b * SEQ + blk * 256) * 1536 + 1024 + h * 64 + lane;
            const int lim = (blk == qb) ? (s & 255) + 1 : 256;
#pragma unroll 8
            for (int kk = 0; kk < lim; ++kk) o += scw[sg * 256 + kk] * bf2f(vp[(size_t)kk * 1536]);
            ++sg; }
        YA[(size_t)tok * 512 + h * 64 + lane] = (bf16)f2bf(o / sum);
    }
}

template <int LDW> __device__ __forceinline__ void dn_load_chunk(KArgs a, const Ctx& c, int l, int b, int h, int t0, LAS float* qs, LAS float* ks, LAS float* vs) {
    const bf16* QKVB = (const bf16*)(a->ws + WS_QKVB); const float* cw = a->in[I_CONVW] + (size_t)l * 4 * 1536;
    const int cg = c.tid & 15, r0 = c.tid >> 4;
#pragma unroll
    for (int part = 0; part < 3; ++part) {
        const int colb = part * 512 + h * 128 + 8 * cg;
        float w[4][8];
#pragma unroll
        for (int i = 0; i < 4; ++i) { const f32x4 w0 = *(const f32x4*)(cw + i * 1536 + colb), w1 = *(const f32x4*)(cw + i * 1536 + colb + 4);
            w[i][0] = w0.x; w[i][1] = w0.y; w[i][2] = w0.z; w[i][3] = w0.w; w[i][4] = w1.x; w[i][5] = w1.y; w[i][6] = w1.z; w[i][7] = w1.w; }
        LAS float* dst = part == 0 ? qs : part == 1 ? ks : vs;
#pragma unroll
        for (int pass = 0; pass < 2; ++pass) {
            const int r = r0 + 32 * pass, t = t0 + r;
            float y[8];
#pragma unroll
            for (int e = 0; e < 8; ++e) y[e] = 0.f;
#pragma unroll
            for (int i = 0; i < 4; ++i) { const int tt = t - 3 + i; if (tt >= 0) { const v4u x = *(const v4u*)(QKVB + (size_t)(b * SEQ + tt) * 1536 + colb);
                y[0] += w[i][0] * bflo(x.x); y[1] += w[i][1] * bfhi(x.x); y[2] += w[i][2] * bflo(x.y); y[3] += w[i][3] * bfhi(x.y); y[4] += w[i][4] * bflo(x.z); y[5] += w[i][5] * bfhi(x.z); y[6] += w[i][6] * bflo(x.w); y[7] += w[i][7] * bfhi(x.w); } }
            float ss = 0.f;
#pragma unroll
            for (int e = 0; e < 8; ++e) { y[e] = siluf_(y[e]); ss += y[e] * y[e]; }
            if (part < 2) { ss += shx(ss, 1, c.lane); ss += shx(ss, 2, c.lane); ss += shx(ss, 4, c.lane); ss += shx(ss, 8, c.lane);
                const float rs = __builtin_amdgcn_rsqf(ss + EPS) * (part == 0 ? 0.08838834764831845f : 1.f);
#pragma unroll
                for (int e = 0; e < 8; ++e) y[e] *= rs; }
            *(LAS f32x4*)(dst + r * LDW + 8 * cg) = (f32x4){y[0], y[1], y[2], y[3]}; *(LAS f32x4*)(dst + r * LDW + 8 * cg + 4) = (f32x4){y[4], y[5], y[6], y[7]};
        }
    }
}
__device__ __forceinline__ void dn_store_chunk(KArgs a, const Ctx& c, int l, int b, int h, int t0, const LAS float* os) {
    const bf16* ZB = (const bf16*)(a->ws + WS_ZB); bf16* YB = (bf16*)(a->ws + WS_YB); const float* onw = a->in[I_ONW] + l * 128;
    const int r = c.tid >> 3, sub = c.tid & 7, tok = b * SEQ + t0 + r;
    float o[16]; float ss = 0.f;
#pragma unroll
    for (int q = 0; q < 4; ++q) { const f32x4 v = *(const LAS f32x4*)(os + r * 128 + sub * 16 + q * 4); o[q * 4] = v.x; o[q * 4 + 1] = v.y; o[q * 4 + 2] = v.z; o[q * 4 + 3] = v.w; ss += (v.x * v.x + v.y * v.y) + (v.z * v.z + v.w * v.w); }
    ss += shx(ss, 1, c.lane); ss += shx(ss, 2, c.lane); ss += shx(ss, 4, c.lane);
    const float rstd = __builtin_amdgcn_rsqf(ss * (1.f / 128.f) + EPS);
    const bf16* zp = ZB + (size_t)tok * 512 + h * 128 + sub * 16; bf16* yp = YB + (size_t)tok * 512 + h * 128 + sub * 16;
#pragma unroll
    for (int q = 0; q < 2; ++q) { const v4u z = *(const v4u*)(zp + q * 8); const f32x4 w0 = *(const f32x4*)(onw + sub * 16 + q * 8), w1 = *(const f32x4*)(onw + sub * 16 + q * 8 + 4);
        v4u y; y.x = pk2(o[q * 8 + 0] * rstd * w0.x * siluf_(bflo(z.x)), o[q * 8 + 1] * rstd * w0.y * siluf_(bfhi(z.x)));
        y.y = pk2(o[q * 8 + 2] * rstd * w0.z * siluf_(bflo(z.y)), o[q * 8 + 3] * rstd * w0.w * siluf_(bfhi(z.y)));
        y.z = pk2(o[q * 8 + 4] * rstd * w1.x * siluf_(bflo(z.z)), o[q * 8 + 5] * rstd * w1.y * siluf_(bfhi(z.z)));
        y.w = pk2(o[q * 8 + 6] * rstd * w1.z * siluf_(bflo(z.w)), o[q * 8 + 7] * rstd * w1.w * siluf_(bfhi(z.w)));
        *(v4u*)(yp + q * 8) = y; }
}
__device__ __forceinline__ void ph_dn_simple(KArgs a, const Ctx& c, int l) {
    LAS float* qs = (LAS float*)c.lds; LAS float* ks = qs + 8192; LAS float* vs = ks + 8192; LAS float* os = vs + 8192;
    LAS float* bt = (LAS float*)(c.lds + MISC_OFF + 1024); LAS float* at = bt + 64;
    const float* beta = (const float*)(a->ws + WS_BETA); const float* glog = (const float*)(a->ws + WS_GLOG);
    const int v = c.tid >> 2, kq = c.tid & 3;
    for (int item = c.bid; item < NB * HB; item += c.G) {
        const int b = item >> 2, h = item & 3;
        float S[32];
#pragma unroll
        for (int q = 0; q < 32; ++q) S[q] = 0.f;
        for (int n = 0; n < NCH; ++n) {
            const int t0 = n * DNC;
            __syncthreads();
            dn_load_chunk<128>(a, c, l, b, h, t0, qs, ks, vs);
            if (c.tid < 64) { const int tok = b * SEQ + t0 + c.tid; bt[c.tid] = beta[tok * 4 + h]; at[c.tid] = __expf(glog[tok * 4 + h]); }
            __syncthreads();
            for (int tt = 0; tt < DNC; ++tt) {
                const float a_t = at[tt], b_t = bt[tt];
                float kr[32];
#pragma unroll
                for (int q = 0; q < 8; ++q) { const f32x4 k4 = *(const LAS f32x4*)(ks + tt * 128 + kq * 32 + q * 4); kr[q * 4] = k4.x; kr[q * 4 + 1] = k4.y; kr[q * 4 + 2] = k4.z; kr[q * 4 + 3] = k4.w; }
                float kS = 0.f;
#pragma unroll
                for (int q = 0; q < 32; ++q) kS += kr[q] * S[q];
                kS += shx(kS, 1, c.lane); kS += shx(kS, 2, c.lane);
                const float vn = b_t * (vs[tt * 128 + v] - a_t * kS);
                float o = 0.f;
#pragma unroll
                for (int q = 0; q < 8; ++q) { const f32x4 q4 = *(const LAS f32x4*)(qs + tt * 128 + kq * 32 + q * 4);
                    S[q * 4] = a_t * S[q * 4] + kr[q * 4] * vn; S[q * 4 + 1] = a_t * S[q * 4 + 1] + kr[q * 4 + 1] * vn; S[q * 4 + 2] = a_t * S[q * 4 + 2] + kr[q * 4 + 2] * vn; S[q * 4 + 3] = a_t * S[q * 4 + 3] + kr[q * 4 + 3] * vn;
                    o += (q4.x * S[q * 4] + q4.y * S[q * 4 + 1]) + (q4.z * S[q * 4 + 2] + q4.w * S[q * 4 + 3]); }
                o += shx(o, 1, c.lane); o += shx(o, 2, c.lane);
                if (kq == 0) os[tt * 128 + v] = o;
            }
            __syncthreads();
            dn_store_chunk(a, c, l, b, h, t0, os);
        }
    }
}

struct EpiProj {
    static constexpr bool PERM = true, AFTER_DRAIN = false; unsigned char* ws;
    __device__ __forceinline__ void operator()(const pg8::f32x4 (&acc)[2][2][4][2], const pg8::Unit& u, int wr, int wc, int fr, int fq) const {
        const int pn = u.pn; bf16* base; int ld, ct; bool sg = false;
        if (pn < 6) { base = (bf16*)(ws + WS_QKVA); ld = 1536; ct = pn; } else if (pn < 12) { base = (bf16*)(ws + WS_QKVB); ld = 1536; ct = pn - 6; }
        else if (pn < 14) { base = (bf16*)(ws + WS_ZB); ld = 512; ct = pn - 12; } else { base = (bf16*)(ws + WS_GATES); ld = 2048; ct = pn - 14; sg = true; }
        const int row0 = u.pm * 256 + wr * 64 + fr, col0 = ct * 256 + wc * 32 + 8 * fq;
#pragma unroll
        for (int ai = 0; ai < 2; ++ai)
#pragma unroll
            for (int m = 0; m < 4; ++m) { bf16* rowp = base + (size_t)(row0 + ai * 128 + m * 16) * ld + col0;
#pragma unroll
                for (int bj = 0; bj < 2; ++bj) { f32x4 v0 = acc[ai][bj][m][0], v1 = acc[ai][bj][m][1];
                    if (sg) { v0.x = sigmoidf_(v0.x); v0.y = sigmoidf_(v0.y); v0.z = sigmoidf_(v0.z); v0.w = sigmoidf_(v0.w); v1.x = sigmoidf_(v1.x); v1.y = sigmoidf_(v1.y); v1.z = sigmoidf_(v1.z); v1.w = sigmoidf_(v1.w); }
                    v4u w; w.x = pk2(v0.x, v0.y); w.y = pk2(v0.z, v0.w); w.z = pk2(v1.x, v1.y); w.w = pk2(v1.z, v1.w);
                    *(v4u*)(rowp + bj * 128) = w; } }
    }
};
template <bool SECOND> struct EpiMerge {
    static constexpr bool PERM = true, AFTER_DRAIN = false; unsigned char* ws;
    __device__ __forceinline__ void operator()(const pg8::f32x4 (&acc)[2][2][4][2], const pg8::Unit& u, int wr, int wc, int fr, int fq) const {
        bf16* M = (bf16*)(ws + WS_M); const bf16* GT = (const bf16*)(ws + WS_GATES) + (SECOND ? 1024 : 0);
        const int row0 = u.pm * 256 + wr * 64 + fr, col0 = u.pn * 256 + wc * 32 + 8 * fq;
#pragma unroll
        for (int ai = 0; ai < 2; ++ai)
#pragma unroll
            for (int m = 0; m < 4; ++m) { const size_t row = row0 + ai * 128 + m * 16;
#pragma unroll
                for (int bj = 0; bj < 2; ++bj) { const int col = col0 + bj * 128; const f32x4 v0 = acc[ai][bj][m][0], v1 = acc[ai][bj][m][1];
                    const v4u g = *(const v4u*)(GT + row * 2048 + col);
                    float o[8] = {bflo(g.x) * v0.x, bfhi(g.x) * v0.y, bflo(g.y) * v0.z, bfhi(g.y) * v0.w, bflo(g.z) * v1.x, bfhi(g.z) * v1.y, bflo(g.w) * v1.z, bfhi(g.w) * v1.w};
                    if (SECOND) { const v4u p = *(const v4u*)(M + row * 1024 + col); o[0] += bflo(p.x); o[1] += bfhi(p.x); o[2] += bflo(p.y); o[3] += bfhi(p.y); o[4] += bflo(p.z); o[5] += bfhi(p.z); o[6] += bflo(p.w); o[7] += bfhi(p.w); }
                    v4u w; w.x = pk2(o[0], o[1]); w.y = pk2(o[2], o[3]); w.z = pk2(o[4], o[5]); w.w = pk2(o[6], o[7]);
                    *(v4u*)(M + row * 1024 + col) = w; } }
    }
};
struct EpiOut {
    static constexpr bool PERM = true, AFTER_DRAIN = false; const float* xin; float* xout; const float* g1;
    __device__ __forceinline__ void operator()(const pg8::f32x4 (&acc)[2][2][4][2], const pg8::Unit& u, int wr, int wc, int fr, int fq) const {
        const int row0 = u.pm * 256 + wr * 64 + fr, col0 = u.pn * 256 + wc * 32 + 8 * fq; const int b = (u.pm * 256) >> 12;
#pragma unroll
        for (int bj = 0; bj < 2; ++bj) { const int col = col0 + bj * 128; const f32x4 ga = *(const f32x4*)(g1 + b * 6144 + col), gb = *(const f32x4*)(g1 + b * 6144 + col + 4);
#pragma unroll
            for (int ai = 0; ai < 2; ++ai)
#pragma unroll
                for (int m = 0; m < 4; ++m) { const size_t off = (size_t)(row0 + ai * 128 + m * 16) * DM + col;
                    const f32x4 x0 = *(const f32x4*)(xin + off), x1 = *(const f32x4*)(xin + off + 4);
                    *(f32x4*)(xout + off) = x0 + ga * acc[ai][bj][m][0]; *(f32x4*)(xout + off + 4) = x1 + gb * acc[ai][bj][m][1]; } }
    }
};
struct EpiMoeGU {
    static constexpr bool PERM = true, AFTER_DRAIN = false; unsigned char* ws;
    __device__ __forceinline__ void operator()(const pg8::f32x4 (&acc)[2][2][4][2], const pg8::Unit& u, int wr, int wc, int fr, int fq) const {
        bf16* ACT = (bf16*)(ws + WS_ACT);
        const int row0 = u.pm * 256 + wr * 64 + fr, col0 = (u.pn & 1) * 128 + wc * 32 + 8 * fq;
#pragma unroll
        for (int ai = 0; ai < 2; ++ai)
#pragma unroll
            for (int m = 0; m < 4; ++m) { const f32x4 g0 = acc[ai][0][m][0], g1 = acc[ai][0][m][1], u0 = acc[ai][1][m][0], u1 = acc[ai][1][m][1];
                v4u w; w.x = pk2(siluf_(g0.x) * u0.x, siluf_(g0.y) * u0.y); w.y = pk2(siluf_(g0.z) * u0.z, siluf_(g0.w) * u0.w); w.z = pk2(siluf_(g1.x) * u1.x, siluf_(g1.y) * u1.y); w.w = pk2(siluf_(g1.z) * u1.z, siluf_(g1.w) * u1.w);
                *(v4u*)(ACT + (size_t)(row0 + ai * 128 + m * 16) * 256 + col0) = w; }
    }
};
struct EpiMoeDown {
    static constexpr bool PERM = true, AFTER_DRAIN = false; unsigned char* ws;
    __device__ __forceinline__ void operator()(const pg8::f32x4 (&acc)[2][2][4][2], const pg8::Unit& u, int wr, int wc, int fr, int fq) const {
        bf16* YS = (bf16*)(ws + WS_YS); const int* rowtok = (const int*)(ws + WS_ROWTOK); const float* roww = (const float*)(ws + WS_ROWW);
        const int row0 = u.pm * 256 + wr * 64 + fr, col0 = (u.pn & 3) * 256 + wc * 32 + 8 * fq;
#pragma unroll
        for (int ai = 0; ai < 2; ++ai)
#pragma unroll
            for (int m = 0; m < 4; ++m) { const int row = row0 + ai * 128 + m * 16; const int rt = rowtok[row]; const float wgt = roww[row];
                if (rt >= 0) {
#pragma unroll
                    for (int bj = 0; bj < 2; ++bj) { const f32x4 v0 = acc[ai][bj][m][0] * wgt, v1 = acc[ai][bj][m][1] * wgt;
                        v4u w; w.x = pk2(v0.x, v0.y); w.y = pk2(v0.z, v0.w); w.z = pk2(v1.x, v1.y); w.w = pk2(v1.z, v1.w);
                        *(v4u*)(YS + (size_t)rt * 1024 + col0 + bj * 128) = w; } } }
    }
};
struct MoeOrder {
    const LAS int* tile_exp; int nunits, G, c, sh;
    __device__ __forceinline__ bool next(int i, pg8::Unit& u) const {
        const int L = i * G + c; if (L >= nunits) return false;
        const int r = L >> sh, j = L & ((1 << sh) - 1);
        u.pm = r; u.pn = __builtin_amdgcn_readfirstlane((tile_exp[r] << sh) + j); return true;
    }
    __device__ __forceinline__ void a_ready(const pg8::Unit&) const {}
    __device__ __forceinline__ void done(const pg8::Unit&) const {}
};

__device__ __forceinline__ void ph_router(KArgs a, const Ctx& c, int l) {
    LAS int* lcnt = (LAS int*)(c.lds + MISC_OFF + 1024);
    LAS int* lbase = lcnt + 32;
    LAS int* tinf = lcnt + 64;
    LAS float* wreT = (LAS float*)c.lds;
    const int lane = c.lane;
    bf16* H2 = (bf16*)(a->ws + WS_H); unsigned* tokinfo = (unsigned*)(a->ws + WS_TOKINFO); int* rowtok = (int*)(a->ws + WS_ROWTOK);
    unsigned* gcnt = (unsigned*)(a->ws + WS_CTL) + CW_GCNT + l * 32;
    const float* n2w = a->in[I_N2W] + l * DM; const float* wrg = a->in[I_WRG] + (size_t)l * 1024 * 4; const float* wre = a->in[I_WRE] + (size_t)l * 1024 * 32;
    for (int i = c.bid * NTHR + c.tid; i < MOE_MAXROWS; i += c.G * NTHR) rowtok[i] = -1;
    for (int i = c.tid; i < 8192; i += NTHR) { const int k = i >> 3, n4 = (i & 7) * 4; const f32x4 w = *(const f32x4*)(wre + (size_t)k * 32 + n4);
        wreT[(n4 + 0) * 1024 + k] = w.x; wreT[(n4 + 1) * 1024 + k] = w.y; wreT[(n4 + 2) * 1024 + k] = w.z; wreT[(n4 + 3) * 1024 + k] = w.w; }
    LAS float* wrgT = (LAS float*)(c.lds + 131072);
    LAS float* rbias = (LAS float*)(c.lds + MISC_OFF + 3072);
    for (int i = c.tid; i < 1024; i += NTHR) { const f32x4 w = *(const f32x4*)(wrg + (size_t)i * 4); wrgT[i] = w.x; wrgT[1024 + i] = w.y; wrgT[2048 + i] = w.z; wrgT[3072 + i] = w.w; }
    if (c.tid < 36) rbias[c.tid] = c.tid < 4 ? a->in[I_BRG][l * 4 + c.tid] : a->in[I_BRE][l * 32 + c.tid - 4];
#if MK_PROBE_A >= 40 && MK_PROBE_A <= 42
    unsigned rpa = 0, rq = (unsigned)__builtin_amdgcn_s_memrealtime();
#define RP_TICK(w) do { const unsigned t_ = (unsigned)__builtin_amdgcn_s_memrealtime(); if ((w) == MK_PROBE_A - 40) rpa += t_ - rq; rq = t_; } while (0)
#else
#define RP_TICK(w) do {} while (0)
#endif
    for (int tb = c.bid; tb < NTOK / 64; tb += c.G) {
        __syncthreads();
        RP_TICK(0);
        if (c.tid < 32) lcnt[c.tid] = 0;
        __syncthreads();
        f32x4 cnw[4], csh[4], csc[4];
        { const float* mod = (const float*)(a->ws + WS_MOD) + (l * 4 + ((tb * 64) >> 12)) * 6144;
#pragma unroll
          for (int j = 0; j < 4; ++j) { const int col = 256 * j + 4 * lane; cnw[j] = *(const f32x4*)(n2w + col); csh[j] = *(const f32x4*)(mod + 3072 + col); csc[j] = *(const f32x4*)(mod + 4096 + col) + 1.0f; } }
        f32x4 hn[4];
        { const float* xr0 = (const float*)a->out + (size_t)(tb * 64 + c.wave * 8) * DM;
#pragma unroll
          for (int j = 0; j < 4; ++j) hn[j] = *(const f32x4*)(xr0 + 256 * j + 4 * lane); }
        for (int i = 0; i < 8; ++i) {
            const int tl = c.wave * 8 + i, m = tb * 64 + tl;
            f32x4 h[4];
#pragma unroll
            for (int j = 0; j < 4; ++j) h[j] = hn[j];
            if (i < 7) { const float* xr1 = (const float*)a->out + (size_t)(m + 1) * DM;
#pragma unroll
                for (int j = 0; j < 4; ++j) hn[j] = *(const f32x4*)(xr1 + 256 * j + 4 * lane); }
            const float rstd = row_rstd(h, lane);
            float ag[4] = {0.f, 0.f, 0.f, 0.f};
#pragma unroll
            for (int j = 0; j < 4; ++j) { const int col = 256 * j + 4 * lane;
                h[j] = h[j] * rstd * cnw[j] * csc[j] + csh[j];
                v2u o; o.x = pk2(h[j].x, h[j].y); o.y = pk2(h[j].z, h[j].w); *(v2u*)(H2 + (size_t)m * DM + col) = o;
#pragma unroll
                for (int q = 0; q < 4; ++q) { const f32x4 w = *(const LAS f32x4*)(wrgT + q * 1024 + col); ag[q] += (h[j].x * w.x + h[j].y * w.y) + (h[j].z * w.z + h[j].w * w.w); } }
#pragma unroll
            for (int q = 0; q < 4; ++q) ag[q] = wave_sum(ag[q], lane) + rbias[q];
            int g = 0; float gm = ag[0];
#pragma unroll
            for (int q = 1; q < 4; ++q) if (ag[q] > gm) { gm = ag[q]; g = q; }
            float den = 0.f;
#pragma unroll
            for (int q = 0; q < 4; ++q) den += __expf(ag[q] - gm);
            const float ptop = 1.f / den;
            float ae[8] = {0.f, 0.f, 0.f, 0.f, 0.f, 0.f, 0.f, 0.f};
#pragma unroll
            for (int j = 0; j < 4; ++j) { const int col = 256 * j + 4 * lane;
#pragma unroll
                for (int e = 0; e < 8; ++e) { const f32x4 w = *(const LAS f32x4*)(wreT + (g * 8 + e) * 1024 + col); ae[e] += (h[j].x * w.x + h[j].y * w.y) + (h[j].z * w.z + h[j].w * w.w); } }
#pragma unroll
            for (int q = 0; q < 8; ++q) ae[q] = wave_sum(ae[q], lane) + rbias[4 + g * 8 + q];
            int e0 = 0; float v0 = ae[0];
#pragma unroll
            for (int q = 1; q < 8; ++q) if (ae[q] > v0) { v0 = ae[q]; e0 = q; }
            int e1 = -1; float v1 = -3e38f;
#pragma unroll
            for (int q = 0; q < 8; ++q) if (q != e0 && ae[q] > v1) { v1 = ae[q]; e1 = q; }
            const float ex = __expf(v1 - v0); const float w0 = ptop / (1.f + ex), w1 = ptop * ex / (1.f + ex);
            if (lane == 0) { const int E0 = g * 8 + e0, E1 = g * 8 + e1;
                const int r0 = atomicAdd((int*)(lcnt + E0), 1), r1 = atomicAdd((int*)(lcnt + E1), 1);
                tinf[tl * 6 + 0] = E0; tinf[tl * 6 + 1] = E1; tinf[tl * 6 + 2] = r0; tinf[tl * 6 + 3] = r1; tinf[tl * 6 + 4] = __float_as_int(w0); tinf[tl * 6 + 5] = __float_as_int(w1); }
        }
        __syncthreads();
        RP_TICK(1);
        if (c.tid < 32) lbase[c.tid] = (int)__hip_atomic_fetch_add(gcnt + c.tid, (unsigned)lcnt[c.tid], RLX_AGENT);
        __syncthreads();
        if (c.tid < 64) { const int m = tb * 64 + c.tid; const int E0 = tinf[c.tid * 6], E1 = tinf[c.tid * 6 + 1];
            v4u o; o.x = (unsigned)E0; o.y = (unsigned)E1; o.z = (unsigned)(lbase[E0] + tinf[c.tid * 6 + 2]); o.w = (unsigned)(lbase[E1] + tinf[c.tid * 6 + 3]);
            *(v4u*)(tokinfo + (size_t)m * 8) = o; *(v2u*)(tokinfo + (size_t)m * 8 + 4) = (v2u){(unsigned)tinf[c.tid * 6 + 4], (unsigned)tinf[c.tid * 6 + 5]}; }
        RP_TICK(2);
    }
#if MK_PROBE_A >= 40 && MK_PROBE_A <= 42
    if (blockIdx.x == 0 && c.tid == 0) ((unsigned long long*)((unsigned*)(a->ws + WS_CTL) + 12288))[60 + l] = rpa;
#endif
}
__device__ __forceinline__ void moe_table(KArgs a, const Ctx& c, int l) {
    LAS int* tile_exp = (LAS int*)(c.lds + MISC_OFF + 2048); LAS int* offs = tile_exp + 192; LAS int* ntl = offs + 32; LAS int* pre = ntl + 4;
    const unsigned* gcnt = (const unsigned*)(a->ws + WS_CTL) + CW_GCNT + l * 32;
    __syncthreads();
    if (c.tid < 64) { const int e = c.tid & 31; const int cnt = (int)__hip_atomic_load(gcnt + e, RLX_AGENT); const int nt = (cnt + 255) >> 8; int inc = nt;
#pragma unroll
        for (int o = 1; o < 32; o <<= 1) { const int v = shidx_i(inc, (c.lane - o) & 63); if (e >= o) inc += v; }
        if (c.tid < 32) { offs[e] = (inc - nt) * 256; pre[e] = inc; if (e == 31) ntl[0] = inc; } }
    __syncthreads();
    if (c.tid < MOE_MAXTILES) { int E = 0;
#pragma unroll
        for (int e = 0; e < 32; ++e) E += (pre[e] <= c.tid) ? 1 : 0;
        tile_exp[c.tid] = E < 31 ? E : 31; }
    __syncthreads();
}
__device__ __forceinline__ void ph_gather(KArgs a, const Ctx& c, int l) {
    moe_table(a, c, l);
    const LAS int* offs = (const LAS int*)(c.lds + MISC_OFF + 2048) + 192;
    const int gw = c.bid * NW + c.wave, NGW = c.G * NW, lane = c.lane;
    const bf16* H2 = (const bf16*)(a->ws + WS_H); bf16* HS = (bf16*)(a->ws + WS_HS); const unsigned* tokinfo = (const unsigned*)(a->ws + WS_TOKINFO);
    int* rowtok = (int*)(a->ws + WS_ROWTOK); float* roww = (float*)(a->ws + WS_ROWW);
    for (int m = gw; m < NTOK; m += NGW) {
        const v4u ti = *(const v4u*)(tokinfo + (size_t)m * 8); const v2u tw = *(const v2u*)(tokinfo + (size_t)m * 8 + 4);
        const int d0 = offs[ti.x] + (int)ti.z, d1 = offs[ti.y] + (int)ti.w;
        const v4u x0 = *(const v4u*)(H2 + (size_t)m * DM + lane * 8), x1 = *(const v4u*)(H2 + (size_t)m * DM + 512 + lane * 8);
        *(v4u*)(HS + (size_t)d0 * DM + lane * 8) = x0; *(v4u*)(HS + (size_t)d0 * DM + 512 + lane * 8) = x1;
        *(v4u*)(HS + (size_t)d1 * DM + lane * 8) = x0; *(v4u*)(HS + (size_t)d1 * DM + 512 + lane * 8) = x1;
        if (lane == 0) { rowtok[d0] = m * 2; rowtok[d1] = m * 2 + 1; roww[d0] = __uint_as_float(tw.x); roww[d1] = __uint_as_float(tw.y); }
    }
}
constexpr int DN_IMG = 57344, DN_LDW = 132, DN_LDA = 68;
typedef __bf16 bf16x2_t __attribute__((ext_vector_type(2)));
typedef float f32x2_t __attribute__((ext_vector_type(2)));
__device__ __forceinline__ unsigned cvtpk(float lo, float hi) { f32x2_t v = {lo, hi}; bf16x2_t b = __builtin_convertvector(v, bf16x2_t); return __builtin_bit_cast(unsigned, b); }
__device__ __forceinline__ bf16x8 pack8(f32x4 a, f32x4 b) { v4u w; w.x = cvtpk(a.x, a.y); w.y = cvtpk(a.z, a.w); w.z = cvtpk(b.x, b.y); w.w = cvtpk(b.z, b.w); return __builtin_bit_cast(bf16x8, w); }
#define MFMA16(a, b, c) __builtin_amdgcn_mfma_f32_16x16x32_bf16((a), (b), (c), 0, 0, 0)

__device__ __forceinline__ void dn_raw_load(KArgs a, const Ctx& c, int item, v4u (&raw)[3][5]) {
    const bf16* QKVB = (const bf16*)(a->ws + WS_QKVB);
    const int n = item & 63, h = (item >> 6) & 3, b = item >> 8, t0 = n * DNC;
    const int cg = c.tid & 15, rg = c.tid >> 4, tA = t0 + 2 * rg - 3;
#pragma unroll
    for (int part = 0; part < 3; ++part)
#pragma unroll
        for (int i = 0; i < 5; ++i) { const int tt = tA + i; raw[part][i] = (v4u){0u, 0u, 0u, 0u};
            if (tt >= 0) raw[part][i] = *(const v4u*)(QKVB + (size_t)(b * SEQ + tt) * 1536 + part * 512 + h * 128 + 8 * cg); }
}
__device__ __forceinline__ void dn_conv_store(KArgs a, const Ctx& c, int l, int h, const v4u (&raw)[3][5], LAS float* qs, LAS float* ks, LAS float* vs) {
    const float* cw = a->in[I_CONVW] + (size_t)l * 4 * 1536;
    const int cg = c.tid & 15, rg = c.tid >> 4;
#pragma unroll
    for (int part = 0; part < 3; ++part) {
        const int colb = part * 512 + h * 128 + 8 * cg;
        float w[4][8];
#pragma unroll
        for (int i = 0; i < 4; ++i) { const f32x4 w0 = *(const f32x4*)(cw + i * 1536 + colb), w1 = *(const f32x4*)(cw + i * 1536 + colb + 4);
            w[i][0] = w0.x; w[i][1] = w0.y; w[i][2] = w0.z; w[i][3] = w0.w; w[i][4] = w1.x; w[i][5] = w1.y; w[i][6] = w1.z; w[i][7] = w1.w; }
        LAS float* dst = part == 0 ? qs : part == 1 ? ks : vs;
#pragma unroll
        for (int rr = 0; rr < 2; ++rr) {
            float y[8];
#pragma unroll
            for (int e = 0; e < 8; ++e) y[e] = 0.f;
#pragma unroll
            for (int i = 0; i < 4; ++i) { const v4u x = raw[part][rr + i];
                y[0] += w[i][0] * bflo(x.x); y[1] += w[i][1] * bfhi(x.x); y[2] += w[i][2] * bflo(x.y); y[3] += w[i][3] * bfhi(x.y); y[4] += w[i][4] * bflo(x.z); y[5] += w[i][5] * bfhi(x.z); y[6] += w[i][6] * bflo(x.w); y[7] += w[i][7] * bfhi(x.w); }
            float ss = 0.f;
#pragma unroll
            for (int e = 0; e < 8; ++e) { y[e] = siluf_(y[e]); ss += y[e] * y[e]; }
            if (part < 2) { ss += dpp_f<0xB1>(ss); ss += dpp_f<0x4E>(ss); ss += dpp_f<0x141>(ss); ss += dpp_f<0x140>(ss);
                const float rs = __builtin_amdgcn_rsqf(ss + EPS) * (part == 0 ? 0.08838834764831845f : 1.f);
#pragma unroll
                for (int e = 0; e < 8; ++e) y[e] *= rs; }
            const int r = 2 * rg + rr;
            *(LAS f32x4*)(dst + r * DN_LDW + 8 * cg) = (f32x4){y[0], y[1], y[2], y[3]}; *(LAS f32x4*)(dst + r * DN_LDW + 8 * cg + 4) = (f32x4){y[4], y[5], y[6], y[7]};
        }
    }
}

__device__ __forceinline__ void ph_dn_prep(KArgs a, const Ctx& c, int l) {
    LAS float* qs = (LAS float*)c.lds; LAS float* ks = qs + 64 * DN_LDW; LAS float* vs = ks + 64 * DN_LDW;
    LAS float* Am = vs + 64 * DN_LDW; LAS float* Pm = Am + 64 * DN_LDA;
    LAS float* bt = (LAS float*)(c.lds + MISC_OFF + 1024); LAS float* Gc = bt + 64;
    const float* beta = (const float*)(a->ws + WS_BETA); const float* glog = (const float*)(a->ws + WS_GLOG);
#if MK_PROBE_A >= 30 && MK_PROBE_A <= 36
    unsigned ppa = 0, pq = (unsigned)__builtin_amdgcn_s_memrealtime();
#define PP_TICK(w) do { const unsigned t_ = (unsigned)__builtin_amdgcn_s_memrealtime(); if ((w) == MK_PROBE_A - 30) ppa += t_ - pq; pq = t_; } while (0)
#else
#define PP_TICK(w) do {} while (0)
#endif
    v4u raw[3][5];
    if (c.bid < NB * HB * NCH) dn_raw_load(a, c, c.bid, raw);
    for (int item = c.bid; item < NB * HB * NCH; item += c.G) {
        int tid = c.tid; asm volatile("" : "+v"(tid));
        const int lane = tid & 63, row = lane & 15, quad = lane >> 4;
        const int n = item & 63, h = (item >> 6) & 3, b = item >> 8, t0 = n * DNC;
        unsigned char* img = a->ws + WS_IMG + (size_t)item * DN_IMG;
        __syncthreads();
        PP_TICK(6);
        dn_conv_store(a, c, l, h, raw, qs, ks, vs);
        { const int nxt = item + c.G; if (nxt < NB * HB * NCH) dn_raw_load(a, c, nxt, raw); }
        if (tid < 64) { const int tok = b * SEQ + t0 + tid; bt[tid] = beta[tok * 4 + h]; float g = glog[tok * 4 + h];
#pragma unroll
            for (int o = 1; o < 64; o <<= 1) { const float v = shidx(g, (lane - o) & 63); if (lane >= o) g += v; }
            Gc[tid] = g; }
        __syncthreads();
        PP_TICK(0);
        {   const int sel = c.wave >> 2, ti = c.wave & 3; const LAS float* rs = sel == 0 ? ks : qs; LAS float* dstm = sel == 0 ? Am : Pm;
            bf16x8 af[4];
#pragma unroll
            for (int s = 0; s < 4; ++s) { const LAS float* p = rs + (ti * 16 + row) * DN_LDW + 32 * s + 8 * quad; af[s] = pack8(*(const LAS f32x4*)p, *(const LAS f32x4*)(p + 4)); }
            for (int tj = 0; tj < 4; ++tj) {
                f32x4 acc = {0.f, 0.f, 0.f, 0.f};
                if (tj <= ti) {
#pragma unroll
                    for (int s = 0; s < 4; ++s) { const LAS float* p = ks + (tj * 16 + row) * DN_LDW + 32 * s + 8 * quad; const bf16x8 bfr = pack8(*(const LAS f32x4*)p, *(const LAS f32x4*)(p + 4)); acc = MFMA16(af[s], bfr, acc); }
                }
                const int j = tj * 16 + row; const float Gj = Gc[j];
#pragma unroll
                for (int r = 0; r < 4; ++r) { const int i = ti * 16 + 4 * quad + r; const float dec = __expf(fminf(Gc[i] - Gj, 0.f));
                    float v = acc[r] * dec; if (sel == 0) v = (j < i) ? v * bt[i] : 0.f; else v = (j <= i) ? v : 0.f;
                    dstm[i * DN_LDA + j] = v; }
            }
        }
        __syncthreads();
        PP_TICK(1);
        const float Glast = Gc[63];
        {
            for (int q = 0; q < 5; ++q) { const int p = tid + 512 * q, blk = p >> 6; float v[8];
                if (blk < 16) { const int mt = blk >> 2, s = blk & 3, cr = 16 * mt + row, k0 = 32 * s + 4 * quad; const float e = __expf(Gc[cr]);
                    const f32x4 v0 = *(const LAS f32x4*)(qs + cr * DN_LDW + k0), v1 = *(const LAS f32x4*)(qs + cr * DN_LDW + k0 + 16);
                    v[0] = v0.x * e; v[1] = v0.y * e; v[2] = v0.z * e; v[3] = v0.w * e; v[4] = v1.x * e; v[5] = v1.y * e; v[6] = v1.z * e; v[7] = v1.w * e; }
                else if (blk < 32) { const int b2 = blk - 16, mt = b2 >> 1, s = b2 & 1, k = 16 * mt + row;
#pragma unroll
                    for (int j = 0; j < 8; ++j) { const int cj = 32 * s + 16 * (j >> 2) + 4 * quad + (j & 3); v[j] = ks[cj * DN_LDW + k] * __expf(Glast - Gc[cj]); } }
                else { const int b3 = blk - 32, mt = b3 >> 1, s = b3 & 1, i = 16 * mt + row, c0 = 32 * s + 4 * quad;
                    const f32x4 v0 = *(const LAS f32x4*)(Pm + i * DN_LDA + c0), v1 = *(const LAS f32x4*)(Pm + i * DN_LDA + c0 + 16);
                    v[0] = v0.x; v[1] = v0.y; v[2] = v0.z; v[3] = v0.w; v[4] = v1.x; v[5] = v1.y; v[6] = v1.z; v[7] = v1.w; }
                v4u w; w.x = cvtpk(v[0], v[1]); w.y = cvtpk(v[2], v[3]); w.z = cvtpk(v[4], v[5]); w.w = cvtpk(v[6], v[7]);
                *(v4u*)(img + 16384 + (size_t)p * 16) = w; }
            if (tid == 0) ((float*)(a->ws + WS_GL))[item] = __expf(Glast);
        }
        __syncthreads();
        PP_TICK(2);
        LAS float* Ti = Pm;
        if (c.wave < 4 && lane < 16) { const int bI = c.wave; float sv[16];
            int vz = 0; asm volatile("" : "+v"(vz)); const LAS float* AmV = Am + vz + (16 * bI) * DN_LDA + 16 * bI;
#pragma unroll
            for (int r = 0; r < 16; ++r) sv[r] = (r == lane) ? 1.f : 0.f;
#pragma unroll
            for (int rp = 0; rp < 15; ++rp)
#pragma unroll
                for (int r = rp + 1; r < 16; ++r) sv[r] -= AmV[r * DN_LDA + rp] * sv[rp];
#pragma unroll
            for (int r = 0; r < 16; ++r) Ti[(bI * 16 + r) * 20 + lane] = sv[r]; }
        __syncthreads();
        PP_TICK(3);
        {   const float isw0 = 0.f; (void)isw0;
#pragma unroll
            for (int bI = 0; bI < 4; ++bI) {
#pragma unroll
                for (int q = 0; q < 2; ++q) { const int nt = 2 * c.wave + q; const bool isw = nt >= 8; LAS float* xb = (isw ? ks : vs) + (nt & 7) * 16;
                    if (bI > 0) {
                        f32x4 acc = {0.f, 0.f, 0.f, 0.f};
#pragma unroll
                        for (int s2 = 0; s2 < (bI == 3 ? 2 : 1); ++s2) { const int j0 = 32 * s2 + 8 * quad;
                            f32x4 a0 = *(const LAS f32x4*)(Am + (16 * bI + row) * DN_LDA + j0), a1 = *(const LAS f32x4*)(Am + (16 * bI + row) * DN_LDA + j0 + 4);
                            if (j0 >= 16 * bI) { a0 = (f32x4){0.f, 0.f, 0.f, 0.f}; a1 = a0; }
                            float xv[8];
#pragma unroll
                            for (int j = 0; j < 8; ++j) xv[j] = xb[(j0 + j) * DN_LDW + row];
                            acc = MFMA16(pack8(a0, a1), pack8((f32x4){xv[0], xv[1], xv[2], xv[3]}, (f32x4){xv[4], xv[5], xv[6], xv[7]}), acc); }
#pragma unroll
                        for (int r = 0; r < 4; ++r) { const int i = 16 * bI + 4 * quad + r; const float sc = isw ? bt[i] * __expf(Gc[i]) : bt[i]; xb[i * DN_LDW + row] = xb[i * DN_LDW + row] * sc - acc[r]; }
                    }
                }
                if (bI > 0) __syncthreads();
#pragma unroll
                for (int q = 0; q < 2; ++q) { const int nt = 2 * c.wave + q; const bool isw = nt >= 8; LAS float* xb = (isw ? ks : vs) + (nt & 7) * 16;
                    f32x4 a0 = {0.f, 0.f, 0.f, 0.f}, a1 = a0; float xv[8];
                    if (quad < 2) { a0 = *(const LAS f32x4*)(Ti + (bI * 16 + row) * 20 + 8 * quad); a1 = *(const LAS f32x4*)(Ti + (bI * 16 + row) * 20 + 8 * quad + 4); }
#pragma unroll
                    for (int j = 0; j < 8; ++j) { const int i = 16 * bI + ((8 * quad + j) & 15); float v = xb[i * DN_LDW + row];
                        if (bI == 0) v *= isw ? bt[i] * __expf(Gc[i]) : bt[i];
                        xv[j] = v; }
                    f32x4 acc = {0.f, 0.f, 0.f, 0.f};
                    acc = MFMA16(pack8(a0, a1), pack8((f32x4){xv[0], xv[1], xv[2], xv[3]}, (f32x4){xv[4], xv[5], xv[6], xv[7]}), acc);
#pragma unroll
                    for (int r = 0; r < 4; ++r) xb[(16 * bI + 4 * quad + r) * DN_LDW + row] = acc[r]; }
                __syncthreads();
            }
        }
        PP_TICK(4);
#pragma unroll
        for (int q = 0; q < 2; ++q) { const int p = tid + 512 * q, blk = p >> 6, mt = blk >> 2, s = blk & 3, cr = 16 * mt + row, k0 = 32 * s + 4 * quad;
            const f32x4 v0 = *(const LAS f32x4*)(ks + cr * DN_LDW + k0), v1 = *(const LAS f32x4*)(ks + cr * DN_LDW + k0 + 16);
            v4u w; w.x = cvtpk(-v0.x, -v0.y); w.y = cvtpk(-v0.z, -v0.w); w.z = cvtpk(-v1.x, -v1.y); w.w = cvtpk(-v1.z, -v1.w);
            *(v4u*)(img + (size_t)p * 16) = w; }
        {   unsigned char* ug = a->ws + WS_U + (size_t)item * 16384;
#pragma unroll
            for (int q = 0; q < 2; ++q) { const int p = tid + 512 * q, sl = p >> 7, ln = (p >> 1) & 63, hh = p & 1, v = 16 * sl + (ln & 15), qd = ln >> 4; float u8[8];
#pragma unroll
                for (int e = 0; e < 8; ++e) u8[e] = vs[(16 * (2 * hh + (e >> 2)) + 4 * qd + (e & 3)) * DN_LDW + v];
                v4u w; w.x = cvtpk(u8[0], u8[1]); w.y = cvtpk(u8[2], u8[3]); w.z = cvtpk(u8[4], u8[5]); w.w = cvtpk(u8[6], u8[7]);
                *(v4u*)(ug + (size_t)(sl * 64 + ln) * 32 + hh * 16) = w; } }
        PP_TICK(5);
    }
#if MK_PROBE_A >= 30 && MK_PROBE_A <= 36
    if (blockIdx.x == 0 && c.tid == 0) ((unsigned long long*)((unsigned*)(a->ws + WS_CTL) + 12288))[56 + l] = ppa;
#endif
}

constexpr int DN_OS = 2 * DN_IMG;
__device__ __forceinline__ void ph_dn_scan(KArgs a, const Ctx& c, int l) {
    LAS unsigned char* lds = c.lds;
    const int lane = c.lane, wv = c.wave, tid = c.tid; const bool cw = wv < 4;
    const bf16* ZB = (const bf16*)(a->ws + WS_ZB); bf16* YB = (bf16*)(a->ws + WS_YB); const float* onw = a->in[I_ONW] + l * 128; const float* glp = (const float*)(a->ws + WS_GL);
    float* ssq = (float*)(a->ws + WS_SSQ);
    for (int item = c.bid; item < 2 * NB * HB; item += c.G) {
        const int bh = item >> 1, half = item & 1, b = bh >> 2, h = bh & 3;
        const unsigned char* img0 = a->ws + WS_IMG + (size_t)bh * 64 * DN_IMG;
        __syncthreads();
        if (cw) {
            const unsigned char* ugb = a->ws + WS_U + (size_t)bh * 64 * 16384; const unsigned uoff = (unsigned)((half * 4 + wv) * 64 + lane) * 32u;
            f32x4 S[8];
#pragma unroll
            for (int m = 0; m < 8; ++m) S[m] = (f32x4){0.f, 0.f, 0.f, 0.f};
            v4u uc0 = *(const v4u*)(ugb + uoff), uc1 = *(const v4u*)(ugb + uoff + 16);
            for (int n = 0; n <= NCH; ++n) {
                asm volatile("s_waitcnt lgkmcnt(0)\n\ts_barrier" ::: "memory");
                if (n == NCH) break;
                v4u un0 = uc0, un1 = uc1;
                if (n + 1 < NCH) { un0 = *(const v4u*)(ugb + (size_t)(n + 1) * 16384 + uoff); un1 = *(const v4u*)(ugb + (size_t)(n + 1) * 16384 + uoff + 16); }
                const float gl = glp[bh * 64 + n];
                const LAS unsigned char* im = lds + (n & 1) * DN_IMG + lane * 16;
                bf16x8 Sb[4];
#pragma unroll
                for (int s = 0; s < 4; ++s) Sb[s] = pack8(S[2 * s], S[2 * s + 1]);
                f32x4 X[4], O[4];
                X[0] = (f32x4){bflo(uc0.x), bfhi(uc0.x), bflo(uc0.y), bfhi(uc0.y)}; X[1] = (f32x4){bflo(uc0.z), bfhi(uc0.z), bflo(uc0.w), bfhi(uc0.w)};
                X[2] = (f32x4){bflo(uc1.x), bfhi(uc1.x), bflo(uc1.y), bfhi(uc1.y)}; X[3] = (f32x4){bflo(uc1.z), bfhi(uc1.z), bflo(uc1.w), bfhi(uc1.w)};
                bf16x8 fa[8], fb[8];
#define DN_LDF(arr, off) do { _Pragma("unroll") for (int q_ = 0; q_ < 8; ++q_) arr[q_] = *(const LAS bf16x8*)(im + (off) + q_ * 1024); } while (0)
                DN_LDF(fa, 0); DN_LDF(fb, 8192);
#pragma unroll
                for (int mt = 0; mt < 2; ++mt)
#pragma unroll
                    for (int s = 0; s < 4; ++s) X[mt] = MFMA16(fa[mt * 4 + s], Sb[s], X[mt]);
                DN_LDF(fa, 16384);
#pragma unroll
                for (int mt = 0; mt < 2; ++mt)
#pragma unroll
                    for (int s = 0; s < 4; ++s) X[2 + mt] = MFMA16(fb[mt * 4 + s], Sb[s], X[2 + mt]);
                DN_LDF(fb, 16384 + 8192);
#pragma unroll
                for (int mt = 0; mt < 2; ++mt) { O[mt] = (f32x4){0.f, 0.f, 0.f, 0.f};
#pragma unroll
                    for (int s = 0; s < 4; ++s) O[mt] = MFMA16(fa[mt * 4 + s], Sb[s], O[mt]); }
                DN_LDF(fa, 32768);
#pragma unroll
                for (int mt = 0; mt < 2; ++mt) { O[2 + mt] = (f32x4){0.f, 0.f, 0.f, 0.f};
#pragma unroll
                    for (int s = 0; s < 4; ++s) O[2 + mt] = MFMA16(fb[mt * 4 + s], Sb[s], O[2 + mt]); }
                DN_LDF(fb, 32768 + 8192);
                bf16x8 Xb[2];
                Xb[0] = pack8(X[0], X[1]); Xb[1] = pack8(X[2], X[3]);
#pragma unroll
                for (int m = 0; m < 4; ++m) { S[m] = S[m] * gl;
#pragma unroll
                    for (int s = 0; s < 2; ++s) S[m] = MFMA16(fa[m * 2 + s], Xb[s], S[m]); }
                DN_LDF(fa, 49152);
#pragma unroll
                for (int m = 0; m < 4; ++m) { S[4 + m] = S[4 + m] * gl;
#pragma unroll
                    for (int s = 0; s < 2; ++s) S[4 + m] = MFMA16(fb[m * 2 + s], Xb[s], S[4 + m]); }
#pragma unroll
                for (int mt = 0; mt < 4; ++mt)
#pragma unroll
                    for (int s = 0; s < 2; ++s) O[mt] = MFMA16(fa[mt * 2 + s], Xb[s], O[mt]);
#undef DN_LDF
                LAS unsigned short* os = (LAS unsigned short*)(lds + DN_OS + (n & 1) * 8192);
#pragma unroll
                for (int mt = 0; mt < 4; ++mt)
#pragma unroll
                    for (int r = 0; r < 4; ++r) os[(16 * mt + 4 * (lane >> 4) + r) * 64 + 16 * wv + (lane & 15)] = (unsigned short)(cvtpk(O[mt][r], 0.f) & 0xffffu);
                uc0 = un0; uc1 = un1;
            }
        } else {
            const int ht = tid - 256, hw = wv - 4, nr = ht >> 2, nq = ht & 3;
            const bf16* zpb = ZB + (size_t)(b * SEQ) * 512 + h * 128 + half * 64; bf16* ypb = YB + (size_t)(b * SEQ) * 512 + h * 128 + half * 64; const unsigned zoff = (unsigned)(nr * 512 + nq * 16);
            float* sqp = ssq + ((size_t)(b * SEQ + nr) * 4 + h) * 2 + half;
#define DN_DMA(n, buf) do { _Pragma("unroll") for (int q_ = 0; q_ < 14; ++q_) { const int pc_ = hw + 4 * q_; \
                __builtin_amdgcn_global_load_lds((const unsigned*)(img0 + (size_t)(n) * DN_IMG + pc_ * 1024 + lane * 16), (LAS unsigned*)(lds + (buf) * DN_IMG + pc_ * 1024), 16, 0, 0); } } while (0)
            DN_DMA(0, 0);
            v4u zc0 = *(const v4u*)(zpb + zoff), zc1 = *(const v4u*)(zpb + zoff + 8);
            f32x4 ow[4];
#pragma unroll
            for (int q = 0; q < 4; ++q) ow[q] = *(const f32x4*)(onw + half * 64 + nq * 16 + q * 4);
            asm volatile("s_waitcnt vmcnt(0) lgkmcnt(0)\n\ts_barrier" ::: "memory");
            DN_DMA(1, 1);
            for (int n = 1; n <= NCH; ++n) {
                if (n == 1) asm volatile("s_waitcnt vmcnt(0) lgkmcnt(0)\n\ts_barrier" ::: "memory"); else asm volatile("s_waitcnt vmcnt(3) lgkmcnt(0)\n\ts_barrier" ::: "memory");
                v4u zn0 = zc0, zn1 = zc1;
                if (n < NCH) { zn0 = *(const v4u*)(zpb + (size_t)n * DNC * 512 + zoff); zn1 = *(const v4u*)(zpb + (size_t)n * DNC * 512 + zoff + 8); }
                asm volatile("" ::: "memory");
                if (n + 1 < NCH) DN_DMA(n + 1, (n + 1) & 1);
                asm volatile("" ::: "memory");
                {
                    const LAS unsigned short* os = (const LAS unsigned short*)(lds + DN_OS + ((n - 1) & 1) * 8192) + nr * 64 + nq * 16;
                    float o[16]; float ss = 0.f;
                    const v4u o0 = *(const LAS v4u*)os, o1 = *(const LAS v4u*)(os + 8);
                    o[0] = bflo(o0.x); o[1] = bfhi(o0.x); o[2] = bflo(o0.y); o[3] = bfhi(o0.y); o[4] = bflo(o0.z); o[5] = bfhi(o0.z); o[6] = bflo(o0.w); o[7] = bfhi(o0.w);
                    o[8] = bflo(o1.x); o[9] = bfhi(o1.x); o[10] = bflo(o1.y); o[11] = bfhi(o1.y); o[12] = bflo(o1.z); o[13] = bfhi(o1.z); o[14] = bflo(o1.w); o[15] = bfhi(o1.w);
#pragma unroll
                    for (int e = 0; e < 16; ++e) ss += o[e] * o[e];
                    ss += dpp_f<0xB1>(ss); ss += dpp_f<0x4E>(ss);
                    bf16* yp = ypb + (size_t)(n - 1) * DNC * 512 + zoff;
                    v4u y; y.x = cvtpk(o[0] * ow[0].x * siluf_(bflo(zc0.x)), o[1] * ow[0].y * siluf_(bfhi(zc0.x))); y.y = cvtpk(o[2] * ow[0].z * siluf_(bflo(zc0.y)), o[3] * ow[0].w * siluf_(bfhi(zc0.y)));
                    y.z = cvtpk(o[4] * ow[1].x * siluf_(bflo(zc0.z)), o[5] * ow[1].y * siluf_(bfhi(zc0.z))); y.w = cvtpk(o[6] * ow[1].z * siluf_(bflo(zc0.w)), o[7] * ow[1].w * siluf_(bfhi(zc0.w)));
                    *(v4u*)yp = y;
                    y.x = cvtpk(o[8] * ow[2].x * siluf_(bflo(zc1.x)), o[9] * ow[2].y * siluf_(bfhi(zc1.x))); y.y = cvtpk(o[10] * ow[2].z * siluf_(bflo(zc1.y)), o[11] * ow[2].w * siluf_(bfhi(zc1.y)));
                    y.z = cvtpk(o[12] * ow[3].x * siluf_(bflo(zc1.z)), o[13] * ow[3].y * siluf_(bfhi(zc1.z))); y.w = cvtpk(o[14] * ow[3].z * siluf_(bflo(zc1.w)), o[15] * ow[3].w * siluf_(bfhi(zc1.w)));
                    *(v4u*)(yp + 8) = y;
                    sqp[(size_t)(n - 1) * DNC * 8] = ss;
                }
                zc0 = zn0; zc1 = zn1;
            }
#undef DN_DMA
        }
        asm volatile("s_waitcnt vmcnt(0)" ::: "memory"); __syncthreads();
    }
}
__device__ __forceinline__ void ph_yb_norm(KArgs a, const Ctx& c) {
    const int gw = c.bid * NW + c.wave, NGW = c.G * NW, lane = c.lane; bf16* YB = (bf16*)(a->ws + WS_YB); const float* ssq = (const float*)(a->ws + WS_SSQ);
    for (int m = gw; m < NTOK; m += NGW) {
        const f32x2_t sq = *(const f32x2_t*)(ssq + (size_t)m * 8 + (lane >> 4) * 2); const float rstd = __builtin_amdgcn_rsqf((sq.x + sq.y) * (1.f / 128.f) + EPS);
        v4u w = *(const v4u*)(YB + (size_t)m * 512 + lane * 8);
        w.x = cvtpk(bflo(w.x) * rstd, bfhi(w.x) * rstd); w.y = cvtpk(bflo(w.y) * rstd, bfhi(w.y) * rstd); w.z = cvtpk(bflo(w.z) * rstd, bfhi(w.z) * rstd); w.w = cvtpk(bflo(w.w) * rstd, bfhi(w.w) * rstd);
        *(v4u*)(YB + (size_t)m * 512 + lane * 8) = w;
    }
}
typedef short v4i16_t __attribute__((ext_vector_type(4)));
#define MFMA32(a, b, c) __builtin_amdgcn_mfma_f32_32x32x16_bf16((a), (b), (c), 0, 0, 0)
constexpr int AT_ROWB = 144;
constexpr int AT_TILE = 64 * AT_ROWB, AT_K = 0, AT_V = 3 * AT_TILE, AT_OST = 6 * AT_TILE, AT_BT = AT_OST + 8 * 32 * AT_ROWB, AT_KM = AT_BT + 1024, AT_UW = MISC_OFF + 512;
__device__ __forceinline__ int crow(int r, int hi) { return (r & 3) + 8 * (r >> 2) + 4 * hi; }
__device__ __forceinline__ bf16x8 vtr2(const LAS unsigned char* p) {
    const v4i16_t lo = __builtin_amdgcn_ds_read_tr16_b64_v4i16((LAS v4i16_t*)p), hi = __builtin_amdgcn_ds_read_tr16_b64_v4i16((LAS v4i16_t*)(p + 8 * AT_ROWB));
    return (bf16x8){lo[0], lo[1], lo[2], lo[3], hi[0], hi[1], hi[2], hi[3]};
}
__device__ __forceinline__ void ph_attn(KArgs a, const Ctx& c, int l) {
    LAS unsigned char* lds = c.lds; const int lane = c.lane, wv = c.wave, tid = c.tid, r32 = lane & 31, hi = lane >> 5;
    LAS float* btab = (LAS float*)(lds + AT_BT); LAS float* kms = (LAS float*)(lds + AT_KM); volatile LAS int* uw = (volatile LAS int*)(lds + AT_UW);
    const bf16* QKVA = (const bf16*)(a->ws + WS_QKVA); const float* kmean = (const float*)(a->ws + WS_KMEAN); bf16* YA = (bf16*)(a->ws + WS_YA); const float* relb = a->in[I_RELB];
    unsigned* ctr = (unsigned*)(a->ws + WS_CTL) + CW_ACTR + l * 64;
    const float LOG2E = 1.4426950408889634f, C2 = 0.125f * LOG2E, NINF = -__builtin_inff();
    const int srow = tid >> 3, sch = tid & 7; const unsigned sdst = srow * AT_ROWB + sch * 16;
    for (;;) {
        __syncthreads();
        if (tid == 0) uw[0] = (int)__hip_atomic_fetch_add(ctr, 1u, RLX_AGENT);
        __syncthreads();
        const int u0 = uw[0];
        constexpr int NCVQ = CV_NUNITS - CV_EARLYQ;
        if (u0 < NCVQ) { convert_unit(a, c, l, CV_EARLYQ + u0); continue; }
        const int u = u0 - NCVQ; if (u >= NB * HA * NBLK) break;
        const int qb = 15 - (u >> 5), bh = u & 31, b = bh >> 3, h = bh & 7;
        const float c31 = relb[31 * 8 + h];
        for (int i = tid; i < 129; i += NTHR) btab[i] = (i < 128 ? (relb[(int)T5B[i] * 8 + h] - c31) : 0.f) * LOG2E;
        for (int i = tid; i < 1024; i += NTHR) kms[i] = kmean[(size_t)bh * 1024 + i];
        const int qrel = wv * 32 + r32, tokq = b * SEQ + qb * 256 + qrel;
        const bf16* kbase = QKVA + (size_t)(b * SEQ) * 1536 + 512 + h * 64 + sch * 8;
#define AT_LOAD(tt, KR, VR) do { const int t1_ = (tt), blk1_ = t1_ < 4 ? qb : ((t1_ - 4) >> 2), kt1_ = t1_ < 4 ? t1_ : ((t1_ - 4) & 3); const size_t ro_ = (size_t)(blk1_ * 256 + kt1_ * 64 + srow) * 1536; \
            KR = *(const v4u*)(kbase + ro_); VR = *(const v4u*)(kbase + ro_ + 512); } while (0)
#define AT_STORE(tt, KR, VR) do { const int bo_ = ((tt) % 3) * AT_TILE; *(LAS v4u*)(lds + AT_K + bo_ + sdst) = KR; *(LAS v4u*)(lds + AT_V + bo_ + sdst) = VR; } while (0)
        v4u krA, vrA, krB, vrB;
        AT_LOAD(0, krA, vrA); AT_LOAD(1, krB, vrB);
        float qf[32];
        {   const bf16* qp = QKVA + (size_t)tokq * 1536 + h * 64 + 8 * hi;
#pragma unroll
            for (int s = 0; s < 4; ++s) { const v4u w = *(const v4u*)(qp + 16 * s); qf[s * 8 + 0] = bflo(w.x); qf[s * 8 + 1] = bfhi(w.x); qf[s * 8 + 2] = bflo(w.y); qf[s * 8 + 3] = bfhi(w.y); qf[s * 8 + 4] = bflo(w.z); qf[s * 8 + 5] = bfhi(w.z); qf[s * 8 + 6] = bflo(w.w); qf[s * 8 + 7] = bfhi(w.w); } }
        AT_STORE(0, krA, vrA); AT_STORE(1, krB, vrB); AT_LOAD(2, krA, vrA);
        __syncthreads();
        unsigned selmask = 0u;
        {   float g[16];
#pragma unroll
            for (int n = 0; n < 16; ++n) { g[n] = -3e38f;
                if (n < qb) { float d = 0.f;
#pragma unroll
                    for (int s = 0; s < 4; ++s) { const f32x4 k0 = *(const LAS f32x4*)(kms + n * 64 + 16 * s + 8 * hi), k1 = *(const LAS f32x4*)(kms + n * 64 + 16 * s + 8 * hi + 4);
                        d += qf[s * 8] * k0.x + qf[s * 8 + 1] * k0.y + qf[s * 8 + 2] * k0.z + qf[s * 8 + 3] * k0.w + qf[s * 8 + 4] * k1.x + qf[s * 8 + 5] * k1.y + qf[s * 8 + 6] * k1.z + qf[s * 8 + 7] * k1.w; }
                    g[n] = d + shx(d, 32, lane); } }
#pragma unroll
            for (int t = 0; t < 3; ++t) { float best = -3.4e38f; int bi = 0;
#pragma unroll
                for (int n = 0; n < 16; ++n) { const bool ok = !((selmask >> n) & 1u) && g[n] > best; best = ok ? g[n] : best; bi = ok ? n : bi; }
                selmask |= 1u << bi; }
            selmask &= (1u << qb) - 1u; }
        bf16x8 qs[4];
#pragma unroll
        for (int s = 0; s < 4; ++s) { v4u w; w.x = cvtpk(qf[s * 8] * C2, qf[s * 8 + 1] * C2); w.y = cvtpk(qf[s * 8 + 2] * C2, qf[s * 8 + 3] * C2); w.z = cvtpk(qf[s * 8 + 4] * C2, qf[s * 8 + 5] * C2); w.w = cvtpk(qf[s * 8 + 6] * C2, qf[s * 8 + 7] * C2); qs[s] = __builtin_bit_cast(bf16x8, w); }
        float mref = 0.f, lsum = 0.f; f32x16 o0, o1;
#pragma unroll
        for (int r = 0; r < 16; ++r) { o0[r] = 0.f; o1[r] = 0.f; }
        const int NT = 4 * (qb + 1);
        for (int t0 = 0; t0 < NT; t0 += 2) {
#pragma unroll
            for (int hf = 0; hf < 2; ++hf) {
                const int t = t0 + hf;
                const int blk = t < 4 ? qb : ((t - 4) >> 2), kt = t < 4 ? t : ((t - 4) & 3);
                if (hf == 0) { if (t + 3 < NT) AT_LOAD(t + 3, krB, vrB); } else { if (t + 3 < NT) AT_LOAD(t + 3, krA, vrA); }
                const bool own = t < 4;
                const bool lane_act = own || ((selmask >> blk) & 1u);
                const bool wave_act = own ? (kt * 64 <= wv * 32 + 31) : (__builtin_amdgcn_ballot_w64(lane_act) != 0ull);
                if (wave_act) {
                    const LAS unsigned char* Kb = lds + AT_K + (t % 3) * AT_TILE; const LAS unsigned char* Vb = lds + AT_V + (t % 3) * AT_TILE;
                    const float nm = lane_act ? -mref : NINF;
                    f32x16 p0, p1;
#pragma unroll
                    for (int r = 0; r < 16; ++r) { p0[r] = nm; p1[r] = nm; }
#pragma unroll
                    for (int s = 0; s < 4; ++s) { const bf16x8 a0 = *(const LAS bf16x8*)(Kb + r32 * AT_ROWB + 32 * s + 16 * hi), a1 = *(const LAS bf16x8*)(Kb + (32 + r32) * AT_ROWB + 32 * s + 16 * hi);
                        p0 = MFMA32(a0, qs[s], p0); p1 = MFMA32(a1, qs[s], p1); }
                    if (own) {
#pragma unroll
                        for (int r = 0; r < 16; ++r) { const int d0 = qrel - (kt * 64 + crow(r, hi)), d1 = d0 - 32;
                            const float b0 = btab[d0 < 0 ? 0 : (d0 > 128 ? 128 : d0)], b1 = btab[d1 < 0 ? 0 : (d1 > 128 ? 128 : d1)];
                            p0[r] = d0 >= 0 ? p0[r] + b0 : NINF; p1[r] = d1 >= 0 ? p1[r] + b1 : NINF; }
                    } else if (blk == qb - 1 && kt >= 1) {
#pragma unroll
                        for (int r = 0; r < 16; ++r) { const int d0 = qrel + 256 - (kt * 64 + crow(r, hi)), d1 = d0 - 32;
                            p0[r] += btab[d0 > 128 ? 128 : d0]; p1[r] += btab[d1 > 128 ? 128 : d1]; }
                    }
#define MX3_(a_, b_, c_) __builtin_fmaxf(__builtin_fmaxf((a_), (b_)), (c_))
                    float mxa = MX3_(p0[0], p0[1], p1[0]), mxb = MX3_(p0[2], p0[3], p1[1]); mxa = MX3_(mxa, p1[2], p1[3]);
#pragma unroll
                    for (int r = 4; r < 16; r += 4) { mxa = MX3_(mxa, p0[r], p0[r + 1]); mxb = MX3_(mxb, p0[r + 2], p0[r + 3]); mxa = MX3_(mxa, p1[r], p1[r + 1]); mxb = MX3_(mxb, p1[r + 2], p1[r + 3]); }
#undef MX3_
                    float mx = __builtin_fmaxf(mxa, mxb); mx = __builtin_fmaxf(mx, shx(mx, 32, lane));
                    if (__builtin_amdgcn_ballot_w64(mx > 8.f) != 0ull) { const float dl = __builtin_fmaxf(mx, 0.f); mref += dl; const float f = __builtin_amdgcn_exp2f(-dl);
#pragma unroll
                        for (int r = 0; r < 16; ++r) { p0[r] -= dl; p1[r] -= dl; o0[r] *= f; o1[r] *= f; }
                        lsum *= f; }
                    float rs0 = 0.f, rs1 = 0.f;
#pragma unroll
                    for (int r = 0; r < 16; ++r) { p0[r] = __builtin_amdgcn_exp2f(p0[r]); p1[r] = __builtin_amdgcn_exp2f(p1[r]); rs0 += p0[r]; rs1 += p1[r]; }
                    lsum += rs0 + rs1;
                    bf16x8 pa[4];
                    { v4u w; w.x = cvtpk(p0[0], p0[1]); w.y = cvtpk(p0[2], p0[3]); w.z = cvtpk(p0[4], p0[5]); w.w = cvtpk(p0[6], p0[7]); pa[0] = __builtin_bit_cast(bf16x8, w);
                      w.x = cvtpk(p0[8], p0[9]); w.y = cvtpk(p0[10], p0[11]); w.z = cvtpk(p0[12], p0[13]); w.w = cvtpk(p0[14], p0[15]); pa[1] = __builtin_bit_cast(bf16x8, w);
                      w.x = cvtpk(p1[0], p1[1]); w.y = cvtpk(p1[2], p1[3]); w.z = cvtpk(p1[4], p1[5]); w.w = cvtpk(p1[6], p1[7]); pa[2] = __builtin_bit_cast(bf16x8, w);
                      w.x = cvtpk(p1[8], p1[9]); w.y = cvtpk(p1[10], p1[11]); w.z = cvtpk(p1[12], p1[13]); w.w = cvtpk(p1[14], p1[15]); pa[3] = __builtin_bit_cast(bf16x8, w); }
                    const LAS unsigned char* vp = Vb + (4 * hi + ((lane & 15) >> 2)) * AT_ROWB + 2 * (16 * ((lane >> 4) & 1) + 4 * (lane & 3));
#pragma unroll
                    for (int ks = 0; ks < 4; ++ks) { const bf16x8 v0 = vtr2(vp + 16 * ks * AT_ROWB), v1 = vtr2(vp + 16 * ks * AT_ROWB + 64);
                        o0 = MFMA32(v0, pa[ks], o0); o1 = MFMA32(v1, pa[ks], o1); }
                }

                if (hf == 0) { if (t + 2 < NT) AT_STORE(t + 2, krA, vrA); } else { if (t + 2 < NT) AT_STORE(t + 2, krB, vrB); }
                asm volatile("s_waitcnt lgkmcnt(0)\n\ts_barrier" ::: "memory");
            }
        }
#undef AT_LOAD
#undef AT_STORE
        lsum += shx(lsum, 32, lane);
        const float inv = rcpf_(lsum);
        LAS unsigned short* stg = (LAS unsigned short*)(lds + AT_OST + wv * 32 * AT_ROWB);
#pragma unroll
        for (int r = 0; r < 16; ++r) { stg[r32 * (AT_ROWB / 2) + crow(r, hi)] = (unsigned short)(cvtpk(o0[r] * inv, 0.f) & 0xffffu); stg[r32 * (AT_ROWB / 2) + 32 + crow(r, hi)] = (unsigned short)(cvtpk(o1[r] * inv, 0.f) & 0xffffu); }
        LDS_WAIT();
#pragma unroll
        for (int i = 0; i < 4; ++i) { const int row = i * 8 + (lane >> 3), ch = lane & 7; const v4u v = *(const LAS v4u*)((const LAS unsigned char*)stg + row * AT_ROWB + ch * 16);
            *(v4u*)(YA + (size_t)(b * SEQ + qb * 256 + wv * 32 + row) * 512 + h * 64 + ch * 8) = v; }
    }
}
constexpr int NPH_LAYER = 11, NPHASES = 2 + NLAYER * NPH_LAYER;
#ifndef DN_IMPL
#define DN_IMPL 1
#endif
#ifndef PH_MASK
#define PH_MASK 0xFFFF
#endif
#define PH_EN(k) ((PH_MASK >> (k)) & 1)
#define GEMM_PHASE(EPI, SCHED, g, S, E) pg8::gemm_phase<EPI, SCHED, true, true>(c.lds, g, S, E, c.tid)

#define PHASE_FN static __device__ __forceinline__ void
__device__ __forceinline__ KArgs launder_k(KArgs a) { unsigned long long v = (unsigned long long)a; asm volatile("" : "+s"(v)); return (KArgs)v; }
PHASE_FN f_mod(KArgs a, int& tid) { a = launder_k(a); Ctx c = make_ctx(tid); ph_mod(a, c); }
PHASE_FN f_norm1(KArgs a, int& tid, int l) { a = launder_k(a); Ctx c = make_ctx(tid); ph_norm1(a, c, l); __syncthreads(); ph_convert(a, c, l); }
PHASE_FN f_proj(KArgs a, int& tid, int l) { a = launder_k(a); Ctx c = make_ctx(tid);
    pg8::Gemm g{(const bf16*)(a->ws + WS_H), (const bf16*)(a->ws + WS_WIN), NTOK, DINP, DM}; pg8::StaticOrder S; S.init(NTOK, DINP, c.G, c.bid);
    EpiProj E{a->ws}; GEMM_PHASE(EpiProj, pg8::StaticOrder, g, S, E);
    {   volatile LAS int* uw = (volatile LAS int*)(c.lds + MISC_OFF + 512); unsigned* ctr = (unsigned*)(a->ws + WS_CTL) + CW_CCTR + l * 64;
        for (;;) { __syncthreads(); if (c.tid == 0) uw[0] = (int)__hip_atomic_fetch_add(ctr, 1u, RLX_AGENT); __syncthreads();
            const int u = uw[0]; if (u >= CV_EARLYQ) break; convert_unit(a, c, l, u); } } }
PHASE_FN f_kmean(KArgs a, int& tid) { a = launder_k(a); Ctx c = make_ctx(tid); ph_kmean(a, c); }
#ifndef ATTN_IMPL
#define ATTN_IMPL 1
#endif
#if ATTN_IMPL
PHASE_FN f_attn(KArgs a, int& tid, int l) { a = launder_k(a); Ctx c = make_ctx(tid); ph_attn(a, c, l); }
#else
PHASE_FN f_attn(KArgs a, int& tid, int l) { a = launder_k(a); Ctx c = make_ctx(tid); ph_attn_simple(a, c); }
#endif
PHASE_FN f_dn(KArgs a, int& tid, int l) { a = launder_k(a); Ctx c = make_ctx(tid); ph_dn_simple(a, c, l); }
PHASE_FN f_dn_prep(KArgs a, int& tid, int l) { a = launder_k(a); Ctx c = make_ctx(tid); ph_dn_prep(a, c, l); }
PHASE_FN f_dn_scan(KArgs a, int& tid, int l) { a = launder_k(a); Ctx c = make_ctx(tid); ph_dn_scan(a, c, l); }
PHASE_FN f_merge1(KArgs a, int& tid) { a = launder_k(a); Ctx c = make_ctx(tid);
    ph_yb_norm(a, c);
    pg8::Gemm g{(const bf16*)(a->ws + WS_YA), (const bf16*)(a->ws + WS_WUPA), NTOK, DM, WA}; pg8::StaticOrder S; S.init(NTOK, DM, c.G, c.bid);
    EpiMerge<false> E{a->ws}; GEMM_PHASE(EpiMerge<false>, pg8::StaticOrder, g, S, E); }
PHASE_FN f_merge2(KArgs a, int& tid) { a = launder_k(a); Ctx c = make_ctx(tid);
    pg8::Gemm g{(const bf16*)(a->ws + WS_YB), (const bf16*)(a->ws + WS_WUPB), NTOK, DM, WB}; pg8::StaticOrder S; S.init(NTOK, DM, c.G, c.bid);
    EpiMerge<true> E{a->ws}; GEMM_PHASE(EpiMerge<true>, pg8::StaticOrder, g, S, E); }
PHASE_FN f_out(KArgs a, int& tid, int l) { a = launder_k(a); Ctx c = make_ctx(tid);
    pg8::Gemm g{(const bf16*)(a->ws + WS_M), (const bf16*)(a->ws + WS_WOUT), NTOK, DM, DM}; pg8::StaticOrder S; S.init(NTOK, DM, c.G, c.bid);
    EpiOut E{l == 0 ? a->in[I_X] : (const float*)a->out, a->out, (const float*)(a->ws + WS_MOD) + l * 4 * 6144 + 2048}; GEMM_PHASE(EpiOut, pg8::StaticOrder, g, S, E); }
PHASE_FN f_router(KArgs a, int& tid, int l) { a = launder_k(a); Ctx c = make_ctx(tid); ph_router(a, c, l); }
PHASE_FN f_gather(KArgs a, int& tid, int l) { a = launder_k(a); Ctx c = make_ctx(tid); ph_gather(a, c, l); }
PHASE_FN f_moe_gu(KArgs a, int& tid, int l) { a = launder_k(a); Ctx c = make_ctx(tid);
    moe_table(a, c, l); const LAS int* te = (const LAS int*)(c.lds + MISC_OFF + 2048);
    pg8::Gemm g{(const bf16*)(a->ws + WS_HS), (const bf16*)(a->ws + WS_WEGU), MOE_MAXROWS, NEXP * 512, DM}; MoeOrder S{te, te[192 + 32] * 2, c.G, c.bid, 1};
    EpiMoeGU E{a->ws}; GEMM_PHASE(EpiMoeGU, MoeOrder, g, S, E); }
PHASE_FN f_moe_down(KArgs a, int& tid, int l) { a = launder_k(a); Ctx c = make_ctx(tid);
    moe_table(a, c, l); const LAS int* te = (const LAS int*)(c.lds + MISC_OFF + 2048);
    pg8::Gemm g{(const bf16*)(a->ws + WS_ACT), (const bf16*)(a->ws + WS_WED), MOE_MAXROWS, NEXP * 1024, DFF}; MoeOrder S{te, te[192 + 32] * 4, c.G, c.bid, 2};
    EpiMoeDown E{a->ws}; GEMM_PHASE(EpiMoeDown, MoeOrder, g, S, E); }
PHASE_FN f_final(KArgs a, int& tid) { a = launder_k(a); Ctx c = make_ctx(tid); ph_final(a, c); }

#define KA() launder_k((KArgs)__builtin_amdgcn_kernarg_segment_ptr())
__device__ __forceinline__ bool ph_in(int k) { KArgs a = KA(); return a->ph_lo <= k && k < a->ph_hi; }
#ifndef MK_PROBE_A
#define MK_PROBE_A -1
#endif
#ifndef MK_PROBE_B
#define MK_PROBE_B -1
#endif
constexpr int CW_TS = 12288;
__device__ __forceinline__ void grid_bar(int& tid, int k) {
    asm volatile("" : "+v"(tid));
#if MK_ONE_LAUNCH
    KArgs a = KA(); XcdBarrier b; b.bar = (unsigned*)(a->ws + WS_CTL) + CW_BAR; b.x = xb_xcc_id(); b.st = (volatile LAS unsigned*)((LAS unsigned char*)lds_raw + MISC_OFF) + 8;
    xcd_barrier(b, tid);
    if (MK_PROBE_A >= 0 && blockIdx.x == 0 && tid == 0) ((unsigned long long*)((unsigned*)(a->ws + WS_CTL) + CW_TS))[k + 1] = __builtin_amdgcn_s_memrealtime();
#else
    __syncthreads();
#endif
}
__global__ void __launch_bounds__(NTHR, 2) mk_fwd(Args a_) {
    int tid = threadIdx.x;
    {   volatile LAS unsigned* MISC = (volatile LAS unsigned*)((LAS unsigned char*)lds_raw + MISC_OFF);
        if (tid < 64) MISC[tid] = 0u;
        __syncthreads();
#if MK_ONE_LAUNCH
        (void)xcd_barrier_post((unsigned*)(KA()->ws + WS_CTL) + CW_BAR, MISC + 8, tid);
#endif
        if (MK_PROBE_A >= 0 && blockIdx.x == 0 && tid == 0) ((unsigned long long*)((unsigned*)(KA()->ws + WS_CTL) + CW_TS))[0] = __builtin_amdgcn_s_memrealtime();
    }
#define IN(k) ph_in(k)
#define SEAM(k) do { if (IN(k) && IN((k) + 1)) grid_bar(tid, (k)); } while (0)
    if (IN(0)) f_mod(KA(), tid); SEAM(0);
    for (int l = 0; l < NLAYER; ++l) {
        const int pb = 1 + l * NPH_LAYER;
        if (PH_EN(0) && IN(pb + 0)) f_norm1(KA(), tid, l); SEAM(pb + 0);
        if (PH_EN(1) && IN(pb + 1)) f_proj(KA(), tid, l); SEAM(pb + 1);
#if DN_IMPL
        if (PH_EN(2) && IN(pb + 2)) { f_kmean(KA(), tid); f_dn_prep(KA(), tid, l); } SEAM(pb + 2);
        if (PH_EN(3) && IN(pb + 3)) { f_dn_scan(KA(), tid, l);
            if (MK_PROBE_A == 20 && blockIdx.x == 0 && tid == 0) ((unsigned long long*)((unsigned*)(KA()->ws + WS_CTL) + CW_TS))[40 + l] = __builtin_amdgcn_s_memrealtime();
            __syncthreads(); f_attn(KA(), tid, l);
            if (MK_PROBE_A == 21 && blockIdx.x == 255 && tid == 0) ((unsigned long long*)((unsigned*)(KA()->ws + WS_CTL) + CW_TS))[44 + l] = __builtin_amdgcn_s_memrealtime(); } SEAM(pb + 3);
#else
        if (PH_EN(2) && IN(pb + 2)) f_kmean(KA(), tid); SEAM(pb + 2);
        if (PH_EN(3) && IN(pb + 3)) { f_attn(KA(), tid, l); __syncthreads(); f_dn(KA(), tid, l); } SEAM(pb + 3);
#endif
        if (PH_EN(4) && IN(pb + 4)) f_merge1(KA(), tid); SEAM(pb + 4);
        if (PH_EN(5) && IN(pb + 5)) f_merge2(KA(), tid); SEAM(pb + 5);
        if (PH_EN(6) && IN(pb + 6)) f_out(KA(), tid, l); SEAM(pb + 6);
        if (PH_EN(7) && IN(pb + 7)) f_router(KA(), tid, l); SEAM(pb + 7);
        if (PH_EN(8) && IN(pb + 8)) f_gather(KA(), tid, l); SEAM(pb + 8);
        if (PH_EN(9) && IN(pb + 9)) f_moe_gu(KA(), tid, l); SEAM(pb + 9);
        if (PH_EN(10) && IN(pb + 10)) f_moe_down(KA(), tid, l); SEAM(pb + 10);
    }
    if (IN(NPHASES - 1)) f_final(KA(), tid);
#undef IN
#undef SEAM
}

extern "C" void kernel_launch(void* const* d_in, const int* in_sizes, int n_in, void* d_out, int out_size, void* d_ws, size_t ws_size, hipStream_t stream) {
    static int grid = 0;
    if (grid == 0) {
        if (n_in != 23 || out_size != NTOK * DM || ws_size < WS_END) { fprintf(stderr, "kernel_launch: unexpected shapes (n_in %d out %d ws %zu)\n", n_in, out_size, ws_size); grid = -1; return; }
        int dev = 0, cus = 0, per_cu = 0;
        if (hipGetDevice(&dev) != hipSuccess || hipDeviceGetAttribute(&cus, hipDeviceAttributeMultiprocessorCount, dev) != hipSuccess) { grid = -1; return; }
        if (hipFuncSetAttribute((const void*)mk_fwd, hipFuncAttributeMaxDynamicSharedMemorySize, LDS_BYTES) != hipSuccess) { fprintf(stderr, "kernel_launch: hipFuncSetAttribute failed\n"); grid = -1; return; }
        if (hipOccupancyMaxActiveBlocksPerMultiprocessor(&per_cu, (const void*)mk_fwd, NTHR, LDS_BYTES) != hipSuccess || per_cu < 1) { fprintf(stderr, "kernel_launch: occupancy query says %d\n", per_cu); (void)hipGetLastError(); grid = -1; return; }
        grid = cus;
    }
    if (grid < 0) return;
    (void)hipMemsetAsync((char*)d_ws + WS_CTL, 0, CTL_ZERO_BYTES, stream);
    Args a{};
    for (int i = 0; i < 23; ++i) a.in[i] = (const float*)d_in[i];
    a.out = (float*)d_out; a.ws = (unsigned char*)d_ws;
#if MK_ONE_LAUNCH
    a.ph_lo = 0; a.ph_hi = NPHASES;
    hipLaunchKernelGGL(mk_fwd, dim3(grid), dim3(NTHR), LDS_BYTES, stream, a);
#else
    for (int p = 0; p < NPHASES; ++p) { a.ph_lo = p; a.ph_hi = p + 1; hipLaunchKernelGGL(mk_fwd, dim3(grid), dim3(NTHR), LDS_BYTES, stream, a); }
#endif
}
```
